# Optimizing an MI355X kernel written in HIP

```python
import math
import jax, jax.numpy as jnp
from jax import lax
import numpy as np

D_MODEL = 2048
BATCH = 4
SEQ = 2048
DEPTH = 1

D_MIX = D_MODEL
D_HY = D_MIX // 2
D_ML = D_MIX - D_HY
HY_GROUPS = 8
HY_ORDER = 2
HY_SHORT = 3
HY_EMB = 33
HY_FILT_HID = 64
HY_DECAY_TARGET = 1e-2
HY_FAST_PCT = 0.3
HY_SLOW_PCT = 1.5
ML_HEADS = 8
ML_HEAD_DIM = D_ML // ML_HEADS
ML_SHORT = 3
ML_CHUNK = 128
N_GATE_COLS = 4 * ML_HEADS
D_IN = 3 * D_HY + 4 * D_ML + N_GATE_COLS
N_EXPERTS = 32
TOP_K = 4
D_FF = D_MODEL
SWIGLU_LIMIT = 7.0
SWIGLU_ALPHA = 1.702
MOE_BLOCK = 128
LN_EPS = 1e-5
DN_ALPHA = (2 * DEPTH) ** 0.25
DN_BETA = (8 * DEPTH) ** -0.25

kernel_name = 'hyena_mlstm_parallel_moe_deepnorm'

F32 = jnp.float32


def layer_norm(u, g, b):
    uf = u.astype(F32)
    mu = uf.mean(-1, keepdims=True)
    var = jnp.square(uf - mu).mean(-1, keepdims=True)
    return ((uf - mu) * lax.rsqrt(var + LN_EPS)).astype(u.dtype) * g + b


def group_norm(u, g, groups):
    shp = u.shape
    uf = u.astype(F32).reshape(*shp[:-1], groups, shp[-1] // groups)
    mu = uf.mean(-1, keepdims=True)
    var = jnp.square(uf - mu).mean(-1, keepdims=True)
    y = ((uf - mu) * lax.rsqrt(var + LN_EPS)).reshape(shp)
    return y.astype(u.dtype) * g


def centred_conv(u, w, b):
    width = w.shape[0]
    p = width // 2
    L = u.shape[1]
    up = jnp.pad(u, ((0, 0), (p, p), (0, 0)))
    return sum(w[j] * up[:, j:j + L] for j in range(width)) + b


def hyena_filter_spectrum(w1, b1, w2, b2, w3, freq, L):
    t = jnp.linspace(0.0, 1.0, L, dtype=F32)[:, None]
    bands = (HY_EMB - 1) // 2
    fb = jnp.linspace(1e-4, bands - 1, bands, dtype=F32)[None]
    w = 2.0 * math.pi * jnp.arange(L, dtype=F32)[:, None] / L
    z = jnp.concatenate([t, jnp.cos(fb * w), -jnp.sin(fb * w)], -1)
    h = jnp.sin(freq[0].astype(F32) * (z @ w1.astype(F32) + b1.astype(F32)))
    h = jnp.sin(freq[1].astype(F32) * (h @ w2.astype(F32) + b2.astype(F32)))
    h = (h @ w3.astype(F32)).reshape(L, HY_ORDER, 2, D_HY)
    deltas = jnp.abs(jnp.linspace(math.log(HY_DECAY_TARGET) / HY_SLOW_PCT,
                                  math.log(HY_DECAY_TARGET) / HY_FAST_PCT, D_HY, dtype=F32))
    h = h * jnp.exp(-t[:, :, None, None] * deltas)
    fwd, bwd = h[:, :, 0], h[:, :, 1]
    k = jnp.concatenate([fwd, jnp.zeros_like(fwd[:1]), jnp.flip(bwd[1:], 0)], 0)
    k = k / jnp.sum(jnp.abs(k), axis=0, keepdims=True)
    return jnp.fft.rfft(k, axis=0)


def long_conv(z, kf):
    L = z.shape[1]
    zf = jnp.fft.rfft(z, n=2 * L, axis=1)
    return jnp.fft.irfft(zf * kf[None], n=2 * L, axis=1)[:, :L]


def mlstm_chunkwise(q, k, v, ig, fg):
    B, H, L, d = q.shape
    nc = L // ML_CHUNK
    lf = jax.nn.log_sigmoid(fg)

    def chunks(a):
        a = a.reshape(B, H, nc, ML_CHUNK, *a.shape[3:])
        return jnp.moveaxis(a, 2, 0)

    tril = jnp.tril(jnp.ones((ML_CHUNK, ML_CHUNK), bool))

    def step(carry, xs):
        C, n, m = carry
        qc, kc, vc, ic, lfc = xs
        b = jnp.cumsum(lfc, axis=-1)
        b_last = b[..., -1]
        dmat = jnp.where(tril, b[..., :, None] - b[..., None, :] + ic[..., None, :], -jnp.inf)
        inter = b + m[..., None]
        m_t = jnp.maximum(inter, dmat.max(-1))
        s = jnp.einsum('bhtd,bhsd->bhts', qc, kc) * jnp.exp(dmat - m_t[..., None])
        inter_w = jnp.exp(inter - m_t)
        num = jnp.einsum('bhts,bhsd->bhtd', s, vc) + inter_w[..., None] * jnp.einsum('bhvk,bhtk->bhtv', C, qc)
        den = s.sum(-1) + inter_w * jnp.einsum('bhk,bhtk->bht', n, qc)
        h = num / jnp.maximum(jnp.abs(den), jnp.exp(-m_t))[..., None]
        g = b_last[..., None] - b + ic
        m_new = jnp.maximum(b_last + m, g.max(-1))
        wg = jnp.exp(g - m_new[..., None])
        decay = jnp.exp(b_last + m - m_new)
        C_new = decay[..., None, None] * C + jnp.einsum('bhs,bhsv,bhsk->bhvk', wg, vc, kc)
        n_new = decay[..., None] * n + jnp.einsum('bhs,bhsk->bhk', wg, kc)
        return (C_new, n_new, m_new), h

    init = (jnp.zeros((B, H, d, d), F32), jnp.zeros((B, H, d), F32), jnp.zeros((B, H), F32))
    _, hs = lax.scan(step, init, (chunks(q), chunks(k), chunks(v), chunks(ig), chunks(lf)))
    return jnp.moveaxis(hs, 0, 2).reshape(B, H, L, d)


def hybrid_mixer(x, w_in, b_in, hy_conv_w, hy_conv_b, hy_filt_w1, hy_filt_b1, hy_filt_w2,
                 hy_filt_b2, hy_filt_w3, hy_filt_freq, hy_skip, hy_norm_w, ml_conv_w,
                 ml_conv_b, ml_norm_w, w_out, b_out):
    B, L, _ = x.shape
    proj = x @ w_in + b_in
    o1 = 3 * D_HY
    o2 = o1 + 2 * D_ML
    o3 = o2 + D_ML
    o4 = o3 + D_ML
    hy_u, ml_qk, ml_v, ml_o, ml_g = (proj[..., :o1], proj[..., o1:o2], proj[..., o2:o3],
                                     proj[..., o3:o4], proj[..., o4:])

    hy_u = centred_conv(hy_u, hy_conv_w, hy_conv_b).astype(F32)
    v, x1, x2 = jnp.split(hy_u, 3, axis=-1)
    kf = hyena_filter_spectrum(hy_filt_w1, hy_filt_b1, hy_filt_w2, hy_filt_b2, hy_filt_w3,
                               hy_filt_freq, L)
    skip = hy_skip.astype(F32)
    z = x1 * (long_conv(v, kf[:, 0]) + skip[0] * v)
    z = x2 * (long_conv(z, kf[:, 1]) + skip[1] * z)
    y_hy = group_norm(z, hy_norm_w.astype(F32), HY_GROUPS).astype(x.dtype)

    qk = jax.nn.silu(centred_conv(ml_qk, ml_conv_w, ml_conv_b))
    q, k = jnp.split(qk, 2, axis=-1)

    def to_heads(a):
        return a.reshape(B, L, ML_HEADS, ML_HEAD_DIM).transpose(0, 2, 1, 3).astype(F32)

    q, k, vm = to_heads(q), to_heads(k) * (ML_HEAD_DIM ** -0.5), to_heads(ml_v)
    gates = ml_g.astype(F32).reshape(B, L, 2, 2, ML_HEADS).transpose(2, 3, 0, 4, 1)
    h_f = mlstm_chunkwise(q, k, vm, gates[0, 0], gates[0, 1])

    def rev(a):
        return jnp.flip(a, axis=2)

    h_b = rev(mlstm_chunkwise(rev(q), rev(k), rev(vm), rev(gates[1, 0]), rev(gates[1, 1])))
    h = (h_f + h_b).transpose(0, 2, 1, 3).reshape(B, L, D_ML)
    y_ml = (group_norm(h, ml_norm_w.astype(F32), ML_HEADS) * jax.nn.sigmoid(ml_o.astype(F32))).astype(x.dtype)

    return jnp.concatenate([y_hy, y_ml], axis=-1) @ w_out + b_out


def moe_ffn(x, router_w, router_b, w_gu, b_gu, w_down, b_down):
    B, L, D = x.shape
    T = B * L
    TK = T * TOP_K
    xt = x.reshape(T, D)
    logits = (xt @ router_w + router_b).astype(F32)
    top_v, top_i = lax.top_k(logits, TOP_K)
    gates = jax.nn.softmax(top_v, axis=-1)
    e_flat = top_i.reshape(-1)
    tok_flat = jnp.arange(TK) // TOP_K
    order = jnp.argsort(e_flat)
    e_sorted = e_flat[order]
    tok_sorted = tok_flat[order]
    counts = jnp.bincount(e_flat, length=N_EXPERTS)
    starts = jnp.cumsum(counts) - counts
    padded = (counts + MOE_BLOCK - 1) // MOE_BLOCK * MOE_BLOCK
    pstarts = jnp.cumsum(padded) - padded
    dest = pstarts[e_sorted] + (jnp.arange(TK) - starts[e_sorted])
    n_blocks = (TK + MOE_BLOCK - 1) // MOE_BLOCK + N_EXPERTS
    n_rows = n_blocks * MOE_BLOCK
    buf = jnp.zeros((n_rows, D), x.dtype).at[dest].set(xt[tok_sorted])
    block_e = jnp.clip(jnp.searchsorted(pstarts + padded, jnp.arange(n_blocks) * MOE_BLOCK,
                                        side='right'), 0, N_EXPERTS - 1)

    def expert_block(args):
        xb, e = args
        hgu = xb @ w_gu[e] + b_gu[e]
        gate, up = hgu[:, :D_FF], hgu[:, D_FF:]
        gate = jnp.minimum(gate, SWIGLU_LIMIT)
        up = jnp.clip(up, -SWIGLU_LIMIT, SWIGLU_LIMIT)
        act = (up + 1.0) * (gate * jax.nn.sigmoid(SWIGLU_ALPHA * gate))
        return act @ w_down[e] + b_down[e]

    out_buf = lax.map(expert_block, (buf.reshape(n_blocks, MOE_BLOCK, D), block_e)).reshape(n_rows, D)
    y_assign = out_buf[dest] * gates.reshape(-1)[order][:, None].astype(x.dtype)
    y = jax.ops.segment_sum(y_assign, tok_sorted, num_segments=T)
    return y.reshape(B, L, D)


def setup_inputs(seed: int = 0) -> dict:
    key = jax.random.key(seed)
    ks = jax.random.split(key, 32)

    def nrm(k, shape, s):
        return jax.random.normal(k, shape, F32) * s

    x = nrm(ks[0], (BATCH, SEQ, D_MODEL), 1.0)
    w_in = nrm(ks[1], (DEPTH, D_MODEL, D_IN), D_MODEL ** -0.5)
    b_main = nrm(ks[2], (DEPTH, D_IN - N_GATE_COLS), 0.02)
    ig_bias = nrm(ks[3], (DEPTH, 2, 1, ML_HEADS), 0.1)
    fg_bias = jnp.linspace(3.0, 6.0, ML_HEADS, dtype=F32)[None, None, None, :] + nrm(ks[4], (DEPTH, 2, 1, ML_HEADS), 0.1)
    gate_bias = jnp.concatenate([ig_bias, fg_bias], axis=2).reshape(DEPTH, N_GATE_COLS)
    b_in = jnp.concatenate([b_main, gate_bias], axis=-1)
    return {
        'x': x,
        'w_in': w_in,
        'b_in': b_in,
        'hy_conv_w': nrm(ks[5], (DEPTH, HY_SHORT, 3 * D_HY), HY_SHORT ** -0.5),
        'hy_conv_b': nrm(ks[6], (DEPTH, 3 * D_HY), 0.02),
        'hy_filt_w1': nrm(ks[7], (DEPTH, HY_EMB, HY_FILT_HID), HY_EMB ** -0.5),
        'hy_filt_b1': nrm(ks[8], (DEPTH, HY_FILT_HID), 0.02),
        'hy_filt_w2': nrm(ks[9], (DEPTH, HY_FILT_HID, HY_FILT_HID), HY_FILT_HID ** -0.5),
        'hy_filt_b2': nrm(ks[10], (DEPTH, HY_FILT_HID), 0.02),
        'hy_filt_w3': nrm(ks[11], (DEPTH, HY_FILT_HID, HY_ORDER * 2 * D_HY), HY_FILT_HID ** -0.5),
        'hy_filt_freq': 1.0 + nrm(ks[12], (DEPTH, 2, HY_FILT_HID), 0.1),
        'hy_skip': nrm(ks[13], (DEPTH, HY_ORDER, D_HY), 1.0),
        'hy_norm_w': 1.0 + nrm(ks[14], (DEPTH, D_HY), 0.02),
        'ml_conv_w': nrm(ks[15], (DEPTH, ML_SHORT, 2 * D_ML), ML_SHORT ** -0.5),
        'ml_conv_b': nrm(ks[16], (DEPTH, 2 * D_ML), 0.02),
        'ml_norm_w': 1.0 + nrm(ks[17], (DEPTH, D_ML), 0.02),
        'w_out': nrm(ks[18], (DEPTH, D_MIX, D_MODEL), D_MIX ** -0.5 * DN_BETA),
        'b_out': nrm(ks[19], (DEPTH, D_MODEL), 0.02),
        'ln1_g': 1.0 + nrm(ks[20], (DEPTH, D_MODEL), 0.02),
        'ln1_b': nrm(ks[21], (DEPTH, D_MODEL), 0.02),
        'router_w': nrm(ks[22], (DEPTH, D_MODEL, N_EXPERTS), D_MODEL ** -0.5),
        'router_b': nrm(ks[23], (DEPTH, N_EXPERTS), 0.01),
        'w_gu': nrm(ks[24], (DEPTH, N_EXPERTS, D_MODEL, 2 * D_FF), D_MODEL ** -0.5),
        'b_gu': nrm(ks[25], (DEPTH, N_EXPERTS, 2 * D_FF), 0.02),
        'w_down': nrm(ks[26], (DEPTH, N_EXPERTS, D_FF, D_MODEL), D_FF ** -0.5 * DN_BETA),
        'b_down': nrm(ks[27], (DEPTH, N_EXPERTS, D_MODEL), 0.02),
        'ln2_g': 1.0 + nrm(ks[28], (DEPTH, D_MODEL), 0.02),
        'ln2_b': nrm(ks[29], (DEPTH, D_MODEL), 0.02),
    }


def reference(x, w_in, b_in, hy_conv_w, hy_conv_b, hy_filt_w1, hy_filt_b1, hy_filt_w2,
              hy_filt_b2, hy_filt_w3, hy_filt_freq, hy_skip, hy_norm_w, ml_conv_w, ml_conv_b,
              ml_norm_w, w_out, b_out, ln1_g, ln1_b, router_w, router_b, w_gu, b_gu, w_down,
              b_down, ln2_g, ln2_b):
    for l in range(DEPTH):
        mix = hybrid_mixer(x, w_in[l], b_in[l], hy_conv_w[l], hy_conv_b[l], hy_filt_w1[l],
                           hy_filt_b1[l], hy_filt_w2[l], hy_filt_b2[l], hy_filt_w3[l],
                           hy_filt_freq[l], hy_skip[l], hy_norm_w[l], ml_conv_w[l], ml_conv_b[l],
                           ml_norm_w[l], w_out[l], b_out[l])
        x = layer_norm(DN_ALPHA * x + mix, ln1_g[l], ln1_b[l])
        ff = moe_ffn(x, router_w[l], router_b[l], w_gu[l], b_gu[l], w_down[l], b_down[l])
        x = layer_norm(DN_ALPHA * x + ff, ln2_g[l], ln2_b[l])
    return x
```

```cpp
#include <hip/hip_runtime.h>
#include <cstdio>
#include <cstdint>
namespace pg8 {
#define PG8_LAS __attribute__((address_space(3)))
typedef unsigned short bf16_t;
typedef short bf16x8 __attribute__((ext_vector_type(8)));
typedef float f32x4 __attribute__((ext_vector_type(4)));
typedef unsigned u32x4 __attribute__((ext_vector_type(4)));
constexpr int BM = 256, BK = 64, HALF = 128, HTB = HALF * BK * 2  , STAGE_BYTES = 8 * HTB, NXCD = 8, WGM = 8;

__host__ __device__ __forceinline__ int lds_byte(int r, int c) { const int st = (r >> 4) * 2 + (c >> 5), rr = r & 15, cc = c & 31, ob = rr * 64 + cc * 2; return st * 1024 + (ob ^ (((ob >> 9) & 1) << 5)); }
__host__ __device__ __forceinline__ void stage_rc(int b, int& R, int& C) { const int st = b / 1024, sb = b % 1024, swz = sb ^ (((sb >> 9) & 1) << 5); R = (st >> 1) * 16 + swz / 64; C = (st & 1) * 32 + (swz % 64) / 2; }
__host__ __device__ __forceinline__ int perm32(int rho) { const int n = rho >> 4, i = rho & 15; return 8 * (i >> 2) + 4 * n + (i & 3); }

struct Unit { int pm, pn; };
struct Gemm { const bf16_t* A; const bf16_t* Bt; int M, N, K; };
__device__ __forceinline__ unsigned cvt_pk_bf16(float lo, float hi) { unsigned r; asm volatile("v_cvt_pk_bf16_f32 %0, %1, %2" : "=v"(r) : "v"(lo), "v"(hi)); return r; }
typedef float f32x2 __attribute__((ext_vector_type(2)));
template <class Epi, class Sched, bool ALIGN_EPI = false, bool SP2 = false>
__device__ __forceinline__ void gemm_phase(PG8_LAS unsigned char* lds, const Gemm g, const Sched& S, const Epi& E) {
    const int tid = threadIdx.x, wid = __builtin_amdgcn_readfirstlane(tid >> 6), lane = tid & 63, wr = wid >> 2, wc = wid & 3, fr = lane & 15, fq = lane >> 4;
    const int K = g.K, nt = K / BK;
    unsigned voffA[2], voffB[2];
#pragma unroll
    for (int i = 0; i < 2; ++i) { int R, C; stage_rc(tid * 16 + i * 8192, R, C); const int Rb = Epi::PERM ? ((R & ~31) + perm32(R & 31)) : R;
        voffA[i] = (unsigned)(R * K + C) * 2u; voffB[i] = (unsigned)(Rb * K + C) * 2u; }
    const size_t kstep = (size_t)(BK * 2);
    const size_t hstep = (size_t)HALF * K * 2;
    const size_t tstep = 2 * hstep;
    const unsigned ldsw = (unsigned)wid * 1024u;
    const int aoff = lds_byte(wr * 64 + fr, fq * 8), boff = lds_byte(wc * 32 + fr, fq * 8);
#define PG8_SA(b, h) (((b) * 2 + (h)) * HTB)
#define PG8_SB(b, h) ((4 + (b) * 2 + (h)) * HTB)
#define PG8_STAGE(bufoff, gbase, voff) do { _Pragma("unroll") for (int _i = 0; _i < 2; ++_i) \
        __builtin_amdgcn_global_load_lds((const unsigned*)((const char*)(gbase) + (voff)[_i]), (PG8_LAS unsigned*)(lds + (bufoff) + ldsw + _i * 8192), 16, 0, 0); } while (0)
#define PG8_LDA(dst, b, h) do { _Pragma("unroll") for (int m = 0; m < 4; ++m) _Pragma("unroll") for (int k = 0; k < 2; ++k) dst[m][k] = *(const PG8_LAS bf16x8*)(lds + PG8_SA(b, h) + aoff + m * 2048 + k * 1024); } while (0)
#define PG8_LDB(dst, b, h) do { _Pragma("unroll") for (int n = 0; n < 2; ++n) _Pragma("unroll") for (int k = 0; k < 2; ++k) dst[n][k] = *(const PG8_LAS bf16x8*)(lds + PG8_SB(b, h) + boff + n * 2048 + k * 1024); } while (0)
#define PG8_MMA(ai, bj, At, Bt) do { __builtin_amdgcn_s_setprio(1); _Pragma("unroll") for (int m = 0; m < 4; ++m) _Pragma("unroll") for (int n = 0; n < 2; ++n) _Pragma("unroll") for (int k = 0; k < 2; ++k) \
        acc[ai][bj][m][n] = __builtin_amdgcn_mfma_f32_16x16x32_bf16(Bt[n][k], At[m][k], acc[ai][bj][m][n], 0, 0, 0); __builtin_amdgcn_s_setprio(0); } while (0)
#define PG8_WAIT_V(n) asm volatile("s_waitcnt vmcnt(" #n ")" ::: "memory")
#define PG8_WAIT_L(n) asm volatile("s_waitcnt lgkmcnt(" #n ")" ::: "memory")
#define PG8_BAR __builtin_amdgcn_s_barrier()
#define PG8_SCHED __builtin_amdgcn_sched_barrier(0)
    Unit cur, nxt; int ui = 0;
    if (!S.next(0, cur)) return;
    f32x4 acc[2][2][4][2];
#pragma unroll
    for (int a = 0; a < 2; ++a)
#pragma unroll
        for (int b = 0; b < 2; ++b)
#pragma unroll
            for (int m = 0; m < 4; ++m)
#pragma unroll
                for (int n = 0; n < 2; ++n) acc[a][b][m][n] = (f32x4){0.f, 0.f, 0.f, 0.f};
    bf16x8 At[4][2], B0[2][2], B1[2][2];
    const char* cA = (const char*)g.A + (size_t)cur.pm * tstep; const char* cB = (const char*)g.Bt + (size_t)cur.pn * tstep;
    S.a_ready(cur);
    if constexpr (SP2) {
        PG8_STAGE(PG8_SB(0, 0), cB, voffB); PG8_STAGE(PG8_SB(0, 1), cB + hstep, voffB); PG8_STAGE(PG8_SA(0, 0), cA, voffA); PG8_STAGE(PG8_SA(0, 1), cA + hstep, voffA);
        if (wr == 1) PG8_BAR;
        PG8_WAIT_V(2); PG8_BAR;
        PG8_STAGE(PG8_SB(1, 0), cB + kstep, voffB); PG8_STAGE(PG8_SA(1, 0), cA + kstep, voffA); PG8_STAGE(PG8_SB(1, 1), cB + hstep + kstep, voffB);
        PG8_WAIT_V(6); PG8_BAR;
    } else {
        PG8_STAGE(PG8_SB(0, 0), cB, voffB); PG8_STAGE(PG8_SA(0, 0), cA, voffA); PG8_STAGE(PG8_SB(0, 1), cB + hstep, voffB); PG8_STAGE(PG8_SA(0, 1), cA + hstep, voffA);
        if (wr == 1) PG8_BAR;
        PG8_WAIT_V(4); PG8_BAR;
        PG8_STAGE(PG8_SB(1, 0), cB + kstep, voffB); PG8_STAGE(PG8_SA(1, 0), cA + kstep, voffA); PG8_STAGE(PG8_SB(1, 1), cB + hstep + kstep, voffB);
        PG8_WAIT_V(6); PG8_BAR;
    }
    for (;;) {
        const bool has_next = S.next(ui + 1, nxt);
        const char* nA = has_next ? (const char*)g.A + (size_t)nxt.pm * tstep : cA; const char* nB = has_next ? (const char*)g.Bt + (size_t)nxt.pn * tstep : cB;
        for (int t = 0; t < nt; t += 2) {
            const bool last = (t == nt - 2);
            const char* a1 = cA + (size_t)(t + 1) * kstep;
            const char* a2 = last ? nA : cA + (size_t)(t + 2) * kstep; const char* b2 = last ? nB : cB + (size_t)(t + 2) * kstep;
            const char* a3 = a2 + kstep; const char* b3 = b2 + kstep;
            if (last && has_next) S.a_ready(nxt);
            if constexpr (SP2) {
            PG8_LDB(B0, 0, 0); PG8_LDB(B1, 0, 1); PG8_SCHED; PG8_LDA(At, 0, 0); PG8_STAGE(PG8_SA(1, 1), a1 + hstep, voffA);
            PG8_WAIT_V(8); PG8_WAIT_L(0); PG8_BAR; PG8_MMA(0, 0, At, B0); PG8_MMA(0, 1, At, B1); PG8_BAR; PG8_SCHED;
            PG8_LDA(At, 0, 1); PG8_STAGE(PG8_SB(0, 0), b2, voffB); PG8_STAGE(PG8_SB(0, 1), b2 + hstep, voffB); PG8_STAGE(PG8_SA(0, 0), a2, voffA);
            PG8_WAIT_V(8); PG8_WAIT_L(0); PG8_BAR; PG8_MMA(1, 0, At, B0); PG8_MMA(1, 1, At, B1); PG8_BAR; PG8_SCHED;
            PG8_LDB(B0, 1, 0); PG8_LDB(B1, 1, 1); PG8_SCHED; PG8_LDA(At, 1, 0); PG8_STAGE(PG8_SA(0, 1), a2 + hstep, voffA);
            PG8_WAIT_V(8); PG8_WAIT_L(0); PG8_BAR; PG8_MMA(0, 0, At, B0); PG8_MMA(0, 1, At, B1); PG8_BAR; PG8_SCHED;
            PG8_LDA(At, 1, 1); PG8_STAGE(PG8_SB(1, 0), b3, voffB); PG8_STAGE(PG8_SB(1, 1), b3 + hstep, voffB); PG8_STAGE(PG8_SA(1, 0), a3, voffA);
            PG8_WAIT_V(8); PG8_WAIT_L(0); PG8_BAR; PG8_MMA(1, 0, At, B0); PG8_MMA(1, 1, At, B1); PG8_BAR; PG8_SCHED;
            } else {
            PG8_LDB(B0, 0, 0); PG8_SCHED; PG8_LDA(At, 0, 0); PG8_STAGE(PG8_SA(1, 1), a1 + hstep, voffA);
            PG8_WAIT_L(8); PG8_BAR; PG8_WAIT_L(0); PG8_MMA(0, 0, At, B0); PG8_BAR; PG8_SCHED;
            PG8_LDB(B1, 0, 1); PG8_STAGE(PG8_SB(0, 0), b2, voffB);
            PG8_BAR; PG8_WAIT_L(0); PG8_MMA(0, 1, At, B1); PG8_BAR;
            PG8_LDA(At, 0, 1); PG8_STAGE(PG8_SA(0, 0), a2, voffA);
            PG8_BAR; PG8_WAIT_L(0); PG8_MMA(1, 0, At, B0); PG8_BAR; PG8_SCHED;
            PG8_STAGE(PG8_SB(0, 1), b2 + hstep, voffB);
            PG8_WAIT_V(6); PG8_BAR; PG8_MMA(1, 1, At, B1); PG8_BAR;
            PG8_LDB(B0, 1, 0); PG8_SCHED; PG8_LDA(At, 1, 0); PG8_STAGE(PG8_SA(0, 1), a2 + hstep, voffA);
            PG8_WAIT_L(8); PG8_BAR; PG8_WAIT_L(0); PG8_MMA(0, 0, At, B0); PG8_BAR; PG8_SCHED;
            PG8_LDB(B1, 1, 1); PG8_STAGE(PG8_SB(1, 0), b3, voffB);
            PG8_BAR; PG8_WAIT_L(0); PG8_MMA(0, 1, At, B1); PG8_BAR;
            PG8_LDA(At, 1, 1); PG8_STAGE(PG8_SA(1, 0), a3, voffA);
            PG8_BAR; PG8_WAIT_L(0); PG8_MMA(1, 0, At, B0); PG8_BAR; PG8_SCHED;
            PG8_STAGE(PG8_SB(1, 1), b3 + hstep, voffB);
            PG8_WAIT_V(6); PG8_BAR; PG8_MMA(1, 1, At, B1); PG8_BAR;
            }
        }
        if constexpr (ALIGN_EPI) { if (wr == 0) PG8_BAR; }
        if constexpr (!Epi::AFTER_DRAIN) { E(acc, cur, wr, wc, fr, fq); S.done(cur); }
        if (!has_next) break;
#pragma unroll
        for (int a = 0; a < 2; ++a)
#pragma unroll
            for (int b = 0; b < 2; ++b)
#pragma unroll
                for (int m = 0; m < 4; ++m)
#pragma unroll
                    for (int n = 0; n < 2; ++n) acc[a][b][m][n] = (f32x4){0.f, 0.f, 0.f, 0.f};
        cur = nxt; cA = nA; cB = nB; ++ui;
        if constexpr (ALIGN_EPI) { if (wr == 1) PG8_BAR; }
    }
    PG8_WAIT_V(0);
    if constexpr (!ALIGN_EPI) { if (wr == 0) PG8_BAR; }
    PG8_BAR;
    if constexpr (Epi::AFTER_DRAIN) { E.fused(acc, cur, wr, wc, fr, fq, lds, wid, lane); S.done(cur); }
#undef PG8_SA
#undef PG8_SB
#undef PG8_STAGE
#undef PG8_LDA
#undef PG8_LDB
#undef PG8_MMA
#undef PG8_WAIT_V
#undef PG8_WAIT_L
#undef PG8_BAR
#undef PG8_SCHED
}
}

constexpr int NB = 4, SEQ = 2048, T = NB * SEQ, D = 2048, DHY = 1024, DML = 1024, DIN = 7200, NE = 32, TOPK = 4, NH = 8, HD = 128, DFF = 2048;
constexpr float LN_EPS = 1e-5f, DN_ALPHA = 1.189207115002721f;
constexpr int NWAVES = 8, NTHREADS = 512;
#ifndef MK_ONE_LAUNCH
#define MK_ONE_LAUNCH 1
#endif
constexpr int N_PHASES = 11;

constexpr size_t MiB = 1u << 20;
constexpr size_t WS_CTL = 0, CTL_ZERO_BYTES = 1 * MiB;
constexpr size_t WS_H2 = 1 * MiB;
constexpr size_t WS_GATES = 2 * MiB;
constexpr size_t WS_TOKW = 3 * MiB;
constexpr size_t WS_LIST = 4 * MiB;
constexpr size_t WS_ROWSLOT = 5 * MiB;
constexpr size_t WS_ROWW = 5 * MiB + 512 * 1024;
constexpr size_t WS_GA = 6 * MiB, WS_GP = 6 * MiB + 512 * 1024, WS_GE = 7 * MiB;
constexpr size_t TILE_BYTES = 256 * 2048 * 2;
constexpr int XB_T0 = 8, WIN_T0 = 40, WOUT_T0 = 72, YCAT_T0 = 80, X1B_T0 = 112, ABUF_T0 = 144, ACT_T0 = 304, WGU_T0 = 464, WDN_T0 = 976;
constexpr size_t WS_HYT = 1232 * MiB;
constexpr size_t WS_QKRAW = 1296 * MiB;
constexpr size_t WS_OB = 1328 * MiB;
constexpr size_t WS_QKC = 1344 * MiB;
constexpr size_t WS_KT = 1376 * MiB;
constexpr size_t WS_Z = 1408 * MiB;
constexpr size_t WS_HML = 1440 * MiB;
constexpr size_t WS_R1 = 1504 * MiB;
constexpr size_t WS_YBUF = 1568 * MiB;
constexpr size_t WS_VB = 1824 * MiB;
constexpr size_t WS_END = 1840 * MiB;
constexpr int CW_BAR = 4096, CW_CNT = 16384;

constexpr int LDS_STAGE = 131072, LDS_MISC = LDS_STAGE, LDS_TB = LDS_STAGE + 64, LDS_BYTES = 147456;

#define GAS __attribute__((address_space(1)))
#define LAS __attribute__((address_space(3)))
typedef unsigned short bf16;
typedef unsigned v4u __attribute__((ext_vector_type(4)));
typedef unsigned v2u __attribute__((ext_vector_type(2)));
typedef float f32x4 __attribute__((ext_vector_type(4)));
typedef float f32x2 __attribute__((ext_vector_type(2)));
#define LDS_WAIT() asm volatile("s_waitcnt lgkmcnt(0)" ::: "memory")
__device__ __forceinline__ unsigned f2bf(float f) { unsigned u = __builtin_bit_cast(unsigned, f); return (u + 0x7fffu + ((u >> 16) & 1u)) >> 16; }
__device__ __forceinline__ unsigned pk2(float lo, float hi) { return f2bf(lo) | (f2bf(hi) << 16); }
__device__ __forceinline__ float bflo(unsigned w) { return __builtin_bit_cast(float, w << 16); }
__device__ __forceinline__ float bfhi(unsigned w) { return __builtin_bit_cast(float, w & 0xffff0000u); }
__device__ __forceinline__ float bf2f(bf16 b) { return __builtin_bit_cast(float, (unsigned)b << 16); }
__device__ __forceinline__ float wave_sum(float v) {
#pragma unroll
    for (int o = 1; o < 64; o <<= 1) v += __shfl_xor(v, o);
    return v;
}
__device__ __forceinline__ float wave_max(float v) {
#pragma unroll
    for (int o = 1; o < 64; o <<= 1) v = fmaxf(v, __shfl_xor(v, o));
    return v;
}

#define XB_TMO      128
#define XB_XCNT(j)  (256  + 64 * (j))
#define XB_XSUB(j)  (1280 + 64 * (j))
#define XB_XGEN(j)  (2304 + 64 * (j))
#define XB_TOP      3328
#define XB_TOPGEN   3392
#define XCD_BAR_WORDS 3456
#define XB_SPIN_CAP (1u << 22)

__device__ __forceinline__ unsigned xb_ld(unsigned* p)              { return __hip_atomic_load(p, __ATOMIC_RELAXED, __HIP_MEMORY_SCOPE_AGENT); }
__device__ __forceinline__ unsigned xb_add(unsigned* p, unsigned v) { return __hip_atomic_fetch_add(p, v, __ATOMIC_RELAXED, __HIP_MEMORY_SCOPE_AGENT); }
__device__ __forceinline__ unsigned xb_xcc_id() { return (unsigned)__builtin_amdgcn_s_getreg((3 << 11) | 20) & 0xFu; }
#define XB_SPIN(cond, bar) do { unsigned _sp = 0; while (cond) { __builtin_amdgcn_s_sleep(1); \
    if ((++_sp & 255u) == 0u) { if (xb_ld(&(bar)[XB_TMO])) break; if (_sp > XB_SPIN_CAP) { atomicAdd(&(bar)[XB_TMO], 1u); break; } } } } while (0)

struct XcdBarrier {
    unsigned* bar; unsigned x;
    volatile LAS unsigned* st;
};

__device__ __forceinline__ XcdBarrier xcd_barrier_post(unsigned* bar, volatile LAS unsigned* st) {
    XcdBarrier b; b.bar = bar; b.x = xb_xcc_id(); b.st = st;
    if (threadIdx.x == 0) (void)xb_add(&bar[XB_XCNT(b.x)], 1u);
    return b;
}
__device__ __forceinline__ void xcd_barrier_complete(unsigned* bar, unsigned x, unsigned& nloc, unsigned& nx) {
    const unsigned G = gridDim.x * gridDim.y * gridDim.z;
    unsigned sum, cnt, mine, sp = 0u;
    for (;;) {
        sum = 0u; cnt = 0u; mine = 0u;
#pragma unroll
        for (unsigned j = 0; j < 16; ++j) { const unsigned c = xb_ld(&bar[XB_XCNT(j)]); sum += c; cnt += (c > 0u) ? 1u : 0u; mine = (j == x) ? c : mine; }
        if (sum == G) break;
        __builtin_amdgcn_s_sleep(1);
        if ((++sp & 255u) == 0u) { if (xb_ld(&bar[XB_TMO])) break; if (sp > XB_SPIN_CAP) { atomicAdd(&bar[XB_TMO], 1u); break; } }
    }
    nloc = mine > 0u ? mine : 1u; nx = cnt > 0u ? cnt : 1u;
}

__device__ __forceinline__ void xcd_barrier(const XcdBarrier& b) {
    asm volatile("s_waitcnt vmcnt(0)" ::: "memory");
    __syncthreads();
    if (threadIdx.x == 0) {
        unsigned* bar = b.bar;
        __builtin_amdgcn_s_waitcnt(0);
        unsigned nloc = b.st[0], nx = b.st[1];
        if (nloc == 0u) { xcd_barrier_complete(bar, b.x, nloc, nx); b.st[0] = nloc; b.st[1] = nx; }
        const unsigned old = xb_add(&bar[XB_XSUB(b.x)], 1u);
        const unsigned gen = old / nloc;
        if (old + 1u == (gen + 1u) * nloc) {
            __builtin_amdgcn_fence(__ATOMIC_RELEASE, "agent");
            asm volatile("s_waitcnt vmcnt(0)" ::: "memory");
            const unsigned og = xb_add(&bar[XB_TOP], 1u);
            const unsigned tg = og / nx;
            if (og + 1u == (tg + 1u) * nx) xb_add(&bar[XB_TOPGEN], 1u);
            else XB_SPIN(xb_ld(&bar[XB_TOPGEN]) == tg, bar);
            __builtin_amdgcn_fence(__ATOMIC_ACQUIRE, "agent");
            xb_add(&bar[XB_XGEN(b.x)], 1u);
            asm volatile("s_waitcnt vmcnt(0)" ::: "memory");
        } else {
            XB_SPIN(xb_ld(&bar[XB_XGEN(b.x)]) == gen, bar);
            __builtin_amdgcn_fence(__ATOMIC_ACQUIRE, "agent");
            asm volatile("s_waitcnt vmcnt(0)" ::: "memory");
        }
    }
    __syncthreads();
}


struct KArgs { const float* in[28]; float* out; unsigned char* ws; int ph_lo, ph_hi; };
struct Ctx {
    const float* in[28]; float* out; unsigned char* ws; LAS unsigned char* lds;
    int tid, lane, wave, G, gw, NGW;
};

__device__ __forceinline__ void transpose_item(const float* __restrict__ W, int N, int k0, int n0, bf16* __restrict__ dst, LAS float* scr, int lane) {
#pragma unroll 8
    for (int i = 0; i < 32; ++i) { const int kk = 2 * i + (lane >> 5); scr[kk * 33 + (lane & 31)] = W[(size_t)(k0 + kk) * N + n0 + (lane & 31)]; }
    LDS_WAIT(); asm volatile("" ::: "memory");
    const int c = lane & 7;
#pragma unroll
    for (int j = 0; j < 4; ++j) { const int n = (lane >> 3) + 8 * j; const LAS float* s = scr + (8 * c) * 33 + n;
        v4u o; o.x = pk2(s[0 * 33], s[1 * 33]); o.y = pk2(s[2 * 33], s[3 * 33]); o.z = pk2(s[4 * 33], s[5 * 33]); o.w = pk2(s[6 * 33], s[7 * 33]);
        *(v4u*)(dst + (size_t)n * 2048 + k0 + 8 * c) = o; }
    LDS_WAIT(); asm volatile("" ::: "memory");
}

__device__ __forceinline__ void phase0(const Ctx& C) {
    unsigned char* ws = C.ws;
    {
        const f32x4* x4 = (const f32x4*)C.in[0]; v4u* xb = (v4u*)(ws + (size_t)XB_T0 * MiB);
        const size_t n8 = (size_t)T * D / 8;
        for (size_t i = (size_t)blockIdx.x * NTHREADS + C.tid; i < n8; i += (size_t)C.G * NTHREADS) {
            const f32x4 a = x4[2 * i], b = x4[2 * i + 1]; v4u o; o.x = pk2(a.x, a.y); o.y = pk2(a.z, a.w); o.z = pk2(b.x, b.y); o.w = pk2(b.z, b.w); xb[i] = o; }
    }
    {
        LAS float* scr = (LAS float*)(C.lds + C.wave * 8448);
        constexpr int I_IN = 32 * 225, I_OUT = 32 * 64, I_GU = NE * 32 * 128, I_DN = NE * 32 * 64, NITEMS = I_IN + I_OUT + I_GU + I_DN;
        bf16* win_t = (bf16*)(ws + (size_t)WIN_T0 * MiB); bf16* wout_t = (bf16*)(ws + (size_t)WOUT_T0 * MiB);
        bf16* wgu_t = (bf16*)(ws + (size_t)WGU_T0 * MiB); bf16* wdn_t = (bf16*)(ws + (size_t)WDN_T0 * MiB);
        for (int it = C.gw; it < NITEMS; it += C.NGW) {
            int r = it;
            if (r < I_IN) { const int kb = r / 225, nb = r % 225; transpose_item(C.in[1], DIN, 64 * kb, 32 * nb, win_t + (size_t)(32 * nb) * 2048, scr, C.lane); continue; } r -= I_IN;
            if (r < I_OUT) { const int kb = r / 64, nb = r % 64; transpose_item(C.in[16], D, 64 * kb, 32 * nb, wout_t + (size_t)(32 * nb) * 2048, scr, C.lane); continue; } r -= I_OUT;
            if (r < I_GU) { const int e = r / 4096, rr = r % 4096, kb = rr / 128, nb = rr % 128, n0 = 32 * nb;
                const int drow = (n0 < 2048) ? ((n0 >> 7) * 256 + (n0 & 127)) : ((((n0 - 2048) >> 7) * 256) + 128 + ((n0 - 2048) & 127));
                transpose_item(C.in[22] + (size_t)e * 2048 * 4096, 4096, 64 * kb, n0, wgu_t + ((size_t)e * 4096 + drow) * 2048, scr, C.lane); continue; } r -= I_GU;
            { const int e = r / 2048, rr = r % 2048, kb = rr / 64, nb = rr % 64;
                transpose_item(C.in[24] + (size_t)e * 2048 * 2048, 2048, 64 * kb, 32 * nb, wdn_t + ((size_t)e * 2048 + 32 * nb) * 2048, scr, C.lane); }
        }
    }
    __syncthreads();
    {
        const float* w1 = C.in[5]; const float* b1 = C.in[6]; const float* w2 = C.in[7]; const float* b2 = C.in[8]; const float* freq = C.in[10];
        float* H2 = (float*)(ws + WS_H2); LAS float* h1s = (LAS float*)C.lds;
        const int tt = C.tid >> 6, j = C.tid & 63;
        for (int tb = blockIdx.x; tb < SEQ / 8; tb += C.G) {
            const int t = tb * 8 + tt;
            const float zt = (float)t / 2047.0f, wt = 6.283185307179586f * (float)t / 2048.0f;
            float acc = b1[j] + zt * w1[j];
            for (int i = 0; i < 16; ++i) { const float fb = 1e-4f + (float)i * ((15.0f - 1e-4f) / 15.0f); const float arg = fb * wt;
                acc += cosf(arg) * w1[(1 + i) * 64 + j] - sinf(arg) * w1[(17 + i) * 64 + j]; }
            h1s[tt * 64 + j] = sinf(freq[j] * acc);
            __syncthreads();
            float a2 = b2[j];
            for (int i = 0; i < 64; ++i) a2 += h1s[tt * 64 + i] * w2[i * 64 + j];
            H2[t * 64 + j] = sinf(freq[64 + j] * a2);
            __syncthreads();
        }
    }
}

#ifndef NAIVE_ML
#define NAIVE_ML 1
#endif
constexpr int N1_SW_TILES = 16, N1_SW = N1_SW_TILES * 32;
constexpr int N1_NORM_TILES = NAIVE_ML ? 17 : 13, N1_NORM = N1_NORM_TILES * 32, N1_UNITS = N1_SW + N1_NORM;
struct Gemm1Order {
    int G, c;
    __device__ __forceinline__ bool next(int i, pg8::Unit& u) const {
        const int L = i * G + c; if (L >= N1_UNITS) return false;
        int w; { const int q = N1_UNITS / 8, r = N1_UNITS % 8, xcd = L % 8, off = L / 8; w = (xcd < r ? xcd * (q + 1) : r * (q + 1) + (xcd - r) * q) + off; }
        if (w < N1_SW) { const int nig = 8 * 32, gid = w / nig, wi = w % nig, mi = gid * 8 + (wi % 8), ni = wi / 8;
            u.pm = WIN_T0 + (mi < 12 ? mi : 8 + mi); u.pn = XB_T0 + ni; }
        else { w -= N1_SW; const int nig = 8 * N1_NORM_TILES, gid = w / nig, wi = w % nig, mi = gid * 8 + (wi % 8), ni = wi / 8;
            int wt;
            if (NAIVE_ML) wt = (ni < 16) ? 12 + ni : 28; else wt = (ni < 8) ? 12 + ni : 16 + ni;
            u.pm = XB_T0 + mi; u.pn = WIN_T0 + wt; }
        return true;
    }
    __device__ __forceinline__ void a_ready(const pg8::Unit&) const {}
    __device__ __forceinline__ void done(const pg8::Unit&) const {}
};
struct Epi1 {
    static constexpr bool PERM = true, AFTER_DRAIN = false;
    const float* b_in; bf16* hyt; bf16* qkraw; bf16* vb; bf16* ob; float* gates;
    __device__ __forceinline__ void operator()(const pg8::f32x4 (&acc)[2][2][4][2], const pg8::Unit& u, int wr, int wc, int fr, int fq) const {
        using pg8::cvt_pk_bf16;
        if (u.pm >= WIN_T0) {
            const int wt = u.pm - WIN_T0, tt = u.pn - XB_T0;
            const int col0 = tt * 256 + wc * 32 + 8 * fq;
#pragma unroll
            for (int ai = 0; ai < 2; ++ai)
#pragma unroll
                for (int m = 0; m < 4; ++m) {
                    const int ch = wt * 256 + ai * 128 + wr * 64 + m * 16 + fr; const float bv = b_in[ch];
                    const int drow = ch < 3072 ? ch : ch - 2048;
                    bf16* rowp = hyt + (size_t)drow * T + col0;
#pragma unroll
                    for (int bj = 0; bj < 2; ++bj) { const pg8::f32x4 v0 = acc[ai][bj][m][0] + bv, v1 = acc[ai][bj][m][1] + bv;
                        v4u w; w.x = cvt_pk_bf16(v0[0], v0[1]); w.y = cvt_pk_bf16(v0[2], v0[3]); w.z = cvt_pk_bf16(v1[0], v1[1]); w.w = cvt_pk_bf16(v1[2], v1[3]);
                        *(v4u*)(rowp + bj * 128) = w; }
                }
        } else {
            const int tt = u.pm - XB_T0, wt = u.pn - WIN_T0;
            const int chb = wt * 256 + wc * 32 + 8 * fq;
            pg8::f32x4 bv[2][2];
#pragma unroll
            for (int bj = 0; bj < 2; ++bj)
#pragma unroll
                for (int n = 0; n < 2; ++n) { const int c0 = chb + bj * 128 + 4 * n; bv[bj][n] = (c0 < DIN) ? *(const pg8::f32x4*)(b_in + c0) : (pg8::f32x4){0.f, 0.f, 0.f, 0.f}; }
            if (wt == 28) {
                if (wc == 0) {
#pragma unroll
                    for (int ai = 0; ai < 2; ++ai)
#pragma unroll
                        for (int m = 0; m < 4; ++m) { const int tok = tt * 256 + ai * 128 + wr * 64 + m * 16 + fr;
                            float* gp = gates + (size_t)tok * 32 + 8 * fq;
                            *(pg8::f32x4*)(gp) = acc[ai][0][m][0] + bv[0][0]; *(pg8::f32x4*)(gp + 4) = acc[ai][0][m][1] + bv[0][1]; }
                }
            } else {
#define EPI1_STORE(base, ld, cb) do { _Pragma("unroll") for (int ai = 0; ai < 2; ++ai) _Pragma("unroll") for (int m = 0; m < 4; ++m) { const int tok = tt * 256 + ai * 128 + wr * 64 + m * 16 + fr; \
                    bf16* rowp = (base) + (size_t)tok * (ld) + (cb); \
                    _Pragma("unroll") for (int bj = 0; bj < 2; ++bj) { const pg8::f32x4 v0 = acc[ai][bj][m][0] + bv[bj][0], v1 = acc[ai][bj][m][1] + bv[bj][1]; \
                        v4u w; w.x = cvt_pk_bf16(v0[0], v0[1]); w.y = cvt_pk_bf16(v0[2], v0[3]); w.z = cvt_pk_bf16(v1[0], v1[1]); w.w = cvt_pk_bf16(v1[2], v1[3]); \
                        *(v4u*)(rowp + bj * 128) = w; } } } while (0)
                if (wt < 20) EPI1_STORE(qkraw, 2048, chb - 3072);
                else if (wt < 24) EPI1_STORE(vb, 1024, chb - 5120);
                else EPI1_STORE(ob, 1024, chb - 6144);
#undef EPI1_STORE
            }
        }
    }
};

template <int OP> __device__ __forceinline__ LAS float* block_scan_2048(LAS float* x, LAS float* y, int tid) {
    LAS float* src = x; LAS float* dst = y;
    for (int off = 1; off < 2048; off <<= 1) {
#pragma unroll
        for (int i = 0; i < 4; ++i) { const int idx = tid + 512 * i; float v = src[idx]; if (idx >= off) { const float w = src[idx - off]; v = OP ? fmaxf(v, w) : v + w; } dst[idx] = v; }
        __syncthreads();
        LAS float* t = src; src = dst; dst = t;
    }
    return src;
}
__device__ __forceinline__ float logsigmoidf(float x) { return fminf(x, 0.f) - log1pf(expf(-fabsf(x))); }

__device__ __forceinline__ void phase2(const Ctx& C) {
    unsigned char* ws = C.ws;
    {
        const float* H2 = (const float*)(ws + WS_H2); const float* w3 = C.in[9]; float* KT = (float*)(ws + WS_KT);
        LAS float* w3s = (LAS float*)C.lds; LAS float* red = (LAS float*)(C.lds + 4096);
        const int ci = C.tid & 7, tsub = C.tid >> 3;
        for (int u = blockIdx.x; u < 256; u += C.G) {
            const int o = u >> 7, c0 = (u & 127) * 8, c = c0 + ci;
            for (int i = C.tid; i < 1024; i += NTHREADS) { const int j = i >> 4, dir = (i >> 3) & 1, cc = i & 7; w3s[i] = w3[(size_t)j * 4096 + o * 2048 + dir * 1024 + c0 + cc]; }
            __syncthreads();
            const float da = -3.0701134573253945f, db = -15.350567286626973f;
            const float delta = fabsf(da + (float)c * ((db - da) / 1023.0f));
            float asum = 0.f;
#pragma unroll 1
            for (int i = 0; i < 32; ++i) {
                const int t = tsub + 64 * i; const f32x4* h2r = (const f32x4*)(H2 + t * 64); float sf = 0.f, sb = 0.f;
#pragma unroll
                for (int j4 = 0; j4 < 16; ++j4) { const f32x4 h = h2r[j4];
                    sf += h.x * w3s[(4 * j4 + 0) * 16 + ci] + h.y * w3s[(4 * j4 + 1) * 16 + ci] + h.z * w3s[(4 * j4 + 2) * 16 + ci] + h.w * w3s[(4 * j4 + 3) * 16 + ci];
                    sb += h.x * w3s[(4 * j4 + 0) * 16 + 8 + ci] + h.y * w3s[(4 * j4 + 1) * 16 + 8 + ci] + h.z * w3s[(4 * j4 + 2) * 16 + 8 + ci] + h.w * w3s[(4 * j4 + 3) * 16 + 8 + ci]; }
                const float dec = expf(-((float)t / 2047.0f) * delta);
                asum += fabsf(sf * dec) + (t >= 1 ? fabsf(sb * dec) : 0.f);
            }
            asum += __shfl_xor(asum, 8); asum += __shfl_xor(asum, 16); asum += __shfl_xor(asum, 32);
            if (C.lane < 8) red[C.wave * 8 + C.lane] = asum;
            __syncthreads();
            float tot = 0.f;
#pragma unroll
            for (int w = 0; w < 8; ++w) tot += red[w * 8 + ci];
            const float inv = 1.0f / tot;
            float* kr = KT + ((size_t)o * 1024 + c) * 4096;
#pragma unroll 1
            for (int i = 0; i < 32; ++i) {
                const int t = tsub + 64 * i; const f32x4* h2r = (const f32x4*)(H2 + t * 64); float sf = 0.f, sb = 0.f;
#pragma unroll
                for (int j4 = 0; j4 < 16; ++j4) { const f32x4 h = h2r[j4];
                    sf += h.x * w3s[(4 * j4 + 0) * 16 + ci] + h.y * w3s[(4 * j4 + 1) * 16 + ci] + h.z * w3s[(4 * j4 + 2) * 16 + ci] + h.w * w3s[(4 * j4 + 3) * 16 + ci];
                    sb += h.x * w3s[(4 * j4 + 0) * 16 + 8 + ci] + h.y * w3s[(4 * j4 + 1) * 16 + 8 + ci] + h.z * w3s[(4 * j4 + 2) * 16 + 8 + ci] + h.w * w3s[(4 * j4 + 3) * 16 + 8 + ci]; }
                const float dec = expf(-((float)t / 2047.0f) * delta);
                kr[t] = sf * dec * inv; if (t >= 1) kr[4096 - t] = sb * dec * inv;
            }
            if (tsub == 0) kr[2048] = 0.f;
            __syncthreads();
        }
    }
    {
        const bf16* raw = (const bf16*)(ws + WS_QKRAW); bf16* qkc = (bf16*)(ws + WS_QKC); const float* cw = C.in[13]; const float* cb = C.in[14];
        for (int g = blockIdx.x * NTHREADS + C.tid; g < T * 256; g += C.G * NTHREADS) {
            const int tok = g >> 8, ch0 = (g & 255) * 8, tl = tok & (SEQ - 1);
            const v4u cur = *(const v4u*)(raw + (size_t)tok * 2048 + ch0);
            v4u prv = (v4u){0u, 0u, 0u, 0u}, nxt = (v4u){0u, 0u, 0u, 0u};
            if (tl > 0) prv = *(const v4u*)(raw + (size_t)(tok - 1) * 2048 + ch0);
            if (tl < SEQ - 1) nxt = *(const v4u*)(raw + (size_t)(tok + 1) * 2048 + ch0);
            const float sc = ch0 >= 1024 ? 0.08838834764831845f : 1.0f;
            float o[8];
#pragma unroll
            for (int i = 0; i < 8; ++i) {
                const unsigned pw = prv[i >> 1], cwd = cur[i >> 1], nw = nxt[i >> 1];
                const float p = (i & 1) ? bfhi(pw) : bflo(pw), q = (i & 1) ? bfhi(cwd) : bflo(cwd), n = (i & 1) ? bfhi(nw) : bflo(nw);
                const int ch = ch0 + i;
                const float v = cw[ch] * p + cw[2048 + ch] * q + cw[4096 + ch] * n + cb[ch];
                o[i] = sc * v / (1.0f + expf(-v));
            }
            v4u w; w.x = pk2(o[0], o[1]); w.y = pk2(o[2], o[3]); w.z = pk2(o[4], o[5]); w.w = pk2(o[6], o[7]);
            *(v4u*)(qkc + (size_t)tok * 2048 + ch0) = w;
        }
    }
    {
        const float* gates = (const float*)(ws + WS_GATES); float* GA = (float*)(ws + WS_GA); float* GP = (float*)(ws + WS_GP); float* GE = (float*)(ws + WS_GE);
        LAS float* s0 = (LAS float*)(C.lds + 8192); LAS float* s1 = s0 + 2048; LAS float* s2 = s1 + 2048; LAS float* s3 = s2 + 2048;
        for (int bhd = blockIdx.x; bhd < 64; bhd += C.G) {
            const int b = bhd >> 4, h = (bhd >> 1) & 7, dir = bhd & 1, col_i = dir * 16 + h, col_f = col_i + 8;
            float ig[4], lf[4];
            __syncthreads();
#pragma unroll
            for (int i = 0; i < 4; ++i) { const int t = C.tid + 512 * i; const float* gr = gates + (size_t)(b * SEQ + t) * 32; ig[i] = gr[col_i]; lf[i] = logsigmoidf(gr[col_f]); s0[t] = lf[i]; }
            __syncthreads();
            LAS float* Fc = block_scan_2048<0>(s0, s1, C.tid);
            float a[4], Fv[4], Gx[4];
#pragma unroll
            for (int i = 0; i < 4; ++i) { const int t = C.tid + 512 * i; Fv[i] = Fc[t]; Gx[i] = Fv[i] - lf[i]; a[i] = dir ? ig[i] + Gx[i] : ig[i] - Fv[i]; s2[dir ? 2047 - t : t] = a[i]; }
            __syncthreads();
            LAS float* Pm = block_scan_2048<1>(s2, s3, C.tid);
#pragma unroll
            for (int i = 0; i < 4; ++i) { const int t = C.tid + 512 * i; const float pm = Pm[dir ? 2047 - t : t];
                const float mt = dir ? pm - Gx[i] : Fv[i] + pm;
                GA[bhd * 2048 + t] = a[i]; GP[bhd * 2048 + t] = pm; GE[bhd * 2048 + t] = expf(-mt); }
        }
        __syncthreads();
    }
}

__device__ __forceinline__ void hyena_naive(const Ctx& C) {
    unsigned char* ws = C.ws;
    const bf16* hyt = (const bf16*)(ws + WS_HYT); const float* KT = (const float*)(ws + WS_KT); float* Z = (float*)(ws + WS_Z);
    const float* cw = C.in[3]; const float* cb = C.in[4]; const float* skip = C.in[11];
    LAS float* sv = (LAS float*)C.lds; LAS float* sk = sv + 2048;
    for (int u = blockIdx.x; u < NB * DHY; u += C.G) {
        const int b = u >> 10, c = u & 1023;
        float v[4], x1[4], x2[4];
#pragma unroll
        for (int part = 0; part < 3; ++part) {
            const int ch = part * 1024 + c; const bf16* row = hyt + (size_t)ch * T + b * SEQ;
            const float w0 = cw[ch], w1 = cw[3072 + ch], w2 = cw[6144 + ch], bb = cb[ch];
#pragma unroll
            for (int i = 0; i < 4; ++i) { const int t = C.tid + 512 * i;
                const float p = t > 0 ? bf2f(row[t - 1]) : 0.f, q = bf2f(row[t]), n = t < SEQ - 1 ? bf2f(row[t + 1]) : 0.f;
                const float r = w0 * p + w1 * q + w2 * n + bb;
                if (part == 0) v[i] = r; else if (part == 1) x1[i] = r; else x2[i] = r; }
        }
        __syncthreads();
#pragma unroll
        for (int i = 0; i < 4; ++i) sv[C.tid + 512 * i] = v[i];
#pragma unroll
        for (int i = 0; i < 8; ++i) sk[C.tid + 512 * i] = KT[(size_t)c * 4096 + C.tid + 512 * i];
        __syncthreads();
        float acc[4] = {0.f, 0.f, 0.f, 0.f};
        for (int s = 0; s < SEQ; ++s) { const float vv = sv[s];
#pragma unroll
            for (int i = 0; i < 4; ++i) acc[i] += sk[(C.tid + 512 * i - s) & 4095] * vv; }
        float z1[4]; const float sk0 = skip[c], sk1 = skip[1024 + c];
#pragma unroll
        for (int i = 0; i < 4; ++i) z1[i] = x1[i] * (acc[i] + sk0 * v[i]);
        __syncthreads();
#pragma unroll
        for (int i = 0; i < 4; ++i) sv[C.tid + 512 * i] = z1[i];
#pragma unroll
        for (int i = 0; i < 8; ++i) sk[C.tid + 512 * i] = KT[(size_t)(1024 + c) * 4096 + C.tid + 512 * i];
        __syncthreads();
#pragma unroll
        for (int i = 0; i < 4; ++i) acc[i] = 0.f;
        for (int s = 0; s < SEQ; ++s) { const float vv = sv[s];
#pragma unroll
            for (int i = 0; i < 4; ++i) acc[i] += sk[(C.tid + 512 * i - s) & 4095] * vv; }
#pragma unroll
        for (int i = 0; i < 4; ++i) Z[(size_t)(b * SEQ + C.tid + 512 * i) * 1024 + c] = x2[i] * (acc[i] + sk1 * z1[i]);
    }
    __syncthreads();
}

__device__ __forceinline__ void mlstm_naive(const Ctx& C) {
    unsigned char* ws = C.ws;
    const bf16* qkc = (const bf16*)(ws + WS_QKC); const bf16* vb = (const bf16*)(ws + WS_VB);
    const float* GA = (const float*)(ws + WS_GA); const float* GP = (const float*)(ws + WS_GP); const float* GE = (const float*)(ws + WS_GE);
    float* HML = (float*)(ws + WS_HML);
    LAS float* qs = (LAS float*)(C.lds + C.wave * 1024); LAS float* ps = qs + 128;
    const int lane = C.lane;
    for (int u = blockIdx.x; u < 64 * 32; u += C.G) {
        const int bhd = u >> 5, qb = u & 31, b = bhd >> 4, h = (bhd >> 1) & 7, dir = bhd & 1;
        for (int qi = 0; qi < 8; ++qi) {
            const int t = qb * 64 + C.wave * 8 + qi;
            { const unsigned w = *(const unsigned*)(qkc + (size_t)(b * SEQ + t) * 2048 + h * 128 + 2 * lane); qs[2 * lane] = bflo(w); qs[2 * lane + 1] = bfhi(w); }
            __builtin_amdgcn_wave_barrier(); LDS_WAIT();
            const float pmt = GP[bhd * 2048 + t];
            const int c_lo = dir ? (t >> 6) : 0, c_hi = dir ? 31 : (t >> 6);
            float acc0 = 0.f, acc1 = 0.f, den = 0.f;
            for (int cch = c_lo; cch <= c_hi; ++cch) {
                const int s = cch * 64 + lane; const bool valid = dir ? (s >= t) : (s <= t);
                const v4u* kr = (const v4u*)(qkc + (size_t)(b * SEQ + s) * 2048 + 1024 + h * 128);
                float sc = 0.f;
#pragma unroll
                for (int j = 0; j < 16; ++j) { const v4u kk = kr[j];
#pragma unroll
                    for (int e = 0; e < 4; ++e) sc += qs[8 * j + 2 * e] * bflo(kk[e]) + qs[8 * j + 2 * e + 1] * bfhi(kk[e]); }
                const float p = valid ? sc * expf(GA[bhd * 2048 + s] - pmt) : 0.f;
                den += p;
                __builtin_amdgcn_wave_barrier();
                ps[lane] = p;
                __builtin_amdgcn_wave_barrier(); LDS_WAIT();
                const bf16* vr = vb + (size_t)(b * SEQ + cch * 64) * 1024 + h * 128 + 2 * lane;
#pragma unroll 8
                for (int s2 = 0; s2 < 64; ++s2) { const unsigned w = *(const unsigned*)(vr + (size_t)s2 * 1024); const float pv = ps[s2]; acc0 += pv * bflo(w); acc1 += pv * bfhi(w); }
                __builtin_amdgcn_wave_barrier();
            }
            den = wave_sum(den);
            const float scl = 1.0f / fmaxf(fabsf(den), GE[bhd * 2048 + t]);
            *(f32x2*)(HML + ((size_t)dir * T + b * SEQ + t) * 1024 + h * 128 + 2 * lane) = (f32x2){acc0 * scl, acc1 * scl};
            __builtin_amdgcn_wave_barrier();
        }
    }
    __syncthreads();
}

__device__ __forceinline__ void phase4(const Ctx& C) {
    unsigned char* ws = C.ws;
    const float* Z = (const float*)(ws + WS_Z); const float* HML = (const float*)(ws + WS_HML); const bf16* ob = (const bf16*)(ws + WS_OB);
    bf16* ycat = (bf16*)(ws + (size_t)YCAT_T0 * MiB); const float* hyw = C.in[12]; const float* mlw = C.in[15];
    const int lane = C.lane;
    for (int tok = C.gw; tok < T; tok += C.NGW) {
#pragma unroll
        for (int part = 0; part < 2; ++part) {
            float x[16];
            if (part == 0) {
#pragma unroll
                for (int j = 0; j < 4; ++j) { const f32x4 a = *(const f32x4*)(Z + (size_t)tok * 1024 + lane * 16 + 4 * j); x[4 * j] = a.x; x[4 * j + 1] = a.y; x[4 * j + 2] = a.z; x[4 * j + 3] = a.w; }
            } else {
#pragma unroll
                for (int j = 0; j < 4; ++j) { const f32x4 a = *(const f32x4*)(HML + (size_t)tok * 1024 + lane * 16 + 4 * j), bq = *(const f32x4*)(HML + ((size_t)T + tok) * 1024 + lane * 16 + 4 * j);
                    x[4 * j] = a.x + bq.x; x[4 * j + 1] = a.y + bq.y; x[4 * j + 2] = a.z + bq.z; x[4 * j + 3] = a.w + bq.w; }
            }
            float s = 0.f;
#pragma unroll
            for (int j = 0; j < 16; ++j) s += x[j];
            s += __shfl_xor(s, 1); s += __shfl_xor(s, 2); s += __shfl_xor(s, 4);
            const float mu = s * (1.0f / 128.0f); float q = 0.f;
#pragma unroll
            for (int j = 0; j < 16; ++j) { x[j] -= mu; q += x[j] * x[j]; }
            q += __shfl_xor(q, 1); q += __shfl_xor(q, 2); q += __shfl_xor(q, 4);
            const float rstd = 1.0f / sqrtf(q * (1.0f / 128.0f) + LN_EPS);
            const float* gw = (part == 0 ? hyw : mlw) + lane * 16;
            float y[16];
#pragma unroll
            for (int j = 0; j < 16; ++j) y[j] = x[j] * rstd * gw[j];
            if (part == 1) {
                const v4u o0 = *(const v4u*)(ob + (size_t)tok * 1024 + lane * 16), o1 = *(const v4u*)(ob + (size_t)tok * 1024 + lane * 16 + 8);
#pragma unroll
                for (int j = 0; j < 4; ++j) { const float a0 = bflo(o0[j]), a1 = bfhi(o0[j]), b0 = bflo(o1[j]), b1 = bfhi(o1[j]);
                    y[2 * j] *= 1.0f / (1.0f + expf(-a0)); y[2 * j + 1] *= 1.0f / (1.0f + expf(-a1)); y[8 + 2 * j] *= 1.0f / (1.0f + expf(-b0)); y[8 + 2 * j + 1] *= 1.0f / (1.0f + expf(-b1)); }
            }
            v4u w0, w1; w0.x = pk2(y[0], y[1]); w0.y = pk2(y[2], y[3]); w0.z = pk2(y[4], y[5]); w0.w = pk2(y[6], y[7]);
            w1.x = pk2(y[8], y[9]); w1.y = pk2(y[10], y[11]); w1.z = pk2(y[12], y[13]); w1.w = pk2(y[14], y[15]);
            bf16* dst = ycat + (size_t)tok * 2048 + part * 1024 + lane * 16;
            *(v4u*)dst = w0; *(v4u*)(dst + 8) = w1;
        }
    }
}

struct TileOrder {
    int nM, nN, a0, b0, G, c;
    __device__ __forceinline__ bool next(int i, pg8::Unit& u) const {
        const int nwg = nM * nN; const int L = i * G + c; if (L >= nwg) return false;
        int w; { const int q = nwg / 8, r = nwg % 8, xcd = L % 8, off = L / 8; w = (xcd < r ? xcd * (q + 1) : r * (q + 1) + (xcd - r) * q) + off; }
        const int nig = 8 * nN, gid = w / nig, wi = w % nig; u.pm = a0 + gid * 8 + (wi % 8); u.pn = b0 + wi / 8; return true;
    }
    __device__ __forceinline__ void a_ready(const pg8::Unit&) const {}
    __device__ __forceinline__ void done(const pg8::Unit&) const {}
};
struct EpiOut {
    static constexpr bool PERM = false, AFTER_DRAIN = false;
    const float* x; const float* bias; float* r1;
    __device__ __forceinline__ void operator()(const pg8::f32x4 (&acc)[2][2][4][2], const pg8::Unit& u, int wr, int wc, int fr, int fq) const {
        const int row0 = (u.pm - YCAT_T0) * 256 + wr * 64 + fr, col0 = (u.pn - WOUT_T0) * 256 + wc * 32 + 4 * fq;
        pg8::f32x4 bv[2][2];
#pragma unroll
        for (int bj = 0; bj < 2; ++bj)
#pragma unroll
            for (int n = 0; n < 2; ++n) bv[bj][n] = *(const pg8::f32x4*)(bias + col0 + bj * 128 + n * 16);
#pragma unroll
        for (int ai = 0; ai < 2; ++ai)
#pragma unroll
            for (int m = 0; m < 4; ++m) { const size_t off = (size_t)(row0 + ai * 128 + m * 16) * D + col0;
#pragma unroll
                for (int bj = 0; bj < 2; ++bj)
#pragma unroll
                    for (int n = 0; n < 2; ++n) { const pg8::f32x4 xs = *(const pg8::f32x4*)(x + off + bj * 128 + n * 16);
                        *(pg8::f32x4*)(r1 + off + bj * 128 + n * 16) = xs * DN_ALPHA + acc[ai][bj][m][n] + bv[bj][n]; } }
    }
};

__device__ __forceinline__ void phase6(const Ctx& C) {
    unsigned char* ws = C.ws;
    float* r1 = (float*)(ws + WS_R1); bf16* x1b = (bf16*)(ws + (size_t)X1B_T0 * MiB);
    const float* g1 = C.in[18]; const float* b1 = C.in[19]; const float* rw = C.in[20]; const float* rb = C.in[21];
    unsigned* cnt = (unsigned*)(ws + WS_CTL) + CW_CNT; int* list = (int*)(ws + WS_LIST); float* tokw = (float*)(ws + WS_TOKW);
    LAS float* xs = (LAS float*)(C.lds + C.wave * 8192);
    const int lane = C.lane;
    for (int tok = C.gw; tok < T; tok += C.NGW) {
        f32x4 v[8]; float s = 0.f;
        float* rr = r1 + (size_t)tok * D;
#pragma unroll
        for (int j = 0; j < 8; ++j) { v[j] = *(const f32x4*)(rr + (lane + 64 * j) * 4); s += (v[j].x + v[j].y) + (v[j].z + v[j].w); }
        const float mean = wave_sum(s) * (1.0f / D); float q = 0.f;
#pragma unroll
        for (int j = 0; j < 8; ++j) { v[j] = v[j] - mean; q += (v[j].x * v[j].x + v[j].y * v[j].y) + (v[j].z * v[j].z + v[j].w * v[j].w); }
        const float rstd = 1.0f / sqrtf(wave_sum(q) * (1.0f / D) + LN_EPS);
        __builtin_amdgcn_wave_barrier();
#pragma unroll
        for (int j = 0; j < 8; ++j) { const int c0 = (lane + 64 * j) * 4; const f32x4 gg = *(const f32x4*)(g1 + c0), bb = *(const f32x4*)(b1 + c0);
            const f32x4 y = v[j] * rstd * gg + bb;
            *(f32x4*)(rr + c0) = y; *(LAS f32x4*)(xs + c0) = y;
            v2u w; w.x = pk2(y.x, y.y); w.y = pk2(y.z, y.w); *(v2u*)(x1b + (size_t)tok * D + c0) = w; }
        __builtin_amdgcn_wave_barrier(); LDS_WAIT();
        const int e = lane & 31, half = lane >> 5; float lg = 0.f;
        const float* rwp = rw + (size_t)(half * 1024) * 32 + e; const LAS float* xp = xs + half * 1024;
#pragma unroll 8
        for (int d = 0; d < 1024; ++d) lg += xp[d] * rwp[(size_t)d * 32];
        lg += __shfl_xor(lg, 32); lg += rb[e];
        float val = lg; int sel_e = 0; float sel_v = 0.f; float vals[4]; int idxs[4];
#pragma unroll
        for (int k = 0; k < 4; ++k) {
            const float m = wave_max(val);
            const unsigned long long bal = __ballot(val == m);
            const int idx = (int)(__builtin_ctzll(bal) & 31);
            vals[k] = m; idxs[k] = idx;
            if (e == idx) val = -3.0e38f;
        }
        const float e1 = expf(vals[1] - vals[0]), e2 = expf(vals[2] - vals[0]), e3 = expf(vals[3] - vals[0]);
        const float inv = 1.0f / (1.0f + e1 + e2 + e3);
        if (lane < 4) {
            sel_e = lane == 0 ? idxs[0] : lane == 1 ? idxs[1] : lane == 2 ? idxs[2] : idxs[3];
            sel_v = (lane == 0 ? 1.0f : lane == 1 ? e1 : lane == 2 ? e2 : e3) * inv;
            const unsigned pos = atomicAdd(cnt + 64 * sel_e, 1u);
            list[sel_e * T + pos] = tok * 4 + lane; tokw[tok * 4 + lane] = sel_v;
        }
        __builtin_amdgcn_wave_barrier();
    }
}

__device__ __forceinline__ void moe_build_tb(const Ctx& C) {
    LAS int* tb = (LAS int*)(C.lds + LDS_TB);
    __syncthreads();
    if (C.tid == 0) { const unsigned* cnt = (const unsigned*)(C.ws + WS_CTL) + CW_CNT; int acc = 0;
        for (int e = 0; e < NE; ++e) { const int n = (int)__hip_atomic_load(cnt + 64 * e, __ATOMIC_RELAXED, __HIP_MEMORY_SCOPE_AGENT); tb[e] = acc; tb[40 + e] = n; acc += (n + 255) >> 8; }
        tb[32] = acc; }
    __syncthreads();
}
__device__ __forceinline__ void phase7(const Ctx& C) {
    unsigned char* ws = C.ws;
    moe_build_tb(C);
    const LAS int* tb = (const LAS int*)(C.lds + LDS_TB);
    const bf16* x1b = (const bf16*)(ws + (size_t)X1B_T0 * MiB); bf16* abuf = (bf16*)(ws + (size_t)ABUF_T0 * MiB);
    const int* list = (const int*)(ws + WS_LIST); const float* tokw = (const float*)(ws + WS_TOKW);
    int* rowslot = (int*)(ws + WS_ROWSLOT); float* roww = (float*)(ws + WS_ROWW);
    const int total_rows = tb[32] * 256;
    for (int row = C.gw; row < total_rows; row += C.NGW) {
        int e = 0; const int rt = row >> 8;
        while (e < NE - 1 && tb[e + 1] <= rt) ++e;
        const int i = row - tb[e] * 256; const int n = tb[40 + e];
        v4u* dst = (v4u*)(abuf + (size_t)row * D);
        if (i < n) { const int slot = list[e * T + i]; const v4u* src = (const v4u*)(x1b + (size_t)(slot >> 2) * D);
#pragma unroll
            for (int j = 0; j < 4; ++j) dst[C.lane + 64 * j] = src[C.lane + 64 * j];
            if (C.lane == 0) { rowslot[row] = slot; roww[row] = tokw[slot]; } }
        else {
#pragma unroll
            for (int j = 0; j < 4; ++j) dst[C.lane + 64 * j] = (v4u){0u, 0u, 0u, 0u};
            if (C.lane == 0) { rowslot[row] = -1; roww[row] = 0.f; } }
    }
}
struct MoeOrder {
    const LAS int* tb; int NJ, a0, w0, G, c;
    __device__ __forceinline__ bool next(int i, pg8::Unit& u) const {
        const int nwg = tb[32] * NJ; const int L = i * G + c; if (L >= nwg) return false;
        int w; { const int q = nwg / 8, r = nwg % 8, xcd = L % 8, off = L / 8; w = (xcd < r ? xcd * (q + 1) : r * (q + 1) + (xcd - r) * q) + off; }
        int e = 0;
        while (e < NE - 1 && tb[e + 1] * NJ <= w) ++e;
        const int local = w - tb[e] * NJ, nt = tb[e + 1] - tb[e], j = local / nt, ti = local - j * nt;
        u.pm = a0 + tb[e] + ti; u.pn = w0 + e * NJ + j; return true;
    }
    __device__ __forceinline__ void a_ready(const pg8::Unit&) const {}
    __device__ __forceinline__ void done(const pg8::Unit&) const {}
};
struct EpiGU {
    static constexpr bool PERM = true, AFTER_DRAIN = false;
    const float* b_gu; bf16* act;
    __device__ __forceinline__ void operator()(const pg8::f32x4 (&acc)[2][2][4][2], const pg8::Unit& u, int wr, int wc, int fr, int fq) const {
        using pg8::cvt_pk_bf16;
        const int rt = u.pm - ABUF_T0, rel = u.pn - WGU_T0, e = rel >> 4, j = rel & 15;
        const int col0 = j * 128 + wc * 32 + 8 * fq;
        pg8::f32x4 bg[2], bu[2];
#pragma unroll
        for (int n = 0; n < 2; ++n) { bg[n] = *(const pg8::f32x4*)(b_gu + (size_t)e * 4096 + col0 + 4 * n); bu[n] = *(const pg8::f32x4*)(b_gu + (size_t)e * 4096 + 2048 + col0 + 4 * n); }
#pragma unroll
        for (int ai = 0; ai < 2; ++ai)
#pragma unroll
            for (int m = 0; m < 4; ++m) { const int row = rt * 256 + ai * 128 + wr * 64 + m * 16 + fr;
                float o[8];
#pragma unroll
                for (int n = 0; n < 2; ++n) { const pg8::f32x4 g = acc[ai][0][m][n] + bg[n], up = acc[ai][1][m][n] + bu[n];
#pragma unroll
                    for (int i = 0; i < 4; ++i) { const float gc = fminf(g[i], 7.0f), uc = fminf(fmaxf(up[i], -7.0f), 7.0f);
                        o[4 * n + i] = (uc + 1.0f) * (gc / (1.0f + __expf(-1.702f * gc))); } }
                v4u w; w.x = cvt_pk_bf16(o[0], o[1]); w.y = cvt_pk_bf16(o[2], o[3]); w.z = cvt_pk_bf16(o[4], o[5]); w.w = cvt_pk_bf16(o[6], o[7]);
                *(v4u*)(act + (size_t)row * DFF + col0) = w; }
    }
};
struct EpiDown {
    static constexpr bool PERM = false, AFTER_DRAIN = false;
    const float* b_down; const int* rowslot; const float* roww; float* ybuf;
    __device__ __forceinline__ void operator()(const pg8::f32x4 (&acc)[2][2][4][2], const pg8::Unit& u, int wr, int wc, int fr, int fq) const {
        const int rt = u.pm - ACT_T0, rel = u.pn - WDN_T0, e = rel >> 3, j = rel & 7;
        const int col0 = j * 256 + wc * 32 + 4 * fq;
        pg8::f32x4 bv[2][2];
#pragma unroll
        for (int bj = 0; bj < 2; ++bj)
#pragma unroll
            for (int n = 0; n < 2; ++n) bv[bj][n] = *(const pg8::f32x4*)(b_down + (size_t)e * D + col0 + bj * 128 + n * 16);
#pragma unroll
        for (int ai = 0; ai < 2; ++ai)
#pragma unroll
            for (int m = 0; m < 4; ++m) { const int row = rt * 256 + ai * 128 + wr * 64 + m * 16 + fr;
                const int slot = rowslot[row]; const float w = roww[row];
                if (slot >= 0) { float* dst = ybuf + (size_t)slot * D + col0;
#pragma unroll
                    for (int bj = 0; bj < 2; ++bj)
#pragma unroll
                        for (int n = 0; n < 2; ++n) *(pg8::f32x4*)(dst + bj * 128 + n * 16) = (acc[ai][bj][m][n] + bv[bj][n]) * w; } }
    }
};

__device__ __forceinline__ void phase10(const Ctx& C) {
    unsigned char* ws = C.ws;
    const float* x1 = (const float*)(ws + WS_R1); const float* ybuf = (const float*)(ws + WS_YBUF);
    const float* g2 = C.in[26]; const float* b2 = C.in[27]; const int lane = C.lane;
    for (int tok = C.gw; tok < T; tok += C.NGW) {
        f32x4 v[8]; float s = 0.f;
#pragma unroll
        for (int j = 0; j < 8; ++j) { const int c0 = (lane + 64 * j) * 4; f32x4 a = *(const f32x4*)(x1 + (size_t)tok * D + c0) * DN_ALPHA;
#pragma unroll
            for (int k = 0; k < 4; ++k) a = a + *(const f32x4*)(ybuf + ((size_t)tok * 4 + k) * D + c0);
            v[j] = a; s += (a.x + a.y) + (a.z + a.w); }
        const float mean = wave_sum(s) * (1.0f / D); float q = 0.f;
#pragma unroll
        for (int j = 0; j < 8; ++j) { v[j] = v[j] - mean; q += (v[j].x * v[j].x + v[j].y * v[j].y) + (v[j].z * v[j].z + v[j].w * v[j].w); }
        const float rstd = 1.0f / sqrtf(wave_sum(q) * (1.0f / D) + LN_EPS);
#pragma unroll
        for (int j = 0; j < 8; ++j) { const int c0 = (lane + 64 * j) * 4; const f32x4 gg = *(const f32x4*)(g2 + c0), bb = *(const f32x4*)(b2 + c0);
            *(f32x4*)(C.out + (size_t)tok * D + c0) = v[j] * rstd * gg + bb; }
    }
}

__global__ void __launch_bounds__(NTHREADS, 2) fwd_kernel(KArgs args) {
    extern __shared__ __attribute__((aligned(16))) unsigned char lds_raw[];
    Ctx C;
#pragma unroll
    for (int i = 0; i < 28; ++i) C.in[i] = args.in[i];
    C.out = args.out; C.ws = args.ws; C.lds = (LAS unsigned char*)lds_raw;
    C.tid = threadIdx.x; C.lane = C.tid & 63; C.wave = __builtin_amdgcn_readfirstlane(C.tid >> 6); C.G = gridDim.x;
    C.gw = blockIdx.x * NWAVES + C.wave; C.NGW = C.G * NWAVES;
    volatile LAS unsigned* MISC = (volatile LAS unsigned*)(C.lds + LDS_MISC);
    if (C.tid < 4) MISC[C.tid] = 0u;
    __syncthreads();
    unsigned* ctl = (unsigned*)(args.ws + WS_CTL);
    XcdBarrier bar; bar.bar = ctl + CW_BAR; bar.x = 0; bar.st = MISC;
    const int lo = args.ph_lo, hi = args.ph_hi;
    if (hi - lo > 1) bar = xcd_barrier_post(ctl + CW_BAR, MISC);
#ifndef PHASE_MASK
#define PHASE_MASK 0x7ff
#endif
#define IN(k) (((PHASE_MASK >> (k)) & 1) && lo <= (k) && (k) < hi)
#define SEAM(k) do { if (IN(k) && IN((k) + 1)) xcd_barrier(bar); } while (0)
    const pg8::Gemm g{(const pg8::bf16_t*)args.ws, (const pg8::bf16_t*)args.ws, 0, 0, 2048};
    PG8_LAS unsigned char* glds = (PG8_LAS unsigned char*)lds_raw;

    if (IN(0)) { phase0(C); } SEAM(0);
    if (IN(1)) {
        Gemm1Order S{C.G, (int)blockIdx.x};
        unsigned char* ws = args.ws;
        Epi1 E{C.in[2], (bf16*)(ws + WS_HYT), (bf16*)(ws + WS_QKRAW), (bf16*)(ws + WS_VB), (bf16*)(ws + WS_OB), (float*)(ws + WS_GATES)};
        pg8::gemm_phase<Epi1, Gemm1Order, true, true>(glds, g, S, E);
    } SEAM(1);
    if (IN(2)) { phase2(C); } SEAM(2);
    if (IN(3)) { hyena_naive(C); mlstm_naive(C); } SEAM(3);
    if (IN(4)) { phase4(C); } SEAM(4);
    if (IN(5)) {
        TileOrder S{32, 8, YCAT_T0, WOUT_T0, C.G, (int)blockIdx.x};
        EpiOut E{C.in[0], C.in[17], (float*)(args.ws + WS_R1)};
        pg8::gemm_phase<EpiOut, TileOrder, true, true>(glds, g, S, E);
    } SEAM(5);
    if (IN(6)) { phase6(C); } SEAM(6);
    if (IN(7)) { phase7(C); } SEAM(7);
    if (IN(8)) {
        moe_build_tb(C);
        MoeOrder S{(const LAS int*)(C.lds + LDS_TB), 16, ABUF_T0, WGU_T0, C.G, (int)blockIdx.x};
        EpiGU E{C.in[23], (bf16*)(args.ws + (size_t)ACT_T0 * MiB)};
        pg8::gemm_phase<EpiGU, MoeOrder, true, true>(glds, g, S, E);
    } SEAM(8);
    if (IN(9)) {
        moe_build_tb(C);
        MoeOrder S{(const LAS int*)(C.lds + LDS_TB), 8, ACT_T0, WDN_T0, C.G, (int)blockIdx.x};
        EpiDown E{C.in[25], (const int*)(args.ws + WS_ROWSLOT), (const float*)(args.ws + WS_ROWW), (float*)(args.ws + WS_YBUF)};
        pg8::gemm_phase<EpiDown, MoeOrder, true, true>(glds, g, S, E);
    } SEAM(9);
    if (IN(10)) { phase10(C); }
#undef IN
#undef SEAM
}

extern "C" void kernel_launch(void* const* d_in, const int* in_sizes, int n_in, void* d_out, int out_size, void* d_ws, size_t ws_size, hipStream_t stream) {
    static int grid = 0;
    if (grid == 0) {
        if (n_in != 28 || in_sizes[0] != T * D || out_size != T * D || ws_size < WS_END) { fprintf(stderr, "kernel_launch: unexpected shapes (n_in %d, in0 %d, out %d, ws %zu)\n", n_in, n_in > 0 ? in_sizes[0] : -1, out_size, ws_size); grid = -1; return; }
        int dev = 0, cus = 0;
        if (hipGetDevice(&dev) != hipSuccess || hipDeviceGetAttribute(&cus, hipDeviceAttributeMultiprocessorCount, dev) != hipSuccess) { grid = -1; return; }
        if (hipFuncSetAttribute((const void*)fwd_kernel, hipFuncAttributeMaxDynamicSharedMemorySize, LDS_BYTES) != hipSuccess) { fprintf(stderr, "kernel_launch: hipFuncSetAttribute failed\n"); grid = -1; return; }
        int per_cu = 0;
        if (hipOccupancyMaxActiveBlocksPerMultiprocessor(&per_cu, (const void*)fwd_kernel, NTHREADS, LDS_BYTES) != hipSuccess || per_cu < 1) fprintf(stderr, "kernel_launch: occupancy query says %d\n", per_cu);
        (void)hipGetLastError();
        grid = cus;
    }
    if (grid < 0) return;
    if (hipMemsetAsync((char*)d_ws + WS_CTL, 0, CTL_ZERO_BYTES, stream) != hipSuccess) return;
    KArgs a{};
    for (int i = 0; i < 28; ++i) a.in[i] = (const float*)d_in[i];
    a.out = (float*)d_out; a.ws = (unsigned char*)d_ws;
#if MK_ONE_LAUNCH
    a.ph_lo = 0; a.ph_hi = N_PHASES;
    hipLaunchKernelGGL(fwd_kernel, dim3(grid), dim3(NTHREADS), LDS_BYTES, stream, a);
#else
    for (int ph = 0; ph < N_PHASES; ++ph) { a.ph_lo = ph; a.ph_hi = ph + 1; hipLaunchKernelGGL(fwd_kernel, dim3(grid), dim3(NTHREADS), LDS_BYTES, stream, a); }
#endif
}
```

```cpp
#include <hip/hip_runtime.h>
#include <cstdio>
#include <cstdint>
namespace pg8 {
#define PG8_LAS __attribute__((address_space(3)))
typedef unsigned short bf16_t;
typedef short bf16x8 __attribute__((ext_vector_type(8)));
typedef float f32x4 __attribute__((ext_vector_type(4)));
typedef unsigned u32x4 __attribute__((ext_vector_type(4)));
constexpr int BM = 256, BK = 64, HALF = 128, HTB = HALF * BK * 2  , STAGE_BYTES = 8 * HTB, NXCD = 8, WGM = 8;

__host__ __device__ __forceinline__ int lds_byte(int r, int c) { const int st = (r >> 4) * 2 + (c >> 5), rr = r & 15, cc = c & 31, ob = rr * 64 + cc * 2; return st * 1024 + (ob ^ (((ob >> 9) & 1) << 5)); }
__host__ __device__ __forceinline__ void stage_rc(int b, int& R, int& C) { const int st = b / 1024, sb = b % 1024, swz = sb ^ (((sb >> 9) & 1) << 5); R = (st >> 1) * 16 + swz / 64; C = (st & 1) * 32 + (swz % 64) / 2; }
__host__ __device__ __forceinline__ int perm32(int rho) { const int n = rho >> 4, i = rho & 15; return 8 * (i >> 2) + 4 * n + (i & 3); }

struct Unit { int pm, pn; };
struct Gemm { const bf16_t* A; const bf16_t* Bt; int M, N, K; };
__device__ __forceinline__ unsigned cvt_pk_bf16(float lo, float hi) { unsigned r; asm volatile("v_cvt_pk_bf16_f32 %0, %1, %2" : "=v"(r) : "v"(lo), "v"(hi)); return r; }
typedef float f32x2 __attribute__((ext_vector_type(2)));
template <class Epi, class Sched, bool ALIGN_EPI = false, bool SP2 = false>
__device__ __forceinline__ void gemm_phase(PG8_LAS unsigned char* lds, const Gemm g, const Sched& S, const Epi& E) {
    const int tid = threadIdx.x, wid = __builtin_amdgcn_readfirstlane(tid >> 6), lane = tid & 63, wr = wid >> 2, wc = wid & 3, fr = lane & 15, fq = lane >> 4;
    const int K = g.K, nt = K / BK;
    unsigned voffA[2], voffB[2];
#pragma unroll
    for (int i = 0; i < 2; ++i) { int R, C; stage_rc(tid * 16 + i * 8192, R, C); const int Rb = Epi::PERM ? ((R & ~31) + perm32(R & 31)) : R;
        voffA[i] = (unsigned)(R * K + C) * 2u; voffB[i] = (unsigned)(Rb * K + C) * 2u; }
    const size_t kstep = (size_t)(BK * 2);
    const size_t hstep = (size_t)HALF * K * 2;
    const size_t tstep = 2 * hstep;
    const unsigned ldsw = (unsigned)wid * 1024u;
    const int aoff = lds_byte(wr * 64 + fr, fq * 8), boff = lds_byte(wc * 32 + fr, fq * 8);
#define PG8_SA(b, h) (((b) * 2 + (h)) * HTB)
#define PG8_SB(b, h) ((4 + (b) * 2 + (h)) * HTB)
#define PG8_STAGE(bufoff, gbase, voff) do { _Pragma("unroll") for (int _i = 0; _i < 2; ++_i) \
        __builtin_amdgcn_global_load_lds((const unsigned*)((const char*)(gbase) + (voff)[_i]), (PG8_LAS unsigned*)(lds + (bufoff) + ldsw + _i * 8192), 16, 0, 0); } while (0)
#define PG8_LDA(dst, b, h) do { _Pragma("unroll") for (int m = 0; m < 4; ++m) _Pragma("unroll") for (int k = 0; k < 2; ++k) dst[m][k] = *(const PG8_LAS bf16x8*)(lds + PG8_SA(b, h) + aoff + m * 2048 + k * 1024); } while (0)
#define PG8_LDB(dst, b, h) do { _Pragma("unroll") for (int n = 0; n < 2; ++n) _Pragma("unroll") for (int k = 0; k < 2; ++k) dst[n][k] = *(const PG8_LAS bf16x8*)(lds + PG8_SB(b, h) + boff + n * 2048 + k * 1024); } while (0)
#define PG8_MMA(ai, bj, At, Bt) do { __builtin_amdgcn_s_setprio(1); _Pragma("unroll") for (int m = 0; m < 4; ++m) _Pragma("unroll") for (int n = 0; n < 2; ++n) _Pragma("unroll") for (int k = 0; k < 2; ++k) \
        acc[ai][bj][m][n] = __builtin_amdgcn_mfma_f32_16x16x32_bf16(Bt[n][k], At[m][k], acc[ai][bj][m][n], 0, 0, 0); __builtin_amdgcn_s_setprio(0); } while (0)
#define PG8_WAIT_V(n) asm volatile("s_waitcnt vmcnt(" #n ")" ::: "memory")
#define PG8_WAIT_L(n) asm volatile("s_waitcnt lgkmcnt(" #n ")" ::: "memory")
#define PG8_BAR __builtin_amdgcn_s_barrier()
#define PG8_SCHED __builtin_amdgcn_sched_barrier(0)
    Unit cur, nxt; int ui = 0;
    if (!S.next(0, cur)) return;
    f32x4 acc[2][2][4][2];
#pragma unroll
    for (int a = 0; a < 2; ++a)
#pragma unroll
        for (int b = 0; b < 2; ++b)
#pragma unroll
            for (int m = 0; m < 4; ++m)
#pragma unroll
                for (int n = 0; n < 2; ++n) acc[a][b][m][n] = (f32x4){0.f, 0.f, 0.f, 0.f};
    bf16x8 At[4][2], B0[2][2], B1[2][2];
    const char* cA = (const char*)g.A + (size_t)cur.pm * tstep; const char* cB = (const char*)g.Bt + (size_t)cur.pn * tstep;
    S.a_ready(cur);
    if constexpr (SP2) {
        PG8_STAGE(PG8_SB(0, 0), cB, voffB); PG8_STAGE(PG8_SB(0, 1), cB + hstep, voffB); PG8_STAGE(PG8_SA(0, 0), cA, voffA); PG8_STAGE(PG8_SA(0, 1), cA + hstep, voffA);
        if (wr == 1) PG8_BAR;
        PG8_WAIT_V(2); PG8_BAR;
        PG8_STAGE(PG8_SB(1, 0), cB + kstep, voffB); PG8_STAGE(PG8_SA(1, 0), cA + kstep, voffA); PG8_STAGE(PG8_SB(1, 1), cB + hstep + kstep, voffB);
        PG8_WAIT_V(6); PG8_BAR;
    } else {
        PG8_STAGE(PG8_SB(0, 0), cB, voffB); PG8_STAGE(PG8_SA(0, 0), cA, voffA); PG8_STAGE(PG8_SB(0, 1), cB + hstep, voffB); PG8_STAGE(PG8_SA(0, 1), cA + hstep, voffA);
        if (wr == 1) PG8_BAR;
        PG8_WAIT_V(4); PG8_BAR;
        PG8_STAGE(PG8_SB(1, 0), cB + kstep, voffB); PG8_STAGE(PG8_SA(1, 0), cA + kstep, voffA); PG8_STAGE(PG8_SB(1, 1), cB + hstep + kstep, voffB);
        PG8_WAIT_V(6); PG8_BAR;
    }
    for (;;) {
        const bool has_next = S.next(ui + 1, nxt);
        const char* nA = has_next ? (const char*)g.A + (size_t)nxt.pm * tstep : cA; const char* nB = has_next ? (const char*)g.Bt + (size_t)nxt.pn * tstep : cB;
        for (int t = 0; t < nt; t += 2) {
            const bool last = (t == nt - 2);
            const char* a1 = cA + (size_t)(t + 1) * kstep;
            const char* a2 = last ? nA : cA + (size_t)(t + 2) * kstep; const char* b2 = last ? nB : cB + (size_t)(t + 2) * kstep;
            const char* a3 = a2 + kstep; const char* b3 = b2 + kstep;
            if (last && has_next) S.a_ready(nxt);
            if constexpr (SP2) {
            PG8_LDB(B0, 0, 0); PG8_LDB(B1, 0, 1); PG8_SCHED; PG8_LDA(At, 0, 0); PG8_STAGE(PG8_SA(1, 1), a1 + hstep, voffA);
            PG8_WAIT_V(8); PG8_WAIT_L(0); PG8_BAR; PG8_MMA(0, 0, At, B0); PG8_MMA(0, 1, At, B1); PG8_BAR; PG8_SCHED;
            PG8_LDA(At, 0, 1); PG8_STAGE(PG8_SB(0, 0), b2, voffB); PG8_STAGE(PG8_SB(0, 1), b2 + hstep, voffB); PG8_STAGE(PG8_SA(0, 0), a2, voffA);
            PG8_WAIT_V(8); PG8_WAIT_L(0); PG8_BAR; PG8_MMA(1, 0, At, B0); PG8_MMA(1, 1, At, B1); PG8_BAR; PG8_SCHED;
            PG8_LDB(B0, 1, 0); PG8_LDB(B1, 1, 1); PG8_SCHED; PG8_LDA(At, 1, 0); PG8_STAGE(PG8_SA(0, 1), a2 + hstep, voffA);
            PG8_WAIT_V(8); PG8_WAIT_L(0); PG8_BAR; PG8_MMA(0, 0, At, B0); PG8_MMA(0, 1, At, B1); PG8_BAR; PG8_SCHED;
            PG8_LDA(At, 1, 1); PG8_STAGE(PG8_SB(1, 0), b3, voffB); PG8_STAGE(PG8_SB(1, 1), b3 + hstep, voffB); PG8_STAGE(PG8_SA(1, 0), a3, voffA);
            PG8_WAIT_V(8); PG8_WAIT_L(0); PG8_BAR; PG8_MMA(1, 0, At, B0); PG8_MMA(1, 1, At, B1); PG8_BAR; PG8_SCHED;
            } else {
            PG8_LDB(B0, 0, 0); PG8_SCHED; PG8_LDA(At, 0, 0); PG8_STAGE(PG8_SA(1, 1), a1 + hstep, voffA);
            PG8_WAIT_L(8); PG8_BAR; PG8_WAIT_L(0); PG8_MMA(0, 0, At, B0); PG8_BAR; PG8_SCHED;
            PG8_LDB(B1, 0, 1); PG8_STAGE(PG8_SB(0, 0), b2, voffB);
            PG8_BAR; PG8_WAIT_L(0); PG8_MMA(0, 1, At, B1); PG8_BAR;
            PG8_LDA(At, 0, 1); PG8_STAGE(PG8_SA(0, 0), a2, voffA);
            PG8_BAR; PG8_WAIT_L(0); PG8_MMA(1, 0, At, B0); PG8_BAR; PG8_SCHED;
            PG8_STAGE(PG8_SB(0, 1), b2 + hstep, voffB);
            PG8_WAIT_V(6); PG8_BAR; PG8_MMA(1, 1, At, B1); PG8_BAR;
            PG8_LDB(B0, 1, 0); PG8_SCHED; PG8_LDA(At, 1, 0); PG8_STAGE(PG8_SA(0, 1), a2 + hstep, voffA);
            PG8_WAIT_L(8); PG8_BAR; PG8_WAIT_L(0); PG8_MMA(0, 0, At, B0); PG8_BAR; PG8_SCHED;
            PG8_LDB(B1, 1, 1); PG8_STAGE(PG8_SB(1, 0), b3, voffB);
            PG8_BAR; PG8_WAIT_L(0); PG8_MMA(0, 1, At, B1); PG8_BAR;
            PG8_LDA(At, 1, 1); PG8_STAGE(PG8_SA(1, 0), a3, voffA);
            PG8_BAR; PG8_WAIT_L(0); PG8_MMA(1, 0, At, B0); PG8_BAR; PG8_SCHED;
            PG8_STAGE(PG8_SB(1, 1), b3 + hstep, voffB);
            PG8_WAIT_V(6); PG8_BAR; PG8_MMA(1, 1, At, B1); PG8_BAR;
            }
        }
        if constexpr (ALIGN_EPI) { if (wr == 0) PG8_BAR; }
        if constexpr (!Epi::AFTER_DRAIN) { E(acc, cur, wr, wc, fr, fq); S.done(cur); }
        if (!has_next) break;
#pragma unroll
        for (int a = 0; a < 2; ++a)
#pragma unroll
            for (int b = 0; b < 2; ++b)
#pragma unroll
                for (int m = 0; m < 4; ++m)
#pragma unroll
                    for (int n = 0; n < 2; ++n) acc[a][b][m][n] = (f32x4){0.f, 0.f, 0.f, 0.f};
        cur = nxt; cA = nA; cB = nB; ++ui;
        if constexpr (ALIGN_EPI) { if (wr == 1) PG8_BAR; }
    }
    PG8_WAIT_V(0);
    if constexpr (!ALIGN_EPI) { if (wr == 0) PG8_BAR; }
    PG8_BAR;
    if constexpr (Epi::AFTER_DRAIN) { E.fused(acc, cur, wr, wc, fr, fq, lds, wid, lane); S.done(cur); }
#undef PG8_SA
#undef PG8_SB
#undef PG8_STAGE
#undef PG8_LDA
#undef PG8_LDB
#undef PG8_MMA
#undef PG8_WAIT_V
#undef PG8_WAIT_L
#undef PG8_BAR
#undef PG8_SCHED
}
}

constexpr int NB = 4, SEQ = 2048, T = NB * SEQ, D = 2048, DHY = 1024, DML = 1024, DIN = 7200, NE = 32, TOPK = 4, NH = 8, HD = 128, DFF = 2048;
constexpr float LN_EPS = 1e-5f, DN_ALPHA = 1.189207115002721f;
constexpr int NWAVES = 8, NTHREADS = 512;
#ifndef MK_ONE_LAUNCH
#define MK_ONE_LAUNCH 1
#endif
constexpr int N_PHASES = 11;

constexpr size_t MiB = 1u << 20;
constexpr size_t WS_CTL = 0, CTL_ZERO_BYTES = 1 * MiB;
constexpr size_t WS_H2 = 1 * MiB;
constexpr size_t WS_GATES = 2 * MiB;
constexpr size_t WS_TOKW = 3 * MiB;
constexpr size_t WS_LIST = 4 * MiB;
constexpr size_t WS_ROWSLOT = 5 * MiB;
constexpr size_t WS_ROWW = 5 * MiB + 512 * 1024;
constexpr size_t WS_GA = 6 * MiB, WS_GP = 6 * MiB + 512 * 1024, WS_GE = 7 * MiB;
constexpr size_t TILE_BYTES = 256 * 2048 * 2;
constexpr int XB_T0 = 8, WIN_T0 = 40, WOUT_T0 = 72, YCAT_T0 = 80, X1B_T0 = 112, ABUF_T0 = 144, ACT_T0 = 304, WGU_T0 = 464, WDN_T0 = 976;
constexpr size_t WS_HYT = 1232 * MiB;
constexpr size_t WS_QKRAW = 1296 * MiB;
constexpr size_t WS_OB = 1328 * MiB;
constexpr size_t WS_QKC = 1344 * MiB;
constexpr size_t WS_KT = 1376 * MiB;
constexpr size_t WS_KF = 1840 * MiB;
constexpr size_t WS_ZT = 1904 * MiB;
constexpr size_t WS_Z = 1408 * MiB;
constexpr size_t WS_HML = 1440 * MiB;
constexpr size_t WS_R1 = 1504 * MiB;
constexpr size_t WS_YBUF = 1568 * MiB;
constexpr size_t WS_VB = 1824 * MiB;
constexpr size_t WS_END = 1936 * MiB;
constexpr int CW_BAR = 4096, CW_CNT = 16384;

constexpr int LDS_STAGE = 131072, LDS_MISC = LDS_STAGE, LDS_TB = LDS_STAGE + 64, LDS_BYTES = 147456;

#define GAS __attribute__((address_space(1)))
#define LAS __attribute__((address_space(3)))
typedef unsigned short bf16;
typedef unsigned v4u __attribute__((ext_vector_type(4)));
typedef unsigned v2u __attribute__((ext_vector_type(2)));
typedef float f32x4 __attribute__((ext_vector_type(4)));
typedef float f32x2 __attribute__((ext_vector_type(2)));
#define LDS_WAIT() asm volatile("s_waitcnt lgkmcnt(0)" ::: "memory")
__device__ __forceinline__ unsigned f2bf(float f) { unsigned u = __builtin_bit_cast(unsigned, f); return (u + 0x7fffu + ((u >> 16) & 1u)) >> 16; }
__device__ __forceinline__ unsigned pk2(float lo, float hi) { return f2bf(lo) | (f2bf(hi) << 16); }
__device__ __forceinline__ float bflo(unsigned w) { return __builtin_bit_cast(float, w << 16); }
__device__ __forceinline__ float bfhi(unsigned w) { return __builtin_bit_cast(float, w & 0xffff0000u); }
__device__ __forceinline__ float bf2f(bf16 b) { return __builtin_bit_cast(float, (unsigned)b << 16); }
__device__ __forceinline__ float wave_sum(float v) {
#pragma unroll
    for (int o = 1; o < 64; o <<= 1) v += __shfl_xor(v, o);
    return v;
}
__device__ __forceinline__ float wave_max(float v) {
#pragma unroll
    for (int o = 1; o < 64; o <<= 1) v = fmaxf(v, __shfl_xor(v, o));
    return v;
}

#define XB_TMO      128
#define XB_XCNT(j)  (256  + 64 * (j))
#define XB_XSUB(j)  (1280 + 64 * (j))
#define XB_XGEN(j)  (2304 + 64 * (j))
#define XB_TOP      3328
#define XB_TOPGEN   3392
#define XCD_BAR_WORDS 3456
#define XB_SPIN_CAP (1u << 22)

__device__ __forceinline__ unsigned xb_ld(unsigned* p)              { return __hip_atomic_load(p, __ATOMIC_RELAXED, __HIP_MEMORY_SCOPE_AGENT); }
__device__ __forceinline__ unsigned xb_add(unsigned* p, unsigned v) { return __hip_atomic_fetch_add(p, v, __ATOMIC_RELAXED, __HIP_MEMORY_SCOPE_AGENT); }
__device__ __forceinline__ unsigned xb_xcc_id() { return (unsigned)__builtin_amdgcn_s_getreg((3 << 11) | 20) & 0xFu; }
#define XB_SPIN(cond, bar) do { unsigned _sp = 0; while (cond) { __builtin_amdgcn_s_sleep(1); \
    if ((++_sp & 255u) == 0u) { if (xb_ld(&(bar)[XB_TMO])) break; if (_sp > XB_SPIN_CAP) { atomicAdd(&(bar)[XB_TMO], 1u); break; } } } } while (0)

struct XcdBarrier {
    unsigned* bar; unsigned x;
    volatile LAS unsigned* st;
};

__device__ __forceinline__ XcdBarrier xcd_barrier_post(unsigned* bar, volatile LAS unsigned* st) {
    XcdBarrier b; b.bar = bar; b.x = xb_xcc_id(); b.st = st;
    if (threadIdx.x == 0) (void)xb_add(&bar[XB_XCNT(b.x)], 1u);
    return b;
}
__device__ __forceinline__ void xcd_barrier_complete(unsigned* bar, unsigned x, unsigned& nloc, unsigned& nx) {
    const unsigned G = gridDim.x * gridDim.y * gridDim.z;
    unsigned sum, cnt, mine, sp = 0u;
    for (;;) {
        sum = 0u; cnt = 0u; mine = 0u;
#pragma unroll
        for (unsigned j = 0; j < 16; ++j) { const unsigned c = xb_ld(&bar[XB_XCNT(j)]); sum += c; cnt += (c > 0u) ? 1u : 0u; mine = (j == x) ? c : mine; }
        if (sum == G) break;
        __builtin_amdgcn_s_sleep(1);
        if ((++sp & 255u) == 0u) { if (xb_ld(&bar[XB_TMO])) break; if (sp > XB_SPIN_CAP) { atomicAdd(&bar[XB_TMO], 1u); break; } }
    }
    nloc = mine > 0u ? mine : 1u; nx = cnt > 0u ? cnt : 1u;
}

__device__ __forceinline__ void xcd_barrier(const XcdBarrier& b) {
    asm volatile("s_waitcnt vmcnt(0)" ::: "memory");
    __syncthreads();
    if (threadIdx.x == 0) {
        unsigned* bar = b.bar;
        __builtin_amdgcn_s_waitcnt(0);
        unsigned nloc = b.st[0], nx = b.st[1];
        if (nloc == 0u) { xcd_barrier_complete(bar, b.x, nloc, nx); b.st[0] = nloc; b.st[1] = nx; }
        const unsigned old = xb_add(&bar[XB_XSUB(b.x)], 1u);
        const unsigned gen = old / nloc;
        if (old + 1u == (gen + 1u) * nloc) {
            __builtin_amdgcn_fence(__ATOMIC_RELEASE, "agent");
            asm volatile("s_waitcnt vmcnt(0)" ::: "memory");
            const unsigned og = xb_add(&bar[XB_TOP], 1u);
            const unsigned tg = og / nx;
            if (og + 1u == (tg + 1u) * nx) xb_add(&bar[XB_TOPGEN], 1u);
            else XB_SPIN(xb_ld(&bar[XB_TOPGEN]) == tg, bar);
            __builtin_amdgcn_fence(__ATOMIC_ACQUIRE, "agent");
            xb_add(&bar[XB_XGEN(b.x)], 1u);
            asm volatile("s_waitcnt vmcnt(0)" ::: "memory");
        } else {
            XB_SPIN(xb_ld(&bar[XB_XGEN(b.x)]) == gen, bar);
            __builtin_amdgcn_fence(__ATOMIC_ACQUIRE, "agent");
            asm volatile("s_waitcnt vmcnt(0)" ::: "memory");
        }
    }
    __syncthreads();
}


#ifndef FFT_HD
#define FFT_HD __device__ __forceinline__
#define FFT_LDS LAS
#endif
constexpr int FFT_WORDS = 4096 + 1024 + 256;
FFT_HD int fidx(int i) { return i + 4 * (i >> 4) + 16 * (i >> 8); }

template <bool INV> FFT_HD void dft4(float& ar, float& ai, float& br, float& bi, float& cr, float& ci, float& dr, float& di) {
    const float s0r = ar + cr, s0i = ai + ci, s1r = ar - cr, s1i = ai - ci;
    const float s2r = br + dr, s2i = bi + di, s3r = br - dr, s3i = bi - di;
    ar = s0r + s2r; ai = s0i + s2i;
    cr = s0r - s2r; ci = s0i - s2i;
    if (!INV) { br = s1r + s3i; bi = s1i - s3r; dr = s1r - s3i; di = s1i + s3r; }
    else      { br = s1r - s3i; bi = s1i + s3r; dr = s1r + s3i; di = s1i - s3r; }
}
template <bool INV> FFT_HD void dft16(float (&xr)[16], float (&xi)[16]) {
#pragma unroll
    for (int n0 = 0; n0 < 4; ++n0) dft4<INV>(xr[n0], xi[n0], xr[n0 + 4], xi[n0 + 4], xr[n0 + 8], xi[n0 + 8], xr[n0 + 12], xi[n0 + 12]);
    constexpr float C1 = 0.9238795325112867f, S1 = 0.3826834323650898f, C2 = 0.7071067811865476f;
    const float tc[10] = {1.f, C1, C2, S1, 0.f, -S1, -C2, -C1, -1.f, -C1};
    const float ts[10] = {0.f, S1, C2, C1, 1.f, C1, C2, S1, 0.f, -S1};
#pragma unroll
    for (int n0 = 1; n0 < 4; ++n0)
#pragma unroll
        for (int k0 = 1; k0 < 4; ++k0) { const int m = n0 * k0; const float wr = tc[m], wi = INV ? ts[m] : -ts[m];
            const int id = n0 + 4 * k0; const float r = xr[id] * wr - xi[id] * wi, i = xr[id] * wi + xi[id] * wr; xr[id] = r; xi[id] = i; }
#pragma unroll
    for (int k0 = 0; k0 < 4; ++k0) dft4<INV>(xr[4 * k0], xi[4 * k0], xr[4 * k0 + 1], xi[4 * k0 + 1], xr[4 * k0 + 2], xi[4 * k0 + 2], xr[4 * k0 + 3], xi[4 * k0 + 3]);
#pragma unroll
    for (int a = 0; a < 4; ++a)
#pragma unroll
        for (int b = a + 1; b < 4; ++b) { float t = xr[4 * a + b]; xr[4 * a + b] = xr[4 * b + a]; xr[4 * b + a] = t; t = xi[4 * a + b]; xi[4 * a + b] = xi[4 * b + a]; xi[4 * b + a] = t; }
}
template <bool INV> FFT_HD void twiddle16(float (&xr)[16], float (&xi)[16], int j, int n) {
    float s, c;
#ifdef __HIP_DEVICE_COMPILE__
    asm volatile("" : "+v"(j));
    sincospif(2.0f * (float)j / (float)n, &s, &c);
#else
    s = (float)sin(2.0 * 3.14159265358979323846 * j / n); c = (float)cos(2.0 * 3.14159265358979323846 * j / n);
#endif
    const float wr = c, wi = INV ? s : -s;
    float pr = wr, pi = wi;
#pragma unroll
    for (int k = 1; k < 16; ++k) {
        const float r = xr[k] * pr - xi[k] * pi, i = xr[k] * pi + xi[k] * pr; xr[k] = r; xi[k] = i;
        const float nr = pr * wr - pi * wi, ni = pr * wi + pi * wr; pr = nr; pi = ni;
    }
}
FFT_HD void fft_store_s256(FFT_LDS float* re, FFT_LDS float* im, int g, const float (&xr)[16], const float (&xi)[16]) {
    const int a0 = fidx(g);
#pragma unroll
    for (int k = 0; k < 16; ++k) { re[a0 + 336 * k] = xr[k]; im[a0 + 336 * k] = xi[k]; }
}
FFT_HD void fft_load_s256(const FFT_LDS float* re, const FFT_LDS float* im, int g, float (&xr)[16], float (&xi)[16]) {
    const int a0 = fidx(g);
#pragma unroll
    for (int k = 0; k < 16; ++k) { xr[k] = re[a0 + 336 * k]; xi[k] = im[a0 + 336 * k]; }
}
FFT_HD void fft_load_s16(const FFT_LDS float* re, const FFT_LDS float* im, int g, float (&xr)[16], float (&xi)[16]) {
    const int a0 = fidx((g >> 4) * 256 + (g & 15));
#pragma unroll
    for (int k = 0; k < 16; ++k) { xr[k] = re[a0 + 20 * k]; xi[k] = im[a0 + 20 * k]; }
}
FFT_HD void fft_store_s16(FFT_LDS float* re, FFT_LDS float* im, int g, const float (&xr)[16], const float (&xi)[16]) {
    const int a0 = fidx((g >> 4) * 256 + (g & 15));
#pragma unroll
    for (int k = 0; k < 16; ++k) { re[a0 + 20 * k] = xr[k]; im[a0 + 20 * k] = xi[k]; }
}
FFT_HD void fft_load_s1(const FFT_LDS float* re, const FFT_LDS float* im, int g, float (&xr)[16], float (&xi)[16]) {
    const int a = fidx(g * 16);
#pragma unroll
    for (int k = 0; k < 16; ++k) { xr[k] = re[a + k]; xi[k] = im[a + k]; }
}
FFT_HD void fft_store_s1(FFT_LDS float* re, FFT_LDS float* im, int g, const float (&xr)[16], const float (&xi)[16]) {
    const int a = fidx(g * 16);
#pragma unroll
    for (int k = 0; k < 16; ++k) { re[a + k] = xr[k]; im[a + k] = xi[k]; }
}


struct KArgs { const float* in[28]; float* out; unsigned char* ws; int ph_lo, ph_hi; };
struct Ctx {
    const float* in[28]; float* out; unsigned char* ws; LAS unsigned char* lds;
    int tid, lane, wave, G, gw, NGW;
};

__device__ __forceinline__ void transpose_item(const float* __restrict__ W, int N, int k0, int n0, bf16* __restrict__ dst, LAS float* scr, int lane) {
#pragma unroll 8
    for (int i = 0; i < 32; ++i) { const int kk = 2 * i + (lane >> 5); scr[kk * 33 + (lane & 31)] = W[(size_t)(k0 + kk) * N + n0 + (lane & 31)]; }
    LDS_WAIT(); asm volatile("" ::: "memory");
    const int c = lane & 7;
#pragma unroll
    for (int j = 0; j < 4; ++j) { const int n = (lane >> 3) + 8 * j; const LAS float* s = scr + (8 * c) * 33 + n;
        v4u o; o.x = pk2(s[0 * 33], s[1 * 33]); o.y = pk2(s[2 * 33], s[3 * 33]); o.z = pk2(s[4 * 33], s[5 * 33]); o.w = pk2(s[6 * 33], s[7 * 33]);
        *(v4u*)(dst + (size_t)n * 2048 + k0 + 8 * c) = o; }
    LDS_WAIT(); asm volatile("" ::: "memory");
}

__device__ __forceinline__ void phase0(const Ctx& C) {
    unsigned char* ws = C.ws;
    {
        const f32x4* x4 = (const f32x4*)C.in[0]; v4u* xb = (v4u*)(ws + (size_t)XB_T0 * MiB);
        const size_t n8 = (size_t)T * D / 8;
        for (size_t i = (size_t)blockIdx.x * NTHREADS + C.tid; i < n8; i += (size_t)C.G * NTHREADS) {
            const f32x4 a = x4[2 * i], b = x4[2 * i + 1]; v4u o; o.x = pk2(a.x, a.y); o.y = pk2(a.z, a.w); o.z = pk2(b.x, b.y); o.w = pk2(b.z, b.w); xb[i] = o; }
    }
    {
        LAS float* scr = (LAS float*)(C.lds + C.wave * 8448);
        constexpr int I_IN = 32 * 225, I_OUT = 32 * 64, I_GU = NE * 32 * 128, I_DN = NE * 32 * 64, NITEMS = I_IN + I_OUT + I_GU + I_DN;
        bf16* win_t = (bf16*)(ws + (size_t)WIN_T0 * MiB); bf16* wout_t = (bf16*)(ws + (size_t)WOUT_T0 * MiB);
        bf16* wgu_t = (bf16*)(ws + (size_t)WGU_T0 * MiB); bf16* wdn_t = (bf16*)(ws + (size_t)WDN_T0 * MiB);
        for (int it = C.gw; it < NITEMS; it += C.NGW) {
            int r = it;
            if (r < I_IN) { const int kb = r / 225, nb = r % 225; transpose_item(C.in[1], DIN, 64 * kb, 32 * nb, win_t + (size_t)(32 * nb) * 2048, scr, C.lane); continue; } r -= I_IN;
            if (r < I_OUT) { const int kb = r / 64, nb = r % 64; transpose_item(C.in[16], D, 64 * kb, 32 * nb, wout_t + (size_t)(32 * nb) * 2048, scr, C.lane); continue; } r -= I_OUT;
            if (r < I_GU) { const int e = r / 4096, rr = r % 4096, kb = rr / 128, nb = rr % 128, n0 = 32 * nb;
                const int drow = (n0 < 2048) ? ((n0 >> 7) * 256 + (n0 & 127)) : ((((n0 - 2048) >> 7) * 256) + 128 + ((n0 - 2048) & 127));
                transpose_item(C.in[22] + (size_t)e * 2048 * 4096, 4096, 64 * kb, n0, wgu_t + ((size_t)e * 4096 + drow) * 2048, scr, C.lane); continue; } r -= I_GU;
            { const int e = r / 2048, rr = r % 2048, kb = rr / 64, nb = rr % 64;
                transpose_item(C.in[24] + (size_t)e * 2048 * 2048, 2048, 64 * kb, 32 * nb, wdn_t + ((size_t)e * 2048 + 32 * nb) * 2048, scr, C.lane); }
        }
    }
    __syncthreads();
    {
        const float* w1 = C.in[5]; const float* b1 = C.in[6]; const float* w2 = C.in[7]; const float* b2 = C.in[8]; const float* freq = C.in[10];
        float* H2 = (float*)(ws + WS_H2); LAS float* h1s = (LAS float*)C.lds;
        const int tt = C.tid >> 6, j = C.tid & 63;
        for (int tb = blockIdx.x; tb < SEQ / 8; tb += C.G) {
            const int t = tb * 8 + tt;
            const float zt = (float)t / 2047.0f, wt = 6.283185307179586f * (float)t / 2048.0f;
            float acc = b1[j] + zt * w1[j];
            for (int i = 0; i < 16; ++i) { const float fb = 1e-4f + (float)i * ((15.0f - 1e-4f) / 15.0f); const float arg = fb * wt;
                acc += cosf(arg) * w1[(1 + i) * 64 + j] - sinf(arg) * w1[(17 + i) * 64 + j]; }
            h1s[tt * 64 + j] = sinf(freq[j] * acc);
            __syncthreads();
            float a2 = b2[j];
            for (int i = 0; i < 64; ++i) a2 += h1s[tt * 64 + i] * w2[i * 64 + j];
            H2[t * 64 + j] = sinf(freq[64 + j] * a2);
            __syncthreads();
        }
    }
}

#ifndef NAIVE_ML
#define NAIVE_ML 0
#endif
constexpr int N1_SW_TILES = 16, N1_SW = N1_SW_TILES * 32;
constexpr int N1_NORM_TILES = NAIVE_ML ? 17 : 13, N1_NORM = N1_NORM_TILES * 32, N1_UNITS = N1_SW + N1_NORM;
struct Gemm1Order {
    int G, c;
    __device__ __forceinline__ bool next(int i, pg8::Unit& u) const {
        const int L = i * G + c; if (L >= N1_UNITS) return false;
        int w; { const int q = N1_UNITS / 8, r = N1_UNITS % 8, xcd = L % 8, off = L / 8; w = (xcd < r ? xcd * (q + 1) : r * (q + 1) + (xcd - r) * q) + off; }
        if (w < N1_SW) { const int nig = 8 * 32, gid = w / nig, wi = w % nig, mi = gid * 8 + (wi % 8), ni = wi / 8;
            u.pm = WIN_T0 + (mi < 12 ? mi : 8 + mi); u.pn = XB_T0 + ni; }
        else { w -= N1_SW; const int nig = 8 * N1_NORM_TILES, gid = w / nig, wi = w % nig, mi = gid * 8 + (wi % 8), ni = wi / 8;
            int wt;
            if (NAIVE_ML) wt = (ni < 16) ? 12 + ni : 28; else wt = (ni < 8) ? 12 + ni : 16 + ni;
            u.pm = XB_T0 + mi; u.pn = WIN_T0 + wt; }
        return true;
    }
    __device__ __forceinline__ void a_ready(const pg8::Unit&) const {}
    __device__ __forceinline__ void done(const pg8::Unit&) const {}
};
struct Epi1 {
    static constexpr bool PERM = true, AFTER_DRAIN = false;
    const float* b_in; bf16* hyt; bf16* qkraw; bf16* vb; bf16* ob; float* gates;
    __device__ __forceinline__ void operator()(const pg8::f32x4 (&acc)[2][2][4][2], const pg8::Unit& u, int wr, int wc, int fr, int fq) const {
        using pg8::cvt_pk_bf16;
        if (u.pm >= WIN_T0) {
            const int wt = u.pm - WIN_T0, tt = u.pn - XB_T0;
            const int col0 = tt * 256 + wc * 32 + 8 * fq;
#pragma unroll
            for (int ai = 0; ai < 2; ++ai)
#pragma unroll
                for (int m = 0; m < 4; ++m) {
                    const int ch = wt * 256 + ai * 128 + wr * 64 + m * 16 + fr; const float bv = b_in[ch];
                    const int drow = ch < 3072 ? ch : ch - 2048;
                    bf16* rowp = hyt + (size_t)drow * T + col0;
#pragma unroll
                    for (int bj = 0; bj < 2; ++bj) { const pg8::f32x4 v0 = acc[ai][bj][m][0] + bv, v1 = acc[ai][bj][m][1] + bv;
                        v4u w; w.x = cvt_pk_bf16(v0[0], v0[1]); w.y = cvt_pk_bf16(v0[2], v0[3]); w.z = cvt_pk_bf16(v1[0], v1[1]); w.w = cvt_pk_bf16(v1[2], v1[3]);
                        *(v4u*)(rowp + bj * 128) = w; }
                }
        } else {
            const int tt = u.pm - XB_T0, wt = u.pn - WIN_T0;
            const int chb = wt * 256 + wc * 32 + 8 * fq;
            pg8::f32x4 bv[2][2];
#pragma unroll
            for (int bj = 0; bj < 2; ++bj)
#pragma unroll
                for (int n = 0; n < 2; ++n) { const int c0 = chb + bj * 128 + 4 * n; bv[bj][n] = (c0 < DIN) ? *(const pg8::f32x4*)(b_in + c0) : (pg8::f32x4){0.f, 0.f, 0.f, 0.f}; }
            if (wt == 28) {
                if (wc == 0) {
#pragma unroll
                    for (int ai = 0; ai < 2; ++ai)
#pragma unroll
                        for (int m = 0; m < 4; ++m) { const int tok = tt * 256 + ai * 128 + wr * 64 + m * 16 + fr;
                            float* gp = gates + (size_t)tok * 32 + 8 * fq;
                            *(pg8::f32x4*)(gp) = acc[ai][0][m][0] + bv[0][0]; *(pg8::f32x4*)(gp + 4) = acc[ai][0][m][1] + bv[0][1]; }
                }
            } else {
#define EPI1_STORE(base, ld, cb) do { _Pragma("unroll") for (int ai = 0; ai < 2; ++ai) _Pragma("unroll") for (int m = 0; m < 4; ++m) { const int tok = tt * 256 + ai * 128 + wr * 64 + m * 16 + fr; \
                    bf16* rowp = (base) + (size_t)tok * (ld) + (cb); \
                    _Pragma("unroll") for (int bj = 0; bj < 2; ++bj) { const pg8::f32x4 v0 = acc[ai][bj][m][0] + bv[bj][0], v1 = acc[ai][bj][m][1] + bv[bj][1]; \
                        v4u w; w.x = cvt_pk_bf16(v0[0], v0[1]); w.y = cvt_pk_bf16(v0[2], v0[3]); w.z = cvt_pk_bf16(v1[0], v1[1]); w.w = cvt_pk_bf16(v1[2], v1[3]); \
                        *(v4u*)(rowp + bj * 128) = w; } } } while (0)
                if (wt < 20) EPI1_STORE(qkraw, 2048, chb - 3072);
                else if (wt < 24) EPI1_STORE(vb, 1024, chb - 5120);
                else EPI1_STORE(ob, 1024, chb - 6144);
#undef EPI1_STORE
            }
        }
    }
};

template <int OP> __device__ __forceinline__ LAS float* block_scan_2048(LAS float* x, LAS float* y, int tid) {
    LAS float* src = x; LAS float* dst = y;
    for (int off = 1; off < 2048; off <<= 1) {
#pragma unroll
        for (int i = 0; i < 4; ++i) { const int idx = tid + 512 * i; float v = src[idx]; if (idx >= off) { const float w = src[idx - off]; v = OP ? fmaxf(v, w) : v + w; } dst[idx] = v; }
        __syncthreads();
        LAS float* t = src; src = dst; dst = t;
    }
    return src;
}
__device__ __forceinline__ float logsigmoidf(float x) { return fminf(x, 0.f) - log1pf(expf(-fabsf(x))); }

__device__ __forceinline__ void phase2(const Ctx& C) {
    unsigned char* ws = C.ws;
    {
        const float* H2 = (const float*)(ws + WS_H2); const float* w3 = C.in[9]; f32x4* KF = (f32x4*)(ws + WS_KF);
        const int half = C.tid >> 8, g = C.tid & 255;
        LAS float* re = (LAS float*)(C.lds + half * (2 * FFT_WORDS * 4)); LAS float* im = re + FFT_WORDS;
        LAS float* w3s = (LAS float*)(C.lds + 4 * FFT_WORDS * 4); LAS float* red = w3s + 256;
        for (int u = blockIdx.x; u < 1024; u += C.G) {
            const int o = u >> 9, c0 = (u & 511) * 2, c = c0 + half;
            __syncthreads();
            if (C.tid < 256) { const int hf = C.tid >> 7, dir = (C.tid >> 6) & 1, j = C.tid & 63; w3s[C.tid] = w3[(size_t)j * 4096 + o * 2048 + dir * 1024 + c0 + hf]; }
            __syncthreads();
            const float da = -3.0701134573253945f, db = -15.350567286626973f;
            const float delta = fabsf(da + (float)c * ((db - da) / 1023.0f));
            float asum = 0.f;
#pragma unroll 1
            for (int m = 0; m < 16; ++m) {
                const int idx = g + 256 * m; const int dir = m >= 8 ? 1 : 0; int t = m >= 8 ? 4096 - idx : idx; const bool zero = (idx == 2048); if (zero) t = 0;
                const f32x4* h2r = (const f32x4*)(H2 + t * 64); const LAS float* wv = w3s + half * 128 + dir * 64; float sf = 0.f;
#pragma unroll
                for (int j4 = 0; j4 < 16; ++j4) { const f32x4 h = h2r[j4]; sf += h.x * wv[4 * j4] + h.y * wv[4 * j4 + 1] + h.z * wv[4 * j4 + 2] + h.w * wv[4 * j4 + 3]; }
                const float val = zero ? 0.f : sf * expf(-((float)t / 2047.0f) * delta);
                re[fidx(idx)] = val; asum += fabsf(val);
            }
            float xr[16], xi[16];
#pragma unroll
            for (int m = 0; m < 16; ++m) { xr[m] = re[fidx(g + 256 * m)]; xi[m] = 0.f; }
            asum = wave_sum(asum);
            if (C.lane == 0) red[C.wave] = asum;
            __syncthreads();
            const float tot = red[half * 4] + red[half * 4 + 1] + red[half * 4 + 2] + red[half * 4 + 3];
            const float scl = 1.0f / (tot * 4096.0f);
#pragma unroll
            for (int m = 0; m < 16; ++m) xr[m] *= scl;
            dft16<false>(xr, xi); twiddle16<false>(xr, xi, g, 4096); fft_store_s256(re, im, g, xr, xi);
            __syncthreads();
            fft_load_s16(re, im, g, xr, xi); dft16<false>(xr, xi); twiddle16<false>(xr, xi, g & 15, 256); fft_store_s16(re, im, g, xr, xi);
            __syncthreads();
            fft_load_s1(re, im, g, xr, xi); dft16<false>(xr, xi);
            f32x4* dst = KF + ((size_t)(o * 1024 + c) * 4096 + g * 16) / 2;
#pragma unroll
            for (int k = 0; k < 8; ++k) dst[k] = (f32x4){xr[2 * k], xi[2 * k], xr[2 * k + 1], xi[2 * k + 1]};
        }
        __syncthreads();
    }
    {
        const bf16* raw = (const bf16*)(ws + WS_QKRAW); bf16* qkc = (bf16*)(ws + WS_QKC); const float* cw = C.in[13]; const float* cb = C.in[14];
        for (int g = blockIdx.x * NTHREADS + C.tid; g < T * 256; g += C.G * NTHREADS) {
            const int tok = g >> 8, ch0 = (g & 255) * 8, tl = tok & (SEQ - 1);
            const v4u cur = *(const v4u*)(raw + (size_t)tok * 2048 + ch0);
            v4u prv = (v4u){0u, 0u, 0u, 0u}, nxt = (v4u){0u, 0u, 0u, 0u};
            if (tl > 0) prv = *(const v4u*)(raw + (size_t)(tok - 1) * 2048 + ch0);
            if (tl < SEQ - 1) nxt = *(const v4u*)(raw + (size_t)(tok + 1) * 2048 + ch0);
            const float sc = ch0 >= 1024 ? 0.08838834764831845f : 1.0f;
            float o[8];
#pragma unroll
            for (int i = 0; i < 8; ++i) {
                const unsigned pw = prv[i >> 1], cwd = cur[i >> 1], nw = nxt[i >> 1];
                const float p = (i & 1) ? bfhi(pw) : bflo(pw), q = (i & 1) ? bfhi(cwd) : bflo(cwd), n = (i & 1) ? bfhi(nw) : bflo(nw);
                const int ch = ch0 + i;
                const float v = cw[ch] * p + cw[2048 + ch] * q + cw[4096 + ch] * n + cb[ch];
                o[i] = sc * v / (1.0f + expf(-v));
            }
            v4u w; w.x = pk2(o[0], o[1]); w.y = pk2(o[2], o[3]); w.z = pk2(o[4], o[5]); w.w = pk2(o[6], o[7]);
            *(v4u*)(qkc + (size_t)tok * 2048 + ch0) = w;
        }
    }
    {
        const float* gates = (const float*)(ws + WS_GATES); float* GA = (float*)(ws + WS_GA); float* GP = (float*)(ws + WS_GP); float* GE = (float*)(ws + WS_GE);
        LAS float* s0 = (LAS float*)(C.lds + 8192); LAS float* s1 = s0 + 2048; LAS float* s2 = s1 + 2048; LAS float* s3 = s2 + 2048;
        for (int bhd = blockIdx.x; bhd < 64; bhd += C.G) {
            const int b = bhd >> 4, h = (bhd >> 1) & 7, dir = bhd & 1, col_i = dir * 16 + h, col_f = col_i + 8;
            float ig[4], lf[4];
            __syncthreads();
#pragma unroll
            for (int i = 0; i < 4; ++i) { const int t = C.tid + 512 * i; const float* gr = gates + (size_t)(b * SEQ + t) * 32; ig[i] = gr[col_i]; lf[i] = logsigmoidf(gr[col_f]); s0[t] = lf[i]; }
            __syncthreads();
            LAS float* Fc = block_scan_2048<0>(s0, s1, C.tid);
            float a[4], Fv[4], Gx[4];
#pragma unroll
            for (int i = 0; i < 4; ++i) { const int t = C.tid + 512 * i; Fv[i] = Fc[t]; Gx[i] = Fv[i] - lf[i]; a[i] = dir ? ig[i] + Gx[i] : ig[i] - Fv[i]; s2[dir ? 2047 - t : t] = a[i]; }
            __syncthreads();
            LAS float* Pm = block_scan_2048<1>(s2, s3, C.tid);
#pragma unroll
            for (int i = 0; i < 4; ++i) { const int t = C.tid + 512 * i; const float pm = Pm[dir ? 2047 - t : t];
                const float mt = dir ? pm - Gx[i] : Fv[i] + pm;
                GA[bhd * 2048 + t] = a[i]; GP[bhd * 2048 + t] = pm; GE[bhd * 2048 + t] = expf(-mt); }
        }
        __syncthreads();
    }
}

__device__ __forceinline__ void hyena_naive(const Ctx& C) {
    unsigned char* ws = C.ws;
    const bf16* hyt = (const bf16*)(ws + WS_HYT); const float* KT = (const float*)(ws + WS_KT); float* Z = (float*)(ws + WS_Z);
    const float* cw = C.in[3]; const float* cb = C.in[4]; const float* skip = C.in[11];
    LAS float* sv = (LAS float*)C.lds; LAS float* sk = sv + 2048;
    for (int u = blockIdx.x; u < NB * DHY; u += C.G) {
        const int b = u >> 10, c = u & 1023;
        float v[4], x1[4], x2[4];
#pragma unroll
        for (int part = 0; part < 3; ++part) {
            const int ch = part * 1024 + c; const bf16* row = hyt + (size_t)ch * T + b * SEQ;
            const float w0 = cw[ch], w1 = cw[3072 + ch], w2 = cw[6144 + ch], bb = cb[ch];
#pragma unroll
            for (int i = 0; i < 4; ++i) { const int t = C.tid + 512 * i;
                const float p = t > 0 ? bf2f(row[t - 1]) : 0.f, q = bf2f(row[t]), n = t < SEQ - 1 ? bf2f(row[t + 1]) : 0.f;
                const float r = w0 * p + w1 * q + w2 * n + bb;
                if (part == 0) v[i] = r; else if (part == 1) x1[i] = r; else x2[i] = r; }
        }
        __syncthreads();
#pragma unroll
        for (int i = 0; i < 4; ++i) sv[C.tid + 512 * i] = v[i];
#pragma unroll
        for (int i = 0; i < 8; ++i) sk[C.tid + 512 * i] = KT[(size_t)c * 4096 + C.tid + 512 * i];
        __syncthreads();
        float acc[4] = {0.f, 0.f, 0.f, 0.f};
        for (int s = 0; s < SEQ; ++s) { const float vv = sv[s];
#pragma unroll
            for (int i = 0; i < 4; ++i) acc[i] += sk[(C.tid + 512 * i - s) & 4095] * vv; }
        float z1[4]; const float sk0 = skip[c], sk1 = skip[1024 + c];
#pragma unroll
        for (int i = 0; i < 4; ++i) z1[i] = x1[i] * (acc[i] + sk0 * v[i]);
        __syncthreads();
#pragma unroll
        for (int i = 0; i < 4; ++i) sv[C.tid + 512 * i] = z1[i];
#pragma unroll
        for (int i = 0; i < 8; ++i) sk[C.tid + 512 * i] = KT[(size_t)(1024 + c) * 4096 + C.tid + 512 * i];
        __syncthreads();
#pragma unroll
        for (int i = 0; i < 4; ++i) acc[i] = 0.f;
        for (int s = 0; s < SEQ; ++s) { const float vv = sv[s];
#pragma unroll
            for (int i = 0; i < 4; ++i) acc[i] += sk[(C.tid + 512 * i - s) & 4095] * vv; }
#pragma unroll
        for (int i = 0; i < 4; ++i) Z[(size_t)(b * SEQ + C.tid + 512 * i) * 1024 + c] = x2[i] * (acc[i] + sk1 * z1[i]);
    }
    __syncthreads();
}

__device__ __forceinline__ void hyena_conv_once(LAS float* re, LAS float* im, int g, float (&xr)[16], float (&xi)[16], const f32x4* __restrict__ kf) {
    __syncthreads();
    dft16<false>(xr, xi); twiddle16<false>(xr, xi, g, 4096); fft_store_s256(re, im, g, xr, xi);
    __syncthreads();
    fft_load_s16(re, im, g, xr, xi); dft16<false>(xr, xi); twiddle16<false>(xr, xi, g & 15, 256); fft_store_s16(re, im, g, xr, xi);
    __syncthreads();
    fft_load_s1(re, im, g, xr, xi); dft16<false>(xr, xi);
#pragma unroll
    for (int k = 0; k < 8; ++k) { const f32x4 w = kf[g * 8 + k];
        const float r0 = xr[2 * k] * w.x - xi[2 * k] * w.y, i0 = xr[2 * k] * w.y + xi[2 * k] * w.x;
        const float r1 = xr[2 * k + 1] * w.z - xi[2 * k + 1] * w.w, i1 = xr[2 * k + 1] * w.w + xi[2 * k + 1] * w.z;
        xr[2 * k] = r0; xi[2 * k] = i0; xr[2 * k + 1] = r1; xi[2 * k + 1] = i1; }
    dft16<true>(xr, xi); fft_store_s1(re, im, g, xr, xi);
    __syncthreads();
    fft_load_s16(re, im, g, xr, xi); twiddle16<true>(xr, xi, g & 15, 256); dft16<true>(xr, xi); fft_store_s16(re, im, g, xr, xi);
    __syncthreads();
    fft_load_s256(re, im, g, xr, xi); twiddle16<true>(xr, xi, g, 4096); dft16<true>(xr, xi);
}
__device__ __forceinline__ void hyena_fft(const Ctx& C) {
    unsigned char* ws = C.ws;
    const bf16* hyt = (const bf16*)(ws + WS_HYT); const f32x4* KF = (const f32x4*)(ws + WS_KF); float* ZT = (float*)(ws + WS_ZT);
    const float* cw = C.in[3]; const float* cb = C.in[4]; const float* skip = C.in[11];
    const int half = C.tid >> 8, g = C.tid & 255;
    LAS float* re = (LAS float*)(C.lds + half * (2 * FFT_WORDS * 4)); LAS float* im = re + FFT_WORDS;
    for (int c = blockIdx.x; c < DHY; c += C.G) {
        float vr[8], vi[8], ar[8], ai[8], br[8], bi[8];
#pragma unroll
        for (int part = 0; part < 3; ++part) {
            const int ch = part * 1024 + c; const float w0 = cw[ch], w1 = cw[3072 + ch], w2 = cw[6144 + ch], bb = cb[ch];
#pragma unroll
            for (int bq = 0; bq < 2; ++bq) { const bf16* row = hyt + (size_t)ch * T + (2 * half + bq) * SEQ;
#pragma unroll
                for (int m = 0; m < 8; ++m) { const int t = g + 256 * m;
                    const float p = t > 0 ? bf2f(row[t - 1]) : 0.f, q = bf2f(row[t]), n = t < SEQ - 1 ? bf2f(row[t + 1]) : 0.f;
                    const float r = w0 * p + w1 * q + w2 * n + bb;
                    if (part == 0) { if (bq == 0) vr[m] = r; else vi[m] = r; } else if (part == 1) { if (bq == 0) ar[m] = r; else ai[m] = r; } else { if (bq == 0) br[m] = r; else bi[m] = r; } }
                asm volatile("" ::: "memory"); }
        }
        const float sk0 = skip[c], sk1 = skip[1024 + c];
        float xr[16], xi[16];
#pragma unroll
        for (int m = 0; m < 8; ++m) { xr[m] = vr[m]; xi[m] = vi[m]; xr[m + 8] = 0.f; xi[m + 8] = 0.f; }
        hyena_conv_once(re, im, g, xr, xi, KF + (size_t)c * 2048);
#pragma unroll
        for (int m = 0; m < 8; ++m) { vr[m] = ar[m] * (xr[m] + sk0 * vr[m]); vi[m] = ai[m] * (xi[m] + sk0 * vi[m]); xr[m] = vr[m]; xi[m] = vi[m]; xr[m + 8] = 0.f; xi[m + 8] = 0.f; }
        hyena_conv_once(re, im, g, xr, xi, KF + (size_t)(1024 + c) * 2048);
        float* zr = ZT + (size_t)c * T + (2 * half) * SEQ;
#pragma unroll
        for (int m = 0; m < 8; ++m) { const int t = g + 256 * m; zr[t] = br[m] * (xr[m] + sk1 * vr[m]); zr[SEQ + t] = bi[m] * (xi[m] + sk1 * vi[m]); }
    }
    __syncthreads();
}

__device__ __forceinline__ void mlstm_naive(const Ctx& C) {
    unsigned char* ws = C.ws;
    const bf16* qkc = (const bf16*)(ws + WS_QKC); const bf16* vb = (const bf16*)(ws + WS_VB);
    const float* GA = (const float*)(ws + WS_GA); const float* GP = (const float*)(ws + WS_GP); const float* GE = (const float*)(ws + WS_GE);
    float* HML = (float*)(ws + WS_HML);
    LAS float* qs = (LAS float*)(C.lds + C.wave * 1024); LAS float* ps = qs + 128;
    const int lane = C.lane;
    for (int u = blockIdx.x; u < 64 * 32; u += C.G) {
        const int bhd = u >> 5, qb = u & 31, b = bhd >> 4, h = (bhd >> 1) & 7, dir = bhd & 1;
        for (int qi = 0; qi < 8; ++qi) {
            const int t = qb * 64 + C.wave * 8 + qi;
            { const unsigned w = *(const unsigned*)(qkc + (size_t)(b * SEQ + t) * 2048 + h * 128 + 2 * lane); qs[2 * lane] = bflo(w); qs[2 * lane + 1] = bfhi(w); }
            __builtin_amdgcn_wave_barrier(); LDS_WAIT();
            const float pmt = GP[bhd * 2048 + t];
            const int c_lo = dir ? (t >> 6) : 0, c_hi = dir ? 31 : (t >> 6);
            float acc0 = 0.f, acc1 = 0.f, den = 0.f;
            for (int cch = c_lo; cch <= c_hi; ++cch) {
                const int s = cch * 64 + lane; const bool valid = dir ? (s >= t) : (s <= t);
                const v4u* kr = (const v4u*)(qkc + (size_t)(b * SEQ + s) * 2048 + 1024 + h * 128);
                float sc = 0.f;
#pragma unroll
                for (int j = 0; j < 16; ++j) { const v4u kk = kr[j];
#pragma unroll
                    for (int e = 0; e < 4; ++e) sc += qs[8 * j + 2 * e] * bflo(kk[e]) + qs[8 * j + 2 * e + 1] * bfhi(kk[e]); }
                const float p = valid ? sc * expf(GA[bhd * 2048 + s] - pmt) : 0.f;
                den += p;
                __builtin_amdgcn_wave_barrier();
                ps[lane] = p;
                __builtin_amdgcn_wave_barrier(); LDS_WAIT();
                const bf16* vr = vb + (size_t)(b * SEQ + cch * 64) * 1024 + h * 128 + 2 * lane;
#pragma unroll 8
                for (int s2 = 0; s2 < 64; ++s2) { const unsigned w = *(const unsigned*)(vr + (size_t)s2 * 1024); const float pv = ps[s2]; acc0 += pv * bflo(w); acc1 += pv * bfhi(w); }
                __builtin_amdgcn_wave_barrier();
            }
            den = wave_sum(den);
            const float scl = 1.0f / fmaxf(fabsf(den), GE[bhd * 2048 + t]);
            *(f32x2*)(HML + ((size_t)dir * T + b * SEQ + t) * 1024 + h * 128 + 2 * lane) = (f32x2){acc0 * scl, acc1 * scl};
            __builtin_amdgcn_wave_barrier();
        }
    }
    __syncthreads();
}

typedef short ml_bf16x8 __attribute__((ext_vector_type(8)));
typedef short ml_s16x4 __attribute__((ext_vector_type(4)));
typedef float ml_f32x16 __attribute__((ext_vector_type(16)));
typedef __bf16 ml_bf2 __attribute__((ext_vector_type(2)));
constexpr int ML_KROW = 272, ML_VROW = 136, ML_KBUF = 64 * ML_KROW, ML_VBUF = 128 * ML_VROW;
__device__ __forceinline__ unsigned ml_pk(float lo, float hi) { const f32x2 v = {lo, hi}; return __builtin_bit_cast(unsigned, __builtin_convertvector(v, ml_bf2)); }
__device__ __forceinline__ void mlstm_mfma(const Ctx& C) {
    unsigned char* ws = C.ws;
    const bf16* qkc = (const bf16*)(ws + WS_QKC); const bf16* vt = (const bf16*)(ws + WS_HYT) + (size_t)3072 * T;
    const float* GA = (const float*)(ws + WS_GA); const float* GP = (const float*)(ws + WS_GP); const float* GE = (const float*)(ws + WS_GE);
    float* HML = (float*)(ws + WS_HML);
    LAS unsigned char* KB = C.lds; LAS unsigned char* VB = C.lds + 2 * ML_KBUF; LAS float* AS = (LAS float*)(C.lds + 2 * ML_KBUF + 2 * ML_VBUF);
    const int w = C.wave, lane = C.lane, r = lane & 31, hh = lane >> 5, tid = C.tid;
    for (int pu = blockIdx.x; pu < 256; pu += C.G) {
        const int bhd = pu >> 2, pq = pu & 3, b = bhd >> 4, h = (bhd >> 1) & 7, dir = bhd & 1;
        __syncthreads();
        for (int i = tid; i < SEQ; i += NTHREADS) AS[i] = GA[bhd * SEQ + i];
        const bf16* kbase = qkc + (size_t)(b * SEQ) * 2048 + 1024 + h * 128;
        const bf16* vbase = vt + (size_t)(h * 128) * T + b * SEQ;
#pragma unroll 1
        for (int hf = 0; hf < 2; ++hf) {
            const int qb = hf ? 7 - pq : pq;
            const int qlo = 256 * qb + 32 * w, tq = qlo + r;
            ml_bf16x8 qf[8];
            { const bf16* qrow = qkc + (size_t)(b * SEQ + tq) * 2048 + h * 128 + 8 * hh;
#pragma unroll
              for (int s = 0; s < 8; ++s) qf[s] = *(const ml_bf16x8*)(qrow + 16 * s); }
            const float pmt = GP[bhd * SEQ + tq];
            ml_f32x16 O[4];
#pragma unroll
            for (int d = 0; d < 4; ++d)
#pragma unroll
                for (int i = 0; i < 16; ++i) O[d][i] = 0.f;
            float den = 0.f;
            const int kt0 = dir ? 4 * qb : 0, kt1 = dir ? 31 : 4 * qb + 3;
            v4u kr0, kr1, vr0, vr1;
#define ML_LOAD(kt) do { const int p0 = tid, p1 = tid + 512; \
                kr0 = *(const v4u*)(kbase + (size_t)(64 * (kt) + (p0 >> 4)) * 2048 + (p0 & 15) * 8); kr1 = *(const v4u*)(kbase + (size_t)(64 * (kt) + (p1 >> 4)) * 2048 + (p1 & 15) * 8); \
                vr0 = *(const v4u*)(vbase + (size_t)(p0 >> 3) * T + 64 * (kt) + (p0 & 7) * 8); vr1 = *(const v4u*)(vbase + (size_t)(p1 >> 3) * T + 64 * (kt) + (p1 & 7) * 8); } while (0)
#define ML_STORE(buf) do { const int p0 = tid, p1 = tid + 512; \
                *(LAS v4u*)(KB + (buf) * ML_KBUF + (p0 >> 4) * ML_KROW + (p0 & 15) * 16) = kr0; *(LAS v4u*)(KB + (buf) * ML_KBUF + (p1 >> 4) * ML_KROW + (p1 & 15) * 16) = kr1; \
                { LAS unsigned char* d0 = VB + (buf) * ML_VBUF + (p0 >> 3) * ML_VROW + (p0 & 7) * 16; *(LAS v2u*)d0 = (v2u){vr0.x, vr0.y}; *(LAS v2u*)(d0 + 8) = (v2u){vr0.z, vr0.w}; } \
                { LAS unsigned char* d1 = VB + (buf) * ML_VBUF + (p1 >> 3) * ML_VROW + (p1 & 7) * 16; *(LAS v2u*)d1 = (v2u){vr1.x, vr1.y}; *(LAS v2u*)(d1 + 8) = (v2u){vr1.z, vr1.w}; } } while (0)
            ML_LOAD(kt0);
            __syncthreads();
            ML_STORE(0);
            __syncthreads();
#pragma unroll 1
            for (int kt = kt0; kt <= kt1; ++kt) {
                const int cur = (kt - kt0) & 1;
                if (kt < kt1) ML_LOAD(kt + 1);
                const int klo = 64 * kt, khi = klo + 63, qhi = qlo + 31;
                const bool none = dir ? (khi < qlo) : (klo > qhi);
                const bool all = dir ? (klo >= qhi) : (khi <= qlo);
                if (!none) {
                    const LAS unsigned char* Kb = KB + cur * ML_KBUF; const LAS unsigned char* Vb = VB + cur * ML_VBUF;
                    ml_f32x16 S0, S1;
#pragma unroll
                    for (int i = 0; i < 16; ++i) { S0[i] = 0.f; S1[i] = 0.f; }
#pragma unroll
                    for (int s = 0; s < 8; ++s) {
                        const ml_bf16x8 k0 = *(const LAS ml_bf16x8*)(Kb + r * ML_KROW + (16 * s + 8 * hh) * 2);
                        const ml_bf16x8 k1 = *(const LAS ml_bf16x8*)(Kb + (32 + r) * ML_KROW + (16 * s + 8 * hh) * 2);
                        S0 = __builtin_amdgcn_mfma_f32_32x32x16_bf16(k0, qf[s], S0, 0, 0, 0);
                        S1 = __builtin_amdgcn_mfma_f32_32x32x16_bf16(k1, qf[s], S1, 0, 0, 0);
                    }
#pragma unroll
                    for (int kb = 0; kb < 2; ++kb)
#pragma unroll
                        for (int g4 = 0; g4 < 4; ++g4) {
                            const f32x4 a4 = *(const LAS f32x4*)(AS + klo + 32 * kb + 8 * g4 + 4 * hh);
#pragma unroll
                            for (int e = 0; e < 4; ++e) {
                                const int i = 4 * g4 + e; const int sg = klo + 32 * kb + 8 * g4 + 4 * hh + e;
                                const float sv = kb ? S1[i] : S0[i];
                                float p = sv * __expf(a4[e] - pmt);
                                if (!all) { const bool valid = dir ? (sg >= tq) : (sg <= tq); p = valid ? p : 0.f; }
                                den += p;
                                if (kb) S1[i] = p; else S0[i] = p;
                            }
                        }
#pragma unroll
                    for (int kb = 0; kb < 2; ++kb)
#pragma unroll
                        for (int s = 0; s < 2; ++s) {
                            v4u pw;
                            if (kb == 0) { pw.x = ml_pk(S0[8 * s], S0[8 * s + 1]); pw.y = ml_pk(S0[8 * s + 2], S0[8 * s + 3]); pw.z = ml_pk(S0[8 * s + 4], S0[8 * s + 5]); pw.w = ml_pk(S0[8 * s + 6], S0[8 * s + 7]); }
                            else { pw.x = ml_pk(S1[8 * s], S1[8 * s + 1]); pw.y = ml_pk(S1[8 * s + 2], S1[8 * s + 3]); pw.z = ml_pk(S1[8 * s + 4], S1[8 * s + 5]); pw.w = ml_pk(S1[8 * s + 6], S1[8 * s + 7]); }
                            const ml_bf16x8 pf = __builtin_bit_cast(ml_bf16x8, pw);
#pragma unroll
                            for (int db = 0; db < 4; ++db) {
                                const LAS unsigned char* vp = Vb + (32 * db + r) * ML_VROW + 2 * (32 * kb + 16 * s + 4 * hh);
                                const ml_s16x4 lo = *(const LAS ml_s16x4*)vp, hi = *(const LAS ml_s16x4*)(vp + 16);
                                const ml_bf16x8 vf = __builtin_shufflevector(lo, hi, 0, 1, 2, 3, 4, 5, 6, 7);
                                O[db] = __builtin_amdgcn_mfma_f32_32x32x16_bf16(vf, pf, O[db], 0, 0, 0);
                            }
                        }
                }
                if (kt < kt1) ML_STORE(cur ^ 1);
                __syncthreads();
            }
#undef ML_LOAD
#undef ML_STORE
            den += __shfl_xor(den, 32);
            const float scl = 1.0f / fmaxf(fabsf(den), GE[bhd * SEQ + tq]);
            float* orow = HML + ((size_t)dir * T + b * SEQ + tq) * 1024 + h * 128 + 4 * hh;
#pragma unroll
            for (int db = 0; db < 4; ++db)
#pragma unroll
                for (int g4 = 0; g4 < 4; ++g4)
                    *(f32x4*)(orow + 32 * db + 8 * g4) = (f32x4){O[db][4 * g4] * scl, O[db][4 * g4 + 1] * scl, O[db][4 * g4 + 2] * scl, O[db][4 * g4 + 3] * scl};
        }
    }
    __syncthreads();
}

__device__ __forceinline__ void phase4(const Ctx& C) {
    unsigned char* ws = C.ws;
    const float* ZT = (const float*)(ws + WS_ZT); const float* HML = (const float*)(ws + WS_HML); const bf16* ob = (const bf16*)(ws + WS_OB);
    bf16* ycat = (bf16*)(ws + (size_t)YCAT_T0 * MiB); const float* hyw = C.in[12]; const float* mlw = C.in[15];
    const int lane = C.lane;
    {
        LAS float* red = (LAS float*)C.lds;
        for (int u = blockIdx.x; u < 128 * 8; u += C.G) {
            const int tt = u >> 3, gi = u & 7, tok = tt * 64 + lane, ch0 = gi * 128 + C.wave * 16;
            float x[16]; float s = 0.f;
#pragma unroll
            for (int i = 0; i < 16; ++i) { x[i] = ZT[(size_t)(ch0 + i) * T + tok]; s += x[i]; }
            __syncthreads();
            red[C.wave * 64 + lane] = s;
            __syncthreads();
            float tot = 0.f;
#pragma unroll
            for (int w = 0; w < 8; ++w) tot += red[w * 64 + lane];
            const float mu = tot * (1.0f / 128.0f); float q = 0.f;
#pragma unroll
            for (int i = 0; i < 16; ++i) { x[i] -= mu; q += x[i] * x[i]; }
            __syncthreads();
            red[C.wave * 64 + lane] = q;
            __syncthreads();
            float qt = 0.f;
#pragma unroll
            for (int w = 0; w < 8; ++w) qt += red[w * 64 + lane];
            const float rstd = 1.0f / sqrtf(qt * (1.0f / 128.0f) + LN_EPS);
            float y[16];
#pragma unroll
            for (int i = 0; i < 16; ++i) y[i] = x[i] * rstd * hyw[ch0 + i];
            v4u w0, w1; w0.x = pk2(y[0], y[1]); w0.y = pk2(y[2], y[3]); w0.z = pk2(y[4], y[5]); w0.w = pk2(y[6], y[7]);
            w1.x = pk2(y[8], y[9]); w1.y = pk2(y[10], y[11]); w1.z = pk2(y[12], y[13]); w1.w = pk2(y[14], y[15]);
            bf16* dst = ycat + (size_t)tok * 2048 + ch0;
            *(v4u*)dst = w0; *(v4u*)(dst + 8) = w1;
        }
        __syncthreads();
    }
    for (int tok = C.gw; tok < T; tok += C.NGW) {
        float x[16];
#pragma unroll
        for (int j = 0; j < 4; ++j) { const f32x4 a = *(const f32x4*)(HML + (size_t)tok * 1024 + lane * 16 + 4 * j), bq = *(const f32x4*)(HML + ((size_t)T + tok) * 1024 + lane * 16 + 4 * j);
            x[4 * j] = a.x + bq.x; x[4 * j + 1] = a.y + bq.y; x[4 * j + 2] = a.z + bq.z; x[4 * j + 3] = a.w + bq.w; }
        float s = 0.f;
#pragma unroll
        for (int j = 0; j < 16; ++j) s += x[j];
        s += __shfl_xor(s, 1); s += __shfl_xor(s, 2); s += __shfl_xor(s, 4);
        const float mu = s * (1.0f / 128.0f); float q = 0.f;
#pragma unroll
        for (int j = 0; j < 16; ++j) { x[j] -= mu; q += x[j] * x[j]; }
        q += __shfl_xor(q, 1); q += __shfl_xor(q, 2); q += __shfl_xor(q, 4);
        const float rstd = 1.0f / sqrtf(q * (1.0f / 128.0f) + LN_EPS);
        const float* gw = mlw + lane * 16;
        float y[16];
#pragma unroll
        for (int j = 0; j < 16; ++j) y[j] = x[j] * rstd * gw[j];
        const v4u o0 = *(const v4u*)(ob + (size_t)tok * 1024 + lane * 16), o1 = *(const v4u*)(ob + (size_t)tok * 1024 + lane * 16 + 8);
#pragma unroll
        for (int j = 0; j < 4; ++j) { const float a0 = bflo(o0[j]), a1 = bfhi(o0[j]), b0 = bflo(o1[j]), b1 = bfhi(o1[j]);
            y[2 * j] *= 1.0f / (1.0f + expf(-a0)); y[2 * j + 1] *= 1.0f / (1.0f + expf(-a1)); y[8 + 2 * j] *= 1.0f / (1.0f + expf(-b0)); y[8 + 2 * j + 1] *= 1.0f / (1.0f + expf(-b1)); }
        v4u w0, w1; w0.x = pk2(y[0], y[1]); w0.y = pk2(y[2], y[3]); w0.z = pk2(y[4], y[5]); w0.w = pk2(y[6], y[7]);
        w1.x = pk2(y[8], y[9]); w1.y = pk2(y[10], y[11]); w1.z = pk2(y[12], y[13]); w1.w = pk2(y[14], y[15]);
        bf16* dst = ycat + (size_t)tok * 2048 + 1024 + lane * 16;
        *(v4u*)dst = w0; *(v4u*)(dst + 8) = w1;
    }
}

struct TileOrder {
    int nM, nN, a0, b0, G, c;
    __device__ __forceinline__ bool next(int i, pg8::Unit& u) const {
        const int nwg = nM * nN; const int L = i * G + c; if (L >= nwg) return false;
        int w; { const int q = nwg / 8, r = nwg % 8, xcd = L % 8, off = L / 8; w = (xcd < r ? xcd * (q + 1) : r * (q + 1) + (xcd - r) * q) + off; }
        const int nig = 8 * nN, gid = w / nig, wi = w % nig; u.pm = a0 + gid * 8 + (wi % 8); u.pn = b0 + wi / 8; return true;
    }
    __device__ __forceinline__ void a_ready(const pg8::Unit&) const {}
    __device__ __forceinline__ void done(const pg8::Unit&) const {}
};
struct EpiOut {
    static constexpr bool PERM = false, AFTER_DRAIN = false;
    const float* x; const float* bias; float* r1;
    __device__ __forceinline__ void operator()(const pg8::f32x4 (&acc)[2][2][4][2], const pg8::Unit& u, int wr, int wc, int fr, int fq) const {
        const int row0 = (u.pm - YCAT_T0) * 256 + wr * 64 + fr, col0 = (u.pn - WOUT_T0) * 256 + wc * 32 + 4 * fq;
        pg8::f32x4 bv[2][2];
#pragma unroll
        for (int bj = 0; bj < 2; ++bj)
#pragma unroll
            for (int n = 0; n < 2; ++n) bv[bj][n] = *(const pg8::f32x4*)(bias + col0 + bj * 128 + n * 16);
#pragma unroll
        for (int ai = 0; ai < 2; ++ai)
#pragma unroll
            for (int m = 0; m < 4; ++m) { const size_t off = (size_t)(row0 + ai * 128 + m * 16) * D + col0;
#pragma unroll
                for (int bj = 0; bj < 2; ++bj)
#pragma unroll
                    for (int n = 0; n < 2; ++n) { const pg8::f32x4 xs = *(const pg8::f32x4*)(x + off + bj * 128 + n * 16);
                        *(pg8::f32x4*)(r1 + off + bj * 128 + n * 16) = xs * DN_ALPHA + acc[ai][bj][m][n] + bv[bj][n]; } }
    }
};

__device__ __forceinline__ void phase6(const Ctx& C) {
    unsigned char* ws = C.ws;
    float* r1 = (float*)(ws + WS_R1); bf16* x1b = (bf16*)(ws + (size_t)X1B_T0 * MiB);
    const float* g1 = C.in[18]; const float* b1 = C.in[19]; const float* rw = C.in[20]; const float* rb = C.in[21];
    unsigned* cnt = (unsigned*)(ws + WS_CTL) + CW_CNT; int* list = (int*)(ws + WS_LIST); float* tokw = (float*)(ws + WS_TOKW);
    LAS float* xs = (LAS float*)(C.lds + C.wave * 8192);
    const int lane = C.lane;
    for (int tok = C.gw; tok < T; tok += C.NGW) {
        f32x4 v[8]; float s = 0.f;
        float* rr = r1 + (size_t)tok * D;
#pragma unroll
        for (int j = 0; j < 8; ++j) { v[j] = *(const f32x4*)(rr + (lane + 64 * j) * 4); s += (v[j].x + v[j].y) + (v[j].z + v[j].w); }
        const float mean = wave_sum(s) * (1.0f / D); float q = 0.f;
#pragma unroll
        for (int j = 0; j < 8; ++j) { v[j] = v[j] - mean; q += (v[j].x * v[j].x + v[j].y * v[j].y) + (v[j].z * v[j].z + v[j].w * v[j].w); }
        const float rstd = 1.0f / sqrtf(wave_sum(q) * (1.0f / D) + LN_EPS);
        __builtin_amdgcn_wave_barrier();
#pragma unroll
        for (int j = 0; j < 8; ++j) { const int c0 = (lane + 64 * j) * 4; const f32x4 gg = *(const f32x4*)(g1 + c0), bb = *(const f32x4*)(b1 + c0);
            const f32x4 y = v[j] * rstd * gg + bb;
            *(f32x4*)(rr + c0) = y; *(LAS f32x4*)(xs + c0) = y;
            v2u w; w.x = pk2(y.x, y.y); w.y = pk2(y.z, y.w); *(v2u*)(x1b + (size_t)tok * D + c0) = w; }
        __builtin_amdgcn_wave_barrier(); LDS_WAIT();
        const int e = lane & 31, half = lane >> 5; float lg = 0.f;
        const float* rwp = rw + (size_t)(half * 1024) * 32 + e; const LAS float* xp = xs + half * 1024;
#pragma unroll 8
        for (int d = 0; d < 1024; ++d) lg += xp[d] * rwp[(size_t)d * 32];
        lg += __shfl_xor(lg, 32); lg += rb[e];
        float val = lg; int sel_e = 0; float sel_v = 0.f; float vals[4]; int idxs[4];
#pragma unroll
        for (int k = 0; k < 4; ++k) {
            const float m = wave_max(val);
            const unsigned long long bal = __ballot(val == m);
            const int idx = (int)(__builtin_ctzll(bal) & 31);
            vals[k] = m; idxs[k] = idx;
            if (e == idx) val = -3.0e38f;
        }
        const float e1 = expf(vals[1] - vals[0]), e2 = expf(vals[2] - vals[0]), e3 = expf(vals[3] - vals[0]);
        const float inv = 1.0f / (1.0f + e1 + e2 + e3);
        if (lane < 4) {
            sel_e = lane == 0 ? idxs[0] : lane == 1 ? idxs[1] : lane == 2 ? idxs[2] : idxs[3];
            sel_v = (lane == 0 ? 1.0f : lane == 1 ? e1 : lane == 2 ? e2 : e3) * inv;
            const unsigned pos = atomicAdd(cnt + 64 * sel_e, 1u);
            list[sel_e * T + pos] = tok * 4 + lane; tokw[tok * 4 + lane] = sel_v;
        }
        __builtin_amdgcn_wave_barrier();
    }
}

__device__ __forceinline__ void moe_build_tb(const Ctx& C) {
    LAS int* tb = (LAS int*)(C.lds + LDS_TB);
    __syncthreads();
    if (C.tid == 0) { const unsigned* cnt = (const unsigned*)(C.ws + WS_CTL) + CW_CNT; int acc = 0;
        for (int e = 0; e < NE; ++e) { const int n = (int)__hip_atomic_load(cnt + 64 * e, __ATOMIC_RELAXED, __HIP_MEMORY_SCOPE_AGENT); tb[e] = acc; tb[40 + e] = n; acc += (n + 255) >> 8; }
        tb[32] = acc; }
    __syncthreads();
}
__device__ __forceinline__ void phase7(const Ctx& C) {
    unsigned char* ws = C.ws;
    moe_build_tb(C);
    const LAS int* tb = (const LAS int*)(C.lds + LDS_TB);
    const bf16* x1b = (const bf16*)(ws + (size_t)X1B_T0 * MiB); bf16* abuf = (bf16*)(ws + (size_t)ABUF_T0 * MiB);
    const int* list = (const int*)(ws + WS_LIST); const float* tokw = (const float*)(ws + WS_TOKW);
    int* rowslot = (int*)(ws + WS_ROWSLOT); float* roww = (float*)(ws + WS_ROWW);
    const int total_rows = tb[32] * 256;
    for (int row = C.gw; row < total_rows; row += C.NGW) {
        int e = 0; const int rt = row >> 8;
        while (e < NE - 1 && tb[e + 1] <= rt) ++e;
        const int i = row - tb[e] * 256; const int n = tb[40 + e];
        v4u* dst = (v4u*)(abuf + (size_t)row * D);
        if (i < n) { const int slot = list[e * T + i]; const v4u* src = (const v4u*)(x1b + (size_t)(slot >> 2) * D);
#pragma unroll
            for (int j = 0; j < 4; ++j) dst[C.lane + 64 * j] = src[C.lane + 64 * j];
            if (C.lane == 0) { rowslot[row] = slot; roww[row] = tokw[slot]; } }
        else {
#pragma unroll
            for (int j = 0; j < 4; ++j) dst[C.lane + 64 * j] = (v4u){0u, 0u, 0u, 0u};
            if (C.lane == 0) { rowslot[row] = -1; roww[row] = 0.f; } }
    }
}
struct MoeOrder {
    const LAS int* tb; int NJ, a0, w0, G, c;
    __device__ __forceinline__ bool next(int i, pg8::Unit& u) const {
        const int nwg = tb[32] * NJ; const int L = i * G + c; if (L >= nwg) return false;
        int w; { const int q = nwg / 8, r = nwg % 8, xcd = L % 8, off = L / 8; w = (xcd < r ? xcd * (q + 1) : r * (q + 1) + (xcd - r) * q) + off; }
        int e = 0;
        while (e < NE - 1 && tb[e + 1] * NJ <= w) ++e;
        const int local = w - tb[e] * NJ, nt = tb[e + 1] - tb[e], j = local / nt, ti = local - j * nt;
        u.pm = a0 + tb[e] + ti; u.pn = w0 + e * NJ + j; return true;
    }
    __device__ __forceinline__ void a_ready(const pg8::Unit&) const {}
    __device__ __forceinline__ void done(const pg8::Unit&) const {}
};
struct EpiGU {
    static constexpr bool PERM = true, AFTER_DRAIN = false;
    const float* b_gu; bf16* act;
    __device__ __forceinline__ void operator()(const pg8::f32x4 (&acc)[2][2][4][2], const pg8::Unit& u, int wr, int wc, int fr, int fq) const {
        using pg8::cvt_pk_bf16;
        const int rt = u.pm - ABUF_T0, rel = u.pn - WGU_T0, e = rel >> 4, j = rel & 15;
        const int col0 = j * 128 + wc * 32 + 8 * fq;
        pg8::f32x4 bg[2], bu[2];
#pragma unroll
        for (int n = 0; n < 2; ++n) { bg[n] = *(const pg8::f32x4*)(b_gu + (size_t)e * 4096 + col0 + 4 * n); bu[n] = *(const pg8::f32x4*)(b_gu + (size_t)e * 4096 + 2048 + col0 + 4 * n); }
#pragma unroll
        for (int ai = 0; ai < 2; ++ai)
#pragma unroll
            for (int m = 0; m < 4; ++m) { const int row = rt * 256 + ai * 128 + wr * 64 + m * 16 + fr;
                float o[8];
#pragma unroll
                for (int n = 0; n < 2; ++n) { const pg8::f32x4 g = acc[ai][0][m][n] + bg[n], up = acc[ai][1][m][n] + bu[n];
#pragma unroll
                    for (int i = 0; i < 4; ++i) { const float gc = fminf(g[i], 7.0f), uc = fminf(fmaxf(up[i], -7.0f), 7.0f);
                        o[4 * n + i] = (uc + 1.0f) * (gc / (1.0f + __expf(-1.702f * gc))); } }
                v4u w; w.x = cvt_pk_bf16(o[0], o[1]); w.y = cvt_pk_bf16(o[2], o[3]); w.z = cvt_pk_bf16(o[4], o[5]); w.w = cvt_pk_bf16(o[6], o[7]);
                *(v4u*)(act + (size_t)row * DFF + col0) = w; }
    }
};
struct EpiDown {
    static constexpr bool PERM = false, AFTER_DRAIN = false;
    const float* b_down; const int* rowslot; const float* roww; float* ybuf;
    __device__ __forceinline__ void operator()(const pg8::f32x4 (&acc)[2][2][4][2], const pg8::Unit& u, int wr, int wc, int fr, int fq) const {
        const int rt = u.pm - ACT_T0, rel = u.pn - WDN_T0, e = rel >> 3, j = rel & 7;
        const int col0 = j * 256 + wc * 32 + 4 * fq;
        pg8::f32x4 bv[2][2];
#pragma unroll
        for (int bj = 0; bj < 2; ++bj)
#pragma unroll
            for (int n = 0; n < 2; ++n) bv[bj][n] = *(const pg8::f32x4*)(b_down + (size_t)e * D + col0 + bj * 128 + n * 16);
#pragma unroll
        for (int ai = 0; ai < 2; ++ai)
#pragma unroll
            for (int m = 0; m < 4; ++m) { const int row = rt * 256 + ai * 128 + wr * 64 + m * 16 + fr;
                const int slot = rowslot[row]; const float w = roww[row];
                if (slot >= 0) { float* dst = ybuf + (size_t)slot * D + col0;
#pragma unroll
                    for (int bj = 0; bj < 2; ++bj)
#pragma unroll
                        for (int n = 0; n < 2; ++n) *(pg8::f32x4*)(dst + bj * 128 + n * 16) = (acc[ai][bj][m][n] + bv[bj][n]) * w; } }
    }
};

__device__ __forceinline__ void phase10(const Ctx& C) {
    unsigned char* ws = C.ws;
    const float* x1 = (const float*)(ws + WS_R1); const float* ybuf = (const float*)(ws + WS_YBUF);
    const float* g2 = C.in[26]; const float* b2 = C.in[27]; const int lane = C.lane;
    for (int tok = C.gw; tok < T; tok += C.NGW) {
        f32x4 v[8]; float s = 0.f;
#pragma unroll
        for (int j = 0; j < 8; ++j) { const int c0 = (lane + 64 * j) * 4; f32x4 a = *(const f32x4*)(x1 + (size_t)tok * D + c0) * DN_ALPHA;
#pragma unroll
            for (int k = 0; k < 4; ++k) a = a + *(const f32x4*)(ybuf + ((size_t)tok * 4 + k) * D + c0);
            v[j] = a; s += (a.x + a.y) + (a.z + a.w); }
        const float mean = wave_sum(s) * (1.0f / D); float q = 0.f;
#pragma unroll
        for (int j = 0; j < 8; ++j) { v[j] = v[j] - mean; q += (v[j].x * v[j].x + v[j].y * v[j].y) + (v[j].z * v[j].z + v[j].w * v[j].w); }
        const float rstd = 1.0f / sqrtf(wave_sum(q) * (1.0f / D) + LN_EPS);
#pragma unroll
        for (int j = 0; j < 8; ++j) { const int c0 = (lane + 64 * j) * 4; const f32x4 gg = *(const f32x4*)(g2 + c0), bb = *(const f32x4*)(b2 + c0);
            *(f32x4*)(C.out + (size_t)tok * D + c0) = v[j] * rstd * gg + bb; }
    }
}

__global__ void __launch_bounds__(NTHREADS, 2) fwd_kernel(KArgs args) {
    extern __shared__ __attribute__((aligned(16))) unsigned char lds_raw[];
    Ctx C;
#pragma unroll
    for (int i = 0; i < 28; ++i) C.in[i] = args.in[i];
    C.out = args.out; C.ws = args.ws; C.lds = (LAS unsigned char*)lds_raw;
    C.tid = threadIdx.x; C.lane = C.tid & 63; C.wave = __builtin_amdgcn_readfirstlane(C.tid >> 6); C.G = gridDim.x;
    C.gw = blockIdx.x * NWAVES + C.wave; C.NGW = C.G * NWAVES;
    volatile LAS unsigned* MISC = (volatile LAS unsigned*)(C.lds + LDS_MISC);
    if (C.tid < 4) MISC[C.tid] = 0u;
    __syncthreads();
    unsigned* ctl = (unsigned*)(args.ws + WS_CTL);
    XcdBarrier bar; bar.bar = ctl + CW_BAR; bar.x = 0; bar.st = MISC;
    const int lo = args.ph_lo, hi = args.ph_hi;
    if (hi - lo > 1) bar = xcd_barrier_post(ctl + CW_BAR, MISC);
#ifndef PHASE_MASK
#define PHASE_MASK 0x7ff
#endif
#define IN(k) (((PHASE_MASK >> (k)) & 1) && lo <= (k) && (k) < hi)
#define SEAM(k) do { if (IN(k) && IN((k) + 1)) xcd_barrier(bar); } while (0)
    const pg8::Gemm g{(const pg8::bf16_t*)args.ws, (const pg8::bf16_t*)args.ws, 0, 0, 2048};
    PG8_LAS unsigned char* glds = (PG8_LAS unsigned char*)lds_raw;

    if (IN(0)) { phase0(C); } SEAM(0);
    if (IN(1)) {
        Gemm1Order S{C.G, (int)blockIdx.x};
        unsigned char* ws = args.ws;
        Epi1 E{C.in[2], (bf16*)(ws + WS_HYT), (bf16*)(ws + WS_QKRAW), (bf16*)(ws + WS_VB), (bf16*)(ws + WS_OB), (float*)(ws + WS_GATES)};
        pg8::gemm_phase<Epi1, Gemm1Order, true, true>(glds, g, S, E);
    } SEAM(1);
    if (IN(2)) { phase2(C); } SEAM(2);
    if (IN(3)) { hyena_fft(C); if (NAIVE_ML) mlstm_naive(C); else mlstm_mfma(C); } SEAM(3);
    if (IN(4)) { phase4(C); } SEAM(4);
    if (IN(5)) {
        TileOrder S{32, 8, YCAT_T0, WOUT_T0, C.G, (int)blockIdx.x};
        EpiOut E{C.in[0], C.in[17], (float*)(args.ws + WS_R1)};
        pg8::gemm_phase<EpiOut, TileOrder, true, true>(glds, g, S, E);
    } SEAM(5);
    if (IN(6)) { phase6(C); } SEAM(6);
    if (IN(7)) { phase7(C); } SEAM(7);
    if (IN(8)) {
        moe_build_tb(C);
        MoeOrder S{(const LAS int*)(C.lds + LDS_TB), 16, ABUF_T0, WGU_T0, C.G, (int)blockIdx.x};
        EpiGU E{C.in[23], (bf16*)(args.ws + (size_t)ACT_T0 * MiB)};
        pg8::gemm_phase<EpiGU, MoeOrder, true, true>(glds, g, S, E);
    } SEAM(8);
    if (IN(9)) {
        moe_build_tb(C);
        MoeOrder S{(const LAS int*)(C.lds + LDS_TB), 8, ACT_T0, WDN_T0, C.G, (int)blockIdx.x};
        EpiDown E{C.in[25], (const int*)(args.ws + WS_ROWSLOT), (const float*)(args.ws + WS_ROWW), (float*)(args.ws + WS_YBUF)};
        pg8::gemm_phase<EpiDown, MoeOrder, true, true>(glds, g, S, E);
    } SEAM(9);
    if (IN(10)) { phase10(C); }
#undef IN
#undef SEAM
}

extern "C" void kernel_launch(void* const* d_in, const int* in_sizes, int n_in, void* d_out, int out_size, void* d_ws, size_t ws_size, hipStream_t stream) {
    static int grid = 0;
    if (grid == 0) {
        if (n_in != 28 || in_sizes[0] != T * D || out_size != T * D || ws_size < WS_END) { fprintf(stderr, "kernel_launch: unexpected shapes (n_in %d, in0 %d, out %d, ws %zu)\n", n_in, n_in > 0 ? in_sizes[0] : -1, out_size, ws_size); grid = -1; return; }
        int dev = 0, cus = 0;
        if (hipGetDevice(&dev) != hipSuccess || hipDeviceGetAttribute(&cus, hipDeviceAttributeMultiprocessorCount, dev) != hipSuccess) { grid = -1; return; }
        if (hipFuncSetAttribute((const void*)fwd_kernel, hipFuncAttributeMaxDynamicSharedMemorySize, LDS_BYTES) != hipSuccess) { fprintf(stderr, "kernel_launch: hipFuncSetAttribute failed\n"); grid = -1; return; }
        int per_cu = 0;
        if (hipOccupancyMaxActiveBlocksPerMultiprocessor(&per_cu, (const void*)fwd_kernel, NTHREADS, LDS_BYTES) != hipSuccess || per_cu < 1) fprintf(stderr, "kernel_launch: occupancy query says %d\n", per_cu);
        (void)hipGetLastError();
        grid = cus;
    }
    if (grid < 0) return;
    if (hipMemsetAsync((char*)d_ws + WS_CTL, 0, CTL_ZERO_BYTES, stream) != hipSuccess) return;
    KArgs a{};
    for (int i = 0; i < 28; ++i) a.in[i] = (const float*)d_in[i];
    a.out = (float*)d_out; a.ws = (unsigned char*)d_ws;
#if MK_ONE_LAUNCH
    a.ph_lo = 0; a.ph_hi = N_PHASES;
    hipLaunchKernelGGL(fwd_kernel, dim3(grid), dim3(NTHREADS), LDS_BYTES, stream, a);
#else
    for (int ph = 0; ph < N_PHASES; ++ph) { a.ph_lo = ph; a.ph_hi = ph + 1; hipLaunchKernelGGL(fwd_kernel, dim3(grid), dim3(NTHREADS), LDS_BYTES, stream, a); }
#endif
}
```

```cpp
#include <hip/hip_runtime.h>
#include <cstdio>
#include <cstdint>
namespace pg8 {
#define PG8_LAS __attribute__((address_space(3)))
typedef unsigned short bf16_t;
typedef short bf16x8 __attribute__((ext_vector_type(8)));
typedef float f32x4 __attribute__((ext_vector_type(4)));
typedef unsigned u32x4 __attribute__((ext_vector_type(4)));
constexpr int BM = 256, BK = 64, HALF = 128, HTB = HALF * BK * 2  , STAGE_BYTES = 8 * HTB, NXCD = 8, WGM = 8;

__host__ __device__ __forceinline__ int lds_byte(int r, int c) { const int st = (r >> 4) * 2 + (c >> 5), rr = r & 15, cc = c & 31, ob = rr * 64 + cc * 2; return st * 1024 + (ob ^ (((ob >> 9) & 1) << 5)); }
__host__ __device__ __forceinline__ void stage_rc(int b, int& R, int& C) { const int st = b / 1024, sb = b % 1024, swz = sb ^ (((sb >> 9) & 1) << 5); R = (st >> 1) * 16 + swz / 64; C = (st & 1) * 32 + (swz % 64) / 2; }
__host__ __device__ __forceinline__ int perm32(int rho) { const int n = rho >> 4, i = rho & 15; return 8 * (i >> 2) + 4 * n + (i & 3); }

struct Unit { int pm, pn; };
struct Gemm { const bf16_t* A; const bf16_t* Bt; int M, N, K; };
__device__ __forceinline__ unsigned cvt_pk_bf16(float lo, float hi) { unsigned r; asm volatile("v_cvt_pk_bf16_f32 %0, %1, %2" : "=v"(r) : "v"(lo), "v"(hi)); return r; }
typedef float f32x2 __attribute__((ext_vector_type(2)));
template <class Epi, class Sched, bool ALIGN_EPI = false, bool SP2 = false>
__device__ __forceinline__ void gemm_phase(PG8_LAS unsigned char* lds, const Gemm g, const Sched& S, const Epi& E) {
    const int tid = threadIdx.x, wid = __builtin_amdgcn_readfirstlane(tid >> 6), lane = tid & 63, wr = wid >> 2, wc = wid & 3, fr = lane & 15, fq = lane >> 4;
    const int K = g.K, nt = K / BK;
    unsigned voffA[2], voffB[2];
#pragma unroll
    for (int i = 0; i < 2; ++i) { int R, C; stage_rc(tid * 16 + i * 8192, R, C); const int Rb = Epi::PERM ? ((R & ~31) + perm32(R & 31)) : R;
        voffA[i] = (unsigned)(R * K + C) * 2u; voffB[i] = (unsigned)(Rb * K + C) * 2u; }
    const size_t kstep = (size_t)(BK * 2);
    const size_t hstep = (size_t)HALF * K * 2;
    const size_t tstep = 2 * hstep;
    const unsigned ldsw = (unsigned)wid * 1024u;
    const int aoff = lds_byte(wr * 64 + fr, fq * 8), boff = lds_byte(wc * 32 + fr, fq * 8);
#define PG8_SA(b, h) (((b) * 2 + (h)) * HTB)
#define PG8_SB(b, h) ((4 + (b) * 2 + (h)) * HTB)
#define PG8_STAGE(bufoff, gbase, voff) do { _Pragma("unroll") for (int _i = 0; _i < 2; ++_i) \
        __builtin_amdgcn_global_load_lds((const unsigned*)((const char*)(gbase) + (voff)[_i]), (PG8_LAS unsigned*)(lds + (bufoff) + ldsw + _i * 8192), 16, 0, 0); } while (0)
#define PG8_LDA(dst, b, h) do { _Pragma("unroll") for (int m = 0; m < 4; ++m) _Pragma("unroll") for (int k = 0; k < 2; ++k) dst[m][k] = *(const PG8_LAS bf16x8*)(lds + PG8_SA(b, h) + aoff + m * 2048 + k * 1024); } while (0)
#define PG8_LDB(dst, b, h) do { _Pragma("unroll") for (int n = 0; n < 2; ++n) _Pragma("unroll") for (int k = 0; k < 2; ++k) dst[n][k] = *(const PG8_LAS bf16x8*)(lds + PG8_SB(b, h) + boff + n * 2048 + k * 1024); } while (0)
#define PG8_MMA(ai, bj, At, Bt) do { __builtin_amdgcn_s_setprio(1); _Pragma("unroll") for (int m = 0; m < 4; ++m) _Pragma("unroll") for (int n = 0; n < 2; ++n) _Pragma("unroll") for (int k = 0; k < 2; ++k) \
        acc[ai][bj][m][n] = __builtin_amdgcn_mfma_f32_16x16x32_bf16(Bt[n][k], At[m][k], acc[ai][bj][m][n], 0, 0, 0); __builtin_amdgcn_s_setprio(0); } while (0)
#define PG8_WAIT_V(n) asm volatile("s_waitcnt vmcnt(" #n ")" ::: "memory")
#define PG8_WAIT_L(n) asm volatile("s_waitcnt lgkmcnt(" #n ")" ::: "memory")
#define PG8_BAR __builtin_amdgcn_s_barrier()
#define PG8_SCHED __builtin_amdgcn_sched_barrier(0)
    Unit cur, nxt; int ui = 0;
    if (!S.next(0, cur)) return;
    f32x4 acc[2][2][4][2];
#pragma unroll
    for (int a = 0; a < 2; ++a)
#pragma unroll
        for (int b = 0; b < 2; ++b)
#pragma unroll
            for (int m = 0; m < 4; ++m)
#pragma unroll
                for (int n = 0; n < 2; ++n) acc[a][b][m][n] = (f32x4){0.f, 0.f, 0.f, 0.f};
    bf16x8 At[4][2], B0[2][2], B1[2][2];
    const char* cA = (const char*)g.A + (size_t)cur.pm * tstep; const char* cB = (const char*)g.Bt + (size_t)cur.pn * tstep;
    S.a_ready(cur);
    if constexpr (SP2) {
        PG8_STAGE(PG8_SB(0, 0), cB, voffB); PG8_STAGE(PG8_SB(0, 1), cB + hstep, voffB); PG8_STAGE(PG8_SA(0, 0), cA, voffA); PG8_STAGE(PG8_SA(0, 1), cA + hstep, voffA);
        if (wr == 1) PG8_BAR;
        PG8_WAIT_V(2); PG8_BAR;
        PG8_STAGE(PG8_SB(1, 0), cB + kstep, voffB); PG8_STAGE(PG8_SA(1, 0), cA + kstep, voffA); PG8_STAGE(PG8_SB(1, 1), cB + hstep + kstep, voffB);
        PG8_WAIT_V(6); PG8_BAR;
    } else {
        PG8_STAGE(PG8_SB(0, 0), cB, voffB); PG8_STAGE(PG8_SA(0, 0), cA, voffA); PG8_STAGE(PG8_SB(0, 1), cB + hstep, voffB); PG8_STAGE(PG8_SA(0, 1), cA + hstep, voffA);
        if (wr == 1) PG8_BAR;
        PG8_WAIT_V(4); PG8_BAR;
        PG8_STAGE(PG8_SB(1, 0), cB + kstep, voffB); PG8_STAGE(PG8_SA(1, 0), cA + kstep, voffA); PG8_STAGE(PG8_SB(1, 1), cB + hstep + kstep, voffB);
        PG8_WAIT_V(6); PG8_BAR;
    }
    for (;;) {
        const bool has_next = S.next(ui + 1, nxt);
        const char* nA = has_next ? (const char*)g.A + (size_t)nxt.pm * tstep : cA; const char* nB = has_next ? (const char*)g.Bt + (size_t)nxt.pn * tstep : cB;
        for (int t = 0; t < nt; t += 2) {
            const bool last = (t == nt - 2);
            const char* a1 = cA + (size_t)(t + 1) * kstep;
            const char* a2 = last ? nA : cA + (size_t)(t + 2) * kstep; const char* b2 = last ? nB : cB + (size_t)(t + 2) * kstep;
            const char* a3 = a2 + kstep; const char* b3 = b2 + kstep;
            if (last && has_next) S.a_ready(nxt);
            if constexpr (SP2) {
            PG8_LDB(B0, 0, 0); PG8_LDB(B1, 0, 1); PG8_SCHED; PG8_LDA(At, 0, 0); PG8_STAGE(PG8_SA(1, 1), a1 + hstep, voffA);
            PG8_WAIT_V(8); PG8_WAIT_L(0); PG8_BAR; PG8_MMA(0, 0, At, B0); PG8_MMA(0, 1, At, B1); PG8_BAR; PG8_SCHED;
            PG8_LDA(At, 0, 1); PG8_STAGE(PG8_SB(0, 0), b2, voffB); PG8_STAGE(PG8_SB(0, 1), b2 + hstep, voffB); PG8_STAGE(PG8_SA(0, 0), a2, voffA);
            PG8_WAIT_V(8); PG8_WAIT_L(0); PG8_BAR; PG8_MMA(1, 0, At, B0); PG8_MMA(1, 1, At, B1); PG8_BAR; PG8_SCHED;
            PG8_LDB(B0, 1, 0); PG8_LDB(B1, 1, 1); PG8_SCHED; PG8_LDA(At, 1, 0); PG8_STAGE(PG8_SA(0, 1), a2 + hstep, voffA);
            PG8_WAIT_V(8); PG8_WAIT_L(0); PG8_BAR; PG8_MMA(0, 0, At, B0); PG8_MMA(0, 1, At, B1); PG8_BAR; PG8_SCHED;
            PG8_LDA(At, 1, 1); PG8_STAGE(PG8_SB(1, 0), b3, voffB); PG8_STAGE(PG8_SB(1, 1), b3 + hstep, voffB); PG8_STAGE(PG8_SA(1, 0), a3, voffA);
            PG8_WAIT_V(8); PG8_WAIT_L(0); PG8_BAR; PG8_MMA(1, 0, At, B0); PG8_MMA(1, 1, At, B1); PG8_BAR; PG8_SCHED;
            } else {
            PG8_LDB(B0, 0, 0); PG8_SCHED; PG8_LDA(At, 0, 0); PG8_STAGE(PG8_SA(1, 1), a1 + hstep, voffA);
            PG8_WAIT_L(8); PG8_BAR; PG8_WAIT_L(0); PG8_MMA(0, 0, At, B0); PG8_BAR; PG8_SCHED;
            PG8_LDB(B1, 0, 1); PG8_STAGE(PG8_SB(0, 0), b2, voffB);
            PG8_BAR; PG8_WAIT_L(0); PG8_MMA(0, 1, At, B1); PG8_BAR;
            PG8_LDA(At, 0, 1); PG8_STAGE(PG8_SA(0, 0), a2, voffA);
            PG8_BAR; PG8_WAIT_L(0); PG8_MMA(1, 0, At, B0); PG8_BAR; PG8_SCHED;
            PG8_STAGE(PG8_SB(0, 1), b2 + hstep, voffB);
            PG8_WAIT_V(6); PG8_BAR; PG8_MMA(1, 1, At, B1); PG8_BAR;
            PG8_LDB(B0, 1, 0); PG8_SCHED; PG8_LDA(At, 1, 0); PG8_STAGE(PG8_SA(0, 1), a2 + hstep, voffA);
            PG8_WAIT_L(8); PG8_BAR; PG8_WAIT_L(0); PG8_MMA(0, 0, At, B0); PG8_BAR; PG8_SCHED;
            PG8_LDB(B1, 1, 1); PG8_STAGE(PG8_SB(1, 0), b3, voffB);
            PG8_BAR; PG8_WAIT_L(0); PG8_MMA(0, 1, At, B1); PG8_BAR;
            PG8_LDA(At, 1, 1); PG8_STAGE(PG8_SA(1, 0), a3, voffA);
            PG8_BAR; PG8_WAIT_L(0); PG8_MMA(1, 0, At, B0); PG8_BAR; PG8_SCHED;
            PG8_STAGE(PG8_SB(1, 1), b3 + hstep, voffB);
            PG8_WAIT_V(6); PG8_BAR; PG8_MMA(1, 1, At, B1); PG8_BAR;
            }
        }
        if constexpr (ALIGN_EPI) { if (wr == 0) PG8_BAR; }
        if constexpr (!Epi::AFTER_DRAIN) { E(acc, cur, wr, wc, fr, fq); S.done(cur); }
        if (!has_next) break;
#pragma unroll
        for (int a = 0; a < 2; ++a)
#pragma unroll
            for (int b = 0; b < 2; ++b)
#pragma unroll
                for (int m = 0; m < 4; ++m)
#pragma unroll
                    for (int n = 0; n < 2; ++n) acc[a][b][m][n] = (f32x4){0.f, 0.f, 0.f, 0.f};
        cur = nxt; cA = nA; cB = nB; ++ui;
        if constexpr (ALIGN_EPI) { if (wr == 1) PG8_BAR; }
    }
    PG8_WAIT_V(0);
    if constexpr (!ALIGN_EPI) { if (wr == 0) PG8_BAR; }
    PG8_BAR;
    if constexpr (Epi::AFTER_DRAIN) { E.fused(acc, cur, wr, wc, fr, fq, lds, wid, lane); S.done(cur); }
#undef PG8_SA
#undef PG8_SB
#undef PG8_STAGE
#undef PG8_LDA
#undef PG8_LDB
#undef PG8_MMA
#undef PG8_WAIT_V
#undef PG8_WAIT_L
#undef PG8_BAR
#undef PG8_SCHED
}
}

constexpr int NB = 4, SEQ = 2048, T = NB * SEQ, D = 2048, DHY = 1024, DML = 1024, DIN = 7200, NE = 32, TOPK = 4, NH = 8, HD = 128, DFF = 2048;
constexpr float LN_EPS = 1e-5f, DN_ALPHA = 1.189207115002721f;
constexpr int NWAVES = 8, NTHREADS = 512;
#ifndef MK_ONE_LAUNCH
#define MK_ONE_LAUNCH 1
#endif
constexpr int N_PHASES = 11;

constexpr size_t MiB = 1u << 20;
constexpr size_t WS_CTL = 0, CTL_ZERO_BYTES = 1 * MiB;
constexpr size_t WS_H2P = 1936 * MiB;
constexpr size_t WS_W3P = 1937 * MiB;
constexpr size_t WS_GATES = 2 * MiB;
constexpr size_t WS_TOKW = 3 * MiB;
constexpr size_t WS_LIST = 4 * MiB;
constexpr size_t WS_ROWSLOT = 5 * MiB;
constexpr size_t WS_ROWW = 5 * MiB + 512 * 1024;
constexpr size_t WS_GA = 6 * MiB, WS_GP = 6 * MiB + 512 * 1024, WS_GE = 7 * MiB;
constexpr size_t TILE_BYTES = 256 * 2048 * 2;
constexpr int XB_T0 = 8, WIN_T0 = 40, WOUT_T0 = 72, YCAT_T0 = 80, X1B_T0 = 112, ABUF_T0 = 144, ACT_T0 = 304, WGU_T0 = 464, WDN_T0 = 976;
constexpr size_t WS_HYT = 1232 * MiB;
constexpr size_t WS_QKRAW = 1296 * MiB;
constexpr size_t WS_OB = 1328 * MiB;
constexpr size_t WS_QKC = 1344 * MiB;
constexpr size_t WS_KT = 1376 * MiB;
constexpr size_t WS_KF = 1840 * MiB;
constexpr size_t WS_ZT = 1904 * MiB;
constexpr size_t WS_Z = 1408 * MiB;
constexpr size_t WS_HML = 1440 * MiB;
constexpr size_t WS_R1 = 1504 * MiB;
constexpr size_t WS_YBUF = 1568 * MiB;
constexpr size_t WS_VB = 1824 * MiB;
constexpr size_t WS_END = 1940 * MiB;
constexpr int CW_BAR = 4096, CW_CNT = 16384;

constexpr int LDS_STAGE = 131072, LDS_MISC = LDS_STAGE, LDS_TB = LDS_STAGE + 64, LDS_BYTES = 147456;

#define GAS __attribute__((address_space(1)))
#define LAS __attribute__((address_space(3)))
typedef unsigned short bf16;
typedef unsigned v4u __attribute__((ext_vector_type(4)));
typedef unsigned v2u __attribute__((ext_vector_type(2)));
typedef float f32x4 __attribute__((ext_vector_type(4)));
typedef float f32x2 __attribute__((ext_vector_type(2)));
#define LDS_WAIT() asm volatile("s_waitcnt lgkmcnt(0)" ::: "memory")
__device__ __forceinline__ unsigned f2bf(float f) { unsigned u = __builtin_bit_cast(unsigned, f); return (u + 0x7fffu + ((u >> 16) & 1u)) >> 16; }
__device__ __forceinline__ unsigned pk2(float lo, float hi) { return f2bf(lo) | (f2bf(hi) << 16); }
__device__ __forceinline__ float bflo(unsigned w) { return __builtin_bit_cast(float, w << 16); }
__device__ __forceinline__ float bfhi(unsigned w) { return __builtin_bit_cast(float, w & 0xffff0000u); }
__device__ __forceinline__ float bf2f(bf16 b) { return __builtin_bit_cast(float, (unsigned)b << 16); }
__device__ __forceinline__ float wave_sum(float v) {
#pragma unroll
    for (int o = 1; o < 64; o <<= 1) v += __shfl_xor(v, o);
    return v;
}
__device__ __forceinline__ float wave_max(float v) {
#pragma unroll
    for (int o = 1; o < 64; o <<= 1) v = fmaxf(v, __shfl_xor(v, o));
    return v;
}

#define XB_TMO      128
#define XB_XCNT(j)  (256  + 64 * (j))
#define XB_XSUB(j)  (1280 + 64 * (j))
#define XB_XGEN(j)  (2304 + 64 * (j))
#define XB_TOP      3328
#define XB_TOPGEN   3392
#define XCD_BAR_WORDS 3456
#define XB_SPIN_CAP (1u << 22)

__device__ __forceinline__ unsigned xb_ld(unsigned* p)              { return __hip_atomic_load(p, __ATOMIC_RELAXED, __HIP_MEMORY_SCOPE_AGENT); }
__device__ __forceinline__ unsigned xb_add(unsigned* p, unsigned v) { return __hip_atomic_fetch_add(p, v, __ATOMIC_RELAXED, __HIP_MEMORY_SCOPE_AGENT); }
__device__ __forceinline__ unsigned xb_xcc_id() { return (unsigned)__builtin_amdgcn_s_getreg((3 << 11) | 20) & 0xFu; }
#define XB_SPIN(cond, bar) do { unsigned _sp = 0; while (cond) { __builtin_amdgcn_s_sleep(1); \
    if ((++_sp & 255u) == 0u) { if (xb_ld(&(bar)[XB_TMO])) break; if (_sp > XB_SPIN_CAP) { atomicAdd(&(bar)[XB_TMO], 1u); break; } } } } while (0)

struct XcdBarrier {
    unsigned* bar; unsigned x;
    volatile LAS unsigned* st;
};

__device__ __forceinline__ XcdBarrier xcd_barrier_post(unsigned* bar, volatile LAS unsigned* st) {
    XcdBarrier b; b.bar = bar; b.x = xb_xcc_id(); b.st = st;
    if (threadIdx.x == 0) (void)xb_add(&bar[XB_XCNT(b.x)], 1u);
    return b;
}
__device__ __forceinline__ void xcd_barrier_complete(unsigned* bar, unsigned x, unsigned& nloc, unsigned& nx) {
    const unsigned G = gridDim.x * gridDim.y * gridDim.z;
    unsigned sum, cnt, mine, sp = 0u;
    for (;;) {
        sum = 0u; cnt = 0u; mine = 0u;
#pragma unroll
        for (unsigned j = 0; j < 16; ++j) { const unsigned c = xb_ld(&bar[XB_XCNT(j)]); sum += c; cnt += (c > 0u) ? 1u : 0u; mine = (j == x) ? c : mine; }
        if (sum == G) break;
        __builtin_amdgcn_s_sleep(1);
        if ((++sp & 255u) == 0u) { if (xb_ld(&bar[XB_TMO])) break; if (sp > XB_SPIN_CAP) { atomicAdd(&bar[XB_TMO], 1u); break; } }
    }
    nloc = mine > 0u ? mine : 1u; nx = cnt > 0u ? cnt : 1u;
}

__device__ __forceinline__ void xcd_barrier(const XcdBarrier& b) {
    asm volatile("s_waitcnt vmcnt(0)" ::: "memory");
    __syncthreads();
    if (threadIdx.x == 0) {
        unsigned* bar = b.bar;
        __builtin_amdgcn_s_waitcnt(0);
        unsigned nloc = b.st[0], nx = b.st[1];
        if (nloc == 0u) { xcd_barrier_complete(bar, b.x, nloc, nx); b.st[0] = nloc; b.st[1] = nx; }
        const unsigned old = xb_add(&bar[XB_XSUB(b.x)], 1u);
        const unsigned gen = old / nloc;
        if (old + 1u == (gen + 1u) * nloc) {
            __builtin_amdgcn_fence(__ATOMIC_RELEASE, "agent");
            asm volatile("s_waitcnt vmcnt(0)" ::: "memory");
            const unsigned og = xb_add(&bar[XB_TOP], 1u);
            const unsigned tg = og / nx;
            if (og + 1u == (tg + 1u) * nx) xb_add(&bar[XB_TOPGEN], 1u);
            else XB_SPIN(xb_ld(&bar[XB_TOPGEN]) == tg, bar);
            __builtin_amdgcn_fence(__ATOMIC_ACQUIRE, "agent");
            xb_add(&bar[XB_XGEN(b.x)], 1u);
            asm volatile("s_waitcnt vmcnt(0)" ::: "memory");
        } else {
            XB_SPIN(xb_ld(&bar[XB_XGEN(b.x)]) == gen, bar);
            __builtin_amdgcn_fence(__ATOMIC_ACQUIRE, "agent");
            asm volatile("s_waitcnt vmcnt(0)" ::: "memory");
        }
    }
    __syncthreads();
}


#ifndef FFT_HD
#define FFT_HD __device__ __forceinline__
#define FFT_LDS LAS
#endif
constexpr int FFT_WORDS = 4096 + 1024 + 256;
FFT_HD int fidx(int i) { return i + 4 * (i >> 4) + 16 * (i >> 8); }

template <bool INV> FFT_HD void dft4(float& ar, float& ai, float& br, float& bi, float& cr, float& ci, float& dr, float& di) {
    const float s0r = ar + cr, s0i = ai + ci, s1r = ar - cr, s1i = ai - ci;
    const float s2r = br + dr, s2i = bi + di, s3r = br - dr, s3i = bi - di;
    ar = s0r + s2r; ai = s0i + s2i;
    cr = s0r - s2r; ci = s0i - s2i;
    if (!INV) { br = s1r + s3i; bi = s1i - s3r; dr = s1r - s3i; di = s1i + s3r; }
    else      { br = s1r - s3i; bi = s1i + s3r; dr = s1r + s3i; di = s1i - s3r; }
}
template <bool INV> FFT_HD void dft16(float (&xr)[16], float (&xi)[16]) {
#pragma unroll
    for (int n0 = 0; n0 < 4; ++n0) dft4<INV>(xr[n0], xi[n0], xr[n0 + 4], xi[n0 + 4], xr[n0 + 8], xi[n0 + 8], xr[n0 + 12], xi[n0 + 12]);
    constexpr float C1 = 0.9238795325112867f, S1 = 0.3826834323650898f, C2 = 0.7071067811865476f;
    const float tc[10] = {1.f, C1, C2, S1, 0.f, -S1, -C2, -C1, -1.f, -C1};
    const float ts[10] = {0.f, S1, C2, C1, 1.f, C1, C2, S1, 0.f, -S1};
#pragma unroll
    for (int n0 = 1; n0 < 4; ++n0)
#pragma unroll
        for (int k0 = 1; k0 < 4; ++k0) { const int m = n0 * k0; const float wr = tc[m], wi = INV ? ts[m] : -ts[m];
            const int id = n0 + 4 * k0; const float r = xr[id] * wr - xi[id] * wi, i = xr[id] * wi + xi[id] * wr; xr[id] = r; xi[id] = i; }
#pragma unroll
    for (int k0 = 0; k0 < 4; ++k0) dft4<INV>(xr[4 * k0], xi[4 * k0], xr[4 * k0 + 1], xi[4 * k0 + 1], xr[4 * k0 + 2], xi[4 * k0 + 2], xr[4 * k0 + 3], xi[4 * k0 + 3]);
#pragma unroll
    for (int a = 0; a < 4; ++a)
#pragma unroll
        for (int b = a + 1; b < 4; ++b) { float t = xr[4 * a + b]; xr[4 * a + b] = xr[4 * b + a]; xr[4 * b + a] = t; t = xi[4 * a + b]; xi[4 * a + b] = xi[4 * b + a]; xi[4 * b + a] = t; }
}
template <bool INV> FFT_HD void twiddle16(float (&xr)[16], float (&xi)[16], int j, int n) {
    float s, c;
#ifdef __HIP_DEVICE_COMPILE__
    asm volatile("" : "+v"(j));
    sincospif(2.0f * (float)j / (float)n, &s, &c);
#else
    s = (float)sin(2.0 * 3.14159265358979323846 * j / n); c = (float)cos(2.0 * 3.14159265358979323846 * j / n);
#endif
    const float wr = c, wi = INV ? s : -s;
    float pr = wr, pi = wi;
#pragma unroll
    for (int k = 1; k < 16; ++k) {
        const float r = xr[k] * pr - xi[k] * pi, i = xr[k] * pi + xi[k] * pr; xr[k] = r; xi[k] = i;
        const float nr = pr * wr - pi * wi, ni = pr * wi + pi * wr; pr = nr; pi = ni;
    }
}
FFT_HD void fft_store_s256(FFT_LDS float* re, FFT_LDS float* im, int g, const float (&xr)[16], const float (&xi)[16]) {
    const int a0 = fidx(g);
#pragma unroll
    for (int k = 0; k < 16; ++k) { re[a0 + 336 * k] = xr[k]; im[a0 + 336 * k] = xi[k]; }
}
FFT_HD void fft_load_s256(const FFT_LDS float* re, const FFT_LDS float* im, int g, float (&xr)[16], float (&xi)[16]) {
    const int a0 = fidx(g);
#pragma unroll
    for (int k = 0; k < 16; ++k) { xr[k] = re[a0 + 336 * k]; xi[k] = im[a0 + 336 * k]; }
}
FFT_HD void fft_load_s16(const FFT_LDS float* re, const FFT_LDS float* im, int g, float (&xr)[16], float (&xi)[16]) {
    const int a0 = fidx((g >> 4) * 256 + (g & 15));
#pragma unroll
    for (int k = 0; k < 16; ++k) { xr[k] = re[a0 + 20 * k]; xi[k] = im[a0 + 20 * k]; }
}
FFT_HD void fft_store_s16(FFT_LDS float* re, FFT_LDS float* im, int g, const float (&xr)[16], const float (&xi)[16]) {
    const int a0 = fidx((g >> 4) * 256 + (g & 15));
#pragma unroll
    for (int k = 0; k < 16; ++k) { re[a0 + 20 * k] = xr[k]; im[a0 + 20 * k] = xi[k]; }
}
FFT_HD void fft_load_s1(const FFT_LDS float* re, const FFT_LDS float* im, int g, float (&xr)[16], float (&xi)[16]) {
    const int a = fidx(g * 16);
#pragma unroll
    for (int k = 0; k < 16; ++k) { xr[k] = re[a + k]; xi[k] = im[a + k]; }
}
FFT_HD void fft_store_s1(FFT_LDS float* re, FFT_LDS float* im, int g, const float (&xr)[16], const float (&xi)[16]) {
    const int a = fidx(g * 16);
#pragma unroll
    for (int k = 0; k < 16; ++k) { re[a + k] = xr[k]; im[a + k] = xi[k]; }
}


struct KArgs { const float* in[28]; float* out; unsigned char* ws; int ph_lo, ph_hi; };
struct Ctx {
    const float* in[28]; float* out; unsigned char* ws; LAS unsigned char* lds;
    int tid, lane, wave, G, gw, NGW;
};

__device__ __forceinline__ void transpose_item(const float* __restrict__ W, int N, int k0, int n0, bf16* __restrict__ dst, LAS float* scr, int lane) {
#pragma unroll 8
    for (int i = 0; i < 32; ++i) { const int kk = 2 * i + (lane >> 5); scr[kk * 33 + (lane & 31)] = W[(size_t)(k0 + kk) * N + n0 + (lane & 31)]; }
    LDS_WAIT(); asm volatile("" ::: "memory");
    const int c = lane & 7;
#pragma unroll
    for (int j = 0; j < 4; ++j) { const int n = (lane >> 3) + 8 * j; const LAS float* s = scr + (8 * c) * 33 + n;
        v4u o; o.x = pk2(s[0 * 33], s[1 * 33]); o.y = pk2(s[2 * 33], s[3 * 33]); o.z = pk2(s[4 * 33], s[5 * 33]); o.w = pk2(s[6 * 33], s[7 * 33]);
        *(v4u*)(dst + (size_t)n * 2048 + k0 + 8 * c) = o; }
    LDS_WAIT(); asm volatile("" ::: "memory");
}

__device__ __forceinline__ void phase0(const Ctx& C) {
    unsigned char* ws = C.ws;
    {
        const f32x4* x4 = (const f32x4*)C.in[0]; v4u* xb = (v4u*)(ws + (size_t)XB_T0 * MiB);
        const size_t n8 = (size_t)T * D / 8;
        for (size_t i = (size_t)blockIdx.x * NTHREADS + C.tid; i < n8; i += (size_t)C.G * NTHREADS) {
            const f32x4 a = x4[2 * i], b = x4[2 * i + 1]; v4u o; o.x = pk2(a.x, a.y); o.y = pk2(a.z, a.w); o.z = pk2(b.x, b.y); o.w = pk2(b.z, b.w); xb[i] = o; }
    }
    {
        LAS float* scr = (LAS float*)(C.lds + C.wave * 8448);
        constexpr int I_IN = 32 * 225, I_OUT = 32 * 64, I_GU = NE * 32 * 128, I_DN = NE * 32 * 64, NITEMS = I_IN + I_OUT + I_GU + I_DN;
        bf16* win_t = (bf16*)(ws + (size_t)WIN_T0 * MiB); bf16* wout_t = (bf16*)(ws + (size_t)WOUT_T0 * MiB);
        bf16* wgu_t = (bf16*)(ws + (size_t)WGU_T0 * MiB); bf16* wdn_t = (bf16*)(ws + (size_t)WDN_T0 * MiB);
        for (int it = C.gw; it < NITEMS; it += C.NGW) {
            int r = it;
            if (r < I_IN) { const int kb = r / 225, nb = r % 225; transpose_item(C.in[1], DIN, 64 * kb, 32 * nb, win_t + (size_t)(32 * nb) * 2048, scr, C.lane); continue; } r -= I_IN;
            if (r < I_OUT) { const int kb = r / 64, nb = r % 64; transpose_item(C.in[16], D, 64 * kb, 32 * nb, wout_t + (size_t)(32 * nb) * 2048, scr, C.lane); continue; } r -= I_OUT;
            if (r < I_GU) { const int e = r / 4096, rr = r % 4096, kb = rr / 128, nb = rr % 128, n0 = 32 * nb;
                const int drow = (n0 < 2048) ? ((n0 >> 7) * 256 + (n0 & 127)) : ((((n0 - 2048) >> 7) * 256) + 128 + ((n0 - 2048) & 127));
                transpose_item(C.in[22] + (size_t)e * 2048 * 4096, 4096, 64 * kb, n0, wgu_t + ((size_t)e * 4096 + drow) * 2048, scr, C.lane); continue; } r -= I_GU;
            { const int e = r / 2048, rr = r % 2048, kb = rr / 64, nb = rr % 64;
                transpose_item(C.in[24] + (size_t)e * 2048 * 2048, 2048, 64 * kb, 32 * nb, wdn_t + ((size_t)e * 2048 + 32 * nb) * 2048, scr, C.lane); }
        }
    }
    __syncthreads();
    {
        const float* w1 = C.in[5]; const float* b1 = C.in[6]; const float* w2 = C.in[7]; const float* b2 = C.in[8]; const float* freq = C.in[10];
        LAS float* h1s = (LAS float*)C.lds;
        const int tt = C.tid >> 6, j = C.tid & 63;
        for (int tb = blockIdx.x; tb < SEQ / 8; tb += C.G) {
            const int t = tb * 8 + tt;
            const float zt = (float)t / 2047.0f, wt = 6.283185307179586f * (float)t / 2048.0f;
            float acc = b1[j] + zt * w1[j];
            for (int i = 0; i < 16; ++i) { const float fb = 1e-4f + (float)i * ((15.0f - 1e-4f) / 15.0f); const float arg = fb * wt;
                acc += cosf(arg) * w1[(1 + i) * 64 + j] - sinf(arg) * w1[(17 + i) * 64 + j]; }
            h1s[tt * 64 + j] = sinf(freq[j] * acc);
            __syncthreads();
            float a2 = b2[j];
            for (int i = 0; i < 64; ++i) a2 += h1s[tt * 64 + i] * w2[i * 64 + j];
            { const float hv = sinf(freq[64 + j] * a2); const unsigned hi = f2bf(hv); const float lo = hv - bflo(hi);
              bf16* hp = (bf16*)(ws + WS_H2P) + (size_t)t * 256; hp[j] = (bf16)hi; hp[64 + j] = (bf16)hi; hp[128 + j] = (bf16)f2bf(lo); hp[192 + j] = 0; }
            __syncthreads();
        }
        const float* w3 = C.in[9]; bf16* wp = (bf16*)(ws + WS_W3P);
        for (int i = blockIdx.x * NTHREADS + C.tid; i < 4096 * 8; i += C.G * NTHREADS) {
            const int col = i & 4095, jo = i >> 12; float wv[8]; unsigned hi[8], lo[8];
#pragma unroll
            for (int k = 0; k < 8; ++k) { wv[k] = w3[(size_t)(jo * 8 + k) * 4096 + col]; hi[k] = f2bf(wv[k]); lo[k] = f2bf(wv[k] - bflo(hi[k])); }
            v4u vh, vl; vh.x = hi[0] | (hi[1] << 16); vh.y = hi[2] | (hi[3] << 16); vh.z = hi[4] | (hi[5] << 16); vh.w = hi[6] | (hi[7] << 16);
            vl.x = lo[0] | (lo[1] << 16); vl.y = lo[2] | (lo[3] << 16); vl.z = lo[4] | (lo[5] << 16); vl.w = lo[6] | (lo[7] << 16);
            bf16* row = wp + (size_t)col * 256 + jo * 8;
            *(v4u*)row = vh; *(v4u*)(row + 64) = vl; *(v4u*)(row + 128) = vh; *(v4u*)(row + 192) = (v4u){0u, 0u, 0u, 0u};
        }
    }
}

#ifndef NAIVE_ML
#define NAIVE_ML 0
#endif
constexpr int N1_SW_TILES = 16, N1_SW = N1_SW_TILES * 32;
constexpr int N1_NORM_TILES = NAIVE_ML ? 17 : 13, N1_NORM = N1_NORM_TILES * 32, N1_UNITS = N1_SW + N1_NORM;
struct Gemm1Order {
    int G, c;
    __device__ __forceinline__ bool next(int i, pg8::Unit& u) const {
        const int L = i * G + c; if (L >= N1_UNITS) return false;
        int w; { const int q = N1_UNITS / 8, r = N1_UNITS % 8, xcd = L % 8, off = L / 8; w = (xcd < r ? xcd * (q + 1) : r * (q + 1) + (xcd - r) * q) + off; }
        if (w < N1_SW) { const int nig = 8 * 32, gid = w / nig, wi = w % nig, mi = gid * 8 + (wi % 8), ni = wi / 8;
            u.pm = WIN_T0 + (mi < 12 ? mi : 8 + mi); u.pn = XB_T0 + ni; }
        else { w -= N1_SW; const int nig = 8 * N1_NORM_TILES, gid = w / nig, wi = w % nig, mi = gid * 8 + (wi % 8), ni = wi / 8;
            int wt;
            if (NAIVE_ML) wt = (ni < 16) ? 12 + ni : 28; else wt = (ni < 8) ? 12 + ni : 16 + ni;
            u.pm = XB_T0 + mi; u.pn = WIN_T0 + wt; }
        return true;
    }
    __device__ __forceinline__ void a_ready(const pg8::Unit&) const {}
    __device__ __forceinline__ void done(const pg8::Unit&) const {}
};
struct Epi1 {
    static constexpr bool PERM = true, AFTER_DRAIN = false;
    const float* b_in; bf16* hyt; bf16* qkraw; bf16* vb; bf16* ob; float* gates;
    __device__ __forceinline__ void operator()(const pg8::f32x4 (&acc)[2][2][4][2], const pg8::Unit& u, int wr, int wc, int fr, int fq) const {
        using pg8::cvt_pk_bf16;
        if (u.pm >= WIN_T0) {
            const int wt = u.pm - WIN_T0, tt = u.pn - XB_T0;
            const int col0 = tt * 256 + wc * 32 + 8 * fq;
#pragma unroll
            for (int ai = 0; ai < 2; ++ai)
#pragma unroll
                for (int m = 0; m < 4; ++m) {
                    const int ch = wt * 256 + ai * 128 + wr * 64 + m * 16 + fr; const float bv = b_in[ch];
                    const int drow = ch < 3072 ? ch : ch - 2048;
                    bf16* rowp = hyt + (size_t)drow * T + col0;
#pragma unroll
                    for (int bj = 0; bj < 2; ++bj) { const pg8::f32x4 v0 = acc[ai][bj][m][0] + bv, v1 = acc[ai][bj][m][1] + bv;
                        v4u w; w.x = cvt_pk_bf16(v0[0], v0[1]); w.y = cvt_pk_bf16(v0[2], v0[3]); w.z = cvt_pk_bf16(v1[0], v1[1]); w.w = cvt_pk_bf16(v1[2], v1[3]);
                        *(v4u*)(rowp + bj * 128) = w; }
                }
        } else {
            const int tt = u.pm - XB_T0, wt = u.pn - WIN_T0;
            const int chb = wt * 256 + wc * 32 + 8 * fq;
            pg8::f32x4 bv[2][2];
#pragma unroll
            for (int bj = 0; bj < 2; ++bj)
#pragma unroll
                for (int n = 0; n < 2; ++n) { const int c0 = chb + bj * 128 + 4 * n; bv[bj][n] = (c0 < DIN) ? *(const pg8::f32x4*)(b_in + c0) : (pg8::f32x4){0.f, 0.f, 0.f, 0.f}; }
            if (wt == 28) {
                if (wc == 0) {
#pragma unroll
                    for (int ai = 0; ai < 2; ++ai)
#pragma unroll
                        for (int m = 0; m < 4; ++m) { const int tok = tt * 256 + ai * 128 + wr * 64 + m * 16 + fr;
                            float* gp = gates + (size_t)tok * 32 + 8 * fq;
                            *(pg8::f32x4*)(gp) = acc[ai][0][m][0] + bv[0][0]; *(pg8::f32x4*)(gp + 4) = acc[ai][0][m][1] + bv[0][1]; }
                }
            } else {
#define EPI1_STORE(base, ld, cb) do { _Pragma("unroll") for (int ai = 0; ai < 2; ++ai) _Pragma("unroll") for (int m = 0; m < 4; ++m) { const int tok = tt * 256 + ai * 128 + wr * 64 + m * 16 + fr; \
                    bf16* rowp = (base) + (size_t)tok * (ld) + (cb); \
                    _Pragma("unroll") for (int bj = 0; bj < 2; ++bj) { const pg8::f32x4 v0 = acc[ai][bj][m][0] + bv[bj][0], v1 = acc[ai][bj][m][1] + bv[bj][1]; \
                        v4u w; w.x = cvt_pk_bf16(v0[0], v0[1]); w.y = cvt_pk_bf16(v0[2], v0[3]); w.z = cvt_pk_bf16(v1[0], v1[1]); w.w = cvt_pk_bf16(v1[2], v1[3]); \
                        *(v4u*)(rowp + bj * 128) = w; } } } while (0)
                if (wt < 20) EPI1_STORE(qkraw, 2048, chb - 3072);
                else if (wt < 24) EPI1_STORE(vb, 1024, chb - 5120);
                else EPI1_STORE(ob, 1024, chb - 6144);
#undef EPI1_STORE
            }
        }
    }
};

struct KtOrder {
    int G, c;
    __device__ __forceinline__ bool next(int i, pg8::Unit& u) const { const int cc = G - 1 - c; if (i != 0 || cc >= 128) return false; u.pm = cc >> 3; u.pn = cc & 7; return true; }
    __device__ __forceinline__ void a_ready(const pg8::Unit&) const {}
    __device__ __forceinline__ void done(const pg8::Unit&) const {}
};
struct EpiKT {
    static constexpr bool PERM = true, AFTER_DRAIN = false;
    float* kt;
    __device__ __forceinline__ void operator()(const pg8::f32x4 (&acc)[2][2][4][2], const pg8::Unit& u, int wr, int wc, int fr, int fq) const {
        const float da = -3.0701134573253945f, db = -15.350567286626973f;
#pragma unroll
        for (int ai = 0; ai < 2; ++ai)
#pragma unroll
            for (int m = 0; m < 4; ++m) {
                const int col = u.pm * 256 + ai * 128 + wr * 64 + m * 16 + fr, o = col >> 11, dir = (col >> 10) & 1, c = col & 1023;
                const float delta = fabsf(da + (float)c * ((db - da) / 1023.0f)) * (1.0f / 2047.0f);
                float* kr = kt + ((size_t)o * 1024 + c) * 4096;
#pragma unroll
                for (int bj = 0; bj < 2; ++bj) {
                    const int t0 = u.pn * 256 + bj * 128 + wc * 32 + 8 * fq; float v[8];
#pragma unroll
                    for (int n = 0; n < 2; ++n)
#pragma unroll
                        for (int e = 0; e < 4; ++e) v[4 * n + e] = acc[ai][bj][m][n][e] * expf(-(float)(t0 + 4 * n + e) * delta);
                    if (dir == 0) { *(pg8::f32x4*)(kr + t0) = (pg8::f32x4){v[0], v[1], v[2], v[3]}; *(pg8::f32x4*)(kr + t0 + 4) = (pg8::f32x4){v[4], v[5], v[6], v[7]}; }
                    else {
#pragma unroll
                        for (int e = 0; e < 8; ++e) if (t0 + e >= 1) kr[4096 - t0 - e] = v[e]; }
                }
            }
    }
};

template <int OP> __device__ __forceinline__ LAS float* block_scan_2048(LAS float* x, LAS float* y, int tid) {
    LAS float* src = x; LAS float* dst = y;
    for (int off = 1; off < 2048; off <<= 1) {
#pragma unroll
        for (int i = 0; i < 4; ++i) { const int idx = tid + 512 * i; float v = src[idx]; if (idx >= off) { const float w = src[idx - off]; v = OP ? fmaxf(v, w) : v + w; } dst[idx] = v; }
        __syncthreads();
        LAS float* t = src; src = dst; dst = t;
    }
    return src;
}
__device__ __forceinline__ float logsigmoidf(float x) { return fminf(x, 0.f) - log1pf(expf(-fabsf(x))); }

__device__ __forceinline__ void phase2(const Ctx& C) {
    unsigned char* ws = C.ws;
    {
        const float* KT = (const float*)(ws + WS_KT); f32x4* KF = (f32x4*)(ws + WS_KF);
        const int half = C.tid >> 8, g = C.tid & 255;
        LAS float* re = (LAS float*)(C.lds + half * (2 * FFT_WORDS * 4)); LAS float* im = re + FFT_WORDS;
        LAS float* red = (LAS float*)(C.lds + 4 * FFT_WORDS * 4);
        for (int u = blockIdx.x; u < 1024; u += C.G) {
            const int o = u >> 9, c0 = (u & 511) * 2, c = c0 + half;
            __syncthreads();
            const float* kcol = KT + ((size_t)o * 1024 + c) * 4096;
            float xr[16], xi[16]; float asum = 0.f;
#pragma unroll
            for (int m = 0; m < 16; ++m) { const int idx = g + 256 * m; const float val = (idx == 2048) ? 0.f : kcol[idx]; xr[m] = val; xi[m] = 0.f; asum += fabsf(val); }
            asum = wave_sum(asum);
            if (C.lane == 0) red[C.wave] = asum;
            __syncthreads();
            const float tot = red[half * 4] + red[half * 4 + 1] + red[half * 4 + 2] + red[half * 4 + 3];
            const float scl = 1.0f / (tot * 4096.0f);
#pragma unroll
            for (int m = 0; m < 16; ++m) xr[m] *= scl;
            dft16<false>(xr, xi); twiddle16<false>(xr, xi, g, 4096); fft_store_s256(re, im, g, xr, xi);
            __syncthreads();
            fft_load_s16(re, im, g, xr, xi); dft16<false>(xr, xi); twiddle16<false>(xr, xi, g & 15, 256); fft_store_s16(re, im, g, xr, xi);
            __syncthreads();
            fft_load_s1(re, im, g, xr, xi); dft16<false>(xr, xi);
            f32x4* dst = KF + ((size_t)(o * 1024 + c) * 4096 + g * 16) / 2;
#pragma unroll
            for (int k = 0; k < 8; ++k) dst[k] = (f32x4){xr[2 * k], xi[2 * k], xr[2 * k + 1], xi[2 * k + 1]};
        }
        __syncthreads();
    }
    {
        const bf16* raw = (const bf16*)(ws + WS_QKRAW); bf16* qkc = (bf16*)(ws + WS_QKC); const float* cw = C.in[13]; const float* cb = C.in[14];
        for (int g = blockIdx.x * NTHREADS + C.tid; g < T * 256; g += C.G * NTHREADS) {
            const int tok = g >> 8, ch0 = (g & 255) * 8, tl = tok & (SEQ - 1);
            const v4u cur = *(const v4u*)(raw + (size_t)tok * 2048 + ch0);
            v4u prv = (v4u){0u, 0u, 0u, 0u}, nxt = (v4u){0u, 0u, 0u, 0u};
            if (tl > 0) prv = *(const v4u*)(raw + (size_t)(tok - 1) * 2048 + ch0);
            if (tl < SEQ - 1) nxt = *(const v4u*)(raw + (size_t)(tok + 1) * 2048 + ch0);
            const float sc = ch0 >= 1024 ? 0.08838834764831845f : 1.0f;
            float o[8];
#pragma unroll
            for (int i = 0; i < 8; ++i) {
                const unsigned pw = prv[i >> 1], cwd = cur[i >> 1], nw = nxt[i >> 1];
                const float p = (i & 1) ? bfhi(pw) : bflo(pw), q = (i & 1) ? bfhi(cwd) : bflo(cwd), n = (i & 1) ? bfhi(nw) : bflo(nw);
                const int ch = ch0 + i;
                const float v = cw[ch] * p + cw[2048 + ch] * q + cw[4096 + ch] * n + cb[ch];
                o[i] = sc * v / (1.0f + expf(-v));
            }
            v4u w; w.x = pk2(o[0], o[1]); w.y = pk2(o[2], o[3]); w.z = pk2(o[4], o[5]); w.w = pk2(o[6], o[7]);
            *(v4u*)(qkc + (size_t)tok * 2048 + ch0) = w;
        }
    }
    {
        const float* gates = (const float*)(ws + WS_GATES); float* GA = (float*)(ws + WS_GA); float* GP = (float*)(ws + WS_GP); float* GE = (float*)(ws + WS_GE);
        LAS float* s0 = (LAS float*)(C.lds + 8192); LAS float* s1 = s0 + 2048; LAS float* s2 = s1 + 2048; LAS float* s3 = s2 + 2048;
        for (int bhd = blockIdx.x; bhd < 64; bhd += C.G) {
            const int b = bhd >> 4, h = (bhd >> 1) & 7, dir = bhd & 1, col_i = dir * 16 + h, col_f = col_i + 8;
            float ig[4], lf[4];
            __syncthreads();
#pragma unroll
            for (int i = 0; i < 4; ++i) { const int t = C.tid + 512 * i; const float* gr = gates + (size_t)(b * SEQ + t) * 32; ig[i] = gr[col_i]; lf[i] = logsigmoidf(gr[col_f]); s0[t] = lf[i]; }
            __syncthreads();
            LAS float* Fc = block_scan_2048<0>(s0, s1, C.tid);
            float a[4], Fv[4], Gx[4];
#pragma unroll
            for (int i = 0; i < 4; ++i) { const int t = C.tid + 512 * i; Fv[i] = Fc[t]; Gx[i] = Fv[i] - lf[i]; a[i] = dir ? ig[i] + Gx[i] : ig[i] - Fv[i]; s2[dir ? 2047 - t : t] = a[i]; }
            __syncthreads();
            LAS float* Pm = block_scan_2048<1>(s2, s3, C.tid);
#pragma unroll
            for (int i = 0; i < 4; ++i) { const int t = C.tid + 512 * i; const float pm = Pm[dir ? 2047 - t : t];
                const float mt = dir ? pm - Gx[i] : Fv[i] + pm;
                GA[bhd * 2048 + t] = a[i]; GP[bhd * 2048 + t] = pm; GE[bhd * 2048 + t] = expf(-mt); }
        }
        __syncthreads();
    }
}

__device__ __forceinline__ void hyena_naive(const Ctx& C) {
    unsigned char* ws = C.ws;
    const bf16* hyt = (const bf16*)(ws + WS_HYT); const float* KT = (const float*)(ws + WS_KT); float* Z = (float*)(ws + WS_Z);
    const float* cw = C.in[3]; const float* cb = C.in[4]; const float* skip = C.in[11];
    LAS float* sv = (LAS float*)C.lds; LAS float* sk = sv + 2048;
    for (int u = blockIdx.x; u < NB * DHY; u += C.G) {
        const int b = u >> 10, c = u & 1023;
        float v[4], x1[4], x2[4];
#pragma unroll
        for (int part = 0; part < 3; ++part) {
            const int ch = part * 1024 + c; const bf16* row = hyt + (size_t)ch * T + b * SEQ;
            const float w0 = cw[ch], w1 = cw[3072 + ch], w2 = cw[6144 + ch], bb = cb[ch];
#pragma unroll
            for (int i = 0; i < 4; ++i) { const int t = C.tid + 512 * i;
                const float p = t > 0 ? bf2f(row[t - 1]) : 0.f, q = bf2f(row[t]), n = t < SEQ - 1 ? bf2f(row[t + 1]) : 0.f;
                const float r = w0 * p + w1 * q + w2 * n + bb;
                if (part == 0) v[i] = r; else if (part == 1) x1[i] = r; else x2[i] = r; }
        }
        __syncthreads();
#pragma unroll
        for (int i = 0; i < 4; ++i) sv[C.tid + 512 * i] = v[i];
#pragma unroll
        for (int i = 0; i < 8; ++i) sk[C.tid + 512 * i] = KT[(size_t)c * 4096 + C.tid + 512 * i];
        __syncthreads();
        float acc[4] = {0.f, 0.f, 0.f, 0.f};
        for (int s = 0; s < SEQ; ++s) { const float vv = sv[s];
#pragma unroll
            for (int i = 0; i < 4; ++i) acc[i] += sk[(C.tid + 512 * i - s) & 4095] * vv; }
        float z1[4]; const float sk0 = skip[c], sk1 = skip[1024 + c];
#pragma unroll
        for (int i = 0; i < 4; ++i) z1[i] = x1[i] * (acc[i] + sk0 * v[i]);
        __syncthreads();
#pragma unroll
        for (int i = 0; i < 4; ++i) sv[C.tid + 512 * i] = z1[i];
#pragma unroll
        for (int i = 0; i < 8; ++i) sk[C.tid + 512 * i] = KT[(size_t)(1024 + c) * 4096 + C.tid + 512 * i];
        __syncthreads();
#pragma unroll
        for (int i = 0; i < 4; ++i) acc[i] = 0.f;
        for (int s = 0; s < SEQ; ++s) { const float vv = sv[s];
#pragma unroll
            for (int i = 0; i < 4; ++i) acc[i] += sk[(C.tid + 512 * i - s) & 4095] * vv; }
#pragma unroll
        for (int i = 0; i < 4; ++i) Z[(size_t)(b * SEQ + C.tid + 512 * i) * 1024 + c] = x2[i] * (acc[i] + sk1 * z1[i]);
    }
    __syncthreads();
}

__device__ __forceinline__ void hyena_conv_once(LAS float* re, LAS float* im, int g, float (&xr)[16], float (&xi)[16], const f32x4* __restrict__ kf) {
    __syncthreads();
    dft16<false>(xr, xi); twiddle16<false>(xr, xi, g, 4096); fft_store_s256(re, im, g, xr, xi);
    __syncthreads();
    fft_load_s16(re, im, g, xr, xi); dft16<false>(xr, xi); twiddle16<false>(xr, xi, g & 15, 256); fft_store_s16(re, im, g, xr, xi);
    __syncthreads();
    fft_load_s1(re, im, g, xr, xi); dft16<false>(xr, xi);
#pragma unroll
    for (int k = 0; k < 8; ++k) { const f32x4 w = kf[g * 8 + k];
        const float r0 = xr[2 * k] * w.x - xi[2 * k] * w.y, i0 = xr[2 * k] * w.y + xi[2 * k] * w.x;
        const float r1 = xr[2 * k + 1] * w.z - xi[2 * k + 1] * w.w, i1 = xr[2 * k + 1] * w.w + xi[2 * k + 1] * w.z;
        xr[2 * k] = r0; xi[2 * k] = i0; xr[2 * k + 1] = r1; xi[2 * k + 1] = i1; }
    dft16<true>(xr, xi); fft_store_s1(re, im, g, xr, xi);
    __syncthreads();
    fft_load_s16(re, im, g, xr, xi); twiddle16<true>(xr, xi, g & 15, 256); dft16<true>(xr, xi); fft_store_s16(re, im, g, xr, xi);
    __syncthreads();
    fft_load_s256(re, im, g, xr, xi); twiddle16<true>(xr, xi, g, 4096); dft16<true>(xr, xi);
}
__device__ __forceinline__ void hyena_fft(const Ctx& C) {
    unsigned char* ws = C.ws;
    const bf16* hyt = (const bf16*)(ws + WS_HYT); const f32x4* KF = (const f32x4*)(ws + WS_KF); float* ZT = (float*)(ws + WS_ZT);
    const float* cw = C.in[3]; const float* cb = C.in[4]; const float* skip = C.in[11];
    const int half = C.tid >> 8, g = C.tid & 255;
    LAS float* re = (LAS float*)(C.lds + half * (2 * FFT_WORDS * 4)); LAS float* im = re + FFT_WORDS;
    for (int c = blockIdx.x; c < DHY; c += C.G) {
        float vr[8], vi[8], ar[8], ai[8], br[8], bi[8];
#pragma unroll
        for (int part = 0; part < 3; ++part) {
            const int ch = part * 1024 + c; const float w0 = cw[ch], w1 = cw[3072 + ch], w2 = cw[6144 + ch], bb = cb[ch];
#pragma unroll
            for (int bq = 0; bq < 2; ++bq) { const bf16* row = hyt + (size_t)ch * T + (2 * half + bq) * SEQ;
#pragma unroll
                for (int m = 0; m < 8; ++m) { const int t = g + 256 * m;
                    const float p = t > 0 ? bf2f(row[t - 1]) : 0.f, q = bf2f(row[t]), n = t < SEQ - 1 ? bf2f(row[t + 1]) : 0.f;
                    const float r = w0 * p + w1 * q + w2 * n + bb;
                    if (part == 0) { if (bq == 0) vr[m] = r; else vi[m] = r; } else if (part == 1) { if (bq == 0) ar[m] = r; else ai[m] = r; } else { if (bq == 0) br[m] = r; else bi[m] = r; } }
                asm volatile("" ::: "memory"); }
        }
        const float sk0 = skip[c], sk1 = skip[1024 + c];
        float xr[16], xi[16];
#pragma unroll
        for (int m = 0; m < 8; ++m) { xr[m] = vr[m]; xi[m] = vi[m]; xr[m + 8] = 0.f; xi[m + 8] = 0.f; }
        hyena_conv_once(re, im, g, xr, xi, KF + (size_t)c * 2048);
#pragma unroll
        for (int m = 0; m < 8; ++m) { vr[m] = ar[m] * (xr[m] + sk0 * vr[m]); vi[m] = ai[m] * (xi[m] + sk0 * vi[m]); xr[m] = vr[m]; xi[m] = vi[m]; xr[m + 8] = 0.f; xi[m + 8] = 0.f; }
        hyena_conv_once(re, im, g, xr, xi, KF + (size_t)(1024 + c) * 2048);
        float* zr = ZT + (size_t)c * T + (2 * half) * SEQ;
#pragma unroll
        for (int m = 0; m < 8; ++m) { const int t = g + 256 * m; zr[t] = br[m] * (xr[m] + sk1 * vr[m]); zr[SEQ + t] = bi[m] * (xi[m] + sk1 * vi[m]); }
    }
    __syncthreads();
}

__device__ __forceinline__ void mlstm_naive(const Ctx& C) {
    unsigned char* ws = C.ws;
    const bf16* qkc = (const bf16*)(ws + WS_QKC); const bf16* vb = (const bf16*)(ws + WS_VB);
    const float* GA = (const float*)(ws + WS_GA); const float* GP = (const float*)(ws + WS_GP); const float* GE = (const float*)(ws + WS_GE);
    float* HML = (float*)(ws + WS_HML);
    LAS float* qs = (LAS float*)(C.lds + C.wave * 1024); LAS float* ps = qs + 128;
    const int lane = C.lane;
    for (int u = blockIdx.x; u < 64 * 32; u += C.G) {
        const int bhd = u >> 5, qb = u & 31, b = bhd >> 4, h = (bhd >> 1) & 7, dir = bhd & 1;
        for (int qi = 0; qi < 8; ++qi) {
            const int t = qb * 64 + C.wave * 8 + qi;
            { const unsigned w = *(const unsigned*)(qkc + (size_t)(b * SEQ + t) * 2048 + h * 128 + 2 * lane); qs[2 * lane] = bflo(w); qs[2 * lane + 1] = bfhi(w); }
            __builtin_amdgcn_wave_barrier(); LDS_WAIT();
            const float pmt = GP[bhd * 2048 + t];
            const int c_lo = dir ? (t >> 6) : 0, c_hi = dir ? 31 : (t >> 6);
            float acc0 = 0.f, acc1 = 0.f, den = 0.f;
            for (int cch = c_lo; cch <= c_hi; ++cch) {
                const int s = cch * 64 + lane; const bool valid = dir ? (s >= t) : (s <= t);
                const v4u* kr = (const v4u*)(qkc + (size_t)(b * SEQ + s) * 2048 + 1024 + h * 128);
                float sc = 0.f;
#pragma unroll
                for (int j = 0; j < 16; ++j) { const v4u kk = kr[j];
#pragma unroll
                    for (int e = 0; e < 4; ++e) sc += qs[8 * j + 2 * e] * bflo(kk[e]) + qs[8 * j + 2 * e + 1] * bfhi(kk[e]); }
                const float p = valid ? sc * expf(GA[bhd * 2048 + s] - pmt) : 0.f;
                den += p;
                __builtin_amdgcn_wave_barrier();
                ps[lane] = p;
                __builtin_amdgcn_wave_barrier(); LDS_WAIT();
                const bf16* vr = vb + (size_t)(b * SEQ + cch * 64) * 1024 + h * 128 + 2 * lane;
#pragma unroll 8
                for (int s2 = 0; s2 < 64; ++s2) { const unsigned w = *(const unsigned*)(vr + (size_t)s2 * 1024); const float pv = ps[s2]; acc0 += pv * bflo(w); acc1 += pv * bfhi(w); }
                __builtin_amdgcn_wave_barrier();
            }
            den = wave_sum(den);
            const float scl = 1.0f / fmaxf(fabsf(den), GE[bhd * 2048 + t]);
            *(f32x2*)(HML + ((size_t)dir * T + b * SEQ + t) * 1024 + h * 128 + 2 * lane) = (f32x2){acc0 * scl, acc1 * scl};
            __builtin_amdgcn_wave_barrier();
        }
    }
    __syncthreads();
}

typedef short ml_bf16x8 __attribute__((ext_vector_type(8)));
typedef short ml_s16x4 __attribute__((ext_vector_type(4)));
typedef float ml_f32x16 __attribute__((ext_vector_type(16)));
typedef __bf16 ml_bf2 __attribute__((ext_vector_type(2)));
constexpr int ML_KROW = 272, ML_VROW = 136, ML_KBUF = 64 * ML_KROW, ML_VBUF = 128 * ML_VROW;
__device__ __forceinline__ unsigned ml_pk(float lo, float hi) { const f32x2 v = {lo, hi}; return __builtin_bit_cast(unsigned, __builtin_convertvector(v, ml_bf2)); }
__device__ __forceinline__ void mlstm_mfma(const Ctx& C) {
    unsigned char* ws = C.ws;
    const bf16* qkc = (const bf16*)(ws + WS_QKC); const bf16* vt = (const bf16*)(ws + WS_HYT) + (size_t)3072 * T;
    const float* GA = (const float*)(ws + WS_GA); const float* GP = (const float*)(ws + WS_GP); const float* GE = (const float*)(ws + WS_GE);
    float* HML = (float*)(ws + WS_HML);
    LAS unsigned char* KB = C.lds; LAS unsigned char* VB = C.lds + 2 * ML_KBUF; LAS float* AS = (LAS float*)(C.lds + 2 * ML_KBUF + 2 * ML_VBUF);
    const int w = C.wave, lane = C.lane, r = lane & 31, hh = lane >> 5, tid = C.tid;
    for (int pu = blockIdx.x; pu < 256; pu += C.G) {
        const int bhd = pu >> 2, pq = pu & 3, b = bhd >> 4, h = (bhd >> 1) & 7, dir = bhd & 1;
        __syncthreads();
        for (int i = tid; i < SEQ; i += NTHREADS) AS[i] = GA[bhd * SEQ + i];
        const bf16* kbase = qkc + (size_t)(b * SEQ) * 2048 + 1024 + h * 128;
        const bf16* vbase = vt + (size_t)(h * 128) * T + b * SEQ;
#pragma unroll 1
        for (int hf = 0; hf < 2; ++hf) {
            const int qb = hf ? 7 - pq : pq;
            const int qlo = 256 * qb + 32 * w, tq = qlo + r;
            ml_bf16x8 qf[8];
            { const bf16* qrow = qkc + (size_t)(b * SEQ + tq) * 2048 + h * 128 + 8 * hh;
#pragma unroll
              for (int s = 0; s < 8; ++s) qf[s] = *(const ml_bf16x8*)(qrow + 16 * s); }
            const float pmt = GP[bhd * SEQ + tq];
            ml_f32x16 O[4];
#pragma unroll
            for (int d = 0; d < 4; ++d)
#pragma unroll
                for (int i = 0; i < 16; ++i) O[d][i] = 0.f;
            float den = 0.f;
            const int kt0 = dir ? 4 * qb : 0, kt1 = dir ? 31 : 4 * qb + 3;
            v4u kr0, kr1, vr0, vr1;
#define ML_LOAD(kt) do { const int p0 = tid, p1 = tid + 512; \
                kr0 = *(const v4u*)(kbase + (size_t)(64 * (kt) + (p0 >> 4)) * 2048 + (p0 & 15) * 8); kr1 = *(const v4u*)(kbase + (size_t)(64 * (kt) + (p1 >> 4)) * 2048 + (p1 & 15) * 8); \
                vr0 = *(const v4u*)(vbase + (size_t)(p0 >> 3) * T + 64 * (kt) + (p0 & 7) * 8); vr1 = *(const v4u*)(vbase + (size_t)(p1 >> 3) * T + 64 * (kt) + (p1 & 7) * 8); } while (0)
#define ML_STORE(buf) do { const int p0 = tid, p1 = tid + 512; \
                *(LAS v4u*)(KB + (buf) * ML_KBUF + (p0 >> 4) * ML_KROW + (p0 & 15) * 16) = kr0; *(LAS v4u*)(KB + (buf) * ML_KBUF + (p1 >> 4) * ML_KROW + (p1 & 15) * 16) = kr1; \
                { LAS unsigned char* d0 = VB + (buf) * ML_VBUF + (p0 >> 3) * ML_VROW + (p0 & 7) * 16; *(LAS v2u*)d0 = (v2u){vr0.x, vr0.y}; *(LAS v2u*)(d0 + 8) = (v2u){vr0.z, vr0.w}; } \
                { LAS unsigned char* d1 = VB + (buf) * ML_VBUF + (p1 >> 3) * ML_VROW + (p1 & 7) * 16; *(LAS v2u*)d1 = (v2u){vr1.x, vr1.y}; *(LAS v2u*)(d1 + 8) = (v2u){vr1.z, vr1.w}; } } while (0)
            ML_LOAD(kt0);
            __syncthreads();
            ML_STORE(0);
            __syncthreads();
#pragma unroll 1
            for (int kt = kt0; kt <= kt1; ++kt) {
                const int cur = (kt - kt0) & 1;
                if (kt < kt1) ML_LOAD(kt + 1);
                const int klo = 64 * kt, khi = klo + 63, qhi = qlo + 31;
                const bool none = dir ? (khi < qlo) : (klo > qhi);
                const bool all = dir ? (klo >= qhi) : (khi <= qlo);
                if (!none) {
                    const LAS unsigned char* Kb = KB + cur * ML_KBUF; const LAS unsigned char* Vb = VB + cur * ML_VBUF;
                    ml_f32x16 S0, S1;
#pragma unroll
                    for (int i = 0; i < 16; ++i) { S0[i] = 0.f; S1[i] = 0.f; }
#pragma unroll
                    for (int s = 0; s < 8; ++s) {
                        const ml_bf16x8 k0 = *(const LAS ml_bf16x8*)(Kb + r * ML_KROW + (16 * s + 8 * hh) * 2);
                        const ml_bf16x8 k1 = *(const LAS ml_bf16x8*)(Kb + (32 + r) * ML_KROW + (16 * s + 8 * hh) * 2);
                        S0 = __builtin_amdgcn_mfma_f32_32x32x16_bf16(k0, qf[s], S0, 0, 0, 0);
                        S1 = __builtin_amdgcn_mfma_f32_32x32x16_bf16(k1, qf[s], S1, 0, 0, 0);
                    }
#pragma unroll
                    for (int kb = 0; kb < 2; ++kb)
#pragma unroll
                        for (int g4 = 0; g4 < 4; ++g4) {
                            const f32x4 a4 = *(const LAS f32x4*)(AS + klo + 32 * kb + 8 * g4 + 4 * hh);
#pragma unroll
                            for (int e = 0; e < 4; ++e) {
                                const int i = 4 * g4 + e; const int sg = klo + 32 * kb + 8 * g4 + 4 * hh + e;
                                const float sv = kb ? S1[i] : S0[i];
                                float p = sv * __expf(a4[e] - pmt);
                                if (!all) { const bool valid = dir ? (sg >= tq) : (sg <= tq); p = valid ? p : 0.f; }
                                den += p;
                                if (kb) S1[i] = p; else S0[i] = p;
                            }
                        }
#pragma unroll
                    for (int kb = 0; kb < 2; ++kb)
#pragma unroll
                        for (int s = 0; s < 2; ++s) {
                            v4u pw;
                            if (kb == 0) { pw.x = ml_pk(S0[8 * s], S0[8 * s + 1]); pw.y = ml_pk(S0[8 * s + 2], S0[8 * s + 3]); pw.z = ml_pk(S0[8 * s + 4], S0[8 * s + 5]); pw.w = ml_pk(S0[8 * s + 6], S0[8 * s + 7]); }
                            else { pw.x = ml_pk(S1[8 * s], S1[8 * s + 1]); pw.y = ml_pk(S1[8 * s + 2], S1[8 * s + 3]); pw.z = ml_pk(S1[8 * s + 4], S1[8 * s + 5]); pw.w = ml_pk(S1[8 * s + 6], S1[8 * s + 7]); }
                            const ml_bf16x8 pf = __builtin_bit_cast(ml_bf16x8, pw);
#pragma unroll
                            for (int db = 0; db < 4; ++db) {
                                const LAS unsigned char* vp = Vb + (32 * db + r) * ML_VROW + 2 * (32 * kb + 16 * s + 4 * hh);
                                const ml_s16x4 lo = *(const LAS ml_s16x4*)vp, hi = *(const LAS ml_s16x4*)(vp + 16);
                                const ml_bf16x8 vf = __builtin_shufflevector(lo, hi, 0, 1, 2, 3, 4, 5, 6, 7);
                                O[db] = __builtin_amdgcn_mfma_f32_32x32x16_bf16(vf, pf, O[db], 0, 0, 0);
                            }
                        }
                }
                if (kt < kt1) ML_STORE(cur ^ 1);
                __syncthreads();
            }
#undef ML_LOAD
#undef ML_STORE
            den += __shfl_xor(den, 32);
            const float scl = 1.0f / fmaxf(fabsf(den), GE[bhd * SEQ + tq]);
            float* orow = HML + ((size_t)dir * T + b * SEQ + tq) * 1024 + h * 128 + 4 * hh;
#pragma unroll
            for (int db = 0; db < 4; ++db)
#pragma unroll
                for (int g4 = 0; g4 < 4; ++g4)
                    *(f32x4*)(orow + 32 * db + 8 * g4) = (f32x4){O[db][4 * g4] * scl, O[db][4 * g4 + 1] * scl, O[db][4 * g4 + 2] * scl, O[db][4 * g4 + 3] * scl};
        }
    }
    __syncthreads();
}

__device__ __forceinline__ void phase4(const Ctx& C) {
    unsigned char* ws = C.ws;
    const float* ZT = (const float*)(ws + WS_ZT); const float* HML = (const float*)(ws + WS_HML); const bf16* ob = (const bf16*)(ws + WS_OB);
    bf16* ycat = (bf16*)(ws + (size_t)YCAT_T0 * MiB); const float* hyw = C.in[12]; const float* mlw = C.in[15];
    const int lane = C.lane;
    {
        LAS float* red = (LAS float*)C.lds;
        for (int u = blockIdx.x; u < 128 * 8; u += C.G) {
            const int tt = u >> 3, gi = u & 7, tok = tt * 64 + lane, ch0 = gi * 128 + C.wave * 16;
            float x[16]; float s = 0.f;
#pragma unroll
            for (int i = 0; i < 16; ++i) { x[i] = ZT[(size_t)(ch0 + i) * T + tok]; s += x[i]; }
            __syncthreads();
            red[C.wave * 64 + lane] = s;
            __syncthreads();
            float tot = 0.f;
#pragma unroll
            for (int w = 0; w < 8; ++w) tot += red[w * 64 + lane];
            const float mu = tot * (1.0f / 128.0f); float q = 0.f;
#pragma unroll
            for (int i = 0; i < 16; ++i) { x[i] -= mu; q += x[i] * x[i]; }
            __syncthreads();
            red[C.wave * 64 + lane] = q;
            __syncthreads();
            float qt = 0.f;
#pragma unroll
            for (int w = 0; w < 8; ++w) qt += red[w * 64 + lane];
            const float rstd = 1.0f / sqrtf(qt * (1.0f / 128.0f) + LN_EPS);
            float y[16];
#pragma unroll
            for (int i = 0; i < 16; ++i) y[i] = x[i] * rstd * hyw[ch0 + i];
            v4u w0, w1; w0.x = pk2(y[0], y[1]); w0.y = pk2(y[2], y[3]); w0.z = pk2(y[4], y[5]); w0.w = pk2(y[6], y[7]);
            w1.x = pk2(y[8], y[9]); w1.y = pk2(y[10], y[11]); w1.z = pk2(y[12], y[13]); w1.w = pk2(y[14], y[15]);
            bf16* dst = ycat + (size_t)tok * 2048 + ch0;
            *(v4u*)dst = w0; *(v4u*)(dst + 8) = w1;
        }
        __syncthreads();
    }
    for (int tok = C.gw; tok < T; tok += C.NGW) {
        float x[16];
#pragma unroll
        for (int j = 0; j < 4; ++j) { const f32x4 a = *(const f32x4*)(HML + (size_t)tok * 1024 + lane * 16 + 4 * j), bq = *(const f32x4*)(HML + ((size_t)T + tok) * 1024 + lane * 16 + 4 * j);
            x[4 * j] = a.x + bq.x; x[4 * j + 1] = a.y + bq.y; x[4 * j + 2] = a.z + bq.z; x[4 * j + 3] = a.w + bq.w; }
        float s = 0.f;
#pragma unroll
        for (int j = 0; j < 16; ++j) s += x[j];
        s += __shfl_xor(s, 1); s += __shfl_xor(s, 2); s += __shfl_xor(s, 4);
        const float mu = s * (1.0f / 128.0f); float q = 0.f;
#pragma unroll
        for (int j = 0; j < 16; ++j) { x[j] -= mu; q += x[j] * x[j]; }
        q += __shfl_xor(q, 1); q += __shfl_xor(q, 2); q += __shfl_xor(q, 4);
        const float rstd = 1.0f / sqrtf(q * (1.0f / 128.0f) + LN_EPS);
        const float* gw = mlw + lane * 16;
        float y[16];
#pragma unroll
        for (int j = 0; j < 16; ++j) y[j] = x[j] * rstd * gw[j];
        const v4u o0 = *(const v4u*)(ob + (size_t)tok * 1024 + lane * 16), o1 = *(const v4u*)(ob + (size_t)tok * 1024 + lane * 16 + 8);
#pragma unroll
        for (int j = 0; j < 4; ++j) { const float a0 = bflo(o0[j]), a1 = bfhi(o0[j]), b0 = bflo(o1[j]), b1 = bfhi(o1[j]);
            y[2 * j] *= 1.0f / (1.0f + expf(-a0)); y[2 * j + 1] *= 1.0f / (1.0f + expf(-a1)); y[8 + 2 * j] *= 1.0f / (1.0f + expf(-b0)); y[8 + 2 * j + 1] *= 1.0f / (1.0f + expf(-b1)); }
        v4u w0, w1; w0.x = pk2(y[0], y[1]); w0.y = pk2(y[2], y[3]); w0.z = pk2(y[4], y[5]); w0.w = pk2(y[6], y[7]);
        w1.x = pk2(y[8], y[9]); w1.y = pk2(y[10], y[11]); w1.z = pk2(y[12], y[13]); w1.w = pk2(y[14], y[15]);
        bf16* dst = ycat + (size_t)tok * 2048 + 1024 + lane * 16;
        *(v4u*)dst = w0; *(v4u*)(dst + 8) = w1;
    }
}

struct TileOrder {
    int nM, nN, a0, b0, G, c;
    __device__ __forceinline__ bool next(int i, pg8::Unit& u) const {
        const int nwg = nM * nN; const int L = i * G + c; if (L >= nwg) return false;
        int w; { const int q = nwg / 8, r = nwg % 8, xcd = L % 8, off = L / 8; w = (xcd < r ? xcd * (q + 1) : r * (q + 1) + (xcd - r) * q) + off; }
        const int nig = 8 * nN, gid = w / nig, wi = w % nig; u.pm = a0 + gid * 8 + (wi % 8); u.pn = b0 + wi / 8; return true;
    }
    __device__ __forceinline__ void a_ready(const pg8::Unit&) const {}
    __device__ __forceinline__ void done(const pg8::Unit&) const {}
};
struct EpiOut {
    static constexpr bool PERM = false, AFTER_DRAIN = false;
    const float* x; const float* bias; float* r1;
    __device__ __forceinline__ void operator()(const pg8::f32x4 (&acc)[2][2][4][2], const pg8::Unit& u, int wr, int wc, int fr, int fq) const {
        const int row0 = (u.pm - YCAT_T0) * 256 + wr * 64 + fr, col0 = (u.pn - WOUT_T0) * 256 + wc * 32 + 4 * fq;
        pg8::f32x4 bv[2][2];
#pragma unroll
        for (int bj = 0; bj < 2; ++bj)
#pragma unroll
            for (int n = 0; n < 2; ++n) bv[bj][n] = *(const pg8::f32x4*)(bias + col0 + bj * 128 + n * 16);
#pragma unroll
        for (int ai = 0; ai < 2; ++ai)
#pragma unroll
            for (int m = 0; m < 4; ++m) { const size_t off = (size_t)(row0 + ai * 128 + m * 16) * D + col0;
#pragma unroll
                for (int bj = 0; bj < 2; ++bj)
#pragma unroll
                    for (int n = 0; n < 2; ++n) { const pg8::f32x4 xs = *(const pg8::f32x4*)(x + off + bj * 128 + n * 16);
                        *(pg8::f32x4*)(r1 + off + bj * 128 + n * 16) = xs * DN_ALPHA + acc[ai][bj][m][n] + bv[bj][n]; } }
    }
};

#define P6_RS_STEP(NV, XM) do { const bool up = (lane & (XM)) != 0; _Pragma("unroll") for (int e_ = 0; e_ < (NV); ++e_) { \
        const float keep0 = up ? a0[e_ + (NV)] : a0[e_], send0 = up ? a0[e_] : a0[e_ + (NV)]; a0[e_] = keep0 + __shfl_xor(send0, (XM)); \
        const float keep1 = up ? a1[e_ + (NV)] : a1[e_], send1 = up ? a1[e_] : a1[e_ + (NV)]; a1[e_] = keep1 + __shfl_xor(send1, (XM)); } } while (0)
__device__ __forceinline__ void phase6(const Ctx& C, int dummy) {
    unsigned char* ws = C.ws;
    float* r1 = (float*)(ws + WS_R1); bf16* x1b = (bf16*)(ws + (size_t)X1B_T0 * MiB);
    const float* g1 = C.in[18]; const float* b1 = C.in[19]; const float* rw = C.in[20]; const float* rb = C.in[21];
    unsigned* cnt = (unsigned*)(ws + WS_CTL) + CW_CNT + (dummy ? 4096 : 0); int* list = (int*)(ws + (dummy ? WS_YBUF : WS_LIST)); float* tokw = (float*)(ws + (dummy ? WS_YBUF + 2 * MiB : WS_TOKW));
    const int lane = C.lane;
    for (int pair = C.gw; pair < T / 2; pair += C.NGW) {
        int ln = lane; asm volatile("" : "+v"(ln));
        f32x4 v0[8], v1[8];
#pragma unroll
        for (int tk = 0; tk < 2; ++tk) {
            const int tok = 2 * pair + tk; float* rr = r1 + (size_t)tok * D; f32x4 v[8]; float s = 0.f;
#pragma unroll
            for (int j = 0; j < 8; ++j) { v[j] = *(const f32x4*)(rr + (ln + 64 * j) * 4); s += (v[j].x + v[j].y) + (v[j].z + v[j].w); }
            const float mean = wave_sum(s) * (1.0f / D); float q = 0.f;
#pragma unroll
            for (int j = 0; j < 8; ++j) { v[j] = v[j] - mean; q += (v[j].x * v[j].x + v[j].y * v[j].y) + (v[j].z * v[j].z + v[j].w * v[j].w); }
            const float rstd = 1.0f / sqrtf(wave_sum(q) * (1.0f / D) + LN_EPS);
#pragma unroll
            for (int j = 0; j < 8; ++j) { const int c0 = (ln + 64 * j) * 4; const f32x4 gg = *(const f32x4*)(g1 + c0), bb = *(const f32x4*)(b1 + c0);
                const f32x4 y = v[j] * rstd * gg + bb;
                if (!dummy) { *(f32x4*)(rr + c0) = y; v2u w; w.x = pk2(y.x, y.y); w.y = pk2(y.z, y.w); *(v2u*)(x1b + (size_t)tok * D + c0) = w; }
                if (tk == 0) v0[j] = y; else v1[j] = y; }
        }
        float a0[32], a1[32]; const unsigned voff = (unsigned)ln * 512u;
#pragma unroll
        for (int e = 0; e < 32; ++e) { a0[e] = 0.f; a1[e] = 0.f; }
#pragma unroll
        for (int j = 0; j < 8; ++j)
#pragma unroll
            for (int i = 0; i < 4; ++i) {
                const f32x4* wr = (const f32x4*)((const char*)rw + (size_t)((256 * j + i) * 128) + voff);
                const float x0 = v0[j][i], x1 = v1[j][i];
#pragma unroll
                for (int q4 = 0; q4 < 8; ++q4) { const f32x4 w4 = wr[q4];
                    a0[4 * q4] += x0 * w4.x; a0[4 * q4 + 1] += x0 * w4.y; a0[4 * q4 + 2] += x0 * w4.z; a0[4 * q4 + 3] += x0 * w4.w;
                    a1[4 * q4] += x1 * w4.x; a1[4 * q4 + 1] += x1 * w4.y; a1[4 * q4 + 2] += x1 * w4.z; a1[4 * q4 + 3] += x1 * w4.w; }
                asm volatile("" ::: "memory");
            }
        P6_RS_STEP(16, 32); P6_RS_STEP(8, 16); P6_RS_STEP(4, 8); P6_RS_STEP(2, 4); P6_RS_STEP(1, 2);
        const int e = lane >> 1; const float rbe = rb[e];
        float lg0 = a0[0] + __shfl_xor(a0[0], 1) + rbe, lg1 = a1[0] + __shfl_xor(a1[0], 1) + rbe;
#pragma unroll
        for (int tk = 0; tk < 2; ++tk) {
            const int tok = 2 * pair + tk; float val = tk ? lg1 : lg0; float vals[4]; int idxs[4];
#pragma unroll
            for (int k = 0; k < 4; ++k) {
                const float m = wave_max(val);
                const unsigned long long bal = __ballot(val == m);
                const int idx = (int)(__builtin_ctzll(bal) >> 1);
                vals[k] = m; idxs[k] = idx;
                if (e == idx) val = -3.0e38f;
            }
            const float e1 = expf(vals[1] - vals[0]), e2 = expf(vals[2] - vals[0]), e3 = expf(vals[3] - vals[0]);
            const float inv = 1.0f / (1.0f + e1 + e2 + e3);
            if (lane < 4) {
                const int sel_e = lane == 0 ? idxs[0] : lane == 1 ? idxs[1] : lane == 2 ? idxs[2] : idxs[3];
                const float sel_v = (lane == 0 ? 1.0f : lane == 1 ? e1 : lane == 2 ? e2 : e3) * inv;
                const unsigned pos = atomicAdd(cnt + 64 * sel_e, 1u);
                list[sel_e * T + pos] = tok * 4 + lane; tokw[tok * 4 + lane] = sel_v;
            }
        }
    }
}
#undef P6_RS_STEP

__device__ __forceinline__ void moe_build_tb(const Ctx& C) {
    LAS int* tb = (LAS int*)(C.lds + LDS_TB);
    __syncthreads();
    if (C.tid == 0) { const unsigned* cnt = (const unsigned*)(C.ws + WS_CTL) + CW_CNT; int acc = 0;
        for (int e = 0; e < NE; ++e) { const int n = (int)__hip_atomic_load(cnt + 64 * e, __ATOMIC_RELAXED, __HIP_MEMORY_SCOPE_AGENT); tb[e] = acc; tb[40 + e] = n; acc += (n + 255) >> 8; }
        tb[32] = acc; }
    __syncthreads();
}
__device__ __forceinline__ void phase7(const Ctx& C) {
    unsigned char* ws = C.ws;
    moe_build_tb(C);
    const LAS int* tb = (const LAS int*)(C.lds + LDS_TB);
    const bf16* x1b = (const bf16*)(ws + (size_t)X1B_T0 * MiB); bf16* abuf = (bf16*)(ws + (size_t)ABUF_T0 * MiB);
    const int* list = (const int*)(ws + WS_LIST); const float* tokw = (const float*)(ws + WS_TOKW);
    int* rowslot = (int*)(ws + WS_ROWSLOT); float* roww = (float*)(ws + WS_ROWW);
    const int total_rows = tb[32] * 256;
    for (int row = C.gw; row < total_rows; row += C.NGW) {
        int e = 0; const int rt = row >> 8;
        while (e < NE - 1 && tb[e + 1] <= rt) ++e;
        const int i = row - tb[e] * 256; const int n = tb[40 + e];
        v4u* dst = (v4u*)(abuf + (size_t)row * D);
        if (i < n) { const int slot = list[e * T + i]; const v4u* src = (const v4u*)(x1b + (size_t)(slot >> 2) * D);
#pragma unroll
            for (int j = 0; j < 4; ++j) dst[C.lane + 64 * j] = src[C.lane + 64 * j];
            if (C.lane == 0) { rowslot[row] = slot; roww[row] = tokw[slot]; } }
        else {
#pragma unroll
            for (int j = 0; j < 4; ++j) dst[C.lane + 64 * j] = (v4u){0u, 0u, 0u, 0u};
            if (C.lane == 0) { rowslot[row] = -1; roww[row] = 0.f; } }
    }
}
struct MoeOrder {
    const LAS int* tb; int NJ, a0, w0, G, c;
    __device__ __forceinline__ bool next(int i, pg8::Unit& u) const {
        const int nwg = tb[32] * NJ; const int L = i * G + c; if (L >= nwg) return false;
        int w; { const int q = nwg / 8, r = nwg % 8, xcd = L % 8, off = L / 8; w = (xcd < r ? xcd * (q + 1) : r * (q + 1) + (xcd - r) * q) + off; }
        int e = 0;
        while (e < NE - 1 && tb[e + 1] * NJ <= w) ++e;
        const int local = w - tb[e] * NJ, nt = tb[e + 1] - tb[e], j = local / nt, ti = local - j * nt;
        u.pm = a0 + tb[e] + ti; u.pn = w0 + e * NJ + j; return true;
    }
    __device__ __forceinline__ void a_ready(const pg8::Unit&) const {}
    __device__ __forceinline__ void done(const pg8::Unit&) const {}
};
struct EpiGU {
    static constexpr bool PERM = true, AFTER_DRAIN = false;
    const float* b_gu; bf16* act;
    __device__ __forceinline__ void operator()(const pg8::f32x4 (&acc)[2][2][4][2], const pg8::Unit& u, int wr, int wc, int fr, int fq) const {
        using pg8::cvt_pk_bf16;
        const int rt = u.pm - ABUF_T0, rel = u.pn - WGU_T0, e = rel >> 4, j = rel & 15;
        const int col0 = j * 128 + wc * 32 + 8 * fq;
        pg8::f32x4 bg[2], bu[2];
#pragma unroll
        for (int n = 0; n < 2; ++n) { bg[n] = *(const pg8::f32x4*)(b_gu + (size_t)e * 4096 + col0 + 4 * n); bu[n] = *(const pg8::f32x4*)(b_gu + (size_t)e * 4096 + 2048 + col0 + 4 * n); }
#pragma unroll
        for (int ai = 0; ai < 2; ++ai)
#pragma unroll
            for (int m = 0; m < 4; ++m) { const int row = rt * 256 + ai * 128 + wr * 64 + m * 16 + fr;
                float o[8];
#pragma unroll
                for (int n = 0; n < 2; ++n) { const pg8::f32x4 g = acc[ai][0][m][n] + bg[n], up = acc[ai][1][m][n] + bu[n];
#pragma unroll
                    for (int i = 0; i < 4; ++i) { const float gc = fminf(g[i], 7.0f), uc = fminf(fmaxf(up[i], -7.0f), 7.0f);
                        o[4 * n + i] = (uc + 1.0f) * (gc / (1.0f + __expf(-1.702f * gc))); } }
                v4u w; w.x = cvt_pk_bf16(o[0], o[1]); w.y = cvt_pk_bf16(o[2], o[3]); w.z = cvt_pk_bf16(o[4], o[5]); w.w = cvt_pk_bf16(o[6], o[7]);
                *(v4u*)(act + (size_t)row * DFF + col0) = w; }
    }
};
struct EpiDown {
    static constexpr bool PERM = false, AFTER_DRAIN = false;
    const float* b_down; const int* rowslot; const float* roww; float* ybuf;
    __device__ __forceinline__ void operator()(const pg8::f32x4 (&acc)[2][2][4][2], const pg8::Unit& u, int wr, int wc, int fr, int fq) const {
        const int rt = u.pm - ACT_T0, rel = u.pn - WDN_T0, e = rel >> 3, j = rel & 7;
        const int col0 = j * 256 + wc * 32 + 4 * fq;
        pg8::f32x4 bv[2][2];
#pragma unroll
        for (int bj = 0; bj < 2; ++bj)
#pragma unroll
            for (int n = 0; n < 2; ++n) bv[bj][n] = *(const pg8::f32x4*)(b_down + (size_t)e * D + col0 + bj * 128 + n * 16);
#pragma unroll
        for (int ai = 0; ai < 2; ++ai)
#pragma unroll
            for (int m = 0; m < 4; ++m) { const int row = rt * 256 + ai * 128 + wr * 64 + m * 16 + fr;
                const int slot = rowslot[row]; const float w = roww[row];
                if (slot >= 0) { float* dst = ybuf + (size_t)slot * D + col0;
#pragma unroll
                    for (int bj = 0; bj < 2; ++bj)
#pragma unroll
                        for (int n = 0; n < 2; ++n) *(pg8::f32x4*)(dst + bj * 128 + n * 16) = (acc[ai][bj][m][n] + bv[bj][n]) * w; } }
    }
};

__device__ __forceinline__ void phase10(const Ctx& C) {
    unsigned char* ws = C.ws;
    const float* x1 = (const float*)(ws + WS_R1); const float* ybuf = (const float*)(ws + WS_YBUF);
    const float* g2 = C.in[26]; const float* b2 = C.in[27]; const int lane = C.lane;
    for (int tok = C.gw; tok < T; tok += C.NGW) {
        f32x4 v[8]; float s = 0.f;
#pragma unroll
        for (int j = 0; j < 8; ++j) { const int c0 = (lane + 64 * j) * 4; f32x4 a = *(const f32x4*)(x1 + (size_t)tok * D + c0) * DN_ALPHA;
#pragma unroll
            for (int k = 0; k < 4; ++k) a = a + *(const f32x4*)(ybuf + ((size_t)tok * 4 + k) * D + c0);
            v[j] = a; s += (a.x + a.y) + (a.z + a.w); }
        const float mean = wave_sum(s) * (1.0f / D); float q = 0.f;
#pragma unroll
        for (int j = 0; j < 8; ++j) { v[j] = v[j] - mean; q += (v[j].x * v[j].x + v[j].y * v[j].y) + (v[j].z * v[j].z + v[j].w * v[j].w); }
        const float rstd = 1.0f / sqrtf(wave_sum(q) * (1.0f / D) + LN_EPS);
#pragma unroll
        for (int j = 0; j < 8; ++j) { const int c0 = (lane + 64 * j) * 4; const f32x4 gg = *(const f32x4*)(g2 + c0), bb = *(const f32x4*)(b2 + c0);
            *(f32x4*)(C.out + (size_t)tok * D + c0) = v[j] * rstd * gg + bb; }
    }
}

__global__ void __launch_bounds__(NTHREADS, 2) fwd_kernel(KArgs args) {
    extern __shared__ __attribute__((aligned(16))) unsigned char lds_raw[];
    Ctx C;
#pragma unroll
    for (int i = 0; i < 28; ++i) C.in[i] = args.in[i];
    C.out = args.out; C.ws = args.ws; C.lds = (LAS unsigned char*)lds_raw;
    C.tid = threadIdx.x; C.lane = C.tid & 63; C.wave = __builtin_amdgcn_readfirstlane(C.tid >> 6); C.G = gridDim.x;
    C.gw = blockIdx.x * NWAVES + C.wave; C.NGW = C.G * NWAVES;
    volatile LAS unsigned* MISC = (volatile LAS unsigned*)(C.lds + LDS_MISC);
    if (C.tid < 4) MISC[C.tid] = 0u;
    __syncthreads();
    unsigned* ctl = (unsigned*)(args.ws + WS_CTL);
    XcdBarrier bar; bar.bar = ctl + CW_BAR; bar.x = 0; bar.st = MISC;
    const int lo = args.ph_lo, hi = args.ph_hi;
    if (hi - lo > 1) bar = xcd_barrier_post(ctl + CW_BAR, MISC);
#ifndef PHASE_MASK
#define PHASE_MASK 0x7ff
#endif
#define IN(k) (((PHASE_MASK >> (k)) & 1) && lo <= (k) && (k) < hi)
#define SEAM(k) do { if (IN(k) && IN((k) + 1)) xcd_barrier(bar); } while (0)
    const pg8::Gemm g{(const pg8::bf16_t*)args.ws, (const pg8::bf16_t*)args.ws, 0, 0, 2048};
    PG8_LAS unsigned char* glds = (PG8_LAS unsigned char*)lds_raw;

#ifndef PROBE_DOUBLE
#define PROBE_DOUBLE 0
#endif
#define REP(k) for (int _rep = 0; _rep < (((PROBE_DOUBLE >> (k)) & 1) ? 2 : 1); ++_rep)
    if (IN(0)) { REP(0) phase0(C); } SEAM(0);
    if (IN(1)) {
        Gemm1Order S{C.G, (int)blockIdx.x};
        unsigned char* ws = args.ws;
        Epi1 E{C.in[2], (bf16*)(ws + WS_HYT), (bf16*)(ws + WS_QKRAW), (bf16*)(ws + WS_VB), (bf16*)(ws + WS_OB), (float*)(ws + WS_GATES)};
        REP(1) pg8::gemm_phase<Epi1, Gemm1Order, true, true>(glds, g, S, E);
        { const pg8::Gemm g2{(const pg8::bf16_t*)(ws + WS_W3P), (const pg8::bf16_t*)(ws + WS_H2P), 0, 0, 256}; KtOrder S2{C.G, (int)blockIdx.x}; EpiKT E2{(float*)(ws + WS_KT)};
          pg8::gemm_phase<EpiKT, KtOrder, true, true>(glds, g2, S2, E2); }
    } SEAM(1);
    if (IN(2)) { REP(2) phase2(C); } SEAM(2);
    if (IN(3)) { REP(3) hyena_fft(C); REP(11) { if (NAIVE_ML) mlstm_naive(C); else mlstm_mfma(C); } } SEAM(3);
    if (IN(4)) { REP(4) phase4(C); } SEAM(4);
    if (IN(5)) {
        TileOrder S{32, 8, YCAT_T0, WOUT_T0, C.G, (int)blockIdx.x};
        EpiOut E{C.in[0], C.in[17], (float*)(args.ws + WS_R1)};
        REP(5) pg8::gemm_phase<EpiOut, TileOrder, true, true>(glds, g, S, E);
    } SEAM(5);
    if (IN(6)) { REP(6) phase6(C, _rep); } SEAM(6);
    if (IN(7)) { REP(7) phase7(C); } SEAM(7);
    if (IN(8)) {
        moe_build_tb(C);
        MoeOrder S{(const LAS int*)(C.lds + LDS_TB), 16, ABUF_T0, WGU_T0, C.G, (int)blockIdx.x};
        EpiGU E{C.in[23], (bf16*)(args.ws + (size_t)ACT_T0 * MiB)};
        REP(8) pg8::gemm_phase<EpiGU, MoeOrder, true, true>(glds, g, S, E);
    } SEAM(8);
    if (IN(9)) {
        moe_build_tb(C);
        MoeOrder S{(const LAS int*)(C.lds + LDS_TB), 8, ACT_T0, WDN_T0, C.G, (int)blockIdx.x};
        EpiDown E{C.in[25], (const int*)(args.ws + WS_ROWSLOT), (const float*)(args.ws + WS_ROWW), (float*)(args.ws + WS_YBUF)};
        REP(9) pg8::gemm_phase<EpiDown, MoeOrder, true, true>(glds, g, S, E);
    } SEAM(9);
    if (IN(10)) { REP(10) phase10(C); }
#undef IN
#undef SEAM
}

extern "C" void kernel_launch(void* const* d_in, const int* in_sizes, int n_in, void* d_out, int out_size, void* d_ws, size_t ws_size, hipStream_t stream) {
    static int grid = 0;
    if (grid == 0) {
        if (n_in != 28 || in_sizes[0] != T * D || out_size != T * D || ws_size < WS_END) { fprintf(stderr, "kernel_launch: unexpected shapes (n_in %d, in0 %d, out %d, ws %zu)\n", n_in, n_in > 0 ? in_sizes[0] : -1, out_size, ws_size); grid = -1; return; }
        int dev = 0, cus = 0;
        if (hipGetDevice(&dev) != hipSuccess || hipDeviceGetAttribute(&cus, hipDeviceAttributeMultiprocessorCount, dev) != hipSuccess) { grid = -1; return; }
        if (hipFuncSetAttribute((const void*)fwd_kernel, hipFuncAttributeMaxDynamicSharedMemorySize, LDS_BYTES) != hipSuccess) { fprintf(stderr, "kernel_launch: hipFuncSetAttribute failed\n"); grid = -1; return; }
        int per_cu = 0;
        if (hipOccupancyMaxActiveBlocksPerMultiprocessor(&per_cu, (const void*)fwd_kernel, NTHREADS, LDS_BYTES) != hipSuccess || per_cu < 1) fprintf(stderr, "kernel_launch: occupancy query says %d\n", per_cu);
        (void)hipGetLastError();
        grid = cus;
    }
    if (grid < 0) return;
    if (hipMemsetAsync((char*)d_ws + WS_CTL, 0, CTL_ZERO_BYTES, stream) != hipSuccess) return;
    KArgs a{};
    for (int i = 0; i < 28; ++i) a.in[i] = (const float*)d_in[i];
    a.out = (float*)d_out; a.ws = (unsigned char*)d_ws;
#if MK_ONE_LAUNCH
    a.ph_lo = 0; a.ph_hi = N_PHASES;
    hipLaunchKernelGGL(fwd_kernel, dim3(grid), dim3(NTHREADS), LDS_BYTES, stream, a);
#else
    for (int ph = 0; ph < N_PHASES; ++ph) { a.ph_lo = ph; a.ph_hi = ph + 1; hipLaunchKernelGGL(fwd_kernel, dim3(grid), dim3(NTHREADS), LDS_BYTES, stream, a); }
#endif
}
```

```cpp
#include <hip/hip_runtime.h>
#include <cstdio>
#include <cstdint>
namespace pg8 {
#define PG8_LAS __attribute__((address_space(3)))
typedef unsigned short bf16_t;
typedef short bf16x8 __attribute__((ext_vector_type(8)));
typedef float f32x4 __attribute__((ext_vector_type(4)));
typedef unsigned u32x4 __attribute__((ext_vector_type(4)));
constexpr int BM = 256, BK = 64, HALF = 128, HTB = HALF * BK * 2  , STAGE_BYTES = 8 * HTB, NXCD = 8, WGM = 8;

__host__ __device__ __forceinline__ int lds_byte(int r, int c) { const int st = (r >> 4) * 2 + (c >> 5), rr = r & 15, cc = c & 31, ob = rr * 64 + cc * 2; return st * 1024 + (ob ^ (((ob >> 9) & 1) << 5)); }
__host__ __device__ __forceinline__ void stage_rc(int b, int& R, int& C) { const int st = b / 1024, sb = b % 1024, swz = sb ^ (((sb >> 9) & 1) << 5); R = (st >> 1) * 16 + swz / 64; C = (st & 1) * 32 + (swz % 64) / 2; }
__host__ __device__ __forceinline__ int perm32(int rho) { const int n = rho >> 4, i = rho & 15; return 8 * (i >> 2) + 4 * n + (i & 3); }

struct Unit { int pm, pn; };
struct Gemm { const bf16_t* A; const bf16_t* Bt; int M, N, K; };
__device__ __forceinline__ unsigned cvt_pk_bf16(float lo, float hi) { unsigned r; asm volatile("v_cvt_pk_bf16_f32 %0, %1, %2" : "=v"(r) : "v"(lo), "v"(hi)); return r; }
typedef float f32x2 __attribute__((ext_vector_type(2)));
template <class Epi, class Sched, bool ALIGN_EPI = false, bool SP2 = false>
__device__ __forceinline__ void gemm_phase(PG8_LAS unsigned char* lds, const Gemm g, const Sched& S, const Epi& E) {
    const int tid = threadIdx.x, wid = __builtin_amdgcn_readfirstlane(tid >> 6), lane = tid & 63, wr = wid >> 2, wc = wid & 3, fr = lane & 15, fq = lane >> 4;
    const int K = g.K, nt = K / BK;
    unsigned voffA[2], voffB[2];
#pragma unroll
    for (int i = 0; i < 2; ++i) { int R, C; stage_rc(tid * 16 + i * 8192, R, C); const int Rb = Epi::PERM ? ((R & ~31) + perm32(R & 31)) : R;
        voffA[i] = (unsigned)(R * K + C) * 2u; voffB[i] = (unsigned)(Rb * K + C) * 2u; }
    const size_t kstep = (size_t)(BK * 2);
    const size_t hstep = (size_t)HALF * K * 2;
    const size_t tstep = 2 * hstep;
    const unsigned ldsw = (unsigned)wid * 1024u;
    const int aoff = lds_byte(wr * 64 + fr, fq * 8), boff = lds_byte(wc * 32 + fr, fq * 8);
#define PG8_SA(b, h) (((b) * 2 + (h)) * HTB)
#define PG8_SB(b, h) ((4 + (b) * 2 + (h)) * HTB)
#define PG8_STAGE(bufoff, gbase, voff) do { _Pragma("unroll") for (int _i = 0; _i < 2; ++_i) \
        __builtin_amdgcn_global_load_lds((const unsigned*)((const char*)(gbase) + (voff)[_i]), (PG8_LAS unsigned*)(lds + (bufoff) + ldsw + _i * 8192), 16, 0, 0); } while (0)
#define PG8_LDA(dst, b, h) do { _Pragma("unroll") for (int m = 0; m < 4; ++m) _Pragma("unroll") for (int k = 0; k < 2; ++k) dst[m][k] = *(const PG8_LAS bf16x8*)(lds + PG8_SA(b, h) + aoff + m * 2048 + k * 1024); } while (0)
#define PG8_LDB(dst, b, h) do { _Pragma("unroll") for (int n = 0; n < 2; ++n) _Pragma("unroll") for (int k = 0; k < 2; ++k) dst[n][k] = *(const PG8_LAS bf16x8*)(lds + PG8_SB(b, h) + boff + n * 2048 + k * 1024); } while (0)
#define PG8_MMA(ai, bj, At, Bt) do { __builtin_amdgcn_s_setprio(1); _Pragma("unroll") for (int m = 0; m < 4; ++m) _Pragma("unroll") for (int n = 0; n < 2; ++n) _Pragma("unroll") for (int k = 0; k < 2; ++k) \
        acc[ai][bj][m][n] = __builtin_amdgcn_mfma_f32_16x16x32_bf16(Bt[n][k], At[m][k], acc[ai][bj][m][n], 0, 0, 0); __builtin_amdgcn_s_setprio(0); } while (0)
#define PG8_WAIT_V(n) asm volatile("s_waitcnt vmcnt(" #n ")" ::: "memory")
#define PG8_WAIT_L(n) asm volatile("s_waitcnt lgkmcnt(" #n ")" ::: "memory")
#define PG8_BAR __builtin_amdgcn_s_barrier()
#define PG8_SCHED __builtin_amdgcn_sched_barrier(0)
    Unit cur, nxt; int ui = 0;
    if (!S.next(0, cur)) return;
    f32x4 acc[2][2][4][2];
#pragma unroll
    for (int a = 0; a < 2; ++a)
#pragma unroll
        for (int b = 0; b < 2; ++b)
#pragma unroll
            for (int m = 0; m < 4; ++m)
#pragma unroll
                for (int n = 0; n < 2; ++n) acc[a][b][m][n] = (f32x4){0.f, 0.f, 0.f, 0.f};
    bf16x8 At[4][2], B0[2][2], B1[2][2];
    const char* cA = (const char*)g.A + (size_t)cur.pm * tstep; const char* cB = (const char*)g.Bt + (size_t)cur.pn * tstep;
    S.a_ready(cur);
    if constexpr (SP2) {
        PG8_STAGE(PG8_SB(0, 0), cB, voffB); PG8_STAGE(PG8_SB(0, 1), cB + hstep, voffB); PG8_STAGE(PG8_SA(0, 0), cA, voffA); PG8_STAGE(PG8_SA(0, 1), cA + hstep, voffA);
        if (wr == 1) PG8_BAR;
        PG8_WAIT_V(2); PG8_BAR;
        PG8_STAGE(PG8_SB(1, 0), cB + kstep, voffB); PG8_STAGE(PG8_SA(1, 0), cA + kstep, voffA); PG8_STAGE(PG8_SB(1, 1), cB + hstep + kstep, voffB);
        PG8_WAIT_V(6); PG8_BAR;
    } else {
        PG8_STAGE(PG8_SB(0, 0), cB, voffB); PG8_STAGE(PG8_SA(0, 0), cA, voffA); PG8_STAGE(PG8_SB(0, 1), cB + hstep, voffB); PG8_STAGE(PG8_SA(0, 1), cA + hstep, voffA);
        if (wr == 1) PG8_BAR;
        PG8_WAIT_V(4); PG8_BAR;
        PG8_STAGE(PG8_SB(1, 0), cB + kstep, voffB); PG8_STAGE(PG8_SA(1, 0), cA + kstep, voffA); PG8_STAGE(PG8_SB(1, 1), cB + hstep + kstep, voffB);
        PG8_WAIT_V(6); PG8_BAR;
    }
    for (;;) {
        const bool has_next = S.next(ui + 1, nxt);
        const char* nA = has_next ? (const char*)g.A + (size_t)nxt.pm * tstep : cA; const char* nB = has_next ? (const char*)g.Bt + (size_t)nxt.pn * tstep : cB;
        for (int t = 0; t < nt; t += 2) {
            const bool last = (t == nt - 2);
            const char* a1 = cA + (size_t)(t + 1) * kstep;
            const char* a2 = last ? nA : cA + (size_t)(t + 2) * kstep; const char* b2 = last ? nB : cB + (size_t)(t + 2) * kstep;
            const char* a3 = a2 + kstep; const char* b3 = b2 + kstep;
            if (last && has_next) S.a_ready(nxt);
            if constexpr (SP2) {
            PG8_LDB(B0, 0, 0); PG8_LDB(B1, 0, 1); PG8_SCHED; PG8_LDA(At, 0, 0); PG8_STAGE(PG8_SA(1, 1), a1 + hstep, voffA);
            PG8_WAIT_V(8); PG8_WAIT_L(0); PG8_BAR; PG8_MMA(0, 0, At, B0); PG8_MMA(0, 1, At, B1); PG8_BAR; PG8_SCHED;
            PG8_LDA(At, 0, 1); PG8_STAGE(PG8_SB(0, 0), b2, voffB); PG8_STAGE(PG8_SB(0, 1), b2 + hstep, voffB); PG8_STAGE(PG8_SA(0, 0), a2, voffA);
            PG8_WAIT_V(8); PG8_WAIT_L(0); PG8_BAR; PG8_MMA(1, 0, At, B0); PG8_MMA(1, 1, At, B1); PG8_BAR; PG8_SCHED;
            PG8_LDB(B0, 1, 0); PG8_LDB(B1, 1, 1); PG8_SCHED; PG8_LDA(At, 1, 0); PG8_STAGE(PG8_SA(0, 1), a2 + hstep, voffA);
            PG8_WAIT_V(8); PG8_WAIT_L(0); PG8_BAR; PG8_MMA(0, 0, At, B0); PG8_MMA(0, 1, At, B1); PG8_BAR; PG8_SCHED;
            PG8_LDA(At, 1, 1); PG8_STAGE(PG8_SB(1, 0), b3, voffB); PG8_STAGE(PG8_SB(1, 1), b3 + hstep, voffB); PG8_STAGE(PG8_SA(1, 0), a3, voffA);
            PG8_WAIT_V(8); PG8_WAIT_L(0); PG8_BAR; PG8_MMA(1, 0, At, B0); PG8_MMA(1, 1, At, B1); PG8_BAR; PG8_SCHED;
            } else {
            PG8_LDB(B0, 0, 0); PG8_SCHED; PG8_LDA(At, 0, 0); PG8_STAGE(PG8_SA(1, 1), a1 + hstep, voffA);
            PG8_WAIT_L(8); PG8_BAR; PG8_WAIT_L(0); PG8_MMA(0, 0, At, B0); PG8_BAR; PG8_SCHED;
            PG8_LDB(B1, 0, 1); PG8_STAGE(PG8_SB(0, 0), b2, voffB);
            PG8_BAR; PG8_WAIT_L(0); PG8_MMA(0, 1, At, B1); PG8_BAR;
            PG8_LDA(At, 0, 1); PG8_STAGE(PG8_SA(0, 0), a2, voffA);
            PG8_BAR; PG8_WAIT_L(0); PG8_MMA(1, 0, At, B0); PG8_BAR; PG8_SCHED;
            PG8_STAGE(PG8_SB(0, 1), b2 + hstep, voffB);
            PG8_WAIT_V(6); PG8_BAR; PG8_MMA(1, 1, At, B1); PG8_BAR;
            PG8_LDB(B0, 1, 0); PG8_SCHED; PG8_LDA(At, 1, 0); PG8_STAGE(PG8_SA(0, 1), a2 + hstep, voffA);
            PG8_WAIT_L(8); PG8_BAR; PG8_WAIT_L(0); PG8_MMA(0, 0, At, B0); PG8_BAR; PG8_SCHED;
            PG8_LDB(B1, 1, 1); PG8_STAGE(PG8_SB(1, 0), b3, voffB);
            PG8_BAR; PG8_WAIT_L(0); PG8_MMA(0, 1, At, B1); PG8_BAR;
            PG8_LDA(At, 1, 1); PG8_STAGE(PG8_SA(1, 0), a3, voffA);
            PG8_BAR; PG8_WAIT_L(0); PG8_MMA(1, 0, At, B0); PG8_BAR; PG8_SCHED;
            PG8_STAGE(PG8_SB(1, 1), b3 + hstep, voffB);
            PG8_WAIT_V(6); PG8_BAR; PG8_MMA(1, 1, At, B1); PG8_BAR;
            }
        }
        if constexpr (ALIGN_EPI) { if (wr == 0) PG8_BAR; }
        if constexpr (!Epi::AFTER_DRAIN) { E(acc, cur, wr, wc, fr, fq); S.done(cur); }
        if (!has_next) break;
#pragma unroll
        for (int a = 0; a < 2; ++a)
#pragma unroll
            for (int b = 0; b < 2; ++b)
#pragma unroll
                for (int m = 0; m < 4; ++m)
#pragma unroll
                    for (int n = 0; n < 2; ++n) acc[a][b][m][n] = (f32x4){0.f, 0.f, 0.f, 0.f};
        cur = nxt; cA = nA; cB = nB; ++ui;
        if constexpr (ALIGN_EPI) { if (wr == 1) PG8_BAR; }
    }
    PG8_WAIT_V(0);
    if constexpr (!ALIGN_EPI) { if (wr == 0) PG8_BAR; }
    PG8_BAR;
    if constexpr (Epi::AFTER_DRAIN) { E.fused(acc, cur, wr, wc, fr, fq, lds, wid, lane); S.done(cur); }
#undef PG8_SA
#undef PG8_SB
#undef PG8_STAGE
#undef PG8_LDA
#undef PG8_LDB
#undef PG8_MMA
#undef PG8_WAIT_V
#undef PG8_WAIT_L
#undef PG8_BAR
#undef PG8_SCHED
}
}

constexpr int NB = 4, SEQ = 2048, T = NB * SEQ, D = 2048, DHY = 1024, DML = 1024, DIN = 7200, NE = 32, TOPK = 4, NH = 8, HD = 128, DFF = 2048;
constexpr float LN_EPS = 1e-5f, DN_ALPHA = 1.189207115002721f;
constexpr int NWAVES = 8, NTHREADS = 512;
#ifndef MK_ONE_LAUNCH
#define MK_ONE_LAUNCH 1
#endif
constexpr int N_PHASES = 11;
#ifndef MOE_PRECONVERT
#define MOE_PRECONVERT 1
#endif

constexpr size_t MiB = 1u << 20;
constexpr size_t WS_CTL = 0, CTL_ZERO_BYTES = 1 * MiB;
constexpr size_t WS_H2P = 1936 * MiB;
constexpr size_t WS_W3P = 1937 * MiB;
constexpr size_t WS_GATES = 2 * MiB;
constexpr size_t WS_TOKW = 3 * MiB;
constexpr size_t WS_LIST = 4 * MiB;
constexpr size_t WS_ROWSLOT = 5 * MiB;
constexpr size_t WS_ROWW = 5 * MiB + 512 * 1024;
constexpr size_t WS_GA = 6 * MiB, WS_GP = 6 * MiB + 512 * 1024, WS_GE = 7 * MiB;
constexpr size_t TILE_BYTES = 256 * 2048 * 2;
constexpr int XB_T0 = 8, WIN_T0 = 40, WOUT_T0 = 72, YCAT_T0 = 80, X1B_T0 = 112, ABUF_T0 = 144, ACT_T0 = 304, WGU_T0 = 464, WDN_T0 = 976;
constexpr size_t WS_HYT = 1232 * MiB;
constexpr size_t WS_QKRAW = 1296 * MiB;
constexpr size_t WS_OB = 1328 * MiB;
constexpr size_t WS_QKC = 1344 * MiB;
constexpr size_t WS_KT = 1376 * MiB;
constexpr size_t WS_KF = 1840 * MiB;
constexpr size_t WS_ZT = 1904 * MiB;
constexpr size_t WS_Z = 1408 * MiB;
constexpr size_t WS_HML = 1440 * MiB;
constexpr size_t WS_R1 = 1504 * MiB;
constexpr size_t WS_YBUF = 1568 * MiB;
constexpr size_t WS_VB = 1824 * MiB;
constexpr size_t WS_END = 1940 * MiB;
constexpr int CW_BAR = 4096, CW_CNT = 16384;

constexpr int LDS_STAGE = 131072, LDS_MISC = LDS_STAGE, LDS_TB = LDS_STAGE + 64, LDS_BYTES = 147456;

#define GAS __attribute__((address_space(1)))
#define LAS __attribute__((address_space(3)))
typedef unsigned short bf16;
typedef unsigned v4u __attribute__((ext_vector_type(4)));
typedef unsigned v2u __attribute__((ext_vector_type(2)));
typedef float f32x4 __attribute__((ext_vector_type(4)));
typedef float f32x2 __attribute__((ext_vector_type(2)));
#define LDS_WAIT() asm volatile("s_waitcnt lgkmcnt(0)" ::: "memory")
__device__ __forceinline__ unsigned f2bf(float f) { unsigned u = __builtin_bit_cast(unsigned, f); return (u + 0x7fffu + ((u >> 16) & 1u)) >> 16; }
__device__ __forceinline__ unsigned pk2(float lo, float hi) { return f2bf(lo) | (f2bf(hi) << 16); }
__device__ __forceinline__ float bflo(unsigned w) { return __builtin_bit_cast(float, w << 16); }
__device__ __forceinline__ float bfhi(unsigned w) { return __builtin_bit_cast(float, w & 0xffff0000u); }
__device__ __forceinline__ float bf2f(bf16 b) { return __builtin_bit_cast(float, (unsigned)b << 16); }
__device__ __forceinline__ float wave_sum(float v) {
#pragma unroll
    for (int o = 1; o < 64; o <<= 1) v += __shfl_xor(v, o);
    return v;
}
__device__ __forceinline__ float wave_max(float v) {
#pragma unroll
    for (int o = 1; o < 64; o <<= 1) v = fmaxf(v, __shfl_xor(v, o));
    return v;
}

#define XB_TMO      128
#define XB_XCNT(j)  (256  + 64 * (j))
#define XB_XSUB(j)  (1280 + 64 * (j))
#define XB_XGEN(j)  (2304 + 64 * (j))
#define XB_TOP      3328
#define XB_TOPGEN   3392
#define XCD_BAR_WORDS 3456
#define XB_SPIN_CAP (1u << 22)

__device__ __forceinline__ unsigned xb_ld(unsigned* p)              { return __hip_atomic_load(p, __ATOMIC_RELAXED, __HIP_MEMORY_SCOPE_AGENT); }
__device__ __forceinline__ unsigned xb_add(unsigned* p, unsigned v) { return __hip_atomic_fetch_add(p, v, __ATOMIC_RELAXED, __HIP_MEMORY_SCOPE_AGENT); }
__device__ __forceinline__ unsigned xb_xcc_id() { return (unsigned)__builtin_amdgcn_s_getreg((3 << 11) | 20) & 0xFu; }
#define XB_SPIN(cond, bar) do { unsigned _sp = 0; while (cond) { __builtin_amdgcn_s_sleep(1); \
    if ((++_sp & 255u) == 0u) { if (xb_ld(&(bar)[XB_TMO])) break; if (_sp > XB_SPIN_CAP) { atomicAdd(&(bar)[XB_TMO], 1u); break; } } } } while (0)

struct XcdBarrier {
    unsigned* bar; unsigned x;
    volatile LAS unsigned* st;
};

__device__ __forceinline__ XcdBarrier xcd_barrier_post(unsigned* bar, volatile LAS unsigned* st) {
    XcdBarrier b; b.bar = bar; b.x = xb_xcc_id(); b.st = st;
    if (threadIdx.x == 0) (void)xb_add(&bar[XB_XCNT(b.x)], 1u);
    return b;
}
__device__ __forceinline__ void xcd_barrier_complete(unsigned* bar, unsigned x, unsigned& nloc, unsigned& nx) {
    const unsigned G = gridDim.x * gridDim.y * gridDim.z;
    unsigned sum, cnt, mine, sp = 0u;
    for (;;) {
        sum = 0u; cnt = 0u; mine = 0u;
#pragma unroll
        for (unsigned j = 0; j < 16; ++j) { const unsigned c = xb_ld(&bar[XB_XCNT(j)]); sum += c; cnt += (c > 0u) ? 1u : 0u; mine = (j == x) ? c : mine; }
        if (sum == G) break;
        __builtin_amdgcn_s_sleep(1);
        if ((++sp & 255u) == 0u) { if (xb_ld(&bar[XB_TMO])) break; if (sp > XB_SPIN_CAP) { atomicAdd(&bar[XB_TMO], 1u); break; } }
    }
    nloc = mine > 0u ? mine : 1u; nx = cnt > 0u ? cnt : 1u;
}

__device__ __forceinline__ void xcd_barrier(const XcdBarrier& b) {
    asm volatile("s_waitcnt vmcnt(0)" ::: "memory");
    __syncthreads();
    if (threadIdx.x == 0) {
        unsigned* bar = b.bar;
        __builtin_amdgcn_s_waitcnt(0);
        unsigned nloc = b.st[0], nx = b.st[1];
        if (nloc == 0u) { xcd_barrier_complete(bar, b.x, nloc, nx); b.st[0] = nloc; b.st[1] = nx; }
        const unsigned old = xb_add(&bar[XB_XSUB(b.x)], 1u);
        const unsigned gen = old / nloc;
        if (old + 1u == (gen + 1u) * nloc) {
            __builtin_amdgcn_fence(__ATOMIC_RELEASE, "agent");
            asm volatile("s_waitcnt vmcnt(0)" ::: "memory");
            const unsigned og = xb_add(&bar[XB_TOP], 1u);
            const unsigned tg = og / nx;
            if (og + 1u == (tg + 1u) * nx) xb_add(&bar[XB_TOPGEN], 1u);
            else XB_SPIN(xb_ld(&bar[XB_TOPGEN]) == tg, bar);
            __builtin_amdgcn_fence(__ATOMIC_ACQUIRE, "agent");
            xb_add(&bar[XB_XGEN(b.x)], 1u);
            asm volatile("s_waitcnt vmcnt(0)" ::: "memory");
        } else {
            XB_SPIN(xb_ld(&bar[XB_XGEN(b.x)]) == gen, bar);
            __builtin_amdgcn_fence(__ATOMIC_ACQUIRE, "agent");
            asm volatile("s_waitcnt vmcnt(0)" ::: "memory");
        }
    }
    __syncthreads();
}


#ifndef FFT_HD
#define FFT_HD __device__ __forceinline__
#define FFT_LDS LAS
#endif
constexpr int FFT_WORDS = 4096 + 1024 + 256;
FFT_HD int fidx(int i) { return i + 4 * (i >> 4) + 16 * (i >> 8); }

template <bool INV> FFT_HD void dft4(float& ar, float& ai, float& br, float& bi, float& cr, float& ci, float& dr, float& di) {
    const float s0r = ar + cr, s0i = ai + ci, s1r = ar - cr, s1i = ai - ci;
    const float s2r = br + dr, s2i = bi + di, s3r = br - dr, s3i = bi - di;
    ar = s0r + s2r; ai = s0i + s2i;
    cr = s0r - s2r; ci = s0i - s2i;
    if (!INV) { br = s1r + s3i; bi = s1i - s3r; dr = s1r - s3i; di = s1i + s3r; }
    else      { br = s1r - s3i; bi = s1i + s3r; dr = s1r + s3i; di = s1i - s3r; }
}
template <bool INV> FFT_HD void dft16(float (&xr)[16], float (&xi)[16]) {
#pragma unroll
    for (int n0 = 0; n0 < 4; ++n0) dft4<INV>(xr[n0], xi[n0], xr[n0 + 4], xi[n0 + 4], xr[n0 + 8], xi[n0 + 8], xr[n0 + 12], xi[n0 + 12]);
    constexpr float C1 = 0.9238795325112867f, S1 = 0.3826834323650898f, C2 = 0.7071067811865476f;
    const float tc[10] = {1.f, C1, C2, S1, 0.f, -S1, -C2, -C1, -1.f, -C1};
    const float ts[10] = {0.f, S1, C2, C1, 1.f, C1, C2, S1, 0.f, -S1};
#pragma unroll
    for (int n0 = 1; n0 < 4; ++n0)
#pragma unroll
        for (int k0 = 1; k0 < 4; ++k0) { const int m = n0 * k0; const float wr = tc[m], wi = INV ? ts[m] : -ts[m];
            const int id = n0 + 4 * k0; const float r = xr[id] * wr - xi[id] * wi, i = xr[id] * wi + xi[id] * wr; xr[id] = r; xi[id] = i; }
#pragma unroll
    for (int k0 = 0; k0 < 4; ++k0) dft4<INV>(xr[4 * k0], xi[4 * k0], xr[4 * k0 + 1], xi[4 * k0 + 1], xr[4 * k0 + 2], xi[4 * k0 + 2], xr[4 * k0 + 3], xi[4 * k0 + 3]);
#pragma unroll
    for (int a = 0; a < 4; ++a)
#pragma unroll
        for (int b = a + 1; b < 4; ++b) { float t = xr[4 * a + b]; xr[4 * a + b] = xr[4 * b + a]; xr[4 * b + a] = t; t = xi[4 * a + b]; xi[4 * a + b] = xi[4 * b + a]; xi[4 * b + a] = t; }
}
template <bool INV> FFT_HD void twiddle16(float (&xr)[16], float (&xi)[16], int j, int n) {
    float s, c;
#ifdef __HIP_DEVICE_COMPILE__
    asm volatile("" : "+v"(j));
    sincospif(2.0f * (float)j / (float)n, &s, &c);
#else
    s = (float)sin(2.0 * 3.14159265358979323846 * j / n); c = (float)cos(2.0 * 3.14159265358979323846 * j / n);
#endif
    const float wr = c, wi = INV ? s : -s;
    float pr = wr, pi = wi;
#pragma unroll
    for (int k = 1; k < 16; ++k) {
        const float r = xr[k] * pr - xi[k] * pi, i = xr[k] * pi + xi[k] * pr; xr[k] = r; xi[k] = i;
        const float nr = pr * wr - pi * wi, ni = pr * wi + pi * wr; pr = nr; pi = ni;
    }
}
FFT_HD void fft_store_s256(FFT_LDS float* re, FFT_LDS float* im, int g, const float (&xr)[16], const float (&xi)[16]) {
    const int a0 = fidx(g);
#pragma unroll
    for (int k = 0; k < 16; ++k) { re[a0 + 336 * k] = xr[k]; im[a0 + 336 * k] = xi[k]; }
}
FFT_HD void fft_load_s256(const FFT_LDS float* re, const FFT_LDS float* im, int g, float (&xr)[16], float (&xi)[16]) {
    const int a0 = fidx(g);
#pragma unroll
    for (int k = 0; k < 16; ++k) { xr[k] = re[a0 + 336 * k]; xi[k] = im[a0 + 336 * k]; }
}
FFT_HD void fft_load_s16(const FFT_LDS float* re, const FFT_LDS float* im, int g, float (&xr)[16], float (&xi)[16]) {
    const int a0 = fidx((g >> 4) * 256 + (g & 15));
#pragma unroll
    for (int k = 0; k < 16; ++k) { xr[k] = re[a0 + 20 * k]; xi[k] = im[a0 + 20 * k]; }
}
FFT_HD void fft_store_s16(FFT_LDS float* re, FFT_LDS float* im, int g, const float (&xr)[16], const float (&xi)[16]) {
    const int a0 = fidx((g >> 4) * 256 + (g & 15));
#pragma unroll
    for (int k = 0; k < 16; ++k) { re[a0 + 20 * k] = xr[k]; im[a0 + 20 * k] = xi[k]; }
}
FFT_HD void fft_load_s1(const FFT_LDS float* re, const FFT_LDS float* im, int g, float (&xr)[16], float (&xi)[16]) {
    const int a = fidx(g * 16);
#pragma unroll
    for (int k = 0; k < 16; ++k) { xr[k] = re[a + k]; xi[k] = im[a + k]; }
}
FFT_HD void fft_store_s1(FFT_LDS float* re, FFT_LDS float* im, int g, const float (&xr)[16], const float (&xi)[16]) {
    const int a = fidx(g * 16);
#pragma unroll
    for (int k = 0; k < 16; ++k) { re[a + k] = xr[k]; im[a + k] = xi[k]; }
}


struct KArgs { const float* in[28]; float* out; unsigned char* ws; int ph_lo, ph_hi; };
struct Ctx {
    const KArgs& A; float* out; unsigned char* ws; LAS unsigned char* lds;
    int tid, lane, wave, G, gw, NGW;
};

__device__ __forceinline__ void transpose_item(const float* __restrict__ W, int N, int k0, int n0, bf16* __restrict__ dst, LAS float* scr, int lane) {
#pragma unroll 8
    for (int i = 0; i < 32; ++i) { const int kk = 2 * i + (lane >> 5); scr[kk * 33 + (lane & 31)] = W[(size_t)(k0 + kk) * N + n0 + (lane & 31)]; }
    LDS_WAIT(); asm volatile("" ::: "memory");
    const int c = lane & 7;
#pragma unroll
    for (int j = 0; j < 4; ++j) { const int n = (lane >> 3) + 8 * j; const LAS float* s = scr + (8 * c) * 33 + n;
        v4u o; o.x = pk2(s[0 * 33], s[1 * 33]); o.y = pk2(s[2 * 33], s[3 * 33]); o.z = pk2(s[4 * 33], s[5 * 33]); o.w = pk2(s[6 * 33], s[7 * 33]);
        *(v4u*)(dst + (size_t)n * 2048 + k0 + 8 * c) = o; }
    LDS_WAIT(); asm volatile("" ::: "memory");
}

__device__ __forceinline__ void phase0(const Ctx& C) {
    unsigned char* ws = C.ws;
    {
        const f32x4* x4 = (const f32x4*)C.A.in[0]; v4u* xb = (v4u*)(ws + (size_t)XB_T0 * MiB);
        const size_t n8 = (size_t)T * D / 8;
        for (size_t i = (size_t)blockIdx.x * NTHREADS + C.tid; i < n8; i += (size_t)C.G * NTHREADS) {
            const f32x4 a = x4[2 * i], b = x4[2 * i + 1]; v4u o; o.x = pk2(a.x, a.y); o.y = pk2(a.z, a.w); o.z = pk2(b.x, b.y); o.w = pk2(b.z, b.w); xb[i] = o; }
    }
    {
        LAS float* scr = (LAS float*)(C.lds + C.wave * 8448);
        constexpr int I_IN = 32 * 225, I_OUT = 32 * 64, I_GU = MOE_PRECONVERT ? NE * 32 * 128 : 0, I_DN = MOE_PRECONVERT ? NE * 32 * 64 : 0, NITEMS = I_IN + I_OUT + I_GU + I_DN;
        bf16* win_t = (bf16*)(ws + (size_t)WIN_T0 * MiB); bf16* wout_t = (bf16*)(ws + (size_t)WOUT_T0 * MiB);
        bf16* wgu_t = (bf16*)(ws + (size_t)WGU_T0 * MiB); bf16* wdn_t = (bf16*)(ws + (size_t)WDN_T0 * MiB);
        for (int it = C.gw; it < NITEMS; it += C.NGW) {
            int r = it;
            if (r < I_IN) { const int kb = r / 225, nb = r % 225; transpose_item(C.A.in[1], DIN, 64 * kb, 32 * nb, win_t + (size_t)(32 * nb) * 2048, scr, C.lane); continue; } r -= I_IN;
            if (r < I_OUT) { const int kb = r / 64, nb = r % 64; transpose_item(C.A.in[16], D, 64 * kb, 32 * nb, wout_t + (size_t)(32 * nb) * 2048, scr, C.lane); continue; } r -= I_OUT;
            if (r < I_GU) { const int e = r / 4096, rr = r % 4096, kb = rr / 128, nb = rr % 128, n0 = 32 * nb;
                const int drow = (n0 < 2048) ? ((n0 >> 7) * 256 + (n0 & 127)) : ((((n0 - 2048) >> 7) * 256) + 128 + ((n0 - 2048) & 127));
                transpose_item(C.A.in[22] + (size_t)e * 2048 * 4096, 4096, 64 * kb, n0, wgu_t + ((size_t)e * 4096 + drow) * 2048, scr, C.lane); continue; } r -= I_GU;
            { const int e = r / 2048, rr = r % 2048, kb = rr / 64, nb = rr % 64;
                transpose_item(C.A.in[24] + (size_t)e * 2048 * 2048, 2048, 64 * kb, 32 * nb, wdn_t + ((size_t)e * 2048 + 32 * nb) * 2048, scr, C.lane); }
        }
    }
    __syncthreads();
    {
        const float* w1 = C.A.in[5]; const float* b1 = C.A.in[6]; const float* w2 = C.A.in[7]; const float* b2 = C.A.in[8]; const float* freq = C.A.in[10];
        LAS float* h1s = (LAS float*)C.lds;
        const int tt = C.tid >> 6, j = C.tid & 63;
        for (int tb = blockIdx.x; tb < SEQ / 8; tb += C.G) {
            const int t = tb * 8 + tt;
            const float zt = (float)t / 2047.0f, wt = 6.283185307179586f * (float)t / 2048.0f;
            float acc = b1[j] + zt * w1[j];
            for (int i = 0; i < 16; ++i) { const float fb = 1e-4f + (float)i * ((15.0f - 1e-4f) / 15.0f); const float arg = fb * wt;
                acc += cosf(arg) * w1[(1 + i) * 64 + j] - sinf(arg) * w1[(17 + i) * 64 + j]; }
            h1s[tt * 64 + j] = sinf(freq[j] * acc);
            __syncthreads();
            float a2 = b2[j];
            for (int i = 0; i < 64; ++i) a2 += h1s[tt * 64 + i] * w2[i * 64 + j];
            { const float hv = sinf(freq[64 + j] * a2); const unsigned hi = f2bf(hv); const float lo = hv - bflo(hi);
              bf16* hp = (bf16*)(ws + WS_H2P) + (size_t)t * 256; hp[j] = (bf16)hi; hp[64 + j] = (bf16)hi; hp[128 + j] = (bf16)f2bf(lo); hp[192 + j] = 0; }
            __syncthreads();
        }
        const float* w3 = C.A.in[9]; bf16* wp = (bf16*)(ws + WS_W3P);
        for (int i = blockIdx.x * NTHREADS + C.tid; i < 4096 * 8; i += C.G * NTHREADS) {
            const int col = i & 4095, jo = i >> 12; float wv[8]; unsigned hi[8], lo[8];
#pragma unroll
            for (int k = 0; k < 8; ++k) { wv[k] = w3[(size_t)(jo * 8 + k) * 4096 + col]; hi[k] = f2bf(wv[k]); lo[k] = f2bf(wv[k] - bflo(hi[k])); }
            v4u vh, vl; vh.x = hi[0] | (hi[1] << 16); vh.y = hi[2] | (hi[3] << 16); vh.z = hi[4] | (hi[5] << 16); vh.w = hi[6] | (hi[7] << 16);
            vl.x = lo[0] | (lo[1] << 16); vl.y = lo[2] | (lo[3] << 16); vl.z = lo[4] | (lo[5] << 16); vl.w = lo[6] | (lo[7] << 16);
            bf16* row = wp + (size_t)col * 256 + jo * 8;
            *(v4u*)row = vh; *(v4u*)(row + 64) = vl; *(v4u*)(row + 128) = vh; *(v4u*)(row + 192) = (v4u){0u, 0u, 0u, 0u};
        }
    }
}

#ifndef NAIVE_ML
#define NAIVE_ML 0
#endif
constexpr int N1_SW_TILES = 16, N1_SW = N1_SW_TILES * 32;
constexpr int N1_NORM_TILES = NAIVE_ML ? 17 : 13, N1_NORM = N1_NORM_TILES * 32, N1_UNITS = N1_SW + N1_NORM;
struct Gemm1Order {
    int G, c;
    __device__ __forceinline__ bool next(int i, pg8::Unit& u) const {
        const int L = i * G + c; if (L >= N1_UNITS) return false;
        int w; { const int q = N1_UNITS / 8, r = N1_UNITS % 8, xcd = L % 8, off = L / 8; w = (xcd < r ? xcd * (q + 1) : r * (q + 1) + (xcd - r) * q) + off; }
        if (w < N1_SW) { const int nig = 8 * 32, gid = w / nig, wi = w % nig, mi = gid * 8 + (wi % 8), ni = wi / 8;
            u.pm = WIN_T0 + (mi < 12 ? mi : 8 + mi); u.pn = XB_T0 + ni; }
        else { w -= N1_SW; const int nig = 8 * N1_NORM_TILES, gid = w / nig, wi = w % nig, mi = gid * 8 + (wi % 8), ni = wi / 8;
            int wt;
            if (NAIVE_ML) wt = (ni < 16) ? 12 + ni : 28; else wt = (ni < 8) ? 12 + ni : 16 + ni;
            u.pm = XB_T0 + mi; u.pn = WIN_T0 + wt; }
        return true;
    }
    __device__ __forceinline__ void a_ready(const pg8::Unit&) const {}
    __device__ __forceinline__ void done(const pg8::Unit&) const {}
};
struct Epi1 {
    static constexpr bool PERM = true, AFTER_DRAIN = false;
    const float* b_in; bf16* hyt; bf16* qkraw; bf16* vb; bf16* ob; float* gates;
    __device__ __forceinline__ void operator()(const pg8::f32x4 (&acc)[2][2][4][2], const pg8::Unit& u, int wr, int wc, int fr, int fq) const {
        using pg8::cvt_pk_bf16;
        if (u.pm >= WIN_T0) {
            const int wt = u.pm - WIN_T0, tt = u.pn - XB_T0;
            const int col0 = tt * 256 + wc * 32 + 8 * fq;
#pragma unroll
            for (int ai = 0; ai < 2; ++ai)
#pragma unroll
                for (int m = 0; m < 4; ++m) {
                    const int ch = wt * 256 + ai * 128 + wr * 64 + m * 16 + fr; const float bv = b_in[ch];
                    const int drow = ch < 3072 ? ch : ch - 2048;
                    bf16* rowp = hyt + (size_t)drow * T + col0;
#pragma unroll
                    for (int bj = 0; bj < 2; ++bj) { const pg8::f32x4 v0 = acc[ai][bj][m][0] + bv, v1 = acc[ai][bj][m][1] + bv;
                        v4u w; w.x = cvt_pk_bf16(v0[0], v0[1]); w.y = cvt_pk_bf16(v0[2], v0[3]); w.z = cvt_pk_bf16(v1[0], v1[1]); w.w = cvt_pk_bf16(v1[2], v1[3]);
                        *(v4u*)(rowp + bj * 128) = w; }
                }
        } else {
            const int tt = u.pm - XB_T0, wt = u.pn - WIN_T0;
            const int chb = wt * 256 + wc * 32 + 8 * fq;
            pg8::f32x4 bv[2][2];
#pragma unroll
            for (int bj = 0; bj < 2; ++bj)
#pragma unroll
                for (int n = 0; n < 2; ++n) { const int c0 = chb + bj * 128 + 4 * n; bv[bj][n] = (c0 < DIN) ? *(const pg8::f32x4*)(b_in + c0) : (pg8::f32x4){0.f, 0.f, 0.f, 0.f}; }
            if (wt == 28) {
                if (wc == 0) {
#pragma unroll
                    for (int ai = 0; ai < 2; ++ai)
#pragma unroll
                        for (int m = 0; m < 4; ++m) { const int tok = tt * 256 + ai * 128 + wr * 64 + m * 16 + fr;
                            float* gp = gates + (size_t)tok * 32 + 8 * fq;
                            *(pg8::f32x4*)(gp) = acc[ai][0][m][0] + bv[0][0]; *(pg8::f32x4*)(gp + 4) = acc[ai][0][m][1] + bv[0][1]; }
                }
            } else {
#define EPI1_STORE(base, ld, cb) do { _Pragma("unroll") for (int ai = 0; ai < 2; ++ai) _Pragma("unroll") for (int m = 0; m < 4; ++m) { const int tok = tt * 256 + ai * 128 + wr * 64 + m * 16 + fr; \
                    bf16* rowp = (base) + (size_t)tok * (ld) + (cb); \
                    _Pragma("unroll") for (int bj = 0; bj < 2; ++bj) { const pg8::f32x4 v0 = acc[ai][bj][m][0] + bv[bj][0], v1 = acc[ai][bj][m][1] + bv[bj][1]; \
                        v4u w; w.x = cvt_pk_bf16(v0[0], v0[1]); w.y = cvt_pk_bf16(v0[2], v0[3]); w.z = cvt_pk_bf16(v1[0], v1[1]); w.w = cvt_pk_bf16(v1[2], v1[3]); \
                        *(v4u*)(rowp + bj * 128) = w; } } } while (0)
                if (wt < 20) EPI1_STORE(qkraw, 2048, chb - 3072);
                else if (wt < 24) EPI1_STORE(vb, 1024, chb - 5120);
                else EPI1_STORE(ob, 1024, chb - 6144);
#undef EPI1_STORE
            }
        }
    }
};

struct KtOrder {
    int G, c;
    __device__ __forceinline__ bool next(int i, pg8::Unit& u) const { const int cc = G - 1 - c; if (i != 0 || cc >= 128) return false; u.pm = cc >> 3; u.pn = cc & 7; return true; }
    __device__ __forceinline__ void a_ready(const pg8::Unit&) const {}
    __device__ __forceinline__ void done(const pg8::Unit&) const {}
};
struct EpiKT {
    static constexpr bool PERM = true, AFTER_DRAIN = false;
    float* kt;
    __device__ __forceinline__ void operator()(const pg8::f32x4 (&acc)[2][2][4][2], const pg8::Unit& u, int wr, int wc, int fr, int fq) const {
        const float da = -3.0701134573253945f, db = -15.350567286626973f;
#pragma unroll
        for (int ai = 0; ai < 2; ++ai)
#pragma unroll
            for (int m = 0; m < 4; ++m) {
                const int col = u.pm * 256 + ai * 128 + wr * 64 + m * 16 + fr, o = col >> 11, dir = (col >> 10) & 1, c = col & 1023;
                const float delta = fabsf(da + (float)c * ((db - da) / 1023.0f)) * (1.0f / 2047.0f);
                float* kr = kt + ((size_t)o * 1024 + c) * 4096;
#pragma unroll
                for (int bj = 0; bj < 2; ++bj) {
                    const int t0 = u.pn * 256 + bj * 128 + wc * 32 + 8 * fq; float v[8];
#pragma unroll
                    for (int n = 0; n < 2; ++n)
#pragma unroll
                        for (int e = 0; e < 4; ++e) v[4 * n + e] = acc[ai][bj][m][n][e] * expf(-(float)(t0 + 4 * n + e) * delta);
                    if (dir == 0) { *(pg8::f32x4*)(kr + t0) = (pg8::f32x4){v[0], v[1], v[2], v[3]}; *(pg8::f32x4*)(kr + t0 + 4) = (pg8::f32x4){v[4], v[5], v[6], v[7]}; }
                    else {
#pragma unroll
                        for (int e = 0; e < 8; ++e) if (t0 + e >= 1) kr[4096 - t0 - e] = v[e]; }
                }
            }
    }
};

template <int OP> __device__ __forceinline__ LAS float* block_scan_2048(LAS float* x, LAS float* y, int tid) {
    LAS float* src = x; LAS float* dst = y;
    for (int off = 1; off < 2048; off <<= 1) {
#pragma unroll
        for (int i = 0; i < 4; ++i) { const int idx = tid + 512 * i; float v = src[idx]; if (idx >= off) { const float w = src[idx - off]; v = OP ? fmaxf(v, w) : v + w; } dst[idx] = v; }
        __syncthreads();
        LAS float* t = src; src = dst; dst = t;
    }
    return src;
}
__device__ __forceinline__ float logsigmoidf(float x) { return fminf(x, 0.f) - log1pf(expf(-fabsf(x))); }

__device__ __forceinline__ void phase2(const Ctx& C) {
    unsigned char* ws = C.ws;
    {
        const float* KT = (const float*)(ws + WS_KT); f32x4* KF = (f32x4*)(ws + WS_KF);
        const int half = C.tid >> 8, g = C.tid & 255;
        LAS float* re = (LAS float*)(C.lds + half * (2 * FFT_WORDS * 4)); LAS float* im = re + FFT_WORDS;
        LAS float* red = (LAS float*)(C.lds + 4 * FFT_WORDS * 4);
        for (int u = blockIdx.x; u < 1024; u += C.G) {
            const int o = u >> 9, c0 = (u & 511) * 2, c = c0 + half;
            __syncthreads();
            const float* kcol = KT + ((size_t)o * 1024 + c) * 4096;
            float xr[16], xi[16]; float asum = 0.f;
#pragma unroll
            for (int m = 0; m < 16; ++m) { const int idx = g + 256 * m; const float val = (idx == 2048) ? 0.f : kcol[idx]; xr[m] = val; xi[m] = 0.f; asum += fabsf(val); }
            asum = wave_sum(asum);
            if (C.lane == 0) red[C.wave] = asum;
            __syncthreads();
            const float tot = red[half * 4] + red[half * 4 + 1] + red[half * 4 + 2] + red[half * 4 + 3];
            const float scl = 1.0f / (tot * 4096.0f);
#pragma unroll
            for (int m = 0; m < 16; ++m) xr[m] *= scl;
            dft16<false>(xr, xi); twiddle16<false>(xr, xi, g, 4096); fft_store_s256(re, im, g, xr, xi);
            __syncthreads();
            fft_load_s16(re, im, g, xr, xi); dft16<false>(xr, xi); twiddle16<false>(xr, xi, g & 15, 256); fft_store_s16(re, im, g, xr, xi);
            __syncthreads();
            fft_load_s1(re, im, g, xr, xi); dft16<false>(xr, xi);
            f32x4* dst = KF + ((size_t)(o * 1024 + c) * 4096 + g * 16) / 2;
#pragma unroll
            for (int k = 0; k < 8; ++k) dst[k] = (f32x4){xr[2 * k], xi[2 * k], xr[2 * k + 1], xi[2 * k + 1]};
        }
        __syncthreads();
    }
    {
        const bf16* raw = (const bf16*)(ws + WS_QKRAW); bf16* qkc = (bf16*)(ws + WS_QKC); const float* cw = C.A.in[13]; const float* cb = C.A.in[14];
        for (int g = blockIdx.x * NTHREADS + C.tid; g < T * 256; g += C.G * NTHREADS) {
            const int tok = g >> 8, ch0 = (g & 255) * 8, tl = tok & (SEQ - 1);
            const v4u cur = *(const v4u*)(raw + (size_t)tok * 2048 + ch0);
            v4u prv = (v4u){0u, 0u, 0u, 0u}, nxt = (v4u){0u, 0u, 0u, 0u};
            if (tl > 0) prv = *(const v4u*)(raw + (size_t)(tok - 1) * 2048 + ch0);
            if (tl < SEQ - 1) nxt = *(const v4u*)(raw + (size_t)(tok + 1) * 2048 + ch0);
            const float sc = ch0 >= 1024 ? 0.08838834764831845f : 1.0f;
            float o[8];
#pragma unroll
            for (int i = 0; i < 8; ++i) {
                const unsigned pw = prv[i >> 1], cwd = cur[i >> 1], nw = nxt[i >> 1];
                const float p = (i & 1) ? bfhi(pw) : bflo(pw), q = (i & 1) ? bfhi(cwd) : bflo(cwd), n = (i & 1) ? bfhi(nw) : bflo(nw);
                const int ch = ch0 + i;
                const float v = cw[ch] * p + cw[2048 + ch] * q + cw[4096 + ch] * n + cb[ch];
                o[i] = sc * v / (1.0f + expf(-v));
            }
            v4u w; w.x = pk2(o[0], o[1]); w.y = pk2(o[2], o[3]); w.z = pk2(o[4], o[5]); w.w = pk2(o[6], o[7]);
            *(v4u*)(qkc + (size_t)tok * 2048 + ch0) = w;
        }
    }
    {
        const float* gates = (const float*)(ws + WS_GATES); float* GA = (float*)(ws + WS_GA); float* GP = (float*)(ws + WS_GP); float* GE = (float*)(ws + WS_GE);
        LAS float* s0 = (LAS float*)(C.lds + 8192); LAS float* s1 = s0 + 2048; LAS float* s2 = s1 + 2048; LAS float* s3 = s2 + 2048;
        for (int bhd = blockIdx.x; bhd < 64; bhd += C.G) {
            const int b = bhd >> 4, h = (bhd >> 1) & 7, dir = bhd & 1, col_i = dir * 16 + h, col_f = col_i + 8;
            float ig[4], lf[4];
            __syncthreads();
#pragma unroll
            for (int i = 0; i < 4; ++i) { const int t = C.tid + 512 * i; const float* gr = gates + (size_t)(b * SEQ + t) * 32; ig[i] = gr[col_i]; lf[i] = logsigmoidf(gr[col_f]); s0[t] = lf[i]; }
            __syncthreads();
            LAS float* Fc = block_scan_2048<0>(s0, s1, C.tid);
            float a[4], Fv[4], Gx[4];
#pragma unroll
            for (int i = 0; i < 4; ++i) { const int t = C.tid + 512 * i; Fv[i] = Fc[t]; Gx[i] = Fv[i] - lf[i]; a[i] = dir ? ig[i] + Gx[i] : ig[i] - Fv[i]; s2[dir ? 2047 - t : t] = a[i]; }
            __syncthreads();
            LAS float* Pm = block_scan_2048<1>(s2, s3, C.tid);
#pragma unroll
            for (int i = 0; i < 4; ++i) { const int t = C.tid + 512 * i; const float pm = Pm[dir ? 2047 - t : t];
                const float mt = dir ? pm - Gx[i] : Fv[i] + pm;
                GA[bhd * 2048 + t] = a[i]; GP[bhd * 2048 + t] = pm; GE[bhd * 2048 + t] = expf(-mt); }
        }
        __syncthreads();
    }
}

__device__ __forceinline__ void hyena_naive(const Ctx& C) {
    unsigned char* ws = C.ws;
    const bf16* hyt = (const bf16*)(ws + WS_HYT); const float* KT = (const float*)(ws + WS_KT); float* Z = (float*)(ws + WS_Z);
    const float* cw = C.A.in[3]; const float* cb = C.A.in[4]; const float* skip = C.A.in[11];
    LAS float* sv = (LAS float*)C.lds; LAS float* sk = sv + 2048;
    for (int u = blockIdx.x; u < NB * DHY; u += C.G) {
        const int b = u >> 10, c = u & 1023;
        float v[4], x1[4], x2[4];
#pragma unroll
        for (int part = 0; part < 3; ++part) {
            const int ch = part * 1024 + c; const bf16* row = hyt + (size_t)ch * T + b * SEQ;
            const float w0 = cw[ch], w1 = cw[3072 + ch], w2 = cw[6144 + ch], bb = cb[ch];
#pragma unroll
            for (int i = 0; i < 4; ++i) { const int t = C.tid + 512 * i;
                const float p = t > 0 ? bf2f(row[t - 1]) : 0.f, q = bf2f(row[t]), n = t < SEQ - 1 ? bf2f(row[t + 1]) : 0.f;
                const float r = w0 * p + w1 * q + w2 * n + bb;
                if (part == 0) v[i] = r; else if (part == 1) x1[i] = r; else x2[i] = r; }
        }
        __syncthreads();
#pragma unroll
        for (int i = 0; i < 4; ++i) sv[C.tid + 512 * i] = v[i];
#pragma unroll
        for (int i = 0; i < 8; ++i) sk[C.tid + 512 * i] = KT[(size_t)c * 4096 + C.tid + 512 * i];
        __syncthreads();
        float acc[4] = {0.f, 0.f, 0.f, 0.f};
        for (int s = 0; s < SEQ; ++s) { const float vv = sv[s];
#pragma unroll
            for (int i = 0; i < 4; ++i) acc[i] += sk[(C.tid + 512 * i - s) & 4095] * vv; }
        float z1[4]; const float sk0 = skip[c], sk1 = skip[1024 + c];
#pragma unroll
        for (int i = 0; i < 4; ++i) z1[i] = x1[i] * (acc[i] + sk0 * v[i]);
        __syncthreads();
#pragma unroll
        for (int i = 0; i < 4; ++i) sv[C.tid + 512 * i] = z1[i];
#pragma unroll
        for (int i = 0; i < 8; ++i) sk[C.tid + 512 * i] = KT[(size_t)(1024 + c) * 4096 + C.tid + 512 * i];
        __syncthreads();
#pragma unroll
        for (int i = 0; i < 4; ++i) acc[i] = 0.f;
        for (int s = 0; s < SEQ; ++s) { const float vv = sv[s];
#pragma unroll
            for (int i = 0; i < 4; ++i) acc[i] += sk[(C.tid + 512 * i - s) & 4095] * vv; }
#pragma unroll
        for (int i = 0; i < 4; ++i) Z[(size_t)(b * SEQ + C.tid + 512 * i) * 1024 + c] = x2[i] * (acc[i] + sk1 * z1[i]);
    }
    __syncthreads();
}

__device__ __forceinline__ void hyena_conv_once(LAS float* re, LAS float* im, int g, float (&xr)[16], float (&xi)[16], const f32x4* __restrict__ kf) {
    __syncthreads();
    dft16<false>(xr, xi); twiddle16<false>(xr, xi, g, 4096); fft_store_s256(re, im, g, xr, xi);
    __syncthreads();
    fft_load_s16(re, im, g, xr, xi); dft16<false>(xr, xi); twiddle16<false>(xr, xi, g & 15, 256); fft_store_s16(re, im, g, xr, xi);
    __syncthreads();
    fft_load_s1(re, im, g, xr, xi); dft16<false>(xr, xi);
#pragma unroll
    for (int k = 0; k < 8; ++k) { const f32x4 w = kf[g * 8 + k];
        const float r0 = xr[2 * k] * w.x - xi[2 * k] * w.y, i0 = xr[2 * k] * w.y + xi[2 * k] * w.x;
        const float r1 = xr[2 * k + 1] * w.z - xi[2 * k + 1] * w.w, i1 = xr[2 * k + 1] * w.w + xi[2 * k + 1] * w.z;
        xr[2 * k] = r0; xi[2 * k] = i0; xr[2 * k + 1] = r1; xi[2 * k + 1] = i1; }
    dft16<true>(xr, xi); fft_store_s1(re, im, g, xr, xi);
    __syncthreads();
    fft_load_s16(re, im, g, xr, xi); twiddle16<true>(xr, xi, g & 15, 256); dft16<true>(xr, xi); fft_store_s16(re, im, g, xr, xi);
    __syncthreads();
    fft_load_s256(re, im, g, xr, xi); twiddle16<true>(xr, xi, g, 4096); dft16<true>(xr, xi);
}
__device__ __forceinline__ void hyena_fft(const Ctx& C) {
    unsigned char* ws = C.ws;
    const bf16* hyt = (const bf16*)(ws + WS_HYT); const f32x4* KF = (const f32x4*)(ws + WS_KF); float* ZT = (float*)(ws + WS_ZT);
    const float* cw = C.A.in[3]; const float* cb = C.A.in[4]; const float* skip = C.A.in[11];
    const int half = C.tid >> 8, g = C.tid & 255;
    LAS float* re = (LAS float*)(C.lds + half * (2 * FFT_WORDS * 4)); LAS float* im = re + FFT_WORDS;
    for (int c = blockIdx.x; c < DHY; c += C.G) {
        float vr[8], vi[8], ar[8], ai[8], br[8], bi[8];
#pragma unroll
        for (int part = 0; part < 3; ++part) {
            const int ch = part * 1024 + c; const float w0 = cw[ch], w1 = cw[3072 + ch], w2 = cw[6144 + ch], bb = cb[ch];
#pragma unroll
            for (int bq = 0; bq < 2; ++bq) { const bf16* row = hyt + (size_t)ch * T + (2 * half + bq) * SEQ;
#pragma unroll
                for (int m = 0; m < 8; ++m) { const int t = g + 256 * m;
                    const float p = t > 0 ? bf2f(row[t - 1]) : 0.f, q = bf2f(row[t]), n = t < SEQ - 1 ? bf2f(row[t + 1]) : 0.f;
                    const float r = w0 * p + w1 * q + w2 * n + bb;
                    if (part == 0) { if (bq == 0) vr[m] = r; else vi[m] = r; } else if (part == 1) { if (bq == 0) ar[m] = r; else ai[m] = r; } else { if (bq == 0) br[m] = r; else bi[m] = r; } }
                asm volatile("" ::: "memory"); }
        }
        const float sk0 = skip[c], sk1 = skip[1024 + c];
        float xr[16], xi[16];
#pragma unroll
        for (int m = 0; m < 8; ++m) { xr[m] = vr[m]; xi[m] = vi[m]; xr[m + 8] = 0.f; xi[m + 8] = 0.f; }
        hyena_conv_once(re, im, g, xr, xi, KF + (size_t)c * 2048);
#pragma unroll
        for (int m = 0; m < 8; ++m) { vr[m] = ar[m] * (xr[m] + sk0 * vr[m]); vi[m] = ai[m] * (xi[m] + sk0 * vi[m]); xr[m] = vr[m]; xi[m] = vi[m]; xr[m + 8] = 0.f; xi[m + 8] = 0.f; }
        hyena_conv_once(re, im, g, xr, xi, KF + (size_t)(1024 + c) * 2048);
        float* zr = ZT + (size_t)c * T + (2 * half) * SEQ;
#pragma unroll
        for (int m = 0; m < 8; ++m) { const int t = g + 256 * m; zr[t] = br[m] * (xr[m] + sk1 * vr[m]); zr[SEQ + t] = bi[m] * (xi[m] + sk1 * vi[m]); }
    }
    __syncthreads();
}

__device__ __forceinline__ void mlstm_naive(const Ctx& C) {
    unsigned char* ws = C.ws;
    const bf16* qkc = (const bf16*)(ws + WS_QKC); const bf16* vb = (const bf16*)(ws + WS_VB);
    const float* GA = (const float*)(ws + WS_GA); const float* GP = (const float*)(ws + WS_GP); const float* GE = (const float*)(ws + WS_GE);
    float* HML = (float*)(ws + WS_HML);
    LAS float* qs = (LAS float*)(C.lds + C.wave * 1024); LAS float* ps = qs + 128;
    const int lane = C.lane;
    for (int u = blockIdx.x; u < 64 * 32; u += C.G) {
        const int bhd = u >> 5, qb = u & 31, b = bhd >> 4, h = (bhd >> 1) & 7, dir = bhd & 1;
        for (int qi = 0; qi < 8; ++qi) {
            const int t = qb * 64 + C.wave * 8 + qi;
            { const unsigned w = *(const unsigned*)(qkc + (size_t)(b * SEQ + t) * 2048 + h * 128 + 2 * lane); qs[2 * lane] = bflo(w); qs[2 * lane + 1] = bfhi(w); }
            __builtin_amdgcn_wave_barrier(); LDS_WAIT();
            const float pmt = GP[bhd * 2048 + t];
            const int c_lo = dir ? (t >> 6) : 0, c_hi = dir ? 31 : (t >> 6);
            float acc0 = 0.f, acc1 = 0.f, den = 0.f;
            for (int cch = c_lo; cch <= c_hi; ++cch) {
                const int s = cch * 64 + lane; const bool valid = dir ? (s >= t) : (s <= t);
                const v4u* kr = (const v4u*)(qkc + (size_t)(b * SEQ + s) * 2048 + 1024 + h * 128);
                float sc = 0.f;
#pragma unroll
                for (int j = 0; j < 16; ++j) { const v4u kk = kr[j];
#pragma unroll
                    for (int e = 0; e < 4; ++e) sc += qs[8 * j + 2 * e] * bflo(kk[e]) + qs[8 * j + 2 * e + 1] * bfhi(kk[e]); }
                const float p = valid ? sc * expf(GA[bhd * 2048 + s] - pmt) : 0.f;
                den += p;
                __builtin_amdgcn_wave_barrier();
                ps[lane] = p;
                __builtin_amdgcn_wave_barrier(); LDS_WAIT();
                const bf16* vr = vb + (size_t)(b * SEQ + cch * 64) * 1024 + h * 128 + 2 * lane;
#pragma unroll 8
                for (int s2 = 0; s2 < 64; ++s2) { const unsigned w = *(const unsigned*)(vr + (size_t)s2 * 1024); const float pv = ps[s2]; acc0 += pv * bflo(w); acc1 += pv * bfhi(w); }
                __builtin_amdgcn_wave_barrier();
            }
            den = wave_sum(den);
            const float scl = 1.0f / fmaxf(fabsf(den), GE[bhd * 2048 + t]);
            *(f32x2*)(HML + ((size_t)dir * T + b * SEQ + t) * 1024 + h * 128 + 2 * lane) = (f32x2){acc0 * scl, acc1 * scl};
            __builtin_amdgcn_wave_barrier();
        }
    }
    __syncthreads();
}

typedef short ml_bf16x8 __attribute__((ext_vector_type(8)));
typedef short ml_s16x4 __attribute__((ext_vector_type(4)));
typedef float ml_f32x16 __attribute__((ext_vector_type(16)));
typedef __bf16 ml_bf2 __attribute__((ext_vector_type(2)));
constexpr int ML_KROW = 272, ML_VROW = 136, ML_KBUF = 64 * ML_KROW, ML_VBUF = 128 * ML_VROW;
__device__ __forceinline__ unsigned ml_pk(float lo, float hi) { const f32x2 v = {lo, hi}; return __builtin_bit_cast(unsigned, __builtin_convertvector(v, ml_bf2)); }
__device__ __forceinline__ void mlstm_mfma(const Ctx& C) {
    unsigned char* ws = C.ws;
    const bf16* qkc = (const bf16*)(ws + WS_QKC); const bf16* vt = (const bf16*)(ws + WS_HYT) + (size_t)3072 * T;
    const float* GA = (const float*)(ws + WS_GA); const float* GP = (const float*)(ws + WS_GP); const float* GE = (const float*)(ws + WS_GE);
    float* HML = (float*)(ws + WS_HML);
    LAS unsigned char* KB = C.lds; LAS unsigned char* VB = C.lds + 2 * ML_KBUF; LAS float* AS = (LAS float*)(C.lds + 2 * ML_KBUF + 2 * ML_VBUF);
    const int w = C.wave, lane = C.lane, r = lane & 31, hh = lane >> 5, tid = C.tid;
    for (int pu = blockIdx.x; pu < 256; pu += C.G) {
        const int bhd = pu >> 2, pq = pu & 3, b = bhd >> 4, h = (bhd >> 1) & 7, dir = bhd & 1;
        __syncthreads();
        for (int i = tid; i < SEQ; i += NTHREADS) AS[i] = GA[bhd * SEQ + i];
        const bf16* kbase = qkc + (size_t)(b * SEQ) * 2048 + 1024 + h * 128;
        const bf16* vbase = vt + (size_t)(h * 128) * T + b * SEQ;
#pragma unroll 1
        for (int hf = 0; hf < 2; ++hf) {
            const int qb = hf ? 7 - pq : pq;
            const int qlo = 256 * qb + 32 * w, tq = qlo + r;
            ml_bf16x8 qf[8];
            { const bf16* qrow = qkc + (size_t)(b * SEQ + tq) * 2048 + h * 128 + 8 * hh;
#pragma unroll
              for (int s = 0; s < 8; ++s) qf[s] = *(const ml_bf16x8*)(qrow + 16 * s); }
            const float pmt = GP[bhd * SEQ + tq];
            ml_f32x16 O[4];
#pragma unroll
            for (int d = 0; d < 4; ++d)
#pragma unroll
                for (int i = 0; i < 16; ++i) O[d][i] = 0.f;
            float den = 0.f;
            const int kt0 = dir ? 4 * qb : 0, kt1 = dir ? 31 : 4 * qb + 3;
            v4u kr0, kr1, vr0, vr1;
#define ML_LOAD(kt) do { const int p0 = tid, p1 = tid + 512; \
                kr0 = *(const v4u*)(kbase + (size_t)(64 * (kt) + (p0 >> 4)) * 2048 + (p0 & 15) * 8); kr1 = *(const v4u*)(kbase + (size_t)(64 * (kt) + (p1 >> 4)) * 2048 + (p1 & 15) * 8); \
                vr0 = *(const v4u*)(vbase + (size_t)(p0 >> 3) * T + 64 * (kt) + (p0 & 7) * 8); vr1 = *(const v4u*)(vbase + (size_t)(p1 >> 3) * T + 64 * (kt) + (p1 & 7) * 8); } while (0)
#define ML_STORE(buf) do { const int p0 = tid, p1 = tid + 512; \
                *(LAS v4u*)(KB + (buf) * ML_KBUF + (p0 >> 4) * ML_KROW + (p0 & 15) * 16) = kr0; *(LAS v4u*)(KB + (buf) * ML_KBUF + (p1 >> 4) * ML_KROW + (p1 & 15) * 16) = kr1; \
                { LAS unsigned char* d0 = VB + (buf) * ML_VBUF + (p0 >> 3) * ML_VROW + (p0 & 7) * 16; *(LAS v2u*)d0 = (v2u){vr0.x, vr0.y}; *(LAS v2u*)(d0 + 8) = (v2u){vr0.z, vr0.w}; } \
                { LAS unsigned char* d1 = VB + (buf) * ML_VBUF + (p1 >> 3) * ML_VROW + (p1 & 7) * 16; *(LAS v2u*)d1 = (v2u){vr1.x, vr1.y}; *(LAS v2u*)(d1 + 8) = (v2u){vr1.z, vr1.w}; } } while (0)
            ML_LOAD(kt0);
            __syncthreads();
            ML_STORE(0);
            __syncthreads();
#pragma unroll 1
            for (int kt = kt0; kt <= kt1; ++kt) {
                const int cur = (kt - kt0) & 1;
                if (kt < kt1) ML_LOAD(kt + 1);
                const int klo = 64 * kt, khi = klo + 63, qhi = qlo + 31;
                const bool none = dir ? (khi < qlo) : (klo > qhi);
                const bool all = dir ? (klo >= qhi) : (khi <= qlo);
                if (!none) {
                    const LAS unsigned char* Kb = KB + cur * ML_KBUF; const LAS unsigned char* Vb = VB + cur * ML_VBUF;
                    ml_f32x16 S0, S1;
#pragma unroll
                    for (int i = 0; i < 16; ++i) { S0[i] = 0.f; S1[i] = 0.f; }
#pragma unroll
                    for (int s = 0; s < 8; ++s) {
                        const ml_bf16x8 k0 = *(const LAS ml_bf16x8*)(Kb + r * ML_KROW + (16 * s + 8 * hh) * 2);
                        const ml_bf16x8 k1 = *(const LAS ml_bf16x8*)(Kb + (32 + r) * ML_KROW + (16 * s + 8 * hh) * 2);
                        S0 = __builtin_amdgcn_mfma_f32_32x32x16_bf16(k0, qf[s], S0, 0, 0, 0);
                        S1 = __builtin_amdgcn_mfma_f32_32x32x16_bf16(k1, qf[s], S1, 0, 0, 0);
                    }
#pragma unroll
                    for (int kb = 0; kb < 2; ++kb)
#pragma unroll
                        for (int g4 = 0; g4 < 4; ++g4) {
                            const f32x4 a4 = *(const LAS f32x4*)(AS + klo + 32 * kb + 8 * g4 + 4 * hh);
#pragma unroll
                            for (int e = 0; e < 4; ++e) {
                                const int i = 4 * g4 + e; const int sg = klo + 32 * kb + 8 * g4 + 4 * hh + e;
                                const float sv = kb ? S1[i] : S0[i];
                                float p = sv * __expf(a4[e] - pmt);
                                if (!all) { const bool valid = dir ? (sg >= tq) : (sg <= tq); p = valid ? p : 0.f; }
                                den += p;
                                if (kb) S1[i] = p; else S0[i] = p;
                            }
                        }
#pragma unroll
                    for (int kb = 0; kb < 2; ++kb)
#pragma unroll
                        for (int s = 0; s < 2; ++s) {
                            v4u pw;
                            if (kb == 0) { pw.x = ml_pk(S0[8 * s], S0[8 * s + 1]); pw.y = ml_pk(S0[8 * s + 2], S0[8 * s + 3]); pw.z = ml_pk(S0[8 * s + 4], S0[8 * s + 5]); pw.w = ml_pk(S0[8 * s + 6], S0[8 * s + 7]); }
                            else { pw.x = ml_pk(S1[8 * s], S1[8 * s + 1]); pw.y = ml_pk(S1[8 * s + 2], S1[8 * s + 3]); pw.z = ml_pk(S1[8 * s + 4], S1[8 * s + 5]); pw.w = ml_pk(S1[8 * s + 6], S1[8 * s + 7]); }
                            const ml_bf16x8 pf = __builtin_bit_cast(ml_bf16x8, pw);
#pragma unroll
                            for (int db = 0; db < 4; ++db) {
                                const LAS unsigned char* vp = Vb + (32 * db + r) * ML_VROW + 2 * (32 * kb + 16 * s + 4 * hh);
                                const ml_s16x4 lo = *(const LAS ml_s16x4*)vp, hi = *(const LAS ml_s16x4*)(vp + 16);
                                const ml_bf16x8 vf = __builtin_shufflevector(lo, hi, 0, 1, 2, 3, 4, 5, 6, 7);
                                O[db] = __builtin_amdgcn_mfma_f32_32x32x16_bf16(vf, pf, O[db], 0, 0, 0);
                            }
                        }
                }
                if (kt < kt1) ML_STORE(cur ^ 1);
                __syncthreads();
            }
#undef ML_LOAD
#undef ML_STORE
            den += __shfl_xor(den, 32);
            const float scl = 1.0f / fmaxf(fabsf(den), GE[bhd * SEQ + tq]);
            float* orow = HML + ((size_t)dir * T + b * SEQ + tq) * 1024 + h * 128 + 4 * hh;
#pragma unroll
            for (int db = 0; db < 4; ++db)
#pragma unroll
                for (int g4 = 0; g4 < 4; ++g4)
                    *(f32x4*)(orow + 32 * db + 8 * g4) = (f32x4){O[db][4 * g4] * scl, O[db][4 * g4 + 1] * scl, O[db][4 * g4 + 2] * scl, O[db][4 * g4 + 3] * scl};
        }
    }
    __syncthreads();
}

__device__ __forceinline__ void phase4(const Ctx& C) {
    unsigned char* ws = C.ws;
    const float* ZT = (const float*)(ws + WS_ZT); const float* HML = (const float*)(ws + WS_HML); const bf16* ob = (const bf16*)(ws + WS_OB);
    bf16* ycat = (bf16*)(ws + (size_t)YCAT_T0 * MiB); const float* hyw = C.A.in[12]; const float* mlw = C.A.in[15];
    const int lane = C.lane;
    {
        LAS float* red = (LAS float*)C.lds;
        for (int u = blockIdx.x; u < 128 * 8; u += C.G) {
            const int tt = u >> 3, gi = u & 7, tok = tt * 64 + lane, ch0 = gi * 128 + C.wave * 16;
            float x[16]; float s = 0.f;
#pragma unroll
            for (int i = 0; i < 16; ++i) { x[i] = ZT[(size_t)(ch0 + i) * T + tok]; s += x[i]; }
            __syncthreads();
            red[C.wave * 64 + lane] = s;
            __syncthreads();
            float tot = 0.f;
#pragma unroll
            for (int w = 0; w < 8; ++w) tot += red[w * 64 + lane];
            const float mu = tot * (1.0f / 128.0f); float q = 0.f;
#pragma unroll
            for (int i = 0; i < 16; ++i) { x[i] -= mu; q += x[i] * x[i]; }
            __syncthreads();
            red[C.wave * 64 + lane] = q;
            __syncthreads();
            float qt = 0.f;
#pragma unroll
            for (int w = 0; w < 8; ++w) qt += red[w * 64 + lane];
            const float rstd = 1.0f / sqrtf(qt * (1.0f / 128.0f) + LN_EPS);
            float y[16];
#pragma unroll
            for (int i = 0; i < 16; ++i) y[i] = x[i] * rstd * hyw[ch0 + i];
            v4u w0, w1; w0.x = pk2(y[0], y[1]); w0.y = pk2(y[2], y[3]); w0.z = pk2(y[4], y[5]); w0.w = pk2(y[6], y[7]);
            w1.x = pk2(y[8], y[9]); w1.y = pk2(y[10], y[11]); w1.z = pk2(y[12], y[13]); w1.w = pk2(y[14], y[15]);
            bf16* dst = ycat + (size_t)tok * 2048 + ch0;
            *(v4u*)dst = w0; *(v4u*)(dst + 8) = w1;
        }
        __syncthreads();
    }
    for (int tok = C.gw; tok < T; tok += C.NGW) {
        float x[16];
#pragma unroll
        for (int j = 0; j < 4; ++j) { const f32x4 a = *(const f32x4*)(HML + (size_t)tok * 1024 + lane * 16 + 4 * j), bq = *(const f32x4*)(HML + ((size_t)T + tok) * 1024 + lane * 16 + 4 * j);
            x[4 * j] = a.x + bq.x; x[4 * j + 1] = a.y + bq.y; x[4 * j + 2] = a.z + bq.z; x[4 * j + 3] = a.w + bq.w; }
        float s = 0.f;
#pragma unroll
        for (int j = 0; j < 16; ++j) s += x[j];
        s += __shfl_xor(s, 1); s += __shfl_xor(s, 2); s += __shfl_xor(s, 4);
        const float mu = s * (1.0f / 128.0f); float q = 0.f;
#pragma unroll
        for (int j = 0; j < 16; ++j) { x[j] -= mu; q += x[j] * x[j]; }
        q += __shfl_xor(q, 1); q += __shfl_xor(q, 2); q += __shfl_xor(q, 4);
        const float rstd = 1.0f / sqrtf(q * (1.0f / 128.0f) + LN_EPS);
        const float* gw = mlw + lane * 16;
        float y[16];
#pragma unroll
        for (int j = 0; j < 16; ++j) y[j] = x[j] * rstd * gw[j];
        const v4u o0 = *(const v4u*)(ob + (size_t)tok * 1024 + lane * 16), o1 = *(const v4u*)(ob + (size_t)tok * 1024 + lane * 16 + 8);
#pragma unroll
        for (int j = 0; j < 4; ++j) { const float a0 = bflo(o0[j]), a1 = bfhi(o0[j]), b0 = bflo(o1[j]), b1 = bfhi(o1[j]);
            y[2 * j] *= 1.0f / (1.0f + expf(-a0)); y[2 * j + 1] *= 1.0f / (1.0f + expf(-a1)); y[8 + 2 * j] *= 1.0f / (1.0f + expf(-b0)); y[8 + 2 * j + 1] *= 1.0f / (1.0f + expf(-b1)); }
        v4u w0, w1; w0.x = pk2(y[0], y[1]); w0.y = pk2(y[2], y[3]); w0.z = pk2(y[4], y[5]); w0.w = pk2(y[6], y[7]);
        w1.x = pk2(y[8], y[9]); w1.y = pk2(y[10], y[11]); w1.z = pk2(y[12], y[13]); w1.w = pk2(y[14], y[15]);
        bf16* dst = ycat + (size_t)tok * 2048 + 1024 + lane * 16;
        *(v4u*)dst = w0; *(v4u*)(dst + 8) = w1;
    }
}

struct TileOrder {
    int nM, nN, a0, b0, G, c;
    __device__ __forceinline__ bool next(int i, pg8::Unit& u) const {
        const int nwg = nM * nN; const int L = i * G + c; if (L >= nwg) return false;
        int w; { const int q = nwg / 8, r = nwg % 8, xcd = L % 8, off = L / 8; w = (xcd < r ? xcd * (q + 1) : r * (q + 1) + (xcd - r) * q) + off; }
        const int nig = 8 * nN, gid = w / nig, wi = w % nig; u.pm = a0 + gid * 8 + (wi % 8); u.pn = b0 + wi / 8; return true;
    }
    __device__ __forceinline__ void a_ready(const pg8::Unit&) const {}
    __device__ __forceinline__ void done(const pg8::Unit&) const {}
};
struct EpiOut {
    static constexpr bool PERM = false, AFTER_DRAIN = false;
    const float* x; const float* bias; float* r1;
    __device__ __forceinline__ void operator()(const pg8::f32x4 (&acc)[2][2][4][2], const pg8::Unit& u, int wr, int wc, int fr, int fq) const {
        const int row0 = (u.pm - YCAT_T0) * 256 + wr * 64 + fr, col0 = (u.pn - WOUT_T0) * 256 + wc * 32 + 4 * fq;
        pg8::f32x4 bv[2][2];
#pragma unroll
        for (int bj = 0; bj < 2; ++bj)
#pragma unroll
            for (int n = 0; n < 2; ++n) bv[bj][n] = *(const pg8::f32x4*)(bias + col0 + bj * 128 + n * 16);
#pragma unroll
        for (int ai = 0; ai < 2; ++ai)
#pragma unroll
            for (int m = 0; m < 4; ++m) { const size_t off = (size_t)(row0 + ai * 128 + m * 16) * D + col0;
#pragma unroll
                for (int bj = 0; bj < 2; ++bj)
#pragma unroll
                    for (int n = 0; n < 2; ++n) { const pg8::f32x4 xs = *(const pg8::f32x4*)(x + off + bj * 128 + n * 16);
                        *(pg8::f32x4*)(r1 + off + bj * 128 + n * 16) = xs * DN_ALPHA + acc[ai][bj][m][n] + bv[bj][n]; } }
    }
};

#define P6_RS_STEP(NV, XM) do { const bool up = (lane & (XM)) != 0; _Pragma("unroll") for (int e_ = 0; e_ < (NV); ++e_) { \
        const float keep0 = up ? a0[e_ + (NV)] : a0[e_], send0 = up ? a0[e_] : a0[e_ + (NV)]; a0[e_] = keep0 + __shfl_xor(send0, (XM)); \
        const float keep1 = up ? a1[e_ + (NV)] : a1[e_], send1 = up ? a1[e_] : a1[e_ + (NV)]; a1[e_] = keep1 + __shfl_xor(send1, (XM)); } } while (0)
__device__ __forceinline__ void phase6(const Ctx& C, int dummy) {
    unsigned char* ws = C.ws;
    float* r1 = (float*)(ws + WS_R1); bf16* x1b = (bf16*)(ws + (size_t)X1B_T0 * MiB);
    const float* g1 = C.A.in[18]; const float* b1 = C.A.in[19]; const float* rw = C.A.in[20]; const float* rb = C.A.in[21];
    unsigned* cnt = (unsigned*)(ws + WS_CTL) + CW_CNT + (dummy ? 4096 : 0); int* list = (int*)(ws + (dummy ? WS_YBUF : WS_LIST)); float* tokw = (float*)(ws + (dummy ? WS_YBUF + 2 * MiB : WS_TOKW));
    const int lane = C.lane;
    for (int pair = C.gw; pair < T / 2; pair += C.NGW) {
        int ln = lane; asm volatile("" : "+v"(ln));
        f32x4 v0[8], v1[8];
#pragma unroll
        for (int tk = 0; tk < 2; ++tk) {
            const int tok = 2 * pair + tk; float* rr = r1 + (size_t)tok * D; f32x4 v[8]; float s = 0.f;
#pragma unroll
            for (int j = 0; j < 8; ++j) { v[j] = *(const f32x4*)(rr + (ln + 64 * j) * 4); s += (v[j].x + v[j].y) + (v[j].z + v[j].w); }
            const float mean = wave_sum(s) * (1.0f / D); float q = 0.f;
#pragma unroll
            for (int j = 0; j < 8; ++j) { v[j] = v[j] - mean; q += (v[j].x * v[j].x + v[j].y * v[j].y) + (v[j].z * v[j].z + v[j].w * v[j].w); }
            const float rstd = 1.0f / sqrtf(wave_sum(q) * (1.0f / D) + LN_EPS);
#pragma unroll
            for (int j = 0; j < 8; ++j) { const int c0 = (ln + 64 * j) * 4; const f32x4 gg = *(const f32x4*)(g1 + c0), bb = *(const f32x4*)(b1 + c0);
                const f32x4 y = v[j] * rstd * gg + bb;
                if (!dummy) { *(f32x4*)(rr + c0) = y; v2u w; w.x = pk2(y.x, y.y); w.y = pk2(y.z, y.w); *(v2u*)(x1b + (size_t)tok * D + c0) = w; }
                if (tk == 0) v0[j] = y; else v1[j] = y; }
        }
        float a0[32], a1[32]; const unsigned voff = (unsigned)ln * 512u;
#pragma unroll
        for (int e = 0; e < 32; ++e) { a0[e] = 0.f; a1[e] = 0.f; }
#pragma unroll
        for (int j = 0; j < 8; ++j)
#pragma unroll
            for (int i = 0; i < 4; ++i) {
                const f32x4* wr = (const f32x4*)((const char*)rw + (size_t)((256 * j + i) * 128) + voff);
                const float x0 = v0[j][i], x1 = v1[j][i];
#pragma unroll
                for (int q4 = 0; q4 < 8; ++q4) { const f32x4 w4 = wr[q4];
                    a0[4 * q4] += x0 * w4.x; a0[4 * q4 + 1] += x0 * w4.y; a0[4 * q4 + 2] += x0 * w4.z; a0[4 * q4 + 3] += x0 * w4.w;
                    a1[4 * q4] += x1 * w4.x; a1[4 * q4 + 1] += x1 * w4.y; a1[4 * q4 + 2] += x1 * w4.z; a1[4 * q4 + 3] += x1 * w4.w; }
                asm volatile("" ::: "memory");
            }
        P6_RS_STEP(16, 32); P6_RS_STEP(8, 16); P6_RS_STEP(4, 8); P6_RS_STEP(2, 4); P6_RS_STEP(1, 2);
        const int e = lane >> 1; const float rbe = rb[e];
        float lg0 = a0[0] + __shfl_xor(a0[0], 1) + rbe, lg1 = a1[0] + __shfl_xor(a1[0], 1) + rbe;
#pragma unroll
        for (int tk = 0; tk < 2; ++tk) {
            const int tok = 2 * pair + tk; float val = tk ? lg1 : lg0; float vals[4]; int idxs[4];
#pragma unroll
            for (int k = 0; k < 4; ++k) {
                const float m = wave_max(val);
                const unsigned long long bal = __ballot(val == m);
                const int idx = (int)(__builtin_ctzll(bal) >> 1);
                vals[k] = m; idxs[k] = idx;
                if (e == idx) val = -3.0e38f;
            }
            const float e1 = expf(vals[1] - vals[0]), e2 = expf(vals[2] - vals[0]), e3 = expf(vals[3] - vals[0]);
            const float inv = 1.0f / (1.0f + e1 + e2 + e3);
            if (lane < 4) {
                const int sel_e = lane == 0 ? idxs[0] : lane == 1 ? idxs[1] : lane == 2 ? idxs[2] : idxs[3];
                const float sel_v = (lane == 0 ? 1.0f : lane == 1 ? e1 : lane == 2 ? e2 : e3) * inv;
                const unsigned pos = atomicAdd(cnt + 64 * sel_e, 1u);
                list[sel_e * T + pos] = tok * 4 + lane; tokw[tok * 4 + lane] = sel_v;
            }
        }
    }
}
#undef P6_RS_STEP

__device__ __forceinline__ void moe_build_tb(const Ctx& C) {
    LAS int* tb = (LAS int*)(C.lds + LDS_TB);
    __syncthreads();
    if (C.tid == 0) { const unsigned* cnt = (const unsigned*)(C.ws + WS_CTL) + CW_CNT; int acc = 0;
        for (int e = 0; e < NE; ++e) { const int n = (int)__hip_atomic_load(cnt + 64 * e, __ATOMIC_RELAXED, __HIP_MEMORY_SCOPE_AGENT); tb[e] = acc; tb[40 + e] = n; acc += (n + 255) >> 8; }
        tb[32] = acc; }
    __syncthreads();
}
__device__ __forceinline__ void phase7(const Ctx& C) {
    unsigned char* ws = C.ws;
    moe_build_tb(C);
    const LAS int* tb = (const LAS int*)(C.lds + LDS_TB);
    const bf16* x1b = (const bf16*)(ws + (size_t)X1B_T0 * MiB); bf16* abuf = (bf16*)(ws + (size_t)ABUF_T0 * MiB);
    const int* list = (const int*)(ws + WS_LIST); const float* tokw = (const float*)(ws + WS_TOKW);
    int* rowslot = (int*)(ws + WS_ROWSLOT); float* roww = (float*)(ws + WS_ROWW);
    const int total_rows = tb[32] * 256;
    for (int row = C.gw; row < total_rows; row += C.NGW) {
        int e = 0; const int rt = row >> 8;
        while (e < NE - 1 && tb[e + 1] <= rt) ++e;
        const int i = row - tb[e] * 256; const int n = tb[40 + e];
        v4u* dst = (v4u*)(abuf + (size_t)row * D);
        if (i < n) { const int slot = list[e * T + i]; const v4u* src = (const v4u*)(x1b + (size_t)(slot >> 2) * D);
#pragma unroll
            for (int j = 0; j < 4; ++j) dst[C.lane + 64 * j] = src[C.lane + 64 * j];
            if (C.lane == 0) { rowslot[row] = slot; roww[row] = tokw[slot]; } }
        else {
#pragma unroll
            for (int j = 0; j < 4; ++j) dst[C.lane + 64 * j] = (v4u){0u, 0u, 0u, 0u};
            if (C.lane == 0) { rowslot[row] = -1; roww[row] = 0.f; } }
    }
}
struct MoeOrder {
    const LAS int* tb; int NJ, a0, w0, G, c; const int* list;
    __device__ __forceinline__ int a_row(const pg8::Unit& u, int r) const { const int e = (u.pn - w0) / NJ; const int i = (u.pm - a0 - tb[e]) * 256 + r; return i < tb[40 + e] ? (list[e * T + i] >> 2) : 0; }
    __device__ __forceinline__ bool next(int i, pg8::Unit& u) const {
        const int nwg = tb[32] * NJ; const int L = i * G + c; if (L >= nwg) return false;
        int w; { const int q = nwg / 8, r = nwg % 8, xcd = L % 8, off = L / 8; w = (xcd < r ? xcd * (q + 1) : r * (q + 1) + (xcd - r) * q) + off; }
        int e = 0;
        while (e < NE - 1 && tb[e + 1] * NJ <= w) ++e;
        const int local = w - tb[e] * NJ, nt = tb[e + 1] - tb[e], j = local / nt, ti = local - j * nt;
        u.pm = __builtin_amdgcn_readfirstlane(a0 + tb[e] + ti); u.pn = __builtin_amdgcn_readfirstlane(w0 + e * NJ + j); return true;
    }
    __device__ __forceinline__ void a_ready(const pg8::Unit&) const {}
    __device__ __forceinline__ void done(const pg8::Unit&) const {}
};
struct EpiGU {
    static constexpr bool PERM = true, AFTER_DRAIN = false;
    const float* b_gu; bf16* act;
    __device__ __forceinline__ void operator()(const pg8::f32x4 (&acc)[2][2][4][2], const pg8::Unit& u, int wr, int wc, int fr_, int fq_) const {
        int ln_ = threadIdx.x & 63; asm volatile("" : "+v"(ln_));
        const int fr = ln_ & 15, fq = ln_ >> 4;
        using pg8::cvt_pk_bf16;
        const int rt = u.pm - ABUF_T0, rel = u.pn - WGU_T0, e = rel >> 4, j = rel & 15;
        const int col0 = j * 128 + wc * 32 + 8 * fq;
        pg8::f32x4 bg[2], bu[2];
#pragma unroll
        for (int n = 0; n < 2; ++n) { bg[n] = *(const pg8::f32x4*)(b_gu + (size_t)e * 4096 + col0 + 4 * n); bu[n] = *(const pg8::f32x4*)(b_gu + (size_t)e * 4096 + 2048 + col0 + 4 * n); }
#pragma unroll
        for (int ai = 0; ai < 2; ++ai)
#pragma unroll
            for (int m = 0; m < 4; ++m) { const int row = rt * 256 + ai * 128 + wr * 64 + m * 16 + fr;
                float o[8];
#pragma unroll
                for (int n = 0; n < 2; ++n) { const pg8::f32x4 g = acc[ai][0][m][n] + bg[n], up = acc[ai][1][m][n] + bu[n];
#pragma unroll
                    for (int i = 0; i < 4; ++i) { const float gc = fminf(g[i], 7.0f), uc = fminf(fmaxf(up[i], -7.0f), 7.0f);
                        o[4 * n + i] = (uc + 1.0f) * (gc / (1.0f + __expf(-1.702f * gc))); } }
                v4u w; w.x = cvt_pk_bf16(o[0], o[1]); w.y = cvt_pk_bf16(o[2], o[3]); w.z = cvt_pk_bf16(o[4], o[5]); w.w = cvt_pk_bf16(o[6], o[7]);
                *(v4u*)(act + (size_t)row * DFF + col0) = w; }
    }
};
struct EpiNone {
    static constexpr bool PERM = true, AFTER_DRAIN = false; float* sink;
    __device__ __forceinline__ void operator()(const pg8::f32x4 (&acc)[2][2][4][2], const pg8::Unit& u, int wr, int wc, int fr, int fq) const {
        pg8::f32x4 t = acc[0][0][0][0];
#pragma unroll
        for (int ai = 0; ai < 2; ++ai)
#pragma unroll
            for (int bj = 0; bj < 2; ++bj)
#pragma unroll
                for (int m = 0; m < 4; ++m)
#pragma unroll
                    for (int n = 0; n < 2; ++n) t = t + acc[ai][bj][m][n];
        if (t[0] == 123.456f) sink[threadIdx.x] = t[1] + t[2] + t[3];
    }
};
struct EpiDown {
    static constexpr bool PERM = true, AFTER_DRAIN = false;
    const float* b_down; const int* list; const float* tokw; const LAS int* tb; bf16* ybuf;
    __device__ __forceinline__ void operator()(const pg8::f32x4 (&acc)[2][2][4][2], const pg8::Unit& u, int wr, int wc, int fr_, int fq_) const {
        using pg8::cvt_pk_bf16;
        int ln_ = threadIdx.x & 63; asm volatile("" : "+v"(ln_));
        const int fr = ln_ & 15, fq = ln_ >> 4;
        const int rel = u.pn - WDN_T0, e = rel >> 3, j = rel & 7, ti = u.pm - ACT_T0 - tb[e], n_e = tb[40 + e];
        const int col0 = j * 256 + wc * 32 + 8 * fq;
        pg8::f32x4 bv[2][2];
#pragma unroll
        for (int bj = 0; bj < 2; ++bj)
#pragma unroll
            for (int n = 0; n < 2; ++n) bv[bj][n] = *(const pg8::f32x4*)(b_down + (size_t)e * D + col0 + bj * 128 + 4 * n);
#pragma unroll
        for (int ai = 0; ai < 2; ++ai)
#pragma unroll
            for (int m = 0; m < 4; ++m) { const int i = ti * 256 + ai * 128 + wr * 64 + m * 16 + fr;
                if (i < n_e) { const int slot = list[e * T + i]; const float w = tokw[slot]; bf16* dst = ybuf + (size_t)slot * D + col0;
#pragma unroll
                    for (int bj = 0; bj < 2; ++bj) { const pg8::f32x4 v0 = (acc[ai][bj][m][0] + bv[bj][0]) * w, v1 = (acc[ai][bj][m][1] + bv[bj][1]) * w;
                        v4u o; o.x = cvt_pk_bf16(v0[0], v0[1]); o.y = cvt_pk_bf16(v0[2], v0[3]); o.z = cvt_pk_bf16(v1[0], v1[1]); o.w = cvt_pk_bf16(v1[2], v1[3]);
                        *(v4u*)(dst + bj * 128) = o; } } }
    }
};

namespace pg8 {
template <class Epi, class Sched>
__device__ __forceinline__ void gemm_phase_ga(PG8_LAS unsigned char* lds, const bf16_t* Arows, const bf16_t* Btiles, const int K, const Sched& S, const Epi& E) {
    const int tid = threadIdx.x, wid = __builtin_amdgcn_readfirstlane(tid >> 6), lane = tid & 63, wr = wid >> 2, wc = wid & 3, fr = lane & 15, fq = lane >> 4;
    const int nt = K / BK;
    int sR[2], sC[2]; unsigned voffB[2];
#pragma unroll
    for (int i = 0; i < 2; ++i) { int R, Cc; stage_rc(tid * 16 + i * 8192, R, Cc); sR[i] = R; sC[i] = Cc; const int Rb = Epi::PERM ? ((R & ~31) + perm32(R & 31)) : R; voffB[i] = (unsigned)(Rb * K + Cc) * 2u; }
    const size_t kstep = (size_t)(BK * 2), hstep = (size_t)HALF * K * 2, tstep = 2 * hstep;
    const unsigned ldsw = (unsigned)wid * 1024u;
    const int aoff = lds_byte(wr * 64 + fr, fq * 8), boff = lds_byte(wc * 32 + fr, fq * 8);
#define PG8_SA(b, h) (((b) * 2 + (h)) * HTB)
#define PG8_SB(b, h) ((4 + (b) * 2 + (h)) * HTB)
#define PG8_STAGE(bufoff, gbase, voff) do { _Pragma("unroll") for (int _i = 0; _i < 2; ++_i) \
        __builtin_amdgcn_global_load_lds((const unsigned*)((const char*)(gbase) + (voff)[_i]), (PG8_LAS unsigned*)(lds + (bufoff) + ldsw + _i * 8192), 16, 0, 0); } while (0)
#define PG8_STAGE2(bufoff, gbase, v0, v1) do { \
        __builtin_amdgcn_global_load_lds((const unsigned*)((const char*)(gbase) + (v0)), (PG8_LAS unsigned*)(lds + (bufoff) + ldsw), 16, 0, 0); \
        __builtin_amdgcn_global_load_lds((const unsigned*)((const char*)(gbase) + (v1)), (PG8_LAS unsigned*)(lds + (bufoff) + ldsw + 8192), 16, 0, 0); } while (0)
#define PG8_LDA(dst, b, h) do { _Pragma("unroll") for (int m = 0; m < 4; ++m) _Pragma("unroll") for (int k = 0; k < 2; ++k) dst[m][k] = *(const PG8_LAS bf16x8*)(lds + PG8_SA(b, h) + aoff + m * 2048 + k * 1024); } while (0)
#define PG8_LDB(dst, b, h) do { _Pragma("unroll") for (int n = 0; n < 2; ++n) _Pragma("unroll") for (int k = 0; k < 2; ++k) dst[n][k] = *(const PG8_LAS bf16x8*)(lds + PG8_SB(b, h) + boff + n * 2048 + k * 1024); } while (0)
#define PG8_MMA(ai, bj, At, Bt) do { __builtin_amdgcn_s_setprio(1); _Pragma("unroll") for (int m = 0; m < 4; ++m) _Pragma("unroll") for (int n = 0; n < 2; ++n) _Pragma("unroll") for (int k = 0; k < 2; ++k) \
        acc[ai][bj][m][n] = __builtin_amdgcn_mfma_f32_16x16x32_bf16(Bt[n][k], At[m][k], acc[ai][bj][m][n], 0, 0, 0); __builtin_amdgcn_s_setprio(0); } while (0)
#define PG8_WAIT_V(n) asm volatile("s_waitcnt vmcnt(" #n ")" ::: "memory")
#define PG8_WAIT_L(n) asm volatile("s_waitcnt lgkmcnt(" #n ")" ::: "memory")
#define PG8_BAR __builtin_amdgcn_s_barrier()
#define PG8_SCHED __builtin_amdgcn_sched_barrier(0)
#define PG8_AROWS(vo, u) do { _Pragma("unroll") for (int _h = 0; _h < 2; ++_h) _Pragma("unroll") for (int _i = 0; _i < 2; ++_i) vo[_h * 2 + _i] = (unsigned)S.a_row(u, _h * 128 + sR[_i]) * (unsigned)(K * 2) + (unsigned)(sC[_i] * 2); } while (0)
    Unit cur, nxt; int ui = 0;
    if (!S.next(0, cur)) return;
    f32x4 acc[2][2][4][2];
#pragma unroll
    for (int a = 0; a < 2; ++a)
#pragma unroll
        for (int b = 0; b < 2; ++b)
#pragma unroll
            for (int m = 0; m < 4; ++m)
#pragma unroll
                for (int n = 0; n < 2; ++n) acc[a][b][m][n] = (f32x4){0.f, 0.f, 0.f, 0.f};
    bf16x8 At[4][2], B0[2][2], B1[2][2];
    unsigned voC[4], voN[4];
    PG8_AROWS(voC, cur);
    const char* cA = (const char*)Arows; const char* cB = (const char*)Btiles + (size_t)cur.pn * tstep;
    PG8_STAGE(PG8_SB(0, 0), cB, voffB); PG8_STAGE(PG8_SB(0, 1), cB + hstep, voffB); PG8_STAGE2(PG8_SA(0, 0), cA, voC[0], voC[1]); PG8_STAGE2(PG8_SA(0, 1), cA, voC[2], voC[3]);
    if (wr == 1) PG8_BAR;
    PG8_WAIT_V(2); PG8_BAR;
    PG8_STAGE(PG8_SB(1, 0), cB + kstep, voffB); PG8_STAGE2(PG8_SA(1, 0), cA + kstep, voC[0], voC[1]); PG8_STAGE(PG8_SB(1, 1), cB + hstep + kstep, voffB);
    PG8_WAIT_V(6); PG8_BAR;
    for (;;) {
        const bool has_next = S.next(ui + 1, nxt);
        if (has_next) { PG8_AROWS(voN, nxt); } else {
#pragma unroll
            for (int q = 0; q < 4; ++q) voN[q] = voC[q]; }
        const char* nB = has_next ? (const char*)Btiles + (size_t)nxt.pn * tstep : cB;
        for (int t = 0; t < nt; t += 2) {
            const bool last = (t == nt - 2);
            const char* a1 = cA + (size_t)(t + 1) * kstep;
            const char* a2 = last ? cA : cA + (size_t)(t + 2) * kstep; const char* b2 = last ? nB : cB + (size_t)(t + 2) * kstep;
            const char* a3 = a2 + kstep; const char* b3 = b2 + kstep;
            const unsigned x0 = last ? voN[0] : voC[0], x1 = last ? voN[1] : voC[1], x2 = last ? voN[2] : voC[2], x3 = last ? voN[3] : voC[3];
            PG8_LDB(B0, 0, 0); PG8_LDB(B1, 0, 1); PG8_SCHED; PG8_LDA(At, 0, 0); PG8_STAGE2(PG8_SA(1, 1), a1, voC[2], voC[3]);
            PG8_WAIT_V(8); PG8_WAIT_L(0); PG8_BAR; PG8_MMA(0, 0, At, B0); PG8_MMA(0, 1, At, B1); PG8_BAR; PG8_SCHED;
            PG8_LDA(At, 0, 1); PG8_STAGE(PG8_SB(0, 0), b2, voffB); PG8_STAGE(PG8_SB(0, 1), b2 + hstep, voffB); PG8_STAGE2(PG8_SA(0, 0), a2, x0, x1);
            PG8_WAIT_V(8); PG8_WAIT_L(0); PG8_BAR; PG8_MMA(1, 0, At, B0); PG8_MMA(1, 1, At, B1); PG8_BAR; PG8_SCHED;
            PG8_LDB(B0, 1, 0); PG8_LDB(B1, 1, 1); PG8_SCHED; PG8_LDA(At, 1, 0); PG8_STAGE2(PG8_SA(0, 1), a2, x2, x3);
            PG8_WAIT_V(8); PG8_WAIT_L(0); PG8_BAR; PG8_MMA(0, 0, At, B0); PG8_MMA(0, 1, At, B1); PG8_BAR; PG8_SCHED;
            PG8_LDA(At, 1, 1); PG8_STAGE(PG8_SB(1, 0), b3, voffB); PG8_STAGE(PG8_SB(1, 1), b3 + hstep, voffB); PG8_STAGE2(PG8_SA(1, 0), a3, x0, x1);
            PG8_WAIT_V(8); PG8_WAIT_L(0); PG8_BAR; PG8_MMA(1, 0, At, B0); PG8_MMA(1, 1, At, B1); PG8_BAR; PG8_SCHED;
        }
        if (wr == 0) PG8_BAR;
        E(acc, cur, wr, wc, fr, fq); S.done(cur);
        if (!has_next) break;
#pragma unroll
        for (int a = 0; a < 2; ++a)
#pragma unroll
            for (int b = 0; b < 2; ++b)
#pragma unroll
                for (int m = 0; m < 4; ++m)
#pragma unroll
                    for (int n = 0; n < 2; ++n) acc[a][b][m][n] = (f32x4){0.f, 0.f, 0.f, 0.f};
        cur = nxt; cB = nB; ++ui;
#pragma unroll
        for (int q = 0; q < 4; ++q) voC[q] = voN[q];
        if (wr == 1) PG8_BAR;
    }
    PG8_WAIT_V(0);
    PG8_BAR;
#undef PG8_SA
#undef PG8_SB
#undef PG8_STAGE
#undef PG8_STAGE2
#undef PG8_LDA
#undef PG8_LDB
#undef PG8_MMA
#undef PG8_WAIT_V
#undef PG8_WAIT_L
#undef PG8_BAR
#undef PG8_SCHED
#undef PG8_AROWS
}
}

namespace pg8 {
template <class Epi, class Sched, class BSrc>
__device__ __forceinline__ void gemm_phase_bf32(PG8_LAS unsigned char* lds, const bf16_t* Abase, const int K, const Sched& S, const Epi& E, const BSrc& BS) {
    const int tid = threadIdx.x, wid = __builtin_amdgcn_readfirstlane(tid >> 6), lane = tid & 63, wr = wid >> 2, wc = wid & 3, fr = lane & 15, fq = lane >> 4;
    const int nt = K / BK;
    unsigned voffA[2];
#pragma unroll
    for (int i = 0; i < 2; ++i) { int R, Cc; stage_rc(tid * 16 + i * 8192, R, Cc); voffA[i] = (unsigned)(R * K + Cc) * 2u; }
    const size_t kstep = (size_t)(BK * 2), hstep = (size_t)HALF * K * 2, tstep = 2 * hstep;
    const unsigned ldsw = (unsigned)wid * 1024u;
    const int aoff = lds_byte(wr * 64 + fr, fq * 8), boff = lds_byte(wc * 32 + fr, fq * 8);
    const int kh = wid >> 2, nq = wid & 3, ko = lane & 3, ng = lane >> 2;
    const size_t ldb4 = (size_t)BS.ldb * 4;
    const unsigned gvoff = (unsigned)((8 * ko) * BS.ldb + 4 * ng) * 4u;
    int wslot; { const int r0 = (64 * nq + 4 * ng) & 127; if (Epi::PERM) { const int x = (r0 & 31) >> 2; wslot = (r0 & ~31) + 16 * (x & 1) + 4 * (x >> 1); } else wslot = r0; }
    const unsigned wboff = (unsigned)((nq >> 1) * HTB + lds_byte(wslot, 32 * kh + 8 * ko));
    const bool ngodd = (ng & 1) != 0; const unsigned wbA = wboff + (ngodd ? 64u : 0u), wbB = wboff + (ngodd ? 0u : 64u);
    typedef unsigned u32x2v __attribute__((ext_vector_type(2)));
#define PG8_SA(b, h) (((b) * 2 + (h)) * HTB)
#define PG8_SB(b, h) ((4 + (b) * 2 + (h)) * HTB)
#define PG8_STAGE(bufoff, gbase, voff) do { _Pragma("unroll") for (int _i = 0; _i < 2; ++_i) \
        __builtin_amdgcn_global_load_lds((const unsigned*)((const char*)(gbase) + (voff)[_i]), (PG8_LAS unsigned*)(lds + (bufoff) + ldsw + _i * 8192), 16, 0, 0); } while (0)
#define PG8_LDA(dst, b, h) do { _Pragma("unroll") for (int m = 0; m < 4; ++m) _Pragma("unroll") for (int k = 0; k < 2; ++k) dst[m][k] = *(const PG8_LAS bf16x8*)(lds + PG8_SA(b, h) + aoff + m * 2048 + k * 1024); } while (0)
#define PG8_LDB(dst, b, h) do { _Pragma("unroll") for (int n = 0; n < 2; ++n) _Pragma("unroll") for (int k = 0; k < 2; ++k) dst[n][k] = *(const PG8_LAS bf16x8*)(lds + PG8_SB(b, h) + boff + n * 2048 + k * 1024); } while (0)
#define PG8_MMA(ai, bj, At, Bt) do { __builtin_amdgcn_s_setprio(1); _Pragma("unroll") for (int m = 0; m < 4; ++m) _Pragma("unroll") for (int n = 0; n < 2; ++n) _Pragma("unroll") for (int k = 0; k < 2; ++k) \
        acc[ai][bj][m][n] = __builtin_amdgcn_mfma_f32_16x16x32_bf16(Bt[n][k], At[m][k], acc[ai][bj][m][n], 0, 0, 0); __builtin_amdgcn_s_setprio(0); } while (0)
#define PG8_WAIT_V(n) asm volatile("s_waitcnt vmcnt(" #n ")" ::: "memory")
#define PG8_WAIT_L(n) asm volatile("s_waitcnt lgkmcnt(" #n ")" ::: "memory")
#define PG8_BAR __builtin_amdgcn_s_barrier()
#define PG8_SCHED __builtin_amdgcn_sched_barrier(0)
#define PG8_GLOAD_A(src_) do { const char* src = (src_); _Pragma("unroll") for (int _j = 0; _j < 4; ++_j) asm volatile("global_load_dwordx4 %0, %1, %2" : "=v"(ga[_j]) : "v"(gvoff), "s"(src + (size_t)_j * ldb4) : "memory"); } while (0)
#define PG8_GLOAD_B(src_) do { const char* src = (src_); _Pragma("unroll") for (int _j = 0; _j < 4; ++_j) asm volatile("global_load_dwordx4 %0, %1, %2" : "=v"(gb[_j]) : "v"(gvoff), "s"(src + (size_t)(_j + 4) * ldb4) : "memory"); } while (0)
#define PG8_GWAIT_A(n) asm volatile("s_waitcnt vmcnt(" #n ")" : "+v"(ga[0]), "+v"(ga[1]), "+v"(ga[2]), "+v"(ga[3]) :: "memory")
#define PG8_GWAIT_B(n) asm volatile("s_waitcnt vmcnt(" #n ")" : "+v"(gb[0]), "+v"(gb[1]), "+v"(gb[2]), "+v"(gb[3]) :: "memory")
#define PG8_GWRITE_H(b, gv, hoff) do { _Pragma("unroll") for (int _i = 0; _i < 4; ++_i) { \
        const unsigned _p0 = cvt_pk_bf16(gv[0][_i], gv[1][_i]), _p1 = cvt_pk_bf16(gv[2][_i], gv[3][_i]), _q0 = cvt_pk_bf16(gv[0][_i ^ 1], gv[1][_i ^ 1]), _q1 = cvt_pk_bf16(gv[2][_i ^ 1], gv[3][_i ^ 1]); \
        u32x2v _w; _w.x = ngodd ? _q0 : _p0; _w.y = ngodd ? _q1 : _p1; \
        *(PG8_LAS u32x2v*)(lds + PG8_SB(b, 0) + ((_i & 1) ? wbB : wbA) + 128 * (_i >> 1) + (hoff)) = _w; } } while (0)
    Unit cur, nxt; int ui = 0;
    if (!S.next(0, cur)) return;
    f32x4 acc[2][2][4][2];
#pragma unroll
    for (int a = 0; a < 2; ++a)
#pragma unroll
        for (int b = 0; b < 2; ++b)
#pragma unroll
            for (int m = 0; m < 4; ++m)
#pragma unroll
                for (int n = 0; n < 2; ++n) acc[a][b][m][n] = (f32x4){0.f, 0.f, 0.f, 0.f};
    bf16x8 At[4][2], B0[2][2], B1[2][2];
    f32x4 ga[4], gb[4];
    const char* cA = (const char*)Abase + (size_t)cur.pm * tstep;
    const char* cG = (const char*)(BS.base(cur) + (size_t)(32 * kh) * BS.ldb + BS.col(cur, nq));
    const size_t gstep = 64 * ldb4;
    PG8_GLOAD_A(cG); PG8_GLOAD_B(cG); PG8_STAGE(PG8_SA(0, 0), cA, voffA); PG8_STAGE(PG8_SA(0, 1), cA + hstep, voffA);
    PG8_GWAIT_A(8); PG8_GWRITE_H(0, ga, 0); PG8_GWAIT_B(4); PG8_GWRITE_H(0, gb, 8);
    PG8_WAIT_V(0);
    PG8_GLOAD_A(cG + gstep); PG8_STAGE(PG8_SA(1, 0), cA + kstep, voffA); PG8_GLOAD_B(cG + gstep);
    PG8_WAIT_L(0);
    if (wr == 1) PG8_BAR;
    PG8_BAR; PG8_BAR;
    for (;;) {
        const bool has_next = S.next(ui + 1, nxt);
        const char* nA = has_next ? (const char*)Abase + (size_t)nxt.pm * tstep : cA;
        const char* nG = has_next ? (const char*)(BS.base(nxt) + (size_t)(32 * kh) * BS.ldb + BS.col(nxt, nq)) : cG;
        for (int t = 0; t < nt; t += 2) {
            const bool last = (t == nt - 2);
            const char* a1 = cA + (size_t)(t + 1) * kstep;
            const char* a2 = last ? nA : cA + (size_t)(t + 2) * kstep;
            const char* a3 = a2 + kstep;
            const char* g2 = last ? nG : cG + (size_t)(t + 2) * gstep;
            const char* g3 = g2 + gstep;
            PG8_LDB(B0, 0, 0); PG8_LDB(B1, 0, 1); PG8_SCHED; PG8_LDA(At, 0, 0);
            PG8_GWAIT_A(6); PG8_GWRITE_H(1, ga, 0); PG8_STAGE(PG8_SA(1, 1), a1 + hstep, voffA); PG8_GLOAD_A(g2);
            PG8_WAIT_L(0); PG8_BAR; PG8_MMA(0, 0, At, B0); PG8_MMA(0, 1, At, B1); PG8_BAR; PG8_SCHED;
            PG8_LDA(At, 0, 1);
            PG8_GWAIT_B(6); PG8_GWRITE_H(1, gb, 8); PG8_STAGE(PG8_SA(0, 0), a2, voffA); PG8_GLOAD_B(g2);
            PG8_WAIT_L(0); PG8_BAR; PG8_MMA(1, 0, At, B0); PG8_MMA(1, 1, At, B1); PG8_BAR; PG8_SCHED;
            PG8_LDB(B0, 1, 0); PG8_LDB(B1, 1, 1); PG8_SCHED; PG8_LDA(At, 1, 0);
            PG8_GWAIT_A(6); PG8_GWRITE_H(0, ga, 0); PG8_STAGE(PG8_SA(0, 1), a2 + hstep, voffA); PG8_GLOAD_A(g3);
            PG8_WAIT_L(0); PG8_BAR; PG8_MMA(0, 0, At, B0); PG8_MMA(0, 1, At, B1); PG8_BAR; PG8_SCHED;
            PG8_LDA(At, 1, 1);
            PG8_GWAIT_B(6); PG8_GWRITE_H(0, gb, 8); PG8_STAGE(PG8_SA(1, 0), a3, voffA); PG8_GLOAD_B(g3);
            PG8_WAIT_L(0); PG8_BAR; PG8_MMA(1, 0, At, B0); PG8_MMA(1, 1, At, B1); PG8_BAR; PG8_SCHED;
        }
        if (wr == 0) PG8_BAR;
        E(acc, cur, wr, wc, fr, fq); S.done(cur);
        if (!has_next) break;
#pragma unroll
        for (int a = 0; a < 2; ++a)
#pragma unroll
            for (int b = 0; b < 2; ++b)
#pragma unroll
                for (int m = 0; m < 4; ++m)
#pragma unroll
                    for (int n = 0; n < 2; ++n) acc[a][b][m][n] = (f32x4){0.f, 0.f, 0.f, 0.f};
        cur = nxt; cA = nA; cG = nG; ++ui;
        if (wr == 1) PG8_BAR;
    }
    PG8_GWAIT_A(0); PG8_GWAIT_B(0);
    PG8_BAR;
#undef PG8_SA
#undef PG8_SB
#undef PG8_STAGE
#undef PG8_LDA
#undef PG8_LDB
#undef PG8_MMA
#undef PG8_WAIT_V
#undef PG8_WAIT_L
#undef PG8_BAR
#undef PG8_SCHED
#undef PG8_GLOAD_A
#undef PG8_GLOAD_B
#undef PG8_GWAIT_A
#undef PG8_GWAIT_B
#undef PG8_GWRITE_H
}
}
struct BSrcGU {
    const float* w; int ldb;
    __device__ __forceinline__ const float* base(const pg8::Unit& u) const { return w + (size_t)((u.pn - WGU_T0) >> 4) * 2048 * 4096; }
    __device__ __forceinline__ int col(const pg8::Unit& u, int nq) const { const int j = (u.pn - WGU_T0) & 15; return (nq < 2) ? 128 * j + 64 * nq : 2048 + 128 * j + 64 * (nq - 2); }
};
struct BSrcDown {
    const float* w; int ldb;
    __device__ __forceinline__ const float* base(const pg8::Unit& u) const { return w + (size_t)((u.pn - WDN_T0) >> 3) * 2048 * 2048; }
    __device__ __forceinline__ int col(const pg8::Unit& u, int nq) const { return 256 * ((u.pn - WDN_T0) & 7) + 64 * nq; }
};

__device__ __forceinline__ void phase10(const Ctx& C) {
    unsigned char* ws = C.ws;
    const float* x1 = (const float*)(ws + WS_R1); const bf16* ybuf = (const bf16*)(ws + WS_YBUF);
    const float* g2 = C.A.in[26]; const float* b2 = C.A.in[27]; const int lane = C.lane;
    for (int tok = C.gw; tok < T; tok += C.NGW) {
        f32x4 v[8]; float s = 0.f;
#pragma unroll
        for (int j = 0; j < 8; ++j) { const int c0 = (lane + 64 * j) * 4; f32x4 a = *(const f32x4*)(x1 + (size_t)tok * D + c0) * DN_ALPHA;
#pragma unroll
            for (int k = 0; k < 4; ++k) { const v2u yw = *(const v2u*)(ybuf + ((size_t)tok * 4 + k) * D + c0); a = a + (f32x4){bflo(yw.x), bfhi(yw.x), bflo(yw.y), bfhi(yw.y)}; }
            v[j] = a; s += (a.x + a.y) + (a.z + a.w); }
        const float mean = wave_sum(s) * (1.0f / D); float q = 0.f;
#pragma unroll
        for (int j = 0; j < 8; ++j) { v[j] = v[j] - mean; q += (v[j].x * v[j].x + v[j].y * v[j].y) + (v[j].z * v[j].z + v[j].w * v[j].w); }
        const float rstd = 1.0f / sqrtf(wave_sum(q) * (1.0f / D) + LN_EPS);
#pragma unroll
        for (int j = 0; j < 8; ++j) { const int c0 = (lane + 64 * j) * 4; const f32x4 gg = *(const f32x4*)(g2 + c0), bb = *(const f32x4*)(b2 + c0);
            *(f32x4*)(C.out + (size_t)tok * D + c0) = v[j] * rstd * gg + bb; }
    }
}

__global__ void __launch_bounds__(NTHREADS, 2) fwd_kernel(KArgs args) {
    extern __shared__ __attribute__((aligned(16))) unsigned char lds_raw[];
    const int tid_ = threadIdx.x, wave_ = __builtin_amdgcn_readfirstlane(tid_ >> 6), G_ = gridDim.x;
    Ctx C{args, args.out, args.ws, (LAS unsigned char*)lds_raw, tid_, tid_ & 63, wave_, G_, (int)blockIdx.x * NWAVES + wave_, G_ * NWAVES};
    volatile LAS unsigned* MISC = (volatile LAS unsigned*)(C.lds + LDS_MISC);
    if (C.tid < 4) MISC[C.tid] = 0u;
    __syncthreads();
    unsigned* ctl = (unsigned*)(args.ws + WS_CTL);
    XcdBarrier bar; bar.bar = ctl + CW_BAR; bar.x = 0; bar.st = MISC;
    const int lo = args.ph_lo, hi = args.ph_hi;
    if (hi - lo > 1) bar = xcd_barrier_post(ctl + CW_BAR, MISC);
#ifndef PHASE_MASK
#define PHASE_MASK 0x7ff
#endif
#define IN(k) (((PHASE_MASK >> (k)) & 1) && lo <= (k) && (k) < hi)
#define SEAM(k) do { if (IN(k) && IN((k) + 1)) xcd_barrier(bar); } while (0)
    const pg8::Gemm g{(const pg8::bf16_t*)args.ws, (const pg8::bf16_t*)args.ws, 0, 0, 2048};
    PG8_LAS unsigned char* glds = (PG8_LAS unsigned char*)lds_raw;

#ifndef PROBE_DOUBLE
#define PROBE_DOUBLE 0
#endif
#define REP(k) for (int _rep = 0; _rep < (((PROBE_DOUBLE >> (k)) & 1) ? 2 : 1); ++_rep)
    if (IN(0)) { REP(0) phase0(C); } SEAM(0);
    if (IN(1)) {
        Gemm1Order S{C.G, (int)blockIdx.x};
        unsigned char* ws = args.ws;
        Epi1 E{C.A.in[2], (bf16*)(ws + WS_HYT), (bf16*)(ws + WS_QKRAW), (bf16*)(ws + WS_VB), (bf16*)(ws + WS_OB), (float*)(ws + WS_GATES)};
        REP(1) pg8::gemm_phase<Epi1, Gemm1Order, true, true>(glds, g, S, E);
        { const pg8::Gemm g2{(const pg8::bf16_t*)(ws + WS_W3P), (const pg8::bf16_t*)(ws + WS_H2P), 0, 0, 256}; KtOrder S2{C.G, (int)blockIdx.x}; EpiKT E2{(float*)(ws + WS_KT)};
          pg8::gemm_phase<EpiKT, KtOrder, true, true>(glds, g2, S2, E2); }
    } SEAM(1);
    if (IN(2)) { REP(2) phase2(C); } SEAM(2);
    if (IN(3)) { REP(3) hyena_fft(C); REP(11) { if (NAIVE_ML) mlstm_naive(C); else mlstm_mfma(C); } } SEAM(3);
    if (IN(4)) { REP(4) phase4(C); } SEAM(4);
    if (IN(5)) {
        TileOrder S{32, 8, YCAT_T0, WOUT_T0, C.G, (int)blockIdx.x};
        EpiOut E{C.A.in[0], C.A.in[17], (float*)(args.ws + WS_R1)};
        REP(5) pg8::gemm_phase<EpiOut, TileOrder, true, true>(glds, g, S, E);
    } SEAM(5);
    if (IN(6)) { REP(6) phase6(C, _rep); } if (IN(6) && IN(8)) xcd_barrier(bar);
    if (IN(8)) {
        moe_build_tb(C);
        MoeOrder S{(const LAS int*)(C.lds + LDS_TB), 16, ABUF_T0, WGU_T0, C.G, (int)blockIdx.x, (const int*)(args.ws + WS_LIST)};
        EpiGU E{C.A.in[23], (bf16*)(args.ws + (size_t)ACT_T0 * MiB)};
        BSrcGU BS{C.A.in[22], 4096};
#if MOE_PRECONVERT
        REP(8) pg8::gemm_phase_ga<EpiGU, MoeOrder>(glds, (const pg8::bf16_t*)(args.ws + (size_t)X1B_T0 * MiB), (const pg8::bf16_t*)args.ws, 2048, S, E);
#else
        REP(8) pg8::gemm_phase_bf32<EpiGU, MoeOrder, BSrcGU>(glds, (const pg8::bf16_t*)args.ws, 2048, S, E, BS);
#endif
    } SEAM(8);
    if (IN(9)) {
        moe_build_tb(C);
        MoeOrder S{(const LAS int*)(C.lds + LDS_TB), 8, ACT_T0, WDN_T0, C.G, (int)blockIdx.x, (const int*)(args.ws + WS_LIST)};
        EpiDown E{C.A.in[25], (const int*)(args.ws + WS_LIST), (const float*)(args.ws + WS_TOKW), (const LAS int*)(C.lds + LDS_TB), (bf16*)(args.ws + WS_YBUF)};
        BSrcDown BS{C.A.in[24], 2048};
#if MOE_PRECONVERT
        REP(9) pg8::gemm_phase<EpiDown, MoeOrder, true, true>(glds, g, S, E);
#else
        REP(9) pg8::gemm_phase_bf32<EpiDown, MoeOrder, BSrcDown>(glds, (const pg8::bf16_t*)args.ws, 2048, S, E, BS);
#endif
    } SEAM(9);
    if (IN(10)) { REP(10) phase10(C); }
#ifdef PROBE_BARRIERS
    if (hi - lo > 1) for (int i_ = 0; i_ < PROBE_BARRIERS; ++i_) xcd_barrier(bar);
#endif
#undef IN
#undef SEAM
}

extern "C" void kernel_launch(void* const* d_in, const int* in_sizes, int n_in, void* d_out, int out_size, void* d_ws, size_t ws_size, hipStream_t stream) {
    static int grid = 0;
    if (grid == 0) {
        if (n_in != 28 || in_sizes[0] != T * D || out_size != T * D || ws_size < WS_END) { fprintf(stderr, "kernel_launch: unexpected shapes (n_in %d, in0 %d, out %d, ws %zu)\n", n_in, n_in > 0 ? in_sizes[0] : -1, out_size, ws_size); grid = -1; return; }
        int dev = 0, cus = 0;
        if (hipGetDevice(&dev) != hipSuccess || hipDeviceGetAttribute(&cus, hipDeviceAttributeMultiprocessorCount, dev) != hipSuccess) { grid = -1; return; }
        if (hipFuncSetAttribute((const void*)fwd_kernel, hipFuncAttributeMaxDynamicSharedMemorySize, LDS_BYTES) != hipSuccess) { fprintf(stderr, "kernel_launch: hipFuncSetAttribute failed\n"); grid = -1; return; }
        int per_cu = 0;
        if (hipOccupancyMaxActiveBlocksPerMultiprocessor(&per_cu, (const void*)fwd_kernel, NTHREADS, LDS_BYTES) != hipSuccess || per_cu < 1) fprintf(stderr, "kernel_launch: occupancy query says %d\n", per_cu);
        (void)hipGetLastError();
        grid = cus;
    }
    if (grid < 0) return;
    if (hipMemsetAsync((char*)d_ws + WS_CTL, 0, CTL_ZERO_BYTES, stream) != hipSuccess) return;
    KArgs a{};
    for (int i = 0; i < 28; ++i) a.in[i] = (const float*)d_in[i];
    a.out = (float*)d_out; a.ws = (unsigned char*)d_ws;
#if MK_ONE_LAUNCH
    a.ph_lo = 0; a.ph_hi = N_PHASES;
    hipLaunchKernelGGL(fwd_kernel, dim3(grid), dim3(NTHREADS), LDS_BYTES, stream, a);
#else
    for (int ph = 0; ph < N_PHASES; ++ph) { a.ph_lo = ph; a.ph_hi = ph + 1; hipLaunchKernelGGL(fwd_kernel, dim3(grid), dim3(NTHREADS), LDS_BYTES, stream, a); }
#endif
}
```

```cpp
#include <hip/hip_runtime.h>
#include <cstdio>
#include <cstdint>
namespace pg8 {
#define PG8_LAS __attribute__((address_space(3)))
typedef unsigned short bf16_t;
typedef short bf16x8 __attribute__((ext_vector_type(8)));
typedef float f32x4 __attribute__((ext_vector_type(4)));
typedef unsigned u32x4 __attribute__((ext_vector_type(4)));
constexpr int BM = 256, BK = 64, HALF = 128, HTB = HALF * BK * 2  , STAGE_BYTES = 8 * HTB, NXCD = 8, WGM = 8;

__host__ __device__ __forceinline__ int lds_byte(int r, int c) { const int st = (r >> 4) * 2 + (c >> 5), rr = r & 15, cc = c & 31, ob = rr * 64 + cc * 2; return st * 1024 + (ob ^ (((ob >> 9) & 1) << 5)); }
__host__ __device__ __forceinline__ void stage_rc(int b, int& R, int& C) { const int st = b / 1024, sb = b % 1024, swz = sb ^ (((sb >> 9) & 1) << 5); R = (st >> 1) * 16 + swz / 64; C = (st & 1) * 32 + (swz % 64) / 2; }
__host__ __device__ __forceinline__ int perm32(int rho) { const int n = rho >> 4, i = rho & 15; return 8 * (i >> 2) + 4 * n + (i & 3); }

struct Unit { int pm, pn; };
struct Gemm { const bf16_t* A; const bf16_t* Bt; int M, N, K; };
__device__ __forceinline__ unsigned cvt_pk_bf16(float lo, float hi) { unsigned r; asm volatile("v_cvt_pk_bf16_f32 %0, %1, %2" : "=v"(r) : "v"(lo), "v"(hi)); return r; }
typedef float f32x2 __attribute__((ext_vector_type(2)));
template <class Epi, class Sched, bool ALIGN_EPI = false, bool SP2 = false>
__device__ __forceinline__ void gemm_phase(PG8_LAS unsigned char* lds, const Gemm g, const Sched& S, const Epi& E) {
    const int tid = threadIdx.x, wid = __builtin_amdgcn_readfirstlane(tid >> 6), lane = tid & 63, wr = wid >> 2, wc = wid & 3, fr = lane & 15, fq = lane >> 4;
    const int K = g.K, nt = K / BK;
    unsigned voffA[2], voffB[2];
#pragma unroll
    for (int i = 0; i < 2; ++i) { int R, C; stage_rc(tid * 16 + i * 8192, R, C); const int Rb = Epi::PERM ? ((R & ~31) + perm32(R & 31)) : R;
        voffA[i] = (unsigned)(R * K + C) * 2u; voffB[i] = (unsigned)(Rb * K + C) * 2u; }
    const size_t kstep = (size_t)(BK * 2);
    const size_t hstep = (size_t)HALF * K * 2;
    const size_t tstep = 2 * hstep;
    const unsigned ldsw = (unsigned)wid * 1024u;
    const int aoff = lds_byte(wr * 64 + fr, fq * 8), boff = lds_byte(wc * 32 + fr, fq * 8);
#define PG8_SA(b, h) (((b) * 2 + (h)) * HTB)
#define PG8_SB(b, h) ((4 + (b) * 2 + (h)) * HTB)
#define PG8_STAGE(bufoff, gbase, voff) do { _Pragma("unroll") for (int _i = 0; _i < 2; ++_i) \
        __builtin_amdgcn_global_load_lds((const unsigned*)((const char*)(gbase) + (voff)[_i]), (PG8_LAS unsigned*)(lds + (bufoff) + ldsw + _i * 8192), 16, 0, 0); } while (0)
#define PG8_LDA(dst, b, h) do { _Pragma("unroll") for (int m = 0; m < 4; ++m) _Pragma("unroll") for (int k = 0; k < 2; ++k) dst[m][k] = *(const PG8_LAS bf16x8*)(lds + PG8_SA(b, h) + aoff + m * 2048 + k * 1024); } while (0)
#define PG8_LDB(dst, b, h) do { _Pragma("unroll") for (int n = 0; n < 2; ++n) _Pragma("unroll") for (int k = 0; k < 2; ++k) dst[n][k] = *(const PG8_LAS bf16x8*)(lds + PG8_SB(b, h) + boff + n * 2048 + k * 1024); } while (0)
#define PG8_MMA(ai, bj, At, Bt) do { __builtin_amdgcn_s_setprio(1); _Pragma("unroll") for (int m = 0; m < 4; ++m) _Pragma("unroll") for (int n = 0; n < 2; ++n) _Pragma("unroll") for (int k = 0; k < 2; ++k) \
        acc[ai][bj][m][n] = __builtin_amdgcn_mfma_f32_16x16x32_bf16(Bt[n][k], At[m][k], acc[ai][bj][m][n], 0, 0, 0); __builtin_amdgcn_s_setprio(0); } while (0)
#define PG8_WAIT_V(n) asm volatile("s_waitcnt vmcnt(" #n ")" ::: "memory")
#define PG8_WAIT_L(n) asm volatile("s_waitcnt lgkmcnt(" #n ")" ::: "memory")
#define PG8_BAR __builtin_amdgcn_s_barrier()
#define PG8_SCHED __builtin_amdgcn_sched_barrier(0)
    Unit cur, nxt; int ui = 0;
    if (!S.next(0, cur)) return;
    f32x4 acc[2][2][4][2];
#pragma unroll
    for (int a = 0; a < 2; ++a)
#pragma unroll
        for (int b = 0; b < 2; ++b)
#pragma unroll
            for (int m = 0; m < 4; ++m)
#pragma unroll
                for (int n = 0; n < 2; ++n) acc[a][b][m][n] = (f32x4){0.f, 0.f, 0.f, 0.f};
    bf16x8 At[4][2], B0[2][2], B1[2][2];
    const char* cA = (const char*)g.A + (size_t)cur.pm * tstep; const char* cB = (const char*)g.Bt + (size_t)cur.pn * tstep;
    S.a_ready(cur);
    if constexpr (SP2) {
        PG8_STAGE(PG8_SB(0, 0), cB, voffB); PG8_STAGE(PG8_SB(0, 1), cB + hstep, voffB); PG8_STAGE(PG8_SA(0, 0), cA, voffA); PG8_STAGE(PG8_SA(0, 1), cA + hstep, voffA);
        if (wr == 1) PG8_BAR;
        PG8_WAIT_V(2); PG8_BAR;
        PG8_STAGE(PG8_SB(1, 0), cB + kstep, voffB); PG8_STAGE(PG8_SA(1, 0), cA + kstep, voffA); PG8_STAGE(PG8_SB(1, 1), cB + hstep + kstep, voffB);
        PG8_WAIT_V(6); PG8_BAR;
    } else {
        PG8_STAGE(PG8_SB(0, 0), cB, voffB); PG8_STAGE(PG8_SA(0, 0), cA, voffA); PG8_STAGE(PG8_SB(0, 1), cB + hstep, voffB); PG8_STAGE(PG8_SA(0, 1), cA + hstep, voffA);
        if (wr == 1) PG8_BAR;
        PG8_WAIT_V(4); PG8_BAR;
        PG8_STAGE(PG8_SB(1, 0), cB + kstep, voffB); PG8_STAGE(PG8_SA(1, 0), cA + kstep, voffA); PG8_STAGE(PG8_SB(1, 1), cB + hstep + kstep, voffB);
        PG8_WAIT_V(6); PG8_BAR;
    }
    for (;;) {
        const bool has_next = S.next(ui + 1, nxt);
        const char* nA = has_next ? (const char*)g.A + (size_t)nxt.pm * tstep : cA; const char* nB = has_next ? (const char*)g.Bt + (size_t)nxt.pn * tstep : cB;
        for (int t = 0; t < nt; t += 2) {
            const bool last = (t == nt - 2);
            const char* a1 = cA + (size_t)(t + 1) * kstep;
            const char* a2 = last ? nA : cA + (size_t)(t + 2) * kstep; const char* b2 = last ? nB : cB + (size_t)(t + 2) * kstep;
            const char* a3 = a2 + kstep; const char* b3 = b2 + kstep;
            if (last && has_next) S.a_ready(nxt);
            if constexpr (SP2) {
            PG8_LDB(B0, 0, 0); PG8_LDB(B1, 0, 1); PG8_SCHED; PG8_LDA(At, 0, 0); PG8_STAGE(PG8_SA(1, 1), a1 + hstep, voffA);
            PG8_WAIT_V(8); PG8_WAIT_L(0); PG8_BAR; PG8_MMA(0, 0, At, B0); PG8_MMA(0, 1, At, B1); PG8_BAR; PG8_SCHED;
            PG8_LDA(At, 0, 1); PG8_STAGE(PG8_SB(0, 0), b2, voffB); PG8_STAGE(PG8_SB(0, 1), b2 + hstep, voffB); PG8_STAGE(PG8_SA(0, 0), a2, voffA);
            PG8_WAIT_V(8); PG8_WAIT_L(0); PG8_BAR; PG8_MMA(1, 0, At, B0); PG8_MMA(1, 1, At, B1); PG8_BAR; PG8_SCHED;
            PG8_LDB(B0, 1, 0); PG8_LDB(B1, 1, 1); PG8_SCHED; PG8_LDA(At, 1, 0); PG8_STAGE(PG8_SA(0, 1), a2 + hstep, voffA);
            PG8_WAIT_V(8); PG8_WAIT_L(0); PG8_BAR; PG8_MMA(0, 0, At, B0); PG8_MMA(0, 1, At, B1); PG8_BAR; PG8_SCHED;
            PG8_LDA(At, 1, 1); PG8_STAGE(PG8_SB(1, 0), b3, voffB); PG8_STAGE(PG8_SB(1, 1), b3 + hstep, voffB); PG8_STAGE(PG8_SA(1, 0), a3, voffA);
            PG8_WAIT_V(8); PG8_WAIT_L(0); PG8_BAR; PG8_MMA(1, 0, At, B0); PG8_MMA(1, 1, At, B1); PG8_BAR; PG8_SCHED;
            } else {
            PG8_LDB(B0, 0, 0); PG8_SCHED; PG8_LDA(At, 0, 0); PG8_STAGE(PG8_SA(1, 1), a1 + hstep, voffA);
            PG8_WAIT_L(8); PG8_BAR; PG8_WAIT_L(0); PG8_MMA(0, 0, At, B0); PG8_BAR; PG8_SCHED;
            PG8_LDB(B1, 0, 1); PG8_STAGE(PG8_SB(0, 0), b2, voffB);
            PG8_BAR; PG8_WAIT_L(0); PG8_MMA(0, 1, At, B1); PG8_BAR;
            PG8_LDA(At, 0, 1); PG8_STAGE(PG8_SA(0, 0), a2, voffA);
            PG8_BAR; PG8_WAIT_L(0); PG8_MMA(1, 0, At, B0); PG8_BAR; PG8_SCHED;
            PG8_STAGE(PG8_SB(0, 1), b2 + hstep, voffB);
            PG8_WAIT_V(6); PG8_BAR; PG8_MMA(1, 1, At, B1); PG8_BAR;
            PG8_LDB(B0, 1, 0); PG8_SCHED; PG8_LDA(At, 1, 0); PG8_STAGE(PG8_SA(0, 1), a2 + hstep, voffA);
            PG8_WAIT_L(8); PG8_BAR; PG8_WAIT_L(0); PG8_MMA(0, 0, At, B0); PG8_BAR; PG8_SCHED;
            PG8_LDB(B1, 1, 1); PG8_STAGE(PG8_SB(1, 0), b3, voffB);
            PG8_BAR; PG8_WAIT_L(0); PG8_MMA(0, 1, At, B1); PG8_BAR;
            PG8_LDA(At, 1, 1); PG8_STAGE(PG8_SA(1, 0), a3, voffA);
            PG8_BAR; PG8_WAIT_L(0); PG8_MMA(1, 0, At, B0); PG8_BAR; PG8_SCHED;
            PG8_STAGE(PG8_SB(1, 1), b3 + hstep, voffB);
            PG8_WAIT_V(6); PG8_BAR; PG8_MMA(1, 1, At, B1); PG8_BAR;
            }
        }
        if constexpr (ALIGN_EPI) { if (wr == 0) PG8_BAR; }
        if constexpr (!Epi::AFTER_DRAIN) { E(acc, cur, wr, wc, fr, fq); S.done(cur); }
        if (!has_next) break;
#pragma unroll
        for (int a = 0; a < 2; ++a)
#pragma unroll
            for (int b = 0; b < 2; ++b)
#pragma unroll
                for (int m = 0; m < 4; ++m)
#pragma unroll
                    for (int n = 0; n < 2; ++n) acc[a][b][m][n] = (f32x4){0.f, 0.f, 0.f, 0.f};
        cur = nxt; cA = nA; cB = nB; ++ui;
        if constexpr (ALIGN_EPI) { if (wr == 1) PG8_BAR; }
    }
    PG8_WAIT_V(0);
    if constexpr (!ALIGN_EPI) { if (wr == 0) PG8_BAR; }
    PG8_BAR;
    if constexpr (Epi::AFTER_DRAIN) { E.fused(acc, cur, wr, wc, fr, fq, lds, wid, lane); S.done(cur); }
#undef PG8_SA
#undef PG8_SB
#undef PG8_STAGE
#undef PG8_LDA
#undef PG8_LDB
#undef PG8_MMA
#undef PG8_WAIT_V
#undef PG8_WAIT_L
#undef PG8_BAR
#undef PG8_SCHED
}
}

constexpr int NB = 4, SEQ = 2048, T = NB * SEQ, D = 2048, DHY = 1024, DML = 1024, DIN = 7200, NE = 32, TOPK = 4, NH = 8, HD = 128, DFF = 2048;
constexpr float LN_EPS = 1e-5f, DN_ALPHA = 1.189207115002721f;
constexpr int NWAVES = 8, NTHREADS = 512;
#ifndef MK_ONE_LAUNCH
#define MK_ONE_LAUNCH 1
#endif
constexpr int N_PHASES = 11;
#ifndef MOE_PRECONVERT
#define MOE_PRECONVERT 1
#endif

constexpr size_t MiB = 1u << 20;
constexpr size_t WS_CTL = 0, CTL_ZERO_BYTES = 1 * MiB;
constexpr size_t WS_H2P = 1936 * MiB;
constexpr size_t WS_W3P = 1937 * MiB;
constexpr size_t WS_GATES = 2 * MiB;
constexpr size_t WS_TOKW = 3 * MiB;
constexpr size_t WS_LIST = 4 * MiB;
constexpr size_t WS_ROWSLOT = 5 * MiB;
constexpr size_t WS_ROWW = 5 * MiB + 512 * 1024;
constexpr size_t WS_GA = 6 * MiB, WS_GP = 6 * MiB + 512 * 1024, WS_GE = 7 * MiB;
constexpr size_t TILE_BYTES = 256 * 2048 * 2;
constexpr int XB_T0 = 8, WIN_T0 = 40, WOUT_T0 = 72, YCAT_T0 = 80, X1B_T0 = 112, ABUF_T0 = 144, ACT_T0 = 304, WGU_T0 = 464, WDN_T0 = 976;
constexpr size_t WS_HYT = 1232 * MiB;
constexpr size_t WS_QKRAW = 1296 * MiB;
constexpr size_t WS_OB = 1328 * MiB;
constexpr size_t WS_QKC = 1344 * MiB;
constexpr size_t WS_KT = 1376 * MiB;
constexpr size_t WS_KF = 1840 * MiB;
constexpr size_t WS_ZT = 1904 * MiB;
constexpr size_t WS_Z = 1408 * MiB;
constexpr size_t WS_HML = 1440 * MiB;
constexpr size_t WS_R1 = 1504 * MiB;
constexpr size_t WS_YBUF = 1568 * MiB;
constexpr size_t WS_VB = 1824 * MiB;
constexpr size_t WS_END = 1940 * MiB;
constexpr int CW_BAR = 4096, CW_CNT = 16384;

constexpr int LDS_STAGE = 131072, LDS_MISC = LDS_STAGE, LDS_TB = LDS_STAGE + 64, LDS_BYTES = 147456;

#define GAS __attribute__((address_space(1)))
#define LAS __attribute__((address_space(3)))
typedef unsigned short bf16;
typedef unsigned v4u __attribute__((ext_vector_type(4)));
typedef unsigned v2u __attribute__((ext_vector_type(2)));
typedef float f32x4 __attribute__((ext_vector_type(4)));
typedef float f32x2 __attribute__((ext_vector_type(2)));
#define LDS_WAIT() asm volatile("s_waitcnt lgkmcnt(0)" ::: "memory")
__device__ __forceinline__ unsigned f2bf(float f) { unsigned u = __builtin_bit_cast(unsigned, f); return (u + 0x7fffu + ((u >> 16) & 1u)) >> 16; }
__device__ __forceinline__ unsigned pk2(float lo, float hi) { return f2bf(lo) | (f2bf(hi) << 16); }
__device__ __forceinline__ float bflo(unsigned w) { return __builtin_bit_cast(float, w << 16); }
__device__ __forceinline__ float bfhi(unsigned w) { return __builtin_bit_cast(float, w & 0xffff0000u); }
__device__ __forceinline__ float bf2f(bf16 b) { return __builtin_bit_cast(float, (unsigned)b << 16); }
__device__ __forceinline__ float wave_sum(float v) {
#pragma unroll
    for (int o = 1; o < 64; o <<= 1) v += __shfl_xor(v, o);
    return v;
}
__device__ __forceinline__ float wave_max(float v) {
#pragma unroll
    for (int o = 1; o < 64; o <<= 1) v = fmaxf(v, __shfl_xor(v, o));
    return v;
}

#define XB_TMO      128
#define XB_XCNT(j)  (256  + 64 * (j))
#define XB_XSUB(j)  (1280 + 64 * (j))
#define XB_XGEN(j)  (2304 + 64 * (j))
#define XB_TOP      3328
#define XB_TOPGEN   3392
#define XCD_BAR_WORDS 3456
#define XB_SPIN_CAP (1u << 22)

__device__ __forceinline__ unsigned xb_ld(unsigned* p)              { return __hip_atomic_load(p, __ATOMIC_RELAXED, __HIP_MEMORY_SCOPE_AGENT); }
__device__ __forceinline__ unsigned xb_add(unsigned* p, unsigned v) { return __hip_atomic_fetch_add(p, v, __ATOMIC_RELAXED, __HIP_MEMORY_SCOPE_AGENT); }
__device__ __forceinline__ unsigned xb_xcc_id() { return (unsigned)__builtin_amdgcn_s_getreg((3 << 11) | 20) & 0xFu; }
#define XB_SPIN(cond, bar) do { unsigned _sp = 0; while (cond) { __builtin_amdgcn_s_sleep(1); \
    if ((++_sp & 255u) == 0u) { if (xb_ld(&(bar)[XB_TMO])) break; if (_sp > XB_SPIN_CAP) { atomicAdd(&(bar)[XB_TMO], 1u); break; } } } } while (0)

struct XcdBarrier {
    unsigned* bar; unsigned x;
    volatile LAS unsigned* st;
};

__device__ __forceinline__ XcdBarrier xcd_barrier_post(unsigned* bar, volatile LAS unsigned* st) {
    XcdBarrier b; b.bar = bar; b.x = xb_xcc_id(); b.st = st;
    if (threadIdx.x == 0) (void)xb_add(&bar[XB_XCNT(b.x)], 1u);
    return b;
}
__device__ __forceinline__ void xcd_barrier_complete(unsigned* bar, unsigned x, unsigned& nloc, unsigned& nx) {
    const unsigned G = gridDim.x * gridDim.y * gridDim.z;
    unsigned sum, cnt, mine, sp = 0u;
    for (;;) {
        sum = 0u; cnt = 0u; mine = 0u;
#pragma unroll
        for (unsigned j = 0; j < 16; ++j) { const unsigned c = xb_ld(&bar[XB_XCNT(j)]); sum += c; cnt += (c > 0u) ? 1u : 0u; mine = (j == x) ? c : mine; }
        if (sum == G) break;
        __builtin_amdgcn_s_sleep(1);
        if ((++sp & 255u) == 0u) { if (xb_ld(&bar[XB_TMO])) break; if (sp > XB_SPIN_CAP) { atomicAdd(&bar[XB_TMO], 1u); break; } }
    }
    nloc = mine > 0u ? mine : 1u; nx = cnt > 0u ? cnt : 1u;
}

__device__ __forceinline__ void xcd_barrier(const XcdBarrier& b) {
    asm volatile("s_waitcnt vmcnt(0)" ::: "memory");
    __syncthreads();
    if (threadIdx.x == 0) {
        unsigned* bar = b.bar;
        __builtin_amdgcn_s_waitcnt(0);
        unsigned nloc = b.st[0], nx = b.st[1];
        if (nloc == 0u) { xcd_barrier_complete(bar, b.x, nloc, nx); b.st[0] = nloc; b.st[1] = nx; }
        const unsigned old = xb_add(&bar[XB_XSUB(b.x)], 1u);
        const unsigned gen = old / nloc;
        if (old + 1u == (gen + 1u) * nloc) {
            __builtin_amdgcn_fence(__ATOMIC_RELEASE, "agent");
            asm volatile("s_waitcnt vmcnt(0)" ::: "memory");
            const unsigned og = xb_add(&bar[XB_TOP], 1u);
            const unsigned tg = og / nx;
            if (og + 1u == (tg + 1u) * nx) xb_add(&bar[XB_TOPGEN], 1u);
            else XB_SPIN(xb_ld(&bar[XB_TOPGEN]) == tg, bar);
            __builtin_amdgcn_fence(__ATOMIC_ACQUIRE, "agent");
            xb_add(&bar[XB_XGEN(b.x)], 1u);
            asm volatile("s_waitcnt vmcnt(0)" ::: "memory");
        } else {
            XB_SPIN(xb_ld(&bar[XB_XGEN(b.x)]) == gen, bar);
            __builtin_amdgcn_fence(__ATOMIC_ACQUIRE, "agent");
            asm volatile("s_waitcnt vmcnt(0)" ::: "memory");
        }
    }
    __syncthreads();
}


#ifndef FFT_HD
#define FFT_HD __device__ __forceinline__
#define FFT_LDS LAS
#endif
constexpr int FFT_WORDS = 4096 + 1024 + 256;
FFT_HD int fidx(int i) { return i + 4 * (i >> 4) + 16 * (i >> 8); }

template <bool INV> FFT_HD void dft4(float& ar, float& ai, float& br, float& bi, float& cr, float& ci, float& dr, float& di) {
    const float s0r = ar + cr, s0i = ai + ci, s1r = ar - cr, s1i = ai - ci;
    const float s2r = br + dr, s2i = bi + di, s3r = br - dr, s3i = bi - di;
    ar = s0r + s2r; ai = s0i + s2i;
    cr = s0r - s2r; ci = s0i - s2i;
    if (!INV) { br = s1r + s3i; bi = s1i - s3r; dr = s1r - s3i; di = s1i + s3r; }
    else      { br = s1r - s3i; bi = s1i + s3r; dr = s1r + s3i; di = s1i - s3r; }
}
template <bool INV> FFT_HD void dft16(float (&xr)[16], float (&xi)[16]) {
#pragma unroll
    for (int n0 = 0; n0 < 4; ++n0) dft4<INV>(xr[n0], xi[n0], xr[n0 + 4], xi[n0 + 4], xr[n0 + 8], xi[n0 + 8], xr[n0 + 12], xi[n0 + 12]);
    constexpr float C1 = 0.9238795325112867f, S1 = 0.3826834323650898f, C2 = 0.7071067811865476f;
    const float tc[10] = {1.f, C1, C2, S1, 0.f, -S1, -C2, -C1, -1.f, -C1};
    const float ts[10] = {0.f, S1, C2, C1, 1.f, C1, C2, S1, 0.f, -S1};
#pragma unroll
    for (int n0 = 1; n0 < 4; ++n0)
#pragma unroll
        for (int k0 = 1; k0 < 4; ++k0) { const int m = n0 * k0; const float wr = tc[m], wi = INV ? ts[m] : -ts[m];
            const int id = n0 + 4 * k0; const float r = xr[id] * wr - xi[id] * wi, i = xr[id] * wi + xi[id] * wr; xr[id] = r; xi[id] = i; }
#pragma unroll
    for (int k0 = 0; k0 < 4; ++k0) dft4<INV>(xr[4 * k0], xi[4 * k0], xr[4 * k0 + 1], xi[4 * k0 + 1], xr[4 * k0 + 2], xi[4 * k0 + 2], xr[4 * k0 + 3], xi[4 * k0 + 3]);
#pragma unroll
    for (int a = 0; a < 4; ++a)
#pragma unroll
        for (int b = a + 1; b < 4; ++b) { float t = xr[4 * a + b]; xr[4 * a + b] = xr[4 * b + a]; xr[4 * b + a] = t; t = xi[4 * a + b]; xi[4 * a + b] = xi[4 * b + a]; xi[4 * b + a] = t; }
}
template <bool INV> FFT_HD void twiddle16(float (&xr)[16], float (&xi)[16], int j, int n) {
    float s, c;
#ifdef __HIP_DEVICE_COMPILE__
    asm volatile("" : "+v"(j));
    sincospif(2.0f * (float)j / (float)n, &s, &c);
#else
    s = (float)sin(2.0 * 3.14159265358979323846 * j / n); c = (float)cos(2.0 * 3.14159265358979323846 * j / n);
#endif
    const float wr = c, wi = INV ? s : -s;
    float pr = wr, pi = wi;
#pragma unroll
    for (int k = 1; k < 16; ++k) {
        const float r = xr[k] * pr - xi[k] * pi, i = xr[k] * pi + xi[k] * pr; xr[k] = r; xi[k] = i;
        const float nr = pr * wr - pi * wi, ni = pr * wi + pi * wr; pr = nr; pi = ni;
    }
}
FFT_HD void fft_store_s256(FFT_LDS float* re, FFT_LDS float* im, int g, const float (&xr)[16], const float (&xi)[16]) {
    const int a0 = fidx(g);
#pragma unroll
    for (int k = 0; k < 16; ++k) { re[a0 + 336 * k] = xr[k]; im[a0 + 336 * k] = xi[k]; }
}
FFT_HD void fft_load_s256(const FFT_LDS float* re, const FFT_LDS float* im, int g, float (&xr)[16], float (&xi)[16]) {
    const int a0 = fidx(g);
#pragma unroll
    for (int k = 0; k < 16; ++k) { xr[k] = re[a0 + 336 * k]; xi[k] = im[a0 + 336 * k]; }
}
FFT_HD void fft_load_s16(const FFT_LDS float* re, const FFT_LDS float* im, int g, float (&xr)[16], float (&xi)[16]) {
    const int a0 = fidx((g >> 4) * 256 + (g & 15));
#pragma unroll
    for (int k = 0; k < 16; ++k) { xr[k] = re[a0 + 20 * k]; xi[k] = im[a0 + 20 * k]; }
}
FFT_HD void fft_store_s16(FFT_LDS float* re, FFT_LDS float* im, int g, const float (&xr)[16], const float (&xi)[16]) {
    const int a0 = fidx((g >> 4) * 256 + (g & 15));
#pragma unroll
    for (int k = 0; k < 16; ++k) { re[a0 + 20 * k] = xr[k]; im[a0 + 20 * k] = xi[k]; }
}
FFT_HD void fft_load_s1(const FFT_LDS float* re, const FFT_LDS float* im, int g, float (&xr)[16], float (&xi)[16]) {
    const int a = fidx(g * 16);
#pragma unroll
    for (int k = 0; k < 16; ++k) { xr[k] = re[a + k]; xi[k] = im[a + k]; }
}
FFT_HD void fft_store_s1(FFT_LDS float* re, FFT_LDS float* im, int g, const float (&xr)[16], const float (&xi)[16]) {
    const int a = fidx(g * 16);
#pragma unroll
    for (int k = 0; k < 16; ++k) { re[a + k] = xr[k]; im[a + k] = xi[k]; }
}


struct KArgs { const float* in[28]; float* out; unsigned char* ws; int ph_lo, ph_hi; };
struct Ctx {
    const KArgs& A; float* out; unsigned char* ws; LAS unsigned char* lds;
    int tid, lane, wave, G, gw, NGW;
};

__device__ __forceinline__ void transpose_item(const float* __restrict__ W, int N, int k0, int n0, bf16* __restrict__ dst, LAS float* scr, int lane) {
#pragma unroll 8
    for (int i = 0; i < 32; ++i) { const int kk = 2 * i + (lane >> 5); scr[kk * 33 + (lane & 31)] = W[(size_t)(k0 + kk) * N + n0 + (lane & 31)]; }
    LDS_WAIT(); asm volatile("" ::: "memory");
    const int c = lane & 7;
#pragma unroll
    for (int j = 0; j < 4; ++j) { const int n = (lane >> 3) + 8 * j; const LAS float* s = scr + (8 * c) * 33 + n;
        v4u o; o.x = pk2(s[0 * 33], s[1 * 33]); o.y = pk2(s[2 * 33], s[3 * 33]); o.z = pk2(s[4 * 33], s[5 * 33]); o.w = pk2(s[6 * 33], s[7 * 33]);
        *(v4u*)(dst + (size_t)n * 2048 + k0 + 8 * c) = o; }
    LDS_WAIT(); asm volatile("" ::: "memory");
}

__device__ __forceinline__ void phase0(const Ctx& C) {
    unsigned char* ws = C.ws;
    {
        const f32x4* x4 = (const f32x4*)C.A.in[0]; v4u* xb = (v4u*)(ws + (size_t)XB_T0 * MiB);
        const size_t n8 = (size_t)T * D / 8;
        for (size_t i = (size_t)blockIdx.x * NTHREADS + C.tid; i < n8; i += (size_t)C.G * NTHREADS) {
            const f32x4 a = x4[2 * i], b = x4[2 * i + 1]; v4u o; o.x = pk2(a.x, a.y); o.y = pk2(a.z, a.w); o.z = pk2(b.x, b.y); o.w = pk2(b.z, b.w); xb[i] = o; }
    }
    {
        LAS float* scr = (LAS float*)(C.lds + C.wave * 8448);
        constexpr int I_IN = 32 * 225, I_OUT = 32 * 64, I_GU = MOE_PRECONVERT ? NE * 32 * 128 : 0, I_DN = MOE_PRECONVERT ? NE * 32 * 64 : 0, NITEMS = I_IN + I_OUT + I_GU + I_DN;
        bf16* win_t = (bf16*)(ws + (size_t)WIN_T0 * MiB); bf16* wout_t = (bf16*)(ws + (size_t)WOUT_T0 * MiB);
        bf16* wgu_t = (bf16*)(ws + (size_t)WGU_T0 * MiB); bf16* wdn_t = (bf16*)(ws + (size_t)WDN_T0 * MiB);
        for (int it = C.gw; it < NITEMS; it += C.NGW) {
            int r = it;
            if (r < I_IN) { const int kb = r / 225, nb = r % 225; transpose_item(C.A.in[1], DIN, 64 * kb, 32 * nb, win_t + (size_t)(32 * nb) * 2048, scr, C.lane); continue; } r -= I_IN;
            if (r < I_OUT) { const int kb = r / 64, nb = r % 64; transpose_item(C.A.in[16], D, 64 * kb, 32 * nb, wout_t + (size_t)(32 * nb) * 2048, scr, C.lane); continue; } r -= I_OUT;
            if (r < I_GU) { const int e = r / 4096, rr = r % 4096, kb = rr / 128, nb = rr % 128, n0 = 32 * nb;
                const int drow = (n0 < 2048) ? ((n0 >> 7) * 256 + (n0 & 127)) : ((((n0 - 2048) >> 7) * 256) + 128 + ((n0 - 2048) & 127));
                transpose_item(C.A.in[22] + (size_t)e * 2048 * 4096, 4096, 64 * kb, n0, wgu_t + ((size_t)e * 4096 + drow) * 2048, scr, C.lane); continue; } r -= I_GU;
            { const int e = r / 2048, rr = r % 2048, kb = rr / 64, nb = rr % 64;
                transpose_item(C.A.in[24] + (size_t)e * 2048 * 2048, 2048, 64 * kb, 32 * nb, wdn_t + ((size_t)e * 2048 + 32 * nb) * 2048, scr, C.lane); }
        }
    }
    __syncthreads();
    {
        const float* w1 = C.A.in[5]; const float* b1 = C.A.in[6]; const float* w2 = C.A.in[7]; const float* b2 = C.A.in[8]; const float* freq = C.A.in[10];
        LAS float* h1s = (LAS float*)C.lds;
        const int tt = C.tid >> 6, j = C.tid & 63;
        for (int tb = blockIdx.x; tb < SEQ / 8; tb += C.G) {
            const int t = tb * 8 + tt;
            const float zt = (float)t / 2047.0f, wt = 6.283185307179586f * (float)t / 2048.0f;
            float acc = b1[j] + zt * w1[j];
            for (int i = 0; i < 16; ++i) { const float fb = 1e-4f + (float)i * ((15.0f - 1e-4f) / 15.0f); const float arg = fb * wt;
                acc += cosf(arg) * w1[(1 + i) * 64 + j] - sinf(arg) * w1[(17 + i) * 64 + j]; }
            h1s[tt * 64 + j] = sinf(freq[j] * acc);
            __syncthreads();
            float a2 = b2[j];
            for (int i = 0; i < 64; ++i) a2 += h1s[tt * 64 + i] * w2[i * 64 + j];
            { const float hv = sinf(freq[64 + j] * a2); const unsigned hi = f2bf(hv); const float lo = hv - bflo(hi);
              bf16* hp = (bf16*)(ws + WS_H2P) + (size_t)t * 256; hp[j] = (bf16)hi; hp[64 + j] = (bf16)hi; hp[128 + j] = (bf16)f2bf(lo); hp[192 + j] = 0; }
            __syncthreads();
        }
        const float* w3 = C.A.in[9]; bf16* wp = (bf16*)(ws + WS_W3P);
        for (int i = blockIdx.x * NTHREADS + C.tid; i < 4096 * 8; i += C.G * NTHREADS) {
            const int col = i & 4095, jo = i >> 12; float wv[8]; unsigned hi[8], lo[8];
#pragma unroll
            for (int k = 0; k < 8; ++k) { wv[k] = w3[(size_t)(jo * 8 + k) * 4096 + col]; hi[k] = f2bf(wv[k]); lo[k] = f2bf(wv[k] - bflo(hi[k])); }
            v4u vh, vl; vh.x = hi[0] | (hi[1] << 16); vh.y = hi[2] | (hi[3] << 16); vh.z = hi[4] | (hi[5] << 16); vh.w = hi[6] | (hi[7] << 16);
            vl.x = lo[0] | (lo[1] << 16); vl.y = lo[2] | (lo[3] << 16); vl.z = lo[4] | (lo[5] << 16); vl.w = lo[6] | (lo[7] << 16);
            bf16* row = wp + (size_t)col * 256 + jo * 8;
            *(v4u*)row = vh; *(v4u*)(row + 64) = vl; *(v4u*)(row + 128) = vh; *(v4u*)(row + 192) = (v4u){0u, 0u, 0u, 0u};
        }
    }
}

#ifndef NAIVE_ML
#define NAIVE_ML 0
#endif
constexpr int N1_SW_TILES = 16, N1_SW = N1_SW_TILES * 32;
constexpr int N1_NORM_TILES = NAIVE_ML ? 17 : 13, N1_NORM = N1_NORM_TILES * 32, N1_UNITS = N1_SW + N1_NORM;
struct Gemm1Order {
    int G, c;
    __device__ __forceinline__ bool next(int i, pg8::Unit& u) const {
        const int L = i * G + c; if (L >= N1_UNITS) return false;
        int w; { const int q = N1_UNITS / 8, r = N1_UNITS % 8, xcd = L % 8, off = L / 8; w = (xcd < r ? xcd * (q + 1) : r * (q + 1) + (xcd - r) * q) + off; }
        if (w < N1_SW) { const int nig = 8 * 32, gid = w / nig, wi = w % nig, mi = gid * 8 + (wi % 8), ni = wi / 8;
            u.pm = WIN_T0 + (mi < 12 ? mi : 8 + mi); u.pn = XB_T0 + ni; }
        else { w -= N1_SW; const int nig = 8 * N1_NORM_TILES, gid = w / nig, wi = w % nig, mi = gid * 8 + (wi % 8), ni = wi / 8;
            int wt;
            if (NAIVE_ML) wt = (ni < 16) ? 12 + ni : 28; else wt = (ni < 8) ? 12 + ni : 16 + ni;
            u.pm = XB_T0 + mi; u.pn = WIN_T0 + wt; }
        return true;
    }
    __device__ __forceinline__ void a_ready(const pg8::Unit&) const {}
    __device__ __forceinline__ void done(const pg8::Unit&) const {}
};
struct Epi1 {
    static constexpr bool PERM = true, AFTER_DRAIN = false;
    const float* b_in; bf16* hyt; bf16* qkraw; bf16* vb; bf16* ob; float* gates;
    __device__ __forceinline__ void operator()(const pg8::f32x4 (&acc)[2][2][4][2], const pg8::Unit& u, int wr, int wc, int fr, int fq) const {
        using pg8::cvt_pk_bf16;
        if (u.pm >= WIN_T0) {
            const int wt = u.pm - WIN_T0, tt = u.pn - XB_T0;
            const int col0 = tt * 256 + wc * 32 + 8 * fq;
#pragma unroll
            for (int ai = 0; ai < 2; ++ai)
#pragma unroll
                for (int m = 0; m < 4; ++m) {
                    const int ch = wt * 256 + ai * 128 + wr * 64 + m * 16 + fr; const float bv = b_in[ch];
                    const int drow = ch < 3072 ? ch : ch - 2048;
                    bf16* rowp = hyt + (size_t)drow * T + col0;
#pragma unroll
                    for (int bj = 0; bj < 2; ++bj) { const pg8::f32x4 v0 = acc[ai][bj][m][0] + bv, v1 = acc[ai][bj][m][1] + bv;
                        v4u w; w.x = cvt_pk_bf16(v0[0], v0[1]); w.y = cvt_pk_bf16(v0[2], v0[3]); w.z = cvt_pk_bf16(v1[0], v1[1]); w.w = cvt_pk_bf16(v1[2], v1[3]);
                        *(v4u*)(rowp + bj * 128) = w; }
                }
        } else {
            const int tt = u.pm - XB_T0, wt = u.pn - WIN_T0;
            const int chb = wt * 256 + wc * 32 + 8 * fq;
            pg8::f32x4 bv[2][2];
#pragma unroll
            for (int bj = 0; bj < 2; ++bj)
#pragma unroll
                for (int n = 0; n < 2; ++n) { const int c0 = chb + bj * 128 + 4 * n; bv[bj][n] = (c0 < DIN) ? *(const pg8::f32x4*)(b_in + c0) : (pg8::f32x4){0.f, 0.f, 0.f, 0.f}; }
            if (wt == 28) {
                if (wc == 0) {
#pragma unroll
                    for (int ai = 0; ai < 2; ++ai)
#pragma unroll
                        for (int m = 0; m < 4; ++m) { const int tok = tt * 256 + ai * 128 + wr * 64 + m * 16 + fr;
                            float* gp = gates + (size_t)tok * 32 + 8 * fq;
                            *(pg8::f32x4*)(gp) = acc[ai][0][m][0] + bv[0][0]; *(pg8::f32x4*)(gp + 4) = acc[ai][0][m][1] + bv[0][1]; }
                }
            } else {
#define EPI1_STORE(base, ld, cb) do { _Pragma("unroll") for (int ai = 0; ai < 2; ++ai) _Pragma("unroll") for (int m = 0; m < 4; ++m) { const int tok = tt * 256 + ai * 128 + wr * 64 + m * 16 + fr; \
                    bf16* rowp = (base) + (size_t)tok * (ld) + (cb); \
                    _Pragma("unroll") for (int bj = 0; bj < 2; ++bj) { const pg8::f32x4 v0 = acc[ai][bj][m][0] + bv[bj][0], v1 = acc[ai][bj][m][1] + bv[bj][1]; \
                        v4u w; w.x = cvt_pk_bf16(v0[0], v0[1]); w.y = cvt_pk_bf16(v0[2], v0[3]); w.z = cvt_pk_bf16(v1[0], v1[1]); w.w = cvt_pk_bf16(v1[2], v1[3]); \
                        *(v4u*)(rowp + bj * 128) = w; } } } while (0)
                if (wt < 20) EPI1_STORE(qkraw, 2048, chb - 3072);
                else if (wt < 24) EPI1_STORE(vb, 1024, chb - 5120);
                else EPI1_STORE(ob, 1024, chb - 6144);
#undef EPI1_STORE
            }
        }
    }
};

struct KtOrder {
    int G, c;
    __device__ __forceinline__ bool next(int i, pg8::Unit& u) const { const int cc = G - 1 - c; if (i != 0 || cc >= 128) return false; u.pm = cc >> 3; u.pn = cc & 7; return true; }
    __device__ __forceinline__ void a_ready(const pg8::Unit&) const {}
    __device__ __forceinline__ void done(const pg8::Unit&) const {}
};
struct EpiKT {
    static constexpr bool PERM = true, AFTER_DRAIN = false;
    float* kt;
    __device__ __forceinline__ void operator()(const pg8::f32x4 (&acc)[2][2][4][2], const pg8::Unit& u, int wr, int wc, int fr, int fq) const {
        const float da = -3.0701134573253945f, db = -15.350567286626973f;
#pragma unroll
        for (int ai = 0; ai < 2; ++ai)
#pragma unroll
            for (int m = 0; m < 4; ++m) {
                const int col = u.pm * 256 + ai * 128 + wr * 64 + m * 16 + fr, o = col >> 11, dir = (col >> 10) & 1, c = col & 1023;
                const float delta = fabsf(da + (float)c * ((db - da) / 1023.0f)) * (1.0f / 2047.0f);
                float* kr = kt + ((size_t)o * 1024 + c) * 4096;
#pragma unroll
                for (int bj = 0; bj < 2; ++bj) {
                    const int t0 = u.pn * 256 + bj * 128 + wc * 32 + 8 * fq; float v[8];
#pragma unroll
                    for (int n = 0; n < 2; ++n)
#pragma unroll
                        for (int e = 0; e < 4; ++e) v[4 * n + e] = acc[ai][bj][m][n][e] * expf(-(float)(t0 + 4 * n + e) * delta);
                    if (dir == 0) { *(pg8::f32x4*)(kr + t0) = (pg8::f32x4){v[0], v[1], v[2], v[3]}; *(pg8::f32x4*)(kr + t0 + 4) = (pg8::f32x4){v[4], v[5], v[6], v[7]}; }
                    else {
#pragma unroll
                        for (int e = 0; e < 8; ++e) if (t0 + e >= 1) kr[4096 - t0 - e] = v[e]; }
                }
            }
    }
};

template <int OP> __device__ __forceinline__ LAS float* block_scan_2048(LAS float* x, LAS float* y, int tid) {
    LAS float* src = x; LAS float* dst = y;
    for (int off = 1; off < 2048; off <<= 1) {
#pragma unroll
        for (int i = 0; i < 4; ++i) { const int idx = tid + 512 * i; float v = src[idx]; if (idx >= off) { const float w = src[idx - off]; v = OP ? fmaxf(v, w) : v + w; } dst[idx] = v; }
        __syncthreads();
        LAS float* t = src; src = dst; dst = t;
    }
    return src;
}
__device__ __forceinline__ float logsigmoidf(float x) { return fminf(x, 0.f) - log1pf(expf(-fabsf(x))); }

__device__ __forceinline__ void phase2(const Ctx& C) {
    unsigned char* ws = C.ws;
    {
        const float* KT = (const float*)(ws + WS_KT); f32x4* KF = (f32x4*)(ws + WS_KF);
        const int half = C.tid >> 8, g = C.tid & 255;
        LAS float* re = (LAS float*)(C.lds + half * (2 * FFT_WORDS * 4)); LAS float* im = re + FFT_WORDS;
        LAS float* red = (LAS float*)(C.lds + 4 * FFT_WORDS * 4);
        for (int u = blockIdx.x; u < 1024; u += C.G) {
            const int o = u >> 9, c0 = (u & 511) * 2, c = c0 + half;
            __syncthreads();
            const float* kcol = KT + ((size_t)o * 1024 + c) * 4096;
            float xr[16], xi[16]; float asum = 0.f;
#pragma unroll
            for (int m = 0; m < 16; ++m) { const int idx = g + 256 * m; const float val = (idx == 2048) ? 0.f : kcol[idx]; xr[m] = val; xi[m] = 0.f; asum += fabsf(val); }
            asum = wave_sum(asum);
            if (C.lane == 0) red[C.wave] = asum;
            __syncthreads();
            const float tot = red[half * 4] + red[half * 4 + 1] + red[half * 4 + 2] + red[half * 4 + 3];
            const float scl = 1.0f / (tot * 4096.0f);
#pragma unroll
            for (int m = 0; m < 16; ++m) xr[m] *= scl;
            dft16<false>(xr, xi); twiddle16<false>(xr, xi, g, 4096); fft_store_s256(re, im, g, xr, xi);
            __syncthreads();
            fft_load_s16(re, im, g, xr, xi); dft16<false>(xr, xi); twiddle16<false>(xr, xi, g & 15, 256); fft_store_s16(re, im, g, xr, xi);
            __syncthreads();
            fft_load_s1(re, im, g, xr, xi); dft16<false>(xr, xi);
            f32x4* dst = KF + ((size_t)(o * 1024 + c) * 4096 + g * 16) / 2;
#pragma unroll
            for (int k = 0; k < 8; ++k) dst[k] = (f32x4){xr[2 * k], xi[2 * k], xr[2 * k + 1], xi[2 * k + 1]};
        }
        __syncthreads();
    }
    {
        const bf16* raw = (const bf16*)(ws + WS_QKRAW); bf16* qkc = (bf16*)(ws + WS_QKC); const float* cw = C.A.in[13]; const float* cb = C.A.in[14];
        for (int g = blockIdx.x * NTHREADS + C.tid; g < T * 256; g += C.G * NTHREADS) {
            const int tok = g >> 8, ch0 = (g & 255) * 8, tl = tok & (SEQ - 1);
            const v4u cur = *(const v4u*)(raw + (size_t)tok * 2048 + ch0);
            v4u prv = (v4u){0u, 0u, 0u, 0u}, nxt = (v4u){0u, 0u, 0u, 0u};
            if (tl > 0) prv = *(const v4u*)(raw + (size_t)(tok - 1) * 2048 + ch0);
            if (tl < SEQ - 1) nxt = *(const v4u*)(raw + (size_t)(tok + 1) * 2048 + ch0);
            const float sc = ch0 >= 1024 ? 0.08838834764831845f : 1.0f;
            float o[8];
#pragma unroll
            for (int i = 0; i < 8; ++i) {
                const unsigned pw = prv[i >> 1], cwd = cur[i >> 1], nw = nxt[i >> 1];
                const float p = (i & 1) ? bfhi(pw) : bflo(pw), q = (i & 1) ? bfhi(cwd) : bflo(cwd), n = (i & 1) ? bfhi(nw) : bflo(nw);
                const int ch = ch0 + i;
                const float v = cw[ch] * p + cw[2048 + ch] * q + cw[4096 + ch] * n + cb[ch];
                o[i] = sc * v / (1.0f + expf(-v));
            }
            v4u w; w.x = pk2(o[0], o[1]); w.y = pk2(o[2], o[3]); w.z = pk2(o[4], o[5]); w.w = pk2(o[6], o[7]);
            *(v4u*)(qkc + (size_t)tok * 2048 + ch0) = w;
        }
    }
    {
        const float* gates = (const float*)(ws + WS_GATES); float* GA = (float*)(ws + WS_GA); float* GP = (float*)(ws + WS_GP); float* GE = (float*)(ws + WS_GE);
        LAS float* s0 = (LAS float*)(C.lds + 8192); LAS float* s1 = s0 + 2048; LAS float* s2 = s1 + 2048; LAS float* s3 = s2 + 2048;
        for (int bhd = blockIdx.x; bhd < 64; bhd += C.G) {
            const int b = bhd >> 4, h = (bhd >> 1) & 7, dir = bhd & 1, col_i = dir * 16 + h, col_f = col_i + 8;
            float ig[4], lf[4];
            __syncthreads();
#pragma unroll
            for (int i = 0; i < 4; ++i) { const int t = C.tid + 512 * i; const float* gr = gates + (size_t)(b * SEQ + t) * 32; ig[i] = gr[col_i]; lf[i] = logsigmoidf(gr[col_f]); s0[t] = lf[i]; }
            __syncthreads();
            LAS float* Fc = block_scan_2048<0>(s0, s1, C.tid);
            float a[4], Fv[4], Gx[4];
#pragma unroll
            for (int i = 0; i < 4; ++i) { const int t = C.tid + 512 * i; Fv[i] = Fc[t]; Gx[i] = Fv[i] - lf[i]; a[i] = dir ? ig[i] + Gx[i] : ig[i] - Fv[i]; s2[dir ? 2047 - t : t] = a[i]; }
            __syncthreads();
            LAS float* Pm = block_scan_2048<1>(s2, s3, C.tid);
#pragma unroll
            for (int i = 0; i < 4; ++i) { const int t = C.tid + 512 * i; const float pm = Pm[dir ? 2047 - t : t];
                const float mt = dir ? pm - Gx[i] : Fv[i] + pm;
                GA[bhd * 2048 + t] = a[i]; GP[bhd * 2048 + t] = pm; GE[bhd * 2048 + t] = expf(-mt); }
        }
        __syncthreads();
    }
}

__device__ __forceinline__ void hyena_naive(const Ctx& C) {
    unsigned char* ws = C.ws;
    const bf16* hyt = (const bf16*)(ws + WS_HYT); const float* KT = (const float*)(ws + WS_KT); float* Z = (float*)(ws + WS_Z);
    const float* cw = C.A.in[3]; const float* cb = C.A.in[4]; const float* skip = C.A.in[11];
    LAS float* sv = (LAS float*)C.lds; LAS float* sk = sv + 2048;
    for (int u = blockIdx.x; u < NB * DHY; u += C.G) {
        const int b = u >> 10, c = u & 1023;
        float v[4], x1[4], x2[4];
#pragma unroll
        for (int part = 0; part < 3; ++part) {
            const int ch = part * 1024 + c; const bf16* row = hyt + (size_t)ch * T + b * SEQ;
            const float w0 = cw[ch], w1 = cw[3072 + ch], w2 = cw[6144 + ch], bb = cb[ch];
#pragma unroll
            for (int i = 0; i < 4; ++i) { const int t = C.tid + 512 * i;
                const float p = t > 0 ? bf2f(row[t - 1]) : 0.f, q = bf2f(row[t]), n = t < SEQ - 1 ? bf2f(row[t + 1]) : 0.f;
                const float r = w0 * p + w1 * q + w2 * n + bb;
                if (part == 0) v[i] = r; else if (part == 1) x1[i] = r; else x2[i] = r; }
        }
        __syncthreads();
#pragma unroll
        for (int i = 0; i < 4; ++i) sv[C.tid + 512 * i] = v[i];
#pragma unroll
        for (int i = 0; i < 8; ++i) sk[C.tid + 512 * i] = KT[(size_t)c * 4096 + C.tid + 512 * i];
        __syncthreads();
        float acc[4] = {0.f, 0.f, 0.f, 0.f};
        for (int s = 0; s < SEQ; ++s) { const float vv = sv[s];
#pragma unroll
            for (int i = 0; i < 4; ++i) acc[i] += sk[(C.tid + 512 * i - s) & 4095] * vv; }
        float z1[4]; const float sk0 = skip[c], sk1 = skip[1024 + c];
#pragma unroll
        for (int i = 0; i < 4; ++i) z1[i] = x1[i] * (acc[i] + sk0 * v[i]);
        __syncthreads();
#pragma unroll
        for (int i = 0; i < 4; ++i) sv[C.tid + 512 * i] = z1[i];
#pragma unroll
        for (int i = 0; i < 8; ++i) sk[C.tid + 512 * i] = KT[(size_t)(1024 + c) * 4096 + C.tid + 512 * i];
        __syncthreads();
#pragma unroll
        for (int i = 0; i < 4; ++i) acc[i] = 0.f;
        for (int s = 0; s < SEQ; ++s) { const float vv = sv[s];
#pragma unroll
            for (int i = 0; i < 4; ++i) acc[i] += sk[(C.tid + 512 * i - s) & 4095] * vv; }
#pragma unroll
        for (int i = 0; i < 4; ++i) Z[(size_t)(b * SEQ + C.tid + 512 * i) * 1024 + c] = x2[i] * (acc[i] + sk1 * z1[i]);
    }
    __syncthreads();
}

__device__ __forceinline__ void hyena_conv_once(LAS float* re, LAS float* im, int g, float (&xr)[16], float (&xi)[16], const f32x4* __restrict__ kf) {
    __syncthreads();
    dft16<false>(xr, xi); twiddle16<false>(xr, xi, g, 4096); fft_store_s256(re, im, g, xr, xi);
    __syncthreads();
    fft_load_s16(re, im, g, xr, xi); dft16<false>(xr, xi); twiddle16<false>(xr, xi, g & 15, 256); fft_store_s16(re, im, g, xr, xi);
    __syncthreads();
    fft_load_s1(re, im, g, xr, xi); dft16<false>(xr, xi);
#pragma unroll
    for (int k = 0; k < 8; ++k) { const f32x4 w = kf[g * 8 + k];
        const float r0 = xr[2 * k] * w.x - xi[2 * k] * w.y, i0 = xr[2 * k] * w.y + xi[2 * k] * w.x;
        const float r1 = xr[2 * k + 1] * w.z - xi[2 * k + 1] * w.w, i1 = xr[2 * k + 1] * w.w + xi[2 * k + 1] * w.z;
        xr[2 * k] = r0; xi[2 * k] = i0; xr[2 * k + 1] = r1; xi[2 * k + 1] = i1; }
    dft16<true>(xr, xi); fft_store_s1(re, im, g, xr, xi);
    __syncthreads();
    fft_load_s16(re, im, g, xr, xi); twiddle16<true>(xr, xi, g & 15, 256); dft16<true>(xr, xi); fft_store_s16(re, im, g, xr, xi);
    __syncthreads();
    fft_load_s256(re, im, g, xr, xi); twiddle16<true>(xr, xi, g, 4096); dft16<true>(xr, xi);
}
__device__ __forceinline__ void hyena_fft(const Ctx& C) {
    unsigned char* ws = C.ws;
    const bf16* hyt = (const bf16*)(ws + WS_HYT); const f32x4* KF = (const f32x4*)(ws + WS_KF); float* ZT = (float*)(ws + WS_ZT);
    const float* cw = C.A.in[3]; const float* cb = C.A.in[4]; const float* skip = C.A.in[11];
    const int half = C.tid >> 8, g = C.tid & 255;
    LAS float* re = (LAS float*)(C.lds + half * (2 * FFT_WORDS * 4)); LAS float* im = re + FFT_WORDS;
    for (int c = blockIdx.x; c < DHY; c += C.G) {
        float vr[8], vi[8], ar[8], ai[8], br[8], bi[8];
#pragma unroll
        for (int part = 0; part < 3; ++part) {
            const int ch = part * 1024 + c; const float w0 = cw[ch], w1 = cw[3072 + ch], w2 = cw[6144 + ch], bb = cb[ch];
#pragma unroll
            for (int bq = 0; bq < 2; ++bq) { const bf16* row = hyt + (size_t)ch * T + (2 * half + bq) * SEQ;
#pragma unroll
                for (int m = 0; m < 8; ++m) { const int t = g + 256 * m;
                    const float p = t > 0 ? bf2f(row[t - 1]) : 0.f, q = bf2f(row[t]), n = t < SEQ - 1 ? bf2f(row[t + 1]) : 0.f;
                    const float r = w0 * p + w1 * q + w2 * n + bb;
                    if (part == 0) { if (bq == 0) vr[m] = r; else vi[m] = r; } else if (part == 1) { if (bq == 0) ar[m] = r; else ai[m] = r; } else { if (bq == 0) br[m] = r; else bi[m] = r; } }
                asm volatile("" ::: "memory"); }
        }
        const float sk0 = skip[c], sk1 = skip[1024 + c];
        float xr[16], xi[16];
#pragma unroll
        for (int m = 0; m < 8; ++m) { xr[m] = vr[m]; xi[m] = vi[m]; xr[m + 8] = 0.f; xi[m + 8] = 0.f; }
        hyena_conv_once(re, im, g, xr, xi, KF + (size_t)c * 2048);
#pragma unroll
        for (int m = 0; m < 8; ++m) { vr[m] = ar[m] * (xr[m] + sk0 * vr[m]); vi[m] = ai[m] * (xi[m] + sk0 * vi[m]); xr[m] = vr[m]; xi[m] = vi[m]; xr[m + 8] = 0.f; xi[m + 8] = 0.f; }
        hyena_conv_once(re, im, g, xr, xi, KF + (size_t)(1024 + c) * 2048);
        float* zr = ZT + (size_t)c * T + (2 * half) * SEQ;
#pragma unroll
        for (int m = 0; m < 8; ++m) { const int t = g + 256 * m; zr[t] = br[m] * (xr[m] + sk1 * vr[m]); zr[SEQ + t] = bi[m] * (xi[m] + sk1 * vi[m]); }
    }
    __syncthreads();
}

__device__ __forceinline__ void mlstm_naive(const Ctx& C) {
    unsigned char* ws = C.ws;
    const bf16* qkc = (const bf16*)(ws + WS_QKC); const bf16* vb = (const bf16*)(ws + WS_VB);
    const float* GA = (const float*)(ws + WS_GA); const float* GP = (const float*)(ws + WS_GP); const float* GE = (const float*)(ws + WS_GE);
    float* HML = (float*)(ws + WS_HML);
    LAS float* qs = (LAS float*)(C.lds + C.wave * 1024); LAS float* ps = qs + 128;
    const int lane = C.lane;
    for (int u = blockIdx.x; u < 64 * 32; u += C.G) {
        const int bhd = u >> 5, qb = u & 31, b = bhd >> 4, h = (bhd >> 1) & 7, dir = bhd & 1;
        for (int qi = 0; qi < 8; ++qi) {
            const int t = qb * 64 + C.wave * 8 + qi;
            { const unsigned w = *(const unsigned*)(qkc + (size_t)(b * SEQ + t) * 2048 + h * 128 + 2 * lane); qs[2 * lane] = bflo(w); qs[2 * lane + 1] = bfhi(w); }
            __builtin_amdgcn_wave_barrier(); LDS_WAIT();
            const float pmt = GP[bhd * 2048 + t];
            const int c_lo = dir ? (t >> 6) : 0, c_hi = dir ? 31 : (t >> 6);
            float acc0 = 0.f, acc1 = 0.f, den = 0.f;
            for (int cch = c_lo; cch <= c_hi; ++cch) {
                const int s = cch * 64 + lane; const bool valid = dir ? (s >= t) : (s <= t);
                const v4u* kr = (const v4u*)(qkc + (size_t)(b * SEQ + s) * 2048 + 1024 + h * 128);
                float sc = 0.f;
#pragma unroll
                for (int j = 0; j < 16; ++j) { const v4u kk = kr[j];
#pragma unroll
                    for (int e = 0; e < 4; ++e) sc += qs[8 * j + 2 * e] * bflo(kk[e]) + qs[8 * j + 2 * e + 1] * bfhi(kk[e]); }
                const float p = valid ? sc * expf(GA[bhd * 2048 + s] - pmt) : 0.f;
                den += p;
                __builtin_amdgcn_wave_barrier();
                ps[lane] = p;
                __builtin_amdgcn_wave_barrier(); LDS_WAIT();
                const bf16* vr = vb + (size_t)(b * SEQ + cch * 64) * 1024 + h * 128 + 2 * lane;
#pragma unroll 8
                for (int s2 = 0; s2 < 64; ++s2) { const unsigned w = *(const unsigned*)(vr + (size_t)s2 * 1024); const float pv = ps[s2]; acc0 += pv * bflo(w); acc1 += pv * bfhi(w); }
                __builtin_amdgcn_wave_barrier();
            }
            den = wave_sum(den);
            const float scl = 1.0f / fmaxf(fabsf(den), GE[bhd * 2048 + t]);
            *(f32x2*)(HML + ((size_t)dir * T + b * SEQ + t) * 1024 + h * 128 + 2 * lane) = (f32x2){acc0 * scl, acc1 * scl};
            __builtin_amdgcn_wave_barrier();
        }
    }
    __syncthreads();
}

typedef short ml_bf16x8 __attribute__((ext_vector_type(8)));
typedef short ml_s16x4 __attribute__((ext_vector_type(4)));
typedef float ml_f32x16 __attribute__((ext_vector_type(16)));
typedef __bf16 ml_bf2 __attribute__((ext_vector_type(2)));
constexpr int ML_KROW = 272, ML_VROW = 136, ML_KBUF = 64 * ML_KROW, ML_VBUF = 128 * ML_VROW;
__device__ __forceinline__ unsigned ml_pk(float lo, float hi) { const f32x2 v = {lo, hi}; return __builtin_bit_cast(unsigned, __builtin_convertvector(v, ml_bf2)); }
__device__ __forceinline__ void mlstm_mfma(const Ctx& C) {
    unsigned char* ws = C.ws;
    const bf16* qkc = (const bf16*)(ws + WS_QKC); const bf16* vt = (const bf16*)(ws + WS_HYT) + (size_t)3072 * T;
    const float* GA = (const float*)(ws + WS_GA); const float* GP = (const float*)(ws + WS_GP); const float* GE = (const float*)(ws + WS_GE);
    float* HML = (float*)(ws + WS_HML);
    LAS unsigned char* KB = C.lds; LAS unsigned char* VB = C.lds + 2 * ML_KBUF; LAS float* AS = (LAS float*)(C.lds + 2 * ML_KBUF + 2 * ML_VBUF);
    const int w = C.wave, lane = C.lane, r = lane & 31, hh = lane >> 5, tid = C.tid;
    for (int pu = blockIdx.x; pu < 256; pu += C.G) {
        const int bhd = pu >> 2, pq = pu & 3, b = bhd >> 4, h = (bhd >> 1) & 7, dir = bhd & 1;
        __syncthreads();
        for (int i = tid; i < SEQ; i += NTHREADS) AS[i] = GA[bhd * SEQ + i];
        const bf16* kbase = qkc + (size_t)(b * SEQ) * 2048 + 1024 + h * 128;
        const bf16* vbase = vt + (size_t)(h * 128) * T + b * SEQ;
#pragma unroll 1
        for (int hf = 0; hf < 2; ++hf) {
            const int qb = hf ? 7 - pq : pq;
            const int qlo = 256 * qb + 32 * w, tq = qlo + r;
            ml_bf16x8 qf[8];
            { const bf16* qrow = qkc + (size_t)(b * SEQ + tq) * 2048 + h * 128 + 8 * hh;
#pragma unroll
              for (int s = 0; s < 8; ++s) qf[s] = *(const ml_bf16x8*)(qrow + 16 * s); }
            const float pmt = GP[bhd * SEQ + tq];
            ml_f32x16 O[4];
#pragma unroll
            for (int d = 0; d < 4; ++d)
#pragma unroll
                for (int i = 0; i < 16; ++i) O[d][i] = 0.f;
            float den = 0.f;
            const int kt0 = dir ? 4 * qb : 0, kt1 = dir ? 31 : 4 * qb + 3;
            v4u kr0, kr1, vr0, vr1;
#define ML_LOAD(kt) do { const int p0 = tid, p1 = tid + 512; \
                kr0 = *(const v4u*)(kbase + (size_t)(64 * (kt) + (p0 >> 4)) * 2048 + (p0 & 15) * 8); kr1 = *(const v4u*)(kbase + (size_t)(64 * (kt) + (p1 >> 4)) * 2048 + (p1 & 15) * 8); \
                vr0 = *(const v4u*)(vbase + (size_t)(p0 >> 3) * T + 64 * (kt) + (p0 & 7) * 8); vr1 = *(const v4u*)(vbase + (size_t)(p1 >> 3) * T + 64 * (kt) + (p1 & 7) * 8); } while (0)
#define ML_STORE(buf) do { const int p0 = tid, p1 = tid + 512; \
                *(LAS v4u*)(KB + (buf) * ML_KBUF + (p0 >> 4) * ML_KROW + (p0 & 15) * 16) = kr0; *(LAS v4u*)(KB + (buf) * ML_KBUF + (p1 >> 4) * ML_KROW + (p1 & 15) * 16) = kr1; \
                { LAS unsigned char* d0 = VB + (buf) * ML_VBUF + (p0 >> 3) * ML_VROW + (p0 & 7) * 16; *(LAS v2u*)d0 = (v2u){vr0.x, vr0.y}; *(LAS v2u*)(d0 + 8) = (v2u){vr0.z, vr0.w}; } \
                { LAS unsigned char* d1 = VB + (buf) * ML_VBUF + (p1 >> 3) * ML_VROW + (p1 & 7) * 16; *(LAS v2u*)d1 = (v2u){vr1.x, vr1.y}; *(LAS v2u*)(d1 + 8) = (v2u){vr1.z, vr1.w}; } } while (0)
            ML_LOAD(kt0);
            __syncthreads();
            ML_STORE(0);
            __syncthreads();
#pragma unroll 1
            for (int kt = kt0; kt <= kt1; ++kt) {
                const int cur = (kt - kt0) & 1;
                if (kt < kt1) ML_LOAD(kt + 1);
                const int klo = 64 * kt, khi = klo + 63, qhi = qlo + 31;
                const bool none = dir ? (khi < qlo) : (klo > qhi);
                const bool all = dir ? (klo >= qhi) : (khi <= qlo);
                if (!none) {
                    const LAS unsigned char* Kb = KB + cur * ML_KBUF; const LAS unsigned char* Vb = VB + cur * ML_VBUF;
                    ml_f32x16 S0, S1;
#pragma unroll
                    for (int i = 0; i < 16; ++i) { S0[i] = 0.f; S1[i] = 0.f; }
#pragma unroll
                    for (int s = 0; s < 8; ++s) {
                        const ml_bf16x8 k0 = *(const LAS ml_bf16x8*)(Kb + r * ML_KROW + (16 * s + 8 * hh) * 2);
                        const ml_bf16x8 k1 = *(const LAS ml_bf16x8*)(Kb + (32 + r) * ML_KROW + (16 * s + 8 * hh) * 2);
                        S0 = __builtin_amdgcn_mfma_f32_32x32x16_bf16(k0, qf[s], S0, 0, 0, 0);
                        S1 = __builtin_amdgcn_mfma_f32_32x32x16_bf16(k1, qf[s], S1, 0, 0, 0);
                    }
#pragma unroll
                    for (int kb = 0; kb < 2; ++kb)
#pragma unroll
                        for (int g4 = 0; g4 < 4; ++g4) {
                            const f32x4 a4 = *(const LAS f32x4*)(AS + klo + 32 * kb + 8 * g4 + 4 * hh);
#pragma unroll
                            for (int e = 0; e < 4; ++e) {
                                const int i = 4 * g4 + e; const int sg = klo + 32 * kb + 8 * g4 + 4 * hh + e;
                                const float sv = kb ? S1[i] : S0[i];
                                float p = sv * __expf(a4[e] - pmt);
                                if (!all) { const bool valid = dir ? (sg >= tq) : (sg <= tq); p = valid ? p : 0.f; }
                                den += p;
                                if (kb) S1[i] = p; else S0[i] = p;
                            }
                        }
#pragma unroll
                    for (int kb = 0; kb < 2; ++kb)
#pragma unroll
                        for (int s = 0; s < 2; ++s) {
                            v4u pw;
                            if (kb == 0) { pw.x = ml_pk(S0[8 * s], S0[8 * s + 1]); pw.y = ml_pk(S0[8 * s + 2], S0[8 * s + 3]); pw.z = ml_pk(S0[8 * s + 4], S0[8 * s + 5]); pw.w = ml_pk(S0[8 * s + 6], S0[8 * s + 7]); }
                            else { pw.x = ml_pk(S1[8 * s], S1[8 * s + 1]); pw.y = ml_pk(S1[8 * s + 2], S1[8 * s + 3]); pw.z = ml_pk(S1[8 * s + 4], S1[8 * s + 5]); pw.w = ml_pk(S1[8 * s + 6], S1[8 * s + 7]); }
                            const ml_bf16x8 pf = __builtin_bit_cast(ml_bf16x8, pw);
#pragma unroll
                            for (int db = 0; db < 4; ++db) {
                                const LAS unsigned char* vp = Vb + (32 * db + r) * ML_VROW + 2 * (32 * kb + 16 * s + 4 * hh);
                                const ml_s16x4 lo = *(const LAS ml_s16x4*)vp, hi = *(const LAS ml_s16x4*)(vp + 16);
                                const ml_bf16x8 vf = __builtin_shufflevector(lo, hi, 0, 1, 2, 3, 4, 5, 6, 7);
                                O[db] = __builtin_amdgcn_mfma_f32_32x32x16_bf16(vf, pf, O[db], 0, 0, 0);
                            }
                        }
                }
                if (kt < kt1) ML_STORE(cur ^ 1);
                __syncthreads();
            }
#undef ML_LOAD
#undef ML_STORE
            den += __shfl_xor(den, 32);
            const float scl = 1.0f / fmaxf(fabsf(den), GE[bhd * SEQ + tq]);
            float* orow = HML + ((size_t)dir * T + b * SEQ + tq) * 1024 + h * 128 + 4 * hh;
#pragma unroll
            for (int db = 0; db < 4; ++db)
#pragma unroll
                for (int g4 = 0; g4 < 4; ++g4)
                    *(f32x4*)(orow + 32 * db + 8 * g4) = (f32x4){O[db][4 * g4] * scl, O[db][4 * g4 + 1] * scl, O[db][4 * g4 + 2] * scl, O[db][4 * g4 + 3] * scl};
        }
    }
    __syncthreads();
}

__device__ __forceinline__ void phase4(const Ctx& C) {
    unsigned char* ws = C.ws;
    const float* ZT = (const float*)(ws + WS_ZT); const float* HML = (const float*)(ws + WS_HML); const bf16* ob = (const bf16*)(ws + WS_OB);
    bf16* ycat = (bf16*)(ws + (size_t)YCAT_T0 * MiB); const float* hyw = C.A.in[12]; const float* mlw = C.A.in[15];
    const int lane = C.lane;
    {
        LAS float* red = (LAS float*)C.lds;
        for (int u = blockIdx.x; u < 128 * 8; u += C.G) {
            const int tt = u >> 3, gi = u & 7, tok = tt * 64 + lane, ch0 = gi * 128 + C.wave * 16;
            float x[16]; float s = 0.f;
#pragma unroll
            for (int i = 0; i < 16; ++i) { x[i] = ZT[(size_t)(ch0 + i) * T + tok]; s += x[i]; }
            __syncthreads();
            red[C.wave * 64 + lane] = s;
            __syncthreads();
            float tot = 0.f;
#pragma unroll
            for (int w = 0; w < 8; ++w) tot += red[w * 64 + lane];
            const float mu = tot * (1.0f / 128.0f); float q = 0.f;
#pragma unroll
            for (int i = 0; i < 16; ++i) { x[i] -= mu; q += x[i] * x[i]; }
            __syncthreads();
            red[C.wave * 64 + lane] = q;
            __syncthreads();
            float qt = 0.f;
#pragma unroll
            for (int w = 0; w < 8; ++w) qt += red[w * 64 + lane];
            const float rstd = 1.0f / sqrtf(qt * (1.0f / 128.0f) + LN_EPS);
            float y[16];
#pragma unroll
            for (int i = 0; i < 16; ++i) y[i] = x[i] * rstd * hyw[ch0 + i];
            v4u w0, w1; w0.x = pk2(y[0], y[1]); w0.y = pk2(y[2], y[3]); w0.z = pk2(y[4], y[5]); w0.w = pk2(y[6], y[7]);
            w1.x = pk2(y[8], y[9]); w1.y = pk2(y[10], y[11]); w1.z = pk2(y[12], y[13]); w1.w = pk2(y[14], y[15]);
            bf16* dst = ycat + (size_t)tok * 2048 + ch0;
            *(v4u*)dst = w0; *(v4u*)(dst + 8) = w1;
        }
        __syncthreads();
    }
    for (int tok = C.gw; tok < T; tok += C.NGW) {
        float x[16];
#pragma unroll
        for (int j = 0; j < 4; ++j) { const f32x4 a = *(const f32x4*)(HML + (size_t)tok * 1024 + lane * 16 + 4 * j), bq = *(const f32x4*)(HML + ((size_t)T + tok) * 1024 + lane * 16 + 4 * j);
            x[4 * j] = a.x + bq.x; x[4 * j + 1] = a.y + bq.y; x[4 * j + 2] = a.z + bq.z; x[4 * j + 3] = a.w + bq.w; }
        float s = 0.f;
#pragma unroll
        for (int j = 0; j < 16; ++j) s += x[j];
        s += __shfl_xor(s, 1); s += __shfl_xor(s, 2); s += __shfl_xor(s, 4);
        const float mu = s * (1.0f / 128.0f); float q = 0.f;
#pragma unroll
        for (int j = 0; j < 16; ++j) { x[j] -= mu; q += x[j] * x[j]; }
        q += __shfl_xor(q, 1); q += __shfl_xor(q, 2); q += __shfl_xor(q, 4);
        const float rstd = 1.0f / sqrtf(q * (1.0f / 128.0f) + LN_EPS);
        const float* gw = mlw + lane * 16;
        float y[16];
#pragma unroll
        for (int j = 0; j < 16; ++j) y[j] = x[j] * rstd * gw[j];
        const v4u o0 = *(const v4u*)(ob + (size_t)tok * 1024 + lane * 16), o1 = *(const v4u*)(ob + (size_t)tok * 1024 + lane * 16 + 8);
#pragma unroll
        for (int j = 0; j < 4; ++j) { const float a0 = bflo(o0[j]), a1 = bfhi(o0[j]), b0 = bflo(o1[j]), b1 = bfhi(o1[j]);
            y[2 * j] *= 1.0f / (1.0f + expf(-a0)); y[2 * j + 1] *= 1.0f / (1.0f + expf(-a1)); y[8 + 2 * j] *= 1.0f / (1.0f + expf(-b0)); y[8 + 2 * j + 1] *= 1.0f / (1.0f + expf(-b1)); }
        v4u w0, w1; w0.x = pk2(y[0], y[1]); w0.y = pk2(y[2], y[3]); w0.z = pk2(y[4], y[5]); w0.w = pk2(y[6], y[7]);
        w1.x = pk2(y[8], y[9]); w1.y = pk2(y[10], y[11]); w1.z = pk2(y[12], y[13]); w1.w = pk2(y[14], y[15]);
        bf16* dst = ycat + (size_t)tok * 2048 + 1024 + lane * 16;
        *(v4u*)dst = w0; *(v4u*)(dst + 8) = w1;
    }
}

struct TileOrder {
    int nM, nN, a0, b0, G, c;
    __device__ __forceinline__ bool next(int i, pg8::Unit& u) const {
        const int nwg = nM * nN; const int L = i * G + c; if (L >= nwg) return false;
        int w; { const int q = nwg / 8, r = nwg % 8, xcd = L % 8, off = L / 8; w = (xcd < r ? xcd * (q + 1) : r * (q + 1) + (xcd - r) * q) + off; }
        const int nig = 8 * nN, gid = w / nig, wi = w % nig; u.pm = a0 + gid * 8 + (wi % 8); u.pn = b0 + wi / 8; return true;
    }
    __device__ __forceinline__ void a_ready(const pg8::Unit&) const {}
    __device__ __forceinline__ void done(const pg8::Unit&) const {}
};
struct EpiOut {
    static constexpr bool PERM = false, AFTER_DRAIN = false;
    const float* x; const float* bias; float* r1;
    __device__ __forceinline__ void operator()(const pg8::f32x4 (&acc)[2][2][4][2], const pg8::Unit& u, int wr, int wc, int fr, int fq) const {
        const int row0 = (u.pm - YCAT_T0) * 256 + wr * 64 + fr, col0 = (u.pn - WOUT_T0) * 256 + wc * 32 + 4 * fq;
        pg8::f32x4 bv[2][2];
#pragma unroll
        for (int bj = 0; bj < 2; ++bj)
#pragma unroll
            for (int n = 0; n < 2; ++n) bv[bj][n] = *(const pg8::f32x4*)(bias + col0 + bj * 128 + n * 16);
#pragma unroll
        for (int ai = 0; ai < 2; ++ai)
#pragma unroll
            for (int m = 0; m < 4; ++m) { const size_t off = (size_t)(row0 + ai * 128 + m * 16) * D + col0;
#pragma unroll
                for (int bj = 0; bj < 2; ++bj)
#pragma unroll
                    for (int n = 0; n < 2; ++n) { const pg8::f32x4 xs = *(const pg8::f32x4*)(x + off + bj * 128 + n * 16);
                        *(pg8::f32x4*)(r1 + off + bj * 128 + n * 16) = xs * DN_ALPHA + acc[ai][bj][m][n] + bv[bj][n]; } }
    }
};

#define P6_RS_STEP(NV, XM) do { const bool up = (lane & (XM)) != 0; _Pragma("unroll") for (int e_ = 0; e_ < (NV); ++e_) { \
        const float keep0 = up ? a0[e_ + (NV)] : a0[e_], send0 = up ? a0[e_] : a0[e_ + (NV)]; a0[e_] = keep0 + __shfl_xor(send0, (XM)); \
        const float keep1 = up ? a1[e_ + (NV)] : a1[e_], send1 = up ? a1[e_] : a1[e_ + (NV)]; a1[e_] = keep1 + __shfl_xor(send1, (XM)); } } while (0)
__device__ __forceinline__ void phase6(const Ctx& C, int dummy) {
    unsigned char* ws = C.ws;
    float* r1 = (float*)(ws + WS_R1); bf16* x1b = (bf16*)(ws + (size_t)X1B_T0 * MiB);
    const float* g1 = C.A.in[18]; const float* b1 = C.A.in[19]; const float* rw = C.A.in[20]; const float* rb = C.A.in[21];
    unsigned* cnt = (unsigned*)(ws + WS_CTL) + CW_CNT + (dummy ? 4096 : 0); int* list = (int*)(ws + (dummy ? WS_YBUF : WS_LIST)); float* tokw = (float*)(ws + (dummy ? WS_YBUF + 2 * MiB : WS_TOKW));
    const int lane = C.lane;
    LAS unsigned char* wbuf = C.lds;
    for (int it = blockIdx.x; it < T / 16; it += C.G) {
        const int pair = it * 8 + C.wave;
        int ln = lane; asm volatile("" : "+v"(ln));
        f32x4 v0[8], v1[8];
#pragma unroll
        for (int tk = 0; tk < 2; ++tk) {
            const int tok = 2 * pair + tk; float* rr = r1 + (size_t)tok * D; f32x4 v[8]; float s = 0.f;
#pragma unroll
            for (int j = 0; j < 8; ++j) { v[j] = *(const f32x4*)(rr + (ln + 64 * j) * 4); s += (v[j].x + v[j].y) + (v[j].z + v[j].w); }
            const float mean = wave_sum(s) * (1.0f / D); float q = 0.f;
#pragma unroll
            for (int j = 0; j < 8; ++j) { v[j] = v[j] - mean; q += (v[j].x * v[j].x + v[j].y * v[j].y) + (v[j].z * v[j].z + v[j].w * v[j].w); }
            const float rstd = 1.0f / sqrtf(wave_sum(q) * (1.0f / D) + LN_EPS);
#pragma unroll
            for (int j = 0; j < 8; ++j) { const int c0 = (ln + 64 * j) * 4; const f32x4 gg = *(const f32x4*)(g1 + c0), bb = *(const f32x4*)(b1 + c0);
                const f32x4 y = v[j] * rstd * gg + bb;
                if (!dummy) { *(f32x4*)(rr + c0) = y; v2u w; w.x = pk2(y.x, y.y); w.y = pk2(y.z, y.w); *(v2u*)(x1b + (size_t)tok * D + c0) = w; }
                if (tk == 0) v0[j] = y; else v1[j] = y; }
        }
        float a0[32], a1[32];
#pragma unroll
        for (int e = 0; e < 32; ++e) { a0[e] = 0.f; a1[e] = 0.f; }
        const int tid = C.tid; f32x4 st[4];
        const bool hi8 = (ln & 8) != 0;
        const unsigned rdoff = (unsigned)(4 * ln) * 128u, rdx = (unsigned)(ln & 7);
#define P6_CHUNK_LOAD(j_) do { _Pragma("unroll") for (int r_ = 0; r_ < 4; ++r_) st[r_] = *(const f32x4*)(rw + (size_t)(j_) * 8192 + (size_t)(tid + 512 * r_) * 4); } while (0)
#define P6_CHUNK_STORE(b_) do { _Pragma("unroll") for (int r_ = 0; r_ < 4; ++r_) { const int idx_ = tid + 512 * r_, row_ = idx_ >> 3, q_ = idx_ & 7; \
            *(LAS f32x4*)(wbuf + (b_) * 32768 + row_ * 128 + 16 * (q_ ^ ((row_ >> 2) & 7))) = st[r_]; } } while (0)
        __syncthreads();
        P6_CHUNK_LOAD(0); P6_CHUNK_STORE(0);
        __syncthreads();
#pragma unroll
        for (int j = 0; j < 8; ++j) {
            if (j < 7) P6_CHUNK_LOAD(j + 1);
            const LAS unsigned char* wb = wbuf + (j & 1) * 32768 + rdoff;
#pragma unroll
            for (int i = 0; i < 4; ++i) {
                const float x0 = hi8 ? v0[j][i ^ 1] : v0[j][i], x1 = hi8 ? v1[j][i ^ 1] : v1[j][i];
                const LAS unsigned char* wrow = wb + (hi8 ? (i ^ 1) : i) * 128;
#pragma unroll
                for (int q4 = 0; q4 < 8; ++q4) { const f32x4 w4 = *(const LAS f32x4*)(wrow + 16 * (q4 ^ rdx));
                    a0[4 * q4] += x0 * w4.x; a0[4 * q4 + 1] += x0 * w4.y; a0[4 * q4 + 2] += x0 * w4.z; a0[4 * q4 + 3] += x0 * w4.w;
                    a1[4 * q4] += x1 * w4.x; a1[4 * q4 + 1] += x1 * w4.y; a1[4 * q4 + 2] += x1 * w4.z; a1[4 * q4 + 3] += x1 * w4.w; }
            }
            if (j < 7) P6_CHUNK_STORE((j + 1) & 1);
            __syncthreads();
        }
#undef P6_CHUNK_LOAD
#undef P6_CHUNK_STORE
        P6_RS_STEP(16, 32); P6_RS_STEP(8, 16); P6_RS_STEP(4, 8); P6_RS_STEP(2, 4); P6_RS_STEP(1, 2);
        const int e = lane >> 1; const float rbe = rb[e];
        float lg0 = a0[0] + __shfl_xor(a0[0], 1) + rbe, lg1 = a1[0] + __shfl_xor(a1[0], 1) + rbe;
#pragma unroll
        for (int tk = 0; tk < 2; ++tk) {
            const int tok = 2 * pair + tk; float val = tk ? lg1 : lg0; float vals[4]; int idxs[4];
#pragma unroll
            for (int k = 0; k < 4; ++k) {
                const float m = wave_max(val);
                const unsigned long long bal = __ballot(val == m);
                const int idx = (int)(__builtin_ctzll(bal) >> 1);
                vals[k] = m; idxs[k] = idx;
                if (e == idx) val = -3.0e38f;
            }
            const float e1 = expf(vals[1] - vals[0]), e2 = expf(vals[2] - vals[0]), e3 = expf(vals[3] - vals[0]);
            const float inv = 1.0f / (1.0f + e1 + e2 + e3);
            if (lane < 4) {
                const int sel_e = lane == 0 ? idxs[0] : lane == 1 ? idxs[1] : lane == 2 ? idxs[2] : idxs[3];
                const float sel_v = (lane == 0 ? 1.0f : lane == 1 ? e1 : lane == 2 ? e2 : e3) * inv;
                const unsigned pos = atomicAdd(cnt + 64 * sel_e, 1u);
                list[sel_e * T + pos] = tok * 4 + lane; tokw[tok * 4 + lane] = sel_v;
            }
        }
    }
}
#undef P6_RS_STEP

__device__ __forceinline__ void moe_build_tb(const Ctx& C) {
    LAS int* tb = (LAS int*)(C.lds + LDS_TB);
    __syncthreads();
    if (C.tid == 0) { const unsigned* cnt = (const unsigned*)(C.ws + WS_CTL) + CW_CNT; int acc = 0;
        for (int e = 0; e < NE; ++e) { const int n = (int)__hip_atomic_load(cnt + 64 * e, __ATOMIC_RELAXED, __HIP_MEMORY_SCOPE_AGENT); tb[e] = acc; tb[40 + e] = n; acc += (n + 255) >> 8; }
        tb[32] = acc; }
    __syncthreads();
}
__device__ __forceinline__ void phase7(const Ctx& C) {
    unsigned char* ws = C.ws;
    moe_build_tb(C);
    const LAS int* tb = (const LAS int*)(C.lds + LDS_TB);
    const bf16* x1b = (const bf16*)(ws + (size_t)X1B_T0 * MiB); bf16* abuf = (bf16*)(ws + (size_t)ABUF_T0 * MiB);
    const int* list = (const int*)(ws + WS_LIST); const float* tokw = (const float*)(ws + WS_TOKW);
    int* rowslot = (int*)(ws + WS_ROWSLOT); float* roww = (float*)(ws + WS_ROWW);
    const int total_rows = tb[32] * 256;
    for (int row = C.gw; row < total_rows; row += C.NGW) {
        int e = 0; const int rt = row >> 8;
        while (e < NE - 1 && tb[e + 1] <= rt) ++e;
        const int i = row - tb[e] * 256; const int n = tb[40 + e];
        v4u* dst = (v4u*)(abuf + (size_t)row * D);
        if (i < n) { const int slot = list[e * T + i]; const v4u* src = (const v4u*)(x1b + (size_t)(slot >> 2) * D);
#pragma unroll
            for (int j = 0; j < 4; ++j) dst[C.lane + 64 * j] = src[C.lane + 64 * j];
            if (C.lane == 0) { rowslot[row] = slot; roww[row] = tokw[slot]; } }
        else {
#pragma unroll
            for (int j = 0; j < 4; ++j) dst[C.lane + 64 * j] = (v4u){0u, 0u, 0u, 0u};
            if (C.lane == 0) { rowslot[row] = -1; roww[row] = 0.f; } }
    }
}
struct MoeOrder {
    const LAS int* tb; int NJ, a0, w0, G, c; const int* list;
    __device__ __forceinline__ int a_row(const pg8::Unit& u, int r) const { const int e = (u.pn - w0) / NJ; const int i = (u.pm - a0 - tb[e]) * 256 + r; return i < tb[40 + e] ? (list[e * T + i] >> 2) : 0; }
    __device__ __forceinline__ bool next(int i, pg8::Unit& u) const {
        const int nwg = tb[32] * NJ; const int L = i * G + c; if (L >= nwg) return false;
        int w; { const int q = nwg / 8, r = nwg % 8, xcd = L % 8, off = L / 8; w = (xcd < r ? xcd * (q + 1) : r * (q + 1) + (xcd - r) * q) + off; }
        int e = 0;
        while (e < NE - 1 && tb[e + 1] * NJ <= w) ++e;
        const int local = w - tb[e] * NJ, nt = tb[e + 1] - tb[e], j = local / nt, ti = local - j * nt;
        u.pm = __builtin_amdgcn_readfirstlane(a0 + tb[e] + ti); u.pn = __builtin_amdgcn_readfirstlane(w0 + e * NJ + j); return true;
    }
    __device__ __forceinline__ void a_ready(const pg8::Unit&) const {}
    __device__ __forceinline__ void done(const pg8::Unit&) const {}
};
struct EpiGU {
    static constexpr bool PERM = true, AFTER_DRAIN = false;
    const float* b_gu; bf16* act;
    __device__ __forceinline__ void operator()(const pg8::f32x4 (&acc)[2][2][4][2], const pg8::Unit& u, int wr, int wc, int fr_, int fq_) const {
        int ln_ = threadIdx.x & 63; asm volatile("" : "+v"(ln_));
        const int fr = ln_ & 15, fq = ln_ >> 4;
        using pg8::cvt_pk_bf16;
        const int rt = u.pm - ABUF_T0, rel = u.pn - WGU_T0, e = rel >> 4, j = rel & 15;
        const int col0 = j * 128 + wc * 32 + 8 * fq;
        pg8::f32x4 bg[2], bu[2];
#pragma unroll
        for (int n = 0; n < 2; ++n) { bg[n] = *(const pg8::f32x4*)(b_gu + (size_t)e * 4096 + col0 + 4 * n); bu[n] = *(const pg8::f32x4*)(b_gu + (size_t)e * 4096 + 2048 + col0 + 4 * n); }
#pragma unroll
        for (int ai = 0; ai < 2; ++ai)
#pragma unroll
            for (int m = 0; m < 4; ++m) { const int row = rt * 256 + ai * 128 + wr * 64 + m * 16 + fr;
                float o[8];
#pragma unroll
                for (int n = 0; n < 2; ++n) { const pg8::f32x4 g = acc[ai][0][m][n] + bg[n], up = acc[ai][1][m][n] + bu[n];
#pragma unroll
                    for (int i = 0; i < 4; ++i) { const float gc = fminf(g[i], 7.0f), uc = fminf(fmaxf(up[i], -7.0f), 7.0f);
                        o[4 * n + i] = (uc + 1.0f) * (gc / (1.0f + __expf(-1.702f * gc))); } }
                v4u w; w.x = cvt_pk_bf16(o[0], o[1]); w.y = cvt_pk_bf16(o[2], o[3]); w.z = cvt_pk_bf16(o[4], o[5]); w.w = cvt_pk_bf16(o[6], o[7]);
                *(v4u*)(act + (size_t)row * DFF + col0) = w; }
    }
};
struct EpiNone {
    static constexpr bool PERM = true, AFTER_DRAIN = false; float* sink;
    __device__ __forceinline__ void operator()(const pg8::f32x4 (&acc)[2][2][4][2], const pg8::Unit& u, int wr, int wc, int fr, int fq) const {
        pg8::f32x4 t = acc[0][0][0][0];
#pragma unroll
        for (int ai = 0; ai < 2; ++ai)
#pragma unroll
            for (int bj = 0; bj < 2; ++bj)
#pragma unroll
                for (int m = 0; m < 4; ++m)
#pragma unroll
                    for (int n = 0; n < 2; ++n) t = t + acc[ai][bj][m][n];
        if (t[0] == 123.456f) sink[threadIdx.x] = t[1] + t[2] + t[3];
    }
};
struct EpiDown {
    static constexpr bool PERM = true, AFTER_DRAIN = false;
    const float* b_down; const int* list; const float* tokw; const LAS int* tb; bf16* ybuf;
    __device__ __forceinline__ void operator()(const pg8::f32x4 (&acc)[2][2][4][2], const pg8::Unit& u, int wr, int wc, int fr_, int fq_) const {
        using pg8::cvt_pk_bf16;
        int ln_ = threadIdx.x & 63; asm volatile("" : "+v"(ln_));
        const int fr = ln_ & 15, fq = ln_ >> 4;
        const int rel = u.pn - WDN_T0, e = rel >> 3, j = rel & 7, ti = u.pm - ACT_T0 - tb[e], n_e = tb[40 + e];
        const int col0 = j * 256 + wc * 32 + 8 * fq;
        pg8::f32x4 bv[2][2];
#pragma unroll
        for (int bj = 0; bj < 2; ++bj)
#pragma unroll
            for (int n = 0; n < 2; ++n) bv[bj][n] = *(const pg8::f32x4*)(b_down + (size_t)e * D + col0 + bj * 128 + 4 * n);
#pragma unroll
        for (int ai = 0; ai < 2; ++ai)
#pragma unroll
            for (int m = 0; m < 4; ++m) { const int i = ti * 256 + ai * 128 + wr * 64 + m * 16 + fr;
                if (i < n_e) { const int slot = list[e * T + i]; const float w = tokw[slot]; bf16* dst = ybuf + (size_t)slot * D + col0;
#pragma unroll
                    for (int bj = 0; bj < 2; ++bj) { const pg8::f32x4 v0 = (acc[ai][bj][m][0] + bv[bj][0]) * w, v1 = (acc[ai][bj][m][1] + bv[bj][1]) * w;
                        v4u o; o.x = cvt_pk_bf16(v0[0], v0[1]); o.y = cvt_pk_bf16(v0[2], v0[3]); o.z = cvt_pk_bf16(v1[0], v1[1]); o.w = cvt_pk_bf16(v1[2], v1[3]);
                        *(v4u*)(dst + bj * 128) = o; } } }
    }
};

namespace pg8 {
template <class Epi, class Sched>
__device__ __forceinline__ void gemm_phase_ga(PG8_LAS unsigned char* lds, const bf16_t* Arows, const bf16_t* Btiles, const int K, const Sched& S, const Epi& E) {
    const int tid = threadIdx.x, wid = __builtin_amdgcn_readfirstlane(tid >> 6), lane = tid & 63, wr = wid >> 2, wc = wid & 3, fr = lane & 15, fq = lane >> 4;
    const int nt = K / BK;
    int sR[2], sC[2]; unsigned voffB[2];
#pragma unroll
    for (int i = 0; i < 2; ++i) { int R, Cc; stage_rc(tid * 16 + i * 8192, R, Cc); sR[i] = R; sC[i] = Cc; const int Rb = Epi::PERM ? ((R & ~31) + perm32(R & 31)) : R; voffB[i] = (unsigned)(Rb * K + Cc) * 2u; }
    const size_t kstep = (size_t)(BK * 2), hstep = (size_t)HALF * K * 2, tstep = 2 * hstep;
    const unsigned ldsw = (unsigned)wid * 1024u;
    const int aoff = lds_byte(wr * 64 + fr, fq * 8), boff = lds_byte(wc * 32 + fr, fq * 8);
#define PG8_SA(b, h) (((b) * 2 + (h)) * HTB)
#define PG8_SB(b, h) ((4 + (b) * 2 + (h)) * HTB)
#define PG8_STAGE(bufoff, gbase, voff) do { _Pragma("unroll") for (int _i = 0; _i < 2; ++_i) \
        __builtin_amdgcn_global_load_lds((const unsigned*)((const char*)(gbase) + (voff)[_i]), (PG8_LAS unsigned*)(lds + (bufoff) + ldsw + _i * 8192), 16, 0, 0); } while (0)
#define PG8_STAGE2(bufoff, gbase, v0, v1) do { \
        __builtin_amdgcn_global_load_lds((const unsigned*)((const char*)(gbase) + (v0)), (PG8_LAS unsigned*)(lds + (bufoff) + ldsw), 16, 0, 0); \
        __builtin_amdgcn_global_load_lds((const unsigned*)((const char*)(gbase) + (v1)), (PG8_LAS unsigned*)(lds + (bufoff) + ldsw + 8192), 16, 0, 0); } while (0)
#define PG8_LDA(dst, b, h) do { _Pragma("unroll") for (int m = 0; m < 4; ++m) _Pragma("unroll") for (int k = 0; k < 2; ++k) dst[m][k] = *(const PG8_LAS bf16x8*)(lds + PG8_SA(b, h) + aoff + m * 2048 + k * 1024); } while (0)
#define PG8_LDB(dst, b, h) do { _Pragma("unroll") for (int n = 0; n < 2; ++n) _Pragma("unroll") for (int k = 0; k < 2; ++k) dst[n][k] = *(const PG8_LAS bf16x8*)(lds + PG8_SB(b, h) + boff + n * 2048 + k * 1024); } while (0)
#define PG8_MMA(ai, bj, At, Bt) do { __builtin_amdgcn_s_setprio(1); _Pragma("unroll") for (int m = 0; m < 4; ++m) _Pragma("unroll") for (int n = 0; n < 2; ++n) _Pragma("unroll") for (int k = 0; k < 2; ++k) \
        acc[ai][bj][m][n] = __builtin_amdgcn_mfma_f32_16x16x32_bf16(Bt[n][k], At[m][k], acc[ai][bj][m][n], 0, 0, 0); __builtin_amdgcn_s_setprio(0); } while (0)
#define PG8_WAIT_V(n) asm volatile("s_waitcnt vmcnt(" #n ")" ::: "memory")
#define PG8_WAIT_L(n) asm volatile("s_waitcnt lgkmcnt(" #n ")" ::: "memory")
#define PG8_BAR __builtin_amdgcn_s_barrier()
#define PG8_SCHED __builtin_amdgcn_sched_barrier(0)
#define PG8_AROWS(vo, u) do { _Pragma("unroll") for (int _h = 0; _h < 2; ++_h) _Pragma("unroll") for (int _i = 0; _i < 2; ++_i) vo[_h * 2 + _i] = (unsigned)S.a_row(u, _h * 128 + sR[_i]) * (unsigned)(K * 2) + (unsigned)(sC[_i] * 2); } while (0)
    Unit cur, nxt; int ui = 0;
    if (!S.next(0, cur)) return;
    f32x4 acc[2][2][4][2];
#pragma unroll
    for (int a = 0; a < 2; ++a)
#pragma unroll
        for (int b = 0; b < 2; ++b)
#pragma unroll
            for (int m = 0; m < 4; ++m)
#pragma unroll
                for (int n = 0; n < 2; ++n) acc[a][b][m][n] = (f32x4){0.f, 0.f, 0.f, 0.f};
    bf16x8 At[4][2], B0[2][2], B1[2][2];
    unsigned voC[4], voN[4];
    PG8_AROWS(voC, cur);
    const char* cA = (const char*)Arows; const char* cB = (const char*)Btiles + (size_t)cur.pn * tstep;
    PG8_STAGE(PG8_SB(0, 0), cB, voffB); PG8_STAGE(PG8_SB(0, 1), cB + hstep, voffB); PG8_STAGE2(PG8_SA(0, 0), cA, voC[0], voC[1]); PG8_STAGE2(PG8_SA(0, 1), cA, voC[2], voC[3]);
    if (wr == 1) PG8_BAR;
    PG8_WAIT_V(2); PG8_BAR;
    PG8_STAGE(PG8_SB(1, 0), cB + kstep, voffB); PG8_STAGE2(PG8_SA(1, 0), cA + kstep, voC[0], voC[1]); PG8_STAGE(PG8_SB(1, 1), cB + hstep + kstep, voffB);
    PG8_WAIT_V(6); PG8_BAR;
    for (;;) {
        const bool has_next = S.next(ui + 1, nxt);
        if (has_next) { PG8_AROWS(voN, nxt); } else {
#pragma unroll
            for (int q = 0; q < 4; ++q) voN[q] = voC[q]; }
        const char* nB = has_next ? (const char*)Btiles + (size_t)nxt.pn * tstep : cB;
        for (int t = 0; t < nt; t += 2) {
            const bool last = (t == nt - 2);
            const char* a1 = cA + (size_t)(t + 1) * kstep;
            const char* a2 = last ? cA : cA + (size_t)(t + 2) * kstep; const char* b2 = last ? nB : cB + (size_t)(t + 2) * kstep;
            const char* a3 = a2 + kstep; const char* b3 = b2 + kstep;
            const unsigned x0 = last ? voN[0] : voC[0], x1 = last ? voN[1] : voC[1], x2 = last ? voN[2] : voC[2], x3 = last ? voN[3] : voC[3];
            PG8_LDB(B0, 0, 0); PG8_LDB(B1, 0, 1); PG8_SCHED; PG8_LDA(At, 0, 0); PG8_STAGE2(PG8_SA(1, 1), a1, voC[2], voC[3]);
            PG8_WAIT_V(8); PG8_WAIT_L(0); PG8_BAR; PG8_MMA(0, 0, At, B0); PG8_MMA(0, 1, At, B1); PG8_BAR; PG8_SCHED;
            PG8_LDA(At, 0, 1); PG8_STAGE(PG8_SB(0, 0), b2, voffB); PG8_STAGE(PG8_SB(0, 1), b2 + hstep, voffB); PG8_STAGE2(PG8_SA(0, 0), a2, x0, x1);
            PG8_WAIT_V(8); PG8_WAIT_L(0); PG8_BAR; PG8_MMA(1, 0, At, B0); PG8_MMA(1, 1, At, B1); PG8_BAR; PG8_SCHED;
            PG8_LDB(B0, 1, 0); PG8_LDB(B1, 1, 1); PG8_SCHED; PG8_LDA(At, 1, 0); PG8_STAGE2(PG8_SA(0, 1), a2, x2, x3);
            PG8_WAIT_V(8); PG8_WAIT_L(0); PG8_BAR; PG8_MMA(0, 0, At, B0); PG8_MMA(0, 1, At, B1); PG8_BAR; PG8_SCHED;
            PG8_LDA(At, 1, 1); PG8_STAGE(PG8_SB(1, 0), b3, voffB); PG8_STAGE(PG8_SB(1, 1), b3 + hstep, voffB); PG8_STAGE2(PG8_SA(1, 0), a3, x0, x1);
            PG8_WAIT_V(8); PG8_WAIT_L(0); PG8_BAR; PG8_MMA(1, 0, At, B0); PG8_MMA(1, 1, At, B1); PG8_BAR; PG8_SCHED;
        }
        if (wr == 0) PG8_BAR;
        E(acc, cur, wr, wc, fr, fq); S.done(cur);
        if (!has_next) break;
#pragma unroll
        for (int a = 0; a < 2; ++a)
#pragma unroll
            for (int b = 0; b < 2; ++b)
#pragma unroll
                for (int m = 0; m < 4; ++m)
#pragma unroll
                    for (int n = 0; n < 2; ++n) acc[a][b][m][n] = (f32x4){0.f, 0.f, 0.f, 0.f};
        cur = nxt; cB = nB; ++ui;
#pragma unroll
        for (int q = 0; q < 4; ++q) voC[q] = voN[q];
        if (wr == 1) PG8_BAR;
    }
    PG8_WAIT_V(0);
    PG8_BAR;
#undef PG8_SA
#undef PG8_SB
#undef PG8_STAGE
#undef PG8_STAGE2
#undef PG8_LDA
#undef PG8_LDB
#undef PG8_MMA
#undef PG8_WAIT_V
#undef PG8_WAIT_L
#undef PG8_BAR
#undef PG8_SCHED
#undef PG8_AROWS
}
}

namespace pg8 {
template <class Epi, class Sched, class BSrc>
__device__ __forceinline__ void gemm_phase_bf32(PG8_LAS unsigned char* lds, const bf16_t* Abase, const int K, const Sched& S, const Epi& E, const BSrc& BS) {
    const int tid = threadIdx.x, wid = __builtin_amdgcn_readfirstlane(tid >> 6), lane = tid & 63, wr = wid >> 2, wc = wid & 3, fr = lane & 15, fq = lane >> 4;
    const int nt = K / BK;
    unsigned voffA[2];
#pragma unroll
    for (int i = 0; i < 2; ++i) { int R, Cc; stage_rc(tid * 16 + i * 8192, R, Cc); voffA[i] = (unsigned)(R * K + Cc) * 2u; }
    const size_t kstep = (size_t)(BK * 2), hstep = (size_t)HALF * K * 2, tstep = 2 * hstep;
    const unsigned ldsw = (unsigned)wid * 1024u;
    const int aoff = lds_byte(wr * 64 + fr, fq * 8), boff = lds_byte(wc * 32 + fr, fq * 8);
    const int kh = wid >> 2, nq = wid & 3, ko = lane & 3, ng = lane >> 2;
    const size_t ldb4 = (size_t)BS.ldb * 4;
    const unsigned gvoff = (unsigned)((8 * ko) * BS.ldb + 4 * ng) * 4u;
    int wslot; { const int r0 = (64 * nq + 4 * ng) & 127; if (Epi::PERM) { const int x = (r0 & 31) >> 2; wslot = (r0 & ~31) + 16 * (x & 1) + 4 * (x >> 1); } else wslot = r0; }
    const unsigned wboff = (unsigned)((nq >> 1) * HTB + lds_byte(wslot, 32 * kh + 8 * ko));
    const bool ngodd = (ng & 1) != 0; const unsigned wbA = wboff + (ngodd ? 64u : 0u), wbB = wboff + (ngodd ? 0u : 64u);
    typedef unsigned u32x2v __attribute__((ext_vector_type(2)));
#define PG8_SA(b, h) (((b) * 2 + (h)) * HTB)
#define PG8_SB(b, h) ((4 + (b) * 2 + (h)) * HTB)
#define PG8_STAGE(bufoff, gbase, voff) do { _Pragma("unroll") for (int _i = 0; _i < 2; ++_i) \
        __builtin_amdgcn_global_load_lds((const unsigned*)((const char*)(gbase) + (voff)[_i]), (PG8_LAS unsigned*)(lds + (bufoff) + ldsw + _i * 8192), 16, 0, 0); } while (0)
#define PG8_LDA(dst, b, h) do { _Pragma("unroll") for (int m = 0; m < 4; ++m) _Pragma("unroll") for (int k = 0; k < 2; ++k) dst[m][k] = *(const PG8_LAS bf16x8*)(lds + PG8_SA(b, h) + aoff + m * 2048 + k * 1024); } while (0)
#define PG8_LDB(dst, b, h) do { _Pragma("unroll") for (int n = 0; n < 2; ++n) _Pragma("unroll") for (int k = 0; k < 2; ++k) dst[n][k] = *(const PG8_LAS bf16x8*)(lds + PG8_SB(b, h) + boff + n * 2048 + k * 1024); } while (0)
#define PG8_MMA(ai, bj, At, Bt) do { __builtin_amdgcn_s_setprio(1); _Pragma("unroll") for (int m = 0; m < 4; ++m) _Pragma("unroll") for (int n = 0; n < 2; ++n) _Pragma("unroll") for (int k = 0; k < 2; ++k) \
        acc[ai][bj][m][n] = __builtin_amdgcn_mfma_f32_16x16x32_bf16(Bt[n][k], At[m][k], acc[ai][bj][m][n], 0, 0, 0); __builtin_amdgcn_s_setprio(0); } while (0)
#define PG8_WAIT_V(n) asm volatile("s_waitcnt vmcnt(" #n ")" ::: "memory")
#define PG8_WAIT_L(n) asm volatile("s_waitcnt lgkmcnt(" #n ")" ::: "memory")
#define PG8_BAR __builtin_amdgcn_s_barrier()
#define PG8_SCHED __builtin_amdgcn_sched_barrier(0)
#define PG8_GLOAD_A(src_) do { const char* src = (src_); _Pragma("unroll") for (int _j = 0; _j < 4; ++_j) asm volatile("global_load_dwordx4 %0, %1, %2" : "=v"(ga[_j]) : "v"(gvoff), "s"(src + (size_t)_j * ldb4) : "memory"); } while (0)
#define PG8_GLOAD_B(src_) do { const char* src = (src_); _Pragma("unroll") for (int _j = 0; _j < 4; ++_j) asm volatile("global_load_dwordx4 %0, %1, %2" : "=v"(gb[_j]) : "v"(gvoff), "s"(src + (size_t)(_j + 4) * ldb4) : "memory"); } while (0)
#define PG8_GWAIT_A(n) asm volatile("s_waitcnt vmcnt(" #n ")" : "+v"(ga[0]), "+v"(ga[1]), "+v"(ga[2]), "+v"(ga[3]) :: "memory")
#define PG8_GWAIT_B(n) asm volatile("s_waitcnt vmcnt(" #n ")" : "+v"(gb[0]), "+v"(gb[1]), "+v"(gb[2]), "+v"(gb[3]) :: "memory")
#define PG8_GWRITE_H(b, gv, hoff) do { _Pragma("unroll") for (int _i = 0; _i < 4; ++_i) { \
        const unsigned _p0 = cvt_pk_bf16(gv[0][_i], gv[1][_i]), _p1 = cvt_pk_bf16(gv[2][_i], gv[3][_i]), _q0 = cvt_pk_bf16(gv[0][_i ^ 1], gv[1][_i ^ 1]), _q1 = cvt_pk_bf16(gv[2][_i ^ 1], gv[3][_i ^ 1]); \
        u32x2v _w; _w.x = ngodd ? _q0 : _p0; _w.y = ngodd ? _q1 : _p1; \
        *(PG8_LAS u32x2v*)(lds + PG8_SB(b, 0) + ((_i & 1) ? wbB : wbA) + 128 * (_i >> 1) + (hoff)) = _w; } } while (0)
    Unit cur, nxt; int ui = 0;
    if (!S.next(0, cur)) return;
    f32x4 acc[2][2][4][2];
#pragma unroll
    for (int a = 0; a < 2; ++a)
#pragma unroll
        for (int b = 0; b < 2; ++b)
#pragma unroll
            for (int m = 0; m < 4; ++m)
#pragma unroll
                for (int n = 0; n < 2; ++n) acc[a][b][m][n] = (f32x4){0.f, 0.f, 0.f, 0.f};
    bf16x8 At[4][2], B0[2][2], B1[2][2];
    f32x4 ga[4], gb[4];
    const char* cA = (const char*)Abase + (size_t)cur.pm * tstep;
    const char* cG = (const char*)(BS.base(cur) + (size_t)(32 * kh) * BS.ldb + BS.col(cur, nq));
    const size_t gstep = 64 * ldb4;
    PG8_GLOAD_A(cG); PG8_GLOAD_B(cG); PG8_STAGE(PG8_SA(0, 0), cA, voffA); PG8_STAGE(PG8_SA(0, 1), cA + hstep, voffA);
    PG8_GWAIT_A(8); PG8_GWRITE_H(0, ga, 0); PG8_GWAIT_B(4); PG8_GWRITE_H(0, gb, 8);
    PG8_WAIT_V(0);
    PG8_GLOAD_A(cG + gstep); PG8_STAGE(PG8_SA(1, 0), cA + kstep, voffA); PG8_GLOAD_B(cG + gstep);
    PG8_WAIT_L(0);
    if (wr == 1) PG8_BAR;
    PG8_BAR; PG8_BAR;
    for (;;) {
        const bool has_next = S.next(ui + 1, nxt);
        const char* nA = has_next ? (const char*)Abase + (size_t)nxt.pm * tstep : cA;
        const char* nG = has_next ? (const char*)(BS.base(nxt) + (size_t)(32 * kh) * BS.ldb + BS.col(nxt, nq)) : cG;
        for (int t = 0; t < nt; t += 2) {
            const bool last = (t == nt - 2);
            const char* a1 = cA + (size_t)(t + 1) * kstep;
            const char* a2 = last ? nA : cA + (size_t)(t + 2) * kstep;
            const char* a3 = a2 + kstep;
            const char* g2 = last ? nG : cG + (size_t)(t + 2) * gstep;
            const char* g3 = g2 + gstep;
            PG8_LDB(B0, 0, 0); PG8_LDB(B1, 0, 1); PG8_SCHED; PG8_LDA(At, 0, 0);
            PG8_GWAIT_A(6); PG8_GWRITE_H(1, ga, 0); PG8_STAGE(PG8_SA(1, 1), a1 + hstep, voffA); PG8_GLOAD_A(g2);
            PG8_WAIT_L(0); PG8_BAR; PG8_MMA(0, 0, At, B0); PG8_MMA(0, 1, At, B1); PG8_BAR; PG8_SCHED;
            PG8_LDA(At, 0, 1);
            PG8_GWAIT_B(6); PG8_GWRITE_H(1, gb, 8); PG8_STAGE(PG8_SA(0, 0), a2, voffA); PG8_GLOAD_B(g2);
            PG8_WAIT_L(0); PG8_BAR; PG8_MMA(1, 0, At, B0); PG8_MMA(1, 1, At, B1); PG8_BAR; PG8_SCHED;
            PG8_LDB(B0, 1, 0); PG8_LDB(B1, 1, 1); PG8_SCHED; PG8_LDA(At, 1, 0);
            PG8_GWAIT_A(6); PG8_GWRITE_H(0, ga, 0); PG8_STAGE(PG8_SA(0, 1), a2 + hstep, voffA); PG8_GLOAD_A(g3);
            PG8_WAIT_L(0); PG8_BAR; PG8_MMA(0, 0, At, B0); PG8_MMA(0, 1, At, B1); PG8_BAR; PG8_SCHED;
            PG8_LDA(At, 1, 1);
            PG8_GWAIT_B(6); PG8_GWRITE_H(0, gb, 8); PG8_STAGE(PG8_SA(1, 0), a3, voffA); PG8_GLOAD_B(g3);
            PG8_WAIT_L(0); PG8_BAR; PG8_MMA(1, 0, At, B0); PG8_MMA(1, 1, At, B1); PG8_BAR; PG8_SCHED;
        }
        if (wr == 0) PG8_BAR;
        E(acc, cur, wr, wc, fr, fq); S.done(cur);
        if (!has_next) break;
#pragma unroll
        for (int a = 0; a < 2; ++a)
#pragma unroll
            for (int b = 0; b < 2; ++b)
#pragma unroll
                for (int m = 0; m < 4; ++m)
#pragma unroll
                    for (int n = 0; n < 2; ++n) acc[a][b][m][n] = (f32x4){0.f, 0.f, 0.f, 0.f};
        cur = nxt; cA = nA; cG = nG; ++ui;
        if (wr == 1) PG8_BAR;
    }
    PG8_GWAIT_A(0); PG8_GWAIT_B(0);
    PG8_BAR;
#undef PG8_SA
#undef PG8_SB
#undef PG8_STAGE
#undef PG8_LDA
#undef PG8_LDB
#undef PG8_MMA
#undef PG8_WAIT_V
#undef PG8_WAIT_L
#undef PG8_BAR
#undef PG8_SCHED
#undef PG8_GLOAD_A
#undef PG8_GLOAD_B
#undef PG8_GWAIT_A
#undef PG8_GWAIT_B
#undef PG8_GWRITE_H
}
}
struct BSrcGU {
    const float* w; int ldb;
    __device__ __forceinline__ const float* base(const pg8::Unit& u) const { return w + (size_t)((u.pn - WGU_T0) >> 4) * 2048 * 4096; }
    __device__ __forceinline__ int col(const pg8::Unit& u, int nq) const { const int j = (u.pn - WGU_T0) & 15; return (nq < 2) ? 128 * j + 64 * nq : 2048 + 128 * j + 64 * (nq - 2); }
};
struct BSrcDown {
    const float* w; int ldb;
    __device__ __forceinline__ const float* base(const pg8::Unit& u) const { return w + (size_t)((u.pn - WDN_T0) >> 3) * 2048 * 2048; }
    __device__ __forceinline__ int col(const pg8::Unit& u, int nq) const { return 256 * ((u.pn - WDN_T0) & 7) + 64 * nq; }
};

__device__ __forceinline__ void phase10(const Ctx& C) {
    unsigned char* ws = C.ws;
    const float* x1 = (const float*)(ws + WS_R1); const bf16* ybuf = (const bf16*)(ws + WS_YBUF);
    const float* g2 = C.A.in[26]; const float* b2 = C.A.in[27]; const int lane = C.lane;
    for (int tok = C.gw; tok < T; tok += C.NGW) {
        f32x4 v[8]; float s = 0.f;
#pragma unroll
        for (int j = 0; j < 8; ++j) { const int c0 = (lane + 64 * j) * 4; f32x4 a = *(const f32x4*)(x1 + (size_t)tok * D + c0) * DN_ALPHA;
#pragma unroll
            for (int k = 0; k < 4; ++k) { const v2u yw = *(const v2u*)(ybuf + ((size_t)tok * 4 + k) * D + c0); a = a + (f32x4){bflo(yw.x), bfhi(yw.x), bflo(yw.y), bfhi(yw.y)}; }
            v[j] = a; s += (a.x + a.y) + (a.z + a.w); }
        const float mean = wave_sum(s) * (1.0f / D); float q = 0.f;
#pragma unroll
        for (int j = 0; j < 8; ++j) { v[j] = v[j] - mean; q += (v[j].x * v[j].x + v[j].y * v[j].y) + (v[j].z * v[j].z + v[j].w * v[j].w); }
        const float rstd = 1.0f / sqrtf(wave_sum(q) * (1.0f / D) + LN_EPS);
#pragma unroll
        for (int j = 0; j < 8; ++j) { const int c0 = (lane + 64 * j) * 4; const f32x4 gg = *(const f32x4*)(g2 + c0), bb = *(const f32x4*)(b2 + c0);
            *(f32x4*)(C.out + (size_t)tok * D + c0) = v[j] * rstd * gg + bb; }
    }
}

__global__ void __launch_bounds__(NTHREADS, 2) fwd_kernel(KArgs args) {
    extern __shared__ __attribute__((aligned(16))) unsigned char lds_raw[];
    const int tid_ = threadIdx.x, wave_ = __builtin_amdgcn_readfirstlane(tid_ >> 6), G_ = gridDim.x;
    Ctx C{args, args.out, args.ws, (LAS unsigned char*)lds_raw, tid_, tid_ & 63, wave_, G_, (int)blockIdx.x * NWAVES + wave_, G_ * NWAVES};
    volatile LAS unsigned* MISC = (volatile LAS unsigned*)(C.lds + LDS_MISC);
    if (C.tid < 4) MISC[C.tid] = 0u;
    __syncthreads();
    unsigned* ctl = (unsigned*)(args.ws + WS_CTL);
    XcdBarrier bar; bar.bar = ctl + CW_BAR; bar.x = 0; bar.st = MISC;
    const int lo = args.ph_lo, hi = args.ph_hi;
    if (hi - lo > 1) bar = xcd_barrier_post(ctl + CW_BAR, MISC);
#ifndef PHASE_MASK
#define PHASE_MASK 0x7ff
#endif
#define IN(k) (((PHASE_MASK >> (k)) & 1) && lo <= (k) && (k) < hi)
#define SEAM(k) do { if (IN(k) && IN((k) + 1)) xcd_barrier(bar); } while (0)
    const pg8::Gemm g{(const pg8::bf16_t*)args.ws, (const pg8::bf16_t*)args.ws, 0, 0, 2048};
    PG8_LAS unsigned char* glds = (PG8_LAS unsigned char*)lds_raw;

#ifndef PROBE_DOUBLE
#define PROBE_DOUBLE 0
#endif
#define REP(k) for (int _rep = 0; _rep < (((PROBE_DOUBLE >> (k)) & 1) ? 2 : 1); ++_rep)
    if (IN(0)) { REP(0) phase0(C); } SEAM(0);
    if (IN(1)) {
        Gemm1Order S{C.G, (int)blockIdx.x};
        unsigned char* ws = args.ws;
        Epi1 E{C.A.in[2], (bf16*)(ws + WS_HYT), (bf16*)(ws + WS_QKRAW), (bf16*)(ws + WS_VB), (bf16*)(ws + WS_OB), (float*)(ws + WS_GATES)};
        REP(1) pg8::gemm_phase<Epi1, Gemm1Order, true, true>(glds, g, S, E);
        { const pg8::Gemm g2{(const pg8::bf16_t*)(ws + WS_W3P), (const pg8::bf16_t*)(ws + WS_H2P), 0, 0, 256}; KtOrder S2{C.G, (int)blockIdx.x}; EpiKT E2{(float*)(ws + WS_KT)};
          pg8::gemm_phase<EpiKT, KtOrder, true, true>(glds, g2, S2, E2); }
    } SEAM(1);
    if (IN(2)) { REP(2) phase2(C); } SEAM(2);
    if (IN(3)) { REP(3) hyena_fft(C); REP(11) { if (NAIVE_ML) mlstm_naive(C); else mlstm_mfma(C); } } SEAM(3);
    if (IN(4)) { REP(4) phase4(C); } SEAM(4);
    if (IN(5)) {
        TileOrder S{32, 8, YCAT_T0, WOUT_T0, C.G, (int)blockIdx.x};
        EpiOut E{C.A.in[0], C.A.in[17], (float*)(args.ws + WS_R1)};
        REP(5) pg8::gemm_phase<EpiOut, TileOrder, true, true>(glds, g, S, E);
    } SEAM(5);
    if (IN(6)) { REP(6) phase6(C, _rep); } if (IN(6) && IN(8)) xcd_barrier(bar);
    if (IN(8)) {
        moe_build_tb(C);
        MoeOrder S{(const LAS int*)(C.lds + LDS_TB), 16, ABUF_T0, WGU_T0, C.G, (int)blockIdx.x, (const int*)(args.ws + WS_LIST)};
        EpiGU E{C.A.in[23], (bf16*)(args.ws + (size_t)ACT_T0 * MiB)};
        BSrcGU BS{C.A.in[22], 4096};
#if MOE_PRECONVERT
        REP(8) pg8::gemm_phase_ga<EpiGU, MoeOrder>(glds, (const pg8::bf16_t*)(args.ws + (size_t)X1B_T0 * MiB), (const pg8::bf16_t*)args.ws, 2048, S, E);
#else
        REP(8) pg8::gemm_phase_bf32<EpiGU, MoeOrder, BSrcGU>(glds, (const pg8::bf16_t*)args.ws, 2048, S, E, BS);
#endif
    } SEAM(8);
    if (IN(9)) {
        moe_build_tb(C);
        MoeOrder S{(const LAS int*)(C.lds + LDS_TB), 8, ACT_T0, WDN_T0, C.G, (int)blockIdx.x, (const int*)(args.ws + WS_LIST)};
        EpiDown E{C.A.in[25], (const int*)(args.ws + WS_LIST), (const float*)(args.ws + WS_TOKW), (const LAS int*)(C.lds + LDS_TB), (bf16*)(args.ws + WS_YBUF)};
        BSrcDown BS{C.A.in[24], 2048};
#if MOE_PRECONVERT
        REP(9) pg8::gemm_phase<EpiDown, MoeOrder, true, true>(glds, g, S, E);
#else
        REP(9) pg8::gemm_phase_bf32<EpiDown, MoeOrder, BSrcDown>(glds, (const pg8::bf16_t*)args.ws, 2048, S, E, BS);
#endif
    } SEAM(9);
    if (IN(10)) { REP(10) phase10(C); }
#ifdef PROBE_BARRIERS
    if (hi - lo > 1) for (int i_ = 0; i_ < PROBE_BARRIERS; ++i_) xcd_barrier(bar);
#endif
#undef IN
#undef SEAM
}

extern "C" void kernel_launch(void* const* d_in, const int* in_sizes, int n_in, void* d_out, int out_size, void* d_ws, size_t ws_size, hipStream_t stream) {
    static int grid = 0;
    if (grid == 0) {
        if (n_in != 28 || in_sizes[0] != T * D || out_size != T * D || ws_size < WS_END) { fprintf(stderr, "kernel_launch: unexpected shapes (n_in %d, in0 %d, out %d, ws %zu)\n", n_in, n_in > 0 ? in_sizes[0] : -1, out_size, ws_size); grid = -1; return; }
        int dev = 0, cus = 0;
        if (hipGetDevice(&dev) != hipSuccess || hipDeviceGetAttribute(&cus, hipDeviceAttributeMultiprocessorCount, dev) != hipSuccess) { grid = -1; return; }
        if (hipFuncSetAttribute((const void*)fwd_kernel, hipFuncAttributeMaxDynamicSharedMemorySize, LDS_BYTES) != hipSuccess) { fprintf(stderr, "kernel_launch: hipFuncSetAttribute failed\n"); grid = -1; return; }
        int per_cu = 0;
        if (hipOccupancyMaxActiveBlocksPerMultiprocessor(&per_cu, (const void*)fwd_kernel, NTHREADS, LDS_BYTES) != hipSuccess || per_cu < 1) fprintf(stderr, "kernel_launch: occupancy query says %d\n", per_cu);
        (void)hipGetLastError();
        grid = cus;
    }
    if (grid < 0) return;
    if (hipMemsetAsync((char*)d_ws + WS_CTL, 0, CTL_ZERO_BYTES, stream) != hipSuccess) return;
    KArgs a{};
    for (int i = 0; i < 28; ++i) a.in[i] = (const float*)d_in[i];
    a.out = (float*)d_out; a.ws = (unsigned char*)d_ws;
#if MK_ONE_LAUNCH
    a.ph_lo = 0; a.ph_hi = N_PHASES;
    hipLaunchKernelGGL(fwd_kernel, dim3(grid), dim3(NTHREADS), LDS_BYTES, stream, a);
#else
    for (int ph = 0; ph < N_PHASES; ++ph) { a.ph_lo = ph; a.ph_hi = ph + 1; hipLaunchKernelGGL(fwd_kernel, dim3(grid), dim3(NTHREADS), LDS_BYTES, stream, a); }
#endif
}
```

```cpp
#include <hip/hip_runtime.h>
#include <cstdio>
#include <cstdint>
namespace pg8 {
#define PG8_LAS __attribute__((address_space(3)))
typedef unsigned short bf16_t;
typedef short bf16x8 __attribute__((ext_vector_type(8)));
typedef float f32x4 __attribute__((ext_vector_type(4)));
typedef unsigned u32x4 __attribute__((ext_vector_type(4)));
constexpr int BM = 256, BK = 64, HALF = 128, HTB = HALF * BK * 2  , STAGE_BYTES = 8 * HTB, NXCD = 8, WGM = 8;

__host__ __device__ __forceinline__ int lds_byte(int r, int c) { const int st = (r >> 4) * 2 + (c >> 5), rr = r & 15, cc = c & 31, ob = rr * 64 + cc * 2; return st * 1024 + (ob ^ (((ob >> 9) & 1) << 5)); }
__host__ __device__ __forceinline__ void stage_rc(int b, int& R, int& C) { const int st = b / 1024, sb = b % 1024, swz = sb ^ (((sb >> 9) & 1) << 5); R = (st >> 1) * 16 + swz / 64; C = (st & 1) * 32 + (swz % 64) / 2; }
__host__ __device__ __forceinline__ int perm32(int rho) { const int n = rho >> 4, i = rho & 15; return 8 * (i >> 2) + 4 * n + (i & 3); }

struct Unit { int pm, pn; };
struct Gemm { const bf16_t* A; const bf16_t* Bt; int M, N, K; };
__device__ __forceinline__ unsigned cvt_pk_bf16(float lo, float hi) { unsigned r; asm volatile("v_cvt_pk_bf16_f32 %0, %1, %2" : "=v"(r) : "v"(lo), "v"(hi)); return r; }
typedef float f32x2 __attribute__((ext_vector_type(2)));
template <class Epi, class Sched, bool ALIGN_EPI = false, bool SP2 = false>
__device__ __forceinline__ void gemm_phase(PG8_LAS unsigned char* lds, const Gemm g, const Sched& S, const Epi& E) {
    const int tid = threadIdx.x, wid = __builtin_amdgcn_readfirstlane(tid >> 6), lane = tid & 63, wr = wid >> 2, wc = wid & 3, fr = lane & 15, fq = lane >> 4;
    const int K = g.K, nt = K / BK;
    unsigned voffA[2], voffB[2];
#pragma unroll
    for (int i = 0; i < 2; ++i) { int R, C; stage_rc(tid * 16 + i * 8192, R, C); const int Rb = Epi::PERM ? ((R & ~31) + perm32(R & 31)) : R;
        voffA[i] = (unsigned)(R * K + C) * 2u; voffB[i] = (unsigned)(Rb * K + C) * 2u; }
    const size_t kstep = (size_t)(BK * 2);
    const size_t hstep = (size_t)HALF * K * 2;
    const size_t tstep = 2 * hstep;
    const unsigned ldsw = (unsigned)wid * 1024u;
    const int aoff = lds_byte(wr * 64 + fr, fq * 8), boff = lds_byte(wc * 32 + fr, fq * 8);
#define PG8_SA(b, h) (((b) * 2 + (h)) * HTB)
#define PG8_SB(b, h) ((4 + (b) * 2 + (h)) * HTB)
#define PG8_STAGE(bufoff, gbase, voff) do { _Pragma("unroll") for (int _i = 0; _i < 2; ++_i) \
        __builtin_amdgcn_global_load_lds((const unsigned*)((const char*)(gbase) + (voff)[_i]), (PG8_LAS unsigned*)(lds + (bufoff) + ldsw + _i * 8192), 16, 0, 0); } while (0)
#define PG8_LDA(dst, b, h) do { _Pragma("unroll") for (int m = 0; m < 4; ++m) _Pragma("unroll") for (int k = 0; k < 2; ++k) dst[m][k] = *(const PG8_LAS bf16x8*)(lds + PG8_SA(b, h) + aoff + m * 2048 + k * 1024); } while (0)
#define PG8_LDB(dst, b, h) do { _Pragma("unroll") for (int n = 0; n < 2; ++n) _Pragma("unroll") for (int k = 0; k < 2; ++k) dst[n][k] = *(const PG8_LAS bf16x8*)(lds + PG8_SB(b, h) + boff + n * 2048 + k * 1024); } while (0)
#define PG8_MMA(ai, bj, At, Bt) do { __builtin_amdgcn_s_setprio(1); _Pragma("unroll") for (int m = 0; m < 4; ++m) _Pragma("unroll") for (int n = 0; n < 2; ++n) _Pragma("unroll") for (int k = 0; k < 2; ++k) \
        acc[ai][bj][m][n] = __builtin_amdgcn_mfma_f32_16x16x32_bf16(Bt[n][k], At[m][k], acc[ai][bj][m][n], 0, 0, 0); __builtin_amdgcn_s_setprio(0); } while (0)
#define PG8_WAIT_V(n) asm volatile("s_waitcnt vmcnt(" #n ")" ::: "memory")
#define PG8_WAIT_L(n) asm volatile("s_waitcnt lgkmcnt(" #n ")" ::: "memory")
#define PG8_BAR __builtin_amdgcn_s_barrier()
#define PG8_SCHED __builtin_amdgcn_sched_barrier(0)
    Unit cur, nxt; int ui = 0;
    if (!S.next(0, cur)) return;
    f32x4 acc[2][2][4][2];
#pragma unroll
    for (int a = 0; a < 2; ++a)
#pragma unroll
        for (int b = 0; b < 2; ++b)
#pragma unroll
            for (int m = 0; m < 4; ++m)
#pragma unroll
                for (int n = 0; n < 2; ++n) acc[a][b][m][n] = (f32x4){0.f, 0.f, 0.f, 0.f};
    bf16x8 At[4][2], B0[2][2], B1[2][2];
    const char* cA = (const char*)g.A + (size_t)cur.pm * tstep; const char* cB = (const char*)g.Bt + (size_t)cur.pn * tstep;
    S.a_ready(cur);
    if constexpr (SP2) {
        PG8_STAGE(PG8_SB(0, 0), cB, voffB); PG8_STAGE(PG8_SB(0, 1), cB + hstep, voffB); PG8_STAGE(PG8_SA(0, 0), cA, voffA); PG8_STAGE(PG8_SA(0, 1), cA + hstep, voffA);
        if (wr == 1) PG8_BAR;
        PG8_WAIT_V(2); PG8_BAR;
        PG8_STAGE(PG8_SB(1, 0), cB + kstep, voffB); PG8_STAGE(PG8_SA(1, 0), cA + kstep, voffA); PG8_STAGE(PG8_SB(1, 1), cB + hstep + kstep, voffB);
        PG8_WAIT_V(6); PG8_BAR;
    } else {
        PG8_STAGE(PG8_SB(0, 0), cB, voffB); PG8_STAGE(PG8_SA(0, 0), cA, voffA); PG8_STAGE(PG8_SB(0, 1), cB + hstep, voffB); PG8_STAGE(PG8_SA(0, 1), cA + hstep, voffA);
        if (wr == 1) PG8_BAR;
        PG8_WAIT_V(4); PG8_BAR;
        PG8_STAGE(PG8_SB(1, 0), cB + kstep, voffB); PG8_STAGE(PG8_SA(1, 0), cA + kstep, voffA); PG8_STAGE(PG8_SB(1, 1), cB + hstep + kstep, voffB);
        PG8_WAIT_V(6); PG8_BAR;
    }
    for (;;) {
        const bool has_next = S.next(ui + 1, nxt);
        const char* nA = has_next ? (const char*)g.A + (size_t)nxt.pm * tstep : cA; const char* nB = has_next ? (const char*)g.Bt + (size_t)nxt.pn * tstep : cB;
        for (int t = 0; t < nt; t += 2) {
            const bool last = (t == nt - 2);
            const char* a1 = cA + (size_t)(t + 1) * kstep;
            const char* a2 = last ? nA : cA + (size_t)(t + 2) * kstep; const char* b2 = last ? nB : cB + (size_t)(t + 2) * kstep;
            const char* a3 = a2 + kstep; const char* b3 = b2 + kstep;
            if (last && has_next) S.a_ready(nxt);
            if constexpr (SP2) {
            PG8_LDB(B0, 0, 0); PG8_LDB(B1, 0, 1); PG8_SCHED; PG8_LDA(At, 0, 0); PG8_STAGE(PG8_SA(1, 1), a1 + hstep, voffA);
            PG8_WAIT_V(8); PG8_WAIT_L(0); PG8_BAR; PG8_MMA(0, 0, At, B0); PG8_MMA(0, 1, At, B1); PG8_BAR; PG8_SCHED;
            PG8_LDA(At, 0, 1); PG8_STAGE(PG8_SB(0, 0), b2, voffB); PG8_STAGE(PG8_SB(0, 1), b2 + hstep, voffB); PG8_STAGE(PG8_SA(0, 0), a2, voffA);
            PG8_WAIT_V(8); PG8_WAIT_L(0); PG8_BAR; PG8_MMA(1, 0, At, B0); PG8_MMA(1, 1, At, B1); PG8_BAR; PG8_SCHED;
            PG8_LDB(B0, 1, 0); PG8_LDB(B1, 1, 1); PG8_SCHED; PG8_LDA(At, 1, 0); PG8_STAGE(PG8_SA(0, 1), a2 + hstep, voffA);
            PG8_WAIT_V(8); PG8_WAIT_L(0); PG8_BAR; PG8_MMA(0, 0, At, B0); PG8_MMA(0, 1, At, B1); PG8_BAR; PG8_SCHED;
            PG8_LDA(At, 1, 1); PG8_STAGE(PG8_SB(1, 0), b3, voffB); PG8_STAGE(PG8_SB(1, 1), b3 + hstep, voffB); PG8_STAGE(PG8_SA(1, 0), a3, voffA);
            PG8_WAIT_V(8); PG8_WAIT_L(0); PG8_BAR; PG8_MMA(1, 0, At, B0); PG8_MMA(1, 1, At, B1); PG8_BAR; PG8_SCHED;
            } else {
            PG8_LDB(B0, 0, 0); PG8_SCHED; PG8_LDA(At, 0, 0); PG8_STAGE(PG8_SA(1, 1), a1 + hstep, voffA);
            PG8_WAIT_L(8); PG8_BAR; PG8_WAIT_L(0); PG8_MMA(0, 0, At, B0); PG8_BAR; PG8_SCHED;
            PG8_LDB(B1, 0, 1); PG8_STAGE(PG8_SB(0, 0), b2, voffB);
            PG8_BAR; PG8_WAIT_L(0); PG8_MMA(0, 1, At, B1); PG8_BAR;
            PG8_LDA(At, 0, 1); PG8_STAGE(PG8_SA(0, 0), a2, voffA);
            PG8_BAR; PG8_WAIT_L(0); PG8_MMA(1, 0, At, B0); PG8_BAR; PG8_SCHED;
            PG8_STAGE(PG8_SB(0, 1), b2 + hstep, voffB);
            PG8_WAIT_V(6); PG8_BAR; PG8_MMA(1, 1, At, B1); PG8_BAR;
            PG8_LDB(B0, 1, 0); PG8_SCHED; PG8_LDA(At, 1, 0); PG8_STAGE(PG8_SA(0, 1), a2 + hstep, voffA);
            PG8_WAIT_L(8); PG8_BAR; PG8_WAIT_L(0); PG8_MMA(0, 0, At, B0); PG8_BAR; PG8_SCHED;
            PG8_LDB(B1, 1, 1); PG8_STAGE(PG8_SB(1, 0), b3, voffB);
            PG8_BAR; PG8_WAIT_L(0); PG8_MMA(0, 1, At, B1); PG8_BAR;
            PG8_LDA(At, 1, 1); PG8_STAGE(PG8_SA(1, 0), a3, voffA);
            PG8_BAR; PG8_WAIT_L(0); PG8_MMA(1, 0, At, B0); PG8_BAR; PG8_SCHED;
            PG8_STAGE(PG8_SB(1, 1), b3 + hstep, voffB);
            PG8_WAIT_V(6); PG8_BAR; PG8_MMA(1, 1, At, B1); PG8_BAR;
            }
        }
        if constexpr (ALIGN_EPI) { if (wr == 0) PG8_BAR; }
        if constexpr (!Epi::AFTER_DRAIN) { E(acc, cur, wr, wc, fr, fq); S.done(cur); }
        if (!has_next) break;
#pragma unroll
        for (int a = 0; a < 2; ++a)
#pragma unroll
            for (int b = 0; b < 2; ++b)
#pragma unroll
                for (int m = 0; m < 4; ++m)
#pragma unroll
                    for (int n = 0; n < 2; ++n) acc[a][b][m][n] = (f32x4){0.f, 0.f, 0.f, 0.f};
        cur = nxt; cA = nA; cB = nB; ++ui;
        if constexpr (ALIGN_EPI) { if (wr == 1) PG8_BAR; }
    }
    PG8_WAIT_V(0);
    if constexpr (!ALIGN_EPI) { if (wr == 0) PG8_BAR; }
    PG8_BAR;
    if constexpr (Epi::AFTER_DRAIN) { E.fused(acc, cur, wr, wc, fr, fq, lds, wid, lane); S.done(cur); }
#undef PG8_SA
#undef PG8_SB
#undef PG8_STAGE
#undef PG8_LDA
#undef PG8_LDB
#undef PG8_MMA
#undef PG8_WAIT_V
#undef PG8_WAIT_L
#undef PG8_BAR
#undef PG8_SCHED
}
}

constexpr int NB = 4, SEQ = 2048, T = NB * SEQ, D = 2048, DHY = 1024, DML = 1024, DIN = 7200, NE = 32, TOPK = 4, NH = 8, HD = 128, DFF = 2048;
constexpr float LN_EPS = 1e-5f, DN_ALPHA = 1.189207115002721f;
constexpr int NWAVES = 8, NTHREADS = 512;
#ifndef MK_ONE_LAUNCH
#define MK_ONE_LAUNCH 1
#endif
constexpr int N_PHASES = 11;
#ifndef MOE_PRECONVERT
#define MOE_PRECONVERT 1
#endif
#ifndef MOE_FP8W
#define MOE_FP8W 0
#endif
constexpr float MOE_WSCALE = 64.0f;
#ifndef SIDE_GU_PERIOD
#define SIDE_GU_PERIOD 1
#define SIDE_GU_LAG 1
#endif
#ifndef SIDE_DN_PERIOD
#define SIDE_DN_PERIOD 4
#define SIDE_DN_LAG 2
#endif
#ifndef SIDE_GU_EXPERTS
#define SIDE_GU_EXPERTS 32
#endif
#ifndef MOE_SIDE
#define MOE_SIDE 1
#endif

constexpr size_t MiB = 1u << 20;
constexpr size_t WS_CTL = 0, CTL_ZERO_BYTES = 1 * MiB;
constexpr size_t WS_H2P = 1936 * MiB;
constexpr size_t WS_W3P = 1937 * MiB;
constexpr size_t WS_GATES = 2 * MiB;
constexpr size_t WS_TOKW = 3 * MiB;
constexpr size_t WS_LIST = 4 * MiB;
constexpr size_t WS_ROWSLOT = 5 * MiB;
constexpr size_t WS_ROWW = 5 * MiB + 512 * 1024;
constexpr size_t WS_GA = 6 * MiB, WS_GP = 6 * MiB + 512 * 1024, WS_GE = 7 * MiB;
constexpr size_t TILE_BYTES = 256 * 2048 * 2;
constexpr int XB_T0 = 8, WIN_T0 = 40, WOUT_T0 = 72, YCAT_T0 = 80, X1B_T0 = 112, ABUF_T0 = 144, ACT_T0 = 304, WGU_T0 = 464, WDN_T0 = 976;
constexpr size_t WS_HYT = 1232 * MiB;
constexpr size_t WS_QKRAW = 1296 * MiB;
constexpr size_t WS_OB = 1328 * MiB;
constexpr size_t WS_QKC = 1344 * MiB;
constexpr size_t WS_KT = 1376 * MiB;
constexpr size_t WS_KF = 1840 * MiB;
constexpr size_t WS_ZT = 1904 * MiB;
constexpr size_t WS_Z = 1408 * MiB;
constexpr size_t WS_HML = 1440 * MiB;
constexpr size_t WS_R1 = 1504 * MiB;
constexpr size_t WS_YBUF = 1568 * MiB;
constexpr size_t WS_VB = 1824 * MiB;
constexpr size_t WS_END = 1940 * MiB;
constexpr int CW_BAR = 4096, CW_CNT = 16384;

constexpr int LDS_STAGE = 131072, LDS_MISC = LDS_STAGE, LDS_TB = LDS_STAGE + 64, LDS_BYTES = 147456;

#define GAS __attribute__((address_space(1)))
#define LAS __attribute__((address_space(3)))
typedef unsigned short bf16;
typedef unsigned v4u __attribute__((ext_vector_type(4)));
typedef unsigned v2u __attribute__((ext_vector_type(2)));
typedef float f32x4 __attribute__((ext_vector_type(4)));
typedef float f32x2 __attribute__((ext_vector_type(2)));
#define LDS_WAIT() asm volatile("s_waitcnt lgkmcnt(0)" ::: "memory")
__device__ __forceinline__ unsigned f2bf(float f) { unsigned u = __builtin_bit_cast(unsigned, f); return (u + 0x7fffu + ((u >> 16) & 1u)) >> 16; }
__device__ __forceinline__ unsigned pk2(float lo, float hi) { return f2bf(lo) | (f2bf(hi) << 16); }
__device__ __forceinline__ float bflo(unsigned w) { return __builtin_bit_cast(float, w << 16); }
__device__ __forceinline__ float bfhi(unsigned w) { return __builtin_bit_cast(float, w & 0xffff0000u); }
__device__ __forceinline__ float bf2f(bf16 b) { return __builtin_bit_cast(float, (unsigned)b << 16); }
__device__ __forceinline__ float wave_sum(float v) {
#pragma unroll
    for (int o = 1; o < 64; o <<= 1) v += __shfl_xor(v, o);
    return v;
}
__device__ __forceinline__ float wave_max(float v) {
#pragma unroll
    for (int o = 1; o < 64; o <<= 1) v = fmaxf(v, __shfl_xor(v, o));
    return v;
}

#define XB_TMO      128
#define XB_XCNT(j)  (256  + 64 * (j))
#define XB_XSUB(j)  (1280 + 64 * (j))
#define XB_XGEN(j)  (2304 + 64 * (j))
#define XB_TOP      3328
#define XB_TOPGEN   3392
#define XCD_BAR_WORDS 3456
#define XB_SPIN_CAP (1u << 22)

__device__ __forceinline__ unsigned xb_ld(unsigned* p)              { return __hip_atomic_load(p, __ATOMIC_RELAXED, __HIP_MEMORY_SCOPE_AGENT); }
__device__ __forceinline__ unsigned xb_add(unsigned* p, unsigned v) { return __hip_atomic_fetch_add(p, v, __ATOMIC_RELAXED, __HIP_MEMORY_SCOPE_AGENT); }
__device__ __forceinline__ unsigned xb_xcc_id() { return (unsigned)__builtin_amdgcn_s_getreg((3 << 11) | 20) & 0xFu; }
#define XB_SPIN(cond, bar) do { unsigned _sp = 0; while (cond) { __builtin_amdgcn_s_sleep(1); \
    if ((++_sp & 255u) == 0u) { if (xb_ld(&(bar)[XB_TMO])) break; if (_sp > XB_SPIN_CAP) { atomicAdd(&(bar)[XB_TMO], 1u); break; } } } } while (0)

struct XcdBarrier {
    unsigned* bar; unsigned x;
    volatile LAS unsigned* st;
};

__device__ __forceinline__ XcdBarrier xcd_barrier_post(unsigned* bar, volatile LAS unsigned* st) {
    XcdBarrier b; b.bar = bar; b.x = xb_xcc_id(); b.st = st;
    if (threadIdx.x == 0) (void)xb_add(&bar[XB_XCNT(b.x)], 1u);
    return b;
}
__device__ __forceinline__ void xcd_barrier_complete(unsigned* bar, unsigned x, unsigned& nloc, unsigned& nx) {
    const unsigned G = gridDim.x * gridDim.y * gridDim.z;
    unsigned sum, cnt, mine, sp = 0u;
    for (;;) {
        sum = 0u; cnt = 0u; mine = 0u;
#pragma unroll
        for (unsigned j = 0; j < 16; ++j) { const unsigned c = xb_ld(&bar[XB_XCNT(j)]); sum += c; cnt += (c > 0u) ? 1u : 0u; mine = (j == x) ? c : mine; }
        if (sum == G) break;
        __builtin_amdgcn_s_sleep(1);
        if ((++sp & 255u) == 0u) { if (xb_ld(&bar[XB_TMO])) break; if (sp > XB_SPIN_CAP) { atomicAdd(&bar[XB_TMO], 1u); break; } }
    }
    nloc = mine > 0u ? mine : 1u; nx = cnt > 0u ? cnt : 1u;
}

__device__ __forceinline__ void xcd_barrier(const XcdBarrier& b) {
    asm volatile("s_waitcnt vmcnt(0)" ::: "memory");
    __syncthreads();
    if (threadIdx.x == 0) {
        unsigned* bar = b.bar;
        __builtin_amdgcn_s_waitcnt(0);
        unsigned nloc = b.st[0], nx = b.st[1];
        if (nloc == 0u) { xcd_barrier_complete(bar, b.x, nloc, nx); b.st[0] = nloc; b.st[1] = nx; }
        const unsigned old = xb_add(&bar[XB_XSUB(b.x)], 1u);
        const unsigned gen = old / nloc;
        if (old + 1u == (gen + 1u) * nloc) {
            __builtin_amdgcn_fence(__ATOMIC_RELEASE, "agent");
            asm volatile("s_waitcnt vmcnt(0)" ::: "memory");
            const unsigned og = xb_add(&bar[XB_TOP], 1u);
            const unsigned tg = og / nx;
            if (og + 1u == (tg + 1u) * nx) xb_add(&bar[XB_TOPGEN], 1u);
            else XB_SPIN(xb_ld(&bar[XB_TOPGEN]) == tg, bar);
            __builtin_amdgcn_fence(__ATOMIC_ACQUIRE, "agent");
            xb_add(&bar[XB_XGEN(b.x)], 1u);
            asm volatile("s_waitcnt vmcnt(0)" ::: "memory");
        } else {
            XB_SPIN(xb_ld(&bar[XB_XGEN(b.x)]) == gen, bar);
            __builtin_amdgcn_fence(__ATOMIC_ACQUIRE, "agent");
            asm volatile("s_waitcnt vmcnt(0)" ::: "memory");
        }
    }
    __syncthreads();
}


#ifndef FFT_HD
#define FFT_HD __device__ __forceinline__
#define FFT_LDS LAS
#endif
constexpr int FFT_WORDS = 4096 + 1024 + 256;
FFT_HD int fidx(int i) { return i + 4 * (i >> 4) + 16 * (i >> 8); }

template <bool INV> FFT_HD void dft4(float& ar, float& ai, float& br, float& bi, float& cr, float& ci, float& dr, float& di) {
    const float s0r = ar + cr, s0i = ai + ci, s1r = ar - cr, s1i = ai - ci;
    const float s2r = br + dr, s2i = bi + di, s3r = br - dr, s3i = bi - di;
    ar = s0r + s2r; ai = s0i + s2i;
    cr = s0r - s2r; ci = s0i - s2i;
    if (!INV) { br = s1r + s3i; bi = s1i - s3r; dr = s1r - s3i; di = s1i + s3r; }
    else      { br = s1r - s3i; bi = s1i + s3r; dr = s1r + s3i; di = s1i - s3r; }
}
template <bool INV> FFT_HD void dft16(float (&xr)[16], float (&xi)[16]) {
#pragma unroll
    for (int n0 = 0; n0 < 4; ++n0) dft4<INV>(xr[n0], xi[n0], xr[n0 + 4], xi[n0 + 4], xr[n0 + 8], xi[n0 + 8], xr[n0 + 12], xi[n0 + 12]);
    constexpr float C1 = 0.9238795325112867f, S1 = 0.3826834323650898f, C2 = 0.7071067811865476f;
    const float tc[10] = {1.f, C1, C2, S1, 0.f, -S1, -C2, -C1, -1.f, -C1};
    const float ts[10] = {0.f, S1, C2, C1, 1.f, C1, C2, S1, 0.f, -S1};
#pragma unroll
    for (int n0 = 1; n0 < 4; ++n0)
#pragma unroll
        for (int k0 = 1; k0 < 4; ++k0) { const int m = n0 * k0; const float wr = tc[m], wi = INV ? ts[m] : -ts[m];
            const int id = n0 + 4 * k0; const float r = xr[id] * wr - xi[id] * wi, i = xr[id] * wi + xi[id] * wr; xr[id] = r; xi[id] = i; }
#pragma unroll
    for (int k0 = 0; k0 < 4; ++k0) dft4<INV>(xr[4 * k0], xi[4 * k0], xr[4 * k0 + 1], xi[4 * k0 + 1], xr[4 * k0 + 2], xi[4 * k0 + 2], xr[4 * k0 + 3], xi[4 * k0 + 3]);
#pragma unroll
    for (int a = 0; a < 4; ++a)
#pragma unroll
        for (int b = a + 1; b < 4; ++b) { float t = xr[4 * a + b]; xr[4 * a + b] = xr[4 * b + a]; xr[4 * b + a] = t; t = xi[4 * a + b]; xi[4 * a + b] = xi[4 * b + a]; xi[4 * b + a] = t; }
}
template <bool INV> FFT_HD void twiddle16(float (&xr)[16], float (&xi)[16], int j, int n) {
    float s, c;
#ifdef __HIP_DEVICE_COMPILE__
    asm volatile("" : "+v"(j));
    sincospif(2.0f * (float)j / (float)n, &s, &c);
#else
    s = (float)sin(2.0 * 3.14159265358979323846 * j / n); c = (float)cos(2.0 * 3.14159265358979323846 * j / n);
#endif
    const float wr = c, wi = INV ? s : -s;
    float pr = wr, pi = wi;
#pragma unroll
    for (int k = 1; k < 16; ++k) {
        const float r = xr[k] * pr - xi[k] * pi, i = xr[k] * pi + xi[k] * pr; xr[k] = r; xi[k] = i;
        const float nr = pr * wr - pi * wi, ni = pr * wi + pi * wr; pr = nr; pi = ni;
    }
}
FFT_HD void fft_store_s256(FFT_LDS float* re, FFT_LDS float* im, int g, const float (&xr)[16], const float (&xi)[16]) {
    const int a0 = fidx(g);
#pragma unroll
    for (int k = 0; k < 16; ++k) { re[a0 + 336 * k] = xr[k]; im[a0 + 336 * k] = xi[k]; }
}
FFT_HD void fft_load_s256(const FFT_LDS float* re, const FFT_LDS float* im, int g, float (&xr)[16], float (&xi)[16]) {
    const int a0 = fidx(g);
#pragma unroll
    for (int k = 0; k < 16; ++k) { xr[k] = re[a0 + 336 * k]; xi[k] = im[a0 + 336 * k]; }
}
FFT_HD void fft_load_s16(const FFT_LDS float* re, const FFT_LDS float* im, int g, float (&xr)[16], float (&xi)[16]) {
    const int a0 = fidx((g >> 4) * 256 + (g & 15));
#pragma unroll
    for (int k = 0; k < 16; ++k) { xr[k] = re[a0 + 20 * k]; xi[k] = im[a0 + 20 * k]; }
}
FFT_HD void fft_store_s16(FFT_LDS float* re, FFT_LDS float* im, int g, const float (&xr)[16], const float (&xi)[16]) {
    const int a0 = fidx((g >> 4) * 256 + (g & 15));
#pragma unroll
    for (int k = 0; k < 16; ++k) { re[a0 + 20 * k] = xr[k]; im[a0 + 20 * k] = xi[k]; }
}
FFT_HD void fft_load_s1(const FFT_LDS float* re, const FFT_LDS float* im, int g, float (&xr)[16], float (&xi)[16]) {
    const int a = fidx(g * 16);
#pragma unroll
    for (int k = 0; k < 16; ++k) { xr[k] = re[a + k]; xi[k] = im[a + k]; }
}
FFT_HD void fft_store_s1(FFT_LDS float* re, FFT_LDS float* im, int g, const float (&xr)[16], const float (&xi)[16]) {
    const int a = fidx(g * 16);
#pragma unroll
    for (int k = 0; k < 16; ++k) { re[a + k] = xr[k]; im[a + k] = xi[k]; }
}


struct KArgs { const float* in[28]; float* out; unsigned char* ws; int ph_lo, ph_hi; };
struct Ctx {
    const KArgs& A; float* out; unsigned char* ws; LAS unsigned char* lds;
    int tid, lane, wave, G, gw, NGW;
};

__device__ __forceinline__ void transpose_item(const float* __restrict__ W, int N, int k0, int n0, bf16* __restrict__ dst, LAS float* scr, int lane) {
#pragma unroll 8
    for (int i = 0; i < 32; ++i) { const int kk = 2 * i + (lane >> 5); scr[kk * 33 + (lane & 31)] = W[(size_t)(k0 + kk) * N + n0 + (lane & 31)]; }
    LDS_WAIT(); asm volatile("" ::: "memory");
    const int c = lane & 7;
#pragma unroll
    for (int j = 0; j < 4; ++j) { const int n = (lane >> 3) + 8 * j; const LAS float* s = scr + (8 * c) * 33 + n;
        v4u o; o.x = pk2(s[0 * 33], s[1 * 33]); o.y = pk2(s[2 * 33], s[3 * 33]); o.z = pk2(s[4 * 33], s[5 * 33]); o.w = pk2(s[6 * 33], s[7 * 33]);
        *(v4u*)(dst + (size_t)n * 2048 + k0 + 8 * c) = o; }
    LDS_WAIT(); asm volatile("" ::: "memory");
}

__device__ __forceinline__ void transpose_item8(const float* __restrict__ W, int N, int k0, int n0, unsigned char* __restrict__ dst, LAS float* scr, int lane) {
#pragma unroll 8
    for (int i = 0; i < 32; ++i) { const int kk = 2 * i + (lane >> 5); scr[kk * 33 + (lane & 31)] = W[(size_t)(k0 + kk) * N + n0 + (lane & 31)]; }
    LDS_WAIT(); asm volatile("" ::: "memory");
    const int c = lane & 3;
#pragma unroll
    for (int j = 0; j < 2; ++j) { const int n = (lane >> 2) + 16 * j; const LAS float* sp = scr + (16 * c) * 33 + n; v4u o;
#pragma unroll
        for (int q = 0; q < 4; ++q) { int pk = __builtin_amdgcn_cvt_pk_fp8_f32(sp[(4 * q) * 33] * MOE_WSCALE, sp[(4 * q + 1) * 33] * MOE_WSCALE, 0, false);
            pk = __builtin_amdgcn_cvt_pk_fp8_f32(sp[(4 * q + 2) * 33] * MOE_WSCALE, sp[(4 * q + 3) * 33] * MOE_WSCALE, pk, true); o[q] = (unsigned)pk; }
        *(v4u*)(dst + (size_t)n * 2048 + k0 + 16 * c) = o; }
    LDS_WAIT(); asm volatile("" ::: "memory");
}

__device__ __forceinline__ void phase0(const Ctx& C) {
    unsigned char* ws = C.ws;
    {
        const f32x4* x4 = (const f32x4*)C.A.in[0]; v4u* xb = (v4u*)(ws + (size_t)XB_T0 * MiB);
        const size_t n8 = (size_t)T * D / 8;
        for (size_t i = (size_t)blockIdx.x * NTHREADS + C.tid; i < n8; i += (size_t)C.G * NTHREADS) {
            const f32x4 a = x4[2 * i], b = x4[2 * i + 1]; v4u o; o.x = pk2(a.x, a.y); o.y = pk2(a.z, a.w); o.z = pk2(b.x, b.y); o.w = pk2(b.z, b.w); xb[i] = o; }
    }
    {
        LAS float* scr = (LAS float*)(C.lds + C.wave * 8448);
        constexpr int I_IN = 32 * 225, I_OUT = 32 * 64, E_GU0 = MOE_SIDE ? SIDE_GU_EXPERTS : 0, I_GU = MOE_PRECONVERT ? (NE - E_GU0) * 32 * 128 : 0, I_DN = (MOE_PRECONVERT && !MOE_SIDE) ? NE * 32 * 64 : 0, NITEMS = I_IN + I_OUT + I_GU + I_DN;
        bf16* win_t = (bf16*)(ws + (size_t)WIN_T0 * MiB); bf16* wout_t = (bf16*)(ws + (size_t)WOUT_T0 * MiB);
        bf16* wgu_t = (bf16*)(ws + (size_t)WGU_T0 * MiB); bf16* wdn_t = (bf16*)(ws + (size_t)WDN_T0 * MiB);
        for (int it = C.gw; it < NITEMS; it += C.NGW) {
            int r = it;
            if (r < I_IN) { const int kb = r / 225, nb = r % 225; transpose_item(C.A.in[1], DIN, 64 * kb, 32 * nb, win_t + (size_t)(32 * nb) * 2048, scr, C.lane); continue; } r -= I_IN;
            if (r < I_OUT) { const int kb = r / 64, nb = r % 64; transpose_item(C.A.in[16], D, 64 * kb, 32 * nb, wout_t + (size_t)(32 * nb) * 2048, scr, C.lane); continue; } r -= I_OUT;
            if (r < I_GU) { const int e = E_GU0 + r / 4096, rr = r % 4096, kb = rr / 128, nb = rr % 128, n0 = 32 * nb;
                const int drow = (n0 < 2048) ? ((n0 >> 7) * 256 + (n0 & 127)) : ((((n0 - 2048) >> 7) * 256) + 128 + ((n0 - 2048) & 127));
                if (MOE_FP8W) transpose_item8(C.A.in[22] + (size_t)e * 2048 * 4096, 4096, 64 * kb, n0, (unsigned char*)wgu_t + ((size_t)e * 4096 + drow) * 2048, scr, C.lane);
                else transpose_item(C.A.in[22] + (size_t)e * 2048 * 4096, 4096, 64 * kb, n0, wgu_t + ((size_t)e * 4096 + drow) * 2048, scr, C.lane);
                continue; } r -= I_GU;
            { const int e = r / 2048, rr = r % 2048, kb = rr / 64, nb = rr % 64;
                if (MOE_FP8W) transpose_item8(C.A.in[24] + (size_t)e * 2048 * 2048, 2048, 64 * kb, 32 * nb, (unsigned char*)wdn_t + ((size_t)e * 2048 + 32 * nb) * 2048, scr, C.lane);
                else transpose_item(C.A.in[24] + (size_t)e * 2048 * 2048, 2048, 64 * kb, 32 * nb, wdn_t + ((size_t)e * 2048 + 32 * nb) * 2048, scr, C.lane); }
        }
    }
    __syncthreads();
    {
        const float* w1 = C.A.in[5]; const float* b1 = C.A.in[6]; const float* w2 = C.A.in[7]; const float* b2 = C.A.in[8]; const float* freq = C.A.in[10];
        LAS float* h1s = (LAS float*)C.lds;
        const int tt = C.tid >> 6, j = C.tid & 63;
        for (int tb = blockIdx.x; tb < SEQ / 8; tb += C.G) {
            const int t = tb * 8 + tt;
            const float zt = (float)t / 2047.0f, wt = 6.283185307179586f * (float)t / 2048.0f;
            float acc = b1[j] + zt * w1[j];
            for (int i = 0; i < 16; ++i) { const float fb = 1e-4f + (float)i * ((15.0f - 1e-4f) / 15.0f); const float arg = fb * wt;
                acc += cosf(arg) * w1[(1 + i) * 64 + j] - sinf(arg) * w1[(17 + i) * 64 + j]; }
            h1s[tt * 64 + j] = sinf(freq[j] * acc);
            __syncthreads();
            float a2 = b2[j];
            for (int i = 0; i < 64; ++i) a2 += h1s[tt * 64 + i] * w2[i * 64 + j];
            { const float hv = sinf(freq[64 + j] * a2); const unsigned hi = f2bf(hv); const float lo = hv - bflo(hi);
              bf16* hp = (bf16*)(ws + WS_H2P) + (size_t)t * 256; hp[j] = (bf16)hi; hp[64 + j] = (bf16)hi; hp[128 + j] = (bf16)f2bf(lo); hp[192 + j] = 0; }
            __syncthreads();
        }
        const float* w3 = C.A.in[9]; bf16* wp = (bf16*)(ws + WS_W3P);
        for (int i = blockIdx.x * NTHREADS + C.tid; i < 4096 * 8; i += C.G * NTHREADS) {
            const int col = i & 4095, jo = i >> 12; float wv[8]; unsigned hi[8], lo[8];
#pragma unroll
            for (int k = 0; k < 8; ++k) { wv[k] = w3[(size_t)(jo * 8 + k) * 4096 + col]; hi[k] = f2bf(wv[k]); lo[k] = f2bf(wv[k] - bflo(hi[k])); }
            v4u vh, vl; vh.x = hi[0] | (hi[1] << 16); vh.y = hi[2] | (hi[3] << 16); vh.z = hi[4] | (hi[5] << 16); vh.w = hi[6] | (hi[7] << 16);
            vl.x = lo[0] | (lo[1] << 16); vl.y = lo[2] | (lo[3] << 16); vl.z = lo[4] | (lo[5] << 16); vl.w = lo[6] | (lo[7] << 16);
            bf16* row = wp + (size_t)col * 256 + jo * 8;
            *(v4u*)row = vh; *(v4u*)(row + 64) = vl; *(v4u*)(row + 128) = vh; *(v4u*)(row + 192) = (v4u){0u, 0u, 0u, 0u};
        }
    }
}

#ifndef NAIVE_ML
#define NAIVE_ML 0
#endif
constexpr int N1_SW_TILES = 16, N1_SW = N1_SW_TILES * 32;
constexpr int N1_NORM_TILES = NAIVE_ML ? 17 : 13, N1_NORM = N1_NORM_TILES * 32, N1_UNITS = N1_SW + N1_NORM;
struct Gemm1Order {
    int G, c;
    __device__ __forceinline__ int a_row(const pg8::Unit& u, int r) const { return u.pm * 256 + r; }
    __device__ __forceinline__ bool next(int i, pg8::Unit& u) const {
        const int L = i * G + c; if (L >= N1_UNITS) return false;
        int w; { const int q = N1_UNITS / 8, r = N1_UNITS % 8, xcd = L % 8, off = L / 8; w = (xcd < r ? xcd * (q + 1) : r * (q + 1) + (xcd - r) * q) + off; }
        if (w < N1_SW) { const int nig = 8 * 32, gid = w / nig, wi = w % nig, mi = gid * 8 + (wi % 8), ni = wi / 8;
            u.pm = WIN_T0 + (mi < 12 ? mi : 8 + mi); u.pn = XB_T0 + ni; }
        else { w -= N1_SW; const int nig = 8 * N1_NORM_TILES, gid = w / nig, wi = w % nig, mi = gid * 8 + (wi % 8), ni = wi / 8;
            int wt;
            if (NAIVE_ML) wt = (ni < 16) ? 12 + ni : 28; else wt = (ni < 8) ? 12 + ni : 16 + ni;
            u.pm = XB_T0 + mi; u.pn = WIN_T0 + wt; }
        return true;
    }
    __device__ __forceinline__ void a_ready(const pg8::Unit&) const {}
    __device__ __forceinline__ void done(const pg8::Unit&) const {}
};
struct Epi1 {
    static constexpr bool PERM = true, AFTER_DRAIN = false;
    const float* b_in; bf16* hyt; bf16* qkraw; bf16* vb; bf16* ob; float* gates;
    __device__ __forceinline__ void operator()(const pg8::f32x4 (&acc)[2][2][4][2], const pg8::Unit& u, int wr, int wc, int fr_, int fq_) const {
        int ln_ = threadIdx.x & 63; asm volatile("" : "+v"(ln_));
        const int fr = ln_ & 15, fq = ln_ >> 4;
        using pg8::cvt_pk_bf16;
        if (u.pm >= WIN_T0) {
            const int wt = u.pm - WIN_T0, tt = u.pn - XB_T0;
            const int col0 = tt * 256 + wc * 32 + 8 * fq;
#pragma unroll
            for (int ai = 0; ai < 2; ++ai)
#pragma unroll
                for (int m = 0; m < 4; ++m) {
                    const int ch = wt * 256 + ai * 128 + wr * 64 + m * 16 + fr; const float bv = b_in[ch];
                    const int drow = ch < 3072 ? ch : ch - 2048;
                    bf16* rowp = hyt + (size_t)drow * T + col0;
#pragma unroll
                    for (int bj = 0; bj < 2; ++bj) { const pg8::f32x4 v0 = acc[ai][bj][m][0] + bv, v1 = acc[ai][bj][m][1] + bv;
                        v4u w; w.x = cvt_pk_bf16(v0[0], v0[1]); w.y = cvt_pk_bf16(v0[2], v0[3]); w.z = cvt_pk_bf16(v1[0], v1[1]); w.w = cvt_pk_bf16(v1[2], v1[3]);
                        *(v4u*)(rowp + bj * 128) = w; }
                }
        } else {
            const int tt = u.pm - XB_T0, wt = u.pn - WIN_T0;
            const int chb = wt * 256 + wc * 32 + 8 * fq;
            pg8::f32x4 bv[2][2];
#pragma unroll
            for (int bj = 0; bj < 2; ++bj)
#pragma unroll
                for (int n = 0; n < 2; ++n) { const int c0 = chb + bj * 128 + 4 * n; bv[bj][n] = (c0 < DIN) ? *(const pg8::f32x4*)(b_in + c0) : (pg8::f32x4){0.f, 0.f, 0.f, 0.f}; }
            if (wt == 28) {
                if (wc == 0) {
#pragma unroll
                    for (int ai = 0; ai < 2; ++ai)
#pragma unroll
                        for (int m = 0; m < 4; ++m) { const int tok = tt * 256 + ai * 128 + wr * 64 + m * 16 + fr;
                            float* gp = gates + (size_t)tok * 32 + 8 * fq;
                            *(pg8::f32x4*)(gp) = acc[ai][0][m][0] + bv[0][0]; *(pg8::f32x4*)(gp + 4) = acc[ai][0][m][1] + bv[0][1]; }
                }
            } else {
#define EPI1_STORE(base, ld, cb) do { _Pragma("unroll") for (int ai = 0; ai < 2; ++ai) _Pragma("unroll") for (int m = 0; m < 4; ++m) { const int tok = tt * 256 + ai * 128 + wr * 64 + m * 16 + fr; \
                    bf16* rowp = (base) + (size_t)tok * (ld) + (cb); \
                    _Pragma("unroll") for (int bj = 0; bj < 2; ++bj) { const pg8::f32x4 v0 = acc[ai][bj][m][0] + bv[bj][0], v1 = acc[ai][bj][m][1] + bv[bj][1]; \
                        v4u w; w.x = cvt_pk_bf16(v0[0], v0[1]); w.y = cvt_pk_bf16(v0[2], v0[3]); w.z = cvt_pk_bf16(v1[0], v1[1]); w.w = cvt_pk_bf16(v1[2], v1[3]); \
                        *(v4u*)(rowp + bj * 128) = w; } } } while (0)
                if (wt < 20) EPI1_STORE(qkraw, 2048, chb - 3072);
                else if (wt < 24) EPI1_STORE(vb, 1024, chb - 5120);
                else EPI1_STORE(ob, 1024, chb - 6144);
#undef EPI1_STORE
            }
        }
    }
};

struct KtOrder {
    int G, c;
    __device__ __forceinline__ bool next(int i, pg8::Unit& u) const { const int cc = G - 1 - c; if (i != 0 || cc >= 128) return false; u.pm = cc >> 3; u.pn = cc & 7; return true; }
    __device__ __forceinline__ void a_ready(const pg8::Unit&) const {}
    __device__ __forceinline__ void done(const pg8::Unit&) const {}
};
struct EpiKT {
    static constexpr bool PERM = true, AFTER_DRAIN = false;
    float* kt;
    __device__ __forceinline__ void operator()(const pg8::f32x4 (&acc)[2][2][4][2], const pg8::Unit& u, int wr, int wc, int fr, int fq) const {
        const float da = -3.0701134573253945f, db = -15.350567286626973f;
#pragma unroll
        for (int ai = 0; ai < 2; ++ai)
#pragma unroll
            for (int m = 0; m < 4; ++m) {
                const int col = u.pm * 256 + ai * 128 + wr * 64 + m * 16 + fr, o = col >> 11, dir = (col >> 10) & 1, c = col & 1023;
                const float delta = fabsf(da + (float)c * ((db - da) / 1023.0f)) * (1.0f / 2047.0f);
                float* kr = kt + ((size_t)o * 1024 + c) * 4096;
#pragma unroll
                for (int bj = 0; bj < 2; ++bj) {
                    const int t0 = u.pn * 256 + bj * 128 + wc * 32 + 8 * fq; float v[8];
#pragma unroll
                    for (int n = 0; n < 2; ++n)
#pragma unroll
                        for (int e = 0; e < 4; ++e) v[4 * n + e] = acc[ai][bj][m][n][e] * expf(-(float)(t0 + 4 * n + e) * delta);
                    if (dir == 0) { *(pg8::f32x4*)(kr + t0) = (pg8::f32x4){v[0], v[1], v[2], v[3]}; *(pg8::f32x4*)(kr + t0 + 4) = (pg8::f32x4){v[4], v[5], v[6], v[7]}; }
                    else {
#pragma unroll
                        for (int e = 0; e < 8; ++e) if (t0 + e >= 1) kr[4096 - t0 - e] = v[e]; }
                }
            }
    }
};

template <int OP> __device__ __forceinline__ LAS float* block_scan_2048(LAS float* x, LAS float* y, int tid) {
    LAS float* src = x; LAS float* dst = y;
    for (int off = 1; off < 2048; off <<= 1) {
#pragma unroll
        for (int i = 0; i < 4; ++i) { const int idx = tid + 512 * i; float v = src[idx]; if (idx >= off) { const float w = src[idx - off]; v = OP ? fmaxf(v, w) : v + w; } dst[idx] = v; }
        __syncthreads();
        LAS float* t = src; src = dst; dst = t;
    }
    return src;
}
__device__ __forceinline__ float logsigmoidf(float x) { return fminf(x, 0.f) - log1pf(expf(-fabsf(x))); }

__device__ __forceinline__ void phase2(const Ctx& C) {
    unsigned char* ws = C.ws;
    {
        const float* KT = (const float*)(ws + WS_KT); f32x4* KF = (f32x4*)(ws + WS_KF);
        const int half = C.tid >> 8, g = C.tid & 255;
        LAS float* re = (LAS float*)(C.lds + half * (2 * FFT_WORDS * 4)); LAS float* im = re + FFT_WORDS;
        LAS float* red = (LAS float*)(C.lds + 4 * FFT_WORDS * 4);
        for (int u = blockIdx.x; u < 1024; u += C.G) {
            const int o = u >> 9, c0 = (u & 511) * 2, c = c0 + half;
            __syncthreads();
            const float* kcol = KT + ((size_t)o * 1024 + c) * 4096;
            float xr[16], xi[16]; float asum = 0.f;
#pragma unroll
            for (int m = 0; m < 16; ++m) { const int idx = g + 256 * m; const float val = (idx == 2048) ? 0.f : kcol[idx]; xr[m] = val; xi[m] = 0.f; asum += fabsf(val); }
            asum = wave_sum(asum);
            if (C.lane == 0) red[C.wave] = asum;
            __syncthreads();
            const float tot = red[half * 4] + red[half * 4 + 1] + red[half * 4 + 2] + red[half * 4 + 3];
            const float scl = 1.0f / (tot * 4096.0f);
#pragma unroll
            for (int m = 0; m < 16; ++m) xr[m] *= scl;
            dft16<false>(xr, xi); twiddle16<false>(xr, xi, g, 4096); fft_store_s256(re, im, g, xr, xi);
            __syncthreads();
            fft_load_s16(re, im, g, xr, xi); dft16<false>(xr, xi); twiddle16<false>(xr, xi, g & 15, 256); fft_store_s16(re, im, g, xr, xi);
            __syncthreads();
            fft_load_s1(re, im, g, xr, xi); dft16<false>(xr, xi);
            f32x4* dst = KF + ((size_t)(o * 1024 + c) * 4096 + g * 16) / 2;
#pragma unroll
            for (int k = 0; k < 8; ++k) dst[k] = (f32x4){xr[2 * k], xi[2 * k], xr[2 * k + 1], xi[2 * k + 1]};
        }
        __syncthreads();
    }
    {
        const bf16* raw = (const bf16*)(ws + WS_QKRAW); bf16* qkc = (bf16*)(ws + WS_QKC); const float* cw = C.A.in[13]; const float* cb = C.A.in[14];
        for (int g = blockIdx.x * NTHREADS + C.tid; g < T * 256; g += C.G * NTHREADS) {
            const int tok = g >> 8, ch0 = (g & 255) * 8, tl = tok & (SEQ - 1);
            const v4u cur = *(const v4u*)(raw + (size_t)tok * 2048 + ch0);
            v4u prv = (v4u){0u, 0u, 0u, 0u}, nxt = (v4u){0u, 0u, 0u, 0u};
            if (tl > 0) prv = *(const v4u*)(raw + (size_t)(tok - 1) * 2048 + ch0);
            if (tl < SEQ - 1) nxt = *(const v4u*)(raw + (size_t)(tok + 1) * 2048 + ch0);
            const float sc = ch0 >= 1024 ? 0.08838834764831845f : 1.0f;
            float o[8];
#pragma unroll
            for (int i = 0; i < 8; ++i) {
                const unsigned pw = prv[i >> 1], cwd = cur[i >> 1], nw = nxt[i >> 1];
                const float p = (i & 1) ? bfhi(pw) : bflo(pw), q = (i & 1) ? bfhi(cwd) : bflo(cwd), n = (i & 1) ? bfhi(nw) : bflo(nw);
                const int ch = ch0 + i;
                const float v = cw[ch] * p + cw[2048 + ch] * q + cw[4096 + ch] * n + cb[ch];
                o[i] = sc * v / (1.0f + expf(-v));
            }
            v4u w; w.x = pk2(o[0], o[1]); w.y = pk2(o[2], o[3]); w.z = pk2(o[4], o[5]); w.w = pk2(o[6], o[7]);
            *(v4u*)(qkc + (size_t)tok * 2048 + ch0) = w;
        }
    }
    {
        const float* gates = (const float*)(ws + WS_GATES); float* GA = (float*)(ws + WS_GA); float* GP = (float*)(ws + WS_GP); float* GE = (float*)(ws + WS_GE);
        LAS float* s0 = (LAS float*)(C.lds + 8192); LAS float* s1 = s0 + 2048; LAS float* s2 = s1 + 2048; LAS float* s3 = s2 + 2048;
        for (int bhd = blockIdx.x; bhd < 64; bhd += C.G) {
            const int b = bhd >> 4, h = (bhd >> 1) & 7, dir = bhd & 1, col_i = dir * 16 + h, col_f = col_i + 8;
            float ig[4], lf[4];
            __syncthreads();
#pragma unroll
            for (int i = 0; i < 4; ++i) { const int t = C.tid + 512 * i; const float* gr = gates + (size_t)(b * SEQ + t) * 32; ig[i] = gr[col_i]; lf[i] = logsigmoidf(gr[col_f]); s0[t] = lf[i]; }
            __syncthreads();
            LAS float* Fc = block_scan_2048<0>(s0, s1, C.tid);
            float a[4], Fv[4], Gx[4];
#pragma unroll
            for (int i = 0; i < 4; ++i) { const int t = C.tid + 512 * i; Fv[i] = Fc[t]; Gx[i] = Fv[i] - lf[i]; a[i] = dir ? ig[i] + Gx[i] : ig[i] - Fv[i]; s2[dir ? 2047 - t : t] = a[i]; }
            __syncthreads();
            LAS float* Pm = block_scan_2048<1>(s2, s3, C.tid);
#pragma unroll
            for (int i = 0; i < 4; ++i) { const int t = C.tid + 512 * i; const float pm = Pm[dir ? 2047 - t : t];
                const float mt = dir ? pm - Gx[i] : Fv[i] + pm;
                GA[bhd * 2048 + t] = a[i]; GP[bhd * 2048 + t] = pm; GE[bhd * 2048 + t] = expf(-mt); }
        }
        __syncthreads();
    }
}

__device__ __forceinline__ void hyena_naive(const Ctx& C) {
    unsigned char* ws = C.ws;
    const bf16* hyt = (const bf16*)(ws + WS_HYT); const float* KT = (const float*)(ws + WS_KT); float* Z = (float*)(ws + WS_Z);
    const float* cw = C.A.in[3]; const float* cb = C.A.in[4]; const float* skip = C.A.in[11];
    LAS float* sv = (LAS float*)C.lds; LAS float* sk = sv + 2048;
    for (int u = blockIdx.x; u < NB * DHY; u += C.G) {
        const int b = u >> 10, c = u & 1023;
        float v[4], x1[4], x2[4];
#pragma unroll
        for (int part = 0; part < 3; ++part) {
            const int ch = part * 1024 + c; const bf16* row = hyt + (size_t)ch * T + b * SEQ;
            const float w0 = cw[ch], w1 = cw[3072 + ch], w2 = cw[6144 + ch], bb = cb[ch];
#pragma unroll
            for (int i = 0; i < 4; ++i) { const int t = C.tid + 512 * i;
                const float p = t > 0 ? bf2f(row[t - 1]) : 0.f, q = bf2f(row[t]), n = t < SEQ - 1 ? bf2f(row[t + 1]) : 0.f;
                const float r = w0 * p + w1 * q + w2 * n + bb;
                if (part == 0) v[i] = r; else if (part == 1) x1[i] = r; else x2[i] = r; }
        }
        __syncthreads();
#pragma unroll
        for (int i = 0; i < 4; ++i) sv[C.tid + 512 * i] = v[i];
#pragma unroll
        for (int i = 0; i < 8; ++i) sk[C.tid + 512 * i] = KT[(size_t)c * 4096 + C.tid + 512 * i];
        __syncthreads();
        float acc[4] = {0.f, 0.f, 0.f, 0.f};
        for (int s = 0; s < SEQ; ++s) { const float vv = sv[s];
#pragma unroll
            for (int i = 0; i < 4; ++i) acc[i] += sk[(C.tid + 512 * i - s) & 4095] * vv; }
        float z1[4]; const float sk0 = skip[c], sk1 = skip[1024 + c];
#pragma unroll
        for (int i = 0; i < 4; ++i) z1[i] = x1[i] * (acc[i] + sk0 * v[i]);
        __syncthreads();
#pragma unroll
        for (int i = 0; i < 4; ++i) sv[C.tid + 512 * i] = z1[i];
#pragma unroll
        for (int i = 0; i < 8; ++i) sk[C.tid + 512 * i] = KT[(size_t)(1024 + c) * 4096 + C.tid + 512 * i];
        __syncthreads();
#pragma unroll
        for (int i = 0; i < 4; ++i) acc[i] = 0.f;
        for (int s = 0; s < SEQ; ++s) { const float vv = sv[s];
#pragma unroll
            for (int i = 0; i < 4; ++i) acc[i] += sk[(C.tid + 512 * i - s) & 4095] * vv; }
#pragma unroll
        for (int i = 0; i < 4; ++i) Z[(size_t)(b * SEQ + C.tid + 512 * i) * 1024 + c] = x2[i] * (acc[i] + sk1 * z1[i]);
    }
    __syncthreads();
}

__device__ __forceinline__ void hyena_conv_once(LAS float* re, LAS float* im, int g, float (&xr)[16], float (&xi)[16], const f32x4* __restrict__ kf) {
    __syncthreads();
    dft16<false>(xr, xi); twiddle16<false>(xr, xi, g, 4096); fft_store_s256(re, im, g, xr, xi);
    __syncthreads();
    fft_load_s16(re, im, g, xr, xi); dft16<false>(xr, xi); twiddle16<false>(xr, xi, g & 15, 256); fft_store_s16(re, im, g, xr, xi);
    __syncthreads();
    fft_load_s1(re, im, g, xr, xi); dft16<false>(xr, xi);
#pragma unroll
    for (int k = 0; k < 8; ++k) { const f32x4 w = kf[g * 8 + k];
        const float r0 = xr[2 * k] * w.x - xi[2 * k] * w.y, i0 = xr[2 * k] * w.y + xi[2 * k] * w.x;
        const float r1 = xr[2 * k + 1] * w.z - xi[2 * k + 1] * w.w, i1 = xr[2 * k + 1] * w.w + xi[2 * k + 1] * w.z;
        xr[2 * k] = r0; xi[2 * k] = i0; xr[2 * k + 1] = r1; xi[2 * k + 1] = i1; }
    dft16<true>(xr, xi); fft_store_s1(re, im, g, xr, xi);
    __syncthreads();
    fft_load_s16(re, im, g, xr, xi); twiddle16<true>(xr, xi, g & 15, 256); dft16<true>(xr, xi); fft_store_s16(re, im, g, xr, xi);
    __syncthreads();
    fft_load_s256(re, im, g, xr, xi); twiddle16<true>(xr, xi, g, 4096); dft16<true>(xr, xi);
}
__device__ __forceinline__ void hyena_fft(const Ctx& C) {
    unsigned char* ws = C.ws;
    const bf16* hyt = (const bf16*)(ws + WS_HYT); const f32x4* KF = (const f32x4*)(ws + WS_KF); float* ZT = (float*)(ws + WS_ZT);
    const float* cw = C.A.in[3]; const float* cb = C.A.in[4]; const float* skip = C.A.in[11];
    const int half = C.tid >> 8, g = C.tid & 255;
    LAS float* re = (LAS float*)(C.lds + half * (2 * FFT_WORDS * 4)); LAS float* im = re + FFT_WORDS;
    for (int c = blockIdx.x; c < DHY; c += C.G) {
        float vr[8], vi[8], ar[8], ai[8], br[8], bi[8];
#pragma unroll
        for (int part = 0; part < 3; ++part) {
            const int ch = part * 1024 + c; const float w0 = cw[ch], w1 = cw[3072 + ch], w2 = cw[6144 + ch], bb = cb[ch];
#pragma unroll
            for (int bq = 0; bq < 2; ++bq) { const bf16* row = hyt + (size_t)ch * T + (2 * half + bq) * SEQ;
#pragma unroll
                for (int m = 0; m < 8; ++m) { const int t = g + 256 * m;
                    const float p = t > 0 ? bf2f(row[t - 1]) : 0.f, q = bf2f(row[t]), n = t < SEQ - 1 ? bf2f(row[t + 1]) : 0.f;
                    const float r = w0 * p + w1 * q + w2 * n + bb;
                    if (part == 0) { if (bq == 0) vr[m] = r; else vi[m] = r; } else if (part == 1) { if (bq == 0) ar[m] = r; else ai[m] = r; } else { if (bq == 0) br[m] = r; else bi[m] = r; } }
                asm volatile("" ::: "memory"); }
        }
        const float sk0 = skip[c], sk1 = skip[1024 + c];
        float xr[16], xi[16];
#pragma unroll
        for (int m = 0; m < 8; ++m) { xr[m] = vr[m]; xi[m] = vi[m]; xr[m + 8] = 0.f; xi[m + 8] = 0.f; }
        hyena_conv_once(re, im, g, xr, xi, KF + (size_t)c * 2048);
#pragma unroll
        for (int m = 0; m < 8; ++m) { vr[m] = ar[m] * (xr[m] + sk0 * vr[m]); vi[m] = ai[m] * (xi[m] + sk0 * vi[m]); xr[m] = vr[m]; xi[m] = vi[m]; xr[m + 8] = 0.f; xi[m + 8] = 0.f; }
        hyena_conv_once(re, im, g, xr, xi, KF + (size_t)(1024 + c) * 2048);
        float* zr = ZT + (size_t)c * T + (2 * half) * SEQ;
#pragma unroll
        for (int m = 0; m < 8; ++m) { const int t = g + 256 * m; zr[t] = br[m] * (xr[m] + sk1 * vr[m]); zr[SEQ + t] = bi[m] * (xi[m] + sk1 * vi[m]); }
    }
    __syncthreads();
}

__device__ __forceinline__ void mlstm_naive(const Ctx& C) {
    unsigned char* ws = C.ws;
    const bf16* qkc = (const bf16*)(ws + WS_QKC); const bf16* vb = (const bf16*)(ws + WS_VB);
    const float* GA = (const float*)(ws + WS_GA); const float* GP = (const float*)(ws + WS_GP); const float* GE = (const float*)(ws + WS_GE);
    float* HML = (float*)(ws + WS_HML);
    LAS float* qs = (LAS float*)(C.lds + C.wave * 1024); LAS float* ps = qs + 128;
    const int lane = C.lane;
    for (int u = blockIdx.x; u < 64 * 32; u += C.G) {
        const int bhd = u >> 5, qb = u & 31, b = bhd >> 4, h = (bhd >> 1) & 7, dir = bhd & 1;
        for (int qi = 0; qi < 8; ++qi) {
            const int t = qb * 64 + C.wave * 8 + qi;
            { const unsigned w = *(const unsigned*)(qkc + (size_t)(b * SEQ + t) * 2048 + h * 128 + 2 * lane); qs[2 * lane] = bflo(w); qs[2 * lane + 1] = bfhi(w); }
            __builtin_amdgcn_wave_barrier(); LDS_WAIT();
            const float pmt = GP[bhd * 2048 + t];
            const int c_lo = dir ? (t >> 6) : 0, c_hi = dir ? 31 : (t >> 6);
            float acc0 = 0.f, acc1 = 0.f, den = 0.f;
            for (int cch = c_lo; cch <= c_hi; ++cch) {
                const int s = cch * 64 + lane; const bool valid = dir ? (s >= t) : (s <= t);
                const v4u* kr = (const v4u*)(qkc + (size_t)(b * SEQ + s) * 2048 + 1024 + h * 128);
                float sc = 0.f;
#pragma unroll
                for (int j = 0; j < 16; ++j) { const v4u kk = kr[j];
#pragma unroll
                    for (int e = 0; e < 4; ++e) sc += qs[8 * j + 2 * e] * bflo(kk[e]) + qs[8 * j + 2 * e + 1] * bfhi(kk[e]); }
                const float p = valid ? sc * expf(GA[bhd * 2048 + s] - pmt) : 0.f;
                den += p;
                __builtin_amdgcn_wave_barrier();
                ps[lane] = p;
                __builtin_amdgcn_wave_barrier(); LDS_WAIT();
                const bf16* vr = vb + (size_t)(b * SEQ + cch * 64) * 1024 + h * 128 + 2 * lane;
#pragma unroll 8
                for (int s2 = 0; s2 < 64; ++s2) { const unsigned w = *(const unsigned*)(vr + (size_t)s2 * 1024); const float pv = ps[s2]; acc0 += pv * bflo(w); acc1 += pv * bfhi(w); }
                __builtin_amdgcn_wave_barrier();
            }
            den = wave_sum(den);
            const float scl = 1.0f / fmaxf(fabsf(den), GE[bhd * 2048 + t]);
            *(f32x2*)(HML + ((size_t)dir * T + b * SEQ + t) * 1024 + h * 128 + 2 * lane) = (f32x2){acc0 * scl, acc1 * scl};
            __builtin_amdgcn_wave_barrier();
        }
    }
    __syncthreads();
}

typedef short ml_bf16x8 __attribute__((ext_vector_type(8)));
typedef short ml_s16x4 __attribute__((ext_vector_type(4)));
typedef float ml_f32x16 __attribute__((ext_vector_type(16)));
typedef __bf16 ml_bf2 __attribute__((ext_vector_type(2)));
constexpr int ML_KROW = 272, ML_VROW = 136, ML_KBUF = 64 * ML_KROW, ML_VBUF = 128 * ML_VROW;
__device__ __forceinline__ unsigned ml_pk(float lo, float hi) { const f32x2 v = {lo, hi}; return __builtin_bit_cast(unsigned, __builtin_convertvector(v, ml_bf2)); }
__device__ __forceinline__ void mlstm_mfma(const Ctx& C) {
    unsigned char* ws = C.ws;
    const bf16* qkc = (const bf16*)(ws + WS_QKC); const bf16* vt = (const bf16*)(ws + WS_HYT) + (size_t)3072 * T;
    const float* GA = (const float*)(ws + WS_GA); const float* GP = (const float*)(ws + WS_GP); const float* GE = (const float*)(ws + WS_GE);
    float* HML = (float*)(ws + WS_HML);
    LAS unsigned char* KB = C.lds; LAS unsigned char* VB = C.lds + 2 * ML_KBUF; LAS float* AS = (LAS float*)(C.lds + 2 * ML_KBUF + 2 * ML_VBUF);
    const int w = C.wave, lane = C.lane, r = lane & 31, hh = lane >> 5, tid = C.tid;
    for (int pu = blockIdx.x; pu < 256; pu += C.G) {
        const int bhd = pu >> 2, pq = pu & 3, b = bhd >> 4, h = (bhd >> 1) & 7, dir = bhd & 1;
        __syncthreads();
        for (int i = tid; i < SEQ; i += NTHREADS) AS[i] = GA[bhd * SEQ + i];
        const bf16* kbase = qkc + (size_t)(b * SEQ) * 2048 + 1024 + h * 128;
        const bf16* vbase = vt + (size_t)(h * 128) * T + b * SEQ;
#pragma unroll 1
        for (int hf = 0; hf < 2; ++hf) {
            const int qb = hf ? 7 - pq : pq;
            const int qlo = 256 * qb + 32 * w, tq = qlo + r;
            ml_bf16x8 qf[8];
            { const bf16* qrow = qkc + (size_t)(b * SEQ + tq) * 2048 + h * 128 + 8 * hh;
#pragma unroll
              for (int s = 0; s < 8; ++s) qf[s] = *(const ml_bf16x8*)(qrow + 16 * s); }
            const float pmt = GP[bhd * SEQ + tq];
            ml_f32x16 O[4];
#pragma unroll
            for (int d = 0; d < 4; ++d)
#pragma unroll
                for (int i = 0; i < 16; ++i) O[d][i] = 0.f;
            float den = 0.f;
            const int kt0 = dir ? 4 * qb : 0, kt1 = dir ? 31 : 4 * qb + 3;
            v4u kr0, kr1, vr0, vr1;
#define ML_LOAD(kt) do { const int p0 = tid, p1 = tid + 512; \
                kr0 = *(const v4u*)(kbase + (size_t)(64 * (kt) + (p0 >> 4)) * 2048 + (p0 & 15) * 8); kr1 = *(const v4u*)(kbase + (size_t)(64 * (kt) + (p1 >> 4)) * 2048 + (p1 & 15) * 8); \
                vr0 = *(const v4u*)(vbase + (size_t)(p0 >> 3) * T + 64 * (kt) + (p0 & 7) * 8); vr1 = *(const v4u*)(vbase + (size_t)(p1 >> 3) * T + 64 * (kt) + (p1 & 7) * 8); } while (0)
#define ML_STORE(buf) do { const int p0 = tid, p1 = tid + 512; \
                *(LAS v4u*)(KB + (buf) * ML_KBUF + (p0 >> 4) * ML_KROW + (p0 & 15) * 16) = kr0; *(LAS v4u*)(KB + (buf) * ML_KBUF + (p1 >> 4) * ML_KROW + (p1 & 15) * 16) = kr1; \
                { LAS unsigned char* d0 = VB + (buf) * ML_VBUF + (p0 >> 3) * ML_VROW + (p0 & 7) * 16; *(LAS v2u*)d0 = (v2u){vr0.x, vr0.y}; *(LAS v2u*)(d0 + 8) = (v2u){vr0.z, vr0.w}; } \
                { LAS unsigned char* d1 = VB + (buf) * ML_VBUF + (p1 >> 3) * ML_VROW + (p1 & 7) * 16; *(LAS v2u*)d1 = (v2u){vr1.x, vr1.y}; *(LAS v2u*)(d1 + 8) = (v2u){vr1.z, vr1.w}; } } while (0)
            ML_LOAD(kt0);
            __syncthreads();
            ML_STORE(0);
            __syncthreads();
#pragma unroll 1
            for (int kt = kt0; kt <= kt1; ++kt) {
                const int cur = (kt - kt0) & 1;
                if (kt < kt1) ML_LOAD(kt + 1);
                const int klo = 64 * kt, khi = klo + 63, qhi = qlo + 31;
                const bool none = dir ? (khi < qlo) : (klo > qhi);
                const bool all = dir ? (klo >= qhi) : (khi <= qlo);
                if (!none) {
                    const LAS unsigned char* Kb = KB + cur * ML_KBUF; const LAS unsigned char* Vb = VB + cur * ML_VBUF;
                    ml_f32x16 S0, S1;
#pragma unroll
                    for (int i = 0; i < 16; ++i) { S0[i] = 0.f; S1[i] = 0.f; }
#pragma unroll
                    for (int s = 0; s < 8; ++s) {
                        const ml_bf16x8 k0 = *(const LAS ml_bf16x8*)(Kb + r * ML_KROW + (16 * s + 8 * hh) * 2);
                        const ml_bf16x8 k1 = *(const LAS ml_bf16x8*)(Kb + (32 + r) * ML_KROW + (16 * s + 8 * hh) * 2);
                        S0 = __builtin_amdgcn_mfma_f32_32x32x16_bf16(k0, qf[s], S0, 0, 0, 0);
                        S1 = __builtin_amdgcn_mfma_f32_32x32x16_bf16(k1, qf[s], S1, 0, 0, 0);
                    }
#pragma unroll
                    for (int kb = 0; kb < 2; ++kb)
#pragma unroll
                        for (int g4 = 0; g4 < 4; ++g4) {
                            const f32x4 a4 = *(const LAS f32x4*)(AS + klo + 32 * kb + 8 * g4 + 4 * hh);
#pragma unroll
                            for (int e = 0; e < 4; ++e) {
                                const int i = 4 * g4 + e; const int sg = klo + 32 * kb + 8 * g4 + 4 * hh + e;
                                const float sv = kb ? S1[i] : S0[i];
                                float p = sv * __expf(a4[e] - pmt);
                                if (!all) { const bool valid = dir ? (sg >= tq) : (sg <= tq); p = valid ? p : 0.f; }
                                den += p;
                                if (kb) S1[i] = p; else S0[i] = p;
                            }
                        }
#pragma unroll
                    for (int kb = 0; kb < 2; ++kb)
#pragma unroll
                        for (int s = 0; s < 2; ++s) {
                            v4u pw;
                            if (kb == 0) { pw.x = ml_pk(S0[8 * s], S0[8 * s + 1]); pw.y = ml_pk(S0[8 * s + 2], S0[8 * s + 3]); pw.z = ml_pk(S0[8 * s + 4], S0[8 * s + 5]); pw.w = ml_pk(S0[8 * s + 6], S0[8 * s + 7]); }
                            else { pw.x = ml_pk(S1[8 * s], S1[8 * s + 1]); pw.y = ml_pk(S1[8 * s + 2], S1[8 * s + 3]); pw.z = ml_pk(S1[8 * s + 4], S1[8 * s + 5]); pw.w = ml_pk(S1[8 * s + 6], S1[8 * s + 7]); }
                            const ml_bf16x8 pf = __builtin_bit_cast(ml_bf16x8, pw);
#pragma unroll
                            for (int db = 0; db < 4; ++db) {
                                const LAS unsigned char* vp = Vb + (32 * db + r) * ML_VROW + 2 * (32 * kb + 16 * s + 4 * hh);
                                const ml_s16x4 lo = *(const LAS ml_s16x4*)vp, hi = *(const LAS ml_s16x4*)(vp + 16);
                                const ml_bf16x8 vf = __builtin_shufflevector(lo, hi, 0, 1, 2, 3, 4, 5, 6, 7);
                                O[db] = __builtin_amdgcn_mfma_f32_32x32x16_bf16(vf, pf, O[db], 0, 0, 0);
                            }
                        }
                }
                if (kt < kt1) ML_STORE(cur ^ 1);
                __syncthreads();
            }
#undef ML_LOAD
#undef ML_STORE
            den += __shfl_xor(den, 32);
            const float scl = 1.0f / fmaxf(fabsf(den), GE[bhd * SEQ + tq]);
            float* orow = HML + ((size_t)dir * T + b * SEQ + tq) * 1024 + h * 128 + 4 * hh;
#pragma unroll
            for (int db = 0; db < 4; ++db)
#pragma unroll
                for (int g4 = 0; g4 < 4; ++g4)
                    *(f32x4*)(orow + 32 * db + 8 * g4) = (f32x4){O[db][4 * g4] * scl, O[db][4 * g4 + 1] * scl, O[db][4 * g4 + 2] * scl, O[db][4 * g4 + 3] * scl};
        }
    }
    __syncthreads();
}

__device__ __forceinline__ void phase4(const Ctx& C) {
    unsigned char* ws = C.ws;
    const float* ZT = (const float*)(ws + WS_ZT); const float* HML = (const float*)(ws + WS_HML); const bf16* ob = (const bf16*)(ws + WS_OB);
    bf16* ycat = (bf16*)(ws + (size_t)YCAT_T0 * MiB); const float* hyw = C.A.in[12]; const float* mlw = C.A.in[15];
    const int lane = C.lane;
    {
        LAS float* red = (LAS float*)C.lds;
        for (int u = blockIdx.x; u < 128 * 8; u += C.G) {
            const int tt = u >> 3, gi = u & 7, tok = tt * 64 + lane, ch0 = gi * 128 + C.wave * 16;
            float x[16]; float s = 0.f;
#pragma unroll
            for (int i = 0; i < 16; ++i) { x[i] = ZT[(size_t)(ch0 + i) * T + tok]; s += x[i]; }
            __syncthreads();
            red[C.wave * 64 + lane] = s;
            __syncthreads();
            float tot = 0.f;
#pragma unroll
            for (int w = 0; w < 8; ++w) tot += red[w * 64 + lane];
            const float mu = tot * (1.0f / 128.0f); float q = 0.f;
#pragma unroll
            for (int i = 0; i < 16; ++i) { x[i] -= mu; q += x[i] * x[i]; }
            __syncthreads();
            red[C.wave * 64 + lane] = q;
            __syncthreads();
            float qt = 0.f;
#pragma unroll
            for (int w = 0; w < 8; ++w) qt += red[w * 64 + lane];
            const float rstd = 1.0f / sqrtf(qt * (1.0f / 128.0f) + LN_EPS);
            float y[16];
#pragma unroll
            for (int i = 0; i < 16; ++i) y[i] = x[i] * rstd * hyw[ch0 + i];
            v4u w0, w1; w0.x = pk2(y[0], y[1]); w0.y = pk2(y[2], y[3]); w0.z = pk2(y[4], y[5]); w0.w = pk2(y[6], y[7]);
            w1.x = pk2(y[8], y[9]); w1.y = pk2(y[10], y[11]); w1.z = pk2(y[12], y[13]); w1.w = pk2(y[14], y[15]);
            bf16* dst = ycat + (size_t)tok * 2048 + ch0;
            *(v4u*)dst = w0; *(v4u*)(dst + 8) = w1;
        }
        __syncthreads();
    }
    for (int tok = C.gw; tok < T; tok += C.NGW) {
        float x[16];
#pragma unroll
        for (int j = 0; j < 4; ++j) { const f32x4 a = *(const f32x4*)(HML + (size_t)tok * 1024 + lane * 16 + 4 * j), bq = *(const f32x4*)(HML + ((size_t)T + tok) * 1024 + lane * 16 + 4 * j);
            x[4 * j] = a.x + bq.x; x[4 * j + 1] = a.y + bq.y; x[4 * j + 2] = a.z + bq.z; x[4 * j + 3] = a.w + bq.w; }
        float s = 0.f;
#pragma unroll
        for (int j = 0; j < 16; ++j) s += x[j];
        s += __shfl_xor(s, 1); s += __shfl_xor(s, 2); s += __shfl_xor(s, 4);
        const float mu = s * (1.0f / 128.0f); float q = 0.f;
#pragma unroll
        for (int j = 0; j < 16; ++j) { x[j] -= mu; q += x[j] * x[j]; }
        q += __shfl_xor(q, 1); q += __shfl_xor(q, 2); q += __shfl_xor(q, 4);
        const float rstd = 1.0f / sqrtf(q * (1.0f / 128.0f) + LN_EPS);
        const float* gw = mlw + lane * 16;
        float y[16];
#pragma unroll
        for (int j = 0; j < 16; ++j) y[j] = x[j] * rstd * gw[j];
        const v4u o0 = *(const v4u*)(ob + (size_t)tok * 1024 + lane * 16), o1 = *(const v4u*)(ob + (size_t)tok * 1024 + lane * 16 + 8);
#pragma unroll
        for (int j = 0; j < 4; ++j) { const float a0 = bflo(o0[j]), a1 = bfhi(o0[j]), b0 = bflo(o1[j]), b1 = bfhi(o1[j]);
            y[2 * j] *= 1.0f / (1.0f + expf(-a0)); y[2 * j + 1] *= 1.0f / (1.0f + expf(-a1)); y[8 + 2 * j] *= 1.0f / (1.0f + expf(-b0)); y[8 + 2 * j + 1] *= 1.0f / (1.0f + expf(-b1)); }
        v4u w0, w1; w0.x = pk2(y[0], y[1]); w0.y = pk2(y[2], y[3]); w0.z = pk2(y[4], y[5]); w0.w = pk2(y[6], y[7]);
        w1.x = pk2(y[8], y[9]); w1.y = pk2(y[10], y[11]); w1.z = pk2(y[12], y[13]); w1.w = pk2(y[14], y[15]);
        bf16* dst = ycat + (size_t)tok * 2048 + 1024 + lane * 16;
        *(v4u*)dst = w0; *(v4u*)(dst + 8) = w1;
    }
}

struct TileOrder {
    int nM, nN, a0, b0, G, c;
    __device__ __forceinline__ bool next(int i, pg8::Unit& u) const {
        const int nwg = nM * nN; const int L = i * G + c; if (L >= nwg) return false;
        int w; { const int q = nwg / 8, r = nwg % 8, xcd = L % 8, off = L / 8; w = (xcd < r ? xcd * (q + 1) : r * (q + 1) + (xcd - r) * q) + off; }
        const int nig = 8 * nN, gid = w / nig, wi = w % nig; u.pm = a0 + gid * 8 + (wi % 8); u.pn = b0 + wi / 8; return true;
    }
    __device__ __forceinline__ void a_ready(const pg8::Unit&) const {}
    __device__ __forceinline__ void done(const pg8::Unit&) const {}
};
struct EpiOut {
    static constexpr bool PERM = false, AFTER_DRAIN = false;
    const float* x; const float* bias; float* r1;
    __device__ __forceinline__ void operator()(const pg8::f32x4 (&acc)[2][2][4][2], const pg8::Unit& u, int wr, int wc, int fr, int fq) const {
        const int row0 = (u.pm - YCAT_T0) * 256 + wr * 64 + fr, col0 = (u.pn - WOUT_T0) * 256 + wc * 32 + 4 * fq;
        pg8::f32x4 bv[2][2];
#pragma unroll
        for (int bj = 0; bj < 2; ++bj)
#pragma unroll
            for (int n = 0; n < 2; ++n) bv[bj][n] = *(const pg8::f32x4*)(bias + col0 + bj * 128 + n * 16);
#pragma unroll
        for (int ai = 0; ai < 2; ++ai)
#pragma unroll
            for (int m = 0; m < 4; ++m) { const size_t off = (size_t)(row0 + ai * 128 + m * 16) * D + col0;
#pragma unroll
                for (int bj = 0; bj < 2; ++bj)
#pragma unroll
                    for (int n = 0; n < 2; ++n) { const pg8::f32x4 xs = *(const pg8::f32x4*)(x + off + bj * 128 + n * 16);
                        *(pg8::f32x4*)(r1 + off + bj * 128 + n * 16) = xs * DN_ALPHA + acc[ai][bj][m][n] + bv[bj][n]; } }
    }
};

#define P6_RS_STEP(NV, XM) do { const bool up = (lane & (XM)) != 0; _Pragma("unroll") for (int e_ = 0; e_ < (NV); ++e_) { \
        const float keep0 = up ? a0[e_ + (NV)] : a0[e_], send0 = up ? a0[e_] : a0[e_ + (NV)]; a0[e_] = keep0 + __shfl_xor(send0, (XM)); \
        const float keep1 = up ? a1[e_ + (NV)] : a1[e_], send1 = up ? a1[e_] : a1[e_ + (NV)]; a1[e_] = keep1 + __shfl_xor(send1, (XM)); } } while (0)
__device__ __forceinline__ void phase6(const Ctx& C, int dummy) {
    unsigned char* ws = C.ws;
    float* r1 = (float*)(ws + WS_R1); bf16* x1b = (bf16*)(ws + (size_t)X1B_T0 * MiB);
    const float* g1 = C.A.in[18]; const float* b1 = C.A.in[19]; const float* rw = C.A.in[20]; const float* rb = C.A.in[21];
    unsigned* cnt = (unsigned*)(ws + WS_CTL) + CW_CNT + (dummy ? 4096 : 0); int* list = (int*)(ws + (dummy ? WS_YBUF : WS_LIST)); float* tokw = (float*)(ws + (dummy ? WS_YBUF + 2 * MiB : WS_TOKW));
    const int lane = C.lane;
    LAS unsigned char* wbuf = C.lds;
    for (int it = blockIdx.x; it < T / 16; it += C.G) {
        const int pair = it * 8 + C.wave;
        int ln = lane; asm volatile("" : "+v"(ln));
        f32x4 v0[8], v1[8];
#pragma unroll
        for (int tk = 0; tk < 2; ++tk) {
            const int tok = 2 * pair + tk; float* rr = r1 + (size_t)tok * D; f32x4 v[8]; float s = 0.f;
#pragma unroll
            for (int j = 0; j < 8; ++j) { v[j] = *(const f32x4*)(rr + (ln + 64 * j) * 4); s += (v[j].x + v[j].y) + (v[j].z + v[j].w); }
            const float mean = wave_sum(s) * (1.0f / D); float q = 0.f;
#pragma unroll
            for (int j = 0; j < 8; ++j) { v[j] = v[j] - mean; q += (v[j].x * v[j].x + v[j].y * v[j].y) + (v[j].z * v[j].z + v[j].w * v[j].w); }
            const float rstd = 1.0f / sqrtf(wave_sum(q) * (1.0f / D) + LN_EPS);
#pragma unroll
            for (int j = 0; j < 8; ++j) { const int c0 = (ln + 64 * j) * 4; const f32x4 gg = *(const f32x4*)(g1 + c0), bb = *(const f32x4*)(b1 + c0);
                const f32x4 y = v[j] * rstd * gg + bb;
                if (!dummy) { v2u w; w.x = pk2(y.x, y.y); w.y = pk2(y.z, y.w); *(v2u*)(x1b + (size_t)tok * D + c0) = w; }
                if (tk == 0) v0[j] = y; else v1[j] = y; }
        }
        float a0[32], a1[32];
#pragma unroll
        for (int e = 0; e < 32; ++e) { a0[e] = 0.f; a1[e] = 0.f; }
        const int tid = C.tid; f32x4 st[4];
        const bool hi8 = (ln & 8) != 0;
        const unsigned rdoff = (unsigned)(4 * ln) * 128u, rdx = (unsigned)(ln & 7);
#define P6_CHUNK_LOAD(j_) do { _Pragma("unroll") for (int r_ = 0; r_ < 4; ++r_) st[r_] = *(const f32x4*)(rw + (size_t)(j_) * 8192 + (size_t)(tid + 512 * r_) * 4); } while (0)
#define P6_CHUNK_STORE(b_) do { _Pragma("unroll") for (int r_ = 0; r_ < 4; ++r_) { const int idx_ = tid + 512 * r_, row_ = idx_ >> 3, q_ = idx_ & 7; \
            *(LAS f32x4*)(wbuf + (b_) * 32768 + row_ * 128 + 16 * (q_ ^ ((row_ >> 2) & 7))) = st[r_]; } } while (0)
        __syncthreads();
        P6_CHUNK_LOAD(0); P6_CHUNK_STORE(0);
        __syncthreads();
#pragma unroll
        for (int j = 0; j < 8; ++j) {
            if (j < 7) P6_CHUNK_LOAD(j + 1);
            const LAS unsigned char* wb = wbuf + (j & 1) * 32768 + rdoff;
#pragma unroll
            for (int i = 0; i < 4; ++i) {
                const float x0 = hi8 ? v0[j][i ^ 1] : v0[j][i], x1 = hi8 ? v1[j][i ^ 1] : v1[j][i];
                const LAS unsigned char* wrow = wb + (hi8 ? (i ^ 1) : i) * 128;
#pragma unroll
                for (int q4 = 0; q4 < 8; ++q4) { const f32x4 w4 = *(const LAS f32x4*)(wrow + 16 * (q4 ^ rdx));
                    a0[4 * q4] += x0 * w4.x; a0[4 * q4 + 1] += x0 * w4.y; a0[4 * q4 + 2] += x0 * w4.z; a0[4 * q4 + 3] += x0 * w4.w;
                    a1[4 * q4] += x1 * w4.x; a1[4 * q4 + 1] += x1 * w4.y; a1[4 * q4 + 2] += x1 * w4.z; a1[4 * q4 + 3] += x1 * w4.w; }
            }
            if (j < 7) P6_CHUNK_STORE((j + 1) & 1);
            __syncthreads();
        }
#undef P6_CHUNK_LOAD
#undef P6_CHUNK_STORE
        P6_RS_STEP(16, 32); P6_RS_STEP(8, 16); P6_RS_STEP(4, 8); P6_RS_STEP(2, 4); P6_RS_STEP(1, 2);
        const int e = lane >> 1; const float rbe = rb[e];
        float lg0 = a0[0] + __shfl_xor(a0[0], 1) + rbe, lg1 = a1[0] + __shfl_xor(a1[0], 1) + rbe;
#pragma unroll
        for (int tk = 0; tk < 2; ++tk) {
            const int tok = 2 * pair + tk; float val = tk ? lg1 : lg0; float vals[4]; int idxs[4];
#pragma unroll
            for (int k = 0; k < 4; ++k) {
                const float m = wave_max(val);
                const unsigned long long bal = __ballot(val == m);
                const int idx = (int)(__builtin_ctzll(bal) >> 1);
                vals[k] = m; idxs[k] = idx;
                if (e == idx) val = -3.0e38f;
            }
            const float e1 = expf(vals[1] - vals[0]), e2 = expf(vals[2] - vals[0]), e3 = expf(vals[3] - vals[0]);
            const float inv = 1.0f / (1.0f + e1 + e2 + e3);
            if (lane < 4) {
                const int sel_e = lane == 0 ? idxs[0] : lane == 1 ? idxs[1] : lane == 2 ? idxs[2] : idxs[3];
                const float sel_v = (lane == 0 ? 1.0f : lane == 1 ? e1 : lane == 2 ? e2 : e3) * inv;
                const unsigned pos = atomicAdd(cnt + 64 * sel_e, 1u);
                list[sel_e * T + pos] = tok * 4 + lane; tokw[tok * 4 + lane] = sel_v;
            }
        }
    }
}
#undef P6_RS_STEP

__device__ __forceinline__ void moe_build_tb(const Ctx& C) {
    LAS int* tb = (LAS int*)(C.lds + LDS_TB);
    __syncthreads();
    if (C.tid == 0) { const unsigned* cnt = (const unsigned*)(C.ws + WS_CTL) + CW_CNT; int acc = 0;
        for (int e = 0; e < NE; ++e) { const int n = (int)__hip_atomic_load(cnt + 64 * e, __ATOMIC_RELAXED, __HIP_MEMORY_SCOPE_AGENT); tb[e] = acc; tb[40 + e] = n; acc += (n + 255) >> 8; }
        tb[32] = acc; }
    __syncthreads();
}
__device__ __forceinline__ void phase7(const Ctx& C) {
    unsigned char* ws = C.ws;
    moe_build_tb(C);
    const LAS int* tb = (const LAS int*)(C.lds + LDS_TB);
    const bf16* x1b = (const bf16*)(ws + (size_t)X1B_T0 * MiB); bf16* abuf = (bf16*)(ws + (size_t)ABUF_T0 * MiB);
    const int* list = (const int*)(ws + WS_LIST); const float* tokw = (const float*)(ws + WS_TOKW);
    int* rowslot = (int*)(ws + WS_ROWSLOT); float* roww = (float*)(ws + WS_ROWW);
    const int total_rows = tb[32] * 256;
    for (int row = C.gw; row < total_rows; row += C.NGW) {
        int e = 0; const int rt = row >> 8;
        while (e < NE - 1 && tb[e + 1] <= rt) ++e;
        const int i = row - tb[e] * 256; const int n = tb[40 + e];
        v4u* dst = (v4u*)(abuf + (size_t)row * D);
        if (i < n) { const int slot = list[e * T + i]; const v4u* src = (const v4u*)(x1b + (size_t)(slot >> 2) * D);
#pragma unroll
            for (int j = 0; j < 4; ++j) dst[C.lane + 64 * j] = src[C.lane + 64 * j];
            if (C.lane == 0) { rowslot[row] = slot; roww[row] = tokw[slot]; } }
        else {
#pragma unroll
            for (int j = 0; j < 4; ++j) dst[C.lane + 64 * j] = (v4u){0u, 0u, 0u, 0u};
            if (C.lane == 0) { rowslot[row] = -1; roww[row] = 0.f; } }
    }
}
struct MoeOrder {
    const LAS int* tb; int NJ, a0, w0, G, c; const int* list; int gather;
    __device__ __forceinline__ int a_row(const pg8::Unit& u, int r) const { if (!gather) return (u.pm - a0) * 256 + r; const int e = (u.pn - w0) / NJ; const int i = (u.pm - a0 - tb[e]) * 256 + r; return i < tb[40 + e] ? (list[e * T + i] >> 2) : 0; }
    __device__ __forceinline__ int b_tile(const pg8::Unit& u) const { return u.pn - w0; }
    __device__ __forceinline__ bool next(int i, pg8::Unit& u) const {
        const int nwg = tb[32] * NJ; const int L = i * G + c; if (L >= nwg) return false;
        int w; { const int q = nwg / 8, r = nwg % 8, xcd = L % 8, off = L / 8; w = (xcd < r ? xcd * (q + 1) : r * (q + 1) + (xcd - r) * q) + off; }
        int e = 0;
        while (e < NE - 1 && tb[e + 1] * NJ <= w) ++e;
        const int local = w - tb[e] * NJ, nt = tb[e + 1] - tb[e], j = local / nt, ti = local - j * nt;
        u.pm = __builtin_amdgcn_readfirstlane(a0 + tb[e] + ti); u.pn = __builtin_amdgcn_readfirstlane(w0 + e * NJ + j); return true;
    }
    __device__ __forceinline__ void a_ready(const pg8::Unit&) const {}
    __device__ __forceinline__ void done(const pg8::Unit&) const {}
};
struct EpiGU {
    static constexpr bool PERM = true, AFTER_DRAIN = false;
    const float* b_gu; bf16* act; float wsc;
    __device__ __forceinline__ void operator()(const pg8::f32x4 (&acc)[2][2][4][2], const pg8::Unit& u, int wr, int wc, int fr_, int fq_) const {
        int ln_ = threadIdx.x & 63; asm volatile("" : "+v"(ln_));
        const int fr = ln_ & 15, fq = ln_ >> 4;
        using pg8::cvt_pk_bf16;
        const int rt = u.pm - ABUF_T0, rel = u.pn - WGU_T0, e = rel >> 4, j = rel & 15;
        const int col0 = j * 128 + wc * 32 + 8 * fq;
        pg8::f32x4 bg[2], bu[2];
#pragma unroll
        for (int n = 0; n < 2; ++n) { bg[n] = *(const pg8::f32x4*)(b_gu + (size_t)e * 4096 + col0 + 4 * n); bu[n] = *(const pg8::f32x4*)(b_gu + (size_t)e * 4096 + 2048 + col0 + 4 * n); }
#pragma unroll
        for (int ai = 0; ai < 2; ++ai)
#pragma unroll
            for (int m = 0; m < 4; ++m) { const int row = rt * 256 + ai * 128 + wr * 64 + m * 16 + fr;
                float o[8];
#pragma unroll
                for (int n = 0; n < 2; ++n) { const pg8::f32x4 g = acc[ai][0][m][n] * wsc + bg[n], up = acc[ai][1][m][n] * wsc + bu[n];
#pragma unroll
                    for (int i = 0; i < 4; ++i) { const float gc = fminf(g[i], 7.0f), uc = fminf(fmaxf(up[i], -7.0f), 7.0f);
                        o[4 * n + i] = (uc + 1.0f) * (gc / (1.0f + __expf(-1.702f * gc))); } }
                v4u w; w.x = cvt_pk_bf16(o[0], o[1]); w.y = cvt_pk_bf16(o[2], o[3]); w.z = cvt_pk_bf16(o[4], o[5]); w.w = cvt_pk_bf16(o[6], o[7]);
                *(v4u*)(act + (size_t)row * DFF + col0) = w; }
    }
};
struct EpiNone {
    static constexpr bool PERM = true, AFTER_DRAIN = false; float* sink;
    __device__ __forceinline__ void operator()(const pg8::f32x4 (&acc)[2][2][4][2], const pg8::Unit& u, int wr, int wc, int fr, int fq) const {
        pg8::f32x4 t = acc[0][0][0][0];
#pragma unroll
        for (int ai = 0; ai < 2; ++ai)
#pragma unroll
            for (int bj = 0; bj < 2; ++bj)
#pragma unroll
                for (int m = 0; m < 4; ++m)
#pragma unroll
                    for (int n = 0; n < 2; ++n) t = t + acc[ai][bj][m][n];
        if (t[0] == 123.456f) sink[threadIdx.x] = t[1] + t[2] + t[3];
    }
};
struct EpiDown {
    static constexpr bool PERM = true, AFTER_DRAIN = false;
    const float* b_down; const int* list; const float* tokw; const LAS int* tb; bf16* ybuf; float wsc;
    __device__ __forceinline__ void operator()(const pg8::f32x4 (&acc)[2][2][4][2], const pg8::Unit& u, int wr, int wc, int fr_, int fq_) const {
        using pg8::cvt_pk_bf16;
        int ln_ = threadIdx.x & 63; asm volatile("" : "+v"(ln_));
        const int fr = ln_ & 15, fq = ln_ >> 4;
        const int rel = u.pn - WDN_T0, e = rel >> 3, j = rel & 7, ti = u.pm - ACT_T0 - tb[e], n_e = tb[40 + e];
        const int col0 = j * 256 + wc * 32 + 8 * fq;
        pg8::f32x4 bv[2][2];
#pragma unroll
        for (int bj = 0; bj < 2; ++bj)
#pragma unroll
            for (int n = 0; n < 2; ++n) bv[bj][n] = *(const pg8::f32x4*)(b_down + (size_t)e * D + col0 + bj * 128 + 4 * n);
#pragma unroll
        for (int ai = 0; ai < 2; ++ai)
#pragma unroll
            for (int m = 0; m < 4; ++m) { const int i = ti * 256 + ai * 128 + wr * 64 + m * 16 + fr;
                if (i < n_e) { const int slot = list[e * T + i]; const float w = tokw[slot]; bf16* dst = ybuf + (size_t)slot * D + col0;
#pragma unroll
                    for (int bj = 0; bj < 2; ++bj) { const pg8::f32x4 v0 = (acc[ai][bj][m][0] * wsc + bv[bj][0]) * w, v1 = (acc[ai][bj][m][1] * wsc + bv[bj][1]) * w;
                        v4u o; o.x = cvt_pk_bf16(v0[0], v0[1]); o.y = cvt_pk_bf16(v0[2], v0[3]); o.z = cvt_pk_bf16(v1[0], v1[1]); o.w = cvt_pk_bf16(v1[2], v1[3]);
                        *(v4u*)(dst + bj * 128) = o; } } }
    }
};

namespace pg8 {
template <class Epi, class Sched, class Side>
__device__ __forceinline__ void gemm_phase_ga(PG8_LAS unsigned char* lds, const bf16_t* Arows, const bf16_t* Btiles, const int K, const Sched& S, const Epi& E, const Side& SD) {
    const int tid = threadIdx.x, wid = __builtin_amdgcn_readfirstlane(tid >> 6), lane = tid & 63, wr = wid >> 2, wc = wid & 3, fr = lane & 15, fq = lane >> 4;
    const int nt = K / BK;
    unsigned voffB[2];
#pragma unroll
    for (int i = 0; i < 2; ++i) { int R, Cc; stage_rc(tid * 16 + i * 8192, R, Cc); const int Rb = Epi::PERM ? ((R & ~31) + perm32(R & 31)) : R; voffB[i] = (unsigned)(Rb * K + Cc) * 2u; }
    const size_t kstep = (size_t)(BK * 2), hstep = (size_t)HALF * K * 2, tstep = 2 * hstep;
    const unsigned ldsw = (unsigned)wid * 1024u;
    const int aoff = lds_byte(wr * 64 + fr, fq * 8), boff = lds_byte(wc * 32 + fr, fq * 8);
#define PG8_SA(b, h) (((b) * 2 + (h)) * HTB)
#define PG8_SB(b, h) ((4 + (b) * 2 + (h)) * HTB)
#define PG8_STAGE(bufoff, gbase, voff) do { _Pragma("unroll") for (int _i = 0; _i < 2; ++_i) \
        __builtin_amdgcn_global_load_lds((const unsigned*)((const char*)(gbase) + (voff)[_i]), (PG8_LAS unsigned*)(lds + (bufoff) + ldsw + _i * 8192), 16, 0, 0); } while (0)
#define PG8_STAGE2(bufoff, gbase, v0, v1) do { \
        __builtin_amdgcn_global_load_lds((const unsigned*)((const char*)(gbase) + (v0)), (PG8_LAS unsigned*)(lds + (bufoff) + ldsw), 16, 0, 0); \
        __builtin_amdgcn_global_load_lds((const unsigned*)((const char*)(gbase) + (v1)), (PG8_LAS unsigned*)(lds + (bufoff) + ldsw + 8192), 16, 0, 0); } while (0)
#define PG8_LDA(dst, b, h) do { _Pragma("unroll") for (int m = 0; m < 4; ++m) _Pragma("unroll") for (int k = 0; k < 2; ++k) dst[m][k] = *(const PG8_LAS bf16x8*)(lds + PG8_SA(b, h) + aoff + m * 2048 + k * 1024); } while (0)
#define PG8_LDB(dst, b, h) do { _Pragma("unroll") for (int n = 0; n < 2; ++n) _Pragma("unroll") for (int k = 0; k < 2; ++k) dst[n][k] = *(const PG8_LAS bf16x8*)(lds + PG8_SB(b, h) + boff + n * 2048 + k * 1024); } while (0)
#define PG8_MMA(ai, bj, At, Bt) do { __builtin_amdgcn_s_setprio(1); _Pragma("unroll") for (int m = 0; m < 4; ++m) _Pragma("unroll") for (int n = 0; n < 2; ++n) _Pragma("unroll") for (int k = 0; k < 2; ++k) \
        acc[ai][bj][m][n] = __builtin_amdgcn_mfma_f32_16x16x32_bf16(Bt[n][k], At[m][k], acc[ai][bj][m][n], 0, 0, 0); __builtin_amdgcn_s_setprio(0); } while (0)
#define PG8_WAIT_V(n) asm volatile("s_waitcnt vmcnt(" #n ")" ::: "memory")
#define PG8_WAIT_L(n) asm volatile("s_waitcnt lgkmcnt(" #n ")" ::: "memory")
#define PG8_BAR __builtin_amdgcn_s_barrier()
#define PG8_SCHED __builtin_amdgcn_sched_barrier(0)
#define PG8_AROWS(vo, u) do { int t_ = threadIdx.x; asm volatile("" : "+v"(t_)); _Pragma("unroll") for (int _i = 0; _i < 2; ++_i) { int R_, C_; stage_rc(t_ * 16 + _i * 8192, R_, C_); \
        _Pragma("unroll") for (int _h = 0; _h < 2; ++_h) vo[_h * 2 + _i] = (unsigned)S.a_row(u, _h * 128 + R_) * (unsigned)(K * 2) + (unsigned)(C_ * 2); } } while (0)
    const int skh = wid >> 2, snq = wid & 3, sko = lane & 7, sng = lane >> 3;
    const unsigned sgv = Side::ON ? (unsigned)((4 * sko) * SD.ldb + 4 * sng) * 4u : 0u, sdv = (unsigned)(4 * sng) * 4096u + 8u * (unsigned)sko;
    const size_t sldb4 = Side::ON ? (size_t)SD.ldb * 4 : 0;
    int sstep = Side::ON ? SD.first : 0, sprev = 0, sit = 0, sext = 0, sage = 0; bool spend = false;
    f32x4 sx[4];
    typedef unsigned u32x2s __attribute__((ext_vector_type(2)));
#define PG8_SIDE_LOAD() do { const char* sp_ = (const char*)SD.src(sstep, skh, snq); _Pragma("unroll") for (int _j = 0; _j < 4; ++_j) \
        asm volatile("global_load_dwordx4 %0, %1, %2" : "=v"(sx[_j]) : "v"(sgv), "s"(sp_ + (size_t)_j * sldb4) : "memory"); sprev = sstep; sstep += SD.stride; } while (0)
#define PG8_SIDE_STORE() do { asm volatile("" : "+v"(sx[0]), "+v"(sx[1]), "+v"(sx[2]), "+v"(sx[3])); \
        char* dp_ = (char*)SD.dst(sprev, skh, snq); _Pragma("unroll") for (int _i = 0; _i < 4; ++_i) { u32x2s _w; \
            _w.x = cvt_pk_bf16(sx[0][_i], sx[1][_i]); _w.y = cvt_pk_bf16(sx[2][_i], sx[3][_i]); \
            asm volatile("global_store_dwordx2 %0, %1, %2" :: "v"(sdv), "v"(_w), "s"(dp_ + (size_t)_i * 4096) : "memory"); } } while (0)
#define PG8_SIDE_SLOT() do { if constexpr (Side::ON) { int ext_ = 0; if (spend) { if (++sage == Side::LAG) { if (Side::LAG == 1) PG8_WAIT_V(8); PG8_SIDE_STORE(); spend = false; ext_ += 4; } } \
        if (!spend && (sit % Side::PERIOD == 0) && (sstep < SD.nsteps)) { PG8_SIDE_LOAD(); spend = true; sage = 0; ext_ += 4; } ++sit; sext = ext_; } } while (0)
#define PG8_WAIT_K() do { if constexpr (Side::ON) { if (sext == 0) PG8_WAIT_V(8); else if (sext == 4) PG8_WAIT_V(12); else PG8_WAIT_V(16); } else PG8_WAIT_V(8); } while (0)
    Unit cur, nxt; int ui = 0;
    if (!S.next(0, cur)) {
        if constexpr (Side::ON) { while (sstep < SD.nsteps) { PG8_SIDE_LOAD(); PG8_WAIT_V(0); PG8_SIDE_STORE(); } PG8_WAIT_V(0); }
        return;
    }
    f32x4 acc[2][2][4][2];
#pragma unroll
    for (int a = 0; a < 2; ++a)
#pragma unroll
        for (int b = 0; b < 2; ++b)
#pragma unroll
            for (int m = 0; m < 4; ++m)
#pragma unroll
                for (int n = 0; n < 2; ++n) acc[a][b][m][n] = (f32x4){0.f, 0.f, 0.f, 0.f};
    bf16x8 At[4][2], B0[2][2], B1[2][2];
    unsigned voC[4], voN[4];
    PG8_AROWS(voC, cur);
    const char* cA = (const char*)Arows; const char* cB = (const char*)Btiles + (size_t)cur.pn * tstep;
    PG8_STAGE(PG8_SB(0, 0), cB, voffB); PG8_STAGE(PG8_SB(0, 1), cB + hstep, voffB); PG8_STAGE2(PG8_SA(0, 0), cA, voC[0], voC[1]); PG8_STAGE2(PG8_SA(0, 1), cA, voC[2], voC[3]);
    if (wr == 1) PG8_BAR;
    PG8_WAIT_V(2); PG8_BAR;
    PG8_STAGE(PG8_SB(1, 0), cB + kstep, voffB); PG8_STAGE2(PG8_SA(1, 0), cA + kstep, voC[0], voC[1]); PG8_STAGE(PG8_SB(1, 1), cB + hstep + kstep, voffB);
    PG8_WAIT_V(6); PG8_BAR;
    for (;;) {
        const bool has_next = S.next(ui + 1, nxt);
        if (has_next) { PG8_AROWS(voN, nxt); } else {
#pragma unroll
            for (int q = 0; q < 4; ++q) voN[q] = voC[q]; }
        const char* nB = has_next ? (const char*)Btiles + (size_t)nxt.pn * tstep : cB;
        for (int t = 0; t < nt; t += 2) {
            const bool last = (t == nt - 2);
            const char* a1 = cA + (size_t)(t + 1) * kstep;
            const char* a2 = last ? cA : cA + (size_t)(t + 2) * kstep; const char* b2 = last ? nB : cB + (size_t)(t + 2) * kstep;
            const char* a3 = a2 + kstep; const char* b3 = b2 + kstep;
            const unsigned x0 = last ? voN[0] : voC[0], x1 = last ? voN[1] : voC[1], x2 = last ? voN[2] : voC[2], x3 = last ? voN[3] : voC[3];
            PG8_LDB(B0, 0, 0); PG8_LDB(B1, 0, 1); PG8_SCHED; PG8_LDA(At, 0, 0); PG8_STAGE2(PG8_SA(1, 1), a1, voC[2], voC[3]);
            PG8_WAIT_K(); PG8_WAIT_L(0); PG8_BAR; PG8_MMA(0, 0, At, B0); PG8_MMA(0, 1, At, B1); PG8_BAR; PG8_SCHED;
            PG8_LDA(At, 0, 1); PG8_STAGE(PG8_SB(0, 0), b2, voffB); PG8_STAGE(PG8_SB(0, 1), b2 + hstep, voffB); PG8_STAGE2(PG8_SA(0, 0), a2, x0, x1);
            PG8_WAIT_K(); PG8_SIDE_SLOT(); PG8_WAIT_L(0); PG8_BAR; PG8_MMA(1, 0, At, B0); PG8_MMA(1, 1, At, B1); PG8_BAR; PG8_SCHED;
            PG8_LDB(B0, 1, 0); PG8_LDB(B1, 1, 1); PG8_SCHED; PG8_LDA(At, 1, 0); PG8_STAGE2(PG8_SA(0, 1), a2, x2, x3);
            PG8_WAIT_K(); PG8_WAIT_L(0); PG8_BAR; PG8_MMA(0, 0, At, B0); PG8_MMA(0, 1, At, B1); PG8_BAR; PG8_SCHED;
            PG8_LDA(At, 1, 1); PG8_STAGE(PG8_SB(1, 0), b3, voffB); PG8_STAGE(PG8_SB(1, 1), b3 + hstep, voffB); PG8_STAGE2(PG8_SA(1, 0), a3, x0, x1);
            PG8_WAIT_K(); PG8_SIDE_SLOT(); PG8_WAIT_L(0); PG8_BAR; PG8_MMA(1, 0, At, B0); PG8_MMA(1, 1, At, B1); PG8_BAR; PG8_SCHED;
        }
        if (wr == 0) PG8_BAR;
        E(acc, cur, wr, wc, fr, fq); S.done(cur);
        if (!has_next) break;
#pragma unroll
        for (int a = 0; a < 2; ++a)
#pragma unroll
            for (int b = 0; b < 2; ++b)
#pragma unroll
                for (int m = 0; m < 4; ++m)
#pragma unroll
                    for (int n = 0; n < 2; ++n) acc[a][b][m][n] = (f32x4){0.f, 0.f, 0.f, 0.f};
        cur = nxt; cB = nB; ++ui;
#pragma unroll
        for (int q = 0; q < 4; ++q) voC[q] = voN[q];
        if (wr == 1) PG8_BAR;
    }
    PG8_WAIT_V(0);
    PG8_BAR;
    if constexpr (Side::ON) { if (spend) { PG8_SIDE_STORE(); } while (sstep < SD.nsteps) { PG8_SIDE_LOAD(); PG8_WAIT_V(0); PG8_SIDE_STORE(); } PG8_WAIT_V(0); }
#undef PG8_SA
#undef PG8_SB
#undef PG8_STAGE
#undef PG8_STAGE2
#undef PG8_LDA
#undef PG8_LDB
#undef PG8_MMA
#undef PG8_WAIT_V
#undef PG8_WAIT_L
#undef PG8_BAR
#undef PG8_SCHED
#undef PG8_AROWS
#undef PG8_SIDE_LOAD
#undef PG8_SIDE_STORE
#undef PG8_SIDE_SLOT
#undef PG8_WAIT_K
}
}

namespace pg8 {
__device__ __forceinline__ bf16x8 widen_fp8x8(const unsigned lo, const unsigned hi) {
    typedef float f2 __attribute__((ext_vector_type(2))); typedef __bf16 b2 __attribute__((ext_vector_type(2)));
    const f2 a = __builtin_amdgcn_cvt_pk_f32_fp8((int)lo, false), b = __builtin_amdgcn_cvt_pk_f32_fp8((int)lo, true), c = __builtin_amdgcn_cvt_pk_f32_fp8((int)hi, false), d = __builtin_amdgcn_cvt_pk_f32_fp8((int)hi, true);
    u32x4 w; w.x = __builtin_bit_cast(unsigned, __builtin_convertvector(a, b2)); w.y = __builtin_bit_cast(unsigned, __builtin_convertvector(b, b2));
    w.z = __builtin_bit_cast(unsigned, __builtin_convertvector(c, b2)); w.w = __builtin_bit_cast(unsigned, __builtin_convertvector(d, b2));
    return __builtin_bit_cast(bf16x8, w);
}
template <class Epi, class Sched>
__device__ __forceinline__ void gemm_phase_b8(PG8_LAS unsigned char* lds, const bf16_t* Arows, const unsigned char* B8, const int K, const Sched& S, const Epi& E) {
    const int tid = threadIdx.x, wid = __builtin_amdgcn_readfirstlane(tid >> 6), lane = tid & 63, wr = wid >> 2, wc = wid & 3, fr = lane & 15, fq = lane >> 4;
    const int nt = K / BK;
    int sR[2], sC[2];
#pragma unroll
    for (int i = 0; i < 2; ++i) { int R, Cc; stage_rc(tid * 16 + i * 8192, R, Cc); sR[i] = R; sC[i] = Cc; }
    unsigned voffB;
    { const int bpos = tid * 16, R8 = bpos >> 6, pp = (bpos >> 4) & 3, psrc = pp ^ ((R8 >> 2) & 3); const int Rb = Epi::PERM ? ((R8 & ~31) + perm32(R8 & 31)) : R8; voffB = (unsigned)(Rb * K + psrc * 16); }
    const size_t kstepA = (size_t)(BK * 2), kstepB = (size_t)BK, hstepB = (size_t)HALF * K, tstepB = 2 * hstepB;
    const unsigned ldsw = (unsigned)wid * 1024u;
    const int aoff = lds_byte(wr * 64 + fr, fq * 8);
    const int xr = fr >> 2, pc0 = (fq >> 1) ^ xr;
    const int boff0 = (wc * 32 + fr) * 64 + (pc0 << 4) + 8 * (fq & 1), boff1 = (wc * 32 + fr) * 64 + ((pc0 ^ 2) << 4) + 8 * (fq & 1);
#define PG8_SA(b, h) (((b) * 2 + (h)) * HTB)
#define PG8_SB(b, h) (4 * HTB + ((b) * 2 + (h)) * 8192)
#define PG8_STAGEB(bufoff, gbase) __builtin_amdgcn_global_load_lds((const unsigned*)((const char*)(gbase) + voffB), (PG8_LAS unsigned*)(lds + (bufoff) + ldsw), 16, 0, 0)
#define PG8_STAGE2(bufoff, gbase, v0, v1) do { \
        __builtin_amdgcn_global_load_lds((const unsigned*)((const char*)(gbase) + (v0)), (PG8_LAS unsigned*)(lds + (bufoff) + ldsw), 16, 0, 0); \
        __builtin_amdgcn_global_load_lds((const unsigned*)((const char*)(gbase) + (v1)), (PG8_LAS unsigned*)(lds + (bufoff) + ldsw + 8192), 16, 0, 0); } while (0)
#define PG8_LDA(dst, b, h) do { _Pragma("unroll") for (int m = 0; m < 4; ++m) _Pragma("unroll") for (int k = 0; k < 2; ++k) dst[m][k] = *(const PG8_LAS bf16x8*)(lds + PG8_SA(b, h) + aoff + m * 2048 + k * 1024); } while (0)
#define PG8_LDB8(raw, b, h) do { _Pragma("unroll") for (int n = 0; n < 2; ++n) { raw[n][0] = *(const PG8_LAS u32x2*)(lds + PG8_SB(b, h) + boff0 + n * 1024); raw[n][1] = *(const PG8_LAS u32x2*)(lds + PG8_SB(b, h) + boff1 + n * 1024); } } while (0)
#define PG8_WIDEN(dst, raw) do { _Pragma("unroll") for (int n = 0; n < 2; ++n) _Pragma("unroll") for (int k = 0; k < 2; ++k) dst[n][k] = widen_fp8x8(raw[n][k].x, raw[n][k].y); } while (0)
#define PG8_MMA(ai, bj, At, Bt) do { __builtin_amdgcn_s_setprio(1); _Pragma("unroll") for (int m = 0; m < 4; ++m) _Pragma("unroll") for (int n = 0; n < 2; ++n) _Pragma("unroll") for (int k = 0; k < 2; ++k) \
        acc[ai][bj][m][n] = __builtin_amdgcn_mfma_f32_16x16x32_bf16(Bt[n][k], At[m][k], acc[ai][bj][m][n], 0, 0, 0); __builtin_amdgcn_s_setprio(0); } while (0)
#define PG8_WAIT_V(n) asm volatile("s_waitcnt vmcnt(" #n ")" ::: "memory")
#define PG8_WAIT_L(n) asm volatile("s_waitcnt lgkmcnt(" #n ")" ::: "memory")
#define PG8_BAR __builtin_amdgcn_s_barrier()
#define PG8_SCHED __builtin_amdgcn_sched_barrier(0)
#define PG8_AROWS(vo, u) do { _Pragma("unroll") for (int _h = 0; _h < 2; ++_h) _Pragma("unroll") for (int _i = 0; _i < 2; ++_i) vo[_h * 2 + _i] = (unsigned)S.a_row(u, _h * 128 + sR[_i]) * (unsigned)(K * 2) + (unsigned)(sC[_i] * 2); } while (0)
    typedef unsigned u32x2 __attribute__((ext_vector_type(2)));
    Unit cur, nxt; int ui = 0;
    if (!S.next(0, cur)) return;
    f32x4 acc[2][2][4][2];
#pragma unroll
    for (int a = 0; a < 2; ++a)
#pragma unroll
        for (int b = 0; b < 2; ++b)
#pragma unroll
            for (int m = 0; m < 4; ++m)
#pragma unroll
                for (int n = 0; n < 2; ++n) acc[a][b][m][n] = (f32x4){0.f, 0.f, 0.f, 0.f};
    bf16x8 At[4][2], B0[2][2], B1[2][2]; u32x2 r0[2][2], r1[2][2];
    unsigned voC[4], voN[4];
    PG8_AROWS(voC, cur);
    const char* cA = (const char*)Arows; const char* cB = (const char*)B8 + (size_t)S.b_tile(cur) * tstepB;
    PG8_STAGEB(PG8_SB(0, 0), cB); PG8_STAGEB(PG8_SB(0, 1), cB + hstepB); PG8_STAGE2(PG8_SA(0, 0), cA, voC[0], voC[1]); PG8_STAGE2(PG8_SA(0, 1), cA, voC[2], voC[3]);
    if (wr == 1) PG8_BAR;
    PG8_WAIT_V(2); PG8_BAR;
    PG8_STAGEB(PG8_SB(1, 0), cB + kstepB); PG8_STAGE2(PG8_SA(1, 0), cA + kstepA, voC[0], voC[1]); PG8_STAGEB(PG8_SB(1, 1), cB + hstepB + kstepB);
    PG8_WAIT_V(4); PG8_BAR;
    for (;;) {
        const bool has_next = S.next(ui + 1, nxt);
        if (has_next) { PG8_AROWS(voN, nxt); } else {
#pragma unroll
            for (int q = 0; q < 4; ++q) voN[q] = voC[q]; }
        const char* nB = has_next ? (const char*)B8 + (size_t)S.b_tile(nxt) * tstepB : cB;
        for (int t = 0; t < nt; t += 2) {
            const bool last = (t == nt - 2);
            const char* a1 = cA + (size_t)(t + 1) * kstepA;
            const char* a2 = last ? cA : cA + (size_t)(t + 2) * kstepA; const char* b2 = last ? nB : cB + (size_t)(t + 2) * kstepB;
            const char* a3 = a2 + kstepA; const char* b3 = b2 + kstepB;
            const unsigned x0 = last ? voN[0] : voC[0], x1 = last ? voN[1] : voC[1], x2 = last ? voN[2] : voC[2], x3 = last ? voN[3] : voC[3];
            PG8_LDB8(r0, 0, 0); PG8_LDB8(r1, 0, 1); PG8_SCHED; PG8_LDA(At, 0, 0); PG8_STAGE2(PG8_SA(1, 1), a1, voC[2], voC[3]);
            PG8_WAIT_V(6); PG8_WAIT_L(0); PG8_WIDEN(B0, r0); PG8_WIDEN(B1, r1); PG8_BAR; PG8_MMA(0, 0, At, B0); PG8_MMA(0, 1, At, B1); PG8_BAR; PG8_SCHED;
            PG8_LDA(At, 0, 1); PG8_STAGEB(PG8_SB(0, 0), b2); PG8_STAGEB(PG8_SB(0, 1), b2 + hstepB); PG8_STAGE2(PG8_SA(0, 0), a2, x0, x1);
            PG8_WAIT_V(6); PG8_WAIT_L(0); PG8_BAR; PG8_MMA(1, 0, At, B0); PG8_MMA(1, 1, At, B1); PG8_BAR; PG8_SCHED;
            PG8_LDB8(r0, 1, 0); PG8_LDB8(r1, 1, 1); PG8_SCHED; PG8_LDA(At, 1, 0); PG8_STAGE2(PG8_SA(0, 1), a2, x2, x3);
            PG8_WAIT_V(6); PG8_WAIT_L(0); PG8_WIDEN(B0, r0); PG8_WIDEN(B1, r1); PG8_BAR; PG8_MMA(0, 0, At, B0); PG8_MMA(0, 1, At, B1); PG8_BAR; PG8_SCHED;
            PG8_LDA(At, 1, 1); PG8_STAGEB(PG8_SB(1, 0), b3); PG8_STAGEB(PG8_SB(1, 1), b3 + hstepB); PG8_STAGE2(PG8_SA(1, 0), a3, x0, x1);
            PG8_WAIT_V(6); PG8_WAIT_L(0); PG8_BAR; PG8_MMA(1, 0, At, B0); PG8_MMA(1, 1, At, B1); PG8_BAR; PG8_SCHED;
        }
        if (wr == 0) PG8_BAR;
        E(acc, cur, wr, wc, fr, fq); S.done(cur);
        if (!has_next) break;
#pragma unroll
        for (int a = 0; a < 2; ++a)
#pragma unroll
            for (int b = 0; b < 2; ++b)
#pragma unroll
                for (int m = 0; m < 4; ++m)
#pragma unroll
                    for (int n = 0; n < 2; ++n) acc[a][b][m][n] = (f32x4){0.f, 0.f, 0.f, 0.f};
        cur = nxt; cB = nB; ++ui;
#pragma unroll
        for (int q = 0; q < 4; ++q) voC[q] = voN[q];
        if (wr == 1) PG8_BAR;
    }
    PG8_WAIT_V(0);
    PG8_BAR;
#undef PG8_SA
#undef PG8_SB
#undef PG8_STAGEB
#undef PG8_STAGE2
#undef PG8_LDA
#undef PG8_LDB8
#undef PG8_WIDEN
#undef PG8_MMA
#undef PG8_WAIT_V
#undef PG8_WAIT_L
#undef PG8_BAR
#undef PG8_SCHED
#undef PG8_AROWS
}
}

namespace pg8 {
template <class Epi, class Sched, class BSrc>
__device__ __forceinline__ void gemm_phase_bf32(PG8_LAS unsigned char* lds, const bf16_t* Abase, const int K, const Sched& S, const Epi& E, const BSrc& BS) {
    const int tid = threadIdx.x, wid = __builtin_amdgcn_readfirstlane(tid >> 6), lane = tid & 63, wr = wid >> 2, wc = wid & 3, fr = lane & 15, fq = lane >> 4;
    const int nt = K / BK;
    unsigned voffA[2];
#pragma unroll
    for (int i = 0; i < 2; ++i) { int R, Cc; stage_rc(tid * 16 + i * 8192, R, Cc); voffA[i] = (unsigned)(R * K + Cc) * 2u; }
    const size_t kstep = (size_t)(BK * 2), hstep = (size_t)HALF * K * 2, tstep = 2 * hstep;
    const unsigned ldsw = (unsigned)wid * 1024u;
    const int aoff = lds_byte(wr * 64 + fr, fq * 8), boff = lds_byte(wc * 32 + fr, fq * 8);
    const int kh = wid >> 2, nq = wid & 3, ko = lane & 3, ng = lane >> 2;
    const size_t ldb4 = (size_t)BS.ldb * 4;
    const unsigned gvoff = (unsigned)((8 * ko) * BS.ldb + 4 * ng) * 4u;
    int wslot; { const int r0 = (64 * nq + 4 * ng) & 127; if (Epi::PERM) { const int x = (r0 & 31) >> 2; wslot = (r0 & ~31) + 16 * (x & 1) + 4 * (x >> 1); } else wslot = r0; }
    const unsigned wboff = (unsigned)((nq >> 1) * HTB + lds_byte(wslot, 32 * kh + 8 * ko));
    const bool ngodd = (ng & 1) != 0; const unsigned wbA = wboff + (ngodd ? 64u : 0u), wbB = wboff + (ngodd ? 0u : 64u);
    typedef unsigned u32x2v __attribute__((ext_vector_type(2)));
#define PG8_SA(b, h) (((b) * 2 + (h)) * HTB)
#define PG8_SB(b, h) ((4 + (b) * 2 + (h)) * HTB)
#define PG8_STAGE(bufoff, gbase, voff) do { _Pragma("unroll") for (int _i = 0; _i < 2; ++_i) \
        __builtin_amdgcn_global_load_lds((const unsigned*)((const char*)(gbase) + (voff)[_i]), (PG8_LAS unsigned*)(lds + (bufoff) + ldsw + _i * 8192), 16, 0, 0); } while (0)
#define PG8_LDA(dst, b, h) do { _Pragma("unroll") for (int m = 0; m < 4; ++m) _Pragma("unroll") for (int k = 0; k < 2; ++k) dst[m][k] = *(const PG8_LAS bf16x8*)(lds + PG8_SA(b, h) + aoff + m * 2048 + k * 1024); } while (0)
#define PG8_LDB(dst, b, h) do { _Pragma("unroll") for (int n = 0; n < 2; ++n) _Pragma("unroll") for (int k = 0; k < 2; ++k) dst[n][k] = *(const PG8_LAS bf16x8*)(lds + PG8_SB(b, h) + boff + n * 2048 + k * 1024); } while (0)
#define PG8_MMA(ai, bj, At, Bt) do { __builtin_amdgcn_s_setprio(1); _Pragma("unroll") for (int m = 0; m < 4; ++m) _Pragma("unroll") for (int n = 0; n < 2; ++n) _Pragma("unroll") for (int k = 0; k < 2; ++k) \
        acc[ai][bj][m][n] = __builtin_amdgcn_mfma_f32_16x16x32_bf16(Bt[n][k], At[m][k], acc[ai][bj][m][n], 0, 0, 0); __builtin_amdgcn_s_setprio(0); } while (0)
#define PG8_WAIT_V(n) asm volatile("s_waitcnt vmcnt(" #n ")" ::: "memory")
#define PG8_WAIT_L(n) asm volatile("s_waitcnt lgkmcnt(" #n ")" ::: "memory")
#define PG8_BAR __builtin_amdgcn_s_barrier()
#define PG8_SCHED __builtin_amdgcn_sched_barrier(0)
#define PG8_GLOAD_A(src_) do { const char* src = (src_); _Pragma("unroll") for (int _j = 0; _j < 4; ++_j) asm volatile("global_load_dwordx4 %0, %1, %2" : "=v"(ga[_j]) : "v"(gvoff), "s"(src + (size_t)_j * ldb4) : "memory"); } while (0)
#define PG8_GLOAD_B(src_) do { const char* src = (src_); _Pragma("unroll") for (int _j = 0; _j < 4; ++_j) asm volatile("global_load_dwordx4 %0, %1, %2" : "=v"(gb[_j]) : "v"(gvoff), "s"(src + (size_t)(_j + 4) * ldb4) : "memory"); } while (0)
#define PG8_GWAIT_A(n) asm volatile("s_waitcnt vmcnt(" #n ")" : "+v"(ga[0]), "+v"(ga[1]), "+v"(ga[2]), "+v"(ga[3]) :: "memory")
#define PG8_GWAIT_B(n) asm volatile("s_waitcnt vmcnt(" #n ")" : "+v"(gb[0]), "+v"(gb[1]), "+v"(gb[2]), "+v"(gb[3]) :: "memory")
#define PG8_GWRITE_H(b, gv, hoff) do { _Pragma("unroll") for (int _i = 0; _i < 4; ++_i) { \
        const unsigned _p0 = cvt_pk_bf16(gv[0][_i], gv[1][_i]), _p1 = cvt_pk_bf16(gv[2][_i], gv[3][_i]), _q0 = cvt_pk_bf16(gv[0][_i ^ 1], gv[1][_i ^ 1]), _q1 = cvt_pk_bf16(gv[2][_i ^ 1], gv[3][_i ^ 1]); \
        u32x2v _w; _w.x = ngodd ? _q0 : _p0; _w.y = ngodd ? _q1 : _p1; \
        *(PG8_LAS u32x2v*)(lds + PG8_SB(b, 0) + ((_i & 1) ? wbB : wbA) + 128 * (_i >> 1) + (hoff)) = _w; } } while (0)
    Unit cur, nxt; int ui = 0;
    if (!S.next(0, cur)) return;
    f32x4 acc[2][2][4][2];
#pragma unroll
    for (int a = 0; a < 2; ++a)
#pragma unroll
        for (int b = 0; b < 2; ++b)
#pragma unroll
            for (int m = 0; m < 4; ++m)
#pragma unroll
                for (int n = 0; n < 2; ++n) acc[a][b][m][n] = (f32x4){0.f, 0.f, 0.f, 0.f};
    bf16x8 At[4][2], B0[2][2], B1[2][2];
    f32x4 ga[4], gb[4];
    const char* cA = (const char*)Abase + (size_t)cur.pm * tstep;
    const char* cG = (const char*)(BS.base(cur) + (size_t)(32 * kh) * BS.ldb + BS.col(cur, nq));
    const size_t gstep = 64 * ldb4;
    PG8_GLOAD_A(cG); PG8_GLOAD_B(cG); PG8_STAGE(PG8_SA(0, 0), cA, voffA); PG8_STAGE(PG8_SA(0, 1), cA + hstep, voffA);
    PG8_GWAIT_A(8); PG8_GWRITE_H(0, ga, 0); PG8_GWAIT_B(4); PG8_GWRITE_H(0, gb, 8);
    PG8_WAIT_V(0);
    PG8_GLOAD_A(cG + gstep); PG8_STAGE(PG8_SA(1, 0), cA + kstep, voffA); PG8_GLOAD_B(cG + gstep);
    PG8_WAIT_L(0);
    if (wr == 1) PG8_BAR;
    PG8_BAR; PG8_BAR;
    for (;;) {
        const bool has_next = S.next(ui + 1, nxt);
        const char* nA = has_next ? (const char*)Abase + (size_t)nxt.pm * tstep : cA;
        const char* nG = has_next ? (const char*)(BS.base(nxt) + (size_t)(32 * kh) * BS.ldb + BS.col(nxt, nq)) : cG;
        for (int t = 0; t < nt; t += 2) {
            const bool last = (t == nt - 2);
            const char* a1 = cA + (size_t)(t + 1) * kstep;
            const char* a2 = last ? nA : cA + (size_t)(t + 2) * kstep;
            const char* a3 = a2 + kstep;
            const char* g2 = last ? nG : cG + (size_t)(t + 2) * gstep;
            const char* g3 = g2 + gstep;
            PG8_LDB(B0, 0, 0); PG8_LDB(B1, 0, 1); PG8_SCHED; PG8_LDA(At, 0, 0);
            PG8_GWAIT_A(6); PG8_GWRITE_H(1, ga, 0); PG8_STAGE(PG8_SA(1, 1), a1 + hstep, voffA); PG8_GLOAD_A(g2);
            PG8_WAIT_L(0); PG8_BAR; PG8_MMA(0, 0, At, B0); PG8_MMA(0, 1, At, B1); PG8_BAR; PG8_SCHED;
            PG8_LDA(At, 0, 1);
            PG8_GWAIT_B(6); PG8_GWRITE_H(1, gb, 8); PG8_STAGE(PG8_SA(0, 0), a2, voffA); PG8_GLOAD_B(g2);
            PG8_WAIT_L(0); PG8_BAR; PG8_MMA(1, 0, At, B0); PG8_MMA(1, 1, At, B1); PG8_BAR; PG8_SCHED;
            PG8_LDB(B0, 1, 0); PG8_LDB(B1, 1, 1); PG8_SCHED; PG8_LDA(At, 1, 0);
            PG8_GWAIT_A(6); PG8_GWRITE_H(0, ga, 0); PG8_STAGE(PG8_SA(0, 1), a2 + hstep, voffA); PG8_GLOAD_A(g3);
            PG8_WAIT_L(0); PG8_BAR; PG8_MMA(0, 0, At, B0); PG8_MMA(0, 1, At, B1); PG8_BAR; PG8_SCHED;
            PG8_LDA(At, 1, 1);
            PG8_GWAIT_B(6); PG8_GWRITE_H(0, gb, 8); PG8_STAGE(PG8_SA(1, 0), a3, voffA); PG8_GLOAD_B(g3);
            PG8_WAIT_L(0); PG8_BAR; PG8_MMA(1, 0, At, B0); PG8_MMA(1, 1, At, B1); PG8_BAR; PG8_SCHED;
        }
        if (wr == 0) PG8_BAR;
        E(acc, cur, wr, wc, fr, fq); S.done(cur);
        if (!has_next) break;
#pragma unroll
        for (int a = 0; a < 2; ++a)
#pragma unroll
            for (int b = 0; b < 2; ++b)
#pragma unroll
                for (int m = 0; m < 4; ++m)
#pragma unroll
                    for (int n = 0; n < 2; ++n) acc[a][b][m][n] = (f32x4){0.f, 0.f, 0.f, 0.f};
        cur = nxt; cA = nA; cG = nG; ++ui;
        if (wr == 1) PG8_BAR;
    }
    PG8_GWAIT_A(0); PG8_GWAIT_B(0);
    PG8_BAR;
#undef PG8_SA
#undef PG8_SB
#undef PG8_STAGE
#undef PG8_LDA
#undef PG8_LDB
#undef PG8_MMA
#undef PG8_WAIT_V
#undef PG8_WAIT_L
#undef PG8_BAR
#undef PG8_SCHED
#undef PG8_GLOAD_A
#undef PG8_GLOAD_B
#undef PG8_GWAIT_A
#undef PG8_GWAIT_B
#undef PG8_GWRITE_H
}
}
struct NoSide { static constexpr bool ON = false; static constexpr int PERIOD = 1, LAG = 1; int ldb, first, stride, nsteps;
    __device__ __forceinline__ const float* src(int, int, int) const { return nullptr; } __device__ __forceinline__ bf16* dst(int, int, int) const { return nullptr; } };
template <int PER, int LG> struct SideGU { static constexpr bool ON = true; static constexpr int PERIOD = PER, LAG = LG; const float* w; bf16* wt; int ldb, first, stride, nsteps;
    __device__ __forceinline__ const float* src(int hs, int kh, int nq) const { const int hh = hs & 1, st = hs >> 1, tile = st >> 5, tt = st & 31, e = tile >> 4, j = tile & 15;
        return w + (size_t)e * 2048 * 4096 + (size_t)(64 * tt + 32 * kh) * 4096 + (hh ? 2048 : 0) + 128 * j + 32 * nq; }
    __device__ __forceinline__ bf16* dst(int hs, int kh, int nq) const { const int hh = hs & 1, st = hs >> 1, tile = st >> 5, tt = st & 31; return wt + ((size_t)tile * 256 + 128 * hh + 32 * nq) * 2048 + 64 * tt + 32 * kh; } };
template <int PER, int LG> struct SideDown { static constexpr bool ON = true; static constexpr int PERIOD = PER, LAG = LG; const float* w; bf16* wt; int ldb, first, stride, nsteps;
    __device__ __forceinline__ const float* src(int hs, int kh, int nq) const { const int hh = hs & 1, st = hs >> 1, tile = st >> 5, tt = st & 31, e = tile >> 3, j = tile & 7;
        return w + (size_t)e * 2048 * 2048 + (size_t)(64 * tt + 32 * kh) * 2048 + 256 * j + 128 * hh + 32 * nq; }
    __device__ __forceinline__ bf16* dst(int hs, int kh, int nq) const { const int hh = hs & 1, st = hs >> 1, tile = st >> 5, tt = st & 31; return wt + ((size_t)tile * 256 + 128 * hh + 32 * nq) * 2048 + 64 * tt + 32 * kh; } };
struct BSrcGU {
    const float* w; int ldb;
    __device__ __forceinline__ const float* base(const pg8::Unit& u) const { return w + (size_t)((u.pn - WGU_T0) >> 4) * 2048 * 4096; }
    __device__ __forceinline__ int col(const pg8::Unit& u, int nq) const { const int j = (u.pn - WGU_T0) & 15; return (nq < 2) ? 128 * j + 64 * nq : 2048 + 128 * j + 64 * (nq - 2); }
};
struct BSrcDown {
    const float* w; int ldb;
    __device__ __forceinline__ const float* base(const pg8::Unit& u) const { return w + (size_t)((u.pn - WDN_T0) >> 3) * 2048 * 2048; }
    __device__ __forceinline__ int col(const pg8::Unit& u, int nq) const { return 256 * ((u.pn - WDN_T0) & 7) + 64 * nq; }
};

__device__ __forceinline__ void phase10(const Ctx& C) {
    unsigned char* ws = C.ws;
    const bf16* x1b = (const bf16*)(ws + (size_t)X1B_T0 * MiB); const bf16* ybuf = (const bf16*)(ws + WS_YBUF);
    const float* g2 = C.A.in[26]; const float* b2 = C.A.in[27]; const int lane = C.lane;
    for (int tok = C.gw; tok < T; tok += C.NGW) {
        f32x4 v[8]; float s = 0.f;
#pragma unroll
        for (int j = 0; j < 8; ++j) { const int c0 = (lane + 64 * j) * 4; const v2u xw = *(const v2u*)(x1b + (size_t)tok * D + c0); f32x4 a = (f32x4){bflo(xw.x), bfhi(xw.x), bflo(xw.y), bfhi(xw.y)} * DN_ALPHA;
#pragma unroll
            for (int k = 0; k < 4; ++k) { const v2u yw = *(const v2u*)(ybuf + ((size_t)tok * 4 + k) * D + c0); a = a + (f32x4){bflo(yw.x), bfhi(yw.x), bflo(yw.y), bfhi(yw.y)}; }
            v[j] = a; s += (a.x + a.y) + (a.z + a.w); }
        const float mean = wave_sum(s) * (1.0f / D); float q = 0.f;
#pragma unroll
        for (int j = 0; j < 8; ++j) { v[j] = v[j] - mean; q += (v[j].x * v[j].x + v[j].y * v[j].y) + (v[j].z * v[j].z + v[j].w * v[j].w); }
        const float rstd = 1.0f / sqrtf(wave_sum(q) * (1.0f / D) + LN_EPS);
#pragma unroll
        for (int j = 0; j < 8; ++j) { const int c0 = (lane + 64 * j) * 4; const f32x4 gg = *(const f32x4*)(g2 + c0), bb = *(const f32x4*)(b2 + c0);
            *(f32x4*)(C.out + (size_t)tok * D + c0) = v[j] * rstd * gg + bb; }
    }
}

__global__ void __launch_bounds__(NTHREADS, 2) fwd_kernel(KArgs args) {
    extern __shared__ __attribute__((aligned(16))) unsigned char lds_raw[];
    const int tid_ = threadIdx.x, wave_ = __builtin_amdgcn_readfirstlane(tid_ >> 6), G_ = gridDim.x;
    Ctx C{args, args.out, args.ws, (LAS unsigned char*)lds_raw, tid_, tid_ & 63, wave_, G_, (int)blockIdx.x * NWAVES + wave_, G_ * NWAVES};
    volatile LAS unsigned* MISC = (volatile LAS unsigned*)(C.lds + LDS_MISC);
    if (C.tid < 4) MISC[C.tid] = 0u;
    __syncthreads();
    unsigned* ctl = (unsigned*)(args.ws + WS_CTL);
    XcdBarrier bar; bar.bar = ctl + CW_BAR; bar.x = 0; bar.st = MISC;
    const int lo = args.ph_lo, hi = args.ph_hi;
    if (hi - lo > 1) bar = xcd_barrier_post(ctl + CW_BAR, MISC);
#ifndef PHASE_MASK
#define PHASE_MASK 0x7ff
#endif
#define IN(k) (((PHASE_MASK >> (k)) & 1) && lo <= (k) && (k) < hi)
#define SEAM(k) do { if (IN(k) && IN((k) + 1)) xcd_barrier(bar); } while (0)
    const pg8::Gemm g{(const pg8::bf16_t*)args.ws, (const pg8::bf16_t*)args.ws, 0, 0, 2048};
    PG8_LAS unsigned char* glds = (PG8_LAS unsigned char*)lds_raw;

#ifndef PROBE_DOUBLE
#define PROBE_DOUBLE 0
#endif
#define REP(k) for (int _rep = 0; _rep < (((PROBE_DOUBLE >> (k)) & 1) ? 2 : 1); ++_rep)
    if (IN(0)) { REP(0) phase0(C); } SEAM(0);
    if (IN(1)) {
        Gemm1Order S{C.G, (int)blockIdx.x};
        unsigned char* ws = args.ws;
        Epi1 E{C.A.in[2], (bf16*)(ws + WS_HYT), (bf16*)(ws + WS_QKRAW), (bf16*)(ws + WS_VB), (bf16*)(ws + WS_OB), (float*)(ws + WS_GATES)};
#if MOE_SIDE
        { SideGU<SIDE_GU_PERIOD, SIDE_GU_LAG> SD{C.A.in[22], (bf16*)(ws + (size_t)WGU_T0 * MiB), 4096, (int)blockIdx.x, C.G, SIDE_GU_EXPERTS * 16 * 32 * 2};
          pg8::gemm_phase_ga<Epi1, Gemm1Order, SideGU<SIDE_GU_PERIOD, SIDE_GU_LAG>>(glds, (const pg8::bf16_t*)ws, (const pg8::bf16_t*)ws, 2048, S, E, SD); }
#else
        REP(1) pg8::gemm_phase<Epi1, Gemm1Order, true, true>(glds, g, S, E);
#endif
        { const pg8::Gemm g2{(const pg8::bf16_t*)(ws + WS_W3P), (const pg8::bf16_t*)(ws + WS_H2P), 0, 0, 256}; KtOrder S2{C.G, (int)blockIdx.x}; EpiKT E2{(float*)(ws + WS_KT)};
          pg8::gemm_phase<EpiKT, KtOrder, true, true>(glds, g2, S2, E2); }
    } SEAM(1);
    if (IN(2)) { REP(2) phase2(C); } SEAM(2);
    if (IN(3)) { REP(3) hyena_fft(C); REP(11) { if (NAIVE_ML) mlstm_naive(C); else mlstm_mfma(C); } } SEAM(3);
    if (IN(4)) { REP(4) phase4(C); } SEAM(4);
    if (IN(5)) {
        TileOrder S{32, 8, YCAT_T0, WOUT_T0, C.G, (int)blockIdx.x};
        EpiOut E{C.A.in[0], C.A.in[17], (float*)(args.ws + WS_R1)};
        REP(5) pg8::gemm_phase<EpiOut, TileOrder, true, true>(glds, g, S, E);
    } SEAM(5);
    if (IN(6)) { REP(6) phase6(C, _rep); } if (IN(6) && IN(8)) xcd_barrier(bar);
    if (IN(8)) {
        moe_build_tb(C);
        MoeOrder S{(const LAS int*)(C.lds + LDS_TB), 16, ABUF_T0, WGU_T0, C.G, (int)blockIdx.x, (const int*)(args.ws + WS_LIST), 1};
        EpiGU E{C.A.in[23], (bf16*)(args.ws + (size_t)ACT_T0 * MiB), MOE_FP8W ? 1.0f / MOE_WSCALE : 1.0f};
        BSrcGU BS{C.A.in[22], 4096};
#if MOE_PRECONVERT
#if MOE_FP8W
        REP(8) pg8::gemm_phase_b8<EpiGU, MoeOrder>(glds, (const pg8::bf16_t*)(args.ws + (size_t)X1B_T0 * MiB), args.ws + (size_t)WGU_T0 * MiB, 2048, S, E);
#else
#if MOE_SIDE
        { SideDown<SIDE_DN_PERIOD, SIDE_DN_LAG> SD{C.A.in[24], (bf16*)(args.ws + (size_t)WDN_T0 * MiB), 2048, (int)blockIdx.x, C.G, NE * 8 * 32 * 2};
          pg8::gemm_phase_ga<EpiGU, MoeOrder, SideDown<SIDE_DN_PERIOD, SIDE_DN_LAG>>(glds, (const pg8::bf16_t*)(args.ws + (size_t)X1B_T0 * MiB), (const pg8::bf16_t*)args.ws, 2048, S, E, SD); }
#else
        { NoSide SD{0, 0, 0, 0}; REP(8) pg8::gemm_phase_ga<EpiGU, MoeOrder, NoSide>(glds, (const pg8::bf16_t*)(args.ws + (size_t)X1B_T0 * MiB), (const pg8::bf16_t*)args.ws, 2048, S, E, SD); }
#endif
#endif
#else
        REP(8) pg8::gemm_phase_bf32<EpiGU, MoeOrder, BSrcGU>(glds, (const pg8::bf16_t*)args.ws, 2048, S, E, BS);
#endif
    } SEAM(8);
    if (IN(9)) {
        moe_build_tb(C);
        MoeOrder S{(const LAS int*)(C.lds + LDS_TB), 8, ACT_T0, WDN_T0, C.G, (int)blockIdx.x, (const int*)(args.ws + WS_LIST), 0};
        EpiDown E{C.A.in[25], (const int*)(args.ws + WS_LIST), (const float*)(args.ws + WS_TOKW), (const LAS int*)(C.lds + LDS_TB), (bf16*)(args.ws + WS_YBUF), MOE_FP8W ? 1.0f / MOE_WSCALE : 1.0f};
        BSrcDown BS{C.A.in[24], 2048};
#if MOE_FP8W
        REP(9) pg8::gemm_phase_b8<EpiDown, MoeOrder>(glds, (const pg8::bf16_t*)(args.ws + (size_t)ACT_T0 * MiB), args.ws + (size_t)WDN_T0 * MiB, 2048, S, E);
#elif MOE_PRECONVERT
        REP(9) pg8::gemm_phase<EpiDown, MoeOrder, true, true>(glds, g, S, E);
#else
        REP(9) pg8::gemm_phase_bf32<EpiDown, MoeOrder, BSrcDown>(glds, (const pg8::bf16_t*)args.ws, 2048, S, E, BS);
#endif
    } SEAM(9);
    if (IN(10)) { REP(10) phase10(C); }
#ifdef PROBE_BARRIERS
    if (hi - lo > 1) for (int i_ = 0; i_ < PROBE_BARRIERS; ++i_) xcd_barrier(bar);
#endif
#undef IN
#undef SEAM
}

extern "C" void kernel_launch(void* const* d_in, const int* in_sizes, int n_in, void* d_out, int out_size, void* d_ws, size_t ws_size, hipStream_t stream) {
    static int grid = 0;
    if (grid == 0) {
        if (n_in != 28 || in_sizes[0] != T * D || out_size != T * D || ws_size < WS_END) { fprintf(stderr, "kernel_launch: unexpected shapes (n_in %d, in0 %d, out %d, ws %zu)\n", n_in, n_in > 0 ? in_sizes[0] : -1, out_size, ws_size); grid = -1; return; }
        int dev = 0, cus = 0;
        if (hipGetDevice(&dev) != hipSuccess || hipDeviceGetAttribute(&cus, hipDeviceAttributeMultiprocessorCount, dev) != hipSuccess) { grid = -1; return; }
        if (hipFuncSetAttribute((const void*)fwd_kernel, hipFuncAttributeMaxDynamicSharedMemorySize, LDS_BYTES) != hipSuccess) { fprintf(stderr, "kernel_launch: hipFuncSetAttribute failed\n"); grid = -1; return; }
        int per_cu = 0;
        if (hipOccupancyMaxActiveBlocksPerMultiprocessor(&per_cu, (const void*)fwd_kernel, NTHREADS, LDS_BYTES) != hipSuccess || per_cu < 1) fprintf(stderr, "kernel_launch: occupancy query says %d\n", per_cu);
        (void)hipGetLastError();
        grid = cus;
    }
    if (grid < 0) return;
    if (hipMemsetAsync((char*)d_ws + WS_CTL, 0, CTL_ZERO_BYTES, stream) != hipSuccess) return;
    KArgs a{};
    for (int i = 0; i < 28; ++i) a.in[i] = (const float*)d_in[i];
    a.out = (float*)d_out; a.ws = (unsigned char*)d_ws;
#if MK_ONE_LAUNCH
    a.ph_lo = 0; a.ph_hi = N_PHASES;
    hipLaunchKernelGGL(fwd_kernel, dim3(grid), dim3(NTHREADS), LDS_BYTES, stream, a);
#else
    for (int ph = 0; ph < N_PHASES; ++ph) { a.ph_lo = ph; a.ph_hi = ph + 1; hipLaunchKernelGGL(fwd_kernel, dim3(grid), dim3(NTHREADS), LDS_BYTES, stream, a); }
#endif
}
```

```cpp
#include <hip/hip_runtime.h>
#include <cstdio>
#include <cstdint>
namespace pg8 {
#define PG8_LAS __attribute__((address_space(3)))
typedef unsigned short bf16_t;
typedef short bf16x8 __attribute__((ext_vector_type(8)));
typedef float f32x4 __attribute__((ext_vector_type(4)));
typedef unsigned u32x4 __attribute__((ext_vector_type(4)));
constexpr int BM = 256, BK = 64, HALF = 128, HTB = HALF * BK * 2  , STAGE_BYTES = 8 * HTB, NXCD = 8, WGM = 8;

__host__ __device__ __forceinline__ int lds_byte(int r, int c) { const int st = (r >> 4) * 2 + (c >> 5), rr = r & 15, cc = c & 31, ob = rr * 64 + cc * 2; return st * 1024 + (ob ^ (((ob >> 9) & 1) << 5)); }
__host__ __device__ __forceinline__ void stage_rc(int b, int& R, int& C) { const int st = b / 1024, sb = b % 1024, swz = sb ^ (((sb >> 9) & 1) << 5); R = (st >> 1) * 16 + swz / 64; C = (st & 1) * 32 + (swz % 64) / 2; }
__host__ __device__ __forceinline__ int perm32(int rho) { const int n = rho >> 4, i = rho & 15; return 8 * (i >> 2) + 4 * n + (i & 3); }

struct Unit { int pm, pn; };
struct Gemm { const bf16_t* A; const bf16_t* Bt; int M, N, K; };
__device__ __forceinline__ unsigned cvt_pk_bf16(float lo, float hi) { unsigned r; asm volatile("v_cvt_pk_bf16_f32 %0, %1, %2" : "=v"(r) : "v"(lo), "v"(hi)); return r; }
typedef float f32x2 __attribute__((ext_vector_type(2)));
template <class Epi, class Sched, bool ALIGN_EPI = false, bool SP2 = false>
__device__ __forceinline__ void gemm_phase(PG8_LAS unsigned char* lds, const Gemm g, const Sched& S, const Epi& E) {
    const int tid = threadIdx.x, wid = __builtin_amdgcn_readfirstlane(tid >> 6), lane = tid & 63, wr = wid >> 2, wc = wid & 3, fr = lane & 15, fq = lane >> 4;
    const int K = g.K, nt = K / BK;
    unsigned voffA[2], voffB[2];
#pragma unroll
    for (int i = 0; i < 2; ++i) { int R, C; stage_rc(tid * 16 + i * 8192, R, C); const int Rb = Epi::PERM ? ((R & ~31) + perm32(R & 31)) : R;
        voffA[i] = (unsigned)(R * K + C) * 2u; voffB[i] = (unsigned)(Rb * K + C) * 2u; }
    const size_t kstep = (size_t)(BK * 2);
    const size_t hstep = (size_t)HALF * K * 2;
    const size_t tstep = 2 * hstep;
    const unsigned ldsw = (unsigned)wid * 1024u;
    const int aoff = lds_byte(wr * 64 + fr, fq * 8), boff = lds_byte(wc * 32 + fr, fq * 8);
#define PG8_SA(b, h) (((b) * 2 + (h)) * HTB)
#define PG8_SB(b, h) ((4 + (b) * 2 + (h)) * HTB)
#define PG8_STAGE(bufoff, gbase, voff) do { _Pragma("unroll") for (int _i = 0; _i < 2; ++_i) \
        __builtin_amdgcn_global_load_lds((const unsigned*)((const char*)(gbase) + (voff)[_i]), (PG8_LAS unsigned*)(lds + (bufoff) + ldsw + _i * 8192), 16, 0, 0); } while (0)
#define PG8_LDA(dst, b, h) do { _Pragma("unroll") for (int m = 0; m < 4; ++m) _Pragma("unroll") for (int k = 0; k < 2; ++k) dst[m][k] = *(const PG8_LAS bf16x8*)(lds + PG8_SA(b, h) + aoff + m * 2048 + k * 1024); } while (0)
#define PG8_LDB(dst, b, h) do { _Pragma("unroll") for (int n = 0; n < 2; ++n) _Pragma("unroll") for (int k = 0; k < 2; ++k) dst[n][k] = *(const PG8_LAS bf16x8*)(lds + PG8_SB(b, h) + boff + n * 2048 + k * 1024); } while (0)
#define PG8_MMA(ai, bj, At, Bt) do { __builtin_amdgcn_s_setprio(1); _Pragma("unroll") for (int m = 0; m < 4; ++m) _Pragma("unroll") for (int n = 0; n < 2; ++n) _Pragma("unroll") for (int k = 0; k < 2; ++k) \
        acc[ai][bj][m][n] = __builtin_amdgcn_mfma_f32_16x16x32_bf16(Bt[n][k], At[m][k], acc[ai][bj][m][n], 0, 0, 0); __builtin_amdgcn_s_setprio(0); } while (0)
#define PG8_WAIT_V(n) asm volatile("s_waitcnt vmcnt(" #n ")" ::: "memory")
#define PG8_WAIT_L(n) asm volatile("s_waitcnt lgkmcnt(" #n ")" ::: "memory")
#define PG8_BAR __builtin_amdgcn_s_barrier()
#define PG8_SCHED __builtin_amdgcn_sched_barrier(0)
    Unit cur, nxt; int ui = 0;
    if (!S.next(0, cur)) return;
    f32x4 acc[2][2][4][2];
#pragma unroll
    for (int a = 0; a < 2; ++a)
#pragma unroll
        for (int b = 0; b < 2; ++b)
#pragma unroll
            for (int m = 0; m < 4; ++m)
#pragma unroll
                for (int n = 0; n < 2; ++n) acc[a][b][m][n] = (f32x4){0.f, 0.f, 0.f, 0.f};
    bf16x8 At[4][2], B0[2][2], B1[2][2];
    const char* cA = (const char*)g.A + (size_t)cur.pm * tstep; const char* cB = (const char*)g.Bt + (size_t)cur.pn * tstep;
    S.a_ready(cur);
    if constexpr (SP2) {
        PG8_STAGE(PG8_SB(0, 0), cB, voffB); PG8_STAGE(PG8_SB(0, 1), cB + hstep, voffB); PG8_STAGE(PG8_SA(0, 0), cA, voffA); PG8_STAGE(PG8_SA(0, 1), cA + hstep, voffA);
        if (wr == 1) PG8_BAR;
        PG8_WAIT_V(2); PG8_BAR;
        PG8_STAGE(PG8_SB(1, 0), cB + kstep, voffB); PG8_STAGE(PG8_SA(1, 0), cA + kstep, voffA); PG8_STAGE(PG8_SB(1, 1), cB + hstep + kstep, voffB);
        PG8_WAIT_V(6); PG8_BAR;
    } else {
        PG8_STAGE(PG8_SB(0, 0), cB, voffB); PG8_STAGE(PG8_SA(0, 0), cA, voffA); PG8_STAGE(PG8_SB(0, 1), cB + hstep, voffB); PG8_STAGE(PG8_SA(0, 1), cA + hstep, voffA);
        if (wr == 1) PG8_BAR;
        PG8_WAIT_V(4); PG8_BAR;
        PG8_STAGE(PG8_SB(1, 0), cB + kstep, voffB); PG8_STAGE(PG8_SA(1, 0), cA + kstep, voffA); PG8_STAGE(PG8_SB(1, 1), cB + hstep + kstep, voffB);
        PG8_WAIT_V(6); PG8_BAR;
    }
    for (;;) {
        const bool has_next = S.next(ui + 1, nxt);
        const char* nA = has_next ? (const char*)g.A + (size_t)nxt.pm * tstep : cA; const char* nB = has_next ? (const char*)g.Bt + (size_t)nxt.pn * tstep : cB;
        for (int t = 0; t < nt; t += 2) {
            const bool last = (t == nt - 2);
            const char* a1 = cA + (size_t)(t + 1) * kstep;
            const char* a2 = last ? nA : cA + (size_t)(t + 2) * kstep; const char* b2 = last ? nB : cB + (size_t)(t + 2) * kstep;
            const char* a3 = a2 + kstep; const char* b3 = b2 + kstep;
            if (last && has_next) S.a_ready(nxt);
            if constexpr (SP2) {
            PG8_LDB(B0, 0, 0); PG8_LDB(B1, 0, 1); PG8_SCHED; PG8_LDA(At, 0, 0); PG8_STAGE(PG8_SA(1, 1), a1 + hstep, voffA);
            PG8_WAIT_V(8); PG8_WAIT_L(0); PG8_BAR; PG8_MMA(0, 0, At, B0); PG8_MMA(0, 1, At, B1); PG8_BAR; PG8_SCHED;
            PG8_LDA(At, 0, 1); PG8_STAGE(PG8_SB(0, 0), b2, voffB); PG8_STAGE(PG8_SB(0, 1), b2 + hstep, voffB); PG8_STAGE(PG8_SA(0, 0), a2, voffA);
            PG8_WAIT_V(8); PG8_WAIT_L(0); PG8_BAR; PG8_MMA(1, 0, At, B0); PG8_MMA(1, 1, At, B1); PG8_BAR; PG8_SCHED;
            PG8_LDB(B0, 1, 0); PG8_LDB(B1, 1, 1); PG8_SCHED; PG8_LDA(At, 1, 0); PG8_STAGE(PG8_SA(0, 1), a2 + hstep, voffA);
            PG8_WAIT_V(8); PG8_WAIT_L(0); PG8_BAR; PG8_MMA(0, 0, At, B0); PG8_MMA(0, 1, At, B1); PG8_BAR; PG8_SCHED;
            PG8_LDA(At, 1, 1); PG8_STAGE(PG8_SB(1, 0), b3, voffB); PG8_STAGE(PG8_SB(1, 1), b3 + hstep, voffB); PG8_STAGE(PG8_SA(1, 0), a3, voffA);
            PG8_WAIT_V(8); PG8_WAIT_L(0); PG8_BAR; PG8_MMA(1, 0, At, B0); PG8_MMA(1, 1, At, B1); PG8_BAR; PG8_SCHED;
            } else {
            PG8_LDB(B0, 0, 0); PG8_SCHED; PG8_LDA(At, 0, 0); PG8_STAGE(PG8_SA(1, 1), a1 + hstep, voffA);
            PG8_WAIT_L(8); PG8_BAR; PG8_WAIT_L(0); PG8_MMA(0, 0, At, B0); PG8_BAR; PG8_SCHED;
            PG8_LDB(B1, 0, 1); PG8_STAGE(PG8_SB(0, 0), b2, voffB);
            PG8_BAR; PG8_WAIT_L(0); PG8_MMA(0, 1, At, B1); PG8_BAR;
            PG8_LDA(At, 0, 1); PG8_STAGE(PG8_SA(0, 0), a2, voffA);
            PG8_BAR; PG8_WAIT_L(0); PG8_MMA(1, 0, At, B0); PG8_BAR; PG8_SCHED;
            PG8_STAGE(PG8_SB(0, 1), b2 + hstep, voffB);
            PG8_WAIT_V(6); PG8_BAR; PG8_MMA(1, 1, At, B1); PG8_BAR;
            PG8_LDB(B0, 1, 0); PG8_SCHED; PG8_LDA(At, 1, 0); PG8_STAGE(PG8_SA(0, 1), a2 + hstep, voffA);
            PG8_WAIT_L(8); PG8_BAR; PG8_WAIT_L(0); PG8_MMA(0, 0, At, B0); PG8_BAR; PG8_SCHED;
            PG8_LDB(B1, 1, 1); PG8_STAGE(PG8_SB(1, 0), b3, voffB);
            PG8_BAR; PG8_WAIT_L(0); PG8_MMA(0, 1, At, B1); PG8_BAR;
            PG8_LDA(At, 1, 1); PG8_STAGE(PG8_SA(1, 0), a3, voffA);
            PG8_BAR; PG8_WAIT_L(0); PG8_MMA(1, 0, At, B0); PG8_BAR; PG8_SCHED;
            PG8_STAGE(PG8_SB(1, 1), b3 + hstep, voffB);
            PG8_WAIT_V(6); PG8_BAR; PG8_MMA(1, 1, At, B1); PG8_BAR;
            }
        }
        if constexpr (ALIGN_EPI) { if (wr == 0) PG8_BAR; }
        if constexpr (!Epi::AFTER_DRAIN) { E(acc, cur, wr, wc, fr, fq); S.done(cur); }
        if (!has_next) break;
#pragma unroll
        for (int a = 0; a < 2; ++a)
#pragma unroll
            for (int b = 0; b < 2; ++b)
#pragma unroll
                for (int m = 0; m < 4; ++m)
#pragma unroll
                    for (int n = 0; n < 2; ++n) acc[a][b][m][n] = (f32x4){0.f, 0.f, 0.f, 0.f};
        cur = nxt; cA = nA; cB = nB; ++ui;
        if constexpr (ALIGN_EPI) { if (wr == 1) PG8_BAR; }
    }
    PG8_WAIT_V(0);
    if constexpr (!ALIGN_EPI) { if (wr == 0) PG8_BAR; }
    PG8_BAR;
    if constexpr (Epi::AFTER_DRAIN) { E.fused(acc, cur, wr, wc, fr, fq, lds, wid, lane); S.done(cur); }
#undef PG8_SA
#undef PG8_SB
#undef PG8_STAGE
#undef PG8_LDA
#undef PG8_LDB
#undef PG8_MMA
#undef PG8_WAIT_V
#undef PG8_WAIT_L
#undef PG8_BAR
#undef PG8_SCHED
}
}

constexpr int NB = 4, SEQ = 2048, T = NB * SEQ, D = 2048, DHY = 1024, DML = 1024, DIN = 7200, NE = 32, TOPK = 4, NH = 8, HD = 128, DFF = 2048;
constexpr float LN_EPS = 1e-5f, DN_ALPHA = 1.189207115002721f;
constexpr int NWAVES = 8, NTHREADS = 512;
#ifndef MK_ONE_LAUNCH
#define MK_ONE_LAUNCH 1
#endif
constexpr int N_PHASES = 11;
#ifndef MOE_PRECONVERT
#define MOE_PRECONVERT 1
#endif
#ifndef SIDE_GU_PERIOD
#define SIDE_GU_PERIOD 1
#define SIDE_GU_LAG 1
#endif
#ifndef SIDE_DN_PERIOD
#define SIDE_DN_PERIOD 4
#define SIDE_DN_LAG 2
#endif
#ifndef SIDE_GU_EXPERTS
#define SIDE_GU_EXPERTS 32
#endif
#ifndef MOE_SIDE
#define MOE_SIDE 1
#endif

constexpr size_t MiB = 1u << 20;
constexpr size_t WS_CTL = 0, CTL_ZERO_BYTES = 1 * MiB;
constexpr size_t WS_H2P = 1936 * MiB;
constexpr size_t WS_W3P = 1937 * MiB;
constexpr size_t WS_GATES = 2 * MiB;
constexpr size_t WS_TOKW = 3 * MiB;
constexpr size_t WS_LIST = 4 * MiB;
constexpr size_t WS_ROWSLOT = 5 * MiB;
constexpr size_t WS_ROWW = 5 * MiB + 512 * 1024;
constexpr size_t WS_GA = 6 * MiB, WS_GP = 6 * MiB + 512 * 1024, WS_GE = 7 * MiB;
constexpr size_t TILE_BYTES = 256 * 2048 * 2;
constexpr int XB_T0 = 8, WIN_T0 = 40, WOUT_T0 = 72, YCAT_T0 = 80, X1B_T0 = 112, ABUF_T0 = 144, ACT_T0 = 304, WGU_T0 = 464, WDN_T0 = 976;
constexpr size_t WS_HYT = 1232 * MiB;
constexpr size_t WS_QKRAW = 1296 * MiB;
constexpr size_t WS_OB = 1328 * MiB;
constexpr size_t WS_QKC = 1344 * MiB;
constexpr size_t WS_KT = 1376 * MiB;
constexpr size_t WS_KF = 1840 * MiB;
constexpr size_t WS_ZT = 1904 * MiB;
constexpr size_t WS_Z = 1408 * MiB;
constexpr size_t WS_HML = 1440 * MiB;
constexpr size_t WS_R1 = 1504 * MiB;
constexpr size_t WS_YBUF = 1568 * MiB;
constexpr size_t WS_VB = 1824 * MiB;
constexpr size_t WS_END = 1940 * MiB;
constexpr int CW_BAR = 4096, CW_CNT = 16384;

constexpr int LDS_STAGE = 131072, LDS_MISC = LDS_STAGE, LDS_TB = LDS_STAGE + 64, LDS_UL = LDS_STAGE + 512, LDS_ROWT = LDS_STAGE + 1024, MOE_MAXU = 12, LDS_BYTES = 147456;
static_assert(LDS_ROWT + MOE_MAXU * 256 * 4 <= LDS_BYTES, "LDS map");

#define GAS __attribute__((address_space(1)))
#define LAS __attribute__((address_space(3)))
typedef unsigned short bf16;
typedef unsigned v4u __attribute__((ext_vector_type(4)));
typedef unsigned v2u __attribute__((ext_vector_type(2)));
typedef float f32x4 __attribute__((ext_vector_type(4)));
typedef float f32x2 __attribute__((ext_vector_type(2)));
#define LDS_WAIT() asm volatile("s_waitcnt lgkmcnt(0)" ::: "memory")
__device__ __forceinline__ unsigned f2bf(float f) { unsigned u = __builtin_bit_cast(unsigned, f); return (u + 0x7fffu + ((u >> 16) & 1u)) >> 16; }
__device__ __forceinline__ unsigned pk2(float lo, float hi) { return f2bf(lo) | (f2bf(hi) << 16); }
__device__ __forceinline__ float bflo(unsigned w) { return __builtin_bit_cast(float, w << 16); }
__device__ __forceinline__ float bfhi(unsigned w) { return __builtin_bit_cast(float, w & 0xffff0000u); }
__device__ __forceinline__ float bf2f(bf16 b) { return __builtin_bit_cast(float, (unsigned)b << 16); }
__device__ __forceinline__ float wave_sum(float v) {
#pragma unroll
    for (int o = 1; o < 64; o <<= 1) v += __shfl_xor(v, o);
    return v;
}
__device__ __forceinline__ float wave_max(float v) {
#pragma unroll
    for (int o = 1; o < 64; o <<= 1) v = fmaxf(v, __shfl_xor(v, o));
    return v;
}

#define XB_TMO      128
#define XB_XCNT(j)  (256  + 64 * (j))
#define XB_XSUB(j)  (1280 + 64 * (j))
#define XB_XGEN(j)  (2304 + 64 * (j))
#define XB_TOP      3328
#define XB_TOPGEN   3392
#define XCD_BAR_WORDS 3456
#define XB_SPIN_CAP (1u << 22)

__device__ __forceinline__ unsigned xb_ld(unsigned* p)              { return __hip_atomic_load(p, __ATOMIC_RELAXED, __HIP_MEMORY_SCOPE_AGENT); }
__device__ __forceinline__ unsigned xb_add(unsigned* p, unsigned v) { return __hip_atomic_fetch_add(p, v, __ATOMIC_RELAXED, __HIP_MEMORY_SCOPE_AGENT); }
__device__ __forceinline__ unsigned xb_xcc_id() { return (unsigned)__builtin_amdgcn_s_getreg((3 << 11) | 20) & 0xFu; }
#define XB_SPIN(cond, bar) do { unsigned _sp = 0; while (cond) { __builtin_amdgcn_s_sleep(1); \
    if ((++_sp & 255u) == 0u) { if (xb_ld(&(bar)[XB_TMO])) break; if (_sp > XB_SPIN_CAP) { atomicAdd(&(bar)[XB_TMO], 1u); break; } } } } while (0)

struct XcdBarrier {
    unsigned* bar; unsigned x;
    volatile LAS unsigned* st;
};

__device__ __forceinline__ XcdBarrier xcd_barrier_post(unsigned* bar, volatile LAS unsigned* st) {
    XcdBarrier b; b.bar = bar; b.x = xb_xcc_id(); b.st = st;
    if (threadIdx.x == 0) (void)xb_add(&bar[XB_XCNT(b.x)], 1u);
    return b;
}
__device__ __forceinline__ void xcd_barrier_complete(unsigned* bar, unsigned x, unsigned& nloc, unsigned& nx) {
    const unsigned G = gridDim.x * gridDim.y * gridDim.z;
    unsigned sum, cnt, mine, sp = 0u;
    for (;;) {
        sum = 0u; cnt = 0u; mine = 0u;
#pragma unroll
        for (unsigned j = 0; j < 16; ++j) { const unsigned c = xb_ld(&bar[XB_XCNT(j)]); sum += c; cnt += (c > 0u) ? 1u : 0u; mine = (j == x) ? c : mine; }
        if (sum == G) break;
        __builtin_amdgcn_s_sleep(1);
        if ((++sp & 255u) == 0u) { if (xb_ld(&bar[XB_TMO])) break; if (sp > XB_SPIN_CAP) { atomicAdd(&bar[XB_TMO], 1u); break; } }
    }
    nloc = mine > 0u ? mine : 1u; nx = cnt > 0u ? cnt : 1u;
}

__device__ __forceinline__ void xcd_barrier(const XcdBarrier& b) {
    asm volatile("s_waitcnt vmcnt(0)" ::: "memory");
    __syncthreads();
    if (threadIdx.x == 0) {
        unsigned* bar = b.bar;
        __builtin_amdgcn_s_waitcnt(0);
        unsigned nloc = b.st[0], nx = b.st[1];
        if (nloc == 0u) { xcd_barrier_complete(bar, b.x, nloc, nx); b.st[0] = nloc; b.st[1] = nx; }
        const unsigned old = xb_add(&bar[XB_XSUB(b.x)], 1u);
        const unsigned gen = old / nloc;
        if (old + 1u == (gen + 1u) * nloc) {
            __builtin_amdgcn_fence(__ATOMIC_RELEASE, "agent");
            asm volatile("s_waitcnt vmcnt(0)" ::: "memory");
            const unsigned og = xb_add(&bar[XB_TOP], 1u);
            const unsigned tg = og / nx;
            if (og + 1u == (tg + 1u) * nx) xb_add(&bar[XB_TOPGEN], 1u);
            else XB_SPIN(xb_ld(&bar[XB_TOPGEN]) == tg, bar);
            __builtin_amdgcn_fence(__ATOMIC_ACQUIRE, "agent");
            xb_add(&bar[XB_XGEN(b.x)], 1u);
            asm volatile("s_waitcnt vmcnt(0)" ::: "memory");
        } else {
            XB_SPIN(xb_ld(&bar[XB_XGEN(b.x)]) == gen, bar);
            __builtin_amdgcn_fence(__ATOMIC_ACQUIRE, "agent");
            asm volatile("s_waitcnt vmcnt(0)" ::: "memory");
        }
    }
    __syncthreads();
}


#ifndef FFT_HD
#define FFT_HD __device__ __forceinline__
#define FFT_LDS LAS
#endif
constexpr int FFT_WORDS = 4096 + 1024 + 256;
FFT_HD int fidx(int i) { return i + 4 * (i >> 4) + 16 * (i >> 8); }

template <bool INV> FFT_HD void dft4(float& ar, float& ai, float& br, float& bi, float& cr, float& ci, float& dr, float& di) {
    const float s0r = ar + cr, s0i = ai + ci, s1r = ar - cr, s1i = ai - ci;
    const float s2r = br + dr, s2i = bi + di, s3r = br - dr, s3i = bi - di;
    ar = s0r + s2r; ai = s0i + s2i;
    cr = s0r - s2r; ci = s0i - s2i;
    if (!INV) { br = s1r + s3i; bi = s1i - s3r; dr = s1r - s3i; di = s1i + s3r; }
    else      { br = s1r - s3i; bi = s1i + s3r; dr = s1r + s3i; di = s1i - s3r; }
}
template <bool INV> FFT_HD void dft16(float (&xr)[16], float (&xi)[16]) {
#pragma unroll
    for (int n0 = 0; n0 < 4; ++n0) dft4<INV>(xr[n0], xi[n0], xr[n0 + 4], xi[n0 + 4], xr[n0 + 8], xi[n0 + 8], xr[n0 + 12], xi[n0 + 12]);
    constexpr float C1 = 0.9238795325112867f, S1 = 0.3826834323650898f, C2 = 0.7071067811865476f;
    const float tc[10] = {1.f, C1, C2, S1, 0.f, -S1, -C2, -C1, -1.f, -C1};
    const float ts[10] = {0.f, S1, C2, C1, 1.f, C1, C2, S1, 0.f, -S1};
#pragma unroll
    for (int n0 = 1; n0 < 4; ++n0)
#pragma unroll
        for (int k0 = 1; k0 < 4; ++k0) { const int m = n0 * k0; const float wr = tc[m], wi = INV ? ts[m] : -ts[m];
            const int id = n0 + 4 * k0; const float r = xr[id] * wr - xi[id] * wi, i = xr[id] * wi + xi[id] * wr; xr[id] = r; xi[id] = i; }
#pragma unroll
    for (int k0 = 0; k0 < 4; ++k0) dft4<INV>(xr[4 * k0], xi[4 * k0], xr[4 * k0 + 1], xi[4 * k0 + 1], xr[4 * k0 + 2], xi[4 * k0 + 2], xr[4 * k0 + 3], xi[4 * k0 + 3]);
#pragma unroll
    for (int a = 0; a < 4; ++a)
#pragma unroll
        for (int b = a + 1; b < 4; ++b) { float t = xr[4 * a + b]; xr[4 * a + b] = xr[4 * b + a]; xr[4 * b + a] = t; t = xi[4 * a + b]; xi[4 * a + b] = xi[4 * b + a]; xi[4 * b + a] = t; }
}
template <bool INV> FFT_HD void twiddle16(float (&xr)[16], float (&xi)[16], int j, int n) {
    float s, c;
#ifdef __HIP_DEVICE_COMPILE__
    asm volatile("" : "+v"(j));
    sincospif(2.0f * (float)j / (float)n, &s, &c);
#else
    s = (float)sin(2.0 * 3.14159265358979323846 * j / n); c = (float)cos(2.0 * 3.14159265358979323846 * j / n);
#endif
    const float wr = c, wi = INV ? s : -s;
    float pr = wr, pi = wi;
#pragma unroll
    for (int k = 1; k < 16; ++k) {
        const float r = xr[k] * pr - xi[k] * pi, i = xr[k] * pi + xi[k] * pr; xr[k] = r; xi[k] = i;
        const float nr = pr * wr - pi * wi, ni = pr * wi + pi * wr; pr = nr; pi = ni;
    }
}
FFT_HD void fft_store_s256(FFT_LDS float* re, FFT_LDS float* im, int g, const float (&xr)[16], const float (&xi)[16]) {
    const int a0 = fidx(g);
#pragma unroll
    for (int k = 0; k < 16; ++k) { re[a0 + 336 * k] = xr[k]; im[a0 + 336 * k] = xi[k]; }
}
FFT_HD void fft_load_s256(const FFT_LDS float* re, const FFT_LDS float* im, int g, float (&xr)[16], float (&xi)[16]) {
    const int a0 = fidx(g);
#pragma unroll
    for (int k = 0; k < 16; ++k) { xr[k] = re[a0 + 336 * k]; xi[k] = im[a0 + 336 * k]; }
}
FFT_HD void fft_load_s16(const FFT_LDS float* re, const FFT_LDS float* im, int g, float (&xr)[16], float (&xi)[16]) {
    const int a0 = fidx((g >> 4) * 256 + (g & 15));
#pragma unroll
    for (int k = 0; k < 16; ++k) { xr[k] = re[a0 + 20 * k]; xi[k] = im[a0 + 20 * k]; }
}
FFT_HD void fft_store_s16(FFT_LDS float* re, FFT_LDS float* im, int g, const float (&xr)[16], const float (&xi)[16]) {
    const int a0 = fidx((g >> 4) * 256 + (g & 15));
#pragma unroll
    for (int k = 0; k < 16; ++k) { re[a0 + 20 * k] = xr[k]; im[a0 + 20 * k] = xi[k]; }
}
FFT_HD void fft_load_s1(const FFT_LDS float* re, const FFT_LDS float* im, int g, float (&xr)[16], float (&xi)[16]) {
    const int a = fidx(g * 16);
#pragma unroll
    for (int k = 0; k < 16; ++k) { xr[k] = re[a + k]; xi[k] = im[a + k]; }
}
FFT_HD void fft_store_s1(FFT_LDS float* re, FFT_LDS float* im, int g, const float (&xr)[16], const float (&xi)[16]) {
    const int a = fidx(g * 16);
#pragma unroll
    for (int k = 0; k < 16; ++k) { re[a + k] = xr[k]; im[a + k] = xi[k]; }
}


struct KArgs { const float* in[28]; float* out; unsigned char* ws; int ph_lo, ph_hi; };
struct Ctx {
    const KArgs& A; float* out; unsigned char* ws; LAS unsigned char* lds;
    int tid, lane, wave, G, gw, NGW;
};

__device__ __forceinline__ void transpose_item(const float* __restrict__ W, int N, int k0, int n0, bf16* __restrict__ dst, LAS float* scr, int lane) {
#pragma unroll 8
    for (int i = 0; i < 32; ++i) { const int kk = 2 * i + (lane >> 5); scr[kk * 33 + (lane & 31)] = W[(size_t)(k0 + kk) * N + n0 + (lane & 31)]; }
    LDS_WAIT(); asm volatile("" ::: "memory");
    const int c = lane & 7;
#pragma unroll
    for (int j = 0; j < 4; ++j) { const int n = (lane >> 3) + 8 * j; const LAS float* s = scr + (8 * c) * 33 + n;
        v4u o; o.x = pk2(s[0 * 33], s[1 * 33]); o.y = pk2(s[2 * 33], s[3 * 33]); o.z = pk2(s[4 * 33], s[5 * 33]); o.w = pk2(s[6 * 33], s[7 * 33]);
        *(v4u*)(dst + (size_t)n * 2048 + k0 + 8 * c) = o; }
    LDS_WAIT(); asm volatile("" ::: "memory");
}

__device__ __forceinline__ void phase0(const Ctx& C) {
    unsigned char* ws = C.ws; asm volatile("" : "+s"(ws));
    {
        const f32x4* x4 = (const f32x4*)C.A.in[0]; v4u* xb = (v4u*)(ws + (size_t)XB_T0 * MiB);
        const size_t n8 = (size_t)T * D / 8;
        for (size_t i = (size_t)blockIdx.x * NTHREADS + C.tid; i < n8; i += (size_t)C.G * NTHREADS) {
            const f32x4 a = x4[2 * i], b = x4[2 * i + 1]; v4u o; o.x = pk2(a.x, a.y); o.y = pk2(a.z, a.w); o.z = pk2(b.x, b.y); o.w = pk2(b.z, b.w); xb[i] = o; }
    }
    {
        LAS float* scr = (LAS float*)(C.lds + C.wave * 8448);
        constexpr int I_IN = 32 * 225, I_OUT = 32 * 64, E_GU0 = MOE_SIDE ? SIDE_GU_EXPERTS : 0, I_GU = MOE_PRECONVERT ? (NE - E_GU0) * 32 * 128 : 0, I_DN = (MOE_PRECONVERT && !MOE_SIDE) ? NE * 32 * 64 : 0, NITEMS = I_IN + I_OUT + I_GU + I_DN;
        bf16* win_t = (bf16*)(ws + (size_t)WIN_T0 * MiB); bf16* wout_t = (bf16*)(ws + (size_t)WOUT_T0 * MiB);
        bf16* wgu_t = (bf16*)(ws + (size_t)WGU_T0 * MiB); bf16* wdn_t = (bf16*)(ws + (size_t)WDN_T0 * MiB);
        for (int it = C.gw; it < NITEMS; it += C.NGW) {
            int r = it;
            if (r < I_IN) { const int kb = r / 225, nb = r % 225; transpose_item(C.A.in[1], DIN, 64 * kb, 32 * nb, win_t + (size_t)(32 * nb) * 2048, scr, C.lane); continue; } r -= I_IN;
            if (r < I_OUT) { const int kb = r / 64, nb = r % 64; transpose_item(C.A.in[16], D, 64 * kb, 32 * nb, wout_t + (size_t)(32 * nb) * 2048, scr, C.lane); continue; } r -= I_OUT;
            if (r < I_GU) { const int e = E_GU0 + r / 4096, rr = r % 4096, kb = rr / 128, nb = rr % 128, n0 = 32 * nb;
                const int drow = (n0 < 2048) ? ((n0 >> 7) * 256 + (n0 & 127)) : ((((n0 - 2048) >> 7) * 256) + 128 + ((n0 - 2048) & 127));
                transpose_item(C.A.in[22] + (size_t)e * 2048 * 4096, 4096, 64 * kb, n0, wgu_t + ((size_t)e * 4096 + drow) * 2048, scr, C.lane);
                continue; } r -= I_GU;
            { const int e = r / 2048, rr = r % 2048, kb = rr / 64, nb = rr % 64;
                transpose_item(C.A.in[24] + (size_t)e * 2048 * 2048, 2048, 64 * kb, 32 * nb, wdn_t + ((size_t)e * 2048 + 32 * nb) * 2048, scr, C.lane); }
        }
    }
    __syncthreads();
    {
        const float* w1 = C.A.in[5]; const float* b1 = C.A.in[6]; const float* w2 = C.A.in[7]; const float* b2 = C.A.in[8]; const float* freq = C.A.in[10];
        LAS float* h1s = (LAS float*)C.lds;
        const int tt = C.tid >> 6, j = C.tid & 63;
        for (int tb = blockIdx.x; tb < SEQ / 8; tb += C.G) {
            const int t = tb * 8 + tt;
            const float zt = (float)t / 2047.0f, wt = 6.283185307179586f * (float)t / 2048.0f;
            float acc = b1[j] + zt * w1[j];
            for (int i = 0; i < 16; ++i) { const float fb = 1e-4f + (float)i * ((15.0f - 1e-4f) / 15.0f); const float arg = fb * wt;
                acc += cosf(arg) * w1[(1 + i) * 64 + j] - sinf(arg) * w1[(17 + i) * 64 + j]; }
            h1s[tt * 64 + j] = sinf(freq[j] * acc);
            __syncthreads();
            float a2 = b2[j];
            for (int i = 0; i < 64; ++i) a2 += h1s[tt * 64 + i] * w2[i * 64 + j];
            { const float hv = sinf(freq[64 + j] * a2); const unsigned hi = f2bf(hv); const float lo = hv - bflo(hi);
              bf16* hp = (bf16*)(ws + WS_H2P) + (size_t)t * 256; hp[j] = (bf16)hi; hp[64 + j] = (bf16)hi; hp[128 + j] = (bf16)f2bf(lo); hp[192 + j] = 0; }
            __syncthreads();
        }
        const float* w3 = C.A.in[9]; bf16* wp = (bf16*)(ws + WS_W3P);
        for (int i = blockIdx.x * NTHREADS + C.tid; i < 4096 * 8; i += C.G * NTHREADS) {
            const int col = i & 4095, jo = i >> 12; float wv[8]; unsigned hi[8], lo[8];
#pragma unroll
            for (int k = 0; k < 8; ++k) { wv[k] = w3[(size_t)(jo * 8 + k) * 4096 + col]; hi[k] = f2bf(wv[k]); lo[k] = f2bf(wv[k] - bflo(hi[k])); }
            v4u vh, vl; vh.x = hi[0] | (hi[1] << 16); vh.y = hi[2] | (hi[3] << 16); vh.z = hi[4] | (hi[5] << 16); vh.w = hi[6] | (hi[7] << 16);
            vl.x = lo[0] | (lo[1] << 16); vl.y = lo[2] | (lo[3] << 16); vl.z = lo[4] | (lo[5] << 16); vl.w = lo[6] | (lo[7] << 16);
            bf16* row = wp + (size_t)col * 256 + jo * 8;
            *(v4u*)row = vh; *(v4u*)(row + 64) = vl; *(v4u*)(row + 128) = vh; *(v4u*)(row + 192) = (v4u){0u, 0u, 0u, 0u};
        }
    }
}

#ifndef NAIVE_ML
#define NAIVE_ML 0
#endif
constexpr int N1_SW_TILES = 16, N1_SW = N1_SW_TILES * 32;
constexpr int N1_NORM_TILES = NAIVE_ML ? 17 : 13, N1_NORM = N1_NORM_TILES * 32, N1_UNITS = N1_SW + N1_NORM;
struct Gemm1Order {
    int G, c;
    __device__ __forceinline__ int a_row(const pg8::Unit& u, int, int r) const { return u.pm * 256 + r; }
    __device__ __forceinline__ bool next(int i, pg8::Unit& u) const {
        const int L = i * G + c; if (L >= N1_UNITS) return false;
        int w; { const int q = N1_UNITS / 8, r = N1_UNITS % 8, xcd = L % 8, off = L / 8; w = (xcd < r ? xcd * (q + 1) : r * (q + 1) + (xcd - r) * q) + off; }
        if (w < N1_SW) { const int nig = 8 * 32, gid = w / nig, wi = w % nig, mi = gid * 8 + (wi % 8), ni = wi / 8;
            u.pm = WIN_T0 + (mi < 12 ? mi : 8 + mi); u.pn = XB_T0 + ni; }
        else { w -= N1_SW; const int nig = 8 * N1_NORM_TILES, gid = w / nig, wi = w % nig, mi = gid * 8 + (wi % 8), ni = wi / 8;
            int wt;
            if (NAIVE_ML) wt = (ni < 16) ? 12 + ni : 28; else wt = (ni < 8) ? 12 + ni : 16 + ni;
            u.pm = XB_T0 + mi; u.pn = WIN_T0 + wt; }
        return true;
    }
    __device__ __forceinline__ void a_ready(const pg8::Unit&) const {}
    __device__ __forceinline__ void done(const pg8::Unit&) const {}
};
struct Epi1 {
    static constexpr bool PERM = true, AFTER_DRAIN = false;
    const float* b_in; bf16* hyt; bf16* qkraw; bf16* vb; bf16* ob; float* gates;
    __device__ __forceinline__ void operator()(const pg8::f32x4 (&acc)[2][2][4][2], const pg8::Unit& u, int wr, int wc, int fr_, int fq_) const {
        int ln_ = threadIdx.x & 63; asm volatile("" : "+v"(ln_));
        const int fr = ln_ & 15, fq = ln_ >> 4;
        using pg8::cvt_pk_bf16;
        if (u.pm >= WIN_T0) {
            const int wt = u.pm - WIN_T0, tt = u.pn - XB_T0;
            const int col0 = tt * 256 + wc * 32 + 8 * fq;
#pragma unroll
            for (int ai = 0; ai < 2; ++ai)
#pragma unroll
                for (int m = 0; m < 4; ++m) {
                    const int ch = wt * 256 + ai * 128 + wr * 64 + m * 16 + fr; const float bv = b_in[ch];
                    const int drow = ch < 3072 ? ch : ch - 2048;
                    bf16* rowp = hyt + (size_t)drow * T + col0;
#pragma unroll
                    for (int bj = 0; bj < 2; ++bj) { const pg8::f32x4 v0 = acc[ai][bj][m][0] + bv, v1 = acc[ai][bj][m][1] + bv;
                        v4u w; w.x = cvt_pk_bf16(v0[0], v0[1]); w.y = cvt_pk_bf16(v0[2], v0[3]); w.z = cvt_pk_bf16(v1[0], v1[1]); w.w = cvt_pk_bf16(v1[2], v1[3]);
                        *(v4u*)(rowp + bj * 128) = w; }
                }
        } else {
            const int tt = u.pm - XB_T0, wt = u.pn - WIN_T0;
            const int chb = wt * 256 + wc * 32 + 8 * fq;
            pg8::f32x4 bv[2][2];
#pragma unroll
            for (int bj = 0; bj < 2; ++bj)
#pragma unroll
                for (int n = 0; n < 2; ++n) { const int c0 = chb + bj * 128 + 4 * n; bv[bj][n] = (c0 < DIN) ? *(const pg8::f32x4*)(b_in + c0) : (pg8::f32x4){0.f, 0.f, 0.f, 0.f}; }
            if (wt == 28) {
                if (wc == 0) {
#pragma unroll
                    for (int ai = 0; ai < 2; ++ai)
#pragma unroll
                        for (int m = 0; m < 4; ++m) { const int tok = tt * 256 + ai * 128 + wr * 64 + m * 16 + fr;
                            float* gp = gates + (size_t)tok * 32 + 8 * fq;
                            *(pg8::f32x4*)(gp) = acc[ai][0][m][0] + bv[0][0]; *(pg8::f32x4*)(gp + 4) = acc[ai][0][m][1] + bv[0][1]; }
                }
            } else {
#define EPI1_STORE(base, ld, cb) do { _Pragma("unroll") for (int ai = 0; ai < 2; ++ai) _Pragma("unroll") for (int m = 0; m < 4; ++m) { const int tok = tt * 256 + ai * 128 + wr * 64 + m * 16 + fr; \
                    bf16* rowp = (base) + (size_t)tok * (ld) + (cb); \
                    _Pragma("unroll") for (int bj = 0; bj < 2; ++bj) { const pg8::f32x4 v0 = acc[ai][bj][m][0] + bv[bj][0], v1 = acc[ai][bj][m][1] + bv[bj][1]; \
                        v4u w; w.x = cvt_pk_bf16(v0[0], v0[1]); w.y = cvt_pk_bf16(v0[2], v0[3]); w.z = cvt_pk_bf16(v1[0], v1[1]); w.w = cvt_pk_bf16(v1[2], v1[3]); \
                        *(v4u*)(rowp + bj * 128) = w; } } } while (0)
                if (wt < 20) EPI1_STORE(qkraw, 2048, chb - 3072);
                else if (wt < 24) EPI1_STORE(vb, 1024, chb - 5120);
                else EPI1_STORE(ob, 1024, chb - 6144);
#undef EPI1_STORE
            }
        }
    }
};

struct KtOrder {
    int G, c;
    __device__ __forceinline__ bool next(int i, pg8::Unit& u) const { const int cc = G - 1 - c; if (i != 0 || cc >= 128) return false; u.pm = cc >> 3; u.pn = cc & 7; return true; }
    __device__ __forceinline__ void a_ready(const pg8::Unit&) const {}
    __device__ __forceinline__ void done(const pg8::Unit&) const {}
};
struct EpiKT {
    static constexpr bool PERM = true, AFTER_DRAIN = false;
    float* kt;
    __device__ __forceinline__ void operator()(const pg8::f32x4 (&acc)[2][2][4][2], const pg8::Unit& u, int wr, int wc, int fr, int fq) const {
        const float da = -3.0701134573253945f, db = -15.350567286626973f;
#pragma unroll
        for (int ai = 0; ai < 2; ++ai)
#pragma unroll
            for (int m = 0; m < 4; ++m) {
                const int col = u.pm * 256 + ai * 128 + wr * 64 + m * 16 + fr, o = col >> 11, dir = (col >> 10) & 1, c = col & 1023;
                const float delta = fabsf(da + (float)c * ((db - da) / 1023.0f)) * (1.0f / 2047.0f);
                float* kr = kt + ((size_t)o * 1024 + c) * 4096;
#pragma unroll
                for (int bj = 0; bj < 2; ++bj) {
                    const int t0 = u.pn * 256 + bj * 128 + wc * 32 + 8 * fq; float v[8];
#pragma unroll
                    for (int n = 0; n < 2; ++n)
#pragma unroll
                        for (int e = 0; e < 4; ++e) v[4 * n + e] = acc[ai][bj][m][n][e] * expf(-(float)(t0 + 4 * n + e) * delta);
                    if (dir == 0) { *(pg8::f32x4*)(kr + t0) = (pg8::f32x4){v[0], v[1], v[2], v[3]}; *(pg8::f32x4*)(kr + t0 + 4) = (pg8::f32x4){v[4], v[5], v[6], v[7]}; }
                    else {
#pragma unroll
                        for (int e = 0; e < 8; ++e) if (t0 + e >= 1) kr[4096 - t0 - e] = v[e]; }
                }
            }
    }
};

template <int OP> __device__ __forceinline__ LAS float* block_scan_2048(LAS float* x, LAS float* y, int tid) {
    LAS float* src = x; LAS float* dst = y;
    for (int off = 1; off < 2048; off <<= 1) {
#pragma unroll
        for (int i = 0; i < 4; ++i) { const int idx = tid + 512 * i; float v = src[idx]; if (idx >= off) { const float w = src[idx - off]; v = OP ? fmaxf(v, w) : v + w; } dst[idx] = v; }
        __syncthreads();
        LAS float* t = src; src = dst; dst = t;
    }
    return src;
}
__device__ __forceinline__ float logsigmoidf(float x) { return fminf(x, 0.f) - log1pf(expf(-fabsf(x))); }

__device__ __forceinline__ void phase2(const Ctx& C) {
    unsigned char* ws = C.ws; asm volatile("" : "+s"(ws));
    {
        const float* KT = (const float*)(ws + WS_KT); f32x4* KF = (f32x4*)(ws + WS_KF);
        const int half = C.tid >> 8, g = C.tid & 255;
        LAS float* re = (LAS float*)(C.lds + half * (2 * FFT_WORDS * 4)); LAS float* im = re + FFT_WORDS;
        LAS float* red = (LAS float*)(C.lds + 4 * FFT_WORDS * 4);
        for (int u = blockIdx.x; u < 1024; u += C.G) {
            const int o = u >> 9, c0 = (u & 511) * 2, c = c0 + half;
            __syncthreads();
            const float* kcol = KT + ((size_t)o * 1024 + c) * 4096;
            float xr[16], xi[16]; float asum = 0.f;
#pragma unroll
            for (int m = 0; m < 16; ++m) { const int idx = g + 256 * m; const float val = (idx == 2048) ? 0.f : kcol[idx]; xr[m] = val; xi[m] = 0.f; asum += fabsf(val); }
            asum = wave_sum(asum);
            if (C.lane == 0) red[C.wave] = asum;
            __syncthreads();
            const float tot = red[half * 4] + red[half * 4 + 1] + red[half * 4 + 2] + red[half * 4 + 3];
            const float scl = 1.0f / (tot * 4096.0f);
#pragma unroll
            for (int m = 0; m < 16; ++m) xr[m] *= scl;
            dft16<false>(xr, xi); twiddle16<false>(xr, xi, g, 4096); fft_store_s256(re, im, g, xr, xi);
            __syncthreads();
            fft_load_s16(re, im, g, xr, xi); dft16<false>(xr, xi); twiddle16<false>(xr, xi, g & 15, 256); fft_store_s16(re, im, g, xr, xi);
            __syncthreads();
            fft_load_s1(re, im, g, xr, xi); dft16<false>(xr, xi);
            f32x4* dst = KF + ((size_t)(o * 1024 + c) * 4096 + g * 16) / 2;
#pragma unroll
            for (int k = 0; k < 8; ++k) dst[k] = (f32x4){xr[2 * k], xi[2 * k], xr[2 * k + 1], xi[2 * k + 1]};
        }
        __syncthreads();
    }
    {
        const bf16* raw = (const bf16*)(ws + WS_QKRAW); bf16* qkc = (bf16*)(ws + WS_QKC); const float* cw = C.A.in[13]; const float* cb = C.A.in[14];
        for (int g = blockIdx.x * NTHREADS + C.tid; g < T * 256; g += C.G * NTHREADS) {
            const int tok = g >> 8, ch0 = (g & 255) * 8, tl = tok & (SEQ - 1);
            const v4u cur = *(const v4u*)(raw + (size_t)tok * 2048 + ch0);
            v4u prv = (v4u){0u, 0u, 0u, 0u}, nxt = (v4u){0u, 0u, 0u, 0u};
            if (tl > 0) prv = *(const v4u*)(raw + (size_t)(tok - 1) * 2048 + ch0);
            if (tl < SEQ - 1) nxt = *(const v4u*)(raw + (size_t)(tok + 1) * 2048 + ch0);
            const float sc = ch0 >= 1024 ? 0.08838834764831845f : 1.0f;
            float o[8];
#pragma unroll
            for (int i = 0; i < 8; ++i) {
                const unsigned pw = prv[i >> 1], cwd = cur[i >> 1], nw = nxt[i >> 1];
                const float p = (i & 1) ? bfhi(pw) : bflo(pw), q = (i & 1) ? bfhi(cwd) : bflo(cwd), n = (i & 1) ? bfhi(nw) : bflo(nw);
                const int ch = ch0 + i;
                const float v = cw[ch] * p + cw[2048 + ch] * q + cw[4096 + ch] * n + cb[ch];
                o[i] = sc * v / (1.0f + expf(-v));
            }
            v4u w; w.x = pk2(o[0], o[1]); w.y = pk2(o[2], o[3]); w.z = pk2(o[4], o[5]); w.w = pk2(o[6], o[7]);
            *(v4u*)(qkc + (size_t)tok * 2048 + ch0) = w;
        }
    }
    {
        const float* gates = (const float*)(ws + WS_GATES); float* GA = (float*)(ws + WS_GA); float* GP = (float*)(ws + WS_GP); float* GE = (float*)(ws + WS_GE);
        LAS float* s0 = (LAS float*)(C.lds + 8192); LAS float* s1 = s0 + 2048; LAS float* s2 = s1 + 2048; LAS float* s3 = s2 + 2048;
        for (int bhd = blockIdx.x; bhd < 64; bhd += C.G) {
            const int b = bhd >> 4, h = (bhd >> 1) & 7, dir = bhd & 1, col_i = dir * 16 + h, col_f = col_i + 8;
            float ig[4], lf[4];
            __syncthreads();
#pragma unroll
            for (int i = 0; i < 4; ++i) { const int t = C.tid + 512 * i; const float* gr = gates + (size_t)(b * SEQ + t) * 32; ig[i] = gr[col_i]; lf[i] = logsigmoidf(gr[col_f]); s0[t] = lf[i]; }
            __syncthreads();
            LAS float* Fc = block_scan_2048<0>(s0, s1, C.tid);
            float a[4], Fv[4], Gx[4];
#pragma unroll
            for (int i = 0; i < 4; ++i) { const int t = C.tid + 512 * i; Fv[i] = Fc[t]; Gx[i] = Fv[i] - lf[i]; a[i] = dir ? ig[i] + Gx[i] : ig[i] - Fv[i]; s2[dir ? 2047 - t : t] = a[i]; }
            __syncthreads();
            LAS float* Pm = block_scan_2048<1>(s2, s3, C.tid);
#pragma unroll
            for (int i = 0; i < 4; ++i) { const int t = C.tid + 512 * i; const float pm = Pm[dir ? 2047 - t : t];
                const float mt = dir ? pm - Gx[i] : Fv[i] + pm;
                GA[bhd * 2048 + t] = a[i]; GP[bhd * 2048 + t] = pm; GE[bhd * 2048 + t] = expf(-mt); }
        }
        __syncthreads();
    }
}

__device__ __forceinline__ void hyena_naive(const Ctx& C) {
    unsigned char* ws = C.ws; asm volatile("" : "+s"(ws));
    const bf16* hyt = (const bf16*)(ws + WS_HYT); const float* KT = (const float*)(ws + WS_KT); float* Z = (float*)(ws + WS_Z);
    const float* cw = C.A.in[3]; const float* cb = C.A.in[4]; const float* skip = C.A.in[11];
    LAS float* sv = (LAS float*)C.lds; LAS float* sk = sv + 2048;
    for (int u = blockIdx.x; u < NB * DHY; u += C.G) {
        const int b = u >> 10, c = u & 1023;
        float v[4], x1[4], x2[4];
#pragma unroll
        for (int part = 0; part < 3; ++part) {
            const int ch = part * 1024 + c; const bf16* row = hyt + (size_t)ch * T + b * SEQ;
            const float w0 = cw[ch], w1 = cw[3072 + ch], w2 = cw[6144 + ch], bb = cb[ch];
#pragma unroll
            for (int i = 0; i < 4; ++i) { const int t = C.tid + 512 * i;
                const float p = t > 0 ? bf2f(row[t - 1]) : 0.f, q = bf2f(row[t]), n = t < SEQ - 1 ? bf2f(row[t + 1]) : 0.f;
                const float r = w0 * p + w1 * q + w2 * n + bb;
                if (part == 0) v[i] = r; else if (part == 1) x1[i] = r; else x2[i] = r; }
        }
        __syncthreads();
#pragma unroll
        for (int i = 0; i < 4; ++i) sv[C.tid + 512 * i] = v[i];
#pragma unroll
        for (int i = 0; i < 8; ++i) sk[C.tid + 512 * i] = KT[(size_t)c * 4096 + C.tid + 512 * i];
        __syncthreads();
        float acc[4] = {0.f, 0.f, 0.f, 0.f};
        for (int s = 0; s < SEQ; ++s) { const float vv = sv[s];
#pragma unroll
            for (int i = 0; i < 4; ++i) acc[i] += sk[(C.tid + 512 * i - s) & 4095] * vv; }
        float z1[4]; const float sk0 = skip[c], sk1 = skip[1024 + c];
#pragma unroll
        for (int i = 0; i < 4; ++i) z1[i] = x1[i] * (acc[i] + sk0 * v[i]);
        __syncthreads();
#pragma unroll
        for (int i = 0; i < 4; ++i) sv[C.tid + 512 * i] = z1[i];
#pragma unroll
        for (int i = 0; i < 8; ++i) sk[C.tid + 512 * i] = KT[(size_t)(1024 + c) * 4096 + C.tid + 512 * i];
        __syncthreads();
#pragma unroll
        for (int i = 0; i < 4; ++i) acc[i] = 0.f;
        for (int s = 0; s < SEQ; ++s) { const float vv = sv[s];
#pragma unroll
            for (int i = 0; i < 4; ++i) acc[i] += sk[(C.tid + 512 * i - s) & 4095] * vv; }
#pragma unroll
        for (int i = 0; i < 4; ++i) Z[(size_t)(b * SEQ + C.tid + 512 * i) * 1024 + c] = x2[i] * (acc[i] + sk1 * z1[i]);
    }
    __syncthreads();
}

__device__ __forceinline__ void hyena_conv_once(LAS float* re, LAS float* im, int g, float (&xr)[16], float (&xi)[16], const f32x4* __restrict__ kf) {
    __syncthreads();
    dft16<false>(xr, xi); twiddle16<false>(xr, xi, g, 4096); fft_store_s256(re, im, g, xr, xi);
    __syncthreads();
    fft_load_s16(re, im, g, xr, xi); dft16<false>(xr, xi); twiddle16<false>(xr, xi, g & 15, 256); fft_store_s16(re, im, g, xr, xi);
    __syncthreads();
    fft_load_s1(re, im, g, xr, xi); dft16<false>(xr, xi);
#pragma unroll
    for (int k = 0; k < 8; ++k) { const f32x4 w = kf[g * 8 + k];
        const float r0 = xr[2 * k] * w.x - xi[2 * k] * w.y, i0 = xr[2 * k] * w.y + xi[2 * k] * w.x;
        const float r1 = xr[2 * k + 1] * w.z - xi[2 * k + 1] * w.w, i1 = xr[2 * k + 1] * w.w + xi[2 * k + 1] * w.z;
        xr[2 * k] = r0; xi[2 * k] = i0; xr[2 * k + 1] = r1; xi[2 * k + 1] = i1; }
    dft16<true>(xr, xi); fft_store_s1(re, im, g, xr, xi);
    __syncthreads();
    fft_load_s16(re, im, g, xr, xi); twiddle16<true>(xr, xi, g & 15, 256); dft16<true>(xr, xi); fft_store_s16(re, im, g, xr, xi);
    __syncthreads();
    fft_load_s256(re, im, g, xr, xi); twiddle16<true>(xr, xi, g, 4096); dft16<true>(xr, xi);
}
__device__ __forceinline__ void hyena_fft(const Ctx& C) {
    unsigned char* ws = C.ws; asm volatile("" : "+s"(ws));
    const bf16* hyt = (const bf16*)(ws + WS_HYT); const f32x4* KF = (const f32x4*)(ws + WS_KF); float* ZT = (float*)(ws + WS_ZT);
    const float* cw = C.A.in[3]; const float* cb = C.A.in[4]; const float* skip = C.A.in[11];
    const int half = C.tid >> 8, g = C.tid & 255;
    LAS float* re = (LAS float*)(C.lds + half * (2 * FFT_WORDS * 4)); LAS float* im = re + FFT_WORDS;
    for (int c = blockIdx.x; c < DHY; c += C.G) {
        float vr[8], vi[8], ar[8], ai[8], br[8], bi[8];
#pragma unroll
        for (int part = 0; part < 3; ++part) {
            const int ch = part * 1024 + c; const float w0 = cw[ch], w1 = cw[3072 + ch], w2 = cw[6144 + ch], bb = cb[ch];
#pragma unroll
            for (int bq = 0; bq < 2; ++bq) { const bf16* row = hyt + (size_t)ch * T + (2 * half + bq) * SEQ;
#pragma unroll
                for (int m = 0; m < 8; ++m) { const int t = g + 256 * m;
                    const float p = t > 0 ? bf2f(row[t - 1]) : 0.f, q = bf2f(row[t]), n = t < SEQ - 1 ? bf2f(row[t + 1]) : 0.f;
                    const float r = w0 * p + w1 * q + w2 * n + bb;
                    if (part == 0) { if (bq == 0) vr[m] = r; else vi[m] = r; } else if (part == 1) { if (bq == 0) ar[m] = r; else ai[m] = r; } else { if (bq == 0) br[m] = r; else bi[m] = r; } }
                asm volatile("" ::: "memory"); }
        }
        const float sk0 = skip[c], sk1 = skip[1024 + c];
        float xr[16], xi[16];
#pragma unroll
        for (int m = 0; m < 8; ++m) { xr[m] = vr[m]; xi[m] = vi[m]; xr[m + 8] = 0.f; xi[m + 8] = 0.f; }
        hyena_conv_once(re, im, g, xr, xi, KF + (size_t)c * 2048);
#pragma unroll
        for (int m = 0; m < 8; ++m) { vr[m] = ar[m] * (xr[m] + sk0 * vr[m]); vi[m] = ai[m] * (xi[m] + sk0 * vi[m]); xr[m] = vr[m]; xi[m] = vi[m]; xr[m + 8] = 0.f; xi[m + 8] = 0.f; }
        hyena_conv_once(re, im, g, xr, xi, KF + (size_t)(1024 + c) * 2048);
        float* zr = ZT + (size_t)c * T + (2 * half) * SEQ;
#pragma unroll
        for (int m = 0; m < 8; ++m) { const int t = g + 256 * m; zr[t] = br[m] * (xr[m] + sk1 * vr[m]); zr[SEQ + t] = bi[m] * (xi[m] + sk1 * vi[m]); }
    }
    __syncthreads();
}

__device__ __forceinline__ void mlstm_naive(const Ctx& C) {
    unsigned char* ws = C.ws; asm volatile("" : "+s"(ws));
    const bf16* qkc = (const bf16*)(ws + WS_QKC); const bf16* vb = (const bf16*)(ws + WS_VB);
    const float* GA = (const float*)(ws + WS_GA); const float* GP = (const float*)(ws + WS_GP); const float* GE = (const float*)(ws + WS_GE);
    float* HML = (float*)(ws + WS_HML);
    LAS float* qs = (LAS float*)(C.lds + C.wave * 1024); LAS float* ps = qs + 128;
    const int lane = C.lane;
    for (int u = blockIdx.x; u < 64 * 32; u += C.G) {
        const int bhd = u >> 5, qb = u & 31, b = bhd >> 4, h = (bhd >> 1) & 7, dir = bhd & 1;
        for (int qi = 0; qi < 8; ++qi) {
            const int t = qb * 64 + C.wave * 8 + qi;
            { const unsigned w = *(const unsigned*)(qkc + (size_t)(b * SEQ + t) * 2048 + h * 128 + 2 * lane); qs[2 * lane] = bflo(w); qs[2 * lane + 1] = bfhi(w); }
            __builtin_amdgcn_wave_barrier(); LDS_WAIT();
            const float pmt = GP[bhd * 2048 + t];
            const int c_lo = dir ? (t >> 6) : 0, c_hi = dir ? 31 : (t >> 6);
            float acc0 = 0.f, acc1 = 0.f, den = 0.f;
            for (int cch = c_lo; cch <= c_hi; ++cch) {
                const int s = cch * 64 + lane; const bool valid = dir ? (s >= t) : (s <= t);
                const v4u* kr = (const v4u*)(qkc + (size_t)(b * SEQ + s) * 2048 + 1024 + h * 128);
                float sc = 0.f;
#pragma unroll
                for (int j = 0; j < 16; ++j) { const v4u kk = kr[j];
#pragma unroll
                    for (int e = 0; e < 4; ++e) sc += qs[8 * j + 2 * e] * bflo(kk[e]) + qs[8 * j + 2 * e + 1] * bfhi(kk[e]); }
                const float p = valid ? sc * expf(GA[bhd * 2048 + s] - pmt) : 0.f;
                den += p;
                __builtin_amdgcn_wave_barrier();
                ps[lane] = p;
                __builtin_amdgcn_wave_barrier(); LDS_WAIT();
                const bf16* vr = vb + (size_t)(b * SEQ + cch * 64) * 1024 + h * 128 + 2 * lane;
#pragma unroll 8
                for (int s2 = 0; s2 < 64; ++s2) { const unsigned w = *(const unsigned*)(vr + (size_t)s2 * 1024); const float pv = ps[s2]; acc0 += pv * bflo(w); acc1 += pv * bfhi(w); }
                __builtin_amdgcn_wave_barrier();
            }
            den = wave_sum(den);
            const float scl = 1.0f / fmaxf(fabsf(den), GE[bhd * 2048 + t]);
            *(f32x2*)(HML + ((size_t)dir * T + b * SEQ + t) * 1024 + h * 128 + 2 * lane) = (f32x2){acc0 * scl, acc1 * scl};
            __builtin_amdgcn_wave_barrier();
        }
    }
    __syncthreads();
}

typedef short ml_bf16x8 __attribute__((ext_vector_type(8)));
typedef short ml_s16x4 __attribute__((ext_vector_type(4)));
typedef float ml_f32x16 __attribute__((ext_vector_type(16)));
typedef __bf16 ml_bf2 __attribute__((ext_vector_type(2)));
constexpr int ML_KROW = 272, ML_VROW = 136, ML_KBUF = 64 * ML_KROW, ML_VBUF = 128 * ML_VROW;
__device__ __forceinline__ unsigned ml_pk(float lo, float hi) { const f32x2 v = {lo, hi}; return __builtin_bit_cast(unsigned, __builtin_convertvector(v, ml_bf2)); }
__device__ __forceinline__ void mlstm_mfma(const Ctx& C) {
    unsigned char* ws = C.ws; asm volatile("" : "+s"(ws));
    const bf16* qkc = (const bf16*)(ws + WS_QKC); const bf16* vt = (const bf16*)(ws + WS_HYT) + (size_t)3072 * T;
    const float* GA = (const float*)(ws + WS_GA); const float* GP = (const float*)(ws + WS_GP); const float* GE = (const float*)(ws + WS_GE);
    const bf16* ob = (const bf16*)(ws + WS_OB); bf16* ycat = (bf16*)(ws + (size_t)YCAT_T0 * MiB); const float* mlw = C.A.in[15];
    LAS unsigned char* KB = C.lds; LAS unsigned char* VB = C.lds + 2 * ML_KBUF; LAS float* AS = (LAS float*)(C.lds + 2 * ML_KBUF + 2 * ML_VBUF);
    int tid = C.tid; asm volatile("" : "+v"(tid));
    const int w = C.wave, lane = tid & 63, r = lane & 31, hh = lane >> 5;
    for (int u = blockIdx.x; u < 256; u += C.G) {
        const int bh = u >> 3, qb = u & 7, b = bh >> 3, h = bh & 7;
        const bf16* kbase = qkc + (size_t)(b * SEQ) * 2048 + 1024 + h * 128;
        const bf16* vbase = vt + (size_t)(h * 128) * T + b * SEQ;
        const int qlo = 256 * qb + 32 * w, tq = qlo + r;
        ml_bf16x8 qf[8];
        { const bf16* qrow = qkc + (size_t)(b * SEQ + tq) * 2048 + h * 128 + 8 * hh;
#pragma unroll
          for (int s = 0; s < 8; ++s) qf[s] = *(const ml_bf16x8*)(qrow + 16 * s); }
        ml_f32x16 O[4]; unsigned hfp[4][8];
#pragma unroll 1
        for (int dir = 0; dir < 2; ++dir) {
            const int bhd = bh * 2 + dir;
            __syncthreads();
            for (int i = tid; i < SEQ; i += NTHREADS) AS[i] = GA[bhd * SEQ + i];
            const float pmt = GP[bhd * SEQ + tq];
#pragma unroll
            for (int d = 0; d < 4; ++d)
#pragma unroll
                for (int i = 0; i < 16; ++i) O[d][i] = 0.f;
            float den = 0.f;
            const int kt0 = dir ? 4 * qb : 0, kt1 = dir ? 31 : 4 * qb + 3;
            v4u kr0, kr1, vr0, vr1;
            const unsigned koff0 = (unsigned)((tid >> 4) * 4096 + (tid & 15) * 16), koff1 = koff0 + 32u * 4096u;
            const unsigned voff0 = (unsigned)((tid >> 3) * (T * 2) + (tid & 7) * 16), voff1 = voff0 + 64u * (unsigned)(T * 2);
#define ML_LOAD(kt) do { const char* ku_ = (const char*)kbase + (size_t)(kt) * (64 * 4096); const char* vu_ = (const char*)vbase + (size_t)(kt) * 128; \
                kr0 = *(const v4u*)(ku_ + koff0); kr1 = *(const v4u*)(ku_ + koff1); vr0 = *(const v4u*)(vu_ + voff0); vr1 = *(const v4u*)(vu_ + voff1); } while (0)
#define ML_STORE(buf) do { const int p0 = tid, p1 = tid + 512; \
                *(LAS v4u*)(KB + (buf) * ML_KBUF + (p0 >> 4) * ML_KROW + (p0 & 15) * 16) = kr0; *(LAS v4u*)(KB + (buf) * ML_KBUF + (p1 >> 4) * ML_KROW + (p1 & 15) * 16) = kr1; \
                { LAS unsigned char* d0 = VB + (buf) * ML_VBUF + (p0 >> 3) * ML_VROW + (p0 & 7) * 16; *(LAS v2u*)d0 = (v2u){vr0.x, vr0.y}; *(LAS v2u*)(d0 + 8) = (v2u){vr0.z, vr0.w}; } \
                { LAS unsigned char* d1 = VB + (buf) * ML_VBUF + (p1 >> 3) * ML_VROW + (p1 & 7) * 16; *(LAS v2u*)d1 = (v2u){vr1.x, vr1.y}; *(LAS v2u*)(d1 + 8) = (v2u){vr1.z, vr1.w}; } } while (0)
            ML_LOAD(kt0);
            __syncthreads();
            ML_STORE(0);
            __syncthreads();
#pragma unroll 1
            for (int kt = kt0; kt <= kt1; ++kt) {
                const int cur = (kt - kt0) & 1;
                if (kt < kt1) ML_LOAD(kt + 1);
                const int klo = 64 * kt, khi = klo + 63, qhi = qlo + 31;
                const bool none = dir ? (khi < qlo) : (klo > qhi);
                const bool all = dir ? (klo >= qhi) : (khi <= qlo);
                if (!none) {
                    const LAS unsigned char* Kb = KB + cur * ML_KBUF; const LAS unsigned char* Vb = VB + cur * ML_VBUF;
                    ml_f32x16 S0, S1;
#pragma unroll
                    for (int i = 0; i < 16; ++i) { S0[i] = 0.f; S1[i] = 0.f; }
#pragma unroll
                    for (int s = 0; s < 8; ++s) {
                        const ml_bf16x8 k0 = *(const LAS ml_bf16x8*)(Kb + r * ML_KROW + (16 * s + 8 * hh) * 2);
                        const ml_bf16x8 k1 = *(const LAS ml_bf16x8*)(Kb + (32 + r) * ML_KROW + (16 * s + 8 * hh) * 2);
                        S0 = __builtin_amdgcn_mfma_f32_32x32x16_bf16(k0, qf[s], S0, 0, 0, 0);
                        S1 = __builtin_amdgcn_mfma_f32_32x32x16_bf16(k1, qf[s], S1, 0, 0, 0);
                    }
#pragma unroll
                    for (int kb = 0; kb < 2; ++kb)
#pragma unroll
                        for (int g4 = 0; g4 < 4; ++g4) {
                            const f32x4 a4 = *(const LAS f32x4*)(AS + klo + 32 * kb + 8 * g4 + 4 * hh);
#pragma unroll
                            for (int e = 0; e < 4; ++e) {
                                const int i = 4 * g4 + e; const int sg = klo + 32 * kb + 8 * g4 + 4 * hh + e;
                                const float sv = kb ? S1[i] : S0[i];
                                float p = sv * __expf(a4[e] - pmt);
                                if (!all) { const bool valid = dir ? (sg >= tq) : (sg <= tq); p = valid ? p : 0.f; }
                                den += p;
                                if (kb) S1[i] = p; else S0[i] = p;
                            }
                        }
#pragma unroll
                    for (int kb = 0; kb < 2; ++kb)
#pragma unroll
                        for (int s = 0; s < 2; ++s) {
                            v4u pw;
                            if (kb == 0) { pw.x = ml_pk(S0[8 * s], S0[8 * s + 1]); pw.y = ml_pk(S0[8 * s + 2], S0[8 * s + 3]); pw.z = ml_pk(S0[8 * s + 4], S0[8 * s + 5]); pw.w = ml_pk(S0[8 * s + 6], S0[8 * s + 7]); }
                            else { pw.x = ml_pk(S1[8 * s], S1[8 * s + 1]); pw.y = ml_pk(S1[8 * s + 2], S1[8 * s + 3]); pw.z = ml_pk(S1[8 * s + 4], S1[8 * s + 5]); pw.w = ml_pk(S1[8 * s + 6], S1[8 * s + 7]); }
                            const ml_bf16x8 pf = __builtin_bit_cast(ml_bf16x8, pw);
#pragma unroll
                            for (int db = 0; db < 4; ++db) {
                                const LAS unsigned char* vp = Vb + (32 * db + r) * ML_VROW + 2 * (32 * kb + 16 * s + 4 * hh);
                                const ml_s16x4 lo = *(const LAS ml_s16x4*)vp, hi = *(const LAS ml_s16x4*)(vp + 16);
                                const ml_bf16x8 vf = __builtin_shufflevector(lo, hi, 0, 1, 2, 3, 4, 5, 6, 7);
                                O[db] = __builtin_amdgcn_mfma_f32_32x32x16_bf16(vf, pf, O[db], 0, 0, 0);
                            }
                        }
                }
                if (kt < kt1) ML_STORE(cur ^ 1);
                __syncthreads();
            }
#undef ML_LOAD
#undef ML_STORE
            den += __shfl_xor(den, 32);
            const float scl = 1.0f / fmaxf(fabsf(den), GE[bhd * SEQ + tq]);
            if (dir == 0) {
#pragma unroll
                for (int db = 0; db < 4; ++db)
#pragma unroll
                    for (int j = 0; j < 8; ++j) hfp[db][j] = ml_pk(O[db][2 * j] * scl, O[db][2 * j + 1] * scl);
            } else {
#pragma unroll
                for (int db = 0; db < 4; ++db)
#pragma unroll
                    for (int j = 0; j < 8; ++j) { O[db][2 * j] = O[db][2 * j] * scl + bflo(hfp[db][j]); O[db][2 * j + 1] = O[db][2 * j + 1] * scl + bfhi(hfp[db][j]); }
            }
        }
        float sm = 0.f;
#pragma unroll
        for (int db = 0; db < 4; ++db)
#pragma unroll
            for (int i = 0; i < 16; ++i) sm += O[db][i];
        sm += __shfl_xor(sm, 32);
        const float mu = sm * (1.0f / 128.0f); float qv = 0.f;
#pragma unroll
        for (int db = 0; db < 4; ++db)
#pragma unroll
            for (int i = 0; i < 16; ++i) { O[db][i] -= mu; qv += O[db][i] * O[db][i]; }
        qv += __shfl_xor(qv, 32);
        const float rstd = 1.0f / sqrtf(qv * (1.0f / 128.0f) + LN_EPS);
        LAS unsigned char* TB = C.lds;
        int te = tid; asm volatile("" : "+v"(te));
        __syncthreads();
#pragma unroll
        for (int i = 0; i < 8; ++i) { const int pc = te + 512 * i, row = pc >> 4, ch = pc & 15;
            *(LAS v4u*)(TB + row * 272 + ch * 16) = *(const v4u*)(ob + (size_t)(b * SEQ + 256 * qb + row) * 1024 + h * 128 + ch * 8); }
        __syncthreads();
        LAS unsigned char* myrow = TB + (32 * w + (te & 31)) * 272 + 8 * ((te & 63) >> 5);
#pragma unroll
        for (int db = 0; db < 4; ++db)
#pragma unroll
            for (int g4 = 0; g4 < 4; ++g4) {
                const int dim = 32 * db + 8 * g4 + 4 * hh; const f32x4 gw = *(const f32x4*)(mlw + h * 128 + dim);
                LAS v2u* pp = (LAS v2u*)(myrow + (32 * db + 8 * g4) * 2); const v2u ow = *pp;
                const float o0 = bflo(ow.x), o1 = bfhi(ow.x), o2 = bflo(ow.y), o3 = bfhi(ow.y);
                const float y0 = O[db][4 * g4] * rstd * gw.x / (1.0f + __expf(-o0)), y1 = O[db][4 * g4 + 1] * rstd * gw.y / (1.0f + __expf(-o1));
                const float y2 = O[db][4 * g4 + 2] * rstd * gw.z / (1.0f + __expf(-o2)), y3 = O[db][4 * g4 + 3] * rstd * gw.w / (1.0f + __expf(-o3));
                *pp = (v2u){ml_pk(y0, y1), ml_pk(y2, y3)};
                asm volatile("" ::: "memory");
            }
        __syncthreads();
#pragma unroll
        for (int i = 0; i < 8; ++i) { const int pc = te + 512 * i, row = pc >> 4, ch = pc & 15;
            *(v4u*)(ycat + (size_t)(b * SEQ + 256 * qb + row) * 2048 + 1024 + h * 128 + ch * 8) = *(const LAS v4u*)(TB + row * 272 + ch * 16); }
    }
    __syncthreads();
}

__device__ __forceinline__ void phase4(const Ctx& C) {
    unsigned char* ws = C.ws; asm volatile("" : "+s"(ws));
    const float* ZT = (const float*)(ws + WS_ZT); const float* HML = (const float*)(ws + WS_HML); const bf16* ob = (const bf16*)(ws + WS_OB);
    bf16* ycat = (bf16*)(ws + (size_t)YCAT_T0 * MiB); const float* hyw = C.A.in[12]; const float* mlw = C.A.in[15];
    const int lane = C.lane;
    {
        LAS float* red = (LAS float*)C.lds;
        for (int u = blockIdx.x; u < 128 * 8; u += C.G) {
            const int tt = u >> 3, gi = u & 7, tok = tt * 64 + lane, ch0 = gi * 128 + C.wave * 16;
            float x[16]; float s = 0.f;
#pragma unroll
            for (int i = 0; i < 16; ++i) { x[i] = ZT[(size_t)(ch0 + i) * T + tok]; s += x[i]; }
            __syncthreads();
            red[C.wave * 64 + lane] = s;
            __syncthreads();
            float tot = 0.f;
#pragma unroll
            for (int w = 0; w < 8; ++w) tot += red[w * 64 + lane];
            const float mu = tot * (1.0f / 128.0f); float q = 0.f;
#pragma unroll
            for (int i = 0; i < 16; ++i) { x[i] -= mu; q += x[i] * x[i]; }
            __syncthreads();
            red[C.wave * 64 + lane] = q;
            __syncthreads();
            float qt = 0.f;
#pragma unroll
            for (int w = 0; w < 8; ++w) qt += red[w * 64 + lane];
            const float rstd = 1.0f / sqrtf(qt * (1.0f / 128.0f) + LN_EPS);
            float y[16];
#pragma unroll
            for (int i = 0; i < 16; ++i) y[i] = x[i] * rstd * hyw[ch0 + i];
            v4u w0, w1; w0.x = pk2(y[0], y[1]); w0.y = pk2(y[2], y[3]); w0.z = pk2(y[4], y[5]); w0.w = pk2(y[6], y[7]);
            w1.x = pk2(y[8], y[9]); w1.y = pk2(y[10], y[11]); w1.z = pk2(y[12], y[13]); w1.w = pk2(y[14], y[15]);
            bf16* dst = ycat + (size_t)tok * 2048 + ch0;
            *(v4u*)dst = w0; *(v4u*)(dst + 8) = w1;
        }
        __syncthreads();
    }
}

struct TileOrder {
    int nM, nN, a0, b0, G, c;
    __device__ __forceinline__ bool next(int i, pg8::Unit& u) const {
        const int nwg = nM * nN; const int L = i * G + c; if (L >= nwg) return false;
        int w; { const int q = nwg / 8, r = nwg % 8, xcd = L % 8, off = L / 8; w = (xcd < r ? xcd * (q + 1) : r * (q + 1) + (xcd - r) * q) + off; }
        const int nig = 8 * nN, gid = w / nig, wi = w % nig; u.pm = a0 + gid * 8 + (wi % 8); u.pn = b0 + wi / 8; return true;
    }
    __device__ __forceinline__ void a_ready(const pg8::Unit&) const {}
    __device__ __forceinline__ void done(const pg8::Unit&) const {}
};
struct EpiOut {
    static constexpr bool PERM = false, AFTER_DRAIN = false;
    const float* x; const float* bias; float* r1;
    __device__ __forceinline__ void operator()(const pg8::f32x4 (&acc)[2][2][4][2], const pg8::Unit& u, int wr, int wc, int fr, int fq) const {
        const int row0 = (u.pm - YCAT_T0) * 256 + wr * 64 + fr, col0 = (u.pn - WOUT_T0) * 256 + wc * 32 + 4 * fq;
        pg8::f32x4 bv[2][2];
#pragma unroll
        for (int bj = 0; bj < 2; ++bj)
#pragma unroll
            for (int n = 0; n < 2; ++n) bv[bj][n] = *(const pg8::f32x4*)(bias + col0 + bj * 128 + n * 16);
#pragma unroll
        for (int ai = 0; ai < 2; ++ai)
#pragma unroll
            for (int m = 0; m < 4; ++m) { const size_t off = (size_t)(row0 + ai * 128 + m * 16) * D + col0;
#pragma unroll
                for (int bj = 0; bj < 2; ++bj)
#pragma unroll
                    for (int n = 0; n < 2; ++n) { const pg8::f32x4 xs = *(const pg8::f32x4*)(x + off + bj * 128 + n * 16);
                        *(pg8::f32x4*)(r1 + off + bj * 128 + n * 16) = xs * DN_ALPHA + acc[ai][bj][m][n] + bv[bj][n]; } }
    }
};

#define P6_RS_STEP(NV, XM) do { const bool up = (lane & (XM)) != 0; _Pragma("unroll") for (int e_ = 0; e_ < (NV); ++e_) { \
        const float keep0 = up ? a0[e_ + (NV)] : a0[e_], send0 = up ? a0[e_] : a0[e_ + (NV)]; a0[e_] = keep0 + __shfl_xor(send0, (XM)); \
        const float keep1 = up ? a1[e_ + (NV)] : a1[e_], send1 = up ? a1[e_] : a1[e_ + (NV)]; a1[e_] = keep1 + __shfl_xor(send1, (XM)); } } while (0)
__device__ __forceinline__ void phase6(const Ctx& C, int dummy) {
    unsigned char* ws = C.ws; asm volatile("" : "+s"(ws));
    float* r1 = (float*)(ws + WS_R1); bf16* x1b = (bf16*)(ws + (size_t)X1B_T0 * MiB);
    const float* g1 = C.A.in[18]; const float* b1 = C.A.in[19]; const float* rw = C.A.in[20]; const float* rb = C.A.in[21];
    unsigned* cnt = (unsigned*)(ws + WS_CTL) + CW_CNT + (dummy ? 4096 : 0); int* list = (int*)(ws + (dummy ? WS_YBUF : WS_LIST)); float* tokw = (float*)(ws + (dummy ? WS_YBUF + 2 * MiB : WS_TOKW));
    const int lane = C.lane;
    LAS unsigned char* wbuf = C.lds;
    for (int it = blockIdx.x; it < T / 16; it += C.G) {
        const int pair = it * 8 + C.wave;
        int ln = lane; asm volatile("" : "+v"(ln));
        f32x4 v0[8], v1[8];
#pragma unroll
        for (int tk = 0; tk < 2; ++tk) {
            const int tok = 2 * pair + tk; float* rr = r1 + (size_t)tok * D; f32x4 v[8]; float s = 0.f;
#pragma unroll
            for (int j = 0; j < 8; ++j) { v[j] = *(const f32x4*)(rr + (ln + 64 * j) * 4); s += (v[j].x + v[j].y) + (v[j].z + v[j].w); }
            const float mean = wave_sum(s) * (1.0f / D); float q = 0.f;
#pragma unroll
            for (int j = 0; j < 8; ++j) { v[j] = v[j] - mean; q += (v[j].x * v[j].x + v[j].y * v[j].y) + (v[j].z * v[j].z + v[j].w * v[j].w); }
            const float rstd = 1.0f / sqrtf(wave_sum(q) * (1.0f / D) + LN_EPS);
#pragma unroll
            for (int j = 0; j < 8; ++j) { const int c0 = (ln + 64 * j) * 4; const f32x4 gg = *(const f32x4*)(g1 + c0), bb = *(const f32x4*)(b1 + c0);
                const f32x4 y = v[j] * rstd * gg + bb;
                if (!dummy) { v2u w; w.x = pk2(y.x, y.y); w.y = pk2(y.z, y.w); *(v2u*)(x1b + (size_t)tok * D + c0) = w; }
                if (tk == 0) v0[j] = y; else v1[j] = y; }
        }
        float a0[32], a1[32];
#pragma unroll
        for (int e = 0; e < 32; ++e) { a0[e] = 0.f; a1[e] = 0.f; }
        const int tid = C.tid; f32x4 st[4];
        const bool hi8 = (ln & 8) != 0;
        const unsigned rdoff = (unsigned)(4 * ln) * 128u, rdx = (unsigned)(ln & 7);
#define P6_CHUNK_LOAD(j_) do { _Pragma("unroll") for (int r_ = 0; r_ < 4; ++r_) st[r_] = *(const f32x4*)(rw + (size_t)(j_) * 8192 + (size_t)(tid + 512 * r_) * 4); } while (0)
#define P6_CHUNK_STORE(b_) do { _Pragma("unroll") for (int r_ = 0; r_ < 4; ++r_) { const int idx_ = tid + 512 * r_, row_ = idx_ >> 3, q_ = idx_ & 7; \
            *(LAS f32x4*)(wbuf + (b_) * 32768 + row_ * 128 + 16 * (q_ ^ ((row_ >> 2) & 7))) = st[r_]; } } while (0)
        __syncthreads();
        P6_CHUNK_LOAD(0); P6_CHUNK_STORE(0);
        __syncthreads();
#pragma unroll
        for (int j = 0; j < 8; ++j) {
            if (j < 7) P6_CHUNK_LOAD(j + 1);
            const LAS unsigned char* wb = wbuf + (j & 1) * 32768 + rdoff;
#pragma unroll
            for (int i = 0; i < 4; ++i) {
                const float x0 = hi8 ? v0[j][i ^ 1] : v0[j][i], x1 = hi8 ? v1[j][i ^ 1] : v1[j][i];
                const LAS unsigned char* wrow = wb + (hi8 ? (i ^ 1) : i) * 128;
#pragma unroll
                for (int q4 = 0; q4 < 8; ++q4) { const f32x4 w4 = *(const LAS f32x4*)(wrow + 16 * (q4 ^ rdx));
                    a0[4 * q4] += x0 * w4.x; a0[4 * q4 + 1] += x0 * w4.y; a0[4 * q4 + 2] += x0 * w4.z; a0[4 * q4 + 3] += x0 * w4.w;
                    a1[4 * q4] += x1 * w4.x; a1[4 * q4 + 1] += x1 * w4.y; a1[4 * q4 + 2] += x1 * w4.z; a1[4 * q4 + 3] += x1 * w4.w; }
            }
            if (j < 7) P6_CHUNK_STORE((j + 1) & 1);
            __syncthreads();
        }
#undef P6_CHUNK_LOAD
#undef P6_CHUNK_STORE
        P6_RS_STEP(16, 32); P6_RS_STEP(8, 16); P6_RS_STEP(4, 8); P6_RS_STEP(2, 4); P6_RS_STEP(1, 2);
        const int e = lane >> 1; const float rbe = rb[e];
        float lg0 = a0[0] + __shfl_xor(a0[0], 1) + rbe, lg1 = a1[0] + __shfl_xor(a1[0], 1) + rbe;
#pragma unroll
        for (int tk = 0; tk < 2; ++tk) {
            const int tok = 2 * pair + tk; float val = tk ? lg1 : lg0; float vals[4]; int idxs[4];
#pragma unroll
            for (int k = 0; k < 4; ++k) {
                const float m = wave_max(val);
                const unsigned long long bal = __ballot(val == m);
                const int idx = (int)(__builtin_ctzll(bal) >> 1);
                vals[k] = m; idxs[k] = idx;
                if (e == idx) val = -3.0e38f;
            }
            const float e1 = expf(vals[1] - vals[0]), e2 = expf(vals[2] - vals[0]), e3 = expf(vals[3] - vals[0]);
            const float inv = 1.0f / (1.0f + e1 + e2 + e3);
            if (lane < 4) {
                const int sel_e = lane == 0 ? idxs[0] : lane == 1 ? idxs[1] : lane == 2 ? idxs[2] : idxs[3];
                const float sel_v = (lane == 0 ? 1.0f : lane == 1 ? e1 : lane == 2 ? e2 : e3) * inv;
                const unsigned pos = atomicAdd(cnt + 64 * sel_e, 1u);
                list[sel_e * T + pos] = tok * 4 + lane; tokw[tok * 4 + lane] = sel_v;
            }
        }
    }
}
#undef P6_RS_STEP

__device__ __forceinline__ void moe_build_tb(const Ctx& C) {
    LAS int* tb = (LAS int*)(C.lds + LDS_TB);
    __syncthreads();
    if (C.tid == 0) { const unsigned* cnt = (const unsigned*)(C.ws + WS_CTL) + CW_CNT; int acc = 0;
        for (int e = 0; e < NE; ++e) { const int n = (int)__hip_atomic_load(cnt + 64 * e, __ATOMIC_RELAXED, __HIP_MEMORY_SCOPE_AGENT); tb[e] = acc; tb[40 + e] = n; acc += (n + 255) >> 8; }
        tb[32] = acc; }
    __syncthreads();
}
__device__ __forceinline__ void phase7(const Ctx& C) {
    unsigned char* ws = C.ws; asm volatile("" : "+s"(ws));
    moe_build_tb(C);
    const LAS int* tb = (const LAS int*)(C.lds + LDS_TB);
    const bf16* x1b = (const bf16*)(ws + (size_t)X1B_T0 * MiB); bf16* abuf = (bf16*)(ws + (size_t)ABUF_T0 * MiB);
    const int* list = (const int*)(ws + WS_LIST); const float* tokw = (const float*)(ws + WS_TOKW);
    int* rowslot = (int*)(ws + WS_ROWSLOT); float* roww = (float*)(ws + WS_ROWW);
    const int total_rows = tb[32] * 256;
    for (int row = C.gw; row < total_rows; row += C.NGW) {
        int e = 0; const int rt = row >> 8;
        while (e < NE - 1 && tb[e + 1] <= rt) ++e;
        const int i = row - tb[e] * 256; const int n = tb[40 + e];
        v4u* dst = (v4u*)(abuf + (size_t)row * D);
        if (i < n) { const int slot = list[e * T + i]; const v4u* src = (const v4u*)(x1b + (size_t)(slot >> 2) * D);
#pragma unroll
            for (int j = 0; j < 4; ++j) dst[C.lane + 64 * j] = src[C.lane + 64 * j];
            if (C.lane == 0) { rowslot[row] = slot; roww[row] = tokw[slot]; } }
        else {
#pragma unroll
            for (int j = 0; j < 4; ++j) dst[C.lane + 64 * j] = (v4u){0u, 0u, 0u, 0u};
            if (C.lane == 0) { rowslot[row] = -1; roww[row] = 0.f; } }
    }
}
struct MoeOrder {
    const LAS int* tb; int NJ, a0, w0, G, c; const int* list; int gather;
    const LAS int* ul; const LAS int* rowt;
    __device__ __forceinline__ bool compute(int i, pg8::Unit& u) const {
        const int nwg = tb[32] * NJ; const int L = i * G + c; if (L >= nwg) return false;
        int w; { const int q = nwg / 8, r = nwg % 8, xcd = L % 8, off = L / 8; w = (xcd < r ? xcd * (q + 1) : r * (q + 1) + (xcd - r) * q) + off; }
        int e = 0;
        while (e < NE - 1 && tb[e + 1] * NJ <= w) ++e;
        const int local = w - tb[e] * NJ, nt = tb[e + 1] - tb[e], j = local / nt, ti = local - j * nt;
        u.pm = a0 + tb[e] + ti; u.pn = w0 + e * NJ + j; return true;
    }
    __device__ __forceinline__ bool next(int i, pg8::Unit& u) const {
        if (i < MOE_MAXU) { const int pm = __builtin_amdgcn_readfirstlane(ul[i]); if (pm < 0) return false; u.pm = pm; u.pn = __builtin_amdgcn_readfirstlane(ul[16 + i]); return true; }
        pg8::Unit t; const bool ok = compute(i, t); if (!ok) return false; u.pm = __builtin_amdgcn_readfirstlane(t.pm); u.pn = __builtin_amdgcn_readfirstlane(t.pn); return true;
    }
    __device__ __forceinline__ int row_slow(const pg8::Unit& u, int r) const { const int e = (u.pn - w0) / NJ; const int i = (u.pm - a0 - tb[e]) * 256 + r; return i < tb[40 + e] ? (list[e * T + i] >> 2) : 0; }
    __device__ __forceinline__ int a_row(const pg8::Unit& u, int idx, int r) const { if (!gather) return (u.pm - a0) * 256 + r; if (idx < MOE_MAXU) return rowt[idx * 256 + r]; return row_slow(u, r); }
    __device__ __forceinline__ int b_tile(const pg8::Unit& u) const { return u.pn - w0; }
    __device__ __forceinline__ void a_ready(const pg8::Unit&) const {}
    __device__ __forceinline__ void done(const pg8::Unit&) const {}
    __device__ __forceinline__ void setup(int tid) const {
        LAS int* ulw = (LAS int*)ul; LAS int* rtw = (LAS int*)rowt;
        if (tid < MOE_MAXU) { pg8::Unit t; const bool ok = compute(tid, t); ulw[tid] = ok ? t.pm : -1; ulw[16 + tid] = ok ? t.pn : 0; }
        __syncthreads();
        if (gather) for (int idx = tid; idx < MOE_MAXU * 256; idx += NTHREADS) { const int i = idx >> 8; const int pm = ul[i]; if (pm >= 0) { pg8::Unit t; t.pm = pm; t.pn = ul[16 + i]; rtw[idx] = row_slow(t, idx & 255); } }
        __syncthreads();
    }
};
struct EpiGU {
    static constexpr bool PERM = true, AFTER_DRAIN = false;
    const float* b_gu; bf16* act; float wsc;
    __device__ __forceinline__ void operator()(const pg8::f32x4 (&acc)[2][2][4][2], const pg8::Unit& u, int wr, int wc, int fr_, int fq_) const {
        int ln_ = threadIdx.x & 63; asm volatile("" : "+v"(ln_));
        const int fr = ln_ & 15, fq = ln_ >> 4;
        using pg8::cvt_pk_bf16;
        const int rt = u.pm - ABUF_T0, rel = u.pn - WGU_T0, e = rel >> 4, j = rel & 15;
        const int col0 = j * 128 + wc * 32 + 8 * fq;
        pg8::f32x4 bg[2], bu[2];
#pragma unroll
        for (int n = 0; n < 2; ++n) { bg[n] = *(const pg8::f32x4*)(b_gu + (size_t)e * 4096 + col0 + 4 * n); bu[n] = *(const pg8::f32x4*)(b_gu + (size_t)e * 4096 + 2048 + col0 + 4 * n); }
#pragma unroll
        for (int ai = 0; ai < 2; ++ai)
#pragma unroll
            for (int m = 0; m < 4; ++m) { const int row = rt * 256 + ai * 128 + wr * 64 + m * 16 + fr;
                float o[8];
#pragma unroll
                for (int n = 0; n < 2; ++n) { const pg8::f32x4 g = acc[ai][0][m][n] * wsc + bg[n], up = acc[ai][1][m][n] * wsc + bu[n];
#pragma unroll
                    for (int i = 0; i < 4; ++i) { const float gc = fminf(g[i], 7.0f), uc = fminf(fmaxf(up[i], -7.0f), 7.0f);
                        o[4 * n + i] = (uc + 1.0f) * (gc / (1.0f + __expf(-1.702f * gc))); } }
                v4u w; w.x = cvt_pk_bf16(o[0], o[1]); w.y = cvt_pk_bf16(o[2], o[3]); w.z = cvt_pk_bf16(o[4], o[5]); w.w = cvt_pk_bf16(o[6], o[7]);
                *(v4u*)(act + (size_t)row * DFF + col0) = w; }
    }
};
struct EpiNone {
    static constexpr bool PERM = true, AFTER_DRAIN = false; float* sink;
    __device__ __forceinline__ void operator()(const pg8::f32x4 (&acc)[2][2][4][2], const pg8::Unit& u, int wr, int wc, int fr, int fq) const {
        pg8::f32x4 t = acc[0][0][0][0];
#pragma unroll
        for (int ai = 0; ai < 2; ++ai)
#pragma unroll
            for (int bj = 0; bj < 2; ++bj)
#pragma unroll
                for (int m = 0; m < 4; ++m)
#pragma unroll
                    for (int n = 0; n < 2; ++n) t = t + acc[ai][bj][m][n];
        if (t[0] == 123.456f) sink[threadIdx.x] = t[1] + t[2] + t[3];
    }
};
struct EpiDown {
    static constexpr bool PERM = true, AFTER_DRAIN = false;
    const float* b_down; const int* list; const float* tokw; const LAS int* tb; bf16* ybuf; float wsc;
    __device__ __forceinline__ void operator()(const pg8::f32x4 (&acc)[2][2][4][2], const pg8::Unit& u, int wr, int wc, int fr_, int fq_) const {
        using pg8::cvt_pk_bf16;
        int ln_ = threadIdx.x & 63; asm volatile("" : "+v"(ln_));
        const int fr = ln_ & 15, fq = ln_ >> 4;
        const int rel = u.pn - WDN_T0, e = rel >> 3, j = rel & 7, ti = u.pm - ACT_T0 - tb[e], n_e = tb[40 + e];
        const int col0 = j * 256 + wc * 32 + 8 * fq;
        pg8::f32x4 bv[2][2];
#pragma unroll
        for (int bj = 0; bj < 2; ++bj)
#pragma unroll
            for (int n = 0; n < 2; ++n) bv[bj][n] = *(const pg8::f32x4*)(b_down + (size_t)e * D + col0 + bj * 128 + 4 * n);
#pragma unroll
        for (int ai = 0; ai < 2; ++ai)
#pragma unroll
            for (int m = 0; m < 4; ++m) { const int i = ti * 256 + ai * 128 + wr * 64 + m * 16 + fr;
                if (i < n_e) { const int slot = list[e * T + i]; const float w = tokw[slot]; bf16* dst = ybuf + (size_t)slot * D + col0;
#pragma unroll
                    for (int bj = 0; bj < 2; ++bj) { const pg8::f32x4 v0 = (acc[ai][bj][m][0] * wsc + bv[bj][0]) * w, v1 = (acc[ai][bj][m][1] * wsc + bv[bj][1]) * w;
                        v4u o; o.x = cvt_pk_bf16(v0[0], v0[1]); o.y = cvt_pk_bf16(v0[2], v0[3]); o.z = cvt_pk_bf16(v1[0], v1[1]); o.w = cvt_pk_bf16(v1[2], v1[3]);
                        *(v4u*)(dst + bj * 128) = o; } } }
    }
};

namespace pg8 {
template <class Epi, class Sched, class Side, int PROBE = 0>
__device__ __forceinline__ void gemm_phase_ga(PG8_LAS unsigned char* lds, const bf16_t* Arows, const bf16_t* Btiles, const int K, const Sched& S, const Epi& E, const Side& SD) {
    const int tid = threadIdx.x, wid = __builtin_amdgcn_readfirstlane(tid >> 6), lane = tid & 63, wr = wid >> 2, wc = wid & 3, fr = lane & 15, fq = lane >> 4;
    const int nt = K / BK;
    unsigned voffB[2];
#pragma unroll
    for (int i = 0; i < 2; ++i) { int R, Cc; stage_rc(tid * 16 + i * 8192, R, Cc); const int Rb = Epi::PERM ? ((R & ~31) + perm32(R & 31)) : R; voffB[i] = (unsigned)(Rb * K + Cc) * 2u; }
    const size_t kstep = (size_t)(BK * 2), hstep = (size_t)HALF * K * 2, tstep = 2 * hstep;
    const unsigned ldsw = (unsigned)wid * 1024u;
    const int aoff = lds_byte(wr * 64 + fr, fq * 8), boff = lds_byte(wc * 32 + fr, fq * 8);
#define PG8_SA(b, h) (((b) * 2 + (h)) * HTB)
#define PG8_SB(b, h) ((4 + (b) * 2 + (h)) * HTB)
#define PG8_STAGE(bufoff, gbase, voff) do { _Pragma("unroll") for (int _i = 0; _i < 2; ++_i) \
        __builtin_amdgcn_global_load_lds((const unsigned*)((const char*)(gbase) + (voff)[_i]), (PG8_LAS unsigned*)(lds + (bufoff) + ldsw + _i * 8192), 16, 0, 0); } while (0)
#define PG8_STAGE2(bufoff, gbase, v0, v1) do { \
        __builtin_amdgcn_global_load_lds((const unsigned*)((const char*)(gbase) + (v0)), (PG8_LAS unsigned*)(lds + (bufoff) + ldsw), 16, 0, 0); \
        __builtin_amdgcn_global_load_lds((const unsigned*)((const char*)(gbase) + (v1)), (PG8_LAS unsigned*)(lds + (bufoff) + ldsw + 8192), 16, 0, 0); } while (0)
#define PG8_LDA(dst, b, h) do { _Pragma("unroll") for (int m = 0; m < 4; ++m) _Pragma("unroll") for (int k = 0; k < ((PROBE & 1) ? 1 : 2); ++k) dst[m][k] = *(const PG8_LAS bf16x8*)(lds + PG8_SA(b, h) + aoff + m * 2048 + k * 1024); } while (0)
#define PG8_LDB(dst, b, h) do { _Pragma("unroll") for (int n = 0; n < 2; ++n) _Pragma("unroll") for (int k = 0; k < ((PROBE & 1) ? 1 : 2); ++k) dst[n][k] = *(const PG8_LAS bf16x8*)(lds + PG8_SB(b, h) + boff + n * 2048 + k * 1024); } while (0)
#define PG8_MMA(ai, bj, At, Bt) do { __builtin_amdgcn_s_setprio(1); _Pragma("unroll") for (int m = 0; m < 4; ++m) _Pragma("unroll") for (int n = 0; n < 2; ++n) _Pragma("unroll") for (int k = 0; k < ((PROBE & 2) ? 1 : 2); ++k) \
        acc[ai][bj][m][n] = __builtin_amdgcn_mfma_f32_16x16x32_bf16(Bt[n][k], At[m][k], acc[ai][bj][m][n], 0, 0, 0); __builtin_amdgcn_s_setprio(0); } while (0)
#define PG8_WAIT_V(n) asm volatile("s_waitcnt vmcnt(" #n ")" ::: "memory")
#define PG8_WAIT_L(n) asm volatile("s_waitcnt lgkmcnt(" #n ")" ::: "memory")
#define PG8_BAR __builtin_amdgcn_s_barrier()
#define PG8_SCHED __builtin_amdgcn_sched_barrier(0)
#define PG8_AROWS(vo, u, ix) do { int t_ = threadIdx.x; asm volatile("" : "+v"(t_)); _Pragma("unroll") for (int _i = 0; _i < 2; ++_i) { int R_, C_; stage_rc(t_ * 16 + _i * 8192, R_, C_); \
        _Pragma("unroll") for (int _h = 0; _h < 2; ++_h) vo[_h * 2 + _i] = (unsigned)S.a_row(u, ix, _h * 128 + R_) * (unsigned)(K * 2) + (unsigned)(C_ * 2); } } while (0)
    const int skh = wid >> 2, snq = wid & 3, sko = lane & 7, sng = lane >> 3;
    const unsigned sgv = Side::ON ? (unsigned)((4 * sko) * SD.ldb + 4 * sng) * 4u : 0u, sdv = (unsigned)(4 * sng) * 4096u + 8u * (unsigned)sko;
    const size_t sldb4 = Side::ON ? (size_t)SD.ldb * 4 : 0;
    int sstep = Side::ON ? SD.first : 0, sprev = 0, sit = 0, sext = 0, sage = 0; bool spend = false;
    f32x4 sx[4];
    typedef unsigned u32x2s __attribute__((ext_vector_type(2)));
#define PG8_SIDE_LOAD() do { const char* sp_ = (const char*)SD.src(sstep, skh, snq); _Pragma("unroll") for (int _j = 0; _j < 4; ++_j) \
        asm volatile("global_load_dwordx4 %0, %1, %2" : "=v"(sx[_j]) : "v"(sgv), "s"(sp_ + (size_t)_j * sldb4) : "memory"); sprev = sstep; sstep += SD.stride; } while (0)
#define PG8_SIDE_STORE() do { asm volatile("" : "+v"(sx[0]), "+v"(sx[1]), "+v"(sx[2]), "+v"(sx[3])); \
        char* dp_ = (char*)SD.dst(sprev, skh, snq); _Pragma("unroll") for (int _i = 0; _i < 4; ++_i) { u32x2s _w; \
            _w.x = cvt_pk_bf16(sx[0][_i], sx[1][_i]); _w.y = cvt_pk_bf16(sx[2][_i], sx[3][_i]); \
            asm volatile("global_store_dwordx2 %0, %1, %2" :: "v"(sdv), "v"(_w), "s"(dp_ + (size_t)_i * 4096) : "memory"); } } while (0)
#define PG8_SIDE_SLOT() do { if constexpr (Side::ON) { int ext_ = 0; if (spend) { if (++sage == Side::LAG) { if (Side::LAG == 1) PG8_WAIT_V(8); PG8_SIDE_STORE(); spend = false; ext_ += 4; } } \
        if (!spend && (sit % Side::PERIOD == 0) && (sstep < SD.nsteps)) { PG8_SIDE_LOAD(); spend = true; sage = 0; ext_ += 4; } ++sit; sext = ext_; } } while (0)
#define PG8_WAIT_K() do { if constexpr (Side::ON) { if (sext == 0) PG8_WAIT_V(8); else if (sext == 4) PG8_WAIT_V(12); else PG8_WAIT_V(16); } else PG8_WAIT_V(8); } while (0)
    Unit cur, nxt; int ui = 0;
    if (!S.next(0, cur)) {
        if constexpr (Side::ON) { while (sstep < SD.nsteps) { PG8_SIDE_LOAD(); PG8_WAIT_V(0); PG8_SIDE_STORE(); } PG8_WAIT_V(0); }
        return;
    }
    f32x4 acc[2][2][4][2];
#pragma unroll
    for (int a = 0; a < 2; ++a)
#pragma unroll
        for (int b = 0; b < 2; ++b)
#pragma unroll
            for (int m = 0; m < 4; ++m)
#pragma unroll
                for (int n = 0; n < 2; ++n) acc[a][b][m][n] = (f32x4){0.f, 0.f, 0.f, 0.f};
    bf16x8 At[4][2], B0[2][2], B1[2][2];
    unsigned voC[4], voN[4];
    PG8_AROWS(voC, cur, 0);
    const char* cA = (const char*)Arows; const char* cB = (const char*)Btiles + (size_t)cur.pn * tstep;
    PG8_STAGE(PG8_SB(0, 0), cB, voffB); PG8_STAGE(PG8_SB(0, 1), cB + hstep, voffB); PG8_STAGE2(PG8_SA(0, 0), cA, voC[0], voC[1]); PG8_STAGE2(PG8_SA(0, 1), cA, voC[2], voC[3]);
    if (wr == 1) PG8_BAR;
    PG8_WAIT_V(2); PG8_BAR;
    PG8_STAGE(PG8_SB(1, 0), cB + kstep, voffB); PG8_STAGE2(PG8_SA(1, 0), cA + kstep, voC[0], voC[1]); PG8_STAGE(PG8_SB(1, 1), cB + hstep + kstep, voffB);
    PG8_WAIT_V(6); PG8_BAR;
    for (;;) {
        const bool has_next = S.next(ui + 1, nxt);
        if (has_next) { PG8_AROWS(voN, nxt, ui + 1); } else {
#pragma unroll
            for (int q = 0; q < 4; ++q) voN[q] = voC[q]; }
        const char* nB = has_next ? (const char*)Btiles + (size_t)nxt.pn * tstep : cB;
        for (int t = 0; t < nt; t += 2) {
            const bool last = (t == nt - 2);
            const char* a1 = cA + (size_t)(t + 1) * kstep;
            const char* a2 = last ? cA : cA + (size_t)(t + 2) * kstep; const char* b2 = last ? nB : cB + (size_t)(t + 2) * kstep;
            const char* a3 = a2 + kstep; const char* b3 = b2 + kstep;
            const unsigned x0 = last ? voN[0] : voC[0], x1 = last ? voN[1] : voC[1], x2 = last ? voN[2] : voC[2], x3 = last ? voN[3] : voC[3];
            PG8_LDB(B0, 0, 0); PG8_LDB(B1, 0, 1); PG8_SCHED; PG8_LDA(At, 0, 0); PG8_STAGE2(PG8_SA(1, 1), a1, voC[2], voC[3]);
            PG8_WAIT_K(); PG8_WAIT_L(0); PG8_BAR; PG8_MMA(0, 0, At, B0); PG8_MMA(0, 1, At, B1); PG8_BAR; PG8_SCHED;
            PG8_LDA(At, 0, 1); PG8_STAGE(PG8_SB(0, 0), b2, voffB); PG8_STAGE(PG8_SB(0, 1), b2 + hstep, voffB); PG8_STAGE2(PG8_SA(0, 0), a2, x0, x1);
            PG8_WAIT_K(); PG8_SIDE_SLOT(); PG8_WAIT_L(0); PG8_BAR; PG8_MMA(1, 0, At, B0); PG8_MMA(1, 1, At, B1); PG8_BAR; PG8_SCHED;
            PG8_LDB(B0, 1, 0); PG8_LDB(B1, 1, 1); PG8_SCHED; PG8_LDA(At, 1, 0); PG8_STAGE2(PG8_SA(0, 1), a2, x2, x3);
            PG8_WAIT_K(); PG8_WAIT_L(0); PG8_BAR; PG8_MMA(0, 0, At, B0); PG8_MMA(0, 1, At, B1); PG8_BAR; PG8_SCHED;
            PG8_LDA(At, 1, 1); PG8_STAGE(PG8_SB(1, 0), b3, voffB); PG8_STAGE(PG8_SB(1, 1), b3 + hstep, voffB); PG8_STAGE2(PG8_SA(1, 0), a3, x0, x1);
            PG8_WAIT_K(); PG8_SIDE_SLOT(); PG8_WAIT_L(0); PG8_BAR; PG8_MMA(1, 0, At, B0); PG8_MMA(1, 1, At, B1); PG8_BAR; PG8_SCHED;
        }
        if (wr == 0) PG8_BAR;
        E(acc, cur, wr, wc, fr, fq); S.done(cur);
        if (!has_next) break;
#pragma unroll
        for (int a = 0; a < 2; ++a)
#pragma unroll
            for (int b = 0; b < 2; ++b)
#pragma unroll
                for (int m = 0; m < 4; ++m)
#pragma unroll
                    for (int n = 0; n < 2; ++n) acc[a][b][m][n] = (f32x4){0.f, 0.f, 0.f, 0.f};
        cur = nxt; cB = nB; ++ui;
#pragma unroll
        for (int q = 0; q < 4; ++q) voC[q] = voN[q];
        if (wr == 1) PG8_BAR;
    }
    PG8_WAIT_V(0);
    PG8_BAR;
    if constexpr (Side::ON) { if (spend) { PG8_SIDE_STORE(); } while (sstep < SD.nsteps) { PG8_SIDE_LOAD(); PG8_WAIT_V(0); PG8_SIDE_STORE(); } PG8_WAIT_V(0); }
#undef PG8_SA
#undef PG8_SB
#undef PG8_STAGE
#undef PG8_STAGE2
#undef PG8_LDA
#undef PG8_LDB
#undef PG8_MMA
#undef PG8_WAIT_V
#undef PG8_WAIT_L
#undef PG8_BAR
#undef PG8_SCHED
#undef PG8_AROWS
#undef PG8_SIDE_LOAD
#undef PG8_SIDE_STORE
#undef PG8_SIDE_SLOT
#undef PG8_WAIT_K
}
}

struct NoSide { static constexpr bool ON = false; static constexpr int PERIOD = 1, LAG = 1; int ldb, first, stride, nsteps;
    __device__ __forceinline__ const float* src(int, int, int) const { return nullptr; } __device__ __forceinline__ bf16* dst(int, int, int) const { return nullptr; } };
template <int PER, int LG> struct SideGU { static constexpr bool ON = true; static constexpr int PERIOD = PER, LAG = LG; const float* w; bf16* wt; int ldb, first, stride, nsteps;
    __device__ __forceinline__ const float* src(int hs, int kh, int nq) const { const int hh = hs & 1, st = hs >> 1, tile = st >> 5, tt = st & 31, e = tile >> 4, j = tile & 15;
        return w + (size_t)e * 2048 * 4096 + (size_t)(64 * tt + 32 * kh) * 4096 + (hh ? 2048 : 0) + 128 * j + 32 * nq; }
    __device__ __forceinline__ bf16* dst(int hs, int kh, int nq) const { const int hh = hs & 1, st = hs >> 1, tile = st >> 5, tt = st & 31; return wt + ((size_t)tile * 256 + 128 * hh + 32 * nq) * 2048 + 64 * tt + 32 * kh; } };
template <int PER, int LG> struct SideDown { static constexpr bool ON = true; static constexpr int PERIOD = PER, LAG = LG; const float* w; bf16* wt; int ldb, first, stride, nsteps;
    __device__ __forceinline__ const float* src(int hs, int kh, int nq) const { const int hh = hs & 1, st = hs >> 1, tile = st >> 5, tt = st & 31, e = tile >> 3, j = tile & 7;
        return w + (size_t)e * 2048 * 2048 + (size_t)(64 * tt + 32 * kh) * 2048 + 256 * j + 128 * hh + 32 * nq; }
    __device__ __forceinline__ bf16* dst(int hs, int kh, int nq) const { const int hh = hs & 1, st = hs >> 1, tile = st >> 5, tt = st & 31; return wt + ((size_t)tile * 256 + 128 * hh + 32 * nq) * 2048 + 64 * tt + 32 * kh; } };

__device__ __forceinline__ void phase10(const Ctx& C) {
    unsigned char* ws = C.ws; asm volatile("" : "+s"(ws));
    const bf16* x1b = (const bf16*)(ws + (size_t)X1B_T0 * MiB); const bf16* ybuf = (const bf16*)(ws + WS_YBUF);
    const float* g2 = C.A.in[26]; const float* b2 = C.A.in[27]; const int lane = C.lane;
    for (int tok = C.gw; tok < T; tok += C.NGW) {
        f32x4 v[8]; float s = 0.f;
#pragma unroll
        for (int j = 0; j < 8; ++j) { const int c0 = (lane + 64 * j) * 4; const v2u xw = *(const v2u*)(x1b + (size_t)tok * D + c0); f32x4 a = (f32x4){bflo(xw.x), bfhi(xw.x), bflo(xw.y), bfhi(xw.y)} * DN_ALPHA;
#pragma unroll
            for (int k = 0; k < 4; ++k) { const v2u yw = *(const v2u*)(ybuf + ((size_t)tok * 4 + k) * D + c0); a = a + (f32x4){bflo(yw.x), bfhi(yw.x), bflo(yw.y), bfhi(yw.y)}; }
            v[j] = a; s += (a.x + a.y) + (a.z + a.w); }
        const float mean = wave_sum(s) * (1.0f / D); float q = 0.f;
#pragma unroll
        for (int j = 0; j < 8; ++j) { v[j] = v[j] - mean; q += (v[j].x * v[j].x + v[j].y * v[j].y) + (v[j].z * v[j].z + v[j].w * v[j].w); }
        const float rstd = 1.0f / sqrtf(wave_sum(q) * (1.0f / D) + LN_EPS);
#pragma unroll
        for (int j = 0; j < 8; ++j) { const int c0 = (lane + 64 * j) * 4; const f32x4 gg = *(const f32x4*)(g2 + c0), bb = *(const f32x4*)(b2 + c0);
            *(f32x4*)(C.out + (size_t)tok * D + c0) = v[j] * rstd * gg + bb; }
    }
}

__global__ void __launch_bounds__(NTHREADS, 2) fwd_kernel(KArgs args) {
    extern __shared__ __attribute__((aligned(16))) unsigned char lds_raw[];
    const int tid_ = threadIdx.x, wave_ = __builtin_amdgcn_readfirstlane(tid_ >> 6), G_ = gridDim.x;
    Ctx C{args, args.out, args.ws, (LAS unsigned char*)lds_raw, tid_, tid_ & 63, wave_, G_, (int)blockIdx.x * NWAVES + wave_, G_ * NWAVES};
    volatile LAS unsigned* MISC = (volatile LAS unsigned*)(C.lds + LDS_MISC);
    if (C.tid < 4) MISC[C.tid] = 0u;
    __syncthreads();
    unsigned* ctl = (unsigned*)(args.ws + WS_CTL);
    XcdBarrier bar; bar.bar = ctl + CW_BAR; bar.x = 0; bar.st = MISC;
    const int lo = args.ph_lo, hi = args.ph_hi;
    if (hi - lo > 1) bar = xcd_barrier_post(ctl + CW_BAR, MISC);
#ifndef PHASE_MASK
#define PHASE_MASK 0x7ff
#endif
#define IN(k) (((PHASE_MASK >> (k)) & 1) && lo <= (k) && (k) < hi)
#define SEAM(k) do { if (IN(k) && IN((k) + 1)) xcd_barrier(bar); } while (0)
    const pg8::Gemm g{(const pg8::bf16_t*)args.ws, (const pg8::bf16_t*)args.ws, 0, 0, 2048};
    PG8_LAS unsigned char* glds = (PG8_LAS unsigned char*)lds_raw;

#ifndef PROBE_DOUBLE
#define PROBE_DOUBLE 0
#endif
#define REP(k) for (int _rep = 0; _rep < (((PROBE_DOUBLE >> (k)) & 1) ? 2 : 1); ++_rep)
    if (IN(0)) { REP(0) phase0(C); } SEAM(0);
    if (IN(1)) {
        Gemm1Order S{C.G, (int)blockIdx.x};
        unsigned char* ws = args.ws;
        Epi1 E{C.A.in[2], (bf16*)(ws + WS_HYT), (bf16*)(ws + WS_QKRAW), (bf16*)(ws + WS_VB), (bf16*)(ws + WS_OB), (float*)(ws + WS_GATES)};
#if MOE_SIDE
        { SideGU<SIDE_GU_PERIOD, SIDE_GU_LAG> SD{C.A.in[22], (bf16*)(ws + (size_t)WGU_T0 * MiB), 4096, (int)blockIdx.x, C.G, SIDE_GU_EXPERTS * 16 * 32 * 2};
          pg8::gemm_phase_ga<Epi1, Gemm1Order, SideGU<SIDE_GU_PERIOD, SIDE_GU_LAG>>(glds, (const pg8::bf16_t*)ws, (const pg8::bf16_t*)ws, 2048, S, E, SD); }
#else
        REP(1) pg8::gemm_phase<Epi1, Gemm1Order, true, true>(glds, g, S, E);
#endif
        { const pg8::Gemm g2{(const pg8::bf16_t*)(ws + WS_W3P), (const pg8::bf16_t*)(ws + WS_H2P), 0, 0, 256}; KtOrder S2{C.G, (int)blockIdx.x}; EpiKT E2{(float*)(ws + WS_KT)};
          pg8::gemm_phase<EpiKT, KtOrder, true, true>(glds, g2, S2, E2); }
    } SEAM(1);
    if (IN(2)) { REP(2) phase2(C); } SEAM(2);
    if (IN(3)) { REP(3) hyena_fft(C); REP(11) { if (NAIVE_ML) mlstm_naive(C); else mlstm_mfma(C); } } SEAM(3);
    if (IN(4)) { REP(4) phase4(C); } SEAM(4);
    if (IN(5)) {
        TileOrder S{32, 8, YCAT_T0, WOUT_T0, C.G, (int)blockIdx.x};
        EpiOut E{C.A.in[0], C.A.in[17], (float*)(args.ws + WS_R1)};
        REP(5) pg8::gemm_phase<EpiOut, TileOrder, true, true>(glds, g, S, E);
    } SEAM(5);
    if (IN(6)) { REP(6) phase6(C, _rep); } if (IN(6) && IN(8)) xcd_barrier(bar);
    if (IN(8)) {
        moe_build_tb(C);
        MoeOrder S{(const LAS int*)(C.lds + LDS_TB), 16, ABUF_T0, WGU_T0, C.G, (int)blockIdx.x, (const int*)(args.ws + WS_LIST), 1, (const LAS int*)(C.lds + LDS_UL), (const LAS int*)(C.lds + LDS_ROWT)};
        S.setup(C.tid);
        EpiGU E{C.A.in[23], (bf16*)(args.ws + (size_t)ACT_T0 * MiB), 1.0f};
#if MOE_SIDE
        { SideDown<SIDE_DN_PERIOD, SIDE_DN_LAG> SD{C.A.in[24], (bf16*)(args.ws + (size_t)WDN_T0 * MiB), 2048, (int)blockIdx.x, C.G, NE * 8 * 32 * 2};
          pg8::gemm_phase_ga<EpiGU, MoeOrder, SideDown<SIDE_DN_PERIOD, SIDE_DN_LAG>>(glds, (const pg8::bf16_t*)(args.ws + (size_t)X1B_T0 * MiB), (const pg8::bf16_t*)args.ws, 2048, S, E, SD); }
#else
        { NoSide SD{0, 0, 0, 0}; REP(8) pg8::gemm_phase_ga<EpiGU, MoeOrder, NoSide>(glds, (const pg8::bf16_t*)(args.ws + (size_t)X1B_T0 * MiB), (const pg8::bf16_t*)args.ws, 2048, S, E, SD); }
#endif
    } SEAM(8);
    if (IN(9)) {
        moe_build_tb(C);
        MoeOrder S{(const LAS int*)(C.lds + LDS_TB), 8, ACT_T0, WDN_T0, C.G, (int)blockIdx.x, (const int*)(args.ws + WS_LIST), 0, (const LAS int*)(C.lds + LDS_UL), (const LAS int*)(C.lds + LDS_ROWT)};
        S.setup(C.tid);
        EpiDown E{C.A.in[25], (const int*)(args.ws + WS_LIST), (const float*)(args.ws + WS_TOKW), (const LAS int*)(C.lds + LDS_TB), (bf16*)(args.ws + WS_YBUF), 1.0f};
        REP(9) pg8::gemm_phase<EpiDown, MoeOrder, true, true>(glds, g, S, E);
    } SEAM(9);
    if (IN(10)) { REP(10) phase10(C); }
#ifdef PROBE_BARRIERS
    if (hi - lo > 1) for (int i_ = 0; i_ < PROBE_BARRIERS; ++i_) xcd_barrier(bar);
#endif
#undef IN
#undef SEAM
}

extern "C" void kernel_launch(void* const* d_in, const int* in_sizes, int n_in, void* d_out, int out_size, void* d_ws, size_t ws_size, hipStream_t stream) {
    static int grid = 0;
    if (grid == 0) {
        if (n_in != 28 || in_sizes[0] != T * D || out_size != T * D || ws_size < WS_END) { fprintf(stderr, "kernel_launch: unexpected shapes (n_in %d, in0 %d, out %d, ws %zu)\n", n_in, n_in > 0 ? in_sizes[0] : -1, out_size, ws_size); grid = -1; return; }
        int dev = 0, cus = 0;
        if (hipGetDevice(&dev) != hipSuccess || hipDeviceGetAttribute(&cus, hipDeviceAttributeMultiprocessorCount, dev) != hipSuccess) { grid = -1; return; }
        if (hipFuncSetAttribute((const void*)fwd_kernel, hipFuncAttributeMaxDynamicSharedMemorySize, LDS_BYTES) != hipSuccess) { fprintf(stderr, "kernel_launch: hipFuncSetAttribute failed\n"); grid = -1; return; }
        int per_cu = 0;
        if (hipOccupancyMaxActiveBlocksPerMultiprocessor(&per_cu, (const void*)fwd_kernel, NTHREADS, LDS_BYTES) != hipSuccess || per_cu < 1) fprintf(stderr, "kernel_launch: occupancy query says %d\n", per_cu);
        (void)hipGetLastError();
        grid = cus;
    }
    if (grid < 0) return;
    if (hipMemsetAsync((char*)d_ws + WS_CTL, 0, CTL_ZERO_BYTES, stream) != hipSuccess) return;
    KArgs a{};
    for (int i = 0; i < 28; ++i) a.in[i] = (const float*)d_in[i];
    a.out = (float*)d_out; a.ws = (unsigned char*)d_ws;
#if MK_ONE_LAUNCH
    a.ph_lo = 0; a.ph_hi = N_PHASES;
    hipLaunchKernelGGL(fwd_kernel, dim3(grid), dim3(NTHREADS), LDS_BYTES, stream, a);
#else
    for (int ph = 0; ph < N_PHASES; ++ph) { a.ph_lo = ph; a.ph_hi = ph + 1; hipLaunchKernelGGL(fwd_kernel, dim3(grid), dim3(NTHREADS), LDS_BYTES, stream, a); }
#endif
}
```

```cpp
#include <hip/hip_runtime.h>
#include <cstdio>
#include <cstdint>

namespace pg8 {
#define PG8_LAS __attribute__((address_space(3)))
typedef unsigned short bf16_t;
typedef short bf16x8 __attribute__((ext_vector_type(8)));
typedef float f32x4 __attribute__((ext_vector_type(4)));
typedef unsigned u32x4 __attribute__((ext_vector_type(4)));
constexpr int BM = 256, BK = 64, HALF = 128, HTB = HALF * BK * 2  , STAGE_BYTES = 8 * HTB, NXCD = 8, WGM = 8;

__host__ __device__ __forceinline__ int lds_byte(int r, int c) { const int st = (r >> 4) * 2 + (c >> 5), rr = r & 15, cc = c & 31, ob = rr * 64 + cc * 2; return st * 1024 + (ob ^ (((ob >> 9) & 1) << 5)); }
__host__ __device__ __forceinline__ void stage_rc(int b, int& R, int& C) { const int st = b / 1024, sb = b % 1024, swz = sb ^ (((sb >> 9) & 1) << 5); R = (st >> 1) * 16 + swz / 64; C = (st & 1) * 32 + (swz % 64) / 2; }
__host__ __device__ __forceinline__ int perm32(int rho) { const int n = rho >> 4, i = rho & 15; return 8 * (i >> 2) + 4 * n + (i & 3); }

struct Unit { int pm, pn; };
struct Gemm { const bf16_t* A; const bf16_t* Bt; int M, N, K; };
__device__ __forceinline__ unsigned cvt_pk_bf16(float lo, float hi) { unsigned r; asm volatile("v_cvt_pk_bf16_f32 %0, %1, %2" : "=v"(r) : "v"(lo), "v"(hi)); return r; }
typedef float f32x2 __attribute__((ext_vector_type(2)));
typedef int i32x4 __attribute__((ext_vector_type(4)));
typedef int i32x8 __attribute__((ext_vector_type(8)));
typedef long i64x2 __attribute__((ext_vector_type(2)));
template <class E, class = void> struct epi_f8 { static constexpr bool v = false; };
template <class E> struct epi_f8<E, decltype((void)E::F8)> { static constexpr bool v = E::F8; };
__device__ __forceinline__ i32x8 cat8(const bf16x8 a, const bf16x8 b) { const i32x4 x = __builtin_bit_cast(i32x4, a), y = __builtin_bit_cast(i32x4, b); return (i32x8){x.x, x.y, x.z, x.w, y.x, y.y, y.z, y.w}; }
template <class Epi, class Sched, bool ALIGN_EPI = false, bool SP2 = false>
__device__ __forceinline__ void gemm_phase(PG8_LAS unsigned char* lds, const Gemm g, const Sched& S, const Epi& E) {
    const int tid = threadIdx.x, wid = __builtin_amdgcn_readfirstlane(tid >> 6), lane = tid & 63, wr = wid >> 2, wc = wid & 3, fr = lane & 15, fq = lane >> 4;
    const int K = g.K, nt = K / BK;
    unsigned voffA[2], voffB[2];
#pragma unroll
    for (int i = 0; i < 2; ++i) { int R, C; stage_rc(tid * 16 + i * 8192, R, C); const int Rb = Epi::PERM ? ((R & ~31) + perm32(R & 31)) : R;
        voffA[i] = (unsigned)(R * K + C) * 2u; voffB[i] = (unsigned)(Rb * K + C) * 2u; }
    const size_t kstep = (size_t)(BK * 2);
    const size_t hstep = (size_t)HALF * K * 2;
    const size_t tstep = 2 * hstep;
    const unsigned ldsw = (unsigned)wid * 1024u;
    const int aoff = lds_byte(wr * 64 + fr, fq * 8), boff = lds_byte(wc * 32 + fr, fq * 8);
#define PG8_SA(b, h) (((b) * 2 + (h)) * HTB)
#define PG8_SB(b, h) ((4 + (b) * 2 + (h)) * HTB)
#define PG8_STAGE(bufoff, gbase, voff) do { _Pragma("unroll") for (int _i = 0; _i < 2; ++_i) \
        __builtin_amdgcn_global_load_lds((const unsigned*)((const char*)(gbase) + (voff)[_i]), (PG8_LAS unsigned*)(lds + (bufoff) + ldsw + _i * 8192), 16, 0, 0); } while (0)
#define PG8_LDA(dst, b, h) do { _Pragma("unroll") for (int m = 0; m < 4; ++m) _Pragma("unroll") for (int k = 0; k < 2; ++k) dst[m][k] = *(const PG8_LAS bf16x8*)(lds + PG8_SA(b, h) + aoff + m * 2048 + k * 1024); } while (0)
#define PG8_LDB(dst, b, h) do { _Pragma("unroll") for (int n = 0; n < 2; ++n) _Pragma("unroll") for (int k = 0; k < 2; ++k) dst[n][k] = *(const PG8_LAS bf16x8*)(lds + PG8_SB(b, h) + boff + n * 2048 + k * 1024); } while (0)
#define PG8_MMA(ai, bj, At, Bt) do { __builtin_amdgcn_s_setprio(1); if constexpr (epi_f8<Epi>::v) { _Pragma("unroll") for (int m = 0; m < 4; ++m) _Pragma("unroll") for (int n = 0; n < 2; ++n) \
        { const i32x8 b_ = cat8(Bt[n][0], Bt[n][1]), a_ = cat8(At[m][0], At[m][1]); \
        asm volatile("v_mfma_f32_16x16x128_f8f6f4 %0, %1, %2, %0" : "+v"(acc[ai][bj][m][n]) : "v"(b_), "v"(a_)); } } else { \
        _Pragma("unroll") for (int m = 0; m < 4; ++m) _Pragma("unroll") for (int n = 0; n < 2; ++n) _Pragma("unroll") for (int k = 0; k < 2; ++k) \
        acc[ai][bj][m][n] = __builtin_amdgcn_mfma_f32_16x16x32_bf16(Bt[n][k], At[m][k], acc[ai][bj][m][n], 0, 0, 0); } __builtin_amdgcn_s_setprio(0); } while (0)
#define PG8_WAIT_V(n) asm volatile("s_waitcnt vmcnt(" #n ")" ::: "memory")
#define PG8_WAIT_L(n) asm volatile("s_waitcnt lgkmcnt(" #n ")" ::: "memory")
#define PG8_BAR __builtin_amdgcn_s_barrier()
#define PG8_SCHED __builtin_amdgcn_sched_barrier(0)
    Unit cur, nxt; int ui = 0;
    if (!S.next(0, cur)) return;
    f32x4 acc[2][2][4][2];
#pragma unroll
    for (int a = 0; a < 2; ++a)
#pragma unroll
        for (int b = 0; b < 2; ++b)
#pragma unroll
            for (int m = 0; m < 4; ++m)
#pragma unroll
                for (int n = 0; n < 2; ++n) acc[a][b][m][n] = (f32x4){0.f, 0.f, 0.f, 0.f};
    bf16x8 At[4][2], B0[2][2], B1[2][2];
    const char* cA = (const char*)g.A + (size_t)cur.pm * tstep; const char* cB = (const char*)g.Bt + (size_t)cur.pn * tstep;
    S.a_ready(cur);
    if constexpr (SP2) {
        PG8_STAGE(PG8_SB(0, 0), cB, voffB); PG8_STAGE(PG8_SB(0, 1), cB + hstep, voffB); PG8_STAGE(PG8_SA(0, 0), cA, voffA); PG8_STAGE(PG8_SA(0, 1), cA + hstep, voffA);
        if (wr == 1) PG8_BAR;
        PG8_WAIT_V(2); PG8_BAR;
        PG8_STAGE(PG8_SB(1, 0), cB + kstep, voffB); PG8_STAGE(PG8_SA(1, 0), cA + kstep, voffA); PG8_STAGE(PG8_SB(1, 1), cB + hstep + kstep, voffB);
        PG8_WAIT_V(6); PG8_BAR;
    } else {
        PG8_STAGE(PG8_SB(0, 0), cB, voffB); PG8_STAGE(PG8_SA(0, 0), cA, voffA); PG8_STAGE(PG8_SB(0, 1), cB + hstep, voffB); PG8_STAGE(PG8_SA(0, 1), cA + hstep, voffA);
        if (wr == 1) PG8_BAR;
        PG8_WAIT_V(4); PG8_BAR;
        PG8_STAGE(PG8_SB(1, 0), cB + kstep, voffB); PG8_STAGE(PG8_SA(1, 0), cA + kstep, voffA); PG8_STAGE(PG8_SB(1, 1), cB + hstep + kstep, voffB);
        PG8_WAIT_V(6); PG8_BAR;
    }
    for (;;) {
        const bool has_next = S.next(ui + 1, nxt);
        const char* nA = has_next ? (const char*)g.A + (size_t)nxt.pm * tstep : cA; const char* nB = has_next ? (const char*)g.Bt + (size_t)nxt.pn * tstep : cB;
        for (int t = 0; t < nt; t += 2) {
            const bool last = (t == nt - 2);
            const char* a1 = cA + (size_t)(t + 1) * kstep;
            const char* a2 = last ? nA : cA + (size_t)(t + 2) * kstep; const char* b2 = last ? nB : cB + (size_t)(t + 2) * kstep;
            const char* a3 = a2 + kstep; const char* b3 = b2 + kstep;
            if (last && has_next) S.a_ready(nxt);
            if constexpr (SP2) {
            PG8_LDB(B0, 0, 0); PG8_LDB(B1, 0, 1); PG8_SCHED; PG8_LDA(At, 0, 0); PG8_STAGE(PG8_SA(1, 1), a1 + hstep, voffA);
            PG8_WAIT_V(8); PG8_WAIT_L(0); PG8_BAR; PG8_MMA(0, 0, At, B0); PG8_MMA(0, 1, At, B1); PG8_BAR; PG8_SCHED;
            PG8_LDA(At, 0, 1); PG8_STAGE(PG8_SB(0, 0), b2, voffB); PG8_STAGE(PG8_SB(0, 1), b2 + hstep, voffB); PG8_STAGE(PG8_SA(0, 0), a2, voffA);
            PG8_WAIT_V(8); PG8_WAIT_L(0); PG8_BAR; PG8_MMA(1, 0, At, B0); PG8_MMA(1, 1, At, B1); PG8_BAR; PG8_SCHED;
            PG8_LDB(B0, 1, 0); PG8_LDB(B1, 1, 1); PG8_SCHED; PG8_LDA(At, 1, 0); PG8_STAGE(PG8_SA(0, 1), a2 + hstep, voffA);
            PG8_WAIT_V(8); PG8_WAIT_L(0); PG8_BAR; PG8_MMA(0, 0, At, B0); PG8_MMA(0, 1, At, B1); PG8_BAR; PG8_SCHED;
            PG8_LDA(At, 1, 1); PG8_STAGE(PG8_SB(1, 0), b3, voffB); PG8_STAGE(PG8_SB(1, 1), b3 + hstep, voffB); PG8_STAGE(PG8_SA(1, 0), a3, voffA);
            PG8_WAIT_V(8); PG8_WAIT_L(0); PG8_BAR; PG8_MMA(1, 0, At, B0); PG8_MMA(1, 1, At, B1); PG8_BAR; PG8_SCHED;
            } else {
            PG8_LDB(B0, 0, 0); PG8_SCHED; PG8_LDA(At, 0, 0); PG8_STAGE(PG8_SA(1, 1), a1 + hstep, voffA);
            PG8_WAIT_L(8); PG8_BAR; PG8_WAIT_L(0); PG8_MMA(0, 0, At, B0); PG8_BAR; PG8_SCHED;
            PG8_LDB(B1, 0, 1); PG8_STAGE(PG8_SB(0, 0), b2, voffB);
            PG8_BAR; PG8_WAIT_L(0); PG8_MMA(0, 1, At, B1); PG8_BAR;
            PG8_LDA(At, 0, 1); PG8_STAGE(PG8_SA(0, 0), a2, voffA);
            PG8_BAR; PG8_WAIT_L(0); PG8_MMA(1, 0, At, B0); PG8_BAR; PG8_SCHED;
            PG8_STAGE(PG8_SB(0, 1), b2 + hstep, voffB);
            PG8_WAIT_V(6); PG8_BAR; PG8_MMA(1, 1, At, B1); PG8_BAR;
            PG8_LDB(B0, 1, 0); PG8_SCHED; PG8_LDA(At, 1, 0); PG8_STAGE(PG8_SA(0, 1), a2 + hstep, voffA);
            PG8_WAIT_L(8); PG8_BAR; PG8_WAIT_L(0); PG8_MMA(0, 0, At, B0); PG8_BAR; PG8_SCHED;
            PG8_LDB(B1, 1, 1); PG8_STAGE(PG8_SB(1, 0), b3, voffB);
            PG8_BAR; PG8_WAIT_L(0); PG8_MMA(0, 1, At, B1); PG8_BAR;
            PG8_LDA(At, 1, 1); PG8_STAGE(PG8_SA(1, 0), a3, voffA);
            PG8_BAR; PG8_WAIT_L(0); PG8_MMA(1, 0, At, B0); PG8_BAR; PG8_SCHED;
            PG8_STAGE(PG8_SB(1, 1), b3 + hstep, voffB);
            PG8_WAIT_V(6); PG8_BAR; PG8_MMA(1, 1, At, B1); PG8_BAR;
            }
        }
        if constexpr (ALIGN_EPI) { if (wr == 0) PG8_BAR; }
        if constexpr (epi_f8<Epi>::v) asm volatile("s_nop 7\n\ts_nop 7\n\ts_nop 7\n\ts_nop 7");
        if constexpr (!Epi::AFTER_DRAIN) { E(acc, cur, wr, wc, fr, fq); S.done(cur); }
        if (!has_next) break;
#pragma unroll
        for (int a = 0; a < 2; ++a)
#pragma unroll
            for (int b = 0; b < 2; ++b)
#pragma unroll
                for (int m = 0; m < 4; ++m)
#pragma unroll
                    for (int n = 0; n < 2; ++n) acc[a][b][m][n] = (f32x4){0.f, 0.f, 0.f, 0.f};
        cur = nxt; cA = nA; cB = nB; ++ui;
        if constexpr (ALIGN_EPI) { if (wr == 1) PG8_BAR; }
    }
    PG8_WAIT_V(0);
    if constexpr (!ALIGN_EPI) { if (wr == 0) PG8_BAR; }
    PG8_BAR;
    if constexpr (Epi::AFTER_DRAIN) { E.fused(acc, cur, wr, wc, fr, fq, lds, wid, lane); S.done(cur); }
#undef PG8_SA
#undef PG8_SB
#undef PG8_STAGE
#undef PG8_LDA
#undef PG8_LDB
#undef PG8_MMA
#undef PG8_WAIT_V
#undef PG8_WAIT_L
#undef PG8_BAR
#undef PG8_SCHED
}
}

constexpr int NB = 4, SEQ = 2048, T = NB * SEQ, D = 2048, DHY = 1024, DML = 1024, DIN = 7200, NE = 32, TOPK = 4, NH = 8, HD = 128, DFF = 2048;
constexpr float LN_EPS = 1e-5f, DN_ALPHA = 1.189207115002721f;
constexpr int NWAVES = 8, NTHREADS = 512;
#ifndef MK_ONE_LAUNCH
#define MK_ONE_LAUNCH 1
#endif
constexpr int N_PHASES = 11;
#ifndef MOE_PRECONVERT
#define MOE_PRECONVERT 1
#endif
#ifndef SIDE_GU_PERIOD
#define SIDE_GU_PERIOD 1
#define SIDE_GU_LAG 1
#endif
#ifndef SIDE_DN_PERIOD
#define SIDE_DN_PERIOD 2
#define SIDE_DN_LAG 2
#endif
#ifndef SIDE_GU_EXPERTS
#define SIDE_GU_EXPERTS 32
#endif
#ifndef OUTPROJ_F8
#define OUTPROJ_F8 1
#endif
#ifndef HY_SETS
#define HY_SETS 2
#endif
#ifndef PROBE_SIDE_DUMMY
#define PROBE_SIDE_DUMMY 0
#endif
#ifndef MOE_SIDE
#define MOE_SIDE 1
#endif

constexpr size_t MiB = 1u << 20;
constexpr size_t WS_CTL = 0, CTL_ZERO_BYTES = 1 * MiB;
constexpr size_t WS_H2P = 1936 * MiB;
constexpr size_t WS_W3P = 1937 * MiB;
constexpr size_t WS_GATES = 2 * MiB;
constexpr size_t WS_TOKW = 3 * MiB;
constexpr size_t WS_LIST = 4 * MiB;
constexpr size_t WS_ROWSLOT = 5 * MiB;
constexpr size_t WS_ROWW = 5 * MiB + 512 * 1024;
constexpr size_t WS_GA = 6 * MiB, WS_GP = 6 * MiB + 512 * 1024, WS_GE = 7 * MiB;
constexpr size_t TILE_BYTES = 256 * 2048 * 2;
constexpr int XB_T0 = 8, WIN_T0 = 40, WOUT_T0 = 72, YCAT_T0 = 80, X1B_T0 = 112, ABUF_T0 = 144, ACT_T0 = 304, WGU_T0 = 464, WDN_T0 = 976;
constexpr size_t WS_HYT = 1232 * MiB;
constexpr size_t WS_QKRAW = 1296 * MiB;
constexpr size_t WS_OB = 1328 * MiB;
constexpr size_t WS_QKC = 1344 * MiB;
constexpr size_t WS_KT = 1376 * MiB;
constexpr size_t WS_KF = 1840 * MiB;
constexpr size_t WS_ZT = 1904 * MiB;
constexpr size_t WS_Z = 1408 * MiB;
constexpr size_t WS_HML = 1440 * MiB;
constexpr size_t WS_R1 = 1504 * MiB;
constexpr int WGU_Q0 = 2 * WGU_T0, WDN_Q0 = 2 * WDN_T0, ACT_Q0 = 2 * ACT_T0;
constexpr size_t WS_X1Q = (size_t)ABUF_T0 * MiB;
constexpr float Y8_SCALE = 16.0f;
constexpr float W8_SCALE = 256.0f;
constexpr int DN_STEPS = NE * 8 * 16 * 4;
constexpr size_t WS_YBUF = 1568 * MiB;
constexpr size_t WS_VB = 1824 * MiB;
constexpr size_t WS_END = 1940 * MiB;
constexpr int CW_BAR = 4096, CW_CNT = 16384;

constexpr int LDS_STAGE = 131072, LDS_MISC = LDS_STAGE, LDS_TB = LDS_STAGE + 64, LDS_UL = LDS_STAGE + 512, LDS_ROWT = LDS_STAGE + 1024, MOE_MAXU = 10, LDS_VON = 143360  , LDS_BYTES = 147456;
static_assert(LDS_ROWT + MOE_MAXU * 256 * 4 <= LDS_VON && LDS_VON + 512 * 8 <= LDS_BYTES && LDS_BYTES <= 163840, "LDS map");

#define GAS __attribute__((address_space(1)))
#define LAS __attribute__((address_space(3)))
typedef unsigned short bf16;
typedef unsigned v4u __attribute__((ext_vector_type(4)));
typedef unsigned v2u __attribute__((ext_vector_type(2)));
typedef float f32x4 __attribute__((ext_vector_type(4)));
typedef float f32x2 __attribute__((ext_vector_type(2)));
#define LDS_WAIT() asm volatile("s_waitcnt lgkmcnt(0)" ::: "memory")
__device__ __forceinline__ unsigned f2bf(float f) { unsigned u = __builtin_bit_cast(unsigned, f); return (u + 0x7fffu + ((u >> 16) & 1u)) >> 16; }
__device__ __forceinline__ unsigned pk2(float lo, float hi) { return f2bf(lo) | (f2bf(hi) << 16); }
__device__ __forceinline__ unsigned pk4_fp8(float a, float b, float c, float d) { unsigned w = 0u; w = __builtin_amdgcn_cvt_pk_fp8_f32(a, b, w, false); w = __builtin_amdgcn_cvt_pk_fp8_f32(c, d, w, true); return w; }
__device__ __forceinline__ float bflo(unsigned w) { return __builtin_bit_cast(float, w << 16); }
__device__ __forceinline__ float bfhi(unsigned w) { return __builtin_bit_cast(float, w & 0xffff0000u); }
__device__ __forceinline__ float bf2f(bf16 b) { return __builtin_bit_cast(float, (unsigned)b << 16); }
__device__ __forceinline__ float wave_sum(float v) {
#pragma unroll
    for (int o = 1; o < 64; o <<= 1) v += __shfl_xor(v, o);
    return v;
}
__device__ __forceinline__ float wave_max(float v) {
#pragma unroll
    for (int o = 1; o < 64; o <<= 1) v = fmaxf(v, __shfl_xor(v, o));
    return v;
}

#define XB_TMO      128
#define XB_XCNT(j)  (256  + 64 * (j))
#define XB_XSUB(j)  (1280 + 64 * (j))
#define XB_XGEN(j)  (2304 + 64 * (j))
#define XB_TOP      3328
#define XB_TOPGEN   3392
#define XCD_BAR_WORDS 3456
#define XB_SPIN_CAP (1u << 22)

__device__ __forceinline__ unsigned xb_ld(unsigned* p)              { return __hip_atomic_load(p, __ATOMIC_RELAXED, __HIP_MEMORY_SCOPE_AGENT); }
__device__ __forceinline__ unsigned xb_add(unsigned* p, unsigned v) { return __hip_atomic_fetch_add(p, v, __ATOMIC_RELAXED, __HIP_MEMORY_SCOPE_AGENT); }
__device__ __forceinline__ unsigned xb_xcc_id() { return (unsigned)__builtin_amdgcn_s_getreg((3 << 11) | 20) & 0xFu; }
#define XB_SPIN(cond, bar) do { unsigned _sp = 0; while (cond) { __builtin_amdgcn_s_sleep(1); \
    if ((++_sp & 255u) == 0u) { if (xb_ld(&(bar)[XB_TMO])) break; if (_sp > XB_SPIN_CAP) { atomicAdd(&(bar)[XB_TMO], 1u); break; } } } } while (0)

struct XcdBarrier {
    unsigned* bar; unsigned x;
    volatile LAS unsigned* st;
};

__device__ __forceinline__ XcdBarrier xcd_barrier_post(unsigned* bar, volatile LAS unsigned* st) {
    XcdBarrier b; b.bar = bar; b.x = xb_xcc_id(); b.st = st;
    if (threadIdx.x == 0) (void)xb_add(&bar[XB_XCNT(b.x)], 1u);
    return b;
}
__device__ __forceinline__ void xcd_barrier_complete(unsigned* bar, unsigned x, unsigned& nloc, unsigned& nx) {
    const unsigned G = gridDim.x * gridDim.y * gridDim.z;
    unsigned sum, cnt, mine, sp = 0u;
    for (;;) {
        sum = 0u; cnt = 0u; mine = 0u;
#pragma unroll
        for (unsigned j = 0; j < 16; ++j) { const unsigned c = xb_ld(&bar[XB_XCNT(j)]); sum += c; cnt += (c > 0u) ? 1u : 0u; mine = (j == x) ? c : mine; }
        if (sum == G) break;
        __builtin_amdgcn_s_sleep(1);
        if ((++sp & 255u) == 0u) { if (xb_ld(&bar[XB_TMO])) break; if (sp > XB_SPIN_CAP) { atomicAdd(&bar[XB_TMO], 1u); break; } }
    }
    nloc = mine > 0u ? mine : 1u; nx = cnt > 0u ? cnt : 1u;
}

__device__ __forceinline__ void xcd_barrier(const XcdBarrier& b) {
    asm volatile("s_waitcnt vmcnt(0)" ::: "memory");
    __syncthreads();
    if (threadIdx.x == 0) {
        unsigned* bar = b.bar;
        __builtin_amdgcn_s_waitcnt(0);
        unsigned nloc = b.st[0], nx = b.st[1];
        if (nloc == 0u) { xcd_barrier_complete(bar, b.x, nloc, nx); b.st[0] = nloc; b.st[1] = nx; }
        const unsigned old = xb_add(&bar[XB_XSUB(b.x)], 1u);
        const unsigned gen = old / nloc;
        if (old + 1u == (gen + 1u) * nloc) {
            __builtin_amdgcn_fence(__ATOMIC_RELEASE, "agent");
            asm volatile("s_waitcnt vmcnt(0)" ::: "memory");
            const unsigned og = xb_add(&bar[XB_TOP], 1u);
            const unsigned tg = og / nx;
            if (og + 1u == (tg + 1u) * nx) xb_add(&bar[XB_TOPGEN], 1u);
            else XB_SPIN(xb_ld(&bar[XB_TOPGEN]) == tg, bar);
            __builtin_amdgcn_fence(__ATOMIC_ACQUIRE, "agent");
            xb_add(&bar[XB_XGEN(b.x)], 1u);
            asm volatile("s_waitcnt vmcnt(0)" ::: "memory");
        } else {
            XB_SPIN(xb_ld(&bar[XB_XGEN(b.x)]) == gen, bar);
            __builtin_amdgcn_fence(__ATOMIC_ACQUIRE, "agent");
            asm volatile("s_waitcnt vmcnt(0)" ::: "memory");
        }
    }
    __syncthreads();
}


#ifndef FFT_HD
#define FFT_HD __device__ __forceinline__
#define FFT_LDS LAS
#endif
constexpr int FFT_WORDS = 4096 + 1024 + 256;
FFT_HD int fidx(int i) { return i + 4 * (i >> 4) + 16 * (i >> 8); }

template <bool INV> FFT_HD void dft4(float& ar, float& ai, float& br, float& bi, float& cr, float& ci, float& dr, float& di) {
    const float s0r = ar + cr, s0i = ai + ci, s1r = ar - cr, s1i = ai - ci;
    const float s2r = br + dr, s2i = bi + di, s3r = br - dr, s3i = bi - di;
    ar = s0r + s2r; ai = s0i + s2i;
    cr = s0r - s2r; ci = s0i - s2i;
    if (!INV) { br = s1r + s3i; bi = s1i - s3r; dr = s1r - s3i; di = s1i + s3r; }
    else      { br = s1r - s3i; bi = s1i + s3r; dr = s1r + s3i; di = s1i - s3r; }
}
template <bool INV> FFT_HD void dft16(float (&xr)[16], float (&xi)[16]) {
#pragma unroll
    for (int n0 = 0; n0 < 4; ++n0) dft4<INV>(xr[n0], xi[n0], xr[n0 + 4], xi[n0 + 4], xr[n0 + 8], xi[n0 + 8], xr[n0 + 12], xi[n0 + 12]);
    constexpr float C1 = 0.9238795325112867f, S1 = 0.3826834323650898f, C2 = 0.7071067811865476f;
    const float tc[10] = {1.f, C1, C2, S1, 0.f, -S1, -C2, -C1, -1.f, -C1};
    const float ts[10] = {0.f, S1, C2, C1, 1.f, C1, C2, S1, 0.f, -S1};
#pragma unroll
    for (int n0 = 1; n0 < 4; ++n0)
#pragma unroll
        for (int k0 = 1; k0 < 4; ++k0) { const int m = n0 * k0; const float wr = tc[m], wi = INV ? ts[m] : -ts[m];
            const int id = n0 + 4 * k0; const float r = xr[id] * wr - xi[id] * wi, i = xr[id] * wi + xi[id] * wr; xr[id] = r; xi[id] = i; }
#pragma unroll
    for (int k0 = 0; k0 < 4; ++k0) dft4<INV>(xr[4 * k0], xi[4 * k0], xr[4 * k0 + 1], xi[4 * k0 + 1], xr[4 * k0 + 2], xi[4 * k0 + 2], xr[4 * k0 + 3], xi[4 * k0 + 3]);
#pragma unroll
    for (int a = 0; a < 4; ++a)
#pragma unroll
        for (int b = a + 1; b < 4; ++b) { float t = xr[4 * a + b]; xr[4 * a + b] = xr[4 * b + a]; xr[4 * b + a] = t; t = xi[4 * a + b]; xi[4 * a + b] = xi[4 * b + a]; xi[4 * b + a] = t; }
}
template <bool INV> FFT_HD void twiddle16(float (&xr)[16], float (&xi)[16], int j, int n) {
    float s, c;
#ifdef __HIP_DEVICE_COMPILE__
    asm volatile("" : "+v"(j));
    sincospif(2.0f * (float)j / (float)n, &s, &c);
#else
    s = (float)sin(2.0 * 3.14159265358979323846 * j / n); c = (float)cos(2.0 * 3.14159265358979323846 * j / n);
#endif
    const float wr = c, wi = INV ? s : -s;
    float pr = wr, pi = wi;
#pragma unroll
    for (int k = 1; k < 16; ++k) {
        const float r = xr[k] * pr - xi[k] * pi, i = xr[k] * pi + xi[k] * pr; xr[k] = r; xi[k] = i;
        const float nr = pr * wr - pi * wi, ni = pr * wi + pi * wr; pr = nr; pi = ni;
    }
}
FFT_HD void fft_store_s256(FFT_LDS float* re, FFT_LDS float* im, int g, const float (&xr)[16], const float (&xi)[16]) {
    const int a0 = fidx(g);
#pragma unroll
    for (int k = 0; k < 16; ++k) { re[a0 + 336 * k] = xr[k]; im[a0 + 336 * k] = xi[k]; }
}
FFT_HD void fft_load_s256(const FFT_LDS float* re, const FFT_LDS float* im, int g, float (&xr)[16], float (&xi)[16]) {
    const int a0 = fidx(g);
#pragma unroll
    for (int k = 0; k < 16; ++k) { xr[k] = re[a0 + 336 * k]; xi[k] = im[a0 + 336 * k]; }
}
FFT_HD void fft_load_s16(const FFT_LDS float* re, const FFT_LDS float* im, int g, float (&xr)[16], float (&xi)[16]) {
    const int a0 = fidx((g >> 4) * 256 + (g & 15));
#pragma unroll
    for (int k = 0; k < 16; ++k) { xr[k] = re[a0 + 20 * k]; xi[k] = im[a0 + 20 * k]; }
}
FFT_HD void fft_store_s16(FFT_LDS float* re, FFT_LDS float* im, int g, const float (&xr)[16], const float (&xi)[16]) {
    const int a0 = fidx((g >> 4) * 256 + (g & 15));
#pragma unroll
    for (int k = 0; k < 16; ++k) { re[a0 + 20 * k] = xr[k]; im[a0 + 20 * k] = xi[k]; }
}
FFT_HD void fft_load_s1(const FFT_LDS float* re, const FFT_LDS float* im, int g, float (&xr)[16], float (&xi)[16]) {
    const int a = fidx(g * 16);
#pragma unroll
    for (int k = 0; k < 16; ++k) { xr[k] = re[a + k]; xi[k] = im[a + k]; }
}
FFT_HD void fft_store_s1(FFT_LDS float* re, FFT_LDS float* im, int g, const float (&xr)[16], const float (&xi)[16]) {
    const int a = fidx(g * 16);
#pragma unroll
    for (int k = 0; k < 16; ++k) { re[a + k] = xr[k]; im[a + k] = xi[k]; }
}


struct KArgs { const float* in[28]; float* out; unsigned char* ws; int ph_lo, ph_hi; };
struct Ctx {
    const KArgs& A; float* out; unsigned char* ws; LAS unsigned char* lds;
    int tid, lane, wave, G, gw, NGW;
};

__device__ __forceinline__ void transpose_item(const float* __restrict__ W, int N, int k0, int n0, bf16* __restrict__ dst, LAS float* scr, int lane) {
#pragma unroll 8
    for (int i = 0; i < 32; ++i) { const int kk = 2 * i + (lane >> 5); scr[kk * 33 + (lane & 31)] = W[(size_t)(k0 + kk) * N + n0 + (lane & 31)]; }
    LDS_WAIT(); asm volatile("" ::: "memory");
    const int c = lane & 7;
#pragma unroll
    for (int j = 0; j < 4; ++j) { const int n = (lane >> 3) + 8 * j; const LAS float* s = scr + (8 * c) * 33 + n;
        v4u o; o.x = pk2(s[0 * 33], s[1 * 33]); o.y = pk2(s[2 * 33], s[3 * 33]); o.z = pk2(s[4 * 33], s[5 * 33]); o.w = pk2(s[6 * 33], s[7 * 33]);
        *(v4u*)(dst + (size_t)n * 2048 + k0 + 8 * c) = o; }
    LDS_WAIT(); asm volatile("" ::: "memory");
}

__device__ __forceinline__ void transpose_item8(const float* __restrict__ W, int N, int k0, int n0, unsigned char* __restrict__ dst, LAS float* scr, int lane) {
#pragma unroll 8
    for (int i = 0; i < 32; ++i) { const int kk = 2 * i + (lane >> 5); scr[kk * 33 + (lane & 31)] = W[(size_t)(k0 + kk) * N + n0 + (lane & 31)]; }
    LDS_WAIT(); asm volatile("" ::: "memory");
    const int c = lane & 3;
#pragma unroll
    for (int j = 0; j < 2; ++j) { const int n = (lane >> 2) + 16 * j; const LAS float* q = scr + (16 * c) * 33 + n;
        v4u o; o.x = pk4_fp8(q[0 * 33] * W8_SCALE, q[1 * 33] * W8_SCALE, q[2 * 33] * W8_SCALE, q[3 * 33] * W8_SCALE); o.y = pk4_fp8(q[4 * 33] * W8_SCALE, q[5 * 33] * W8_SCALE, q[6 * 33] * W8_SCALE, q[7 * 33] * W8_SCALE);
        o.z = pk4_fp8(q[8 * 33] * W8_SCALE, q[9 * 33] * W8_SCALE, q[10 * 33] * W8_SCALE, q[11 * 33] * W8_SCALE); o.w = pk4_fp8(q[12 * 33] * W8_SCALE, q[13 * 33] * W8_SCALE, q[14 * 33] * W8_SCALE, q[15 * 33] * W8_SCALE);
        *(v4u*)(dst + (size_t)n * 2048 + k0 + 16 * c) = o; }
    LDS_WAIT(); asm volatile("" ::: "memory");
}

__device__ __forceinline__ void phase0(const Ctx& C) {
    unsigned char* ws = C.ws;
    {
        const f32x4* x4 = (const f32x4*)C.A.in[0]; v4u* xb = (v4u*)(ws + (size_t)XB_T0 * MiB);
        const size_t n8 = (size_t)T * D / 8;
        for (size_t i = (size_t)blockIdx.x * NTHREADS + C.tid; i < n8; i += (size_t)C.G * NTHREADS) {
            const f32x4 a = x4[2 * i], b = x4[2 * i + 1]; v4u o; o.x = pk2(a.x, a.y); o.y = pk2(a.z, a.w); o.z = pk2(b.x, b.y); o.w = pk2(b.z, b.w); xb[i] = o; }
    }
    {
        LAS float* scr = (LAS float*)(C.lds + C.wave * 8448);
        constexpr int I_IN = 32 * 225, I_OUT = 32 * 64, E_GU0 = (MOE_SIDE && !PROBE_SIDE_DUMMY) ? SIDE_GU_EXPERTS : 0, I_GU = MOE_PRECONVERT ? (NE - E_GU0) * 32 * 128 : 0, I_DN = (MOE_PRECONVERT && (!MOE_SIDE || PROBE_SIDE_DUMMY)) ? NE * 32 * 64 : 0, NITEMS = I_IN + I_OUT + I_GU + I_DN;
        bf16* win_t = (bf16*)(ws + (size_t)WIN_T0 * MiB); bf16* wout_t = (bf16*)(ws + (size_t)WOUT_T0 * MiB);
        bf16* wgu_t = (bf16*)(ws + (size_t)WGU_T0 * MiB); bf16* wdn_t = (bf16*)(ws + (size_t)WDN_T0 * MiB);
        for (int it = C.gw; it < NITEMS; it += C.NGW) {
            int r = it;
            if (r < I_IN) { const int kb = r / 225, nb = r % 225; transpose_item(C.A.in[1], DIN, 64 * kb, 32 * nb, win_t + (size_t)(32 * nb) * 2048, scr, C.lane); continue; } r -= I_IN;
#if OUTPROJ_F8
            if (r < I_OUT) { const int kb = r / 64, nb = r % 64; transpose_item8(C.A.in[16], D, 64 * kb, 32 * nb, (unsigned char*)wout_t + (size_t)(32 * nb) * 2048, scr, C.lane); continue; } r -= I_OUT;
#else
            if (r < I_OUT) { const int kb = r / 64, nb = r % 64; transpose_item(C.A.in[16], D, 64 * kb, 32 * nb, wout_t + (size_t)(32 * nb) * 2048, scr, C.lane); continue; } r -= I_OUT;
#endif
            if (r < I_GU) { const int e = E_GU0 + r / 4096, rr = r % 4096, kb = rr / 128, nb = rr % 128, n0 = 32 * nb;
                const int drow = (n0 < 2048) ? ((n0 >> 7) * 256 + (n0 & 127)) : ((((n0 - 2048) >> 7) * 256) + 128 + ((n0 - 2048) & 127));
                transpose_item(C.A.in[22] + (size_t)e * 2048 * 4096, 4096, 64 * kb, n0, wgu_t + ((size_t)e * 4096 + drow) * 2048, scr, C.lane);
                continue; } r -= I_GU;
            { const int e = r / 2048, rr = r % 2048, kb = rr / 64, nb = rr % 64;
                transpose_item(C.A.in[24] + (size_t)e * 2048 * 2048, 2048, 64 * kb, 32 * nb, wdn_t + ((size_t)e * 2048 + 32 * nb) * 2048, scr, C.lane); }
        }
    }
    __syncthreads();
    {
        const float* w1 = C.A.in[5]; const float* b1 = C.A.in[6]; const float* w2 = C.A.in[7]; const float* b2 = C.A.in[8]; const float* freq = C.A.in[10];
        LAS float* h1s = (LAS float*)C.lds;
        const int tt = C.tid >> 6, j = C.tid & 63;
        for (int tb = blockIdx.x; tb < SEQ / 8; tb += C.G) {
            const int t = tb * 8 + tt;
            const float zt = (float)t / 2047.0f, wt = 6.283185307179586f * (float)t / 2048.0f;
            float acc = b1[j] + zt * w1[j];
            for (int i = 0; i < 16; ++i) { const float fb = 1e-4f + (float)i * ((15.0f - 1e-4f) / 15.0f); float sn, cs; sincospif(fb * (float)t * (1.0f / 1024.0f), &sn, &cs);
                acc += cs * w1[(1 + i) * 64 + j] - sn * w1[(17 + i) * 64 + j]; }
            h1s[tt * 64 + j] = sinf(freq[j] * acc);
            __syncthreads();
            float a2 = b2[j];
            for (int i = 0; i < 64; ++i) a2 += h1s[tt * 64 + i] * w2[i * 64 + j];
            { const float hv = sinf(freq[64 + j] * a2); const unsigned hi = f2bf(hv); const float lo = hv - bflo(hi);
              bf16* hp = (bf16*)(ws + WS_H2P) + (size_t)t * 256; hp[j] = (bf16)hi; hp[64 + j] = (bf16)hi; hp[128 + j] = (bf16)f2bf(lo); hp[192 + j] = 0; }
            __syncthreads();
        }
        const float* w3 = C.A.in[9]; bf16* wp = (bf16*)(ws + WS_W3P);
        for (int i = blockIdx.x * NTHREADS + C.tid; i < 4096 * 8; i += C.G * NTHREADS) {
            const int col = i & 4095, jo = i >> 12; float wv[8]; unsigned hi[8], lo[8];
#pragma unroll
            for (int k = 0; k < 8; ++k) { wv[k] = w3[(size_t)(jo * 8 + k) * 4096 + col]; hi[k] = f2bf(wv[k]); lo[k] = f2bf(wv[k] - bflo(hi[k])); }
            v4u vh, vl; vh.x = hi[0] | (hi[1] << 16); vh.y = hi[2] | (hi[3] << 16); vh.z = hi[4] | (hi[5] << 16); vh.w = hi[6] | (hi[7] << 16);
            vl.x = lo[0] | (lo[1] << 16); vl.y = lo[2] | (lo[3] << 16); vl.z = lo[4] | (lo[5] << 16); vl.w = lo[6] | (lo[7] << 16);
            bf16* row = wp + (size_t)col * 256 + jo * 8;
            *(v4u*)row = vh; *(v4u*)(row + 64) = vl; *(v4u*)(row + 128) = vh; *(v4u*)(row + 192) = (v4u){0u, 0u, 0u, 0u};
        }
    }
}

constexpr int N1_SW_TILES = 16, N1_SW = N1_SW_TILES * 32;
constexpr int N1_NORM_TILES = 13, N1_NORM = N1_NORM_TILES * 32, N1_UNITS = N1_SW + N1_NORM;
struct Gemm1Order {
    int G, c;
    __device__ __forceinline__ int a_row(const pg8::Unit& u, int, int r) const { return u.pm * 256 + r; }
    __device__ __forceinline__ bool next(int i, pg8::Unit& u) const {
        const int L = i * G + c; if (L >= N1_UNITS) return false;
        int w; { const int q = N1_UNITS / 8, r = N1_UNITS % 8, xcd = L % 8, off = L / 8; w = (xcd < r ? xcd * (q + 1) : r * (q + 1) + (xcd - r) * q) + off; }
        if (w < N1_SW) { const int nig = 8 * 32, gid = w / nig, wi = w % nig, mi = gid * 8 + (wi % 8), ni = wi / 8;
            u.pm = WIN_T0 + (mi < 12 ? mi : 8 + mi); u.pn = XB_T0 + ni; }
        else { w -= N1_SW; const int nig = 8 * N1_NORM_TILES, gid = w / nig, wi = w % nig, mi = gid * 8 + (wi % 8), ni = wi / 8;
            int wt;
            wt = (ni < 8) ? 12 + ni : 16 + ni;
            u.pm = XB_T0 + mi; u.pn = WIN_T0 + wt; }
        return true;
    }
    __device__ __forceinline__ void a_ready(const pg8::Unit&) const {}
    __device__ __forceinline__ void done(const pg8::Unit&) const {}
};
struct Epi1 {
    static constexpr bool PERM = true, AFTER_DRAIN = false;
    const float* b_in; bf16* hyt; bf16* qkraw; bf16* vb; bf16* ob; float* gates;
    __device__ __forceinline__ void operator()(const pg8::f32x4 (&acc)[2][2][4][2], const pg8::Unit& u, int wr, int wc, int fr_, int fq_) const {
        int ln_ = threadIdx.x & 63; asm volatile("" : "+v"(ln_));
        const int fr = ln_ & 15, fq = ln_ >> 4;
        using pg8::cvt_pk_bf16;
        if (u.pm >= WIN_T0) {
            const int wt = u.pm - WIN_T0, tt = u.pn - XB_T0;
            const int col0 = tt * 256 + wc * 32 + 8 * fq;
#pragma unroll
            for (int ai = 0; ai < 2; ++ai)
#pragma unroll
                for (int m = 0; m < 4; ++m) {
                    const int ch = wt * 256 + ai * 128 + wr * 64 + m * 16 + fr; const float bv = b_in[ch];
                    const int drow = ch < 3072 ? ch : ch - 2048;
                    bf16* rowp = hyt + (size_t)drow * T + col0;
#pragma unroll
                    for (int bj = 0; bj < 2; ++bj) { const pg8::f32x4 v0 = acc[ai][bj][m][0] + bv, v1 = acc[ai][bj][m][1] + bv;
                        v4u w; w.x = cvt_pk_bf16(v0[0], v0[1]); w.y = cvt_pk_bf16(v0[2], v0[3]); w.z = cvt_pk_bf16(v1[0], v1[1]); w.w = cvt_pk_bf16(v1[2], v1[3]);
                        *(v4u*)(rowp + bj * 128) = w; }
                }
        } else {
            const int tt = u.pm - XB_T0, wt = u.pn - WIN_T0;
            const int chb = wt * 256 + wc * 32 + 8 * fq;
            pg8::f32x4 bv[2][2];
#pragma unroll
            for (int bj = 0; bj < 2; ++bj)
#pragma unroll
                for (int n = 0; n < 2; ++n) { const int c0 = chb + bj * 128 + 4 * n; bv[bj][n] = (c0 < DIN) ? *(const pg8::f32x4*)(b_in + c0) : (pg8::f32x4){0.f, 0.f, 0.f, 0.f}; }
            if (wt == 28) {
                if (wc == 0) {
#pragma unroll
                    for (int ai = 0; ai < 2; ++ai)
#pragma unroll
                        for (int m = 0; m < 4; ++m) { const int tok = tt * 256 + ai * 128 + wr * 64 + m * 16 + fr;
                            float* gp = gates + (size_t)tok * 32 + 8 * fq;
                            *(pg8::f32x4*)(gp) = acc[ai][0][m][0] + bv[0][0]; *(pg8::f32x4*)(gp + 4) = acc[ai][0][m][1] + bv[0][1]; }
                }
            } else {
#define EPI1_STORE(base, ld, cb) do { _Pragma("unroll") for (int ai = 0; ai < 2; ++ai) _Pragma("unroll") for (int m = 0; m < 4; ++m) { const int tok = tt * 256 + ai * 128 + wr * 64 + m * 16 + fr; \
                    bf16* rowp = (base) + (size_t)tok * (ld) + (cb); \
                    _Pragma("unroll") for (int bj = 0; bj < 2; ++bj) { const pg8::f32x4 v0 = acc[ai][bj][m][0] + bv[bj][0], v1 = acc[ai][bj][m][1] + bv[bj][1]; \
                        v4u w; w.x = cvt_pk_bf16(v0[0], v0[1]); w.y = cvt_pk_bf16(v0[2], v0[3]); w.z = cvt_pk_bf16(v1[0], v1[1]); w.w = cvt_pk_bf16(v1[2], v1[3]); \
                        *(v4u*)(rowp + bj * 128) = w; } } } while (0)
                if (wt < 20) EPI1_STORE(qkraw, 2048, chb - 3072);
                else if (wt < 24) EPI1_STORE(vb, 1024, chb - 5120);
                else EPI1_STORE(ob, 1024, chb - 6144);
#undef EPI1_STORE
            }
        }
    }
};

struct KtOrder {
    int G, c;
    __device__ __forceinline__ bool next(int i, pg8::Unit& u) const { const int cc = G - 1 - c; if (i != 0 || cc >= 128) return false; u.pm = cc >> 3; u.pn = cc & 7; return true; }
    __device__ __forceinline__ void a_ready(const pg8::Unit&) const {}
    __device__ __forceinline__ void done(const pg8::Unit&) const {}
};
struct EpiKT {
    static constexpr bool PERM = true, AFTER_DRAIN = false;
    float* kt;
    __device__ __forceinline__ void operator()(const pg8::f32x4 (&acc)[2][2][4][2], const pg8::Unit& u, int wr, int wc, int fr, int fq) const {
        const float da = -3.0701134573253945f, db = -15.350567286626973f;
#pragma unroll
        for (int ai = 0; ai < 2; ++ai)
#pragma unroll
            for (int m = 0; m < 4; ++m) {
                const int col = u.pm * 256 + ai * 128 + wr * 64 + m * 16 + fr, o = col >> 11, dir = (col >> 10) & 1, c = col & 1023;
                const float delta = fabsf(da + (float)c * ((db - da) / 1023.0f)) * (1.0f / 2047.0f);
                float* kr = kt + ((size_t)o * 1024 + c) * 4096;
#pragma unroll
                for (int bj = 0; bj < 2; ++bj) {
                    const int t0 = u.pn * 256 + bj * 128 + wc * 32 + 8 * fq; float v[8];
#pragma unroll
                    for (int n = 0; n < 2; ++n)
#pragma unroll
                        for (int e = 0; e < 4; ++e) v[4 * n + e] = acc[ai][bj][m][n][e] * expf(-(float)(t0 + 4 * n + e) * delta);
                    if (dir == 0) { *(pg8::f32x4*)(kr + t0) = (pg8::f32x4){v[0], v[1], v[2], v[3]}; *(pg8::f32x4*)(kr + t0 + 4) = (pg8::f32x4){v[4], v[5], v[6], v[7]}; }
                    else {
#pragma unroll
                        for (int e = 0; e < 8; ++e) if (t0 + e >= 1) kr[4096 - t0 - e] = v[e]; }
                }
            }
    }
};

template <int OP> __device__ __forceinline__ LAS float* block_scan_2048(LAS float* x, LAS float* y, int tid) {
    LAS float* src = x; LAS float* dst = y;
    for (int off = 1; off < 2048; off <<= 1) {
#pragma unroll
        for (int i = 0; i < 4; ++i) { const int idx = tid + 512 * i; float v = src[idx]; if (idx >= off) { const float w = src[idx - off]; v = OP ? fmaxf(v, w) : v + w; } dst[idx] = v; }
        __syncthreads();
        LAS float* t = src; src = dst; dst = t;
    }
    return src;
}
__device__ __forceinline__ float logsigmoidf(float x) { return fminf(x, 0.f) - log1pf(expf(-fabsf(x))); }

__device__ __forceinline__ void phase2(const Ctx& C) {
    unsigned char* ws = C.ws;
    {
        const float* KT = (const float*)(ws + WS_KT); f32x4* KF = (f32x4*)(ws + WS_KF);
        const int half = C.tid >> 8, g = C.tid & 255;
        LAS float* re = (LAS float*)(C.lds + half * (2 * FFT_WORDS * 4)); LAS float* im = re + FFT_WORDS;
        LAS float* red = (LAS float*)(C.lds + 4 * FFT_WORDS * 4);
        for (int u = blockIdx.x; u < 1024; u += C.G) {
            const int o = u >> 9, c0 = (u & 511) * 2, c = c0 + half;
            __syncthreads();
            const float* kcol = KT + ((size_t)o * 1024 + c) * 4096;
            float xr[16], xi[16]; float asum = 0.f;
#pragma unroll
            for (int m = 0; m < 16; ++m) { const int idx = g + 256 * m; const float val = (idx == 2048) ? 0.f : kcol[idx]; xr[m] = val; xi[m] = 0.f; asum += fabsf(val); }
            asum = wave_sum(asum);
            if (C.lane == 0) red[C.wave] = asum;
            __syncthreads();
            const float tot = red[half * 4] + red[half * 4 + 1] + red[half * 4 + 2] + red[half * 4 + 3];
            const float scl = 1.0f / (tot * 4096.0f);
#pragma unroll
            for (int m = 0; m < 16; ++m) xr[m] *= scl;
            dft16<false>(xr, xi); twiddle16<false>(xr, xi, g, 4096); fft_store_s256(re, im, g, xr, xi);
            __syncthreads();
            fft_load_s16(re, im, g, xr, xi); dft16<false>(xr, xi); twiddle16<false>(xr, xi, g & 15, 256); fft_store_s16(re, im, g, xr, xi);
            __syncthreads();
            fft_load_s1(re, im, g, xr, xi); dft16<false>(xr, xi);
            f32x4* dst = KF + ((size_t)(o * 1024 + c) * 4096 + g * 16) / 2;
#pragma unroll
            for (int k = 0; k < 8; ++k) dst[k] = (f32x4){xr[2 * k], xi[2 * k], xr[2 * k + 1], xi[2 * k + 1]};
        }
        __syncthreads();
    }
    {
        const bf16* raw = (const bf16*)(ws + WS_QKRAW); bf16* qkc = (bf16*)(ws + WS_QKC); const float* cw = C.A.in[13]; const float* cb = C.A.in[14];
        const int qwg0 = C.G > 128 ? 64 : 0;
        for (int g = ((int)blockIdx.x - qwg0) * NTHREADS + C.tid; g < T * 256 && (int)blockIdx.x >= qwg0; g += (C.G - qwg0) * NTHREADS) {
            const int tok = g >> 8, ch0 = (g & 255) * 8, tl = tok & (SEQ - 1);
            const v4u cur = *(const v4u*)(raw + (size_t)tok * 2048 + ch0);
            v4u prv = (v4u){0u, 0u, 0u, 0u}, nxt = (v4u){0u, 0u, 0u, 0u};
            if (tl > 0) prv = *(const v4u*)(raw + (size_t)(tok - 1) * 2048 + ch0);
            if (tl < SEQ - 1) nxt = *(const v4u*)(raw + (size_t)(tok + 1) * 2048 + ch0);
            const float sc = ch0 >= 1024 ? 0.08838834764831845f : 1.0f;
            float o[8];
#pragma unroll
            for (int i = 0; i < 8; ++i) {
                const unsigned pw = prv[i >> 1], cwd = cur[i >> 1], nw = nxt[i >> 1];
                const float p = (i & 1) ? bfhi(pw) : bflo(pw), q = (i & 1) ? bfhi(cwd) : bflo(cwd), n = (i & 1) ? bfhi(nw) : bflo(nw);
                const int ch = ch0 + i;
                const float v = cw[ch] * p + cw[2048 + ch] * q + cw[4096 + ch] * n + cb[ch];
                o[i] = sc * v / (1.0f + expf(-v));
            }
            v4u w; w.x = pk2(o[0], o[1]); w.y = pk2(o[2], o[3]); w.z = pk2(o[4], o[5]); w.w = pk2(o[6], o[7]);
            *(v4u*)(qkc + (size_t)tok * 2048 + ch0) = w;
        }
    }
    {
        const float* gates = (const float*)(ws + WS_GATES); float* GA = (float*)(ws + WS_GA); float* GP = (float*)(ws + WS_GP); float* GE = (float*)(ws + WS_GE);
        LAS float* s0 = (LAS float*)(C.lds + 8192); LAS float* s1 = s0 + 2048; LAS float* s2 = s1 + 2048; LAS float* s3 = s2 + 2048;
        for (int bhd = blockIdx.x; bhd < 64; bhd += C.G) {
            const int b = bhd >> 4, h = (bhd >> 1) & 7, dir = bhd & 1, col_i = dir * 16 + h, col_f = col_i + 8;
            float ig[4], lf[4];
            __syncthreads();
#pragma unroll
            for (int i = 0; i < 4; ++i) { const int t = C.tid + 512 * i; const float* gr = gates + (size_t)(b * SEQ + t) * 32; ig[i] = gr[col_i]; lf[i] = logsigmoidf(gr[col_f]); s0[t] = lf[i]; }
            __syncthreads();
            LAS float* Fc = block_scan_2048<0>(s0, s1, C.tid);
            float a[4], Fv[4], Gx[4];
#pragma unroll
            for (int i = 0; i < 4; ++i) { const int t = C.tid + 512 * i; Fv[i] = Fc[t]; Gx[i] = Fv[i] - lf[i]; a[i] = dir ? ig[i] + Gx[i] : ig[i] - Fv[i]; s2[dir ? 2047 - t : t] = a[i]; }
            __syncthreads();
            LAS float* Pm = block_scan_2048<1>(s2, s3, C.tid);
#pragma unroll
            for (int i = 0; i < 4; ++i) { const int t = C.tid + 512 * i; const float pm = Pm[dir ? 2047 - t : t];
                const float mt = dir ? pm - Gx[i] : Fv[i] + pm;
                GA[bhd * 2048 + t] = a[i]; GP[bhd * 2048 + t] = pm; GE[bhd * 2048 + t] = expf(-mt); }
        }
        __syncthreads();
    }
}

template <class Slot>
__device__ __forceinline__ void hyena_conv_once(LAS float* re, LAS float* im, int g, float (&xr)[16], float (&xi)[16], const f32x4* __restrict__ kf, Slot&& slot) {
    __syncthreads();
    dft16<false>(xr, xi); twiddle16<false>(xr, xi, g, 4096); fft_store_s256(re, im, g, xr, xi);
    __syncthreads();
    fft_load_s16(re, im, g, xr, xi); dft16<false>(xr, xi); twiddle16<false>(xr, xi, g & 15, 256); fft_store_s16(re, im, g, xr, xi);
    __syncthreads();
    fft_load_s1(re, im, g, xr, xi); dft16<false>(xr, xi);
#pragma unroll
    for (int k = 0; k < 8; ++k) { const f32x4 w = kf[g * 8 + k];
        const float r0 = xr[2 * k] * w.x - xi[2 * k] * w.y, i0 = xr[2 * k] * w.y + xi[2 * k] * w.x;
        const float r1 = xr[2 * k + 1] * w.z - xi[2 * k + 1] * w.w, i1 = xr[2 * k + 1] * w.w + xi[2 * k + 1] * w.z;
        xr[2 * k] = r0; xi[2 * k] = i0; xr[2 * k + 1] = r1; xi[2 * k + 1] = i1; }
    dft16<true>(xr, xi); fft_store_s1(re, im, g, xr, xi);
    __syncthreads();
    slot();
    fft_load_s16(re, im, g, xr, xi); twiddle16<true>(xr, xi, g & 15, 256); dft16<true>(xr, xi); fft_store_s16(re, im, g, xr, xi);
    __syncthreads();
    fft_load_s256(re, im, g, xr, xi); twiddle16<true>(xr, xi, g, 4096); dft16<true>(xr, xi);
}
__device__ __forceinline__ void hyena_fft(const Ctx& C) {
    unsigned char* ws = C.ws;
    const bf16* hyt = (const bf16*)(ws + WS_HYT); const f32x4* KF = (const f32x4*)(ws + WS_KF); float* ZT = (float*)(ws + WS_ZT);
    const float* cw = C.A.in[3]; const float* cb = C.A.in[4]; const float* skip = C.A.in[11];
    const int half = C.tid >> 8, g_all = C.tid & 255;
    LAS float* re = (LAS float*)(C.lds + half * (2 * FFT_WORDS * 4)); LAS float* im = re + FFT_WORDS;
    LAS bf16* rows = (LAS bf16*)(C.lds + 4 * FFT_WORDS * 4 + half * 16384);
#if HY_SETS > 0
    const float* dnw = C.A.in[24]; unsigned char* dnq = ws + (size_t)WDN_T0 * MiB; const int dwv = C.wave;
    const int dn_end = (8 * HY_SETS * C.G < DN_STEPS) ? 8 * HY_SETS * C.G : DN_STEPS;
    int dstep = (int)blockIdx.x, dprev[HY_SETS]; bool dpend[HY_SETS];
    f32x4 dx[HY_SETS][4];
#pragma unroll
    for (int s_ = 0; s_ < HY_SETS; ++s_) { dprev[s_] = 0; dpend[s_] = false;
#pragma unroll
        for (int j_ = 0; j_ < 4; ++j_) dx[s_][j_] = (f32x4){0.f, 0.f, 0.f, 0.f}; }
    auto dn_slot = [&]() {
        asm volatile("s_waitcnt vmcnt(0)" ::: "memory");
        int t_ = C.tid; asm volatile("" : "+v"(t_));
        const unsigned gv_ = (unsigned)((4 * (t_ & 31)) * 2048 + 4 * ((t_ >> 5) & 1)) * 4u, dv_ = (unsigned)(4 * ((t_ >> 5) & 1)) * 2048u + 4u * (unsigned)(t_ & 31);
#pragma unroll
        for (int s_ = 0; s_ < HY_SETS; ++s_) if (dpend[s_]) {
            const int hs_ = dprev[s_], qq_ = hs_ & 3, st_ = hs_ >> 2, tile_ = st_ >> 4, kt_ = st_ & 15;
            char* dp_ = (char*)(dnq + ((size_t)tile_ * 256 + 64 * qq_ + 8 * dwv) * 2048 + 128 * kt_);
            asm volatile("" : "+v"(dx[s_][0]), "+v"(dx[s_][1]), "+v"(dx[s_][2]), "+v"(dx[s_][3]));
#pragma unroll
            for (int i_ = 0; i_ < 4; ++i_) { const unsigned w_ = pk4_fp8(dx[s_][0][i_] * W8_SCALE, dx[s_][1][i_] * W8_SCALE, dx[s_][2][i_] * W8_SCALE, dx[s_][3][i_] * W8_SCALE);
                asm volatile("global_store_dword %0, %1, %2" :: "v"(dv_), "v"(w_), "s"(dp_ + (size_t)i_ * 2048) : "memory"); }
            dpend[s_] = false; }
#pragma unroll
        for (int s_ = 0; s_ < HY_SETS; ++s_) if (dstep < dn_end) {
            const int hs_ = dstep, qq_ = hs_ & 3, st_ = hs_ >> 2, tile_ = st_ >> 4, kt_ = st_ & 15, e_ = tile_ >> 3, j2_ = tile_ & 7;
            const char* sp_ = (const char*)(dnw + (size_t)e_ * 2048 * 2048 + (size_t)(128 * kt_) * 2048 + 256 * j2_ + 64 * qq_ + 8 * dwv);
#pragma unroll
            for (int j_ = 0; j_ < 4; ++j_) asm volatile("global_load_dwordx4 %0, %1, %2" : "+v"(dx[s_][j_]) : "v"(gv_), "s"(sp_ + (size_t)j_ * 8192) : "memory");
            dprev[s_] = dstep; dstep += C.G; dpend[s_] = true; }
    };
#else
    auto dn_slot = []() {};
#endif
    for (int c = blockIdx.x; c < DHY; c += C.G) {
        int g = g_all; asm volatile("" : "+v"(g));
        float vr[8], vi[8], ar[8], ai[8];
        __syncthreads();
v4u stg_[4];
#pragma unroll
        for (int rr = 0; rr < 4; ++rr) { const int part = rr >> 1, bq = rr & 1; stg_[rr] = *(const v4u*)(hyt + (size_t)(part * 1024 + c) * T + (2 * half + bq) * SEQ + g * 8); }
#pragma unroll
        for (int rr = 0; rr < 4; ++rr) *(LAS v4u*)(rows + rr * 2048 + g * 8) = stg_[rr];
        __syncthreads();
#pragma unroll
        for (int part = 0; part < 2; ++part) {
            const int ch = part * 1024 + c; const float w0 = cw[ch], w1 = cw[3072 + ch], w2 = cw[6144 + ch], bb = cb[ch];
#pragma unroll
            for (int bq = 0; bq < 2; ++bq) { const LAS bf16* row = rows + (part * 2 + bq) * 2048;
#pragma unroll
                for (int m = 0; m < 8; ++m) { const int t = g + 256 * m;
                    const float p = t > 0 ? bf2f(row[t - 1]) : 0.f, q = bf2f(row[t]), n = t < SEQ - 1 ? bf2f(row[t + 1]) : 0.f;
                    const float r = w0 * p + w1 * q + w2 * n + bb;
                    if (part == 0) { if (bq == 0) vr[m] = r; else vi[m] = r; } else { if (bq == 0) ar[m] = r; else ai[m] = r; } } }
        }
        const float sk0 = skip[c], sk1 = skip[1024 + c], x2w0 = cw[2048 + c], x2w1 = cw[3072 + 2048 + c], x2w2 = cw[6144 + 2048 + c], x2bb = cb[2048 + c];
        asm volatile("" :: "v"(sk0), "v"(sk1), "v"(x2w0), "v"(x2w1), "v"(x2w2), "v"(x2bb));
        float xr[16], xi[16];
#pragma unroll
        for (int m = 0; m < 8; ++m) { xr[m] = vr[m]; xi[m] = vi[m]; xr[m + 8] = 0.f; xi[m + 8] = 0.f; }
        hyena_conv_once(re, im, g, xr, xi, KF + (size_t)c * 2048, dn_slot);
#pragma unroll
        for (int m = 0; m < 8; ++m) { vr[m] = ar[m] * (xr[m] + sk0 * vr[m]); vi[m] = ai[m] * (xi[m] + sk0 * vi[m]); xr[m] = vr[m]; xi[m] = vi[m]; xr[m + 8] = 0.f; xi[m + 8] = 0.f; }
        v4u x2a, x2b;
        { const bf16* src = hyt + (size_t)(2048 + c) * T + (2 * half) * SEQ + g * 8; x2a = *(const v4u*)src; x2b = *(const v4u*)(src + SEQ); }
        hyena_conv_once(re, im, g, xr, xi, KF + (size_t)(1024 + c) * 2048, dn_slot);
        *(LAS v4u*)(rows + g * 8) = x2a; *(LAS v4u*)(rows + 2048 + g * 8) = x2b;
        __syncthreads();
        float* zr = ZT + (size_t)c * T + (2 * half) * SEQ;
        { const float w0 = x2w0, w1 = x2w1, w2 = x2w2, bb = x2bb;
#pragma unroll
          for (int bq = 0; bq < 2; ++bq) { const LAS bf16* row = rows + bq * 2048;
#pragma unroll
            for (int m = 0; m < 8; ++m) { const int t = g + 256 * m;
                const float p = t > 0 ? bf2f(row[t - 1]) : 0.f, q = bf2f(row[t]), n = t < SEQ - 1 ? bf2f(row[t + 1]) : 0.f;
                const float x2 = w0 * p + w1 * q + w2 * n + bb;
                if (bq == 0) zr[t] = x2 * (xr[m] + sk1 * vr[m]); else zr[SEQ + t] = x2 * (xi[m] + sk1 * vi[m]); } } }
    }
#if HY_SETS > 0
    for (bool any_ = true; any_;) { dn_slot(); any_ = false;
#pragma unroll
        for (int s_ = 0; s_ < HY_SETS; ++s_) any_ = any_ || dpend[s_]; }
#endif
    __syncthreads();
}

typedef short ml_bf16x8 __attribute__((ext_vector_type(8)));
typedef short ml_s16x4 __attribute__((ext_vector_type(4)));
typedef float ml_f32x16 __attribute__((ext_vector_type(16)));
typedef __bf16 ml_bf2 __attribute__((ext_vector_type(2)));
constexpr int ML_KROW = 272, ML_VROW = 136, ML_KBUF = 64 * ML_KROW, ML_VBUF = 128 * ML_VROW;
__device__ __forceinline__ unsigned ml_pk(float lo, float hi) { const f32x2 v = {lo, hi}; return __builtin_bit_cast(unsigned, __builtin_convertvector(v, ml_bf2)); }
__device__ __forceinline__ void mlstm_mfma(const Ctx& C) {
    unsigned char* ws = C.ws;
    const bf16* qkc = (const bf16*)(ws + WS_QKC); const bf16* vt = (const bf16*)(ws + WS_HYT) + (size_t)3072 * T;
    const float* GA = (const float*)(ws + WS_GA); const float* GP = (const float*)(ws + WS_GP); const float* GE = (const float*)(ws + WS_GE);
    const bf16* ob = (const bf16*)(ws + WS_OB); bf16* ycat = (bf16*)(ws + (size_t)YCAT_T0 * MiB); const float* mlw = C.A.in[15];
    LAS unsigned char* KB = C.lds; LAS unsigned char* VB = C.lds + 2 * ML_KBUF; LAS float* AS = (LAS float*)(C.lds + 2 * ML_KBUF + 2 * ML_VBUF);
    const int w = C.wave;
    for (int u = blockIdx.x; u < 256; u += C.G) {
        int tid = C.tid; asm volatile("" : "+v"(tid));
        const int lane = tid & 63, r = lane & 31, hh = lane >> 5;
        const int bh = u >> 3, qb = u & 7, b = bh >> 3, h = bh & 7;
        const bf16* kbase = qkc + (size_t)(b * SEQ) * 2048 + 1024 + h * 128;
        const bf16* vbase = vt + (size_t)(h * 128) * T + b * SEQ;
        const int qlo = 256 * qb + 32 * w, tq = qlo + r;
        ml_bf16x8 qf[8];
        { const bf16* qrow = qkc + (size_t)(b * SEQ + tq) * 2048 + h * 128 + 8 * hh;
#pragma unroll
          for (int s = 0; s < 8; ++s) qf[s] = *(const ml_bf16x8*)(qrow + 16 * s); }
        ml_f32x16 O[4];
#pragma unroll 1
        for (int dir = 0; dir < 2; ++dir) {
            const int bhd = bh * 2 + dir;
            __syncthreads();
            for (int i = tid; i < SEQ; i += NTHREADS) AS[i] = GA[bhd * SEQ + i] * 1.4426950408889634f;
            const float pmt = GP[bhd * SEQ + tq] * 1.4426950408889634f;
#pragma unroll
            for (int d = 0; d < 4; ++d)
#pragma unroll
                for (int i = 0; i < 16; ++i) O[d][i] = 0.f;
            float den = 0.f;
            const int kt0 = dir ? 4 * qb : 0, kt1 = dir ? 31 : 4 * qb + 3;
            v4u kr0, kr1, vr0, vr1;
            const unsigned koff0 = (unsigned)((tid >> 4) * 4096 + (tid & 15) * 16), koff1 = koff0 + 32u * 4096u;
            const unsigned voff0 = (unsigned)((tid >> 3) * (T * 2) + (tid & 7) * 16), voff1 = voff0 + 64u * (unsigned)(T * 2);
#define ML_LOAD(kt) do { const char* ku_ = (const char*)kbase + (size_t)(kt) * (64 * 4096); const char* vu_ = (const char*)vbase + (size_t)(kt) * 128; \
                kr0 = *(const v4u*)(ku_ + koff0); kr1 = *(const v4u*)(ku_ + koff1); vr0 = *(const v4u*)(vu_ + voff0); vr1 = *(const v4u*)(vu_ + voff1); } while (0)
#define ML_STORE(buf) do { const int p0 = tid, p1 = tid + 512; \
                *(LAS v4u*)(KB + (buf) * ML_KBUF + (p0 >> 4) * ML_KROW + (p0 & 15) * 16) = kr0; *(LAS v4u*)(KB + (buf) * ML_KBUF + (p1 >> 4) * ML_KROW + (p1 & 15) * 16) = kr1; \
                { LAS unsigned char* d0 = VB + (buf) * ML_VBUF + (p0 >> 3) * ML_VROW + (p0 & 7) * 16; *(LAS v2u*)d0 = (v2u){vr0.x, vr0.y}; *(LAS v2u*)(d0 + 8) = (v2u){vr0.z, vr0.w}; } \
                { LAS unsigned char* d1 = VB + (buf) * ML_VBUF + (p1 >> 3) * ML_VROW + (p1 & 7) * 16; *(LAS v2u*)d1 = (v2u){vr1.x, vr1.y}; *(LAS v2u*)(d1 + 8) = (v2u){vr1.z, vr1.w}; } } while (0)
            ML_LOAD(kt0);
            __syncthreads();
            ML_STORE(0);
            __syncthreads();
#pragma unroll 1
            for (int kt = kt0; kt <= kt1; ++kt) {
                const int cur = (kt - kt0) & 1;
                if (kt < kt1) ML_LOAD(kt + 1);
                const int klo = 64 * kt, khi = klo + 63, qhi = qlo + 31;
                const bool none = dir ? (khi < qlo) : (klo > qhi);
                const bool all = dir ? (klo >= qhi) : (khi <= qlo);
                if (!none) {
                    const LAS unsigned char* Kb = KB + cur * ML_KBUF; const LAS unsigned char* Vb = VB + cur * ML_VBUF;
                    ml_f32x16 S0, S1;
#pragma unroll
                    for (int i = 0; i < 16; ++i) { S0[i] = 0.f; S1[i] = 0.f; }
#pragma unroll
                    for (int s = 0; s < 8; ++s) {
                        const ml_bf16x8 k0 = *(const LAS ml_bf16x8*)(Kb + r * ML_KROW + (16 * s + 8 * hh) * 2);
                        const ml_bf16x8 k1 = *(const LAS ml_bf16x8*)(Kb + (32 + r) * ML_KROW + (16 * s + 8 * hh) * 2);
                        S0 = __builtin_amdgcn_mfma_f32_32x32x16_bf16(k0, qf[s], S0, 0, 0, 0);
                        S1 = __builtin_amdgcn_mfma_f32_32x32x16_bf16(k1, qf[s], S1, 0, 0, 0);
                    }
                    float den1 = 0.f;
#define ML_WGT(COND) do { _Pragma("unroll") for (int kb = 0; kb < 2; ++kb) _Pragma("unroll") for (int g4 = 0; g4 < 4; ++g4) { \
                        const f32x4 a4 = *(const LAS f32x4*)(AS + klo + 32 * kb + 8 * g4 + 4 * hh); \
                        _Pragma("unroll") for (int e = 0; e < 4; ++e) { const int i = 4 * g4 + e; const int cpos = 32 * kb + 8 * g4 + e; (void)cpos; \
                            const float sv = kb ? S1[i] : S0[i]; float p = sv * __builtin_amdgcn_exp2f(a4[e] - pmt); \
                            p = (COND) ? p : 0.f; \
                            if (e & 1) den1 += p; else den += p; \
                            if (kb) S1[i] = p; else S0[i] = p; } } } while (0)
                    if (all) { ML_WGT(true); }
                    else { const int sgn = dir ? -1 : 1, dd = sgn * (tq - klo - 4 * hh);
                        ML_WGT(sgn * cpos <= dd); }
#undef ML_WGT
                    den += den1;
#pragma unroll
                    for (int kb = 0; kb < 2; ++kb)
#pragma unroll
                        for (int s = 0; s < 2; ++s) {
                            v4u pw;
                            if (kb == 0) { pw.x = ml_pk(S0[8 * s], S0[8 * s + 1]); pw.y = ml_pk(S0[8 * s + 2], S0[8 * s + 3]); pw.z = ml_pk(S0[8 * s + 4], S0[8 * s + 5]); pw.w = ml_pk(S0[8 * s + 6], S0[8 * s + 7]); }
                            else { pw.x = ml_pk(S1[8 * s], S1[8 * s + 1]); pw.y = ml_pk(S1[8 * s + 2], S1[8 * s + 3]); pw.z = ml_pk(S1[8 * s + 4], S1[8 * s + 5]); pw.w = ml_pk(S1[8 * s + 6], S1[8 * s + 7]); }
                            const ml_bf16x8 pf = __builtin_bit_cast(ml_bf16x8, pw);
#pragma unroll
                            for (int db = 0; db < 4; ++db) {
                                const LAS unsigned char* vp = Vb + (32 * db + r) * ML_VROW + 2 * (32 * kb + 16 * s + 4 * hh);
                                const ml_s16x4 lo = *(const LAS ml_s16x4*)vp, hi = *(const LAS ml_s16x4*)(vp + 16);
                                const ml_bf16x8 vf = __builtin_shufflevector(lo, hi, 0, 1, 2, 3, 4, 5, 6, 7);
                                O[db] = __builtin_amdgcn_mfma_f32_32x32x16_bf16(vf, pf, O[db], 0, 0, 0);
                            }
                        }
                }
                if (kt < kt1) ML_STORE(cur ^ 1);
                __syncthreads();
            }
#undef ML_LOAD
#undef ML_STORE
            den += __shfl_xor(den, 32);
            const float scl = 1.0f / fmaxf(fabsf(den), GE[bhd * SEQ + tq]);
            int th = tid; asm volatile("" : "+v"(th));
            v4u* hp = (v4u*)(ws + WS_HML) + ((size_t)u * NTHREADS + th) * 8;
            if (dir == 0) {
#pragma unroll
                for (int db = 0; db < 4; ++db)
#pragma unroll
                    for (int q2 = 0; q2 < 2; ++q2) { v4u pk;
#pragma unroll
                        for (int j = 0; j < 4; ++j) pk[j] = ml_pk(O[db][8 * q2 + 2 * j] * scl, O[db][8 * q2 + 2 * j + 1] * scl);
                        hp[db * 2 + q2] = pk; }
            } else {
#pragma unroll
                for (int db = 0; db < 4; ++db)
#pragma unroll
                    for (int q2 = 0; q2 < 2; ++q2) { const v4u pk = hp[db * 2 + q2];
#pragma unroll
                        for (int j = 0; j < 4; ++j) { O[db][8 * q2 + 2 * j] = O[db][8 * q2 + 2 * j] * scl + bflo(pk[j]); O[db][8 * q2 + 2 * j + 1] = O[db][8 * q2 + 2 * j + 1] * scl + bfhi(pk[j]); } }
            }
        }
        float sm = 0.f;
#pragma unroll
        for (int db = 0; db < 4; ++db)
#pragma unroll
            for (int i = 0; i < 16; ++i) sm += O[db][i];
        sm += __shfl_xor(sm, 32);
        const float mu = sm * (1.0f / 128.0f); float qv = 0.f;
#pragma unroll
        for (int db = 0; db < 4; ++db)
#pragma unroll
            for (int i = 0; i < 16; ++i) { O[db][i] -= mu; qv += O[db][i] * O[db][i]; }
        qv += __shfl_xor(qv, 32);
        const float rstd = 1.0f / sqrtf(qv * (1.0f / 128.0f) + LN_EPS);
        LAS unsigned char* TB = C.lds;
        int te = tid; asm volatile("" : "+v"(te));
        __syncthreads();
        if (te < 128) AS[te] = mlw[h * 128 + te];
#pragma unroll
        for (int i = 0; i < 8; ++i) { const int pc = te + 512 * i, row = pc >> 4, ch = pc & 15;
            *(LAS v4u*)(TB + row * 272 + ch * 16) = *(const v4u*)(ob + (size_t)(b * SEQ + 256 * qb + row) * 1024 + h * 128 + ch * 8); }
        __syncthreads();
        LAS unsigned char* myrow = TB + (32 * w + (te & 31)) * 272 + 8 * ((te & 63) >> 5);
#pragma unroll
        for (int db = 0; db < 4; ++db)
#pragma unroll
            for (int g4 = 0; g4 < 4; ++g4) {
                const int dim = 32 * db + 8 * g4 + 4 * ((te & 63) >> 5); const f32x4 gw = *(const LAS f32x4*)(AS + dim);
                LAS v2u* pp = (LAS v2u*)(myrow + (32 * db + 8 * g4) * 2); const v2u ow = *pp;
                const float o0 = bflo(ow.x), o1 = bfhi(ow.x), o2 = bflo(ow.y), o3 = bfhi(ow.y);
                const float y0 = O[db][4 * g4] * rstd * gw.x / (1.0f + __expf(-o0)), y1 = O[db][4 * g4 + 1] * rstd * gw.y / (1.0f + __expf(-o1));
                const float y2 = O[db][4 * g4 + 2] * rstd * gw.z / (1.0f + __expf(-o2)), y3 = O[db][4 * g4 + 3] * rstd * gw.w / (1.0f + __expf(-o3));
                *pp = (v2u){ml_pk(y0, y1), ml_pk(y2, y3)};
            }
        __syncthreads();
#pragma unroll
        for (int i = 0; i < 8; ++i) { const int pc = te + 512 * i, row = pc >> 4, ch = pc & 15;
#if OUTPROJ_F8
            { const v4u t8 = *(const LAS v4u*)(TB + row * 272 + ch * 16); v2u o8; o8.x = pk4_fp8(bflo(t8.x) * Y8_SCALE, bfhi(t8.x) * Y8_SCALE, bflo(t8.y) * Y8_SCALE, bfhi(t8.y) * Y8_SCALE); o8.y = pk4_fp8(bflo(t8.z) * Y8_SCALE, bfhi(t8.z) * Y8_SCALE, bflo(t8.w) * Y8_SCALE, bfhi(t8.w) * Y8_SCALE);
              *(v2u*)((unsigned char*)ycat + (size_t)(b * SEQ + 256 * qb + row) * 2048 + 1024 + h * 128 + ch * 8) = o8; } }
#else
            *(v4u*)(ycat + (size_t)(b * SEQ + 256 * qb + row) * 2048 + 1024 + h * 128 + ch * 8) = *(const LAS v4u*)(TB + row * 272 + ch * 16); }
#endif
    }
    __syncthreads();
}

__device__ __forceinline__ void phase4(const Ctx& C) {
    unsigned char* ws = C.ws;
    const float* ZT = (const float*)(ws + WS_ZT); const float* HML = (const float*)(ws + WS_HML); const bf16* ob = (const bf16*)(ws + WS_OB);
    bf16* ycat = (bf16*)(ws + (size_t)YCAT_T0 * MiB); const float* hyw = C.A.in[12]; const float* mlw = C.A.in[15];
    const int lane = C.lane;
    {
        LAS float* red = (LAS float*)C.lds;
        for (int u = blockIdx.x; u < 128 * 8; u += C.G) {
            const int tt = u >> 3, gi = u & 7, tok = tt * 64 + lane, ch0 = gi * 128 + C.wave * 16;
            float x[16]; float s = 0.f;
#pragma unroll
            for (int i = 0; i < 16; ++i) { x[i] = ZT[(size_t)(ch0 + i) * T + tok]; s += x[i]; }
            __syncthreads();
            red[C.wave * 64 + lane] = s;
            __syncthreads();
            float tot = 0.f;
#pragma unroll
            for (int w = 0; w < 8; ++w) tot += red[w * 64 + lane];
            const float mu = tot * (1.0f / 128.0f); float q = 0.f;
#pragma unroll
            for (int i = 0; i < 16; ++i) { x[i] -= mu; q += x[i] * x[i]; }
            __syncthreads();
            red[C.wave * 64 + lane] = q;
            __syncthreads();
            float qt = 0.f;
#pragma unroll
            for (int w = 0; w < 8; ++w) qt += red[w * 64 + lane];
            const float rstd = 1.0f / sqrtf(qt * (1.0f / 128.0f) + LN_EPS);
            float y[16];
#pragma unroll
            for (int i = 0; i < 16; ++i) y[i] = x[i] * rstd * hyw[ch0 + i];
            v4u w0, w1; w0.x = pk2(y[0], y[1]); w0.y = pk2(y[2], y[3]); w0.z = pk2(y[4], y[5]); w0.w = pk2(y[6], y[7]);
            w1.x = pk2(y[8], y[9]); w1.y = pk2(y[10], y[11]); w1.z = pk2(y[12], y[13]); w1.w = pk2(y[14], y[15]);
#if OUTPROJ_F8
            {
#pragma unroll
              for (int i = 0; i < 16; ++i) y[i] *= Y8_SCALE;
              v4u o8; o8.x = pk4_fp8(y[0], y[1], y[2], y[3]); o8.y = pk4_fp8(y[4], y[5], y[6], y[7]); o8.z = pk4_fp8(y[8], y[9], y[10], y[11]); o8.w = pk4_fp8(y[12], y[13], y[14], y[15]);
              *(v4u*)((unsigned char*)ycat + (size_t)tok * 2048 + ch0) = o8; (void)w0; (void)w1; }
#else
            bf16* dst = ycat + (size_t)tok * 2048 + ch0;
            *(v4u*)dst = w0; *(v4u*)(dst + 8) = w1;
#endif
        }
        __syncthreads();
    }
}

struct TileOrder {
    int nM, nN, a0, b0, G, c;
    __device__ __forceinline__ bool next(int i, pg8::Unit& u) const {
        const int nwg = nM * nN; const int L = i * G + c; if (L >= nwg) return false;
        int w; { const int q = nwg / 8, r = nwg % 8, xcd = L % 8, off = L / 8; w = (xcd < r ? xcd * (q + 1) : r * (q + 1) + (xcd - r) * q) + off; }
        const int nig = 8 * nN, gid = w / nig, wi = w % nig; u.pm = a0 + gid * 8 + (wi % 8); u.pn = b0 + wi / 8; return true;
    }
    __device__ __forceinline__ void a_ready(const pg8::Unit&) const {}
    __device__ __forceinline__ void done(const pg8::Unit&) const {}
};
struct EpiOut {
    static constexpr bool PERM = false, AFTER_DRAIN = false, F8 = OUTPROJ_F8 != 0;
    const float* x; const float* bias; float* r1;
    __device__ __forceinline__ void operator()(const pg8::f32x4 (&acc)[2][2][4][2], const pg8::Unit& u, int wr, int wc, int fr, int fq) const {
        constexpr int TS = OUTPROJ_F8 ? 2 : 1; constexpr float WSC = OUTPROJ_F8 ? 1.0f / (W8_SCALE * Y8_SCALE) : 1.0f;
        const int row0 = (u.pm - TS * YCAT_T0) * 256 + wr * 64 + fr, col0 = (u.pn - TS * WOUT_T0) * 256 + wc * 32 + 4 * fq;
        pg8::f32x4 bv[2][2];
#pragma unroll
        for (int bj = 0; bj < 2; ++bj)
#pragma unroll
            for (int n = 0; n < 2; ++n) bv[bj][n] = *(const pg8::f32x4*)(bias + col0 + bj * 128 + n * 16);
#pragma unroll
        for (int ai = 0; ai < 2; ++ai)
#pragma unroll
            for (int m = 0; m < 4; ++m) { const size_t off = (size_t)(row0 + ai * 128 + m * 16) * D + col0;
#pragma unroll
                for (int bj = 0; bj < 2; ++bj)
#pragma unroll
                    for (int n = 0; n < 2; ++n) { const pg8::f32x4 xs = *(const pg8::f32x4*)(x + off + bj * 128 + n * 16);
                        *(pg8::f32x4*)(r1 + off + bj * 128 + n * 16) = xs * DN_ALPHA + acc[ai][bj][m][n] * WSC + bv[bj][n]; } }
    }
};

#define P6_RS_STEP(NV, XM) do { const bool up = (lane & (XM)) != 0; _Pragma("unroll") for (int e_ = 0; e_ < (NV); ++e_) { \
        const float keep0 = up ? a0[e_ + (NV)] : a0[e_], send0 = up ? a0[e_] : a0[e_ + (NV)]; a0[e_] = keep0 + __shfl_xor(send0, (XM)); \
        const float keep1 = up ? a1[e_ + (NV)] : a1[e_], send1 = up ? a1[e_] : a1[e_ + (NV)]; a1[e_] = keep1 + __shfl_xor(send1, (XM)); } } while (0)
__device__ __forceinline__ void phase6(const Ctx& C, int dummy) {
    unsigned char* ws = C.ws;
    float* r1 = (float*)(ws + WS_R1); bf16* x1b = (bf16*)(ws + (size_t)X1B_T0 * MiB);
    const float* g1 = C.A.in[18]; const float* b1 = C.A.in[19]; const float* rw = C.A.in[20]; const float* rb = C.A.in[21];
    unsigned* cnt = (unsigned*)(ws + WS_CTL) + CW_CNT + (dummy ? 4096 : 0); int* list = (int*)(ws + (dummy ? WS_YBUF : WS_LIST)); float* tokw = (float*)(ws + (dummy ? WS_YBUF + 2 * MiB : WS_TOKW));
    const int lane = C.lane;
    LAS unsigned char* wbuf = C.lds;
    LAS unsigned* hist = (LAS unsigned*)(C.lds + 65536); LAS unsigned* hbase = hist + 32;
    if (C.tid < NE) hist[C.tid] = 0u;
    __syncthreads();
    for (int it = blockIdx.x; it < T / 16; it += C.G) {
        const int pair = it * 8 + C.wave;
        int ln = lane; asm volatile("" : "+v"(ln));
        f32x4 v0[8], v1[8];
#pragma unroll
        for (int tk = 0; tk < 2; ++tk) {
            const int tok = 2 * pair + tk; float* rr = r1 + (size_t)tok * D; f32x4 v[8]; float s = 0.f;
#pragma unroll
            for (int j = 0; j < 8; ++j) { v[j] = *(const f32x4*)(rr + (ln + 64 * j) * 4); s += (v[j].x + v[j].y) + (v[j].z + v[j].w); }
            const float mean = wave_sum(s) * (1.0f / D); float q = 0.f;
#pragma unroll
            for (int j = 0; j < 8; ++j) { v[j] = v[j] - mean; q += (v[j].x * v[j].x + v[j].y * v[j].y) + (v[j].z * v[j].z + v[j].w * v[j].w); }
            const float rstd = 1.0f / sqrtf(wave_sum(q) * (1.0f / D) + LN_EPS);
#pragma unroll
            for (int j = 0; j < 8; ++j) { const int c0 = (ln + 64 * j) * 4; const f32x4 gg = *(const f32x4*)(g1 + c0), bb = *(const f32x4*)(b1 + c0);
                const f32x4 y = v[j] * rstd * gg + bb;
                if (!dummy) { v2u w; w.x = pk2(y.x, y.y); w.y = pk2(y.z, y.w); *(v2u*)(x1b + (size_t)tok * D + c0) = w; }
                if (!dummy) { unsigned q8 = 0u; q8 = __builtin_amdgcn_cvt_pk_fp8_f32(y.x, y.y, q8, false); q8 = __builtin_amdgcn_cvt_pk_fp8_f32(y.z, y.w, q8, true); *(unsigned*)(ws + WS_X1Q + (size_t)tok * D + c0) = q8; }
                if (tk == 0) v0[j] = y; else v1[j] = y; }
        }
        int my_e0 = 0, my_r0 = 0, my_e1 = 0, my_r1 = 0;
        float a0[32], a1[32];
#pragma unroll
        for (int e = 0; e < 32; ++e) { a0[e] = 0.f; a1[e] = 0.f; }
        const int tid = C.tid; f32x4 st[4];
        const bool hi8 = (ln & 8) != 0;
        const unsigned rdoff = (unsigned)(4 * ln) * 128u, rdx = (unsigned)(ln & 7);
#define P6_CHUNK_LOAD(j_) do { _Pragma("unroll") for (int r_ = 0; r_ < 4; ++r_) st[r_] = *(const f32x4*)(rw + (size_t)(j_) * 8192 + (size_t)(tid + 512 * r_) * 4); } while (0)
#define P6_CHUNK_STORE(b_) do { _Pragma("unroll") for (int r_ = 0; r_ < 4; ++r_) { const int idx_ = tid + 512 * r_, row_ = idx_ >> 3, q_ = idx_ & 7; \
            *(LAS f32x4*)(wbuf + (b_) * 32768 + row_ * 128 + 16 * (q_ ^ ((row_ >> 2) & 7))) = st[r_]; } } while (0)
        __syncthreads();
        P6_CHUNK_LOAD(0); P6_CHUNK_STORE(0);
        __syncthreads();
#pragma unroll
        for (int j = 0; j < 8; ++j) {
            if (j < 7) P6_CHUNK_LOAD(j + 1);
            const LAS unsigned char* wb = wbuf + (j & 1) * 32768 + rdoff;
#pragma unroll
            for (int i = 0; i < 4; ++i) {
                const float x0 = hi8 ? v0[j][i ^ 1] : v0[j][i], x1 = hi8 ? v1[j][i ^ 1] : v1[j][i];
                const LAS unsigned char* wrow = wb + (hi8 ? (i ^ 1) : i) * 128;
#pragma unroll
                for (int q4 = 0; q4 < 8; ++q4) { const f32x4 w4 = *(const LAS f32x4*)(wrow + 16 * (q4 ^ rdx));
                    a0[4 * q4] += x0 * w4.x; a0[4 * q4 + 1] += x0 * w4.y; a0[4 * q4 + 2] += x0 * w4.z; a0[4 * q4 + 3] += x0 * w4.w;
                    a1[4 * q4] += x1 * w4.x; a1[4 * q4 + 1] += x1 * w4.y; a1[4 * q4 + 2] += x1 * w4.z; a1[4 * q4 + 3] += x1 * w4.w; }
            }
            if (j < 7) P6_CHUNK_STORE((j + 1) & 1);
            __syncthreads();
        }
#undef P6_CHUNK_LOAD
#undef P6_CHUNK_STORE
        P6_RS_STEP(16, 32); P6_RS_STEP(8, 16); P6_RS_STEP(4, 8); P6_RS_STEP(2, 4); P6_RS_STEP(1, 2);
        int le_ = lane; asm volatile("" : "+v"(le_));
        const int e = le_ >> 1; const float rbe = rb[e];
        float lg0 = a0[0] + __shfl_xor(a0[0], 1) + rbe, lg1 = a1[0] + __shfl_xor(a1[0], 1) + rbe;
#pragma unroll
        for (int tk = 0; tk < 2; ++tk) {
            const int tok = 2 * pair + tk; float val = tk ? lg1 : lg0; float vals[4]; int idxs[4];
#pragma unroll
            for (int k = 0; k < 4; ++k) {
                const float m = wave_max(val);
                const unsigned long long bal = __ballot(val == m);
                const int idx = (int)(__builtin_ctzll(bal) >> 1);
                vals[k] = m; idxs[k] = idx;
                if (e == idx) val = -3.0e38f;
            }
            const float e1 = expf(vals[1] - vals[0]), e2 = expf(vals[2] - vals[0]), e3 = expf(vals[3] - vals[0]);
            const float inv = 1.0f / (1.0f + e1 + e2 + e3);
            if (lane < 4) {
                const int sel_e = lane == 0 ? idxs[0] : lane == 1 ? idxs[1] : lane == 2 ? idxs[2] : idxs[3];
                const float sel_v = (lane == 0 ? 1.0f : lane == 1 ? e1 : lane == 2 ? e2 : e3) * inv;
                { int lq_ = lane; asm volatile("" : "+v"(lq_)); tokw[tok * 4 + lq_] = sel_v; }
                const int rk = (int)__hip_atomic_fetch_add(hist + sel_e, 1u, __ATOMIC_RELAXED, __HIP_MEMORY_SCOPE_WORKGROUP);
                if (tk == 0) { my_e0 = sel_e; my_r0 = rk; } else { my_e1 = sel_e; my_r1 = rk; }
            }
        }
        __syncthreads();
        int tl = C.tid; asm volatile("" : "+v"(tl));
        if (tl < NE) { const unsigned n = hist[tl]; hbase[tl] = n ? atomicAdd(cnt + 64 * tl, n) : 0u; }
        __syncthreads();
        if (lane < 4) { int lq_ = lane; asm volatile("" : "+v"(lq_)); list[my_e0 * T + (int)hbase[my_e0] + my_r0] = (2 * pair) * 4 + lq_; list[my_e1 * T + (int)hbase[my_e1] + my_r1] = (2 * pair + 1) * 4 + lq_; }
        __syncthreads();
        if (tl < NE) hist[tl] = 0u;
    }
}
#undef P6_RS_STEP

__device__ __forceinline__ void moe_build_tb(const Ctx& C) {
    LAS int* tb = (LAS int*)(C.lds + LDS_TB);
    __syncthreads();
    if (C.tid == 0) { const unsigned* cnt = (const unsigned*)(C.ws + WS_CTL) + CW_CNT; int acc = 0;
        for (int e = 0; e < NE; ++e) { const int n = (int)__hip_atomic_load(cnt + 64 * e, __ATOMIC_RELAXED, __HIP_MEMORY_SCOPE_AGENT); tb[e] = acc; tb[40 + e] = n; acc += (n + 255) >> 8; }
        tb[32] = acc; }
    __syncthreads();
}
struct MoeOrder {
    const LAS int* tb; int NJ, a0, w0, G, c; const int* list; int gather;
    const LAS int* ul; const LAS int* rowt;
    __device__ __forceinline__ bool compute(int i, pg8::Unit& u) const {
        const int nwg = tb[32] * NJ; const int L = i * G + c; if (L >= nwg) return false;
        int w; { const int q = nwg / 8, r = nwg % 8, xcd = L % 8, off = L / 8; w = (xcd < r ? xcd * (q + 1) : r * (q + 1) + (xcd - r) * q) + off; }
        int e = 0;
        while (e < NE - 1 && tb[e + 1] * NJ <= w) ++e;
        const int local = w - tb[e] * NJ, nt = tb[e + 1] - tb[e], j = local / nt, ti = local - j * nt;
        u.pm = a0 + tb[e] + ti; u.pn = w0 + e * NJ + j; return true;
    }
    __device__ __forceinline__ bool next(int i, pg8::Unit& u) const {
        if (i < MOE_MAXU) { const int pm = __builtin_amdgcn_readfirstlane(ul[i]); if (pm < 0) return false; u.pm = pm; u.pn = __builtin_amdgcn_readfirstlane(ul[16 + i]); return true; }
        pg8::Unit t; const bool ok = compute(i, t); if (!ok) return false; u.pm = __builtin_amdgcn_readfirstlane(t.pm); u.pn = __builtin_amdgcn_readfirstlane(t.pn); return true;
    }
    __device__ __forceinline__ int row_slow(const pg8::Unit& u, int r) const { const int e = (u.pn - w0) / NJ; const int i = (u.pm - a0 - tb[e]) * 256 + r; return i < tb[40 + e] ? (list[e * T + i] >> 2) : 0; }
    __device__ __forceinline__ int a_row(const pg8::Unit& u, int idx, int r) const { if (!gather) return (u.pm - a0) * 256 + r; if (idx < MOE_MAXU) return rowt[idx * 256 + r]; return row_slow(u, r); }
    __device__ __forceinline__ int b_tile(const pg8::Unit& u) const { return u.pn - w0; }
    __device__ __forceinline__ void a_ready(const pg8::Unit&) const {}
    __device__ __forceinline__ void done(const pg8::Unit&) const {}
    __device__ __forceinline__ void setup(int tid) const {
        LAS int* ulw = (LAS int*)ul; LAS int* rtw = (LAS int*)rowt;
        if (tid < MOE_MAXU) { pg8::Unit t; const bool ok = compute(tid, t); ulw[tid] = ok ? t.pm : -1; ulw[16 + tid] = ok ? t.pn : 0; }
        __syncthreads();
        if (gather) for (int idx = tid; idx < MOE_MAXU * 256; idx += NTHREADS) { const int i = idx >> 8; const int pm = ul[i]; if (pm >= 0) { pg8::Unit t; t.pm = pm; t.pn = ul[16 + i]; rtw[idx] = row_slow(t, idx & 255); } }
        __syncthreads();
    }
};
struct EpiGU {
    static constexpr bool PERM = true, AFTER_DRAIN = false, F8 = true;
    const float* b_gu; unsigned char* act; float wsc;
    __device__ __forceinline__ void operator()(const pg8::f32x4 (&acc)[2][2][4][2], const pg8::Unit& u, int wr, int wc, int fr_, int fq_) const {
        int ln_ = threadIdx.x & 63; asm volatile("" : "+v"(ln_));
        const int fr = ln_ & 15, fq = ln_ >> 4;
        using pg8::cvt_pk_bf16;
        const int rt = u.pm - ABUF_T0, rel = u.pn - WGU_Q0, e = rel >> 4, j = rel & 15;
        const int col0 = j * 128 + wc * 32 + 8 * fq;
        pg8::f32x4 bg[2], bu[2];
#pragma unroll
        for (int n = 0; n < 2; ++n) { bg[n] = *(const pg8::f32x4*)(b_gu + (size_t)e * 4096 + col0 + 4 * n); bu[n] = *(const pg8::f32x4*)(b_gu + (size_t)e * 4096 + 2048 + col0 + 4 * n); }
#pragma unroll
        for (int ai = 0; ai < 2; ++ai)
#pragma unroll
            for (int m = 0; m < 4; ++m) { const int row = rt * 256 + ai * 128 + wr * 64 + m * 16 + fr;
                float o[8];
#pragma unroll
                for (int n = 0; n < 2; ++n) { const pg8::f32x4 g = acc[ai][0][m][n] * wsc + bg[n], up = acc[ai][1][m][n] * wsc + bu[n];
#pragma unroll
                    for (int i = 0; i < 4; ++i) { const float gc = fminf(g[i], 7.0f), uc = fminf(fmaxf(up[i], -7.0f), 7.0f);
                        o[4 * n + i] = (uc + 1.0f) * (gc / (1.0f + __expf(-1.702f * gc))); } }
                v2u w; w.x = __builtin_amdgcn_cvt_pk_fp8_f32(o[0], o[1], 0u, false); w.x = __builtin_amdgcn_cvt_pk_fp8_f32(o[2], o[3], w.x, true);
                w.y = __builtin_amdgcn_cvt_pk_fp8_f32(o[4], o[5], 0u, false); w.y = __builtin_amdgcn_cvt_pk_fp8_f32(o[6], o[7], w.y, true);
                *(v2u*)(act + (size_t)row * DFF + col0) = w; }
    }
};
struct EpiDown {
    static constexpr bool PERM = true, AFTER_DRAIN = false, F8 = true;
    const float* b_down; const int* list; const float* tokw; const LAS int* tb; bf16* ybuf; float wsc;
    __device__ __forceinline__ void operator()(const pg8::f32x4 (&acc)[2][2][4][2], const pg8::Unit& u, int wr, int wc, int fr_, int fq_) const {
        using pg8::cvt_pk_bf16;
        int ln_ = threadIdx.x & 63; asm volatile("" : "+v"(ln_));
        const int fr = ln_ & 15, fq = ln_ >> 4;
        const int rel = u.pn - WDN_Q0, e = rel >> 3, j = rel & 7, ti = u.pm - ACT_Q0 - tb[e], n_e = tb[40 + e];
        const int col0 = j * 256 + wc * 32 + 8 * fq;
        pg8::f32x4 bv[2][2];
#pragma unroll
        for (int bj = 0; bj < 2; ++bj)
#pragma unroll
            for (int n = 0; n < 2; ++n) bv[bj][n] = *(const pg8::f32x4*)(b_down + (size_t)e * D + col0 + bj * 128 + 4 * n);
#pragma unroll
        for (int ai = 0; ai < 2; ++ai)
#pragma unroll
            for (int m = 0; m < 4; ++m) { const int i = ti * 256 + ai * 128 + wr * 64 + m * 16 + fr;
                if (i < n_e) { const int slot = list[e * T + i]; const float w = tokw[slot]; bf16* dst = ybuf + (size_t)slot * D + col0;
#pragma unroll
                    for (int bj = 0; bj < 2; ++bj) { const pg8::f32x4 v0 = (acc[ai][bj][m][0] * wsc + bv[bj][0]) * w, v1 = (acc[ai][bj][m][1] * wsc + bv[bj][1]) * w;
                        v4u o; o.x = cvt_pk_bf16(v0[0], v0[1]); o.y = cvt_pk_bf16(v0[2], v0[3]); o.z = cvt_pk_bf16(v1[0], v1[1]); o.w = cvt_pk_bf16(v1[2], v1[3]);
                        *(v4u*)(dst + bj * 128) = o; } } }
    }
};

namespace pg8 {
template <class Epi, class Sched, class Side>
__device__ __forceinline__ void gemm_phase_ga(PG8_LAS unsigned char* lds, const bf16_t* Arows, const bf16_t* Btiles, const int K, const Sched& S, const Epi& E, const Side& SD) {
    const int tid = threadIdx.x, wid = __builtin_amdgcn_readfirstlane(tid >> 6), lane = tid & 63, wr = wid >> 2, wc = wid & 3, fr = lane & 15, fq = lane >> 4;
    const int nt = K / BK;
    unsigned voffB[2];
#pragma unroll
    for (int i = 0; i < 2; ++i) { int R, Cc; stage_rc(tid * 16 + i * 8192, R, Cc); const int Rb = Epi::PERM ? ((R & ~31) + perm32(R & 31)) : R; voffB[i] = (unsigned)(Rb * K + Cc) * 2u; }
    const size_t kstep = (size_t)(BK * 2), hstep = (size_t)HALF * K * 2, tstep = 2 * hstep;
    const unsigned ldsw = (unsigned)wid * 1024u;
    const int aoff = lds_byte(wr * 64 + fr, fq * 8), boff = lds_byte(wc * 32 + fr, fq * 8);
#define PG8_SA(b, h) (((b) * 2 + (h)) * HTB)
#define PG8_SB(b, h) ((4 + (b) * 2 + (h)) * HTB)
    const unsigned ldsb = __builtin_amdgcn_readfirstlane((unsigned)(size_t)lds + ldsw);
#define PG8_DMA(gptr, vo, laddr) asm volatile("s_mov_b32 m0, %2\n\tglobal_load_lds_dwordx4 %0, %1" :: "v"(vo), "s"(gptr), "s"(laddr) : "memory", "m0")
#define PG8_STAGE(bufoff, gbase, voff) do { _Pragma("unroll") for (int _i = 0; _i < 2; ++_i) PG8_DMA((const char*)(gbase), (voff)[_i], ldsb + (unsigned)((bufoff) + _i * 8192)); } while (0)
#define PG8_STAGE2(bufoff, gbase, v0, v1) do { PG8_DMA((const char*)(gbase), v0, ldsb + (unsigned)(bufoff)); PG8_DMA((const char*)(gbase), v1, ldsb + (unsigned)((bufoff) + 8192)); } while (0)
#define PG8_LDA(dst, b, h) do { _Pragma("unroll") for (int m = 0; m < 4; ++m) _Pragma("unroll") for (int k = 0; k < 2; ++k) dst[m][k] = *(const PG8_LAS bf16x8*)(lds + PG8_SA(b, h) + aoff + m * 2048 + k * 1024); } while (0)
#define PG8_LDB(dst, b, h) do { _Pragma("unroll") for (int n = 0; n < 2; ++n) _Pragma("unroll") for (int k = 0; k < 2; ++k) dst[n][k] = *(const PG8_LAS bf16x8*)(lds + PG8_SB(b, h) + boff + n * 2048 + k * 1024); } while (0)
#define PG8_MMA(ai, bj, At, Bt) do { __builtin_amdgcn_s_setprio(1); if constexpr (epi_f8<Epi>::v) { _Pragma("unroll") for (int m = 0; m < 4; ++m) _Pragma("unroll") for (int n = 0; n < 2; ++n) \
        acc[ai][bj][m][n] = __builtin_amdgcn_mfma_scale_f32_16x16x128_f8f6f4(cat8(Bt[n][0], Bt[n][1]), cat8(At[m][0], At[m][1]), acc[ai][bj][m][n], 0, 0, 0, 0, 0, 0); } else { \
        _Pragma("unroll") for (int m = 0; m < 4; ++m) _Pragma("unroll") for (int n = 0; n < 2; ++n) _Pragma("unroll") for (int k = 0; k < 2; ++k) \
        acc[ai][bj][m][n] = __builtin_amdgcn_mfma_f32_16x16x32_bf16(Bt[n][k], At[m][k], acc[ai][bj][m][n], 0, 0, 0); } __builtin_amdgcn_s_setprio(0); } while (0)
#define PG8_WAIT_V(n) asm volatile("s_waitcnt vmcnt(" #n ")" ::: "memory")
#define PG8_WAIT_L(n) asm volatile("s_waitcnt lgkmcnt(" #n ")" ::: "memory")
#define PG8_BAR __builtin_amdgcn_s_barrier()
#define PG8_SCHED __builtin_amdgcn_sched_barrier(0)
#define PG8_AROWS(vo, u, ix) do { int t_ = threadIdx.x; asm volatile("" : "+v"(t_)); _Pragma("unroll") for (int _i = 0; _i < 2; ++_i) { int R_, C_; stage_rc(t_ * 16 + _i * 8192, R_, C_); \
        _Pragma("unroll") for (int _h = 0; _h < 2; ++_h) vo[_h * 2 + _i] = (unsigned)S.a_row(u, ix, _h * 128 + R_) * (unsigned)(K * 2) + (unsigned)(C_ * 2); } } while (0)
    const int skh = 0, snq = wid;
#define PG8_SGV() ({ int t_ = tid; asm volatile("" : "+v"(t_)); (unsigned)((4 * (t_ & 31)) * SD.ldb + 4 * ((t_ >> 5) & 1)) * 4u; })
#define PG8_SDV() ({ int t_ = tid; asm volatile("" : "+v"(t_)); (unsigned)(4 * ((t_ >> 5) & 1)) * 2048u + 4u * (unsigned)(t_ & 31); })
    const size_t sldb4 = Side::ON ? (size_t)SD.ldb * 4 : 0;
    int sstep = Side::ON ? SD.first : 0, sprev = 0, sit = (int)(blockIdx.x >> 3) % Side::PERIOD, sext = 0, sage = 0; bool spend = false;
    f32x4 sx[4] = {(f32x4){0.f, 0.f, 0.f, 0.f}, (f32x4){0.f, 0.f, 0.f, 0.f}, (f32x4){0.f, 0.f, 0.f, 0.f}, (f32x4){0.f, 0.f, 0.f, 0.f}};
    typedef unsigned u32x2s __attribute__((ext_vector_type(2)));
#define PG8_SIDE_LOAD() do { const char* sp_ = (const char*)SD.src(sstep, skh, snq); const unsigned sgv = PG8_SGV(); _Pragma("unroll") for (int _j = 0; _j < 4; ++_j) \
        asm volatile("global_load_dwordx4 %0, %1, %2" : "+v"(sx[_j]) : "v"(sgv), "s"(sp_ + (size_t)_j * sldb4) : "memory"); sprev = sstep; sstep += SD.stride; } while (0)
#define PG8_SIDE_STORE() do { asm volatile("" : "+v"(sx[0]), "+v"(sx[1]), "+v"(sx[2]), "+v"(sx[3])); \
        char* dp_ = (char*)SD.dst(sprev, skh, snq); const unsigned sdv = PG8_SDV(); _Pragma("unroll") for (int _i = 0; _i < 4; ++_i) { unsigned _w = 0u; \
            _w = __builtin_amdgcn_cvt_pk_fp8_f32(sx[0][_i] * W8_SCALE, sx[1][_i] * W8_SCALE, _w, false); _w = __builtin_amdgcn_cvt_pk_fp8_f32(sx[2][_i] * W8_SCALE, sx[3][_i] * W8_SCALE, _w, true); \
            asm volatile("global_store_dword %0, %1, %2" :: "v"(sdv), "v"(_w), "s"(dp_ + (size_t)_i * 2048) : "memory"); } } while (0)
#define PG8_SIDE_SLOT() do { if constexpr (Side::ON && Side::PAIR) { int ext_ = 0; if (spend) { PG8_SIDE_STORE(); spend = false; ext_ += 4; } \
        if (sstep < SD.nsteps) { PG8_SIDE_LOAD(); spend = true; ext_ += 4; } sext = ext_; } else if constexpr (Side::ON) { int ext_ = 0; if (spend) { if (++sage == Side::LAG) { if (Side::LAG == 1) PG8_WAIT_V(8); PG8_SIDE_STORE(); spend = false; ext_ += 4; } } \
        if (!spend && (sit % Side::PERIOD == 0) && (sstep < SD.nsteps)) { PG8_SIDE_LOAD(); spend = true; sage = 0; ext_ += 4; } ++sit; sext = ext_; } } while (0)
#define PG8_WAIT_K() do { if constexpr (Side::ON) { if (sext == 0) PG8_WAIT_V(8); else if (sext == 4) PG8_WAIT_V(12); else PG8_WAIT_V(16); } else PG8_WAIT_V(8); } while (0)
#define PG8_VON_LOAD(y0, y1, y2, y3) do { typedef unsigned u32x2_ __attribute__((ext_vector_type(2))); const u32x2_ q_ = *(const PG8_LAS u32x2_*)(lds + LDS_VON + tid * 8); \
        const unsigned rs_ = (unsigned)__builtin_ctz((unsigned)(K * 2)), m_ = (unsigned)(K * 2) - 1u, c0_ = voC[0] & m_, c1_ = voC[1] & m_; \
        y0 = ((q_.x & 0xffffu) << rs_) | c0_; y1 = ((q_.x >> 16) << rs_) | c1_; y2 = ((q_.y & 0xffffu) << rs_) | c0_; y3 = ((q_.y >> 16) << rs_) | c1_; } while (0)
    Unit cur, nxt; int ui = 0;
    if (!S.next(0, cur)) {
        if constexpr (Side::ON) { while (sstep < SD.nsteps) { PG8_SIDE_LOAD(); PG8_WAIT_V(0); PG8_SIDE_STORE(); } PG8_WAIT_V(0); }
        return;
    }
    f32x4 acc[2][2][4][2];
#pragma unroll
    for (int a = 0; a < 2; ++a)
#pragma unroll
        for (int b = 0; b < 2; ++b)
#pragma unroll
            for (int m = 0; m < 4; ++m)
#pragma unroll
                for (int n = 0; n < 2; ++n) acc[a][b][m][n] = (f32x4){0.f, 0.f, 0.f, 0.f};
    bf16x8 At[4][2], B0[2][2], B1[2][2];
    unsigned voC[4];
    PG8_AROWS(voC, cur, 0);
    const char* cA = (const char*)Arows; const char* cB = (const char*)Btiles + (size_t)cur.pn * tstep;
    PG8_STAGE(PG8_SB(0, 0), cB, voffB); PG8_STAGE(PG8_SB(0, 1), cB + hstep, voffB); PG8_STAGE2(PG8_SA(0, 0), cA, voC[0], voC[1]); PG8_STAGE2(PG8_SA(0, 1), cA, voC[2], voC[3]);
    if (wr == 1) PG8_BAR;
    PG8_WAIT_V(2); PG8_BAR;
    PG8_STAGE(PG8_SB(1, 0), cB + kstep, voffB); PG8_STAGE2(PG8_SA(1, 0), cA + kstep, voC[0], voC[1]); PG8_STAGE(PG8_SB(1, 1), cB + hstep + kstep, voffB);
    PG8_WAIT_V(6); PG8_BAR;
    for (;;) {
        const bool has_next = S.next(ui + 1, nxt);
        if (has_next) { unsigned vn_[4]; PG8_AROWS(vn_, nxt, ui + 1); typedef unsigned u32x2_ __attribute__((ext_vector_type(2)));
            const unsigned rs_ = (unsigned)__builtin_ctz((unsigned)(K * 2));
            *(PG8_LAS u32x2_*)(lds + LDS_VON + tid * 8) = (u32x2_){(vn_[0] >> rs_) | ((vn_[1] >> rs_) << 16), (vn_[2] >> rs_) | ((vn_[3] >> rs_) << 16)}; }
        const char* nB = has_next ? (const char*)Btiles + (size_t)nxt.pn * tstep : cB;
        for (int t = 0; t < nt; t += 2) {
            const bool last = (t == nt - 2);
            const char* a1 = cA + (size_t)(t + 1) * kstep;
            const char* a2 = last ? cA : cA + (size_t)(t + 2) * kstep; const char* b2 = last ? nB : cB + (size_t)(t + 2) * kstep;
            const char* a3 = a2 + kstep; const char* b3 = b2 + kstep;
            PG8_LDB(B0, 0, 0); PG8_LDB(B1, 0, 1); PG8_SCHED; PG8_LDA(At, 0, 0); PG8_STAGE2(PG8_SA(1, 1), a1, voC[2], voC[3]);
            if (last && has_next) PG8_VON_LOAD(voC[0], voC[1], voC[2], voC[3]);
            PG8_WAIT_K(); PG8_WAIT_L(0); PG8_BAR; PG8_MMA(0, 0, At, B0); PG8_MMA(0, 1, At, B1); PG8_BAR; PG8_SCHED;
            PG8_LDA(At, 0, 1); PG8_STAGE(PG8_SB(0, 0), b2, voffB); PG8_STAGE(PG8_SB(0, 1), b2 + hstep, voffB); PG8_STAGE2(PG8_SA(0, 0), a2, voC[0], voC[1]);
            PG8_WAIT_K(); PG8_SIDE_SLOT(); PG8_WAIT_L(0); PG8_BAR; PG8_MMA(1, 0, At, B0); PG8_MMA(1, 1, At, B1); PG8_BAR; PG8_SCHED;
            PG8_LDB(B0, 1, 0); PG8_LDB(B1, 1, 1); PG8_SCHED; PG8_LDA(At, 1, 0); PG8_STAGE2(PG8_SA(0, 1), a2, voC[2], voC[3]);
            PG8_WAIT_K(); PG8_WAIT_L(0); PG8_BAR; PG8_MMA(0, 0, At, B0); PG8_MMA(0, 1, At, B1); PG8_BAR; PG8_SCHED;
            PG8_LDA(At, 1, 1); PG8_STAGE(PG8_SB(1, 0), b3, voffB); PG8_STAGE(PG8_SB(1, 1), b3 + hstep, voffB); PG8_STAGE2(PG8_SA(1, 0), a3, voC[0], voC[1]);
            PG8_WAIT_K(); if constexpr (Side::PAIR) { sext = 0; } else { PG8_SIDE_SLOT(); } PG8_WAIT_L(0); PG8_BAR; PG8_MMA(1, 0, At, B0); PG8_MMA(1, 1, At, B1); PG8_BAR; PG8_SCHED;
        }
        if (wr == 0) PG8_BAR;
        if constexpr (epi_f8<Epi>::v) asm volatile("s_nop 7\n\ts_nop 7\n\ts_nop 7\n\ts_nop 7");
        E(acc, cur, wr, wc, fr, fq); S.done(cur);
        if (!has_next) break;
#pragma unroll
        for (int a = 0; a < 2; ++a)
#pragma unroll
            for (int b = 0; b < 2; ++b)
#pragma unroll
                for (int m = 0; m < 4; ++m)
#pragma unroll
                    for (int n = 0; n < 2; ++n) acc[a][b][m][n] = (f32x4){0.f, 0.f, 0.f, 0.f};
        cur = nxt; cB = nB; ++ui;
        if (wr == 1) PG8_BAR;
    }
    PG8_WAIT_V(0);
    PG8_BAR;
    if constexpr (Side::ON) { if (spend) { PG8_SIDE_STORE(); } while (sstep < SD.nsteps) { PG8_SIDE_LOAD(); PG8_WAIT_V(0); PG8_SIDE_STORE(); } PG8_WAIT_V(0); }
#undef PG8_SA
#undef PG8_SB
#undef PG8_STAGE
#undef PG8_STAGE2
#undef PG8_DMA
#undef PG8_LDA
#undef PG8_LDB
#undef PG8_MMA
#undef PG8_WAIT_V
#undef PG8_WAIT_L
#undef PG8_BAR
#undef PG8_SCHED
#undef PG8_AROWS
#undef PG8_SIDE_LOAD
#undef PG8_VON_LOAD
#undef PG8_SGV
#undef PG8_SDV
#undef PG8_SIDE_STORE
#undef PG8_SIDE_SLOT
#undef PG8_WAIT_K
}
}

struct NoSide { static constexpr bool ON = false, PAIR = false; static constexpr int PERIOD = 1, LAG = 1; int ldb, first, stride, nsteps;
    __device__ __forceinline__ const float* src(int, int, int) const { return nullptr; } __device__ __forceinline__ bf16* dst(int, int, int) const { return nullptr; } };
template <int PER, int LG> struct SideGU { static constexpr bool ON = true, PAIR = false; static constexpr int PERIOD = PER, LAG = LG; const float* w; unsigned char* wt; int ldb, first, stride, nsteps;
    __device__ __forceinline__ const float* src(int hs, int kh, int nq) const { const int qq = hs & 3, st = hs >> 2, tile = st >> 4, kt = st & 15, e = tile >> 4, j = tile & 15;
        return w + (size_t)e * 2048 * 4096 + (size_t)(128 * kt) * 4096 + ((qq >> 1) ? 2048 : 0) + 128 * j + 64 * (qq & 1) + 8 * nq; }
    __device__ __forceinline__ unsigned char* dst(int hs, int kh, int nq) const { const int qq = hs & 3, st = hs >> 2, tile = st >> 4, kt = st & 15; return wt + ((size_t)tile * 256 + 64 * qq + 8 * nq) * 2048 + 128 * kt; } };
template <int PER, int LG> struct SideDown { static constexpr bool ON = true, PAIR = true  ; static constexpr int PERIOD = PER, LAG = LG; const float* w; unsigned char* wt; int ldb, first, stride, nsteps;
    __device__ __forceinline__ const float* src(int hs, int kh, int nq) const { const int qq = hs & 3, st = hs >> 2, tile = st >> 4, kt = st & 15, e = tile >> 3, j = tile & 7;
        return w + (size_t)e * 2048 * 2048 + (size_t)(128 * kt) * 2048 + 256 * j + 64 * qq + 8 * nq; }
    __device__ __forceinline__ unsigned char* dst(int hs, int kh, int nq) const { const int qq = hs & 3, st = hs >> 2, tile = st >> 4, kt = st & 15; return wt + ((size_t)tile * 256 + 64 * qq + 8 * nq) * 2048 + 128 * kt; } };

__device__ __forceinline__ void phase10(const Ctx& C) {
    unsigned char* ws = C.ws;
    const bf16* x1b = (const bf16*)(ws + (size_t)X1B_T0 * MiB); const bf16* ybuf = (const bf16*)(ws + WS_YBUF);
    const float* g2 = C.A.in[26]; const float* b2 = C.A.in[27]; const int lane = C.lane;
    for (int tok = C.gw; tok < T; tok += C.NGW) {
        f32x4 v[8]; float s = 0.f;
#pragma unroll
        for (int j = 0; j < 8; ++j) { const int c0 = (lane + 64 * j) * 4; const v2u xw = *(const v2u*)(x1b + (size_t)tok * D + c0); f32x4 a = (f32x4){bflo(xw.x), bfhi(xw.x), bflo(xw.y), bfhi(xw.y)} * DN_ALPHA;
#pragma unroll
            for (int k = 0; k < 4; ++k) { const v2u yw = *(const v2u*)(ybuf + ((size_t)tok * 4 + k) * D + c0); a = a + (f32x4){bflo(yw.x), bfhi(yw.x), bflo(yw.y), bfhi(yw.y)}; }
            v[j] = a; s += (a.x + a.y) + (a.z + a.w); }
        const float mean = wave_sum(s) * (1.0f / D); float q = 0.f;
#pragma unroll
        for (int j = 0; j < 8; ++j) { v[j] = v[j] - mean; q += (v[j].x * v[j].x + v[j].y * v[j].y) + (v[j].z * v[j].z + v[j].w * v[j].w); }
        const float rstd = 1.0f / sqrtf(wave_sum(q) * (1.0f / D) + LN_EPS);
#pragma unroll
        for (int j = 0; j < 8; ++j) { const int c0 = (lane + 64 * j) * 4; const f32x4 gg = *(const f32x4*)(g2 + c0), bb = *(const f32x4*)(b2 + c0);
            *(f32x4*)(C.out + (size_t)tok * D + c0) = v[j] * rstd * gg + bb; }
    }
}

__global__ void __launch_bounds__(NTHREADS, 2) fwd_kernel(KArgs args) {
    extern __shared__ __attribute__((aligned(16))) unsigned char lds_raw[];
    const int tid_ = threadIdx.x, wave_ = __builtin_amdgcn_readfirstlane(tid_ >> 6), G_ = gridDim.x;
    Ctx C{args, args.out, args.ws, (LAS unsigned char*)lds_raw, tid_, tid_ & 63, wave_, G_, (int)blockIdx.x * NWAVES + wave_, G_ * NWAVES};
    volatile LAS unsigned* MISC = (volatile LAS unsigned*)(C.lds + LDS_MISC);
    if (C.tid < 4) MISC[C.tid] = 0u;
    __syncthreads();
    unsigned* ctl = (unsigned*)(args.ws + WS_CTL);
    XcdBarrier bar; bar.bar = ctl + CW_BAR; bar.x = 0; bar.st = MISC;
    const int lo = args.ph_lo, hi = args.ph_hi;
    if (hi - lo > 1) bar = xcd_barrier_post(ctl + CW_BAR, MISC);
#ifdef PROBE_PHASE
    unsigned long long pt0_ = 0, pdt_ = 0;
#define PT_BEGIN(k) do { if ((k) == PROBE_PHASE) pt0_ = __builtin_amdgcn_s_memrealtime(); } while (0)
#define PT_END(k) do { if ((k) == PROBE_PHASE) pdt_ = __builtin_amdgcn_s_memrealtime() - pt0_; } while (0)
#else
#define PT_BEGIN(k)
#define PT_END(k)
#endif
#ifndef PHASE_MASK
#define PHASE_MASK 0x7ff
#endif
#define IN(k) (((PHASE_MASK >> (k)) & 1) && lo <= (k) && (k) < hi)
#define SEAM(k) do { if (IN(k) && IN((k) + 1)) xcd_barrier(bar); PT_END(k); PT_BEGIN((k) + 1); } while (0)
    const pg8::Gemm g{(const pg8::bf16_t*)args.ws, (const pg8::bf16_t*)args.ws, 0, 0, 2048};
    PG8_LAS unsigned char* glds = (PG8_LAS unsigned char*)lds_raw;

#ifndef PROBE_DOUBLE
#define PROBE_DOUBLE 0
#endif
#define REP(k) for (int _rep = 0; _rep < (((PROBE_DOUBLE >> (k)) & 1) ? 2 : 1); ++_rep)
    PT_BEGIN(0);
    if (IN(0)) { REP(0) phase0(C); } SEAM(0);
    if (IN(1)) {
        Gemm1Order S{C.G, (int)blockIdx.x};
        unsigned char* ws = args.ws;
        Epi1 E{C.A.in[2], (bf16*)(ws + WS_HYT), (bf16*)(ws + WS_QKRAW), (bf16*)(ws + WS_VB), (bf16*)(ws + WS_OB), (float*)(ws + WS_GATES)};
#if MOE_SIDE
        { SideGU<SIDE_GU_PERIOD, SIDE_GU_LAG> SD{C.A.in[22], PROBE_SIDE_DUMMY ? (unsigned char*)(ws + WS_YBUF) : (unsigned char*)(ws + (size_t)WGU_T0 * MiB), 4096, (int)blockIdx.x, C.G, SIDE_GU_EXPERTS * 16 * 32 * 2};
          pg8::gemm_phase_ga<Epi1, Gemm1Order, SideGU<SIDE_GU_PERIOD, SIDE_GU_LAG>>(glds, (const pg8::bf16_t*)ws, (const pg8::bf16_t*)ws, 2048, S, E, SD); }
#else
        REP(1) pg8::gemm_phase<Epi1, Gemm1Order, true, true>(glds, g, S, E);
#endif
        { const pg8::Gemm g2{(const pg8::bf16_t*)(ws + WS_W3P), (const pg8::bf16_t*)(ws + WS_H2P), 0, 0, 256}; KtOrder S2{C.G, (int)blockIdx.x}; EpiKT E2{(float*)(ws + WS_KT)};
          pg8::gemm_phase<EpiKT, KtOrder, true, true>(glds, g2, S2, E2); }
    } SEAM(1);
    if (IN(2)) { REP(2) phase2(C); } SEAM(2);
    if (IN(3)) { REP(3) hyena_fft(C); REP(11) { mlstm_mfma(C); } } SEAM(3);
    if (IN(4)) { REP(4) phase4(C); } SEAM(4);
    if (IN(5)) {
        TileOrder S{32, 8, (OUTPROJ_F8 ? 2 : 1) * YCAT_T0, (OUTPROJ_F8 ? 2 : 1) * WOUT_T0, C.G, (int)blockIdx.x};
        const pg8::Gemm g5{(const pg8::bf16_t*)args.ws, (const pg8::bf16_t*)args.ws, 0, 0, OUTPROJ_F8 ? 1024 : 2048};
        EpiOut E{C.A.in[0], C.A.in[17], (float*)(args.ws + WS_R1)};
        REP(5) pg8::gemm_phase<EpiOut, TileOrder, true, true>(glds, g5, S, E);
    } SEAM(5);
    if (IN(6)) { REP(6) phase6(C, _rep); } if (IN(6) && IN(8)) xcd_barrier(bar); PT_END(6); PT_BEGIN(8);
    if (IN(8)) {
        moe_build_tb(C);
        MoeOrder S{(const LAS int*)(C.lds + LDS_TB), 16, ABUF_T0, WGU_Q0, C.G, (int)blockIdx.x, (const int*)(args.ws + WS_LIST), 1, (const LAS int*)(C.lds + LDS_UL), (const LAS int*)(C.lds + LDS_ROWT)};
        S.setup(C.tid);
        EpiGU E{C.A.in[23], args.ws + (size_t)ACT_T0 * MiB, 1.0f / W8_SCALE};
#if MOE_SIDE
        { SideDown<SIDE_DN_PERIOD, SIDE_DN_LAG> SD{C.A.in[24], PROBE_SIDE_DUMMY ? (unsigned char*)(args.ws + WS_YBUF) : (unsigned char*)(args.ws + (size_t)WDN_T0 * MiB), 2048, ((8 * HY_SETS * C.G < DN_STEPS) ? 8 * HY_SETS * C.G : DN_STEPS) + (int)blockIdx.x, C.G, DN_STEPS};
          pg8::gemm_phase_ga<EpiGU, MoeOrder, SideDown<SIDE_DN_PERIOD, SIDE_DN_LAG>>(glds, (const pg8::bf16_t*)(args.ws + WS_X1Q), (const pg8::bf16_t*)args.ws, 1024, S, E, SD); }
#else
        { NoSide SD{0, 0, 0, 0}; REP(8) pg8::gemm_phase_ga<EpiGU, MoeOrder, NoSide>(glds, (const pg8::bf16_t*)(args.ws + WS_X1Q), (const pg8::bf16_t*)args.ws, 1024, S, E, SD); }
#endif
    } SEAM(8);
    if (IN(9)) {
        moe_build_tb(C);
        MoeOrder S{(const LAS int*)(C.lds + LDS_TB), 8, ACT_Q0, WDN_Q0, C.G, (int)blockIdx.x, (const int*)(args.ws + WS_LIST), 0, (const LAS int*)(C.lds + LDS_UL), (const LAS int*)(C.lds + LDS_ROWT)};
        S.setup(C.tid);
        EpiDown E{C.A.in[25], (const int*)(args.ws + WS_LIST), (const float*)(args.ws + WS_TOKW), (const LAS int*)(C.lds + LDS_TB), (bf16*)(args.ws + WS_YBUF), 1.0f / W8_SCALE};
        const pg8::Gemm g9{(const pg8::bf16_t*)args.ws, (const pg8::bf16_t*)args.ws, 0, 0, 1024};
        REP(9) pg8::gemm_phase<EpiDown, MoeOrder, true, true>(glds, g9, S, E);
    } SEAM(9);
    if (IN(10)) { REP(10) phase10(C); }
#ifdef PROBE_PHASE
    PT_END(10);
    if (blockIdx.x == 0 && C.wave == 0) { const unsigned long long te_ = __builtin_amdgcn_s_memrealtime(); while (__builtin_amdgcn_s_memrealtime() - te_ < 9ull * pdt_) __builtin_amdgcn_s_sleep(32); }
#endif
#ifdef PROBE_BARRIERS
    if (hi - lo > 1) for (int i_ = 0; i_ < PROBE_BARRIERS; ++i_) xcd_barrier(bar);
#endif
#undef IN
#undef SEAM
}

extern "C" void kernel_launch(void* const* d_in, const int* in_sizes, int n_in, void* d_out, int out_size, void* d_ws, size_t ws_size, hipStream_t stream) {
    static int grid = 0;
    if (grid == 0) {
        if (n_in != 28 || in_sizes[0] != T * D || out_size != T * D || ws_size < WS_END) { fprintf(stderr, "kernel_launch: unexpected shapes (n_in %d, in0 %d, out %d, ws %zu)\n", n_in, n_in > 0 ? in_sizes[0] : -1, out_size, ws_size); grid = -1; return; }
        int dev = 0, cus = 0;
        if (hipGetDevice(&dev) != hipSuccess || hipDeviceGetAttribute(&cus, hipDeviceAttributeMultiprocessorCount, dev) != hipSuccess) { grid = -1; return; }
        if (hipFuncSetAttribute((const void*)fwd_kernel, hipFuncAttributeMaxDynamicSharedMemorySize, LDS_BYTES) != hipSuccess) { fprintf(stderr, "kernel_launch: hipFuncSetAttribute failed\n"); grid = -1; return; }
        int per_cu = 0;
        if (hipOccupancyMaxActiveBlocksPerMultiprocessor(&per_cu, (const void*)fwd_kernel, NTHREADS, LDS_BYTES) != hipSuccess || per_cu < 1) fprintf(stderr, "kernel_launch: occupancy query says %d\n", per_cu);
        (void)hipGetLastError();
        grid = cus;
    }
    if (grid < 0) return;
    if (hipMemsetAsync((char*)d_ws + WS_CTL, 0, CTL_ZERO_BYTES, stream) != hipSuccess) return;
    KArgs a{};
    for (int i = 0; i < 28; ++i) a.in[i] = (const float*)d_in[i];
    a.out = (float*)d_out; a.ws = (unsigned char*)d_ws;
#if MK_ONE_LAUNCH
    a.ph_lo = 0; a.ph_hi = N_PHASES;
    hipLaunchKernelGGL(fwd_kernel, dim3(grid), dim3(NTHREADS), LDS_BYTES, stream, a);
#else
    for (int ph = 0; ph < N_PHASES; ++ph) { a.ph_lo = ph; a.ph_hi = ph + 1; hipLaunchKernelGGL(fwd_kernel, dim3(grid), dim3(NTHREADS), LDS_BYTES, stream, a); }
#endif
}
```

```cpp
#include <hip/hip_runtime.h>
#include <cstdio>
#include <cstdint>

namespace pg8 {
#define PG8_LAS __attribute__((address_space(3)))
typedef unsigned short bf16_t;
typedef short bf16x8 __attribute__((ext_vector_type(8)));
typedef float f32x4 __attribute__((ext_vector_type(4)));
typedef unsigned u32x4 __attribute__((ext_vector_type(4)));
constexpr int BM = 256, BK = 64, HALF = 128, HTB = HALF * BK * 2  , STAGE_BYTES = 8 * HTB, NXCD = 8, WGM = 8;

__host__ __device__ __forceinline__ int lds_byte(int r, int c) { const int st = (r >> 4) * 2 + (c >> 5), rr = r & 15, cc = c & 31, ob = rr * 64 + cc * 2; return st * 1024 + (ob ^ (((ob >> 9) & 1) << 5)); }
__host__ __device__ __forceinline__ void stage_rc(int b, int& R, int& C) { const int st = b / 1024, sb = b % 1024, swz = sb ^ (((sb >> 9) & 1) << 5); R = (st >> 1) * 16 + swz / 64; C = (st & 1) * 32 + (swz % 64) / 2; }
__host__ __device__ __forceinline__ int perm32(int rho) { const int n = rho >> 4, i = rho & 15; return 8 * (i >> 2) + 4 * n + (i & 3); }

struct Unit { int pm, pn; };
struct Gemm { const bf16_t* A; const bf16_t* Bt; int M, N, K; };
__device__ __forceinline__ unsigned cvt_pk_bf16(float lo, float hi) { unsigned r; asm volatile("v_cvt_pk_bf16_f32 %0, %1, %2" : "=v"(r) : "v"(lo), "v"(hi)); return r; }
typedef float f32x2 __attribute__((ext_vector_type(2)));
typedef int i32x4 __attribute__((ext_vector_type(4)));
typedef int i32x8 __attribute__((ext_vector_type(8)));
typedef long i64x2 __attribute__((ext_vector_type(2)));
template <class E, class = void> struct epi_f8 { static constexpr bool v = false; };
template <class E> struct epi_f8<E, decltype((void)E::F8)> { static constexpr bool v = E::F8; };
__device__ __forceinline__ i32x8 cat8(const bf16x8 a, const bf16x8 b) { const i32x4 x = __builtin_bit_cast(i32x4, a), y = __builtin_bit_cast(i32x4, b); return (i32x8){x.x, x.y, x.z, x.w, y.x, y.y, y.z, y.w}; }
template <class Epi, class Sched, bool ALIGN_EPI = false, bool SP2 = false>
__device__ __forceinline__ void gemm_phase(PG8_LAS unsigned char* lds, const Gemm g, const Sched& S, const Epi& E) {
    const int tid = threadIdx.x, wid = __builtin_amdgcn_readfirstlane(tid >> 6), lane = tid & 63, wr = wid >> 2, wc = wid & 3, fr = lane & 15, fq = lane >> 4;
    const int K = g.K, nt = K / BK;
    unsigned voffA[2], voffB[2];
#pragma unroll
    for (int i = 0; i < 2; ++i) { int R, C; stage_rc(tid * 16 + i * 8192, R, C); const int Rb = Epi::PERM ? ((R & ~31) + perm32(R & 31)) : R;
        voffA[i] = (unsigned)(R * K + C) * 2u; voffB[i] = (unsigned)(Rb * K + C) * 2u; }
    const size_t kstep = (size_t)(BK * 2);
    const size_t hstep = (size_t)HALF * K * 2;
    const size_t tstep = 2 * hstep;
    const unsigned ldsw = (unsigned)wid * 1024u;
    const int aoff = lds_byte(wr * 64 + fr, fq * 8), boff = lds_byte(wc * 32 + fr, fq * 8);
#define PG8_SA(b, h) (((b) * 2 + (h)) * HTB)
#define PG8_SB(b, h) ((4 + (b) * 2 + (h)) * HTB)
#define PG8_STAGE(bufoff, gbase, voff) do { _Pragma("unroll") for (int _i = 0; _i < 2; ++_i) \
        __builtin_amdgcn_global_load_lds((const unsigned*)((const char*)(gbase) + (voff)[_i]), (PG8_LAS unsigned*)(lds + (bufoff) + ldsw + _i * 8192), 16, 0, 0); } while (0)
#define PG8_LDA(dst, b, h) do { _Pragma("unroll") for (int m = 0; m < 4; ++m) _Pragma("unroll") for (int k = 0; k < 2; ++k) dst[m][k] = *(const PG8_LAS bf16x8*)(lds + PG8_SA(b, h) + aoff + m * 2048 + k * 1024); } while (0)
#define PG8_LDB(dst, b, h) do { _Pragma("unroll") for (int n = 0; n < 2; ++n) _Pragma("unroll") for (int k = 0; k < 2; ++k) dst[n][k] = *(const PG8_LAS bf16x8*)(lds + PG8_SB(b, h) + boff + n * 2048 + k * 1024); } while (0)
#define PG8_MMA(ai, bj, At, Bt) do { __builtin_amdgcn_s_setprio(1); if constexpr (epi_f8<Epi>::v) { _Pragma("unroll") for (int m = 0; m < 4; ++m) _Pragma("unroll") for (int n = 0; n < 2; ++n) \
        { const i32x8 b_ = cat8(Bt[n][0], Bt[n][1]), a_ = cat8(At[m][0], At[m][1]); \
        asm volatile("v_mfma_f32_16x16x128_f8f6f4 %0, %1, %2, %0" : "+v"(acc[ai][bj][m][n]) : "v"(b_), "v"(a_)); } } else { \
        _Pragma("unroll") for (int m = 0; m < 4; ++m) _Pragma("unroll") for (int n = 0; n < 2; ++n) _Pragma("unroll") for (int k = 0; k < 2; ++k) \
        acc[ai][bj][m][n] = __builtin_amdgcn_mfma_f32_16x16x32_bf16(Bt[n][k], At[m][k], acc[ai][bj][m][n], 0, 0, 0); } __builtin_amdgcn_s_setprio(0); } while (0)
#define PG8_WAIT_V(n) asm volatile("s_waitcnt vmcnt(" #n ")" ::: "memory")
#define PG8_WAIT_L(n) asm volatile("s_waitcnt lgkmcnt(" #n ")" ::: "memory")
#define PG8_BAR __builtin_amdgcn_s_barrier()
#define PG8_SCHED __builtin_amdgcn_sched_barrier(0)
    Unit cur, nxt; int ui = 0;
    if (!S.next(0, cur)) return;
    f32x4 acc[2][2][4][2];
#pragma unroll
    for (int a = 0; a < 2; ++a)
#pragma unroll
        for (int b = 0; b < 2; ++b)
#pragma unroll
            for (int m = 0; m < 4; ++m)
#pragma unroll
                for (int n = 0; n < 2; ++n) acc[a][b][m][n] = (f32x4){0.f, 0.f, 0.f, 0.f};
    bf16x8 At[4][2], B0[2][2], B1[2][2];
    const char* cA = (const char*)g.A + (size_t)cur.pm * tstep; const char* cB = (const char*)g.Bt + (size_t)cur.pn * tstep;
    S.a_ready(cur);
    if constexpr (SP2) {
        PG8_STAGE(PG8_SB(0, 0), cB, voffB); PG8_STAGE(PG8_SB(0, 1), cB + hstep, voffB); PG8_STAGE(PG8_SA(0, 0), cA, voffA); PG8_STAGE(PG8_SA(0, 1), cA + hstep, voffA);
        if (wr == 1) PG8_BAR;
        PG8_WAIT_V(2); PG8_BAR;
        PG8_STAGE(PG8_SB(1, 0), cB + kstep, voffB); PG8_STAGE(PG8_SA(1, 0), cA + kstep, voffA); PG8_STAGE(PG8_SB(1, 1), cB + hstep + kstep, voffB);
        PG8_WAIT_V(6); PG8_BAR;
    } else {
        PG8_STAGE(PG8_SB(0, 0), cB, voffB); PG8_STAGE(PG8_SA(0, 0), cA, voffA); PG8_STAGE(PG8_SB(0, 1), cB + hstep, voffB); PG8_STAGE(PG8_SA(0, 1), cA + hstep, voffA);
        if (wr == 1) PG8_BAR;
        PG8_WAIT_V(4); PG8_BAR;
        PG8_STAGE(PG8_SB(1, 0), cB + kstep, voffB); PG8_STAGE(PG8_SA(1, 0), cA + kstep, voffA); PG8_STAGE(PG8_SB(1, 1), cB + hstep + kstep, voffB);
        PG8_WAIT_V(6); PG8_BAR;
    }
    for (;;) {
        const bool has_next = S.next(ui + 1, nxt);
        const char* nA = has_next ? (const char*)g.A + (size_t)nxt.pm * tstep : cA; const char* nB = has_next ? (const char*)g.Bt + (size_t)nxt.pn * tstep : cB;
        for (int t = 0; t < nt; t += 2) {
            const bool last = (t == nt - 2);
            const char* a1 = cA + (size_t)(t + 1) * kstep;
            const char* a2 = last ? nA : cA + (size_t)(t + 2) * kstep; const char* b2 = last ? nB : cB + (size_t)(t + 2) * kstep;
            const char* a3 = a2 + kstep; const char* b3 = b2 + kstep;
            if (last && has_next) S.a_ready(nxt);
            if constexpr (SP2) {
            PG8_LDB(B0, 0, 0); PG8_LDB(B1, 0, 1); PG8_SCHED; PG8_LDA(At, 0, 0); PG8_STAGE(PG8_SA(1, 1), a1 + hstep, voffA);
            PG8_WAIT_V(8); PG8_WAIT_L(0); PG8_BAR; PG8_MMA(0, 0, At, B0); PG8_MMA(0, 1, At, B1); PG8_BAR; PG8_SCHED;
            PG8_LDA(At, 0, 1); PG8_STAGE(PG8_SB(0, 0), b2, voffB); PG8_STAGE(PG8_SB(0, 1), b2 + hstep, voffB); PG8_STAGE(PG8_SA(0, 0), a2, voffA);
            PG8_WAIT_V(8); PG8_WAIT_L(0); PG8_BAR; PG8_MMA(1, 0, At, B0); PG8_MMA(1, 1, At, B1); PG8_BAR; PG8_SCHED;
            PG8_LDB(B0, 1, 0); PG8_LDB(B1, 1, 1); PG8_SCHED; PG8_LDA(At, 1, 0); PG8_STAGE(PG8_SA(0, 1), a2 + hstep, voffA);
            PG8_WAIT_V(8); PG8_WAIT_L(0); PG8_BAR; PG8_MMA(0, 0, At, B0); PG8_MMA(0, 1, At, B1); PG8_BAR; PG8_SCHED;
            PG8_LDA(At, 1, 1); PG8_STAGE(PG8_SB(1, 0), b3, voffB); PG8_STAGE(PG8_SB(1, 1), b3 + hstep, voffB); PG8_STAGE(PG8_SA(1, 0), a3, voffA);
            PG8_WAIT_V(8); PG8_WAIT_L(0); PG8_BAR; PG8_MMA(1, 0, At, B0); PG8_MMA(1, 1, At, B1); PG8_BAR; PG8_SCHED;
            } else {
            PG8_LDB(B0, 0, 0); PG8_SCHED; PG8_LDA(At, 0, 0); PG8_STAGE(PG8_SA(1, 1), a1 + hstep, voffA);
            PG8_WAIT_L(8); PG8_BAR; PG8_WAIT_L(0); PG8_MMA(0, 0, At, B0); PG8_BAR; PG8_SCHED;
            PG8_LDB(B1, 0, 1); PG8_STAGE(PG8_SB(0, 0), b2, voffB);
            PG8_BAR; PG8_WAIT_L(0); PG8_MMA(0, 1, At, B1); PG8_BAR;
            PG8_LDA(At, 0, 1); PG8_STAGE(PG8_SA(0, 0), a2, voffA);
            PG8_BAR; PG8_WAIT_L(0); PG8_MMA(1, 0, At, B0); PG8_BAR; PG8_SCHED;
            PG8_STAGE(PG8_SB(0, 1), b2 + hstep, voffB);
            PG8_WAIT_V(6); PG8_BAR; PG8_MMA(1, 1, At, B1); PG8_BAR;
            PG8_LDB(B0, 1, 0); PG8_SCHED; PG8_LDA(At, 1, 0); PG8_STAGE(PG8_SA(0, 1), a2 + hstep, voffA);
            PG8_WAIT_L(8); PG8_BAR; PG8_WAIT_L(0); PG8_MMA(0, 0, At, B0); PG8_BAR; PG8_SCHED;
            PG8_LDB(B1, 1, 1); PG8_STAGE(PG8_SB(1, 0), b3, voffB);
            PG8_BAR; PG8_WAIT_L(0); PG8_MMA(0, 1, At, B1); PG8_BAR;
            PG8_LDA(At, 1, 1); PG8_STAGE(PG8_SA(1, 0), a3, voffA);
            PG8_BAR; PG8_WAIT_L(0); PG8_MMA(1, 0, At, B0); PG8_BAR; PG8_SCHED;
            PG8_STAGE(PG8_SB(1, 1), b3 + hstep, voffB);
            PG8_WAIT_V(6); PG8_BAR; PG8_MMA(1, 1, At, B1); PG8_BAR;
            }
        }
        if constexpr (ALIGN_EPI) { if (wr == 0) PG8_BAR; }
        if constexpr (epi_f8<Epi>::v) asm volatile("s_nop 7\n\ts_nop 7\n\ts_nop 7\n\ts_nop 7");
        if constexpr (!Epi::AFTER_DRAIN) { E(acc, cur, wr, wc, fr, fq); S.done(cur); }
        if (!has_next) break;
#pragma unroll
        for (int a = 0; a < 2; ++a)
#pragma unroll
            for (int b = 0; b < 2; ++b)
#pragma unroll
                for (int m = 0; m < 4; ++m)
#pragma unroll
                    for (int n = 0; n < 2; ++n) acc[a][b][m][n] = (f32x4){0.f, 0.f, 0.f, 0.f};
        cur = nxt; cA = nA; cB = nB; ++ui;
        if constexpr (ALIGN_EPI) { if (wr == 1) PG8_BAR; }
    }
    PG8_WAIT_V(0);
    if constexpr (!ALIGN_EPI) { if (wr == 0) PG8_BAR; }
    PG8_BAR;
    if constexpr (Epi::AFTER_DRAIN) { E.fused(acc, cur, wr, wc, fr, fq, lds, wid, lane); S.done(cur); }
#undef PG8_SA
#undef PG8_SB
#undef PG8_STAGE
#undef PG8_LDA
#undef PG8_LDB
#undef PG8_MMA
#undef PG8_WAIT_V
#undef PG8_WAIT_L
#undef PG8_BAR
#undef PG8_SCHED
}
}

constexpr int NB = 4, SEQ = 2048, T = NB * SEQ, D = 2048, DHY = 1024, DML = 1024, DIN = 7200, NE = 32, TOPK = 4, NH = 8, HD = 128, DFF = 2048;
constexpr float LN_EPS = 1e-5f, DN_ALPHA = 1.189207115002721f;
constexpr int NWAVES = 8, NTHREADS = 512;
#ifndef MK_ONE_LAUNCH
#define MK_ONE_LAUNCH 1
#endif
constexpr int N_PHASES = 11;
#ifndef MOE_PRECONVERT
#define MOE_PRECONVERT 1
#endif
#ifndef SIDE_GU_PERIOD
#define SIDE_GU_PERIOD 1
#define SIDE_GU_LAG 1
#endif
#ifndef SIDE_DN_PERIOD
#define SIDE_DN_PERIOD 2
#define SIDE_DN_LAG 2
#endif
#ifndef SIDE_GU_EXPERTS
#define SIDE_GU_EXPERTS 32
#endif
#ifndef OUTPROJ_F8
#define OUTPROJ_F8 1
#endif
#ifndef PROBE_SIDE_DUMMY
#define PROBE_SIDE_DUMMY 0
#endif
#ifndef MOE_SIDE
#define MOE_SIDE 1
#endif

constexpr size_t MiB = 1u << 20;
constexpr size_t WS_CTL = 0, CTL_ZERO_BYTES = 1 * MiB;
constexpr size_t WS_H2P = 1936 * MiB;
constexpr size_t WS_W3P = 1937 * MiB;
constexpr size_t WS_GATES = 2 * MiB;
constexpr size_t WS_TOKW = 3 * MiB;
constexpr size_t WS_LIST = 4 * MiB;
constexpr size_t WS_ROWSLOT = 5 * MiB;
constexpr size_t WS_ROWW = 5 * MiB + 512 * 1024;
constexpr size_t WS_GA = 6 * MiB, WS_GP = 6 * MiB + 512 * 1024, WS_GE = 7 * MiB;
constexpr size_t TILE_BYTES = 256 * 2048 * 2;
constexpr int XB_T0 = 8, WIN_T0 = 40, WOUT_T0 = 72, YCAT_T0 = 80, X1B_T0 = 112, ABUF_T0 = 144, ACT_T0 = 304, WGU_T0 = 464, WDN_T0 = 976;
constexpr size_t WS_HYT = 1232 * MiB;
constexpr size_t WS_QKRAW = 1296 * MiB;
constexpr size_t WS_OB = 1328 * MiB;
constexpr size_t WS_QKC = 1344 * MiB;
constexpr size_t WS_KT = 1376 * MiB;
constexpr size_t WS_KF = 1840 * MiB;
constexpr size_t WS_ZT = 1904 * MiB;
constexpr size_t WS_Z = 1408 * MiB;
constexpr size_t WS_HML = 1440 * MiB;
constexpr size_t WS_R1 = 1504 * MiB;
constexpr int WGU_Q0 = 2 * WGU_T0, WDN_Q0 = 2 * WDN_T0, ACT_Q0 = 2 * ACT_T0;
constexpr size_t WS_X1Q = (size_t)ABUF_T0 * MiB;
constexpr float Y8_SCALE = 16.0f;
constexpr float W8_SCALE = 256.0f;
constexpr size_t WS_YBUF = 1568 * MiB;
constexpr size_t WS_VB = 1824 * MiB;
constexpr size_t WS_END = 1940 * MiB;
constexpr int CW_BAR = 4096, CW_CNT = 16384;

constexpr int LDS_STAGE = 131072, LDS_MISC = LDS_STAGE, LDS_TB = LDS_STAGE + 64, LDS_UL = LDS_STAGE + 512, LDS_ROWT = LDS_STAGE + 1024, MOE_MAXU = 10, LDS_VON = 143360  , LDS_BYTES = 147456;
static_assert(LDS_ROWT + MOE_MAXU * 256 * 4 <= LDS_VON && LDS_VON + 512 * 8 <= LDS_BYTES && LDS_BYTES <= 163840, "LDS map");

#define GAS __attribute__((address_space(1)))
#define LAS __attribute__((address_space(3)))
typedef unsigned short bf16;
typedef unsigned v4u __attribute__((ext_vector_type(4)));
typedef unsigned v2u __attribute__((ext_vector_type(2)));
typedef float f32x4 __attribute__((ext_vector_type(4)));
typedef float f32x2 __attribute__((ext_vector_type(2)));
#define LDS_WAIT() asm volatile("s_waitcnt lgkmcnt(0)" ::: "memory")
__device__ __forceinline__ unsigned f2bf(float f) { unsigned u = __builtin_bit_cast(unsigned, f); return (u + 0x7fffu + ((u >> 16) & 1u)) >> 16; }
__device__ __forceinline__ unsigned pk2(float lo, float hi) { return f2bf(lo) | (f2bf(hi) << 16); }
__device__ __forceinline__ unsigned pk4_fp8(float a, float b, float c, float d) { unsigned w = 0u; w = __builtin_amdgcn_cvt_pk_fp8_f32(a, b, w, false); w = __builtin_amdgcn_cvt_pk_fp8_f32(c, d, w, true); return w; }
__device__ __forceinline__ float bflo(unsigned w) { return __builtin_bit_cast(float, w << 16); }
__device__ __forceinline__ float bfhi(unsigned w) { return __builtin_bit_cast(float, w & 0xffff0000u); }
__device__ __forceinline__ float bf2f(bf16 b) { return __builtin_bit_cast(float, (unsigned)b << 16); }
__device__ __forceinline__ float wave_sum(float v) {
#pragma unroll
    for (int o = 1; o < 64; o <<= 1) v += __shfl_xor(v, o);
    return v;
}
__device__ __forceinline__ float wave_max(float v) {
#pragma unroll
    for (int o = 1; o < 64; o <<= 1) v = fmaxf(v, __shfl_xor(v, o));
    return v;
}

#define XB_TMO      128
#define XB_XCNT(j)  (256  + 64 * (j))
#define XB_XSUB(j)  (1280 + 64 * (j))
#define XB_XGEN(j)  (2304 + 64 * (j))
#define XB_TOP      3328
#define XB_TOPGEN   3392
#define XCD_BAR_WORDS 3456
#define XB_SPIN_CAP (1u << 22)

__device__ __forceinline__ unsigned xb_ld(unsigned* p)              { return __hip_atomic_load(p, __ATOMIC_RELAXED, __HIP_MEMORY_SCOPE_AGENT); }
__device__ __forceinline__ unsigned xb_add(unsigned* p, unsigned v) { return __hip_atomic_fetch_add(p, v, __ATOMIC_RELAXED, __HIP_MEMORY_SCOPE_AGENT); }
__device__ __forceinline__ unsigned xb_xcc_id() { return (unsigned)__builtin_amdgcn_s_getreg((3 << 11) | 20) & 0xFu; }
#define XB_SPIN(cond, bar) do { unsigned _sp = 0; while (cond) { __builtin_amdgcn_s_sleep(1); \
    if ((++_sp & 255u) == 0u) { if (xb_ld(&(bar)[XB_TMO])) break; if (_sp > XB_SPIN_CAP) { atomicAdd(&(bar)[XB_TMO], 1u); break; } } } } while (0)

struct XcdBarrier {
    unsigned* bar; unsigned x;
    volatile LAS unsigned* st;
};

__device__ __forceinline__ XcdBarrier xcd_barrier_post(unsigned* bar, volatile LAS unsigned* st) {
    XcdBarrier b; b.bar = bar; b.x = xb_xcc_id(); b.st = st;
    if (threadIdx.x == 0) (void)xb_add(&bar[XB_XCNT(b.x)], 1u);
    return b;
}
__device__ __forceinline__ void xcd_barrier_complete(unsigned* bar, unsigned x, unsigned& nloc, unsigned& nx) {
    const unsigned G = gridDim.x * gridDim.y * gridDim.z;
    unsigned sum, cnt, mine, sp = 0u;
    for (;;) {
        sum = 0u; cnt = 0u; mine = 0u;
#pragma unroll
        for (unsigned j = 0; j < 16; ++j) { const unsigned c = xb_ld(&bar[XB_XCNT(j)]); sum += c; cnt += (c > 0u) ? 1u : 0u; mine = (j == x) ? c : mine; }
        if (sum == G) break;
        __builtin_amdgcn_s_sleep(1);
        if ((++sp & 255u) == 0u) { if (xb_ld(&bar[XB_TMO])) break; if (sp > XB_SPIN_CAP) { atomicAdd(&bar[XB_TMO], 1u); break; } }
    }
    nloc = mine > 0u ? mine : 1u; nx = cnt > 0u ? cnt : 1u;
}

__device__ __forceinline__ void xcd_barrier(const XcdBarrier& b) {
    asm volatile("s_waitcnt vmcnt(0)" ::: "memory");
    __syncthreads();
    if (threadIdx.x == 0) {
        unsigned* bar = b.bar;
        __builtin_amdgcn_s_waitcnt(0);
        unsigned nloc = b.st[0], nx = b.st[1];
        if (nloc == 0u) { xcd_barrier_complete(bar, b.x, nloc, nx); b.st[0] = nloc; b.st[1] = nx; }
        const unsigned old = xb_add(&bar[XB_XSUB(b.x)], 1u);
        const unsigned gen = old / nloc;
        if (old + 1u == (gen + 1u) * nloc) {
            __builtin_amdgcn_fence(__ATOMIC_RELEASE, "agent");
            asm volatile("s_waitcnt vmcnt(0)" ::: "memory");
            const unsigned og = xb_add(&bar[XB_TOP], 1u);
            const unsigned tg = og / nx;
            if (og + 1u == (tg + 1u) * nx) xb_add(&bar[XB_TOPGEN], 1u);
            else XB_SPIN(xb_ld(&bar[XB_TOPGEN]) == tg, bar);
            __builtin_amdgcn_fence(__ATOMIC_ACQUIRE, "agent");
            xb_add(&bar[XB_XGEN(b.x)], 1u);
            asm volatile("s_waitcnt vmcnt(0)" ::: "memory");
        } else {
            XB_SPIN(xb_ld(&bar[XB_XGEN(b.x)]) == gen, bar);
            __builtin_amdgcn_fence(__ATOMIC_ACQUIRE, "agent");
            asm volatile("s_waitcnt vmcnt(0)" ::: "memory");
        }
    }
    __syncthreads();
}


#ifndef FFT_HD
#define FFT_HD __device__ __forceinline__
#define FFT_LDS LAS
#endif
constexpr int FFT_WORDS = 4096 + 1024 + 256;
FFT_HD int fidx(int i) { return i + 4 * (i >> 4) + 16 * (i >> 8); }

template <bool INV> FFT_HD void dft4(float& ar, float& ai, float& br, float& bi, float& cr, float& ci, float& dr, float& di) {
    const float s0r = ar + cr, s0i = ai + ci, s1r = ar - cr, s1i = ai - ci;
    const float s2r = br + dr, s2i = bi + di, s3r = br - dr, s3i = bi - di;
    ar = s0r + s2r; ai = s0i + s2i;
    cr = s0r - s2r; ci = s0i - s2i;
    if (!INV) { br = s1r + s3i; bi = s1i - s3r; dr = s1r - s3i; di = s1i + s3r; }
    else      { br = s1r - s3i; bi = s1i + s3r; dr = s1r + s3i; di = s1i - s3r; }
}
template <bool INV> FFT_HD void dft16(float (&xr)[16], float (&xi)[16]) {
#pragma unroll
    for (int n0 = 0; n0 < 4; ++n0) dft4<INV>(xr[n0], xi[n0], xr[n0 + 4], xi[n0 + 4], xr[n0 + 8], xi[n0 + 8], xr[n0 + 12], xi[n0 + 12]);
    constexpr float C1 = 0.9238795325112867f, S1 = 0.3826834323650898f, C2 = 0.7071067811865476f;
    const float tc[10] = {1.f, C1, C2, S1, 0.f, -S1, -C2, -C1, -1.f, -C1};
    const float ts[10] = {0.f, S1, C2, C1, 1.f, C1, C2, S1, 0.f, -S1};
#pragma unroll
    for (int n0 = 1; n0 < 4; ++n0)
#pragma unroll
        for (int k0 = 1; k0 < 4; ++k0) { const int m = n0 * k0; const float wr = tc[m], wi = INV ? ts[m] : -ts[m];
            const int id = n0 + 4 * k0; const float r = xr[id] * wr - xi[id] * wi, i = xr[id] * wi + xi[id] * wr; xr[id] = r; xi[id] = i; }
#pragma unroll
    for (int k0 = 0; k0 < 4; ++k0) dft4<INV>(xr[4 * k0], xi[4 * k0], xr[4 * k0 + 1], xi[4 * k0 + 1], xr[4 * k0 + 2], xi[4 * k0 + 2], xr[4 * k0 + 3], xi[4 * k0 + 3]);
#pragma unroll
    for (int a = 0; a < 4; ++a)
#pragma unroll
        for (int b = a + 1; b < 4; ++b) { float t = xr[4 * a + b]; xr[4 * a + b] = xr[4 * b + a]; xr[4 * b + a] = t; t = xi[4 * a + b]; xi[4 * a + b] = xi[4 * b + a]; xi[4 * b + a] = t; }
}
template <bool INV> FFT_HD void twiddle16(float (&xr)[16], float (&xi)[16], int j, int n) {
    float s, c;
#ifdef __HIP_DEVICE_COMPILE__
    asm volatile("" : "+v"(j));
    sincospif(2.0f * (float)j / (float)n, &s, &c);
#else
    s = (float)sin(2.0 * 3.14159265358979323846 * j / n); c = (float)cos(2.0 * 3.14159265358979323846 * j / n);
#endif
    const float wr = c, wi = INV ? s : -s;
    float pr = wr, pi = wi;
#pragma unroll
    for (int k = 1; k < 16; ++k) {
        const float r = xr[k] * pr - xi[k] * pi, i = xr[k] * pi + xi[k] * pr; xr[k] = r; xi[k] = i;
        const float nr = pr * wr - pi * wi, ni = pr * wi + pi * wr; pr = nr; pi = ni;
    }
}
FFT_HD void fft_store_s256(FFT_LDS float* re, FFT_LDS float* im, int g, const float (&xr)[16], const float (&xi)[16]) {
    const int a0 = fidx(g);
#pragma unroll
    for (int k = 0; k < 16; ++k) { re[a0 + 336 * k] = xr[k]; im[a0 + 336 * k] = xi[k]; }
}
FFT_HD void fft_load_s256(const FFT_LDS float* re, const FFT_LDS float* im, int g, float (&xr)[16], float (&xi)[16]) {
    const int a0 = fidx(g);
#pragma unroll
    for (int k = 0; k < 16; ++k) { xr[k] = re[a0 + 336 * k]; xi[k] = im[a0 + 336 * k]; }
}
FFT_HD void fft_load_s16(const FFT_LDS float* re, const FFT_LDS float* im, int g, float (&xr)[16], float (&xi)[16]) {
    const int a0 = fidx((g >> 4) * 256 + (g & 15));
#pragma unroll
    for (int k = 0; k < 16; ++k) { xr[k] = re[a0 + 20 * k]; xi[k] = im[a0 + 20 * k]; }
}
FFT_HD void fft_store_s16(FFT_LDS float* re, FFT_LDS float* im, int g, const float (&xr)[16], const float (&xi)[16]) {
    const int a0 = fidx((g >> 4) * 256 + (g & 15));
#pragma unroll
    for (int k = 0; k < 16; ++k) { re[a0 + 20 * k] = xr[k]; im[a0 + 20 * k] = xi[k]; }
}
FFT_HD void fft_load_s1(const FFT_LDS float* re, const FFT_LDS float* im, int g, float (&xr)[16], float (&xi)[16]) {
    const int a = fidx(g * 16);
#pragma unroll
    for (int k = 0; k < 16; ++k) { xr[k] = re[a + k]; xi[k] = im[a + k]; }
}
FFT_HD void fft_store_s1(FFT_LDS float* re, FFT_LDS float* im, int g, const float (&xr)[16], const float (&xi)[16]) {
    const int a = fidx(g * 16);
#pragma unroll
    for (int k = 0; k < 16; ++k) { re[a + k] = xr[k]; im[a + k] = xi[k]; }
}


struct KArgs { const float* in[28]; float* out; unsigned char* ws; int ph_lo, ph_hi; };
struct Ctx {
    const KArgs& A; float* out; unsigned char* ws; LAS unsigned char* lds;
    int tid, lane, wave, G, gw, NGW;
};

__device__ __forceinline__ void transpose_item(const float* __restrict__ W, int N, int k0, int n0, bf16* __restrict__ dst, LAS float* scr, int lane) {
#pragma unroll 8
    for (int i = 0; i < 32; ++i) { const int kk = 2 * i + (lane >> 5); scr[kk * 33 + (lane & 31)] = W[(size_t)(k0 + kk) * N + n0 + (lane & 31)]; }
    LDS_WAIT(); asm volatile("" ::: "memory");
    const int c = lane & 7;
#pragma unroll
    for (int j = 0; j < 4; ++j) { const int n = (lane >> 3) + 8 * j; const LAS float* s = scr + (8 * c) * 33 + n;
        v4u o; o.x = pk2(s[0 * 33], s[1 * 33]); o.y = pk2(s[2 * 33], s[3 * 33]); o.z = pk2(s[4 * 33], s[5 * 33]); o.w = pk2(s[6 * 33], s[7 * 33]);
        *(v4u*)(dst + (size_t)n * 2048 + k0 + 8 * c) = o; }
    LDS_WAIT(); asm volatile("" ::: "memory");
}

__device__ __forceinline__ void transpose_item8(const float* __restrict__ W, int N, int k0, int n0, unsigned char* __restrict__ dst, LAS float* scr, int lane) {
#pragma unroll 8
    for (int i = 0; i < 32; ++i) { const int kk = 2 * i + (lane >> 5); scr[kk * 33 + (lane & 31)] = W[(size_t)(k0 + kk) * N + n0 + (lane & 31)]; }
    LDS_WAIT(); asm volatile("" ::: "memory");
    const int c = lane & 3;
#pragma unroll
    for (int j = 0; j < 2; ++j) { const int n = (lane >> 2) + 16 * j; const LAS float* q = scr + (16 * c) * 33 + n;
        v4u o; o.x = pk4_fp8(q[0 * 33] * W8_SCALE, q[1 * 33] * W8_SCALE, q[2 * 33] * W8_SCALE, q[3 * 33] * W8_SCALE); o.y = pk4_fp8(q[4 * 33] * W8_SCALE, q[5 * 33] * W8_SCALE, q[6 * 33] * W8_SCALE, q[7 * 33] * W8_SCALE);
        o.z = pk4_fp8(q[8 * 33] * W8_SCALE, q[9 * 33] * W8_SCALE, q[10 * 33] * W8_SCALE, q[11 * 33] * W8_SCALE); o.w = pk4_fp8(q[12 * 33] * W8_SCALE, q[13 * 33] * W8_SCALE, q[14 * 33] * W8_SCALE, q[15 * 33] * W8_SCALE);
        *(v4u*)(dst + (size_t)n * 2048 + k0 + 16 * c) = o; }
    LDS_WAIT(); asm volatile("" ::: "memory");
}

__device__ __forceinline__ void phase0(const Ctx& C) {
    unsigned char* ws = C.ws;
    {
        const f32x4* x4 = (const f32x4*)C.A.in[0]; v4u* xb = (v4u*)(ws + (size_t)XB_T0 * MiB);
        const size_t n8 = (size_t)T * D / 8;
        for (size_t i = (size_t)blockIdx.x * NTHREADS + C.tid; i < n8; i += (size_t)C.G * NTHREADS) {
            const f32x4 a = x4[2 * i], b = x4[2 * i + 1]; v4u o; o.x = pk2(a.x, a.y); o.y = pk2(a.z, a.w); o.z = pk2(b.x, b.y); o.w = pk2(b.z, b.w); xb[i] = o; }
    }
    {
        LAS float* scr = (LAS float*)(C.lds + C.wave * 8448);
        constexpr int I_IN = 32 * 225, I_OUT = 32 * 64, E_GU0 = (MOE_SIDE && !PROBE_SIDE_DUMMY) ? SIDE_GU_EXPERTS : 0, I_GU = MOE_PRECONVERT ? (NE - E_GU0) * 32 * 128 : 0, I_DN = (MOE_PRECONVERT && (!MOE_SIDE || PROBE_SIDE_DUMMY)) ? NE * 32 * 64 : 0, NITEMS = I_IN + I_OUT + I_GU + I_DN;
        bf16* win_t = (bf16*)(ws + (size_t)WIN_T0 * MiB); bf16* wout_t = (bf16*)(ws + (size_t)WOUT_T0 * MiB);
        bf16* wgu_t = (bf16*)(ws + (size_t)WGU_T0 * MiB); bf16* wdn_t = (bf16*)(ws + (size_t)WDN_T0 * MiB);
        for (int it = C.gw; it < NITEMS; it += C.NGW) {
            int r = it;
            if (r < I_IN) { const int kb = r / 225, nb = r % 225; transpose_item(C.A.in[1], DIN, 64 * kb, 32 * nb, win_t + (size_t)(32 * nb) * 2048, scr, C.lane); continue; } r -= I_IN;
#if OUTPROJ_F8
            if (r < I_OUT) { const int kb = r / 64, nb = r % 64; transpose_item8(C.A.in[16], D, 64 * kb, 32 * nb, (unsigned char*)wout_t + (size_t)(32 * nb) * 2048, scr, C.lane); continue; } r -= I_OUT;
#else
            if (r < I_OUT) { const int kb = r / 64, nb = r % 64; transpose_item(C.A.in[16], D, 64 * kb, 32 * nb, wout_t + (size_t)(32 * nb) * 2048, scr, C.lane); continue; } r -= I_OUT;
#endif
            if (r < I_GU) { const int e = E_GU0 + r / 4096, rr = r % 4096, kb = rr / 128, nb = rr % 128, n0 = 32 * nb;
                const int drow = (n0 < 2048) ? ((n0 >> 7) * 256 + (n0 & 127)) : ((((n0 - 2048) >> 7) * 256) + 128 + ((n0 - 2048) & 127));
                transpose_item(C.A.in[22] + (size_t)e * 2048 * 4096, 4096, 64 * kb, n0, wgu_t + ((size_t)e * 4096 + drow) * 2048, scr, C.lane);
                continue; } r -= I_GU;
            { const int e = r / 2048, rr = r % 2048, kb = rr / 64, nb = rr % 64;
                transpose_item(C.A.in[24] + (size_t)e * 2048 * 2048, 2048, 64 * kb, 32 * nb, wdn_t + ((size_t)e * 2048 + 32 * nb) * 2048, scr, C.lane); }
        }
    }
    __syncthreads();
    {
        const float* w1 = C.A.in[5]; const float* b1 = C.A.in[6]; const float* w2 = C.A.in[7]; const float* b2 = C.A.in[8]; const float* freq = C.A.in[10];
        LAS float* h1s = (LAS float*)C.lds;
        const int tt = C.tid >> 6, j = C.tid & 63;
        for (int tb = blockIdx.x; tb < SEQ / 8; tb += C.G) {
            const int t = tb * 8 + tt;
            const float zt = (float)t / 2047.0f, wt = 6.283185307179586f * (float)t / 2048.0f;
            float acc = b1[j] + zt * w1[j];
            for (int i = 0; i < 16; ++i) { const float fb = 1e-4f + (float)i * ((15.0f - 1e-4f) / 15.0f); float sn, cs; sincospif(fb * (float)t * (1.0f / 1024.0f), &sn, &cs);
                acc += cs * w1[(1 + i) * 64 + j] - sn * w1[(17 + i) * 64 + j]; }
            h1s[tt * 64 + j] = sinf(freq[j] * acc);
            __syncthreads();
            float a2 = b2[j];
            for (int i = 0; i < 64; ++i) a2 += h1s[tt * 64 + i] * w2[i * 64 + j];
            { const float hv = sinf(freq[64 + j] * a2); const unsigned hi = f2bf(hv); const float lo = hv - bflo(hi);
              bf16* hp = (bf16*)(ws + WS_H2P) + (size_t)t * 256; hp[j] = (bf16)hi; hp[64 + j] = (bf16)hi; hp[128 + j] = (bf16)f2bf(lo); hp[192 + j] = 0; }
            __syncthreads();
        }
        const float* w3 = C.A.in[9]; bf16* wp = (bf16*)(ws + WS_W3P);
        for (int i = blockIdx.x * NTHREADS + C.tid; i < 4096 * 8; i += C.G * NTHREADS) {
            const int col = i & 4095, jo = i >> 12; float wv[8]; unsigned hi[8], lo[8];
#pragma unroll
            for (int k = 0; k < 8; ++k) { wv[k] = w3[(size_t)(jo * 8 + k) * 4096 + col]; hi[k] = f2bf(wv[k]); lo[k] = f2bf(wv[k] - bflo(hi[k])); }
            v4u vh, vl; vh.x = hi[0] | (hi[1] << 16); vh.y = hi[2] | (hi[3] << 16); vh.z = hi[4] | (hi[5] << 16); vh.w = hi[6] | (hi[7] << 16);
            vl.x = lo[0] | (lo[1] << 16); vl.y = lo[2] | (lo[3] << 16); vl.z = lo[4] | (lo[5] << 16); vl.w = lo[6] | (lo[7] << 16);
            bf16* row = wp + (size_t)col * 256 + jo * 8;
            *(v4u*)row = vh; *(v4u*)(row + 64) = vl; *(v4u*)(row + 128) = vh; *(v4u*)(row + 192) = (v4u){0u, 0u, 0u, 0u};
        }
    }
}

constexpr int N1_SW_TILES = 16, N1_SW = N1_SW_TILES * 32;
constexpr int N1_NORM_TILES = 13, N1_NORM = N1_NORM_TILES * 32, N1_UNITS = N1_SW + N1_NORM;
struct Gemm1Order {
    int G, c;
    __device__ __forceinline__ int a_row(const pg8::Unit& u, int, int r) const { return u.pm * 256 + r; }
    __device__ __forceinline__ bool next(int i, pg8::Unit& u) const {
        const int L = i * G + c; if (L >= N1_UNITS) return false;
        int w; { const int q = N1_UNITS / 8, r = N1_UNITS % 8, xcd = L % 8, off = L / 8; w = (xcd < r ? xcd * (q + 1) : r * (q + 1) + (xcd - r) * q) + off; }
        if (w < N1_SW) { const int nig = 8 * 32, gid = w / nig, wi = w % nig, mi = gid * 8 + (wi % 8), ni = wi / 8;
            u.pm = WIN_T0 + (mi < 12 ? mi : 8 + mi); u.pn = XB_T0 + ni; }
        else { w -= N1_SW; const int nig = 8 * N1_NORM_TILES, gid = w / nig, wi = w % nig, mi = gid * 8 + (wi % 8), ni = wi / 8;
            int wt;
            wt = (ni < 8) ? 12 + ni : 16 + ni;
            u.pm = XB_T0 + mi; u.pn = WIN_T0 + wt; }
        return true;
    }
    __device__ __forceinline__ void a_ready(const pg8::Unit&) const {}
    __device__ __forceinline__ void done(const pg8::Unit&) const {}
};
struct Epi1 {
    static constexpr bool PERM = true, AFTER_DRAIN = false;
    const float* b_in; bf16* hyt; bf16* qkraw; bf16* vb; bf16* ob; float* gates;
    __device__ __forceinline__ void operator()(const pg8::f32x4 (&acc)[2][2][4][2], const pg8::Unit& u, int wr, int wc, int fr_, int fq_) const {
        int ln_ = threadIdx.x & 63; asm volatile("" : "+v"(ln_));
        const int fr = ln_ & 15, fq = ln_ >> 4;
        using pg8::cvt_pk_bf16;
        if (u.pm >= WIN_T0) {
            const int wt = u.pm - WIN_T0, tt = u.pn - XB_T0;
            const int col0 = tt * 256 + wc * 32 + 8 * fq;
            float bv8[2][4];
#pragma unroll
            for (int ai = 0; ai < 2; ++ai)
#pragma unroll
                for (int m = 0; m < 4; ++m) bv8[ai][m] = b_in[wt * 256 + ai * 128 + wr * 64 + m * 16 + fr];
#pragma unroll
            for (int ai = 0; ai < 2; ++ai)
#pragma unroll
                for (int m = 0; m < 4; ++m) {
                    const int ch = wt * 256 + ai * 128 + wr * 64 + m * 16 + fr; const float bv = bv8[ai][m];
                    const int drow = ch < 3072 ? ch : ch - 2048;
                    bf16* rowp = hyt + (size_t)drow * T + col0;
#pragma unroll
                    for (int bj = 0; bj < 2; ++bj) { const pg8::f32x4 v0 = acc[ai][bj][m][0] + bv, v1 = acc[ai][bj][m][1] + bv;
                        v4u w; w.x = cvt_pk_bf16(v0[0], v0[1]); w.y = cvt_pk_bf16(v0[2], v0[3]); w.z = cvt_pk_bf16(v1[0], v1[1]); w.w = cvt_pk_bf16(v1[2], v1[3]);
                        *(v4u*)(rowp + bj * 128) = w; }
                }
        } else {
            const int tt = u.pm - XB_T0, wt = u.pn - WIN_T0;
            const int chb = wt * 256 + wc * 32 + 8 * fq;
            pg8::f32x4 bv[2][2];
#pragma unroll
            for (int bj = 0; bj < 2; ++bj)
#pragma unroll
                for (int n = 0; n < 2; ++n) { const int c0 = chb + bj * 128 + 4 * n; bv[bj][n] = (c0 < DIN) ? *(const pg8::f32x4*)(b_in + c0) : (pg8::f32x4){0.f, 0.f, 0.f, 0.f}; }
            if (wt == 28) {
                if (wc == 0) {
#pragma unroll
                    for (int ai = 0; ai < 2; ++ai)
#pragma unroll
                        for (int m = 0; m < 4; ++m) { const int tok = tt * 256 + ai * 128 + wr * 64 + m * 16 + fr;
                            float* gp = gates + (size_t)tok * 32 + 8 * fq;
                            *(pg8::f32x4*)(gp) = acc[ai][0][m][0] + bv[0][0]; *(pg8::f32x4*)(gp + 4) = acc[ai][0][m][1] + bv[0][1]; }
                }
            } else {
#define EPI1_STORE(base, ld, cb) do { _Pragma("unroll") for (int ai = 0; ai < 2; ++ai) _Pragma("unroll") for (int m = 0; m < 4; ++m) { const int tok = tt * 256 + ai * 128 + wr * 64 + m * 16 + fr; \
                    bf16* rowp = (base) + (size_t)tok * (ld) + (cb); \
                    _Pragma("unroll") for (int bj = 0; bj < 2; ++bj) { const pg8::f32x4 v0 = acc[ai][bj][m][0] + bv[bj][0], v1 = acc[ai][bj][m][1] + bv[bj][1]; \
                        v4u w; w.x = cvt_pk_bf16(v0[0], v0[1]); w.y = cvt_pk_bf16(v0[2], v0[3]); w.z = cvt_pk_bf16(v1[0], v1[1]); w.w = cvt_pk_bf16(v1[2], v1[3]); \
                        *(v4u*)(rowp + bj * 128) = w; } } } while (0)
                if (wt < 20) EPI1_STORE(qkraw, 2048, chb - 3072);
                else if (wt < 24) EPI1_STORE(vb, 1024, chb - 5120);
                else EPI1_STORE(ob, 1024, chb - 6144);
#undef EPI1_STORE
            }
        }
    }
};

struct KtOrder {
    int G, c;
    __device__ __forceinline__ bool next(int i, pg8::Unit& u) const { const int cc = G - 1 - c; if (i != 0 || cc >= 128) return false; u.pm = cc >> 3; u.pn = cc & 7; return true; }
    __device__ __forceinline__ void a_ready(const pg8::Unit&) const {}
    __device__ __forceinline__ void done(const pg8::Unit&) const {}
};
struct EpiKT {
    static constexpr bool PERM = true, AFTER_DRAIN = false;
    float* kt;
    __device__ __forceinline__ void operator()(const pg8::f32x4 (&acc)[2][2][4][2], const pg8::Unit& u, int wr, int wc, int fr, int fq) const {
        const float da = -3.0701134573253945f, db = -15.350567286626973f;
#pragma unroll
        for (int ai = 0; ai < 2; ++ai)
#pragma unroll
            for (int m = 0; m < 4; ++m) {
                const int col = u.pm * 256 + ai * 128 + wr * 64 + m * 16 + fr, o = col >> 11, dir = (col >> 10) & 1, c = col & 1023;
                const float delta = fabsf(da + (float)c * ((db - da) / 1023.0f)) * (1.0f / 2047.0f);
                float* kr = kt + ((size_t)o * 1024 + c) * 4096;
#pragma unroll
                for (int bj = 0; bj < 2; ++bj) {
                    const int t0 = u.pn * 256 + bj * 128 + wc * 32 + 8 * fq; float v[8];
#pragma unroll
                    for (int n = 0; n < 2; ++n)
#pragma unroll
                        for (int e = 0; e < 4; ++e) v[4 * n + e] = acc[ai][bj][m][n][e] * expf(-(float)(t0 + 4 * n + e) * delta);
                    if (dir == 0) { *(pg8::f32x4*)(kr + t0) = (pg8::f32x4){v[0], v[1], v[2], v[3]}; *(pg8::f32x4*)(kr + t0 + 4) = (pg8::f32x4){v[4], v[5], v[6], v[7]}; }
                    else {
#pragma unroll
                        for (int e = 0; e < 8; ++e) if (t0 + e >= 1) kr[4096 - t0 - e] = v[e]; }
                }
            }
    }
};

template <int OP> __device__ __forceinline__ LAS float* block_scan_2048(LAS float* x, LAS float* y, int tid) {
    LAS float* src = x; LAS float* dst = y;
    for (int off = 1; off < 2048; off <<= 1) {
#pragma unroll
        for (int i = 0; i < 4; ++i) { const int idx = tid + 512 * i; float v = src[idx]; if (idx >= off) { const float w = src[idx - off]; v = OP ? fmaxf(v, w) : v + w; } dst[idx] = v; }
        __syncthreads();
        LAS float* t = src; src = dst; dst = t;
    }
    return src;
}
__device__ __forceinline__ float logsigmoidf(float x) { return fminf(x, 0.f) - log1pf(expf(-fabsf(x))); }

__device__ __forceinline__ void phase2(const Ctx& C) {
    unsigned char* ws = C.ws;
    {
        const float* KT = (const float*)(ws + WS_KT); f32x4* KF = (f32x4*)(ws + WS_KF);
        const int half = C.tid >> 8, g = C.tid & 255;
        LAS float* re = (LAS float*)(C.lds + half * (2 * FFT_WORDS * 4)); LAS float* im = re + FFT_WORDS;
        LAS float* red = (LAS float*)(C.lds + 4 * FFT_WORDS * 4);
        for (int u = blockIdx.x; u < 1024; u += C.G) {
            const int o = u >> 9, c0 = (u & 511) * 2, c = c0 + half;
            __syncthreads();
            const float* kcol = KT + ((size_t)o * 1024 + c) * 4096;
            float xr[16], xi[16]; float asum = 0.f;
#pragma unroll
            for (int m = 0; m < 16; ++m) { const int idx = g + 256 * m; const float val = (idx == 2048) ? 0.f : kcol[idx]; xr[m] = val; xi[m] = 0.f; asum += fabsf(val); }
            asum = wave_sum(asum);
            if (C.lane == 0) red[C.wave] = asum;
            __syncthreads();
            const float tot = red[half * 4] + red[half * 4 + 1] + red[half * 4 + 2] + red[half * 4 + 3];
            const float scl = 1.0f / (tot * 4096.0f);
#pragma unroll
            for (int m = 0; m < 16; ++m) xr[m] *= scl;
            dft16<false>(xr, xi); twiddle16<false>(xr, xi, g, 4096); fft_store_s256(re, im, g, xr, xi);
            __syncthreads();
            fft_load_s16(re, im, g, xr, xi); dft16<false>(xr, xi); twiddle16<false>(xr, xi, g & 15, 256); fft_store_s16(re, im, g, xr, xi);
            __syncthreads();
            fft_load_s1(re, im, g, xr, xi); dft16<false>(xr, xi);
            f32x4* dst = KF + ((size_t)(o * 1024 + c) * 4096 + g * 16) / 2;
#pragma unroll
            for (int k = 0; k < 8; ++k) dst[k] = (f32x4){xr[2 * k], xi[2 * k], xr[2 * k + 1], xi[2 * k + 1]};
        }
        __syncthreads();
    }
    {
        const bf16* raw = (const bf16*)(ws + WS_QKRAW); bf16* qkc = (bf16*)(ws + WS_QKC); const float* cw = C.A.in[13]; const float* cb = C.A.in[14];
        const int qwg0 = C.G > 128 ? 64 : 0;
        for (int g = ((int)blockIdx.x - qwg0) * NTHREADS + C.tid; g < T * 256 && (int)blockIdx.x >= qwg0; g += (C.G - qwg0) * NTHREADS) {
            const int tok = g >> 8, ch0 = (g & 255) * 8, tl = tok & (SEQ - 1);
            const v4u cur = *(const v4u*)(raw + (size_t)tok * 2048 + ch0);
            v4u prv = (v4u){0u, 0u, 0u, 0u}, nxt = (v4u){0u, 0u, 0u, 0u};
            if (tl > 0) prv = *(const v4u*)(raw + (size_t)(tok - 1) * 2048 + ch0);
            if (tl < SEQ - 1) nxt = *(const v4u*)(raw + (size_t)(tok + 1) * 2048 + ch0);
            const float sc = ch0 >= 1024 ? 0.08838834764831845f : 1.0f;
            float o[8];
#pragma unroll
            for (int i = 0; i < 8; ++i) {
                const unsigned pw = prv[i >> 1], cwd = cur[i >> 1], nw = nxt[i >> 1];
                const float p = (i & 1) ? bfhi(pw) : bflo(pw), q = (i & 1) ? bfhi(cwd) : bflo(cwd), n = (i & 1) ? bfhi(nw) : bflo(nw);
                const int ch = ch0 + i;
                const float v = cw[ch] * p + cw[2048 + ch] * q + cw[4096 + ch] * n + cb[ch];
                o[i] = sc * v / (1.0f + expf(-v));
            }
            v4u w; w.x = pk2(o[0], o[1]); w.y = pk2(o[2], o[3]); w.z = pk2(o[4], o[5]); w.w = pk2(o[6], o[7]);
            *(v4u*)(qkc + (size_t)tok * 2048 + ch0) = w;
        }
    }
    {
        const float* gates = (const float*)(ws + WS_GATES); float* GA = (float*)(ws + WS_GA); float* GP = (float*)(ws + WS_GP); float* GE = (float*)(ws + WS_GE);
        LAS float* s0 = (LAS float*)(C.lds + 8192); LAS float* s1 = s0 + 2048; LAS float* s2 = s1 + 2048; LAS float* s3 = s2 + 2048;
        for (int bhd = blockIdx.x; bhd < 64; bhd += C.G) {
            const int b = bhd >> 4, h = (bhd >> 1) & 7, dir = bhd & 1, col_i = dir * 16 + h, col_f = col_i + 8;
            float ig[4], lf[4];
            __syncthreads();
#pragma unroll
            for (int i = 0; i < 4; ++i) { const int t = C.tid + 512 * i; const float* gr = gates + (size_t)(b * SEQ + t) * 32; ig[i] = gr[col_i]; lf[i] = logsigmoidf(gr[col_f]); s0[t] = lf[i]; }
            __syncthreads();
            LAS float* Fc = block_scan_2048<0>(s0, s1, C.tid);
            float a[4], Fv[4], Gx[4];
#pragma unroll
            for (int i = 0; i < 4; ++i) { const int t = C.tid + 512 * i; Fv[i] = Fc[t]; Gx[i] = Fv[i] - lf[i]; a[i] = dir ? ig[i] + Gx[i] : ig[i] - Fv[i]; s2[dir ? 2047 - t : t] = a[i]; }
            __syncthreads();
            LAS float* Pm = block_scan_2048<1>(s2, s3, C.tid);
#pragma unroll
            for (int i = 0; i < 4; ++i) { const int t = C.tid + 512 * i; const float pm = Pm[dir ? 2047 - t : t];
                const float mt = dir ? pm - Gx[i] : Fv[i] + pm;
                GA[bhd * 2048 + t] = a[i]; GP[bhd * 2048 + t] = pm; GE[bhd * 2048 + t] = expf(-mt); }
        }
        __syncthreads();
    }
}

__device__ __forceinline__ void hyena_conv_once(LAS float* re, LAS float* im, int g, float (&xr)[16], float (&xi)[16], const f32x4* __restrict__ kf) {
    __syncthreads();
    dft16<false>(xr, xi); twiddle16<false>(xr, xi, g, 4096); fft_store_s256(re, im, g, xr, xi);
    __syncthreads();
    fft_load_s16(re, im, g, xr, xi); dft16<false>(xr, xi); twiddle16<false>(xr, xi, g & 15, 256); fft_store_s16(re, im, g, xr, xi);
    __syncthreads();
    fft_load_s1(re, im, g, xr, xi); dft16<false>(xr, xi);
#pragma unroll
    for (int k = 0; k < 8; ++k) { const f32x4 w = kf[g * 8 + k];
        const float r0 = xr[2 * k] * w.x - xi[2 * k] * w.y, i0 = xr[2 * k] * w.y + xi[2 * k] * w.x;
        const float r1 = xr[2 * k + 1] * w.z - xi[2 * k + 1] * w.w, i1 = xr[2 * k + 1] * w.w + xi[2 * k + 1] * w.z;
        xr[2 * k] = r0; xi[2 * k] = i0; xr[2 * k + 1] = r1; xi[2 * k + 1] = i1; }
    dft16<true>(xr, xi); fft_store_s1(re, im, g, xr, xi);
    __syncthreads();
    fft_load_s16(re, im, g, xr, xi); twiddle16<true>(xr, xi, g & 15, 256); dft16<true>(xr, xi); fft_store_s16(re, im, g, xr, xi);
    __syncthreads();
    fft_load_s256(re, im, g, xr, xi); twiddle16<true>(xr, xi, g, 4096); dft16<true>(xr, xi);
}
__device__ __forceinline__ void hyena_fft(const Ctx& C) {
    unsigned char* ws = C.ws;
    const bf16* hyt = (const bf16*)(ws + WS_HYT); const f32x4* KF = (const f32x4*)(ws + WS_KF); float* ZT = (float*)(ws + WS_ZT);
    const float* cw = C.A.in[3]; const float* cb = C.A.in[4]; const float* skip = C.A.in[11];
    const int half = C.tid >> 8, g = C.tid & 255;
    LAS float* re = (LAS float*)(C.lds + half * (2 * FFT_WORDS * 4)); LAS float* im = re + FFT_WORDS;
    LAS bf16* rows = (LAS bf16*)(C.lds + 4 * FFT_WORDS * 4 + half * 16384);
    for (int c = blockIdx.x; c < DHY; c += C.G) {
        float vr[8], vi[8], ar[8], ai[8];
        __syncthreads();
#pragma unroll
        for (int rr = 0; rr < 4; ++rr) { const int part = rr >> 1, bq = rr & 1;
            *(LAS v4u*)(rows + rr * 2048 + g * 8) = *(const v4u*)(hyt + (size_t)(part * 1024 + c) * T + (2 * half + bq) * SEQ + g * 8); }
        __syncthreads();
#pragma unroll
        for (int part = 0; part < 2; ++part) {
            const int ch = part * 1024 + c; const float w0 = cw[ch], w1 = cw[3072 + ch], w2 = cw[6144 + ch], bb = cb[ch];
#pragma unroll
            for (int bq = 0; bq < 2; ++bq) { const LAS bf16* row = rows + (part * 2 + bq) * 2048;
#pragma unroll
                for (int m = 0; m < 8; ++m) { const int t = g + 256 * m;
                    const float p = t > 0 ? bf2f(row[t - 1]) : 0.f, q = bf2f(row[t]), n = t < SEQ - 1 ? bf2f(row[t + 1]) : 0.f;
                    const float r = w0 * p + w1 * q + w2 * n + bb;
                    if (part == 0) { if (bq == 0) vr[m] = r; else vi[m] = r; } else { if (bq == 0) ar[m] = r; else ai[m] = r; } } }
        }
        const float sk0 = skip[c], sk1 = skip[1024 + c];
        float xr[16], xi[16];
#pragma unroll
        for (int m = 0; m < 8; ++m) { xr[m] = vr[m]; xi[m] = vi[m]; xr[m + 8] = 0.f; xi[m + 8] = 0.f; }
        hyena_conv_once(re, im, g, xr, xi, KF + (size_t)c * 2048);
#pragma unroll
        for (int m = 0; m < 8; ++m) { vr[m] = ar[m] * (xr[m] + sk0 * vr[m]); vi[m] = ai[m] * (xi[m] + sk0 * vi[m]); xr[m] = vr[m]; xi[m] = vi[m]; xr[m + 8] = 0.f; xi[m + 8] = 0.f; }
        v4u x2a, x2b;
        { const bf16* src = hyt + (size_t)(2048 + c) * T + (2 * half) * SEQ + g * 8; x2a = *(const v4u*)src; x2b = *(const v4u*)(src + SEQ); }
        hyena_conv_once(re, im, g, xr, xi, KF + (size_t)(1024 + c) * 2048);
        *(LAS v4u*)(rows + g * 8) = x2a; *(LAS v4u*)(rows + 2048 + g * 8) = x2b;
        __syncthreads();
        float* zr = ZT + (size_t)c * T + (2 * half) * SEQ;
        { const int ch = 2048 + c; const float w0 = cw[ch], w1 = cw[3072 + ch], w2 = cw[6144 + ch], bb = cb[ch];
#pragma unroll
          for (int bq = 0; bq < 2; ++bq) { const LAS bf16* row = rows + bq * 2048;
#pragma unroll
            for (int m = 0; m < 8; ++m) { const int t = g + 256 * m;
                const float p = t > 0 ? bf2f(row[t - 1]) : 0.f, q = bf2f(row[t]), n = t < SEQ - 1 ? bf2f(row[t + 1]) : 0.f;
                const float x2 = w0 * p + w1 * q + w2 * n + bb;
                if (bq == 0) zr[t] = x2 * (xr[m] + sk1 * vr[m]); else zr[SEQ + t] = x2 * (xi[m] + sk1 * vi[m]); } } }
    }
    __syncthreads();
}

typedef short ml_bf16x8 __attribute__((ext_vector_type(8)));
typedef short ml_s16x4 __attribute__((ext_vector_type(4)));
typedef float ml_f32x16 __attribute__((ext_vector_type(16)));
typedef __bf16 ml_bf2 __attribute__((ext_vector_type(2)));
constexpr int ML_KROW = 272, ML_VROW = 136, ML_KBUF = 64 * ML_KROW, ML_VBUF = 128 * ML_VROW;
__device__ __forceinline__ unsigned ml_pk(float lo, float hi) { const f32x2 v = {lo, hi}; return __builtin_bit_cast(unsigned, __builtin_convertvector(v, ml_bf2)); }
__device__ __forceinline__ void mlstm_mfma(const Ctx& C) {
    unsigned char* ws = C.ws;
    const bf16* qkc = (const bf16*)(ws + WS_QKC); const bf16* vt = (const bf16*)(ws + WS_HYT) + (size_t)3072 * T;
    const float* GA = (const float*)(ws + WS_GA); const float* GP = (const float*)(ws + WS_GP); const float* GE = (const float*)(ws + WS_GE);
    const bf16* ob = (const bf16*)(ws + WS_OB); bf16* ycat = (bf16*)(ws + (size_t)YCAT_T0 * MiB); const float* mlw = C.A.in[15];
    LAS unsigned char* KB = C.lds; LAS unsigned char* VB = C.lds + 2 * ML_KBUF; LAS float* AS = (LAS float*)(C.lds + 2 * ML_KBUF + 2 * ML_VBUF);
    const int w = C.wave;
    for (int u = blockIdx.x; u < 256; u += C.G) {
        int tid = C.tid; asm volatile("" : "+v"(tid));
        const int lane = tid & 63, r = lane & 31, hh = lane >> 5;
        const int bh = u >> 3, qb = u & 7, b = bh >> 3, h = bh & 7;
        const bf16* kbase = qkc + (size_t)(b * SEQ) * 2048 + 1024 + h * 128;
        const bf16* vbase = vt + (size_t)(h * 128) * T + b * SEQ;
        const int qlo = 256 * qb + 32 * w, tq = qlo + r;
        ml_bf16x8 qf[8];
        { const bf16* qrow = qkc + (size_t)(b * SEQ + tq) * 2048 + h * 128 + 8 * hh;
#pragma unroll
          for (int s = 0; s < 8; ++s) qf[s] = *(const ml_bf16x8*)(qrow + 16 * s); }
        ml_f32x16 O[4];
#pragma unroll 1
        for (int dir = 0; dir < 2; ++dir) {
            const int bhd = bh * 2 + dir;
            __syncthreads();
            for (int i = tid; i < SEQ; i += NTHREADS) AS[i] = GA[bhd * SEQ + i] * 1.4426950408889634f;
            const float pmt = GP[bhd * SEQ + tq] * 1.4426950408889634f;
#pragma unroll
            for (int d = 0; d < 4; ++d)
#pragma unroll
                for (int i = 0; i < 16; ++i) O[d][i] = 0.f;
            float den = 0.f;
            const int kt0 = dir ? 4 * qb : 0, kt1 = dir ? 31 : 4 * qb + 3;
            v4u kr0, kr1, vr0, vr1;
            const unsigned koff0 = (unsigned)((tid >> 4) * 4096 + (tid & 15) * 16), koff1 = koff0 + 32u * 4096u;
            const unsigned voff0 = (unsigned)((tid >> 3) * (T * 2) + (tid & 7) * 16), voff1 = voff0 + 64u * (unsigned)(T * 2);
#define ML_LOAD(kt) do { const char* ku_ = (const char*)kbase + (size_t)(kt) * (64 * 4096); const char* vu_ = (const char*)vbase + (size_t)(kt) * 128; \
                kr0 = *(const v4u*)(ku_ + koff0); kr1 = *(const v4u*)(ku_ + koff1); vr0 = *(const v4u*)(vu_ + voff0); vr1 = *(const v4u*)(vu_ + voff1); } while (0)
#define ML_STORE(buf) do { const int p0 = tid, p1 = tid + 512; \
                *(LAS v4u*)(KB + (buf) * ML_KBUF + (p0 >> 4) * ML_KROW + (p0 & 15) * 16) = kr0; *(LAS v4u*)(KB + (buf) * ML_KBUF + (p1 >> 4) * ML_KROW + (p1 & 15) * 16) = kr1; \
                { LAS unsigned char* d0 = VB + (buf) * ML_VBUF + (p0 >> 3) * ML_VROW + (p0 & 7) * 16; *(LAS v2u*)d0 = (v2u){vr0.x, vr0.y}; *(LAS v2u*)(d0 + 8) = (v2u){vr0.z, vr0.w}; } \
                { LAS unsigned char* d1 = VB + (buf) * ML_VBUF + (p1 >> 3) * ML_VROW + (p1 & 7) * 16; *(LAS v2u*)d1 = (v2u){vr1.x, vr1.y}; *(LAS v2u*)(d1 + 8) = (v2u){vr1.z, vr1.w}; } } while (0)
            ML_LOAD(kt0);
            __syncthreads();
            ML_STORE(0);
            __syncthreads();
#pragma unroll 1
            for (int kt = kt0; kt <= kt1; ++kt) {
                const int cur = (kt - kt0) & 1;
                if (kt < kt1) ML_LOAD(kt + 1);
                const int klo = 64 * kt, khi = klo + 63, qhi = qlo + 31;
                const bool none = dir ? (khi < qlo) : (klo > qhi);
                const bool all = dir ? (klo >= qhi) : (khi <= qlo);
                if (!none) {
                    const LAS unsigned char* Kb = KB + cur * ML_KBUF; const LAS unsigned char* Vb = VB + cur * ML_VBUF;
                    ml_f32x16 S0, S1;
#pragma unroll
                    for (int i = 0; i < 16; ++i) { S0[i] = 0.f; S1[i] = 0.f; }
#pragma unroll
                    for (int s = 0; s < 8; ++s) {
                        const ml_bf16x8 k0 = *(const LAS ml_bf16x8*)(Kb + r * ML_KROW + (16 * s + 8 * hh) * 2);
                        const ml_bf16x8 k1 = *(const LAS ml_bf16x8*)(Kb + (32 + r) * ML_KROW + (16 * s + 8 * hh) * 2);
                        S0 = __builtin_amdgcn_mfma_f32_32x32x16_bf16(k0, qf[s], S0, 0, 0, 0);
                        S1 = __builtin_amdgcn_mfma_f32_32x32x16_bf16(k1, qf[s], S1, 0, 0, 0);
                    }
                    float den1 = 0.f;
#define ML_WGT(COND) do { _Pragma("unroll") for (int kb = 0; kb < 2; ++kb) _Pragma("unroll") for (int g4 = 0; g4 < 4; ++g4) { \
                        const f32x4 a4 = *(const LAS f32x4*)(AS + klo + 32 * kb + 8 * g4 + 4 * hh); \
                        _Pragma("unroll") for (int e = 0; e < 4; ++e) { const int i = 4 * g4 + e; const int cpos = 32 * kb + 8 * g4 + e; (void)cpos; \
                            const float sv = kb ? S1[i] : S0[i]; float p = sv * __builtin_amdgcn_exp2f(a4[e] - pmt); \
                            p = (COND) ? p : 0.f; \
                            if (e & 1) den1 += p; else den += p; \
                            if (kb) S1[i] = p; else S0[i] = p; } } } while (0)
                    if (all) { ML_WGT(true); }
                    else { const int sgn = dir ? -1 : 1, dd = sgn * (tq - klo - 4 * hh);
                        ML_WGT(sgn * cpos <= dd); }
#undef ML_WGT
                    den += den1;
#pragma unroll
                    for (int kb = 0; kb < 2; ++kb)
#pragma unroll
                        for (int s = 0; s < 2; ++s) {
                            v4u pw;
                            if (kb == 0) { pw.x = ml_pk(S0[8 * s], S0[8 * s + 1]); pw.y = ml_pk(S0[8 * s + 2], S0[8 * s + 3]); pw.z = ml_pk(S0[8 * s + 4], S0[8 * s + 5]); pw.w = ml_pk(S0[8 * s + 6], S0[8 * s + 7]); }
                            else { pw.x = ml_pk(S1[8 * s], S1[8 * s + 1]); pw.y = ml_pk(S1[8 * s + 2], S1[8 * s + 3]); pw.z = ml_pk(S1[8 * s + 4], S1[8 * s + 5]); pw.w = ml_pk(S1[8 * s + 6], S1[8 * s + 7]); }
                            const ml_bf16x8 pf = __builtin_bit_cast(ml_bf16x8, pw);
#pragma unroll
                            for (int db = 0; db < 4; ++db) {
                                const LAS unsigned char* vp = Vb + (32 * db + r) * ML_VROW + 2 * (32 * kb + 16 * s + 4 * hh);
                                const ml_s16x4 lo = *(const LAS ml_s16x4*)vp, hi = *(const LAS ml_s16x4*)(vp + 16);
                                const ml_bf16x8 vf = __builtin_shufflevector(lo, hi, 0, 1, 2, 3, 4, 5, 6, 7);
                                O[db] = __builtin_amdgcn_mfma_f32_32x32x16_bf16(vf, pf, O[db], 0, 0, 0);
                            }
                        }
                }
                if (kt < kt1) ML_STORE(cur ^ 1);
                __syncthreads();
            }
#undef ML_LOAD
#undef ML_STORE
            den += __shfl_xor(den, 32);
            const float scl = 1.0f / fmaxf(fabsf(den), GE[bhd * SEQ + tq]);
            int th = tid; asm volatile("" : "+v"(th));
            v4u* hp = (v4u*)(ws + WS_HML) + ((size_t)u * NTHREADS + th) * 8;
            if (dir == 0) {
#pragma unroll
                for (int db = 0; db < 4; ++db)
#pragma unroll
                    for (int q2 = 0; q2 < 2; ++q2) { v4u pk;
#pragma unroll
                        for (int j = 0; j < 4; ++j) pk[j] = ml_pk(O[db][8 * q2 + 2 * j] * scl, O[db][8 * q2 + 2 * j + 1] * scl);
                        hp[db * 2 + q2] = pk; }
            } else {
#pragma unroll
                for (int db = 0; db < 4; ++db)
#pragma unroll
                    for (int q2 = 0; q2 < 2; ++q2) { const v4u pk = hp[db * 2 + q2];
#pragma unroll
                        for (int j = 0; j < 4; ++j) { O[db][8 * q2 + 2 * j] = O[db][8 * q2 + 2 * j] * scl + bflo(pk[j]); O[db][8 * q2 + 2 * j + 1] = O[db][8 * q2 + 2 * j + 1] * scl + bfhi(pk[j]); } }
            }
        }
        float sm = 0.f;
#pragma unroll
        for (int db = 0; db < 4; ++db)
#pragma unroll
            for (int i = 0; i < 16; ++i) sm += O[db][i];
        sm += __shfl_xor(sm, 32);
        const float mu = sm * (1.0f / 128.0f); float qv = 0.f;
#pragma unroll
        for (int db = 0; db < 4; ++db)
#pragma unroll
            for (int i = 0; i < 16; ++i) { O[db][i] -= mu; qv += O[db][i] * O[db][i]; }
        qv += __shfl_xor(qv, 32);
        const float rstd = 1.0f / sqrtf(qv * (1.0f / 128.0f) + LN_EPS);
        LAS unsigned char* TB = C.lds;
        int te = tid; asm volatile("" : "+v"(te));
        __syncthreads();
        if (te < 128) AS[te] = mlw[h * 128 + te];
#pragma unroll
        for (int i = 0; i < 8; ++i) { const int pc = te + 512 * i, row = pc >> 4, ch = pc & 15;
            *(LAS v4u*)(TB + row * 272 + ch * 16) = *(const v4u*)(ob + (size_t)(b * SEQ + 256 * qb + row) * 1024 + h * 128 + ch * 8); }
        __syncthreads();
        LAS unsigned char* myrow = TB + (32 * w + (te & 31)) * 272 + 8 * ((te & 63) >> 5);
#pragma unroll
        for (int db = 0; db < 4; ++db)
#pragma unroll
            for (int g4 = 0; g4 < 4; ++g4) {
                const int dim = 32 * db + 8 * g4 + 4 * ((te & 63) >> 5); const f32x4 gw = *(const LAS f32x4*)(AS + dim);
                LAS v2u* pp = (LAS v2u*)(myrow + (32 * db + 8 * g4) * 2); const v2u ow = *pp;
                const float o0 = bflo(ow.x), o1 = bfhi(ow.x), o2 = bflo(ow.y), o3 = bfhi(ow.y);
                const float y0 = O[db][4 * g4] * rstd * gw.x / (1.0f + __expf(-o0)), y1 = O[db][4 * g4 + 1] * rstd * gw.y / (1.0f + __expf(-o1));
                const float y2 = O[db][4 * g4 + 2] * rstd * gw.z / (1.0f + __expf(-o2)), y3 = O[db][4 * g4 + 3] * rstd * gw.w / (1.0f + __expf(-o3));
                *pp = (v2u){ml_pk(y0, y1), ml_pk(y2, y3)};
            }
        __syncthreads();
#pragma unroll
        for (int i = 0; i < 8; ++i) { const int pc = te + 512 * i, row = pc >> 4, ch = pc & 15;
#if OUTPROJ_F8
            { const v4u t8 = *(const LAS v4u*)(TB + row * 272 + ch * 16); v2u o8; o8.x = pk4_fp8(bflo(t8.x) * Y8_SCALE, bfhi(t8.x) * Y8_SCALE, bflo(t8.y) * Y8_SCALE, bfhi(t8.y) * Y8_SCALE); o8.y = pk4_fp8(bflo(t8.z) * Y8_SCALE, bfhi(t8.z) * Y8_SCALE, bflo(t8.w) * Y8_SCALE, bfhi(t8.w) * Y8_SCALE);
              *(v2u*)((unsigned char*)ycat + (size_t)(b * SEQ + 256 * qb + row) * 2048 + 1024 + h * 128 + ch * 8) = o8; } }
#else
            *(v4u*)(ycat + (size_t)(b * SEQ + 256 * qb + row) * 2048 + 1024 + h * 128 + ch * 8) = *(const LAS v4u*)(TB + row * 272 + ch * 16); }
#endif
    }
    __syncthreads();
}

__device__ __forceinline__ void phase4(const Ctx& C) {
    unsigned char* ws = C.ws;
    const float* ZT = (const float*)(ws + WS_ZT); const float* HML = (const float*)(ws + WS_HML); const bf16* ob = (const bf16*)(ws + WS_OB);
    bf16* ycat = (bf16*)(ws + (size_t)YCAT_T0 * MiB); const float* hyw = C.A.in[12]; const float* mlw = C.A.in[15];
    const int lane = C.lane;
    {
        LAS float* red = (LAS float*)C.lds;
        for (int u = blockIdx.x; u < 128 * 8; u += C.G) {
            const int tt = u >> 3, gi = u & 7, tok = tt * 64 + lane, ch0 = gi * 128 + C.wave * 16;
            float x[16]; float s = 0.f;
#pragma unroll
            for (int i = 0; i < 16; ++i) { x[i] = ZT[(size_t)(ch0 + i) * T + tok]; s += x[i]; }
            __syncthreads();
            red[C.wave * 64 + lane] = s;
            __syncthreads();
            float tot = 0.f;
#pragma unroll
            for (int w = 0; w < 8; ++w) tot += red[w * 64 + lane];
            const float mu = tot * (1.0f / 128.0f); float q = 0.f;
#pragma unroll
            for (int i = 0; i < 16; ++i) { x[i] -= mu; q += x[i] * x[i]; }
            __syncthreads();
            red[C.wave * 64 + lane] = q;
            __syncthreads();
            float qt = 0.f;
#pragma unroll
            for (int w = 0; w < 8; ++w) qt += red[w * 64 + lane];
            const float rstd = 1.0f / sqrtf(qt * (1.0f / 128.0f) + LN_EPS);
            float y[16];
#pragma unroll
            for (int i = 0; i < 16; ++i) y[i] = x[i] * rstd * hyw[ch0 + i];
            v4u w0, w1; w0.x = pk2(y[0], y[1]); w0.y = pk2(y[2], y[3]); w0.z = pk2(y[4], y[5]); w0.w = pk2(y[6], y[7]);
            w1.x = pk2(y[8], y[9]); w1.y = pk2(y[10], y[11]); w1.z = pk2(y[12], y[13]); w1.w = pk2(y[14], y[15]);
#if OUTPROJ_F8
            {
#pragma unroll
              for (int i = 0; i < 16; ++i) y[i] *= Y8_SCALE;
              v4u o8; o8.x = pk4_fp8(y[0], y[1], y[2], y[3]); o8.y = pk4_fp8(y[4], y[5], y[6], y[7]); o8.z = pk4_fp8(y[8], y[9], y[10], y[11]); o8.w = pk4_fp8(y[12], y[13], y[14], y[15]);
              *(v4u*)((unsigned char*)ycat + (size_t)tok * 2048 + ch0) = o8; (void)w0; (void)w1; }
#else
            bf16* dst = ycat + (size_t)tok * 2048 + ch0;
            *(v4u*)dst = w0; *(v4u*)(dst + 8) = w1;
#endif
        }
        __syncthreads();
    }
}

struct TileOrder {
    int nM, nN, a0, b0, G, c;
    __device__ __forceinline__ bool next(int i, pg8::Unit& u) const {
        const int nwg = nM * nN; const int L = i * G + c; if (L >= nwg) return false;
        int w; { const int q = nwg / 8, r = nwg % 8, xcd = L % 8, off = L / 8; w = (xcd < r ? xcd * (q + 1) : r * (q + 1) + (xcd - r) * q) + off; }
        const int nig = 8 * nN, gid = w / nig, wi = w % nig; u.pm = a0 + gid * 8 + (wi % 8); u.pn = b0 + wi / 8; return true;
    }
    __device__ __forceinline__ void a_ready(const pg8::Unit&) const {}
    __device__ __forceinline__ void done(const pg8::Unit&) const {}
};
struct EpiOut {
    static constexpr bool PERM = false, AFTER_DRAIN = false, F8 = OUTPROJ_F8 != 0;
    const float* x; const float* bias; float* r1;
    __device__ __forceinline__ void operator()(const pg8::f32x4 (&acc)[2][2][4][2], const pg8::Unit& u, int wr, int wc, int fr, int fq) const {
        constexpr int TS = OUTPROJ_F8 ? 2 : 1; constexpr float WSC = OUTPROJ_F8 ? 1.0f / (W8_SCALE * Y8_SCALE) : 1.0f;
        const int row0 = (u.pm - TS * YCAT_T0) * 256 + wr * 64 + fr, col0 = (u.pn - TS * WOUT_T0) * 256 + wc * 32 + 4 * fq;
        pg8::f32x4 bv[2][2];
#pragma unroll
        for (int bj = 0; bj < 2; ++bj)
#pragma unroll
            for (int n = 0; n < 2; ++n) bv[bj][n] = *(const pg8::f32x4*)(bias + col0 + bj * 128 + n * 16);
#pragma unroll
        for (int ai = 0; ai < 2; ++ai)
#pragma unroll
            for (int mp = 0; mp < 2; ++mp) { pg8::f32x4 xs[2][2][2];
#pragma unroll
                for (int mm = 0; mm < 2; ++mm) { const size_t off = (size_t)(row0 + ai * 128 + (2 * mp + mm) * 16) * D + col0;
#pragma unroll
                    for (int bj = 0; bj < 2; ++bj)
#pragma unroll
                        for (int n = 0; n < 2; ++n) xs[mm][bj][n] = *(const pg8::f32x4*)(x + off + bj * 128 + n * 16); }
#pragma unroll
                for (int mm = 0; mm < 2; ++mm) { const int m = 2 * mp + mm; const size_t off = (size_t)(row0 + ai * 128 + m * 16) * D + col0;
#pragma unroll
                    for (int bj = 0; bj < 2; ++bj)
#pragma unroll
                        for (int n = 0; n < 2; ++n) *(pg8::f32x4*)(r1 + off + bj * 128 + n * 16) = xs[mm][bj][n] * DN_ALPHA + acc[ai][bj][m][n] * WSC + bv[bj][n]; } }
    }
};

#define P6_RS_STEP(NV, XM) do { const bool up = (lane & (XM)) != 0; _Pragma("unroll") for (int e_ = 0; e_ < (NV); ++e_) { \
        const float keep0 = up ? a0[e_ + (NV)] : a0[e_], send0 = up ? a0[e_] : a0[e_ + (NV)]; a0[e_] = keep0 + __shfl_xor(send0, (XM)); \
        const float keep1 = up ? a1[e_ + (NV)] : a1[e_], send1 = up ? a1[e_] : a1[e_ + (NV)]; a1[e_] = keep1 + __shfl_xor(send1, (XM)); } } while (0)
__device__ __forceinline__ void phase6(const Ctx& C, int dummy) {
    unsigned char* ws = C.ws;
    float* r1 = (float*)(ws + WS_R1); bf16* x1b = (bf16*)(ws + (size_t)X1B_T0 * MiB);
    const float* g1 = C.A.in[18]; const float* b1 = C.A.in[19]; const float* rw = C.A.in[20]; const float* rb = C.A.in[21];
    unsigned* cnt = (unsigned*)(ws + WS_CTL) + CW_CNT + (dummy ? 4096 : 0); int* list = (int*)(ws + (dummy ? WS_YBUF : WS_LIST)); float* tokw = (float*)(ws + (dummy ? WS_YBUF + 2 * MiB : WS_TOKW));
    const int lane = C.lane;
    LAS unsigned char* wbuf = C.lds;
    LAS unsigned* hist = (LAS unsigned*)(C.lds + 65536); LAS unsigned* hbase = hist + 32;
    if (C.tid < NE) hist[C.tid] = 0u;
    __syncthreads();
    for (int it = blockIdx.x; it < T / 16; it += C.G) {
        const int pair = it * 8 + C.wave;
        int ln = lane; asm volatile("" : "+v"(ln));
        f32x4 v0[8], v1[8];
#pragma unroll
        for (int tk = 0; tk < 2; ++tk) {
            const int tok = 2 * pair + tk; float* rr = r1 + (size_t)tok * D; f32x4 v[8]; float s = 0.f;
#pragma unroll
            for (int j = 0; j < 8; ++j) { v[j] = *(const f32x4*)(rr + (ln + 64 * j) * 4); s += (v[j].x + v[j].y) + (v[j].z + v[j].w); }
            const float mean = wave_sum(s) * (1.0f / D); float q = 0.f;
#pragma unroll
            for (int j = 0; j < 8; ++j) { v[j] = v[j] - mean; q += (v[j].x * v[j].x + v[j].y * v[j].y) + (v[j].z * v[j].z + v[j].w * v[j].w); }
            const float rstd = 1.0f / sqrtf(wave_sum(q) * (1.0f / D) + LN_EPS);
#pragma unroll
            for (int j = 0; j < 8; ++j) { const int c0 = (ln + 64 * j) * 4; const f32x4 gg = *(const f32x4*)(g1 + c0), bb = *(const f32x4*)(b1 + c0);
                const f32x4 y = v[j] * rstd * gg + bb;
                if (!dummy) { v2u w; w.x = pk2(y.x, y.y); w.y = pk2(y.z, y.w); *(v2u*)(x1b + (size_t)tok * D + c0) = w; }
                if (!dummy) { unsigned q8 = 0u; q8 = __builtin_amdgcn_cvt_pk_fp8_f32(y.x, y.y, q8, false); q8 = __builtin_amdgcn_cvt_pk_fp8_f32(y.z, y.w, q8, true); *(unsigned*)(ws + WS_X1Q + (size_t)tok * D + c0) = q8; }
                if (tk == 0) v0[j] = y; else v1[j] = y; }
        }
        int my_e0 = 0, my_r0 = 0, my_e1 = 0, my_r1 = 0;
        float a0[32], a1[32];
#pragma unroll
        for (int e = 0; e < 32; ++e) { a0[e] = 0.f; a1[e] = 0.f; }
        const int tid = C.tid; f32x4 st[4];
        const bool hi8 = (ln & 8) != 0;
        const unsigned rdoff = (unsigned)(4 * ln) * 128u, rdx = (unsigned)(ln & 7);
#define P6_CHUNK_LOAD(j_) do { _Pragma("unroll") for (int r_ = 0; r_ < 4; ++r_) st[r_] = *(const f32x4*)(rw + (size_t)(j_) * 8192 + (size_t)(tid + 512 * r_) * 4); } while (0)
#define P6_CHUNK_STORE(b_) do { _Pragma("unroll") for (int r_ = 0; r_ < 4; ++r_) { const int idx_ = tid + 512 * r_, row_ = idx_ >> 3, q_ = idx_ & 7; \
            *(LAS f32x4*)(wbuf + (b_) * 32768 + row_ * 128 + 16 * (q_ ^ ((row_ >> 2) & 7))) = st[r_]; } } while (0)
        __syncthreads();
        P6_CHUNK_LOAD(0); P6_CHUNK_STORE(0);
        __syncthreads();
#pragma unroll
        for (int j = 0; j < 8; ++j) {
            if (j < 7) P6_CHUNK_LOAD(j + 1);
            const LAS unsigned char* wb = wbuf + (j & 1) * 32768 + rdoff;
#pragma unroll
            for (int i = 0; i < 4; ++i) {
                const float x0 = hi8 ? v0[j][i ^ 1] : v0[j][i], x1 = hi8 ? v1[j][i ^ 1] : v1[j][i];
                const LAS unsigned char* wrow = wb + (hi8 ? (i ^ 1) : i) * 128;
#pragma unroll
                for (int q4 = 0; q4 < 8; ++q4) { const f32x4 w4 = *(const LAS f32x4*)(wrow + 16 * (q4 ^ rdx));
                    a0[4 * q4] += x0 * w4.x; a0[4 * q4 + 1] += x0 * w4.y; a0[4 * q4 + 2] += x0 * w4.z; a0[4 * q4 + 3] += x0 * w4.w;
                    a1[4 * q4] += x1 * w4.x; a1[4 * q4 + 1] += x1 * w4.y; a1[4 * q4 + 2] += x1 * w4.z; a1[4 * q4 + 3] += x1 * w4.w; }
            }
            if (j < 7) P6_CHUNK_STORE((j + 1) & 1);
            __syncthreads();
        }
#undef P6_CHUNK_LOAD
#undef P6_CHUNK_STORE
        P6_RS_STEP(16, 32); P6_RS_STEP(8, 16); P6_RS_STEP(4, 8); P6_RS_STEP(2, 4); P6_RS_STEP(1, 2);
        int le_ = lane; asm volatile("" : "+v"(le_));
        const int e = le_ >> 1; const float rbe = rb[e];
        float lg0 = a0[0] + __shfl_xor(a0[0], 1) + rbe, lg1 = a1[0] + __shfl_xor(a1[0], 1) + rbe;
#pragma unroll
        for (int tk = 0; tk < 2; ++tk) {
            const int tok = 2 * pair + tk; float val = tk ? lg1 : lg0; float vals[4]; int idxs[4];
#pragma unroll
            for (int k = 0; k < 4; ++k) {
                const float m = wave_max(val);
                const unsigned long long bal = __ballot(val == m);
                const int idx = (int)(__builtin_ctzll(bal) >> 1);
                vals[k] = m; idxs[k] = idx;
                if (e == idx) val = -3.0e38f;
            }
            const float e1 = expf(vals[1] - vals[0]), e2 = expf(vals[2] - vals[0]), e3 = expf(vals[3] - vals[0]);
            const float inv = 1.0f / (1.0f + e1 + e2 + e3);
            if (lane < 4) {
                const int sel_e = lane == 0 ? idxs[0] : lane == 1 ? idxs[1] : lane == 2 ? idxs[2] : idxs[3];
                const float sel_v = (lane == 0 ? 1.0f : lane == 1 ? e1 : lane == 2 ? e2 : e3) * inv;
                tokw[tok * 4 + lane] = sel_v;
                const int rk = (int)__hip_atomic_fetch_add(hist + sel_e, 1u, __ATOMIC_RELAXED, __HIP_MEMORY_SCOPE_WORKGROUP);
                if (tk == 0) { my_e0 = sel_e; my_r0 = rk; } else { my_e1 = sel_e; my_r1 = rk; }
            }
        }
        __syncthreads();
        int tl = C.tid; asm volatile("" : "+v"(tl));
        if (tl < NE) { const unsigned n = hist[tl]; hbase[tl] = n ? atomicAdd(cnt + 64 * tl, n) : 0u; }
        __syncthreads();
        if (lane < 4) { list[my_e0 * T + (int)hbase[my_e0] + my_r0] = (2 * pair) * 4 + lane; list[my_e1 * T + (int)hbase[my_e1] + my_r1] = (2 * pair + 1) * 4 + lane; }
        __syncthreads();
        if (tl < NE) hist[tl] = 0u;
    }
}
#undef P6_RS_STEP

__device__ __forceinline__ void moe_build_tb(const Ctx& C) {
    LAS int* tb = (LAS int*)(C.lds + LDS_TB);
    __syncthreads();
    if (C.tid == 0) { const unsigned* cnt = (const unsigned*)(C.ws + WS_CTL) + CW_CNT; int acc = 0;
        for (int e = 0; e < NE; ++e) { const int n = (int)__hip_atomic_load(cnt + 64 * e, __ATOMIC_RELAXED, __HIP_MEMORY_SCOPE_AGENT); tb[e] = acc; tb[40 + e] = n; acc += (n + 255) >> 8; }
        tb[32] = acc; }
    __syncthreads();
}
struct MoeOrder {
    const LAS int* tb; int NJ, a0, w0, G, c; const int* list; int gather;
    const LAS int* ul; const LAS int* rowt;
    __device__ __forceinline__ bool compute(int i, pg8::Unit& u) const {
        const int nwg = tb[32] * NJ; const int L = i * G + c; if (L >= nwg) return false;
        int w; { const int q = nwg / 8, r = nwg % 8, xcd = L % 8, off = L / 8; w = (xcd < r ? xcd * (q + 1) : r * (q + 1) + (xcd - r) * q) + off; }
        int e = 0;
        while (e < NE - 1 && tb[e + 1] * NJ <= w) ++e;
        const int local = w - tb[e] * NJ, nt = tb[e + 1] - tb[e], j = local / nt, ti = local - j * nt;
        u.pm = a0 + tb[e] + ti; u.pn = w0 + e * NJ + j; return true;
    }
    __device__ __forceinline__ bool next(int i, pg8::Unit& u) const {
        if (i < MOE_MAXU) { const int pm = __builtin_amdgcn_readfirstlane(ul[i]); if (pm < 0) return false; u.pm = pm; u.pn = __builtin_amdgcn_readfirstlane(ul[16 + i]); return true; }
        pg8::Unit t; const bool ok = compute(i, t); if (!ok) return false; u.pm = __builtin_amdgcn_readfirstlane(t.pm); u.pn = __builtin_amdgcn_readfirstlane(t.pn); return true;
    }
    __device__ __forceinline__ int row_slow(const pg8::Unit& u, int r) const { const int e = (u.pn - w0) / NJ; const int i = (u.pm - a0 - tb[e]) * 256 + r; return i < tb[40 + e] ? (list[e * T + i] >> 2) : 0; }
    __device__ __forceinline__ int a_row(const pg8::Unit& u, int idx, int r) const { if (!gather) return (u.pm - a0) * 256 + r; if (idx < MOE_MAXU) return rowt[idx * 256 + r]; return row_slow(u, r); }
    __device__ __forceinline__ int b_tile(const pg8::Unit& u) const { return u.pn - w0; }
    __device__ __forceinline__ void a_ready(const pg8::Unit&) const {}
    __device__ __forceinline__ void done(const pg8::Unit&) const {}
    __device__ __forceinline__ void setup(int tid) const {
        LAS int* ulw = (LAS int*)ul; LAS int* rtw = (LAS int*)rowt;
        if (tid < MOE_MAXU) { pg8::Unit t; const bool ok = compute(tid, t); ulw[tid] = ok ? t.pm : -1; ulw[16 + tid] = ok ? t.pn : 0; }
        __syncthreads();
        if (gather) for (int idx = tid; idx < MOE_MAXU * 256; idx += NTHREADS) { const int i = idx >> 8; const int pm = ul[i]; if (pm >= 0) { pg8::Unit t; t.pm = pm; t.pn = ul[16 + i]; rtw[idx] = row_slow(t, idx & 255); } }
        __syncthreads();
    }
};
struct EpiGU {
    static constexpr bool PERM = true, AFTER_DRAIN = false, F8 = true;
    const float* b_gu; unsigned char* act; float wsc;
    __device__ __forceinline__ void operator()(const pg8::f32x4 (&acc)[2][2][4][2], const pg8::Unit& u, int wr, int wc, int fr_, int fq_) const {
        int ln_ = threadIdx.x & 63; asm volatile("" : "+v"(ln_));
        const int fr = ln_ & 15, fq = ln_ >> 4;
        using pg8::cvt_pk_bf16;
        const int rt = u.pm - ABUF_T0, rel = u.pn - WGU_Q0, e = rel >> 4, j = rel & 15;
        const int col0 = j * 128 + wc * 32 + 8 * fq;
        pg8::f32x4 bg[2], bu[2];
#pragma unroll
        for (int n = 0; n < 2; ++n) { bg[n] = *(const pg8::f32x4*)(b_gu + (size_t)e * 4096 + col0 + 4 * n); bu[n] = *(const pg8::f32x4*)(b_gu + (size_t)e * 4096 + 2048 + col0 + 4 * n); }
#pragma unroll
        for (int ai = 0; ai < 2; ++ai)
#pragma unroll
            for (int m = 0; m < 4; ++m) { const int row = rt * 256 + ai * 128 + wr * 64 + m * 16 + fr;
                float o[8];
#pragma unroll
                for (int n = 0; n < 2; ++n) { const pg8::f32x4 g = acc[ai][0][m][n] * wsc + bg[n], up = acc[ai][1][m][n] * wsc + bu[n];
#pragma unroll
                    for (int i = 0; i < 4; ++i) { const float gc = fminf(g[i], 7.0f), uc = fminf(fmaxf(up[i], -7.0f), 7.0f);
                        o[4 * n + i] = (uc + 1.0f) * (gc / (1.0f + __expf(-1.702f * gc))); } }
                v2u w; w.x = __builtin_amdgcn_cvt_pk_fp8_f32(o[0], o[1], 0u, false); w.x = __builtin_amdgcn_cvt_pk_fp8_f32(o[2], o[3], w.x, true);
                w.y = __builtin_amdgcn_cvt_pk_fp8_f32(o[4], o[5], 0u, false); w.y = __builtin_amdgcn_cvt_pk_fp8_f32(o[6], o[7], w.y, true);
                *(v2u*)(act + (size_t)row * DFF + col0) = w; }
    }
};
struct EpiDown {
    static constexpr bool PERM = true, AFTER_DRAIN = false, F8 = true;
    const float* b_down; const int* list; const float* tokw; const LAS int* tb; bf16* ybuf; float wsc;
    __device__ __forceinline__ void operator()(const pg8::f32x4 (&acc)[2][2][4][2], const pg8::Unit& u, int wr, int wc, int fr_, int fq_) const {
        using pg8::cvt_pk_bf16;
        int ln_ = threadIdx.x & 63; asm volatile("" : "+v"(ln_));
        const int fr = ln_ & 15, fq = ln_ >> 4;
        const int rel = u.pn - WDN_Q0, e = rel >> 3, j = rel & 7, ti = u.pm - ACT_Q0 - tb[e], n_e = tb[40 + e];
        const int col0 = j * 256 + wc * 32 + 8 * fq;
        pg8::f32x4 bv[2][2];
#pragma unroll
        for (int bj = 0; bj < 2; ++bj)
#pragma unroll
            for (int n = 0; n < 2; ++n) bv[bj][n] = *(const pg8::f32x4*)(b_down + (size_t)e * D + col0 + bj * 128 + 4 * n);
        int slot8[2][4]; float w8[2][4];
#pragma unroll
        for (int ai = 0; ai < 2; ++ai)
#pragma unroll
            for (int m = 0; m < 4; ++m) { const int i = ti * 256 + ai * 128 + wr * 64 + m * 16 + fr; slot8[ai][m] = list[e * T + (i < n_e ? i : (n_e > 0 ? n_e - 1 : 0))]; }
#pragma unroll
        for (int ai = 0; ai < 2; ++ai)
#pragma unroll
            for (int m = 0; m < 4; ++m) w8[ai][m] = tokw[slot8[ai][m]];
#pragma unroll
        for (int ai = 0; ai < 2; ++ai)
#pragma unroll
            for (int m = 0; m < 4; ++m) { const int i = ti * 256 + ai * 128 + wr * 64 + m * 16 + fr;
                { const int slot = (i < n_e) ? slot8[ai][m] : 32768; const float w = w8[ai][m]; bf16* dst = ybuf + (size_t)slot * D + col0;
#pragma unroll
                    for (int bj = 0; bj < 2; ++bj) { const pg8::f32x4 v0 = (acc[ai][bj][m][0] * wsc + bv[bj][0]) * w, v1 = (acc[ai][bj][m][1] * wsc + bv[bj][1]) * w;
                        v4u o; o.x = cvt_pk_bf16(v0[0], v0[1]); o.y = cvt_pk_bf16(v0[2], v0[3]); o.z = cvt_pk_bf16(v1[0], v1[1]); o.w = cvt_pk_bf16(v1[2], v1[3]);
                        *(v4u*)(dst + bj * 128) = o; } } }
    }
};

namespace pg8 {
template <class Epi, class Sched, class Side>
__device__ __forceinline__ void gemm_phase_ga(PG8_LAS unsigned char* lds, const bf16_t* Arows, const bf16_t* Btiles, const int K, const Sched& S, const Epi& E, const Side& SD) {
    const int tid = threadIdx.x, wid = __builtin_amdgcn_readfirstlane(tid >> 6), lane = tid & 63, wr = wid >> 2, wc = wid & 3, fr = lane & 15, fq = lane >> 4;
    const int nt = K / BK;
    unsigned voffB[2];
#pragma unroll
    for (int i = 0; i < 2; ++i) { int R, Cc; stage_rc(tid * 16 + i * 8192, R, Cc); const int Rb = Epi::PERM ? ((R & ~31) + perm32(R & 31)) : R; voffB[i] = (unsigned)(Rb * K + Cc) * 2u; }
    const size_t kstep = (size_t)(BK * 2), hstep = (size_t)HALF * K * 2, tstep = 2 * hstep;
    const unsigned ldsw = (unsigned)wid * 1024u;
    const int aoff = lds_byte(wr * 64 + fr, fq * 8), boff = lds_byte(wc * 32 + fr, fq * 8);
#define PG8_SA(b, h) (((b) * 2 + (h)) * HTB)
#define PG8_SB(b, h) ((4 + (b) * 2 + (h)) * HTB)
    const unsigned ldsb = __builtin_amdgcn_readfirstlane((unsigned)(size_t)lds + ldsw);
#define PG8_DMA(gptr, vo, laddr) asm volatile("s_mov_b32 m0, %2\n\tglobal_load_lds_dwordx4 %0, %1" :: "v"(vo), "s"(gptr), "s"(laddr) : "memory", "m0")
#define PG8_STAGE(bufoff, gbase, voff) do { _Pragma("unroll") for (int _i = 0; _i < 2; ++_i) PG8_DMA((const char*)(gbase), (voff)[_i], ldsb + (unsigned)((bufoff) + _i * 8192)); } while (0)
#define PG8_STAGE2(bufoff, gbase, v0, v1) do { PG8_DMA((const char*)(gbase), v0, ldsb + (unsigned)(bufoff)); PG8_DMA((const char*)(gbase), v1, ldsb + (unsigned)((bufoff) + 8192)); } while (0)
#define PG8_LDA(dst, b, h) do { _Pragma("unroll") for (int m = 0; m < 4; ++m) _Pragma("unroll") for (int k = 0; k < 2; ++k) dst[m][k] = *(const PG8_LAS bf16x8*)(lds + PG8_SA(b, h) + aoff + m * 2048 + k * 1024); } while (0)
#define PG8_LDB(dst, b, h) do { _Pragma("unroll") for (int n = 0; n < 2; ++n) _Pragma("unroll") for (int k = 0; k < 2; ++k) dst[n][k] = *(const PG8_LAS bf16x8*)(lds + PG8_SB(b, h) + boff + n * 2048 + k * 1024); } while (0)
#define PG8_MMA(ai, bj, At, Bt) do { __builtin_amdgcn_s_setprio(1); if constexpr (epi_f8<Epi>::v) { _Pragma("unroll") for (int m = 0; m < 4; ++m) _Pragma("unroll") for (int n = 0; n < 2; ++n) \
        acc[ai][bj][m][n] = __builtin_amdgcn_mfma_scale_f32_16x16x128_f8f6f4(cat8(Bt[n][0], Bt[n][1]), cat8(At[m][0], At[m][1]), acc[ai][bj][m][n], 0, 0, 0, 0, 0, 0); } else { \
        _Pragma("unroll") for (int m = 0; m < 4; ++m) _Pragma("unroll") for (int n = 0; n < 2; ++n) _Pragma("unroll") for (int k = 0; k < 2; ++k) \
        acc[ai][bj][m][n] = __builtin_amdgcn_mfma_f32_16x16x32_bf16(Bt[n][k], At[m][k], acc[ai][bj][m][n], 0, 0, 0); } __builtin_amdgcn_s_setprio(0); } while (0)
#define PG8_WAIT_V(n) asm volatile("s_waitcnt vmcnt(" #n ")" ::: "memory")
#define PG8_WAIT_L(n) asm volatile("s_waitcnt lgkmcnt(" #n ")" ::: "memory")
#define PG8_BAR __builtin_amdgcn_s_barrier()
#define PG8_SCHED __builtin_amdgcn_sched_barrier(0)
#define PG8_AROWS(vo, u, ix) do { int t_ = threadIdx.x; asm volatile("" : "+v"(t_)); _Pragma("unroll") for (int _i = 0; _i < 2; ++_i) { int R_, C_; stage_rc(t_ * 16 + _i * 8192, R_, C_); \
        _Pragma("unroll") for (int _h = 0; _h < 2; ++_h) vo[_h * 2 + _i] = (unsigned)S.a_row(u, ix, _h * 128 + R_) * (unsigned)(K * 2) + (unsigned)(C_ * 2); } } while (0)
    const int skh = 0, snq = wid;
#define PG8_SGV() ({ int t_ = tid; asm volatile("" : "+v"(t_)); (unsigned)((4 * (t_ & 31)) * SD.ldb + 4 * ((t_ >> 5) & 1)) * 4u; })
#define PG8_SDV() ({ int t_ = tid; asm volatile("" : "+v"(t_)); (unsigned)(4 * ((t_ >> 5) & 1)) * 2048u + 4u * (unsigned)(t_ & 31); })
    const size_t sldb4 = Side::ON ? (size_t)SD.ldb * 4 : 0;
    int sstep = Side::ON ? SD.first : 0, sprev = 0, sit = (int)(blockIdx.x >> 3) % Side::PERIOD, sext = 0, sage = 0; bool spend = false;
    f32x4 sx[4] = {(f32x4){0.f, 0.f, 0.f, 0.f}, (f32x4){0.f, 0.f, 0.f, 0.f}, (f32x4){0.f, 0.f, 0.f, 0.f}, (f32x4){0.f, 0.f, 0.f, 0.f}};
    typedef unsigned u32x2s __attribute__((ext_vector_type(2)));
#define PG8_SIDE_LOAD() do { const char* sp_ = (const char*)SD.src(sstep, skh, snq); const unsigned sgv = PG8_SGV(); _Pragma("unroll") for (int _j = 0; _j < 4; ++_j) \
        asm volatile("global_load_dwordx4 %0, %1, %2" : "+v"(sx[_j]) : "v"(sgv), "s"(sp_ + (size_t)_j * sldb4) : "memory"); sprev = sstep; sstep += SD.stride; } while (0)
#define PG8_SIDE_STORE() do { asm volatile("" : "+v"(sx[0]), "+v"(sx[1]), "+v"(sx[2]), "+v"(sx[3])); \
        char* dp_ = (char*)SD.dst(sprev, skh, snq); const unsigned sdv = PG8_SDV(); _Pragma("unroll") for (int _i = 0; _i < 4; ++_i) { unsigned _w = 0u; \
            _w = __builtin_amdgcn_cvt_pk_fp8_f32(sx[0][_i] * W8_SCALE, sx[1][_i] * W8_SCALE, _w, false); _w = __builtin_amdgcn_cvt_pk_fp8_f32(sx[2][_i] * W8_SCALE, sx[3][_i] * W8_SCALE, _w, true); \
            asm volatile("global_store_dword %0, %1, %2" :: "v"(sdv), "v"(_w), "s"(dp_ + (size_t)_i * 2048) : "memory"); } } while (0)
#define PG8_SIDE_SLOT() do { if constexpr (Side::ON && Side::PAIR) { int ext_ = 0; if (spend) { PG8_SIDE_STORE(); spend = false; ext_ += 4; } \
        if (sstep < SD.nsteps) { PG8_SIDE_LOAD(); spend = true; ext_ += 4; } sext = ext_; } else if constexpr (Side::ON) { int ext_ = 0; if (spend) { if (++sage == Side::LAG) { if (Side::LAG == 1) PG8_WAIT_V(8); PG8_SIDE_STORE(); spend = false; ext_ += 4; } } \
        if (!spend && (sit % Side::PERIOD == 0) && (sstep < SD.nsteps)) { PG8_SIDE_LOAD(); spend = true; sage = 0; ext_ += 4; } ++sit; sext = ext_; } } while (0)
#define PG8_WAIT_K() do { if constexpr (Side::ON) { if (sext == 0) PG8_WAIT_V(8); else if (sext == 4) PG8_WAIT_V(12); else PG8_WAIT_V(16); } else PG8_WAIT_V(8); } while (0)
#define PG8_VON_LOAD(y0, y1, y2, y3) do { typedef unsigned u32x2_ __attribute__((ext_vector_type(2))); const u32x2_ q_ = *(const PG8_LAS u32x2_*)(lds + LDS_VON + tid * 8); \
        const unsigned rs_ = (unsigned)__builtin_ctz((unsigned)(K * 2)), m_ = (unsigned)(K * 2) - 1u, c0_ = voC[0] & m_, c1_ = voC[1] & m_; \
        y0 = ((q_.x & 0xffffu) << rs_) | c0_; y1 = ((q_.x >> 16) << rs_) | c1_; y2 = ((q_.y & 0xffffu) << rs_) | c0_; y3 = ((q_.y >> 16) << rs_) | c1_; } while (0)
    Unit cur, nxt; int ui = 0;
    if (!S.next(0, cur)) {
        if constexpr (Side::ON) { while (sstep < SD.nsteps) { PG8_SIDE_LOAD(); PG8_WAIT_V(0); PG8_SIDE_STORE(); } PG8_WAIT_V(0); }
        return;
    }
    f32x4 acc[2][2][4][2];
#pragma unroll
    for (int a = 0; a < 2; ++a)
#pragma unroll
        for (int b = 0; b < 2; ++b)
#pragma unroll
            for (int m = 0; m < 4; ++m)
#pragma unroll
                for (int n = 0; n < 2; ++n) acc[a][b][m][n] = (f32x4){0.f, 0.f, 0.f, 0.f};
    bf16x8 At[4][2], B0[2][2], B1[2][2];
    unsigned voC[4];
    PG8_AROWS(voC, cur, 0);
    const char* cA = (const char*)Arows; const char* cB = (const char*)Btiles + (size_t)cur.pn * tstep;
    PG8_STAGE(PG8_SB(0, 0), cB, voffB); PG8_STAGE(PG8_SB(0, 1), cB + hstep, voffB); PG8_STAGE2(PG8_SA(0, 0), cA, voC[0], voC[1]); PG8_STAGE2(PG8_SA(0, 1), cA, voC[2], voC[3]);
    if (wr == 1) PG8_BAR;
    PG8_WAIT_V(2); PG8_BAR;
    PG8_STAGE(PG8_SB(1, 0), cB + kstep, voffB); PG8_STAGE2(PG8_SA(1, 0), cA + kstep, voC[0], voC[1]); PG8_STAGE(PG8_SB(1, 1), cB + hstep + kstep, voffB);
    PG8_WAIT_V(6); PG8_BAR;
    for (;;) {
        const bool has_next = S.next(ui + 1, nxt);
        if (has_next) { unsigned vn_[4]; PG8_AROWS(vn_, nxt, ui + 1); typedef unsigned u32x2_ __attribute__((ext_vector_type(2)));
            const unsigned rs_ = (unsigned)__builtin_ctz((unsigned)(K * 2));
            *(PG8_LAS u32x2_*)(lds + LDS_VON + tid * 8) = (u32x2_){(vn_[0] >> rs_) | ((vn_[1] >> rs_) << 16), (vn_[2] >> rs_) | ((vn_[3] >> rs_) << 16)}; }
        const char* nB = has_next ? (const char*)Btiles + (size_t)nxt.pn * tstep : cB;
        for (int t = 0; t < nt; t += 2) {
            const bool last = (t == nt - 2);
            const char* a1 = cA + (size_t)(t + 1) * kstep;
            const char* a2 = last ? cA : cA + (size_t)(t + 2) * kstep; const char* b2 = last ? nB : cB + (size_t)(t + 2) * kstep;
            const char* a3 = a2 + kstep; const char* b3 = b2 + kstep;
            PG8_LDB(B0, 0, 0); PG8_LDB(B1, 0, 1); PG8_SCHED; PG8_LDA(At, 0, 0); PG8_STAGE2(PG8_SA(1, 1), a1, voC[2], voC[3]);
            if (last && has_next) PG8_VON_LOAD(voC[0], voC[1], voC[2], voC[3]);
            PG8_WAIT_K(); PG8_WAIT_L(0); PG8_BAR; PG8_MMA(0, 0, At, B0); PG8_MMA(0, 1, At, B1); PG8_BAR; PG8_SCHED;
            PG8_LDA(At, 0, 1); PG8_STAGE(PG8_SB(0, 0), b2, voffB); PG8_STAGE(PG8_SB(0, 1), b2 + hstep, voffB); PG8_STAGE2(PG8_SA(0, 0), a2, voC[0], voC[1]);
            PG8_WAIT_K(); PG8_SIDE_SLOT(); PG8_WAIT_L(0); PG8_BAR; PG8_MMA(1, 0, At, B0); PG8_MMA(1, 1, At, B1); PG8_BAR; PG8_SCHED;
            PG8_LDB(B0, 1, 0); PG8_LDB(B1, 1, 1); PG8_SCHED; PG8_LDA(At, 1, 0); PG8_STAGE2(PG8_SA(0, 1), a2, voC[2], voC[3]);
            PG8_WAIT_K(); PG8_WAIT_L(0); PG8_BAR; PG8_MMA(0, 0, At, B0); PG8_MMA(0, 1, At, B1); PG8_BAR; PG8_SCHED;
            PG8_LDA(At, 1, 1); PG8_STAGE(PG8_SB(1, 0), b3, voffB); PG8_STAGE(PG8_SB(1, 1), b3 + hstep, voffB); PG8_STAGE2(PG8_SA(1, 0), a3, voC[0], voC[1]);
            PG8_WAIT_K(); if constexpr (Side::PAIR) { sext = 0; } else { PG8_SIDE_SLOT(); } PG8_WAIT_L(0); PG8_BAR; PG8_MMA(1, 0, At, B0); PG8_MMA(1, 1, At, B1); PG8_BAR; PG8_SCHED;
        }
        if (wr == 0) PG8_BAR;
        if constexpr (epi_f8<Epi>::v) asm volatile("s_nop 7\n\ts_nop 7\n\ts_nop 7\n\ts_nop 7");
        E(acc, cur, wr, wc, fr, fq); S.done(cur);
        if (!has_next) break;
#pragma unroll
        for (int a = 0; a < 2; ++a)
#pragma unroll
            for (int b = 0; b < 2; ++b)
#pragma unroll
                for (int m = 0; m < 4; ++m)
#pragma unroll
                    for (int n = 0; n < 2; ++n) acc[a][b][m][n] = (f32x4){0.f, 0.f, 0.f, 0.f};
        cur = nxt; cB = nB; ++ui;
        if (wr == 1) PG8_BAR;
    }
    PG8_WAIT_V(0);
    PG8_BAR;
    if constexpr (Side::ON) { if (spend) { PG8_SIDE_STORE(); } while (sstep < SD.nsteps) { PG8_SIDE_LOAD(); PG8_WAIT_V(0); PG8_SIDE_STORE(); } PG8_WAIT_V(0); }
#undef PG8_SA
#undef PG8_SB
#undef PG8_STAGE
#undef PG8_STAGE2
#undef PG8_DMA
#undef PG8_LDA
#undef PG8_LDB
#undef PG8_MMA
#undef PG8_WAIT_V
#undef PG8_WAIT_L
#undef PG8_BAR
#undef PG8_SCHED
#undef PG8_AROWS
#undef PG8_SIDE_LOAD
#undef PG8_VON_LOAD
#undef PG8_SGV
#undef PG8_SDV
#undef PG8_SIDE_STORE
#undef PG8_SIDE_SLOT
#undef PG8_WAIT_K
}
}

struct NoSide { static constexpr bool ON = false, PAIR = false; static constexpr int PERIOD = 1, LAG = 1; int ldb, first, stride, nsteps;
    __device__ __forceinline__ const float* src(int, int, int) const { return nullptr; } __device__ __forceinline__ bf16* dst(int, int, int) const { return nullptr; } };
template <int PER, int LG> struct SideGU { static constexpr bool ON = true, PAIR = false; static constexpr int PERIOD = PER, LAG = LG; const float* w; unsigned char* wt; int ldb, first, stride, nsteps;
    __device__ __forceinline__ const float* src(int hs, int kh, int nq) const { const int qq = hs & 3, st = hs >> 2, tile = st >> 4, kt = st & 15, e = tile >> 4, j = tile & 15;
        return w + (size_t)e * 2048 * 4096 + (size_t)(128 * kt) * 4096 + ((qq >> 1) ? 2048 : 0) + 128 * j + 64 * (qq & 1) + 8 * nq; }
    __device__ __forceinline__ unsigned char* dst(int hs, int kh, int nq) const { const int qq = hs & 3, st = hs >> 2, tile = st >> 4, kt = st & 15; return wt + ((size_t)tile * 256 + 64 * qq + 8 * nq) * 2048 + 128 * kt; } };
template <int PER, int LG> struct SideDown { static constexpr bool ON = true, PAIR = true  ; static constexpr int PERIOD = PER, LAG = LG; const float* w; unsigned char* wt; int ldb, first, stride, nsteps;
    __device__ __forceinline__ const float* src(int hs, int kh, int nq) const { const int qq = hs & 3, st = hs >> 2, tile = st >> 4, kt = st & 15, e = tile >> 3, j = tile & 7;
        return w + (size_t)e * 2048 * 2048 + (size_t)(128 * kt) * 2048 + 256 * j + 64 * qq + 8 * nq; }
    __device__ __forceinline__ unsigned char* dst(int hs, int kh, int nq) const { const int qq = hs & 3, st = hs >> 2, tile = st >> 4, kt = st & 15; return wt + ((size_t)tile * 256 + 64 * qq + 8 * nq) * 2048 + 128 * kt; } };

__device__ __forceinline__ void phase10(const Ctx& C) {
    unsigned char* ws = C.ws;
    const bf16* x1b = (const bf16*)(ws + (size_t)X1B_T0 * MiB); const bf16* ybuf = (const bf16*)(ws + WS_YBUF);
    const float* g2 = C.A.in[26]; const float* b2 = C.A.in[27]; const int lane = C.lane;
    for (int tok = C.gw; tok < T; tok += C.NGW) {
        f32x4 v[8]; float s = 0.f;
#pragma unroll
        for (int j = 0; j < 8; ++j) { const int c0 = (lane + 64 * j) * 4; const v2u xw = *(const v2u*)(x1b + (size_t)tok * D + c0); f32x4 a = (f32x4){bflo(xw.x), bfhi(xw.x), bflo(xw.y), bfhi(xw.y)} * DN_ALPHA;
#pragma unroll
            for (int k = 0; k < 4; ++k) { const v2u yw = *(const v2u*)(ybuf + ((size_t)tok * 4 + k) * D + c0); a = a + (f32x4){bflo(yw.x), bfhi(yw.x), bflo(yw.y), bfhi(yw.y)}; }
            v[j] = a; s += (a.x + a.y) + (a.z + a.w); }
        const float mean = wave_sum(s) * (1.0f / D); float q = 0.f;
#pragma unroll
        for (int j = 0; j < 8; ++j) { v[j] = v[j] - mean; q += (v[j].x * v[j].x + v[j].y * v[j].y) + (v[j].z * v[j].z + v[j].w * v[j].w); }
        const float rstd = 1.0f / sqrtf(wave_sum(q) * (1.0f / D) + LN_EPS);
#pragma unroll
        for (int j = 0; j < 8; ++j) { const int c0 = (lane + 64 * j) * 4; const f32x4 gg = *(const f32x4*)(g2 + c0), bb = *(const f32x4*)(b2 + c0);
            *(f32x4*)(C.out + (size_t)tok * D + c0) = v[j] * rstd * gg + bb; }
    }
}

__global__ void __launch_bounds__(NTHREADS, 2) fwd_kernel(KArgs args) {
    extern __shared__ __attribute__((aligned(16))) unsigned char lds_raw[];
    const int tid_ = threadIdx.x, wave_ = __builtin_amdgcn_readfirstlane(tid_ >> 6), G_ = gridDim.x;
    Ctx C{args, args.out, args.ws, (LAS unsigned char*)lds_raw, tid_, tid_ & 63, wave_, G_, (int)blockIdx.x * NWAVES + wave_, G_ * NWAVES};
    volatile LAS unsigned* MISC = (volatile LAS unsigned*)(C.lds + LDS_MISC);
    if (C.tid < 4) MISC[C.tid] = 0u;
    __syncthreads();
    unsigned* ctl = (unsigned*)(args.ws + WS_CTL);
    XcdBarrier bar; bar.bar = ctl + CW_BAR; bar.x = 0; bar.st = MISC;
    const int lo = args.ph_lo, hi = args.ph_hi;
    if (hi - lo > 1) bar = xcd_barrier_post(ctl + CW_BAR, MISC);
#ifdef PROBE_PHASE
    unsigned long long pt0_ = 0, pdt_ = 0;
#define PT_BEGIN(k) do { if ((k) == PROBE_PHASE) pt0_ = __builtin_amdgcn_s_memrealtime(); } while (0)
#define PT_END(k) do { if ((k) == PROBE_PHASE) pdt_ = __builtin_amdgcn_s_memrealtime() - pt0_; } while (0)
#else
#define PT_BEGIN(k)
#define PT_END(k)
#endif
#ifndef PHASE_MASK
#define PHASE_MASK 0x7ff
#endif
#define IN(k) (((PHASE_MASK >> (k)) & 1) && lo <= (k) && (k) < hi)
#define SEAM(k) do { if (IN(k) && IN((k) + 1)) xcd_barrier(bar); PT_END(k); PT_BEGIN((k) + 1); } while (0)
    const pg8::Gemm g{(const pg8::bf16_t*)args.ws, (const pg8::bf16_t*)args.ws, 0, 0, 2048};
    PG8_LAS unsigned char* glds = (PG8_LAS unsigned char*)lds_raw;

#ifndef PROBE_DOUBLE
#define PROBE_DOUBLE 0
#endif
#define REP(k) for (int _rep = 0; _rep < (((PROBE_DOUBLE >> (k)) & 1) ? 2 : 1); ++_rep)
    PT_BEGIN(0);
    if (IN(0)) { REP(0) phase0(C); } SEAM(0);
    if (IN(1)) {
        Gemm1Order S{C.G, (int)blockIdx.x};
        unsigned char* ws = args.ws;
        Epi1 E{C.A.in[2], (bf16*)(ws + WS_HYT), (bf16*)(ws + WS_QKRAW), (bf16*)(ws + WS_VB), (bf16*)(ws + WS_OB), (float*)(ws + WS_GATES)};
#if MOE_SIDE
        { SideGU<SIDE_GU_PERIOD, SIDE_GU_LAG> SD{C.A.in[22], PROBE_SIDE_DUMMY ? (unsigned char*)(ws + WS_YBUF) : (unsigned char*)(ws + (size_t)WGU_T0 * MiB), 4096, (int)blockIdx.x, C.G, SIDE_GU_EXPERTS * 16 * 32 * 2};
          pg8::gemm_phase_ga<Epi1, Gemm1Order, SideGU<SIDE_GU_PERIOD, SIDE_GU_LAG>>(glds, (const pg8::bf16_t*)ws, (const pg8::bf16_t*)ws, 2048, S, E, SD); }
#else
        REP(1) pg8::gemm_phase<Epi1, Gemm1Order, true, true>(glds, g, S, E);
#endif
        { const pg8::Gemm g2{(const pg8::bf16_t*)(ws + WS_W3P), (const pg8::bf16_t*)(ws + WS_H2P), 0, 0, 256}; KtOrder S2{C.G, (int)blockIdx.x}; EpiKT E2{(float*)(ws + WS_KT)};
          pg8::gemm_phase<EpiKT, KtOrder, true, true>(glds, g2, S2, E2); }
    } SEAM(1);
    if (IN(2)) { REP(2) phase2(C); } SEAM(2);
    if (IN(3)) { REP(3) hyena_fft(C); REP(11) { mlstm_mfma(C); } } SEAM(3);
    if (IN(4)) { REP(4) phase4(C); } SEAM(4);
    if (IN(5)) {
        TileOrder S{32, 8, (OUTPROJ_F8 ? 2 : 1) * YCAT_T0, (OUTPROJ_F8 ? 2 : 1) * WOUT_T0, C.G, (int)blockIdx.x};
        const pg8::Gemm g5{(const pg8::bf16_t*)args.ws, (const pg8::bf16_t*)args.ws, 0, 0, OUTPROJ_F8 ? 1024 : 2048};
        EpiOut E{C.A.in[0], C.A.in[17], (float*)(args.ws + WS_R1)};
        REP(5) pg8::gemm_phase<EpiOut, TileOrder, true, true>(glds, g5, S, E);
    } SEAM(5);
    if (IN(6)) { REP(6) phase6(C, _rep); } if (IN(6) && IN(8)) xcd_barrier(bar); PT_END(6); PT_BEGIN(8);
    if (IN(8)) {
        moe_build_tb(C);
        MoeOrder S{(const LAS int*)(C.lds + LDS_TB), 16, ABUF_T0, WGU_Q0, C.G, (int)blockIdx.x, (const int*)(args.ws + WS_LIST), 1, (const LAS int*)(C.lds + LDS_UL), (const LAS int*)(C.lds + LDS_ROWT)};
        S.setup(C.tid);
        EpiGU E{C.A.in[23], args.ws + (size_t)ACT_T0 * MiB, 1.0f / W8_SCALE};
#if MOE_SIDE
        { SideDown<SIDE_DN_PERIOD, SIDE_DN_LAG> SD{C.A.in[24], PROBE_SIDE_DUMMY ? (unsigned char*)(args.ws + WS_YBUF) : (unsigned char*)(args.ws + (size_t)WDN_T0 * MiB), 2048, (int)blockIdx.x, C.G, NE * 8 * 32 * 2};
          pg8::gemm_phase_ga<EpiGU, MoeOrder, SideDown<SIDE_DN_PERIOD, SIDE_DN_LAG>>(glds, (const pg8::bf16_t*)(args.ws + WS_X1Q), (const pg8::bf16_t*)args.ws, 1024, S, E, SD); }
#else
        { NoSide SD{0, 0, 0, 0}; REP(8) pg8::gemm_phase_ga<EpiGU, MoeOrder, NoSide>(glds, (const pg8::bf16_t*)(args.ws + WS_X1Q), (const pg8::bf16_t*)args.ws, 1024, S, E, SD); }
#endif
    } SEAM(8);
    if (IN(9)) {
        moe_build_tb(C);
        MoeOrder S{(const LAS int*)(C.lds + LDS_TB), 8, ACT_Q0, WDN_Q0, C.G, (int)blockIdx.x, (const int*)(args.ws + WS_LIST), 0, (const LAS int*)(C.lds + LDS_UL), (const LAS int*)(C.lds + LDS_ROWT)};
        S.setup(C.tid);
        EpiDown E{C.A.in[25], (const int*)(args.ws + WS_LIST), (const float*)(args.ws + WS_TOKW), (const LAS int*)(C.lds + LDS_TB), (bf16*)(args.ws + WS_YBUF), 1.0f / W8_SCALE};
        const pg8::Gemm g9{(const pg8::bf16_t*)args.ws, (const pg8::bf16_t*)args.ws, 0, 0, 1024};
        REP(9) pg8::gemm_phase<EpiDown, MoeOrder, true, true>(glds, g9, S, E);
    } SEAM(9);
    if (IN(10)) { REP(10) phase10(C); }
#ifdef PROBE_PHASE
    PT_END(10);
    if (blockIdx.x == 0 && C.wave == 0) { const unsigned long long te_ = __builtin_amdgcn_s_memrealtime(); while (__builtin_amdgcn_s_memrealtime() - te_ < 9ull * pdt_) __builtin_amdgcn_s_sleep(32); }
#endif
#ifdef PROBE_BARRIERS
    if (hi - lo > 1) for (int i_ = 0; i_ < PROBE_BARRIERS; ++i_) xcd_barrier(bar);
#endif
#undef IN
#undef SEAM
}

extern "C" void kernel_launch(void* const* d_in, const int* in_sizes, int n_in, void* d_out, int out_size, void* d_ws, size_t ws_size, hipStream_t stream) {
    static int grid = 0;
    if (grid == 0) {
        if (n_in != 28 || in_sizes[0] != T * D || out_size != T * D || ws_size < WS_END) { fprintf(stderr, "kernel_launch: unexpected shapes (n_in %d, in0 %d, out %d, ws %zu)\n", n_in, n_in > 0 ? in_sizes[0] : -1, out_size, ws_size); grid = -1; return; }
        int dev = 0, cus = 0;
        if (hipGetDevice(&dev) != hipSuccess || hipDeviceGetAttribute(&cus, hipDeviceAttributeMultiprocessorCount, dev) != hipSuccess) { grid = -1; return; }
        if (hipFuncSetAttribute((const void*)fwd_kernel, hipFuncAttributeMaxDynamicSharedMemorySize, LDS_BYTES) != hipSuccess) { fprintf(stderr, "kernel_launch: hipFuncSetAttribute failed\n"); grid = -1; return; }
        int per_cu = 0;
        if (hipOccupancyMaxActiveBlocksPerMultiprocessor(&per_cu, (const void*)fwd_kernel, NTHREADS, LDS_BYTES) != hipSuccess || per_cu < 1) fprintf(stderr, "kernel_launch: occupancy query says %d\n", per_cu);
        (void)hipGetLastError();
        grid = cus;
    }
    if (grid < 0) return;
    if (hipMemsetAsync((char*)d_ws + WS_CTL, 0, CTL_ZERO_BYTES, stream) != hipSuccess) return;
    KArgs a{};
    for (int i = 0; i < 28; ++i) a.in[i] = (const float*)d_in[i];
    a.out = (float*)d_out; a.ws = (unsigned char*)d_ws;
#if MK_ONE_LAUNCH
    a.ph_lo = 0; a.ph_hi = N_PHASES;
    hipLaunchKernelGGL(fwd_kernel, dim3(grid), dim3(NTHREADS), LDS_BYTES, stream, a);
#else
    for (int ph = 0; ph < N_PHASES; ++ph) { a.ph_lo = ph; a.ph_hi = ph + 1; hipLaunchKernelGGL(fwd_kernel, dim3(grid), dim3(NTHREADS), LDS_BYTES, stream, a); }
#endif
}
```

```cpp
#include <hip/hip_runtime.h>
#include <cstdio>
#include <cstdint>

namespace pg8 {
#define PG8_LAS __attribute__((address_space(3)))
typedef unsigned short bf16_t;
typedef short bf16x8 __attribute__((ext_vector_type(8)));
typedef float f32x4 __attribute__((ext_vector_type(4)));
typedef unsigned u32x4 __attribute__((ext_vector_type(4)));
constexpr int BM = 256, BK = 64, HALF = 128, HTB = HALF * BK * 2  , STAGE_BYTES = 8 * HTB, NXCD = 8, WGM = 8;

__host__ __device__ __forceinline__ int lds_byte(int r, int c) { const int st = (r >> 4) * 2 + (c >> 5), rr = r & 15, cc = c & 31, ob = rr * 64 + cc * 2; return st * 1024 + (ob ^ (((ob >> 9) & 1) << 5)); }
__host__ __device__ __forceinline__ void stage_rc(int b, int& R, int& C) { const int st = b / 1024, sb = b % 1024, swz = sb ^ (((sb >> 9) & 1) << 5); R = (st >> 1) * 16 + swz / 64; C = (st & 1) * 32 + (swz % 64) / 2; }
__host__ __device__ __forceinline__ int perm32(int rho) { const int n = rho >> 4, i = rho & 15; return 8 * (i >> 2) + 4 * n + (i & 3); }

struct Unit { int pm, pn; };
struct Gemm { const bf16_t* A; const bf16_t* Bt; int M, N, K; };
__device__ __forceinline__ unsigned cvt_pk_bf16(float lo, float hi) { unsigned r; asm volatile("v_cvt_pk_bf16_f32 %0, %1, %2" : "=v"(r) : "v"(lo), "v"(hi)); return r; }
typedef float f32x2 __attribute__((ext_vector_type(2)));
typedef int i32x4 __attribute__((ext_vector_type(4)));
typedef int i32x8 __attribute__((ext_vector_type(8)));
typedef long i64x2 __attribute__((ext_vector_type(2)));
template <class E, class = void> struct epi_f8 { static constexpr bool v = false; };
template <class E> struct epi_f8<E, decltype((void)E::F8)> { static constexpr bool v = E::F8; };
__device__ __forceinline__ i32x8 cat8(const bf16x8 a, const bf16x8 b) { const i32x4 x = __builtin_bit_cast(i32x4, a), y = __builtin_bit_cast(i32x4, b); return (i32x8){x.x, x.y, x.z, x.w, y.x, y.y, y.z, y.w}; }
template <class Epi, class Sched, bool ALIGN_EPI = false, bool SP2 = false>
__device__ __forceinline__ void gemm_phase(PG8_LAS unsigned char* lds, const Gemm g, const Sched& S, const Epi& E) {
    const int tid = threadIdx.x, wid = __builtin_amdgcn_readfirstlane(tid >> 6), lane = tid & 63, wr = wid >> 2, wc = wid & 3, fr = lane & 15, fq = lane >> 4;
    const int K = g.K, nt = K / BK;
    unsigned voffA[2], voffB[2];
#pragma unroll
    for (int i = 0; i < 2; ++i) { int R, C; stage_rc(tid * 16 + i * 8192, R, C); const int Rb = Epi::PERM ? ((R & ~31) + perm32(R & 31)) : R;
        voffA[i] = (unsigned)(R * K + C) * 2u; voffB[i] = (unsigned)(Rb * K + C) * 2u; }
    const size_t kstep = (size_t)(BK * 2);
    const size_t hstep = (size_t)HALF * K * 2;
    const size_t tstep = 2 * hstep;
    const unsigned ldsw = (unsigned)wid * 1024u;
    const int aoff = lds_byte(wr * 64 + fr, fq * 8), boff = lds_byte(wc * 32 + fr, fq * 8);
#define PG8_SA(b, h) (((b) * 2 + (h)) * HTB)
#define PG8_SB(b, h) ((4 + (b) * 2 + (h)) * HTB)
#define PG8_STAGE(bufoff, gbase, voff) do { _Pragma("unroll") for (int _i = 0; _i < 2; ++_i) \
        __builtin_amdgcn_global_load_lds((const unsigned*)((const char*)(gbase) + (voff)[_i]), (PG8_LAS unsigned*)(lds + (bufoff) + ldsw + _i * 8192), 16, 0, 0); } while (0)
#define PG8_LDA(dst, b, h) do { _Pragma("unroll") for (int m = 0; m < 4; ++m) _Pragma("unroll") for (int k = 0; k < 2; ++k) dst[m][k] = *(const PG8_LAS bf16x8*)(lds + PG8_SA(b, h) + aoff + m * 2048 + k * 1024); } while (0)
#define PG8_LDB(dst, b, h) do { _Pragma("unroll") for (int n = 0; n < 2; ++n) _Pragma("unroll") for (int k = 0; k < 2; ++k) dst[n][k] = *(const PG8_LAS bf16x8*)(lds + PG8_SB(b, h) + boff + n * 2048 + k * 1024); } while (0)
#define PG8_MMA(ai, bj, At, Bt) do { __builtin_amdgcn_s_setprio(1); if constexpr (epi_f8<Epi>::v) { _Pragma("unroll") for (int m = 0; m < 4; ++m) _Pragma("unroll") for (int n = 0; n < 2; ++n) \
        { const i32x8 b_ = cat8(Bt[n][0], Bt[n][1]), a_ = cat8(At[m][0], At[m][1]); \
        asm volatile("v_mfma_f32_16x16x128_f8f6f4 %0, %1, %2, %0" : "+v"(acc[ai][bj][m][n]) : "v"(b_), "v"(a_)); } } else { \
        _Pragma("unroll") for (int m = 0; m < 4; ++m) _Pragma("unroll") for (int n = 0; n < 2; ++n) _Pragma("unroll") for (int k = 0; k < 2; ++k) \
        acc[ai][bj][m][n] = __builtin_amdgcn_mfma_f32_16x16x32_bf16(Bt[n][k], At[m][k], acc[ai][bj][m][n], 0, 0, 0); } __builtin_amdgcn_s_setprio(0); } while (0)
#define PG8_WAIT_V(n) asm volatile("s_waitcnt vmcnt(" #n ")" ::: "memory")
#define PG8_WAIT_L(n) asm volatile("s_waitcnt lgkmcnt(" #n ")" ::: "memory")
#define PG8_BAR __builtin_amdgcn_s_barrier()
#define PG8_SCHED __builtin_amdgcn_sched_barrier(0)
    Unit cur, nxt; int ui = 0;
    if (!S.next(0, cur)) return;
    f32x4 acc[2][2][4][2];
#pragma unroll
    for (int a = 0; a < 2; ++a)
#pragma unroll
        for (int b = 0; b < 2; ++b)
#pragma unroll
            for (int m = 0; m < 4; ++m)
#pragma unroll
                for (int n = 0; n < 2; ++n) acc[a][b][m][n] = (f32x4){0.f, 0.f, 0.f, 0.f};
    bf16x8 At[4][2], B0[2][2], B1[2][2];
    const char* cA = (const char*)g.A + (size_t)cur.pm * tstep; const char* cB = (const char*)g.Bt + (size_t)cur.pn * tstep;
    S.a_ready(cur);
    if constexpr (SP2) {
        PG8_STAGE(PG8_SB(0, 0), cB, voffB); PG8_STAGE(PG8_SB(0, 1), cB + hstep, voffB); PG8_STAGE(PG8_SA(0, 0), cA, voffA); PG8_STAGE(PG8_SA(0, 1), cA + hstep, voffA);
        if (wr == 1) PG8_BAR;
        PG8_WAIT_V(2); PG8_BAR;
        PG8_STAGE(PG8_SB(1, 0), cB + kstep, voffB); PG8_STAGE(PG8_SA(1, 0), cA + kstep, voffA); PG8_STAGE(PG8_SB(1, 1), cB + hstep + kstep, voffB);
        PG8_WAIT_V(6); PG8_BAR;
    } else {
        PG8_STAGE(PG8_SB(0, 0), cB, voffB); PG8_STAGE(PG8_SA(0, 0), cA, voffA); PG8_STAGE(PG8_SB(0, 1), cB + hstep, voffB); PG8_STAGE(PG8_SA(0, 1), cA + hstep, voffA);
        if (wr == 1) PG8_BAR;
        PG8_WAIT_V(4); PG8_BAR;
        PG8_STAGE(PG8_SB(1, 0), cB + kstep, voffB); PG8_STAGE(PG8_SA(1, 0), cA + kstep, voffA); PG8_STAGE(PG8_SB(1, 1), cB + hstep + kstep, voffB);
        PG8_WAIT_V(6); PG8_BAR;
    }
    for (;;) {
        const bool has_next = S.next(ui + 1, nxt);
        const char* nA = has_next ? (const char*)g.A + (size_t)nxt.pm * tstep : cA; const char* nB = has_next ? (const char*)g.Bt + (size_t)nxt.pn * tstep : cB;
        for (int t = 0; t < nt; t += 2) {
            const bool last = (t == nt - 2);
            const char* a1 = cA + (size_t)(t + 1) * kstep;
            const char* a2 = last ? nA : cA + (size_t)(t + 2) * kstep; const char* b2 = last ? nB : cB + (size_t)(t + 2) * kstep;
            const char* a3 = a2 + kstep; const char* b3 = b2 + kstep;
            if (last && has_next) S.a_ready(nxt);
            if constexpr (SP2) {
            PG8_LDB(B0, 0, 0); PG8_LDB(B1, 0, 1); PG8_SCHED; PG8_LDA(At, 0, 0); PG8_STAGE(PG8_SA(1, 1), a1 + hstep, voffA);
            PG8_WAIT_V(8); PG8_WAIT_L(0); PG8_BAR; PG8_MMA(0, 0, At, B0); PG8_MMA(0, 1, At, B1); PG8_BAR; PG8_SCHED;
            PG8_LDA(At, 0, 1); PG8_STAGE(PG8_SB(0, 0), b2, voffB); PG8_STAGE(PG8_SB(0, 1), b2 + hstep, voffB); PG8_STAGE(PG8_SA(0, 0), a2, voffA);
            PG8_WAIT_V(8); PG8_WAIT_L(0); PG8_BAR; PG8_MMA(1, 0, At, B0); PG8_MMA(1, 1, At, B1); PG8_BAR; PG8_SCHED;
            PG8_LDB(B0, 1, 0); PG8_LDB(B1, 1, 1); PG8_SCHED; PG8_LDA(At, 1, 0); PG8_STAGE(PG8_SA(0, 1), a2 + hstep, voffA);
            PG8_WAIT_V(8); PG8_WAIT_L(0); PG8_BAR; PG8_MMA(0, 0, At, B0); PG8_MMA(0, 1, At, B1); PG8_BAR; PG8_SCHED;
            PG8_LDA(At, 1, 1); PG8_STAGE(PG8_SB(1, 0), b3, voffB); PG8_STAGE(PG8_SB(1, 1), b3 + hstep, voffB); PG8_STAGE(PG8_SA(1, 0), a3, voffA);
            PG8_WAIT_V(8); PG8_WAIT_L(0); PG8_BAR; PG8_MMA(1, 0, At, B0); PG8_MMA(1, 1, At, B1); PG8_BAR; PG8_SCHED;
            } else {
            PG8_LDB(B0, 0, 0); PG8_SCHED; PG8_LDA(At, 0, 0); PG8_STAGE(PG8_SA(1, 1), a1 + hstep, voffA);
            PG8_WAIT_L(8); PG8_BAR; PG8_WAIT_L(0); PG8_MMA(0, 0, At, B0); PG8_BAR; PG8_SCHED;
            PG8_LDB(B1, 0, 1); PG8_STAGE(PG8_SB(0, 0), b2, voffB);
            PG8_BAR; PG8_WAIT_L(0); PG8_MMA(0, 1, At, B1); PG8_BAR;
            PG8_LDA(At, 0, 1); PG8_STAGE(PG8_SA(0, 0), a2, voffA);
            PG8_BAR; PG8_WAIT_L(0); PG8_MMA(1, 0, At, B0); PG8_BAR; PG8_SCHED;
            PG8_STAGE(PG8_SB(0, 1), b2 + hstep, voffB);
            PG8_WAIT_V(6); PG8_BAR; PG8_MMA(1, 1, At, B1); PG8_BAR;
            PG8_LDB(B0, 1, 0); PG8_SCHED; PG8_LDA(At, 1, 0); PG8_STAGE(PG8_SA(0, 1), a2 + hstep, voffA);
            PG8_WAIT_L(8); PG8_BAR; PG8_WAIT_L(0); PG8_MMA(0, 0, At, B0); PG8_BAR; PG8_SCHED;
            PG8_LDB(B1, 1, 1); PG8_STAGE(PG8_SB(1, 0), b3, voffB);
            PG8_BAR; PG8_WAIT_L(0); PG8_MMA(0, 1, At, B1); PG8_BAR;
            PG8_LDA(At, 1, 1); PG8_STAGE(PG8_SA(1, 0), a3, voffA);
            PG8_BAR; PG8_WAIT_L(0); PG8_MMA(1, 0, At, B0); PG8_BAR; PG8_SCHED;
            PG8_STAGE(PG8_SB(1, 1), b3 + hstep, voffB);
            PG8_WAIT_V(6); PG8_BAR; PG8_MMA(1, 1, At, B1); PG8_BAR;
            }
        }
        if constexpr (ALIGN_EPI) { if (wr == 0) PG8_BAR; }
        if constexpr (epi_f8<Epi>::v) asm volatile("s_nop 7\n\ts_nop 7\n\ts_nop 7\n\ts_nop 7");
        if constexpr (!Epi::AFTER_DRAIN) { E(acc, cur, wr, wc, fr, fq); S.done(cur); }
        if (!has_next) break;
#pragma unroll
        for (int a = 0; a < 2; ++a)
#pragma unroll
            for (int b = 0; b < 2; ++b)
#pragma unroll
                for (int m = 0; m < 4; ++m)
#pragma unroll
                    for (int n = 0; n < 2; ++n) acc[a][b][m][n] = (f32x4){0.f, 0.f, 0.f, 0.f};
        cur = nxt; cA = nA; cB = nB; ++ui;
        if constexpr (ALIGN_EPI) { if (wr == 1) PG8_BAR; }
    }
    PG8_WAIT_V(0);
    if constexpr (!ALIGN_EPI) { if (wr == 0) PG8_BAR; }
    PG8_BAR;
    if constexpr (Epi::AFTER_DRAIN) { E.fused(acc, cur, wr, wc, fr, fq, lds, wid, lane); S.done(cur); }
#undef PG8_SA
#undef PG8_SB
#undef PG8_STAGE
#undef PG8_LDA
#undef PG8_LDB
#undef PG8_MMA
#undef PG8_WAIT_V
#undef PG8_WAIT_L
#undef PG8_BAR
#undef PG8_SCHED
}
}

constexpr int NB = 4, SEQ = 2048, T = NB * SEQ, D = 2048, DHY = 1024, DML = 1024, DIN = 7200, NE = 32, TOPK = 4, NH = 8, HD = 128, DFF = 2048;
constexpr float LN_EPS = 1e-5f, DN_ALPHA = 1.189207115002721f;
constexpr int NWAVES = 8, NTHREADS = 512;
#ifndef MK_ONE_LAUNCH
#define MK_ONE_LAUNCH 1
#endif
constexpr int N_PHASES = 11;
#ifndef MOE_PRECONVERT
#define MOE_PRECONVERT 1
#endif
#ifndef SIDE_GU_PERIOD
#define SIDE_GU_PERIOD 1
#define SIDE_GU_LAG 1
#endif
#ifndef SIDE_DN_PERIOD
#define SIDE_DN_PERIOD 2
#define SIDE_DN_LAG 2
#endif
#ifndef SIDE_GU_EXPERTS
#define SIDE_GU_EXPERTS 32
#endif
#ifndef OUTPROJ_F8
#define OUTPROJ_F8 1
#endif
#ifndef PROBE_SIDE_DUMMY
#define PROBE_SIDE_DUMMY 0
#endif
#ifndef MOE_SIDE
#define MOE_SIDE 1
#endif

constexpr size_t MiB = 1u << 20;
constexpr size_t WS_CTL = 0, CTL_ZERO_BYTES = 1 * MiB;
constexpr size_t WS_H2P = 1936 * MiB;
constexpr size_t WS_W3P = 1937 * MiB;
constexpr size_t WS_GATES = 2 * MiB;
constexpr size_t WS_TOKW = 3 * MiB;
constexpr size_t WS_LIST = 4 * MiB;
constexpr size_t WS_ROWSLOT = 5 * MiB;
constexpr size_t WS_ROWW = 5 * MiB + 512 * 1024;
constexpr size_t WS_GA = 6 * MiB, WS_GP = 6 * MiB + 512 * 1024, WS_GE = 7 * MiB;
constexpr size_t TILE_BYTES = 256 * 2048 * 2;
constexpr int XB_T0 = 8, WIN_T0 = 40, WOUT_T0 = 72, YCAT_T0 = 80, X1B_T0 = 112, ABUF_T0 = 144, ACT_T0 = 304, WGU_T0 = 464, WDN_T0 = 976;
constexpr size_t WS_HYT = 1232 * MiB;
constexpr size_t WS_QKRAW = 1296 * MiB;
constexpr size_t WS_OB = 1328 * MiB;
constexpr size_t WS_QKC = 1344 * MiB;
constexpr size_t WS_KT = 1376 * MiB;
constexpr size_t WS_KF = 1840 * MiB;
constexpr size_t WS_ZT = 1904 * MiB;
constexpr size_t WS_Z = 1408 * MiB;
constexpr size_t WS_HML = 1440 * MiB;
constexpr size_t WS_R1 = 1504 * MiB;
constexpr int WGU_Q0 = 2 * WGU_T0, WDN_Q0 = 2 * WDN_T0, ACT_Q0 = 2 * ACT_T0;
constexpr size_t WS_X1Q = (size_t)ABUF_T0 * MiB;
constexpr float Y8_SCALE = 16.0f;
constexpr float W8_SCALE = 256.0f;
constexpr size_t WS_YBUF = 1568 * MiB;
constexpr size_t WS_VB = 1824 * MiB;
constexpr size_t WS_END = 1940 * MiB;
constexpr int CW_BAR = 4096, CW_CNT = 16384;

constexpr int LDS_STAGE = 131072, LDS_MISC = LDS_STAGE, LDS_TB = LDS_STAGE + 64, LDS_UL = LDS_STAGE + 512, LDS_ROWT = LDS_STAGE + 1024, MOE_MAXU = 10, LDS_VON = 143360  , LDS_BYTES = 147456;
static_assert(LDS_ROWT + MOE_MAXU * 256 * 4 <= LDS_VON && LDS_VON + 512 * 8 <= LDS_BYTES && LDS_BYTES <= 163840, "LDS map");

#define GAS __attribute__((address_space(1)))
#define LAS __attribute__((address_space(3)))
typedef unsigned short bf16;
typedef unsigned v4u __attribute__((ext_vector_type(4)));
typedef unsigned v2u __attribute__((ext_vector_type(2)));
typedef float f32x4 __attribute__((ext_vector_type(4)));
typedef float f32x2 __attribute__((ext_vector_type(2)));
#define LDS_WAIT() asm volatile("s_waitcnt lgkmcnt(0)" ::: "memory")
__device__ __forceinline__ unsigned f2bf(float f) { unsigned u = __builtin_bit_cast(unsigned, f); return (u + 0x7fffu + ((u >> 16) & 1u)) >> 16; }
__device__ __forceinline__ unsigned pk2(float lo, float hi) { return f2bf(lo) | (f2bf(hi) << 16); }
__device__ __forceinline__ unsigned pk4_fp8(float a, float b, float c, float d) { unsigned w = 0u; w = __builtin_amdgcn_cvt_pk_fp8_f32(a, b, w, false); w = __builtin_amdgcn_cvt_pk_fp8_f32(c, d, w, true); return w; }
__device__ __forceinline__ float bflo(unsigned w) { return __builtin_bit_cast(float, w << 16); }
__device__ __forceinline__ float bfhi(unsigned w) { return __builtin_bit_cast(float, w & 0xffff0000u); }
__device__ __forceinline__ float bf2f(bf16 b) { return __builtin_bit_cast(float, (unsigned)b << 16); }
__device__ __forceinline__ float wave_sum(float v) {
#pragma unroll
    for (int o = 1; o < 64; o <<= 1) v += __shfl_xor(v, o);
    return v;
}
__device__ __forceinline__ float wave_max(float v) {
#pragma unroll
    for (int o = 1; o < 64; o <<= 1) v = fmaxf(v, __shfl_xor(v, o));
    return v;
}

#define XB_TMO      128
#define XB_XCNT(j)  (256  + 64 * (j))
#define XB_XSUB(j)  (1280 + 64 * (j))
#define XB_XGEN(j)  (2304 + 64 * (j))
#define XB_TOP      3328
#define XB_TOPGEN   3392
#define XCD_BAR_WORDS 3456
#define XB_SPIN_CAP (1u << 22)

__device__ __forceinline__ unsigned xb_ld(unsigned* p)              { return __hip_atomic_load(p, __ATOMIC_RELAXED, __HIP_MEMORY_SCOPE_AGENT); }
__device__ __forceinline__ unsigned xb_add(unsigned* p, unsigned v) { return __hip_atomic_fetch_add(p, v, __ATOMIC_RELAXED, __HIP_MEMORY_SCOPE_AGENT); }
__device__ __forceinline__ unsigned xb_xcc_id() { return (unsigned)__builtin_amdgcn_s_getreg((3 << 11) | 20) & 0xFu; }
#define XB_SPIN(cond, bar) do { unsigned _sp = 0; while (cond) { __builtin_amdgcn_s_sleep(1); \
    if ((++_sp & 255u) == 0u) { if (xb_ld(&(bar)[XB_TMO])) break; if (_sp > XB_SPIN_CAP) { atomicAdd(&(bar)[XB_TMO], 1u); break; } } } } while (0)

struct XcdBarrier {
    unsigned* bar; unsigned x;
    volatile LAS unsigned* st;
};

__device__ __forceinline__ XcdBarrier xcd_barrier_post(unsigned* bar, volatile LAS unsigned* st) {
    XcdBarrier b; b.bar = bar; b.x = xb_xcc_id(); b.st = st;
    if (threadIdx.x == 0) (void)xb_add(&bar[XB_XCNT(b.x)], 1u);
    return b;
}
__device__ __forceinline__ void xcd_barrier_complete(unsigned* bar, unsigned x, unsigned& nloc, unsigned& nx) {
    const unsigned G = gridDim.x * gridDim.y * gridDim.z;
    unsigned sum, cnt, mine, sp = 0u;
    for (;;) {
        sum = 0u; cnt = 0u; mine = 0u;
#pragma unroll
        for (unsigned j = 0; j < 16; ++j) { const unsigned c = xb_ld(&bar[XB_XCNT(j)]); sum += c; cnt += (c > 0u) ? 1u : 0u; mine = (j == x) ? c : mine; }
        if (sum == G) break;
        __builtin_amdgcn_s_sleep(1);
        if ((++sp & 255u) == 0u) { if (xb_ld(&bar[XB_TMO])) break; if (sp > XB_SPIN_CAP) { atomicAdd(&bar[XB_TMO], 1u); break; } }
    }
    nloc = mine > 0u ? mine : 1u; nx = cnt > 0u ? cnt : 1u;
}

__device__ __forceinline__ void xcd_barrier(const XcdBarrier& b) {
    asm volatile("s_waitcnt vmcnt(0)" ::: "memory");
    __syncthreads();
    if (threadIdx.x == 0) {
        unsigned* bar = b.bar;
        __builtin_amdgcn_s_waitcnt(0);
        unsigned nloc = b.st[0], nx = b.st[1];
        if (nloc == 0u) { xcd_barrier_complete(bar, b.x, nloc, nx); b.st[0] = nloc; b.st[1] = nx; }
        const unsigned old = xb_add(&bar[XB_XSUB(b.x)], 1u);
        const unsigned gen = old / nloc;
        if (old + 1u == (gen + 1u) * nloc) {
            __builtin_amdgcn_fence(__ATOMIC_RELEASE, "agent");
            asm volatile("s_waitcnt vmcnt(0)" ::: "memory");
            const unsigned og = xb_add(&bar[XB_TOP], 1u);
            const unsigned tg = og / nx;
            if (og + 1u == (tg + 1u) * nx) xb_add(&bar[XB_TOPGEN], 1u);
            else XB_SPIN(xb_ld(&bar[XB_TOPGEN]) == tg, bar);
            __builtin_amdgcn_fence(__ATOMIC_ACQUIRE, "agent");
            xb_add(&bar[XB_XGEN(b.x)], 1u);
            asm volatile("s_waitcnt vmcnt(0)" ::: "memory");
        } else {
            XB_SPIN(xb_ld(&bar[XB_XGEN(b.x)]) == gen, bar);
            __builtin_amdgcn_fence(__ATOMIC_ACQUIRE, "agent");
            asm volatile("s_waitcnt vmcnt(0)" ::: "memory");
        }
    }
    __syncthreads();
}


#ifndef FFT_HD
#define FFT_HD __device__ __forceinline__
#define FFT_LDS LAS
#endif
constexpr int FFT_WORDS = 4096 + 1024 + 256;
FFT_HD int fidx(int i) { return i + 4 * (i >> 4) + 16 * (i >> 8); }

template <bool INV> FFT_HD void dft4(float& ar, float& ai, float& br, float& bi, float& cr, float& ci, float& dr, float& di) {
    const float s0r = ar + cr, s0i = ai + ci, s1r = ar - cr, s1i = ai - ci;
    const float s2r = br + dr, s2i = bi + di, s3r = br - dr, s3i = bi - di;
    ar = s0r + s2r; ai = s0i + s2i;
    cr = s0r - s2r; ci = s0i - s2i;
    if (!INV) { br = s1r + s3i; bi = s1i - s3r; dr = s1r - s3i; di = s1i + s3r; }
    else      { br = s1r - s3i; bi = s1i + s3r; dr = s1r + s3i; di = s1i - s3r; }
}
template <bool INV> FFT_HD void dft16(float (&xr)[16], float (&xi)[16]) {
#pragma unroll
    for (int n0 = 0; n0 < 4; ++n0) dft4<INV>(xr[n0], xi[n0], xr[n0 + 4], xi[n0 + 4], xr[n0 + 8], xi[n0 + 8], xr[n0 + 12], xi[n0 + 12]);
    constexpr float C1 = 0.9238795325112867f, S1 = 0.3826834323650898f, C2 = 0.7071067811865476f;
    const float tc[10] = {1.f, C1, C2, S1, 0.f, -S1, -C2, -C1, -1.f, -C1};
    const float ts[10] = {0.f, S1, C2, C1, 1.f, C1, C2, S1, 0.f, -S1};
#pragma unroll
    for (int n0 = 1; n0 < 4; ++n0)
#pragma unroll
        for (int k0 = 1; k0 < 4; ++k0) { const int m = n0 * k0; const float wr = tc[m], wi = INV ? ts[m] : -ts[m];
            const int id = n0 + 4 * k0; const float r = xr[id] * wr - xi[id] * wi, i = xr[id] * wi + xi[id] * wr; xr[id] = r; xi[id] = i; }
#pragma unroll
    for (int k0 = 0; k0 < 4; ++k0) dft4<INV>(xr[4 * k0], xi[4 * k0], xr[4 * k0 + 1], xi[4 * k0 + 1], xr[4 * k0 + 2], xi[4 * k0 + 2], xr[4 * k0 + 3], xi[4 * k0 + 3]);
#pragma unroll
    for (int a = 0; a < 4; ++a)
#pragma unroll
        for (int b = a + 1; b < 4; ++b) { float t = xr[4 * a + b]; xr[4 * a + b] = xr[4 * b + a]; xr[4 * b + a] = t; t = xi[4 * a + b]; xi[4 * a + b] = xi[4 * b + a]; xi[4 * b + a] = t; }
}
template <bool INV> FFT_HD void twiddle16(float (&xr)[16], float (&xi)[16], int j, int n) {
    float s, c;
#ifdef __HIP_DEVICE_COMPILE__
    asm volatile("" : "+v"(j));
    sincospif(2.0f * (float)j / (float)n, &s, &c);
#else
    s = (float)sin(2.0 * 3.14159265358979323846 * j / n); c = (float)cos(2.0 * 3.14159265358979323846 * j / n);
#endif
    const float wr = c, wi = INV ? s : -s;
    float pr = wr, pi = wi;
#pragma unroll
    for (int k = 1; k < 16; ++k) {
        const float r = xr[k] * pr - xi[k] * pi, i = xr[k] * pi + xi[k] * pr; xr[k] = r; xi[k] = i;
        const float nr = pr * wr - pi * wi, ni = pr * wi + pi * wr; pr = nr; pi = ni;
    }
}
FFT_HD void fft_store_s256(FFT_LDS float* re, FFT_LDS float* im, int g, const float (&xr)[16], const float (&xi)[16]) {
    const int a0 = fidx(g);
#pragma unroll
    for (int k = 0; k < 16; ++k) { re[a0 + 336 * k] = xr[k]; im[a0 + 336 * k] = xi[k]; }
}
FFT_HD void fft_load_s256(const FFT_LDS float* re, const FFT_LDS float* im, int g, float (&xr)[16], float (&xi)[16]) {
    const int a0 = fidx(g);
#pragma unroll
    for (int k = 0; k < 16; ++k) { xr[k] = re[a0 + 336 * k]; xi[k] = im[a0 + 336 * k]; }
}
FFT_HD void fft_load_s16(const FFT_LDS float* re, const FFT_LDS float* im, int g, float (&xr)[16], float (&xi)[16]) {
    const int a0 = fidx((g >> 4) * 256 + (g & 15));
#pragma unroll
    for (int k = 0; k < 16; ++k) { xr[k] = re[a0 + 20 * k]; xi[k] = im[a0 + 20 * k]; }
}
FFT_HD void fft_store_s16(FFT_LDS float* re, FFT_LDS float* im, int g, const float (&xr)[16], const float (&xi)[16]) {
    const int a0 = fidx((g >> 4) * 256 + (g & 15));
#pragma unroll
    for (int k = 0; k < 16; ++k) { re[a0 + 20 * k] = xr[k]; im[a0 + 20 * k] = xi[k]; }
}
FFT_HD void fft_load_s1(const FFT_LDS float* re, const FFT_LDS float* im, int g, float (&xr)[16], float (&xi)[16]) {
    const int a = fidx(g * 16);
#pragma unroll
    for (int k = 0; k < 16; ++k) { xr[k] = re[a + k]; xi[k] = im[a + k]; }
}
FFT_HD void fft_store_s1(FFT_LDS float* re, FFT_LDS float* im, int g, const float (&xr)[16], const float (&xi)[16]) {
    const int a = fidx(g * 16);
#pragma unroll
    for (int k = 0; k < 16; ++k) { re[a + k] = xr[k]; im[a + k] = xi[k]; }
}


struct KArgs { const float* in[28]; float* out; unsigned char* ws; int ph_lo, ph_hi; };
struct Ctx {
    const KArgs& A; float* out; unsigned char* ws; LAS unsigned char* lds;
    int tid, lane, wave, G, gw, NGW;
};

__device__ __forceinline__ void transpose_item(const float* __restrict__ W, int N, int k0, int n0, bf16* __restrict__ dst, LAS float* scr, int lane) {
#pragma unroll 8
    for (int i = 0; i < 32; ++i) { const int kk = 2 * i + (lane >> 5); scr[kk * 33 + (lane & 31)] = W[(size_t)(k0 + kk) * N + n0 + (lane & 31)]; }
    LDS_WAIT(); asm volatile("" ::: "memory");
    const int c = lane & 7;
#pragma unroll
    for (int j = 0; j < 4; ++j) { const int n = (lane >> 3) + 8 * j; const LAS float* s = scr + (8 * c) * 33 + n;
        v4u o; o.x = pk2(s[0 * 33], s[1 * 33]); o.y = pk2(s[2 * 33], s[3 * 33]); o.z = pk2(s[4 * 33], s[5 * 33]); o.w = pk2(s[6 * 33], s[7 * 33]);
        *(v4u*)(dst + (size_t)n * 2048 + k0 + 8 * c) = o; }
    LDS_WAIT(); asm volatile("" ::: "memory");
}

__device__ __forceinline__ void transpose_item8(const float* __restrict__ W, int N, int k0, int n0, unsigned char* __restrict__ dst, LAS float* scr, int lane) {
#pragma unroll 8
    for (int i = 0; i < 32; ++i) { const int kk = 2 * i + (lane >> 5); scr[kk * 33 + (lane & 31)] = W[(size_t)(k0 + kk) * N + n0 + (lane & 31)]; }
    LDS_WAIT(); asm volatile("" ::: "memory");
    const int c = lane & 3;
#pragma unroll
    for (int j = 0; j < 2; ++j) { const int n = (lane >> 2) + 16 * j; const LAS float* q = scr + (16 * c) * 33 + n;
        v4u o; o.x = pk4_fp8(q[0 * 33] * W8_SCALE, q[1 * 33] * W8_SCALE, q[2 * 33] * W8_SCALE, q[3 * 33] * W8_SCALE); o.y = pk4_fp8(q[4 * 33] * W8_SCALE, q[5 * 33] * W8_SCALE, q[6 * 33] * W8_SCALE, q[7 * 33] * W8_SCALE);
        o.z = pk4_fp8(q[8 * 33] * W8_SCALE, q[9 * 33] * W8_SCALE, q[10 * 33] * W8_SCALE, q[11 * 33] * W8_SCALE); o.w = pk4_fp8(q[12 * 33] * W8_SCALE, q[13 * 33] * W8_SCALE, q[14 * 33] * W8_SCALE, q[15 * 33] * W8_SCALE);
        *(v4u*)(dst + (size_t)n * 2048 + k0 + 16 * c) = o; }
    LDS_WAIT(); asm volatile("" ::: "memory");
}

__device__ __forceinline__ void phase0(const Ctx& C) {
    unsigned char* ws = C.ws;
    {
        const f32x4* x4 = (const f32x4*)C.A.in[0]; v4u* xb = (v4u*)(ws + (size_t)XB_T0 * MiB);
        const size_t n8 = (size_t)T * D / 8;
        for (size_t i = (size_t)blockIdx.x * NTHREADS + C.tid; i < n8; i += (size_t)C.G * NTHREADS) {
            const f32x4 a = x4[2 * i], b = x4[2 * i + 1]; v4u o; o.x = pk2(a.x, a.y); o.y = pk2(a.z, a.w); o.z = pk2(b.x, b.y); o.w = pk2(b.z, b.w); xb[i] = o; }
    }
    {
        LAS float* scr = (LAS float*)(C.lds + C.wave * 8448);
        constexpr int I_IN = 32 * 225, I_OUT = 32 * 64, E_GU0 = (MOE_SIDE && !PROBE_SIDE_DUMMY) ? SIDE_GU_EXPERTS : 0, I_GU = MOE_PRECONVERT ? (NE - E_GU0) * 32 * 128 : 0, I_DN = (MOE_PRECONVERT && (!MOE_SIDE || PROBE_SIDE_DUMMY)) ? NE * 32 * 64 : 0, NITEMS = I_IN + I_OUT + I_GU + I_DN;
        bf16* win_t = (bf16*)(ws + (size_t)WIN_T0 * MiB); bf16* wout_t = (bf16*)(ws + (size_t)WOUT_T0 * MiB);
        bf16* wgu_t = (bf16*)(ws + (size_t)WGU_T0 * MiB); bf16* wdn_t = (bf16*)(ws + (size_t)WDN_T0 * MiB);
        for (int it = C.gw; it < NITEMS; it += C.NGW) {
            int r = it;
            if (r < I_IN) { const int kb = r / 225, nb = r % 225; transpose_item(C.A.in[1], DIN, 64 * kb, 32 * nb, win_t + (size_t)(32 * nb) * 2048, scr, C.lane); continue; } r -= I_IN;
#if OUTPROJ_F8
            if (r < I_OUT) { const int kb = r / 64, nb = r % 64; transpose_item8(C.A.in[16], D, 64 * kb, 32 * nb, (unsigned char*)wout_t + (size_t)(32 * nb) * 2048, scr, C.lane); continue; } r -= I_OUT;
#else
            if (r < I_OUT) { const int kb = r / 64, nb = r % 64; transpose_item(C.A.in[16], D, 64 * kb, 32 * nb, wout_t + (size_t)(32 * nb) * 2048, scr, C.lane); continue; } r -= I_OUT;
#endif
            if (r < I_GU) { const int e = E_GU0 + r / 4096, rr = r % 4096, kb = rr / 128, nb = rr % 128, n0 = 32 * nb;
                const int drow = (n0 < 2048) ? ((n0 >> 7) * 256 + (n0 & 127)) : ((((n0 - 2048) >> 7) * 256) + 128 + ((n0 - 2048) & 127));
                transpose_item(C.A.in[22] + (size_t)e * 2048 * 4096, 4096, 64 * kb, n0, wgu_t + ((size_t)e * 4096 + drow) * 2048, scr, C.lane);
                continue; } r -= I_GU;
            { const int e = r / 2048, rr = r % 2048, kb = rr / 64, nb = rr % 64;
                transpose_item(C.A.in[24] + (size_t)e * 2048 * 2048, 2048, 64 * kb, 32 * nb, wdn_t + ((size_t)e * 2048 + 32 * nb) * 2048, scr, C.lane); }
        }
    }
    __syncthreads();
    {
        const float* w1 = C.A.in[5]; const float* b1 = C.A.in[6]; const float* w2 = C.A.in[7]; const float* b2 = C.A.in[8]; const float* freq = C.A.in[10];
        LAS float* h1s = (LAS float*)C.lds;
        const int tt = C.tid >> 6, j = C.tid & 63;
        for (int tb = blockIdx.x; tb < SEQ / 8; tb += C.G) {
            const int t = tb * 8 + tt;
            const float zt = (float)t / 2047.0f, wt = 6.283185307179586f * (float)t / 2048.0f;
            float acc = b1[j] + zt * w1[j];
            for (int i = 0; i < 16; ++i) { const float fb = 1e-4f + (float)i * ((15.0f - 1e-4f) / 15.0f); float sn, cs; sincospif(fb * (float)t * (1.0f / 1024.0f), &sn, &cs);
                acc += cs * w1[(1 + i) * 64 + j] - sn * w1[(17 + i) * 64 + j]; }
            h1s[tt * 64 + j] = sinf(freq[j] * acc);
            __syncthreads();
            float a2 = b2[j];
            for (int i = 0; i < 64; ++i) a2 += h1s[tt * 64 + i] * w2[i * 64 + j];
            { const float hv = sinf(freq[64 + j] * a2); const unsigned hi = f2bf(hv); const float lo = hv - bflo(hi);
              bf16* hp = (bf16*)(ws + WS_H2P) + (size_t)t * 256; hp[j] = (bf16)hi; hp[64 + j] = (bf16)hi; hp[128 + j] = (bf16)f2bf(lo); hp[192 + j] = 0; }
            __syncthreads();
        }
        const float* w3 = C.A.in[9]; bf16* wp = (bf16*)(ws + WS_W3P);
        for (int i = blockIdx.x * NTHREADS + C.tid; i < 4096 * 8; i += C.G * NTHREADS) {
            const int col = i & 4095, jo = i >> 12; float wv[8]; unsigned hi[8], lo[8];
#pragma unroll
            for (int k = 0; k < 8; ++k) { wv[k] = w3[(size_t)(jo * 8 + k) * 4096 + col]; hi[k] = f2bf(wv[k]); lo[k] = f2bf(wv[k] - bflo(hi[k])); }
            v4u vh, vl; vh.x = hi[0] | (hi[1] << 16); vh.y = hi[2] | (hi[3] << 16); vh.z = hi[4] | (hi[5] << 16); vh.w = hi[6] | (hi[7] << 16);
            vl.x = lo[0] | (lo[1] << 16); vl.y = lo[2] | (lo[3] << 16); vl.z = lo[4] | (lo[5] << 16); vl.w = lo[6] | (lo[7] << 16);
            bf16* row = wp + (size_t)col * 256 + jo * 8;
            *(v4u*)row = vh; *(v4u*)(row + 64) = vl; *(v4u*)(row + 128) = vh; *(v4u*)(row + 192) = (v4u){0u, 0u, 0u, 0u};
        }
    }
}

constexpr int N1_SW_TILES = 16, N1_SW = N1_SW_TILES * 32;
constexpr int N1_NORM_TILES = 13, N1_NORM = N1_NORM_TILES * 32, N1_UNITS = N1_SW + N1_NORM;
struct Gemm1Order {
    int G, c;
    __device__ __forceinline__ int a_row(const pg8::Unit& u, int, int r) const { return u.pm * 256 + r; }
    __device__ __forceinline__ bool next(int i, pg8::Unit& u) const {
        const int L = i * G + c; if (L >= N1_UNITS) return false;
        int w; { const int q = N1_UNITS / 8, r = N1_UNITS % 8, xcd = L % 8, off = L / 8; w = (xcd < r ? xcd * (q + 1) : r * (q + 1) + (xcd - r) * q) + off; }
        if (w < N1_SW) { const int nig = 8 * 32, gid = w / nig, wi = w % nig, mi = gid * 8 + (wi % 8), ni = wi / 8;
            u.pm = WIN_T0 + (mi < 12 ? mi : 8 + mi); u.pn = XB_T0 + ni; }
        else { w -= N1_SW; const int nig = 8 * N1_NORM_TILES, gid = w / nig, wi = w % nig, mi = gid * 8 + (wi % 8), ni = wi / 8;
            int wt;
            wt = (ni < 8) ? 12 + ni : 16 + ni;
            u.pm = XB_T0 + mi; u.pn = WIN_T0 + wt; }
        return true;
    }
    __device__ __forceinline__ void a_ready(const pg8::Unit&) const {}
    __device__ __forceinline__ void done(const pg8::Unit&) const {}
};
struct Epi1 {
    static constexpr bool PERM = true, AFTER_DRAIN = false;
    const float* b_in; bf16* hyt; bf16* qkraw; bf16* vb; bf16* ob; float* gates;
    __device__ __forceinline__ void operator()(const pg8::f32x4 (&acc)[2][2][4][2], const pg8::Unit& u, int wr, int wc, int fr_, int fq_) const {
        int ln_ = threadIdx.x & 63; asm volatile("" : "+v"(ln_));
        const int fr = ln_ & 15, fq = ln_ >> 4;
        using pg8::cvt_pk_bf16;
        if (u.pm >= WIN_T0) {
            const int wt = u.pm - WIN_T0, tt = u.pn - XB_T0;
            const int col0 = tt * 256 + wc * 32 + 8 * fq;
            float bv8[2][4];
#pragma unroll
            for (int ai = 0; ai < 2; ++ai)
#pragma unroll
                for (int m = 0; m < 4; ++m) bv8[ai][m] = b_in[wt * 256 + ai * 128 + wr * 64 + m * 16 + fr];
#pragma unroll
            for (int ai = 0; ai < 2; ++ai)
#pragma unroll
                for (int m = 0; m < 4; ++m) {
                    const int ch = wt * 256 + ai * 128 + wr * 64 + m * 16 + fr; const float bv = bv8[ai][m];
                    const int drow = ch < 3072 ? ch : ch - 2048;
                    bf16* rowp = hyt + (size_t)drow * T + col0;
#pragma unroll
                    for (int bj = 0; bj < 2; ++bj) { const pg8::f32x4 v0 = acc[ai][bj][m][0] + bv, v1 = acc[ai][bj][m][1] + bv;
                        v4u w; w.x = cvt_pk_bf16(v0[0], v0[1]); w.y = cvt_pk_bf16(v0[2], v0[3]); w.z = cvt_pk_bf16(v1[0], v1[1]); w.w = cvt_pk_bf16(v1[2], v1[3]);
                        *(v4u*)(rowp + bj * 128) = w; }
                }
        } else {
            const int tt = u.pm - XB_T0, wt = u.pn - WIN_T0;
            const int chb = wt * 256 + wc * 32 + 8 * fq;
            pg8::f32x4 bv[2][2];
#pragma unroll
            for (int bj = 0; bj < 2; ++bj)
#pragma unroll
                for (int n = 0; n < 2; ++n) { const int c0 = chb + bj * 128 + 4 * n; bv[bj][n] = (c0 < DIN) ? *(const pg8::f32x4*)(b_in + c0) : (pg8::f32x4){0.f, 0.f, 0.f, 0.f}; }
            if (wt == 28) {
                if (wc == 0) {
#pragma unroll
                    for (int ai = 0; ai < 2; ++ai)
#pragma unroll
                        for (int m = 0; m < 4; ++m) { const int tok = tt * 256 + ai * 128 + wr * 64 + m * 16 + fr;
                            float* gp = gates + (size_t)tok * 32 + 8 * fq;
                            *(pg8::f32x4*)(gp) = acc[ai][0][m][0] + bv[0][0]; *(pg8::f32x4*)(gp + 4) = acc[ai][0][m][1] + bv[0][1]; }
                }
            } else {
#define EPI1_STORE(base, ld, cb) do { _Pragma("unroll") for (int ai = 0; ai < 2; ++ai) _Pragma("unroll") for (int m = 0; m < 4; ++m) { const int tok = tt * 256 + ai * 128 + wr * 64 + m * 16 + fr; \
                    bf16* rowp = (base) + (size_t)tok * (ld) + (cb); \
                    _Pragma("unroll") for (int bj = 0; bj < 2; ++bj) { const pg8::f32x4 v0 = acc[ai][bj][m][0] + bv[bj][0], v1 = acc[ai][bj][m][1] + bv[bj][1]; \
                        v4u w; w.x = cvt_pk_bf16(v0[0], v0[1]); w.y = cvt_pk_bf16(v0[2], v0[3]); w.z = cvt_pk_bf16(v1[0], v1[1]); w.w = cvt_pk_bf16(v1[2], v1[3]); \
                        *(v4u*)(rowp + bj * 128) = w; } } } while (0)
                if (wt < 20) EPI1_STORE(qkraw, 2048, chb - 3072);
                else if (wt < 24) EPI1_STORE(vb, 1024, chb - 5120);
                else EPI1_STORE(ob, 1024, chb - 6144);
#undef EPI1_STORE
            }
        }
    }
};

struct KtOrder {
    int G, c;
    __device__ __forceinline__ bool next(int i, pg8::Unit& u) const { const int cc = G - 1 - c; if (i != 0 || cc >= 128) return false; u.pm = cc >> 3; u.pn = cc & 7; return true; }
    __device__ __forceinline__ void a_ready(const pg8::Unit&) const {}
    __device__ __forceinline__ void done(const pg8::Unit&) const {}
};
struct EpiKT {
    static constexpr bool PERM = true, AFTER_DRAIN = false;
    float* kt;
    __device__ __forceinline__ void operator()(const pg8::f32x4 (&acc)[2][2][4][2], const pg8::Unit& u, int wr, int wc, int fr, int fq) const {
        const float da = -3.0701134573253945f, db = -15.350567286626973f;
#pragma unroll
        for (int ai = 0; ai < 2; ++ai)
#pragma unroll
            for (int m = 0; m < 4; ++m) {
                const int col = u.pm * 256 + ai * 128 + wr * 64 + m * 16 + fr, o = col >> 11, dir = (col >> 10) & 1, c = col & 1023;
                const float delta = fabsf(da + (float)c * ((db - da) / 1023.0f)) * (1.0f / 2047.0f);
                float* kr = kt + ((size_t)o * 1024 + c) * 4096;
#pragma unroll
                for (int bj = 0; bj < 2; ++bj) {
                    const int t0 = u.pn * 256 + bj * 128 + wc * 32 + 8 * fq; float v[8];
#pragma unroll
                    for (int n = 0; n < 2; ++n)
#pragma unroll
                        for (int e = 0; e < 4; ++e) v[4 * n + e] = acc[ai][bj][m][n][e] * expf(-(float)(t0 + 4 * n + e) * delta);
                    if (dir == 0) { *(pg8::f32x4*)(kr + t0) = (pg8::f32x4){v[0], v[1], v[2], v[3]}; *(pg8::f32x4*)(kr + t0 + 4) = (pg8::f32x4){v[4], v[5], v[6], v[7]}; }
                    else {
#pragma unroll
                        for (int e = 0; e < 8; ++e) if (t0 + e >= 1) kr[4096 - t0 - e] = v[e]; }
                }
            }
    }
};

template <int OP> __device__ __forceinline__ LAS float* block_scan_2048(LAS float* x, LAS float* y, int tid) {
    LAS float* src = x; LAS float* dst = y;
    for (int off = 1; off < 2048; off <<= 1) {
#pragma unroll
        for (int i = 0; i < 4; ++i) { const int idx = tid + 512 * i; float v = src[idx]; if (idx >= off) { const float w = src[idx - off]; v = OP ? fmaxf(v, w) : v + w; } dst[idx] = v; }
        __syncthreads();
        LAS float* t = src; src = dst; dst = t;
    }
    return src;
}
__device__ __forceinline__ float logsigmoidf(float x) { return fminf(x, 0.f) - log1pf(expf(-fabsf(x))); }

__device__ __forceinline__ void phase2(const Ctx& C) {
    unsigned char* ws = C.ws;
    {
        const float* KT = (const float*)(ws + WS_KT); f32x4* KF = (f32x4*)(ws + WS_KF);
        const int half = C.tid >> 8, g = C.tid & 255;
        LAS float* re = (LAS float*)(C.lds + half * (2 * FFT_WORDS * 4)); LAS float* im = re + FFT_WORDS;
        LAS float* red = (LAS float*)(C.lds + 4 * FFT_WORDS * 4);
        for (int u = blockIdx.x; u < 1024; u += C.G) {
            const int o = u >> 9, c0 = (u & 511) * 2, c = c0 + half;
            __syncthreads();
            const float* kcol = KT + ((size_t)o * 1024 + c) * 4096;
            float xr[16], xi[16]; float asum = 0.f;
#pragma unroll
            for (int m = 0; m < 16; ++m) { const int idx = g + 256 * m; const float val = (idx == 2048) ? 0.f : kcol[idx]; xr[m] = val; xi[m] = 0.f; asum += fabsf(val); }
            asum = wave_sum(asum);
            if (C.lane == 0) red[C.wave] = asum;
            __syncthreads();
            const float tot = red[half * 4] + red[half * 4 + 1] + red[half * 4 + 2] + red[half * 4 + 3];
            const float scl = 1.0f / (tot * 4096.0f);
#pragma unroll
            for (int m = 0; m < 16; ++m) xr[m] *= scl;
            dft16<false>(xr, xi); twiddle16<false>(xr, xi, g, 4096); fft_store_s256(re, im, g, xr, xi);
            __syncthreads();
            fft_load_s16(re, im, g, xr, xi); dft16<false>(xr, xi); twiddle16<false>(xr, xi, g & 15, 256); fft_store_s16(re, im, g, xr, xi);
            __syncthreads();
            fft_load_s1(re, im, g, xr, xi); dft16<false>(xr, xi);
            f32x4* dst = KF + ((size_t)(o * 1024 + c) * 4096 + g * 16) / 2;
#pragma unroll
            for (int k = 0; k < 8; ++k) dst[k] = (f32x4){xr[2 * k], xi[2 * k], xr[2 * k + 1], xi[2 * k + 1]};
        }
        __syncthreads();
    }
    {
        const bf16* raw = (const bf16*)(ws + WS_QKRAW); bf16* qkc = (bf16*)(ws + WS_QKC); const float* cw = C.A.in[13]; const float* cb = C.A.in[14];
        const int qwg0 = C.G > 128 ? 64 : 0;
        for (int g = ((int)blockIdx.x - qwg0) * NTHREADS + C.tid; g < T * 256 && (int)blockIdx.x >= qwg0; g += (C.G - qwg0) * NTHREADS) {
            const int tok = g >> 8, ch0 = (g & 255) * 8, tl = tok & (SEQ - 1);
            const v4u cur = *(const v4u*)(raw + (size_t)tok * 2048 + ch0);
            v4u prv = (v4u){0u, 0u, 0u, 0u}, nxt = (v4u){0u, 0u, 0u, 0u};
            if (tl > 0) prv = *(const v4u*)(raw + (size_t)(tok - 1) * 2048 + ch0);
            if (tl < SEQ - 1) nxt = *(const v4u*)(raw + (size_t)(tok + 1) * 2048 + ch0);
            const float sc = ch0 >= 1024 ? 0.08838834764831845f : 1.0f;
            float o[8];
#pragma unroll
            for (int i = 0; i < 8; ++i) {
                const unsigned pw = prv[i >> 1], cwd = cur[i >> 1], nw = nxt[i >> 1];
                const float p = (i & 1) ? bfhi(pw) : bflo(pw), q = (i & 1) ? bfhi(cwd) : bflo(cwd), n = (i & 1) ? bfhi(nw) : bflo(nw);
                const int ch = ch0 + i;
                const float v = cw[ch] * p + cw[2048 + ch] * q + cw[4096 + ch] * n + cb[ch];
                o[i] = sc * v / (1.0f + expf(-v));
            }
            v4u w; w.x = pk2(o[0], o[1]); w.y = pk2(o[2], o[3]); w.z = pk2(o[4], o[5]); w.w = pk2(o[6], o[7]);
            *(v4u*)(qkc + (size_t)tok * 2048 + ch0) = w;
        }
    }
    {
        const float* gates = (const float*)(ws + WS_GATES); float* GA = (float*)(ws + WS_GA); float* GP = (float*)(ws + WS_GP); float* GE = (float*)(ws + WS_GE);
        LAS float* s0 = (LAS float*)(C.lds + 8192); LAS float* s1 = s0 + 2048; LAS float* s2 = s1 + 2048; LAS float* s3 = s2 + 2048;
        for (int bhd = blockIdx.x; bhd < 64; bhd += C.G) {
            const int b = bhd >> 4, h = (bhd >> 1) & 7, dir = bhd & 1, col_i = dir * 16 + h, col_f = col_i + 8;
            float ig[4], lf[4];
            __syncthreads();
#pragma unroll
            for (int i = 0; i < 4; ++i) { const int t = C.tid + 512 * i; const float* gr = gates + (size_t)(b * SEQ + t) * 32; ig[i] = gr[col_i]; lf[i] = logsigmoidf(gr[col_f]); s0[t] = lf[i]; }
            __syncthreads();
            LAS float* Fc = block_scan_2048<0>(s0, s1, C.tid);
            float a[4], Fv[4], Gx[4];
#pragma unroll
            for (int i = 0; i < 4; ++i) { const int t = C.tid + 512 * i; Fv[i] = Fc[t]; Gx[i] = Fv[i] - lf[i]; a[i] = dir ? ig[i] + Gx[i] : ig[i] - Fv[i]; s2[dir ? 2047 - t : t] = a[i]; }
            __syncthreads();
            LAS float* Pm = block_scan_2048<1>(s2, s3, C.tid);
#pragma unroll
            for (int i = 0; i < 4; ++i) { const int t = C.tid + 512 * i; const float pm = Pm[dir ? 2047 - t : t];
                const float mt = dir ? pm - Gx[i] : Fv[i] + pm;
                GA[bhd * 2048 + t] = a[i]; GP[bhd * 2048 + t] = pm; GE[bhd * 2048 + t] = expf(-mt); }
        }
        __syncthreads();
    }
}

__device__ __forceinline__ void hyena_conv_once(LAS float* re, LAS float* im, int g, float (&xr)[16], float (&xi)[16], const f32x4* __restrict__ kf) {
    __syncthreads();
    dft16<false>(xr, xi); twiddle16<false>(xr, xi, g, 4096); fft_store_s256(re, im, g, xr, xi);
    __syncthreads();
    fft_load_s16(re, im, g, xr, xi); dft16<false>(xr, xi); twiddle16<false>(xr, xi, g & 15, 256); fft_store_s16(re, im, g, xr, xi);
    __syncthreads();
    fft_load_s1(re, im, g, xr, xi); dft16<false>(xr, xi);
#pragma unroll
    for (int k = 0; k < 8; ++k) { const f32x4 w = kf[g * 8 + k];
        const float r0 = xr[2 * k] * w.x - xi[2 * k] * w.y, i0 = xr[2 * k] * w.y + xi[2 * k] * w.x;
        const float r1 = xr[2 * k + 1] * w.z - xi[2 * k + 1] * w.w, i1 = xr[2 * k + 1] * w.w + xi[2 * k + 1] * w.z;
        xr[2 * k] = r0; xi[2 * k] = i0; xr[2 * k + 1] = r1; xi[2 * k + 1] = i1; }
    dft16<true>(xr, xi); fft_store_s1(re, im, g, xr, xi);
    __syncthreads();
    fft_load_s16(re, im, g, xr, xi); twiddle16<true>(xr, xi, g & 15, 256); dft16<true>(xr, xi); fft_store_s16(re, im, g, xr, xi);
    __syncthreads();
    fft_load_s256(re, im, g, xr, xi); twiddle16<true>(xr, xi, g, 4096); dft16<true>(xr, xi);
}
__device__ __forceinline__ void hyena_fft(const Ctx& C) {
    unsigned char* ws = C.ws;
    const bf16* hyt = (const bf16*)(ws + WS_HYT); const f32x4* KF = (const f32x4*)(ws + WS_KF); float* ZT = (float*)(ws + WS_ZT);
    const float* cw = C.A.in[3]; const float* cb = C.A.in[4]; const float* skip = C.A.in[11];
    const int half = C.tid >> 8, g = C.tid & 255;
    LAS float* re = (LAS float*)(C.lds + half * (2 * FFT_WORDS * 4)); LAS float* im = re + FFT_WORDS;
    LAS bf16* rows = (LAS bf16*)(C.lds + 4 * FFT_WORDS * 4 + half * 16384);
    for (int c = blockIdx.x; c < DHY; c += C.G) {
        float vr[8], vi[8], ar[8], ai[8];
        __syncthreads();
#pragma unroll
        for (int rr = 0; rr < 4; ++rr) { const int part = rr >> 1, bq = rr & 1;
            *(LAS v4u*)(rows + rr * 2048 + g * 8) = *(const v4u*)(hyt + (size_t)(part * 1024 + c) * T + (2 * half + bq) * SEQ + g * 8); }
        __syncthreads();
#pragma unroll
        for (int part = 0; part < 2; ++part) {
            const int ch = part * 1024 + c; const float w0 = cw[ch], w1 = cw[3072 + ch], w2 = cw[6144 + ch], bb = cb[ch];
#pragma unroll
            for (int bq = 0; bq < 2; ++bq) { const LAS bf16* row = rows + (part * 2 + bq) * 2048;
#pragma unroll
                for (int m = 0; m < 8; ++m) { const int t = g + 256 * m;
                    const float p = t > 0 ? bf2f(row[t - 1]) : 0.f, q = bf2f(row[t]), n = t < SEQ - 1 ? bf2f(row[t + 1]) : 0.f;
                    const float r = w0 * p + w1 * q + w2 * n + bb;
                    if (part == 0) { if (bq == 0) vr[m] = r; else vi[m] = r; } else { if (bq == 0) ar[m] = r; else ai[m] = r; } } }
        }
        const float sk0 = skip[c], sk1 = skip[1024 + c];
        float xr[16], xi[16];
#pragma unroll
        for (int m = 0; m < 8; ++m) { xr[m] = vr[m]; xi[m] = vi[m]; xr[m + 8] = 0.f; xi[m + 8] = 0.f; }
        hyena_conv_once(re, im, g, xr, xi, KF + (size_t)c * 2048);
#pragma unroll
        for (int m = 0; m < 8; ++m) { vr[m] = ar[m] * (xr[m] + sk0 * vr[m]); vi[m] = ai[m] * (xi[m] + sk0 * vi[m]); xr[m] = vr[m]; xi[m] = vi[m]; xr[m + 8] = 0.f; xi[m + 8] = 0.f; }
        v4u x2a, x2b;
        { const bf16* src = hyt + (size_t)(2048 + c) * T + (2 * half) * SEQ + g * 8; x2a = *(const v4u*)src; x2b = *(const v4u*)(src + SEQ); }
        hyena_conv_once(re, im, g, xr, xi, KF + (size_t)(1024 + c) * 2048);
        *(LAS v4u*)(rows + g * 8) = x2a; *(LAS v4u*)(rows + 2048 + g * 8) = x2b;
        __syncthreads();
        float* zr = ZT + (size_t)c * T + (2 * half) * SEQ;
        { const int ch = 2048 + c; const float w0 = cw[ch], w1 = cw[3072 + ch], w2 = cw[6144 + ch], bb = cb[ch];
#pragma unroll
          for (int bq = 0; bq < 2; ++bq) { const LAS bf16* row = rows + bq * 2048;
#pragma unroll
            for (int m = 0; m < 8; ++m) { const int t = g + 256 * m;
                const float p = t > 0 ? bf2f(row[t - 1]) : 0.f, q = bf2f(row[t]), n = t < SEQ - 1 ? bf2f(row[t + 1]) : 0.f;
                const float x2 = w0 * p + w1 * q + w2 * n + bb;
                if (bq == 0) zr[t] = x2 * (xr[m] + sk1 * vr[m]); else zr[SEQ + t] = x2 * (xi[m] + sk1 * vi[m]); } } }
    }
    __syncthreads();
}

typedef short ml_bf16x8 __attribute__((ext_vector_type(8)));
typedef short ml_s16x4 __attribute__((ext_vector_type(4)));
typedef float ml_f32x16 __attribute__((ext_vector_type(16)));
typedef __bf16 ml_bf2 __attribute__((ext_vector_type(2)));
constexpr int ML_KROW = 272, ML_VROW = 136, ML_KBUF = 64 * ML_KROW, ML_VBUF = 128 * ML_VROW;
__device__ __forceinline__ unsigned ml_pk(float lo, float hi) { const f32x2 v = {lo, hi}; return __builtin_bit_cast(unsigned, __builtin_convertvector(v, ml_bf2)); }
__device__ __forceinline__ void mlstm_mfma(const Ctx& C) {
    unsigned char* ws = C.ws;
    const bf16* qkc = (const bf16*)(ws + WS_QKC); const bf16* vt = (const bf16*)(ws + WS_HYT) + (size_t)3072 * T;
    const float* GA = (const float*)(ws + WS_GA); const float* GP = (const float*)(ws + WS_GP); const float* GE = (const float*)(ws + WS_GE);
    const bf16* ob = (const bf16*)(ws + WS_OB); bf16* ycat = (bf16*)(ws + (size_t)YCAT_T0 * MiB); const float* mlw = C.A.in[15];
    LAS unsigned char* KB = C.lds; LAS unsigned char* VB = C.lds + 2 * ML_KBUF; LAS float* AS = (LAS float*)(C.lds + 2 * ML_KBUF + 2 * ML_VBUF);
    const int w = C.wave;
    for (int u = blockIdx.x; u < 256; u += C.G) {
        int tid = C.tid; asm volatile("" : "+v"(tid));
        const int lane = tid & 63, r = lane & 31, hh = lane >> 5;
        const int bh = u >> 3, qb = u & 7, b = bh >> 3, h = bh & 7;
        const bf16* kbase = qkc + (size_t)(b * SEQ) * 2048 + 1024 + h * 128;
        const bf16* vbase = vt + (size_t)(h * 128) * T + b * SEQ;
        const int qlo = 256 * qb + 32 * w, tq = qlo + r;
        ml_bf16x8 qf[8];
        { const bf16* qrow = qkc + (size_t)(b * SEQ + tq) * 2048 + h * 128 + 8 * hh;
#pragma unroll
          for (int s = 0; s < 8; ++s) qf[s] = *(const ml_bf16x8*)(qrow + 16 * s); }
        ml_f32x16 O[4];
#pragma unroll 1
        for (int dir = 0; dir < 2; ++dir) {
            const int bhd = bh * 2 + dir;
            __syncthreads();
            for (int i = tid; i < SEQ; i += NTHREADS) AS[i] = GA[bhd * SEQ + i] * 1.4426950408889634f;
            const float pmt = GP[bhd * SEQ + tq] * 1.4426950408889634f;
#pragma unroll
            for (int d = 0; d < 4; ++d)
#pragma unroll
                for (int i = 0; i < 16; ++i) O[d][i] = 0.f;
            float den = 0.f;
            const int kt0 = dir ? 4 * qb : 0, kt1 = dir ? 31 : 4 * qb + 3;
            v4u kr0, kr1, vr0, vr1;
            const unsigned koff0 = (unsigned)((tid >> 4) * 4096 + (tid & 15) * 16), koff1 = koff0 + 32u * 4096u;
            const unsigned voff0 = (unsigned)((tid >> 3) * (T * 2) + (tid & 7) * 16), voff1 = voff0 + 64u * (unsigned)(T * 2);
#define ML_LOAD(kt) do { const char* ku_ = (const char*)kbase + (size_t)(kt) * (64 * 4096); const char* vu_ = (const char*)vbase + (size_t)(kt) * 128; \
                kr0 = *(const v4u*)(ku_ + koff0); kr1 = *(const v4u*)(ku_ + koff1); vr0 = *(const v4u*)(vu_ + voff0); vr1 = *(const v4u*)(vu_ + voff1); } while (0)
#define ML_STORE(buf) do { const int p0 = tid, p1 = tid + 512; \
                *(LAS v4u*)(KB + (buf) * ML_KBUF + (p0 >> 4) * ML_KROW + (p0 & 15) * 16) = kr0; *(LAS v4u*)(KB + (buf) * ML_KBUF + (p1 >> 4) * ML_KROW + (p1 & 15) * 16) = kr1; \
                { LAS unsigned char* d0 = VB + (buf) * ML_VBUF + (p0 >> 3) * ML_VROW + (p0 & 7) * 16; *(LAS v2u*)d0 = (v2u){vr0.x, vr0.y}; *(LAS v2u*)(d0 + 8) = (v2u){vr0.z, vr0.w}; } \
                { LAS unsigned char* d1 = VB + (buf) * ML_VBUF + (p1 >> 3) * ML_VROW + (p1 & 7) * 16; *(LAS v2u*)d1 = (v2u){vr1.x, vr1.y}; *(LAS v2u*)(d1 + 8) = (v2u){vr1.z, vr1.w}; } } while (0)
            ML_LOAD(kt0);
            __syncthreads();
            ML_STORE(0);
            __syncthreads();
#pragma unroll 1
            for (int kt = kt0; kt <= kt1; ++kt) {
                const int cur = (kt - kt0) & 1;
                if (kt < kt1) ML_LOAD(kt + 1);
                const int klo = 64 * kt, khi = klo + 63, qhi = qlo + 31;
                const bool none = dir ? (khi < qlo) : (klo > qhi);
                const bool all = dir ? (klo >= qhi) : (khi <= qlo);
                if (!none) {
                    const LAS unsigned char* Kb = KB + cur * ML_KBUF; const LAS unsigned char* Vb = VB + cur * ML_VBUF;
                    ml_f32x16 S0, S1;
#pragma unroll
                    for (int i = 0; i < 16; ++i) { S0[i] = 0.f; S1[i] = 0.f; }
#pragma unroll
                    for (int s = 0; s < 8; ++s) {
                        const ml_bf16x8 k0 = *(const LAS ml_bf16x8*)(Kb + r * ML_KROW + (16 * s + 8 * hh) * 2);
                        const ml_bf16x8 k1 = *(const LAS ml_bf16x8*)(Kb + (32 + r) * ML_KROW + (16 * s + 8 * hh) * 2);
                        S0 = __builtin_amdgcn_mfma_f32_32x32x16_bf16(k0, qf[s], S0, 0, 0, 0);
                        S1 = __builtin_amdgcn_mfma_f32_32x32x16_bf16(k1, qf[s], S1, 0, 0, 0);
                    }
                    float den1 = 0.f;
#define ML_WGT(COND) do { _Pragma("unroll") for (int kb = 0; kb < 2; ++kb) _Pragma("unroll") for (int g4 = 0; g4 < 4; ++g4) { \
                        const f32x4 a4 = *(const LAS f32x4*)(AS + klo + 32 * kb + 8 * g4 + 4 * hh); \
                        _Pragma("unroll") for (int e = 0; e < 4; ++e) { const int i = 4 * g4 + e; const int cpos = 32 * kb + 8 * g4 + e; (void)cpos; \
                            const float sv = kb ? S1[i] : S0[i]; float p = sv * __builtin_amdgcn_exp2f(a4[e] - pmt); \
                            p = (COND) ? p : 0.f; \
                            if (e & 1) den1 += p; else den += p; \
                            if (kb) S1[i] = p; else S0[i] = p; } } } while (0)
                    if (all) { ML_WGT(true); }
                    else { const int sgn = dir ? -1 : 1, dd = sgn * (tq - klo - 4 * hh);
                        ML_WGT(sgn * cpos <= dd); }
#undef ML_WGT
                    den += den1;
#pragma unroll
                    for (int kb = 0; kb < 2; ++kb)
#pragma unroll
                        for (int s = 0; s < 2; ++s) {
                            v4u pw;
                            if (kb == 0) { pw.x = ml_pk(S0[8 * s], S0[8 * s + 1]); pw.y = ml_pk(S0[8 * s + 2], S0[8 * s + 3]); pw.z = ml_pk(S0[8 * s + 4], S0[8 * s + 5]); pw.w = ml_pk(S0[8 * s + 6], S0[8 * s + 7]); }
                            else { pw.x = ml_pk(S1[8 * s], S1[8 * s + 1]); pw.y = ml_pk(S1[8 * s + 2], S1[8 * s + 3]); pw.z = ml_pk(S1[8 * s + 4], S1[8 * s + 5]); pw.w = ml_pk(S1[8 * s + 6], S1[8 * s + 7]); }
                            const ml_bf16x8 pf = __builtin_bit_cast(ml_bf16x8, pw);
#pragma unroll
                            for (int db = 0; db < 4; ++db) {
                                const LAS unsigned char* vp = Vb + (32 * db + r) * ML_VROW + 2 * (32 * kb + 16 * s + 4 * hh);
                                const ml_s16x4 lo = *(const LAS ml_s16x4*)vp, hi = *(const LAS ml_s16x4*)(vp + 16);
                                const ml_bf16x8 vf = __builtin_shufflevector(lo, hi, 0, 1, 2, 3, 4, 5, 6, 7);
                                O[db] = __builtin_amdgcn_mfma_f32_32x32x16_bf16(vf, pf, O[db], 0, 0, 0);
                            }
                        }
                }
                if (kt < kt1) ML_STORE(cur ^ 1);
                __syncthreads();
            }
#undef ML_LOAD
#undef ML_STORE
            den += __shfl_xor(den, 32);
            const float scl = 1.0f / fmaxf(fabsf(den), GE[bhd * SEQ + tq]);
            int th = tid; asm volatile("" : "+v"(th));
            v4u* hp = (v4u*)(ws + WS_HML) + ((size_t)u * NTHREADS + th) * 8;
            if (dir == 0) {
#pragma unroll
                for (int db = 0; db < 4; ++db)
#pragma unroll
                    for (int q2 = 0; q2 < 2; ++q2) { v4u pk;
#pragma unroll
                        for (int j = 0; j < 4; ++j) pk[j] = ml_pk(O[db][8 * q2 + 2 * j] * scl, O[db][8 * q2 + 2 * j + 1] * scl);
                        hp[db * 2 + q2] = pk; }
            } else {
#pragma unroll
                for (int db = 0; db < 4; ++db)
#pragma unroll
                    for (int q2 = 0; q2 < 2; ++q2) { const v4u pk = hp[db * 2 + q2];
#pragma unroll
                        for (int j = 0; j < 4; ++j) { O[db][8 * q2 + 2 * j] = O[db][8 * q2 + 2 * j] * scl + bflo(pk[j]); O[db][8 * q2 + 2 * j + 1] = O[db][8 * q2 + 2 * j + 1] * scl + bfhi(pk[j]); } }
            }
        }
        float sm = 0.f;
#pragma unroll
        for (int db = 0; db < 4; ++db)
#pragma unroll
            for (int i = 0; i < 16; ++i) sm += O[db][i];
        sm += __shfl_xor(sm, 32);
        const float mu = sm * (1.0f / 128.0f); float qv = 0.f;
#pragma unroll
        for (int db = 0; db < 4; ++db)
#pragma unroll
            for (int i = 0; i < 16; ++i) { O[db][i] -= mu; qv += O[db][i] * O[db][i]; }
        qv += __shfl_xor(qv, 32);
        const float rstd = 1.0f / sqrtf(qv * (1.0f / 128.0f) + LN_EPS);
        LAS unsigned char* TB = C.lds;
        int te = tid; asm volatile("" : "+v"(te));
        __syncthreads();
        if (te < 128) AS[te] = mlw[h * 128 + te];
#pragma unroll
        for (int i = 0; i < 8; ++i) { const int pc = te + 512 * i, row = pc >> 4, ch = pc & 15;
            *(LAS v4u*)(TB + row * 272 + ch * 16) = *(const v4u*)(ob + (size_t)(b * SEQ + 256 * qb + row) * 1024 + h * 128 + ch * 8); }
        __syncthreads();
        LAS unsigned char* myrow = TB + (32 * w + (te & 31)) * 272 + 8 * ((te & 63) >> 5);
#pragma unroll
        for (int db = 0; db < 4; ++db)
#pragma unroll
            for (int g4 = 0; g4 < 4; ++g4) {
                const int dim = 32 * db + 8 * g4 + 4 * ((te & 63) >> 5); const f32x4 gw = *(const LAS f32x4*)(AS + dim);
                LAS v2u* pp = (LAS v2u*)(myrow + (32 * db + 8 * g4) * 2); const v2u ow = *pp;
                const float o0 = bflo(ow.x), o1 = bfhi(ow.x), o2 = bflo(ow.y), o3 = bfhi(ow.y);
                const float y0 = O[db][4 * g4] * rstd * gw.x / (1.0f + __expf(-o0)), y1 = O[db][4 * g4 + 1] * rstd * gw.y / (1.0f + __expf(-o1));
                const float y2 = O[db][4 * g4 + 2] * rstd * gw.z / (1.0f + __expf(-o2)), y3 = O[db][4 * g4 + 3] * rstd * gw.w / (1.0f + __expf(-o3));
                *pp = (v2u){ml_pk(y0, y1), ml_pk(y2, y3)};
            }
        __syncthreads();
#pragma unroll
        for (int i = 0; i < 8; ++i) { const int pc = te + 512 * i, row = pc >> 4, ch = pc & 15;
#if OUTPROJ_F8
            { const v4u t8 = *(const LAS v4u*)(TB + row * 272 + ch * 16); v2u o8; o8.x = pk4_fp8(bflo(t8.x) * Y8_SCALE, bfhi(t8.x) * Y8_SCALE, bflo(t8.y) * Y8_SCALE, bfhi(t8.y) * Y8_SCALE); o8.y = pk4_fp8(bflo(t8.z) * Y8_SCALE, bfhi(t8.z) * Y8_SCALE, bflo(t8.w) * Y8_SCALE, bfhi(t8.w) * Y8_SCALE);
              *(v2u*)((unsigned char*)ycat + (size_t)(b * SEQ + 256 * qb + row) * 2048 + 1024 + h * 128 + ch * 8) = o8; } }
#else
            *(v4u*)(ycat + (size_t)(b * SEQ + 256 * qb + row) * 2048 + 1024 + h * 128 + ch * 8) = *(const LAS v4u*)(TB + row * 272 + ch * 16); }
#endif
    }
    __syncthreads();
}

__device__ __forceinline__ void phase4(const Ctx& C) {
    unsigned char* ws = C.ws;
    const float* ZT = (const float*)(ws + WS_ZT); const float* HML = (const float*)(ws + WS_HML); const bf16* ob = (const bf16*)(ws + WS_OB);
    bf16* ycat = (bf16*)(ws + (size_t)YCAT_T0 * MiB); const float* hyw = C.A.in[12]; const float* mlw = C.A.in[15];
    const int lane = C.lane;
    {
        LAS float* red = (LAS float*)C.lds;
        for (int u = blockIdx.x; u < 128 * 8; u += C.G) {
            const int tt = u >> 3, gi = u & 7, tok = tt * 64 + lane, ch0 = gi * 128 + C.wave * 16;
            float x[16]; float s = 0.f;
#pragma unroll
            for (int i = 0; i < 16; ++i) { x[i] = ZT[(size_t)(ch0 + i) * T + tok]; s += x[i]; }
            __syncthreads();
            red[C.wave * 64 + lane] = s;
            __syncthreads();
            float tot = 0.f;
#pragma unroll
            for (int w = 0; w < 8; ++w) tot += red[w * 64 + lane];
            const float mu = tot * (1.0f / 128.0f); float q = 0.f;
#pragma unroll
            for (int i = 0; i < 16; ++i) { x[i] -= mu; q += x[i] * x[i]; }
            __syncthreads();
            red[C.wave * 64 + lane] = q;
            __syncthreads();
            float qt = 0.f;
#pragma unroll
            for (int w = 0; w < 8; ++w) qt += red[w * 64 + lane];
            const float rstd = 1.0f / sqrtf(qt * (1.0f / 128.0f) + LN_EPS);
            float y[16];
#pragma unroll
            for (int i = 0; i < 16; ++i) y[i] = x[i] * rstd * hyw[ch0 + i];
            v4u w0, w1; w0.x = pk2(y[0], y[1]); w0.y = pk2(y[2], y[3]); w0.z = pk2(y[4], y[5]); w0.w = pk2(y[6], y[7]);
            w1.x = pk2(y[8], y[9]); w1.y = pk2(y[10], y[11]); w1.z = pk2(y[12], y[13]); w1.w = pk2(y[14], y[15]);
#if OUTPROJ_F8
            {
#pragma unroll
              for (int i = 0; i < 16; ++i) y[i] *= Y8_SCALE;
              v4u o8; o8.x = pk4_fp8(y[0], y[1], y[2], y[3]); o8.y = pk4_fp8(y[4], y[5], y[6], y[7]); o8.z = pk4_fp8(y[8], y[9], y[10], y[11]); o8.w = pk4_fp8(y[12], y[13], y[14], y[15]);
              *(v4u*)((unsigned char*)ycat + (size_t)tok * 2048 + ch0) = o8; (void)w0; (void)w1; }
#else
            bf16* dst = ycat + (size_t)tok * 2048 + ch0;
            *(v4u*)dst = w0; *(v4u*)(dst + 8) = w1;
#endif
        }
        __syncthreads();
    }
}

struct TileOrder {
    int nM, nN, a0, b0, G, c;
    __device__ __forceinline__ bool next(int i, pg8::Unit& u) const {
        const int nwg = nM * nN; const int L = i * G + c; if (L >= nwg) return false;
        int w; { const int q = nwg / 8, r = nwg % 8, xcd = L % 8, off = L / 8; w = (xcd < r ? xcd * (q + 1) : r * (q + 1) + (xcd - r) * q) + off; }
        const int nig = 8 * nN, gid = w / nig, wi = w % nig; u.pm = a0 + gid * 8 + (wi % 8); u.pn = b0 + wi / 8; return true;
    }
    __device__ __forceinline__ void a_ready(const pg8::Unit&) const {}
    __device__ __forceinline__ void done(const pg8::Unit&) const {}
};
struct EpiOut {
    static constexpr bool PERM = false, AFTER_DRAIN = false, F8 = OUTPROJ_F8 != 0;
    const float* x; const float* bias; float* r1;
    __device__ __forceinline__ void operator()(const pg8::f32x4 (&acc)[2][2][4][2], const pg8::Unit& u, int wr, int wc, int fr, int fq) const {
        constexpr int TS = OUTPROJ_F8 ? 2 : 1; constexpr float WSC = OUTPROJ_F8 ? 1.0f / (W8_SCALE * Y8_SCALE) : 1.0f;
        const int row0 = (u.pm - TS * YCAT_T0) * 256 + wr * 64 + fr, col0 = (u.pn - TS * WOUT_T0) * 256 + wc * 32 + 4 * fq;
        pg8::f32x4 bv[2][2];
#pragma unroll
        for (int bj = 0; bj < 2; ++bj)
#pragma unroll
            for (int n = 0; n < 2; ++n) bv[bj][n] = *(const pg8::f32x4*)(bias + col0 + bj * 128 + n * 16);
#pragma unroll
        for (int ai = 0; ai < 2; ++ai)
#pragma unroll
            for (int mp = 0; mp < 2; ++mp) { pg8::f32x4 xs[2][2][2];
#pragma unroll
                for (int mm = 0; mm < 2; ++mm) { const size_t off = (size_t)(row0 + ai * 128 + (2 * mp + mm) * 16) * D + col0;
#pragma unroll
                    for (int bj = 0; bj < 2; ++bj)
#pragma unroll
                        for (int n = 0; n < 2; ++n) xs[mm][bj][n] = *(const pg8::f32x4*)(x + off + bj * 128 + n * 16); }
#pragma unroll
                for (int mm = 0; mm < 2; ++mm) { const int m = 2 * mp + mm; const size_t off = (size_t)(row0 + ai * 128 + m * 16) * D + col0;
#pragma unroll
                    for (int bj = 0; bj < 2; ++bj)
#pragma unroll
                        for (int n = 0; n < 2; ++n) *(pg8::f32x4*)(r1 + off + bj * 128 + n * 16) = xs[mm][bj][n] * DN_ALPHA + acc[ai][bj][m][n] * WSC + bv[bj][n]; } }
    }
};

#define P6_RS_STEP(NV, XM) do { const bool up = (lane & (XM)) != 0; _Pragma("unroll") for (int e_ = 0; e_ < (NV); ++e_) { \
        const float keep0 = up ? a0[e_ + (NV)] : a0[e_], send0 = up ? a0[e_] : a0[e_ + (NV)]; a0[e_] = keep0 + __shfl_xor(send0, (XM)); \
        const float keep1 = up ? a1[e_ + (NV)] : a1[e_], send1 = up ? a1[e_] : a1[e_ + (NV)]; a1[e_] = keep1 + __shfl_xor(send1, (XM)); } } while (0)
__device__ __forceinline__ void phase6(const Ctx& C, int dummy) {
    unsigned char* ws = C.ws;
    float* r1 = (float*)(ws + WS_R1); bf16* x1b = (bf16*)(ws + (size_t)X1B_T0 * MiB);
    const float* g1 = C.A.in[18]; const float* b1 = C.A.in[19]; const float* rw = C.A.in[20]; const float* rb = C.A.in[21];
    unsigned* cnt = (unsigned*)(ws + WS_CTL) + CW_CNT + (dummy ? 4096 : 0); int* list = (int*)(ws + (dummy ? WS_YBUF : WS_LIST)); float* tokw = (float*)(ws + (dummy ? WS_YBUF + 2 * MiB : WS_TOKW));
    const int lane = C.lane;
    LAS unsigned char* wbuf = C.lds;
    LAS unsigned* hist = (LAS unsigned*)(C.lds + 65536); LAS unsigned* hbase = hist + 32;
    if (C.tid < NE) hist[C.tid] = 0u;
    __syncthreads();
    for (int it = blockIdx.x; it < T / 16; it += C.G) {
        const int pair = it * 8 + C.wave;
        int ln = lane; asm volatile("" : "+v"(ln));
        f32x4 v0[8], v1[8];
#pragma unroll
        for (int tk = 0; tk < 2; ++tk) {
            const int tok = 2 * pair + tk; float* rr = r1 + (size_t)tok * D; f32x4 v[8]; float s = 0.f;
#pragma unroll
            for (int j = 0; j < 8; ++j) { v[j] = *(const f32x4*)(rr + (ln + 64 * j) * 4); s += (v[j].x + v[j].y) + (v[j].z + v[j].w); }
            const float mean = wave_sum(s) * (1.0f / D); float q = 0.f;
#pragma unroll
            for (int j = 0; j < 8; ++j) { v[j] = v[j] - mean; q += (v[j].x * v[j].x + v[j].y * v[j].y) + (v[j].z * v[j].z + v[j].w * v[j].w); }
            const float rstd = 1.0f / sqrtf(wave_sum(q) * (1.0f / D) + LN_EPS);
#pragma unroll
            for (int j = 0; j < 8; ++j) { const int c0 = (ln + 64 * j) * 4; const f32x4 gg = *(const f32x4*)(g1 + c0), bb = *(const f32x4*)(b1 + c0);
                const f32x4 y = v[j] * rstd * gg + bb;
                if (!dummy) { v2u w; w.x = pk2(y.x, y.y); w.y = pk2(y.z, y.w); *(v2u*)(x1b + (size_t)tok * D + c0) = w; }
                if (!dummy) { unsigned q8 = 0u; q8 = __builtin_amdgcn_cvt_pk_fp8_f32(y.x, y.y, q8, false); q8 = __builtin_amdgcn_cvt_pk_fp8_f32(y.z, y.w, q8, true); *(unsigned*)(ws + WS_X1Q + (size_t)tok * D + c0) = q8; }
                if (tk == 0) v0[j] = y; else v1[j] = y; }
        }
        int my_e0 = 0, my_r0 = 0, my_e1 = 0, my_r1 = 0;
        float a0[32], a1[32];
#pragma unroll
        for (int e = 0; e < 32; ++e) { a0[e] = 0.f; a1[e] = 0.f; }
        const int tid = C.tid; f32x4 st[4];
        const bool hi8 = (ln & 8) != 0;
        const unsigned rdoff = (unsigned)(4 * ln) * 128u, rdx = (unsigned)(ln & 7);
#define P6_CHUNK_LOAD(j_) do { _Pragma("unroll") for (int r_ = 0; r_ < 4; ++r_) st[r_] = *(const f32x4*)(rw + (size_t)(j_) * 8192 + (size_t)(tid + 512 * r_) * 4); } while (0)
#define P6_CHUNK_STORE(b_) do { _Pragma("unroll") for (int r_ = 0; r_ < 4; ++r_) { const int idx_ = tid + 512 * r_, row_ = idx_ >> 3, q_ = idx_ & 7; \
            *(LAS f32x4*)(wbuf + (b_) * 32768 + row_ * 128 + 16 * (q_ ^ ((row_ >> 2) & 7))) = st[r_]; } } while (0)
        __syncthreads();
        P6_CHUNK_LOAD(0); P6_CHUNK_STORE(0);
        __syncthreads();
#pragma unroll
        for (int j = 0; j < 8; ++j) {
            if (j < 7) P6_CHUNK_LOAD(j + 1);
            const LAS unsigned char* wb = wbuf + (j & 1) * 32768 + rdoff;
#pragma unroll
            for (int i = 0; i < 4; ++i) {
                const float x0 = hi8 ? v0[j][i ^ 1] : v0[j][i], x1 = hi8 ? v1[j][i ^ 1] : v1[j][i];
                const LAS unsigned char* wrow = wb + (hi8 ? (i ^ 1) : i) * 128;
#pragma unroll
                for (int q4 = 0; q4 < 8; ++q4) { const f32x4 w4 = *(const LAS f32x4*)(wrow + 16 * (q4 ^ rdx));
                    a0[4 * q4] += x0 * w4.x; a0[4 * q4 + 1] += x0 * w4.y; a0[4 * q4 + 2] += x0 * w4.z; a0[4 * q4 + 3] += x0 * w4.w;
                    a1[4 * q4] += x1 * w4.x; a1[4 * q4 + 1] += x1 * w4.y; a1[4 * q4 + 2] += x1 * w4.z; a1[4 * q4 + 3] += x1 * w4.w; }
            }
            if (j < 7) P6_CHUNK_STORE((j + 1) & 1);
            __syncthreads();
        }
#undef P6_CHUNK_LOAD
#undef P6_CHUNK_STORE
        P6_RS_STEP(16, 32); P6_RS_STEP(8, 16); P6_RS_STEP(4, 8); P6_RS_STEP(2, 4); P6_RS_STEP(1, 2);
        int le_ = lane; asm volatile("" : "+v"(le_));
        const int e = le_ >> 1; const float rbe = rb[e];
        float lg0 = a0[0] + __shfl_xor(a0[0], 1) + rbe, lg1 = a1[0] + __shfl_xor(a1[0], 1) + rbe;
#pragma unroll
        for (int tk = 0; tk < 2; ++tk) {
            const int tok = 2 * pair + tk; float val = tk ? lg1 : lg0; float vals[4]; int idxs[4];
#pragma unroll
            for (int k = 0; k < 4; ++k) {
                const float m = wave_max(val);
                const unsigned long long bal = __ballot(val == m);
                const int idx = (int)(__builtin_ctzll(bal) >> 1);
                vals[k] = m; idxs[k] = idx;
                if (e == idx) val = -3.0e38f;
            }
            const float e1 = expf(vals[1] - vals[0]), e2 = expf(vals[2] - vals[0]), e3 = expf(vals[3] - vals[0]);
            const float inv = 1.0f / (1.0f + e1 + e2 + e3);
            if (lane < 4) {
                const int sel_e = lane == 0 ? idxs[0] : lane == 1 ? idxs[1] : lane == 2 ? idxs[2] : idxs[3];
                const float sel_v = (lane == 0 ? 1.0f : lane == 1 ? e1 : lane == 2 ? e2 : e3) * inv;
                tokw[tok * 4 + lane] = sel_v;
                const int rk = (int)__hip_atomic_fetch_add(hist + sel_e, 1u, __ATOMIC_RELAXED, __HIP_MEMORY_SCOPE_WORKGROUP);
                if (tk == 0) { my_e0 = sel_e; my_r0 = rk; } else { my_e1 = sel_e; my_r1 = rk; }
            }
        }
        __syncthreads();
        int tl = C.tid; asm volatile("" : "+v"(tl));
        if (tl < NE) { const unsigned n = hist[tl]; hbase[tl] = n ? atomicAdd(cnt + 64 * tl, n) : 0u; }
        __syncthreads();
        if (lane < 4) { list[my_e0 * T + (int)hbase[my_e0] + my_r0] = (2 * pair) * 4 + lane; list[my_e1 * T + (int)hbase[my_e1] + my_r1] = (2 * pair + 1) * 4 + lane; }
        __syncthreads();
        if (tl < NE) hist[tl] = 0u;
    }
}
#undef P6_RS_STEP

__device__ __forceinline__ void moe_build_tb(const Ctx& C) {
    LAS int* tb = (LAS int*)(C.lds + LDS_TB);
    __syncthreads();
    if (C.tid < NE) { const unsigned* cnt = (const unsigned*)(C.ws + WS_CTL) + CW_CNT; tb[40 + C.tid] = (int)__hip_atomic_load(cnt + 64 * C.tid, __ATOMIC_RELAXED, __HIP_MEMORY_SCOPE_AGENT); }
    __syncthreads();
    if (C.tid == 0) { int acc = 0;
        for (int e = 0; e < NE; ++e) { const int n = tb[40 + e]; tb[e] = acc; acc += (n + 255) >> 8; }
        tb[32] = acc; }
    __syncthreads();
}
struct MoeOrder {
    const LAS int* tb; int NJ, a0, w0, G, c; const int* list; int gather;
    const LAS int* ul; const LAS int* rowt;
    __device__ __forceinline__ bool compute(int i, pg8::Unit& u) const {
        const int nwg = tb[32] * NJ; const int L = i * G + c; if (L >= nwg) return false;
        int w; { const int q = nwg / 8, r = nwg % 8, xcd = L % 8, off = L / 8; w = (xcd < r ? xcd * (q + 1) : r * (q + 1) + (xcd - r) * q) + off; }
        int e = 0;
        while (e < NE - 1 && tb[e + 1] * NJ <= w) ++e;
        const int local = w - tb[e] * NJ, nt = tb[e + 1] - tb[e], j = local / nt, ti = local - j * nt;
        u.pm = a0 + tb[e] + ti; u.pn = w0 + e * NJ + j; return true;
    }
    __device__ __forceinline__ bool next(int i, pg8::Unit& u) const {
        if (i < MOE_MAXU) { const int pm = __builtin_amdgcn_readfirstlane(ul[i]); if (pm < 0) return false; u.pm = pm; u.pn = __builtin_amdgcn_readfirstlane(ul[16 + i]); return true; }
        pg8::Unit t; const bool ok = compute(i, t); if (!ok) return false; u.pm = __builtin_amdgcn_readfirstlane(t.pm); u.pn = __builtin_amdgcn_readfirstlane(t.pn); return true;
    }
    __device__ __forceinline__ int row_slow(const pg8::Unit& u, int r) const { const int e = (u.pn - w0) / NJ; const int i = (u.pm - a0 - tb[e]) * 256 + r, n = tb[40 + e];
        const int v = list[e * T + (i < n ? i : (n > 0 ? n - 1 : 0))] >> 2; return i < n ? v : 0; }
    __device__ __forceinline__ int a_row(const pg8::Unit& u, int idx, int r) const { if (!gather) return (u.pm - a0) * 256 + r; if (idx < MOE_MAXU) return rowt[idx * 256 + r]; return row_slow(u, r); }
    __device__ __forceinline__ int b_tile(const pg8::Unit& u) const { return u.pn - w0; }
    __device__ __forceinline__ void a_ready(const pg8::Unit&) const {}
    __device__ __forceinline__ void done(const pg8::Unit&) const {}
    __device__ __forceinline__ void setup(int tid) const {
        LAS int* ulw = (LAS int*)ul; LAS int* rtw = (LAS int*)rowt;
        if (tid < MOE_MAXU) { pg8::Unit t; const bool ok = compute(tid, t); ulw[tid] = ok ? t.pm : -1; ulw[16 + tid] = ok ? t.pn : 0; }
        __syncthreads();
        if (gather) for (int idx = tid; idx < MOE_MAXU * 256; idx += NTHREADS) { const int i = idx >> 8; const int pm = ul[i]; if (pm >= 0) { pg8::Unit t; t.pm = pm; t.pn = ul[16 + i]; rtw[idx] = row_slow(t, idx & 255); } }
        __syncthreads();
    }
};
struct EpiGU {
    static constexpr bool PERM = true, AFTER_DRAIN = false, F8 = true;
    const float* b_gu; unsigned char* act; float wsc;
    __device__ __forceinline__ void operator()(const pg8::f32x4 (&acc)[2][2][4][2], const pg8::Unit& u, int wr, int wc, int fr_, int fq_) const {
        int ln_ = threadIdx.x & 63; asm volatile("" : "+v"(ln_));
        const int fr = ln_ & 15, fq = ln_ >> 4;
        using pg8::cvt_pk_bf16;
        const int rt = u.pm - ABUF_T0, rel = u.pn - WGU_Q0, e = rel >> 4, j = rel & 15;
        const int col0 = j * 128 + wc * 32 + 8 * fq;
        pg8::f32x4 bg[2], bu[2];
#pragma unroll
        for (int n = 0; n < 2; ++n) { bg[n] = *(const pg8::f32x4*)(b_gu + (size_t)e * 4096 + col0 + 4 * n); bu[n] = *(const pg8::f32x4*)(b_gu + (size_t)e * 4096 + 2048 + col0 + 4 * n); }
#pragma unroll
        for (int ai = 0; ai < 2; ++ai)
#pragma unroll
            for (int m = 0; m < 4; ++m) { const int row = rt * 256 + ai * 128 + wr * 64 + m * 16 + fr;
                float o[8];
#pragma unroll
                for (int n = 0; n < 2; ++n) { const pg8::f32x4 g = acc[ai][0][m][n] * wsc + bg[n], up = acc[ai][1][m][n] * wsc + bu[n];
#pragma unroll
                    for (int i = 0; i < 4; ++i) { const float gc = fminf(g[i], 7.0f), uc = fminf(fmaxf(up[i], -7.0f), 7.0f);
                        o[4 * n + i] = (uc + 1.0f) * (gc / (1.0f + __expf(-1.702f * gc))); } }
                v2u w; w.x = __builtin_amdgcn_cvt_pk_fp8_f32(o[0], o[1], 0u, false); w.x = __builtin_amdgcn_cvt_pk_fp8_f32(o[2], o[3], w.x, true);
                w.y = __builtin_amdgcn_cvt_pk_fp8_f32(o[4], o[5], 0u, false); w.y = __builtin_amdgcn_cvt_pk_fp8_f32(o[6], o[7], w.y, true);
                *(v2u*)(act + (size_t)row * DFF + col0) = w; }
    }
};
struct EpiDown {
    static constexpr bool PERM = true, AFTER_DRAIN = false, F8 = true;
    const float* b_down; const int* list; const float* tokw; const LAS int* tb; bf16* ybuf; float wsc;
    __device__ __forceinline__ void operator()(const pg8::f32x4 (&acc)[2][2][4][2], const pg8::Unit& u, int wr, int wc, int fr_, int fq_) const {
        using pg8::cvt_pk_bf16;
        int ln_ = threadIdx.x & 63; asm volatile("" : "+v"(ln_));
        const int fr = ln_ & 15, fq = ln_ >> 4;
        const int rel = u.pn - WDN_Q0, e = rel >> 3, j = rel & 7, ti = u.pm - ACT_Q0 - tb[e], n_e = tb[40 + e];
        const int col0 = j * 256 + wc * 32 + 8 * fq;
        pg8::f32x4 bv[2][2];
#pragma unroll
        for (int bj = 0; bj < 2; ++bj)
#pragma unroll
            for (int n = 0; n < 2; ++n) bv[bj][n] = *(const pg8::f32x4*)(b_down + (size_t)e * D + col0 + bj * 128 + 4 * n);
        int slot8[2][4]; float w8[2][4];
#pragma unroll
        for (int ai = 0; ai < 2; ++ai)
#pragma unroll
            for (int m = 0; m < 4; ++m) { const int i = ti * 256 + ai * 128 + wr * 64 + m * 16 + fr; slot8[ai][m] = list[e * T + (i < n_e ? i : (n_e > 0 ? n_e - 1 : 0))]; }
#pragma unroll
        for (int ai = 0; ai < 2; ++ai)
#pragma unroll
            for (int m = 0; m < 4; ++m) w8[ai][m] = tokw[slot8[ai][m]];
#pragma unroll
        for (int ai = 0; ai < 2; ++ai)
#pragma unroll
            for (int m = 0; m < 4; ++m) { const int i = ti * 256 + ai * 128 + wr * 64 + m * 16 + fr;
                { const int slot = (i < n_e) ? slot8[ai][m] : 32768; const float w = w8[ai][m]; bf16* dst = ybuf + (size_t)slot * D + col0;
#pragma unroll
                    for (int bj = 0; bj < 2; ++bj) { const pg8::f32x4 v0 = (acc[ai][bj][m][0] * wsc + bv[bj][0]) * w, v1 = (acc[ai][bj][m][1] * wsc + bv[bj][1]) * w;
                        v4u o; o.x = cvt_pk_bf16(v0[0], v0[1]); o.y = cvt_pk_bf16(v0[2], v0[3]); o.z = cvt_pk_bf16(v1[0], v1[1]); o.w = cvt_pk_bf16(v1[2], v1[3]);
                        *(v4u*)(dst + bj * 128) = o; } } }
    }
};

namespace pg8 {
template <class Epi, class Sched, class Side>
__device__ __forceinline__ void gemm_phase_ga(PG8_LAS unsigned char* lds, const bf16_t* Arows, const bf16_t* Btiles, const int K, const Sched& S, const Epi& E, const Side& SD) {
    const int tid = threadIdx.x, wid = __builtin_amdgcn_readfirstlane(tid >> 6), lane = tid & 63, wr = wid >> 2, wc = wid & 3, fr = lane & 15, fq = lane >> 4;
    const int nt = K / BK;
    unsigned voffB[2];
#pragma unroll
    for (int i = 0; i < 2; ++i) { int R, Cc; stage_rc(tid * 16 + i * 8192, R, Cc); const int Rb = Epi::PERM ? ((R & ~31) + perm32(R & 31)) : R; voffB[i] = (unsigned)(Rb * K + Cc) * 2u; }
    const size_t kstep = (size_t)(BK * 2), hstep = (size_t)HALF * K * 2, tstep = 2 * hstep;
    const unsigned ldsw = (unsigned)wid * 1024u;
    const int aoff = lds_byte(wr * 64 + fr, fq * 8), boff = lds_byte(wc * 32 + fr, fq * 8);
#define PG8_SA(b, h) (((b) * 2 + (h)) * HTB)
#define PG8_SB(b, h) ((4 + (b) * 2 + (h)) * HTB)
    const unsigned ldsb = __builtin_amdgcn_readfirstlane((unsigned)(size_t)lds + ldsw);
#define PG8_DMA(gptr, vo, laddr) asm volatile("s_mov_b32 m0, %2\n\tglobal_load_lds_dwordx4 %0, %1" :: "v"(vo), "s"(gptr), "s"(laddr) : "memory", "m0")
#define PG8_STAGE(bufoff, gbase, voff) do { _Pragma("unroll") for (int _i = 0; _i < 2; ++_i) PG8_DMA((const char*)(gbase), (voff)[_i], ldsb + (unsigned)((bufoff) + _i * 8192)); } while (0)
#define PG8_STAGE2(bufoff, gbase, v0, v1) do { PG8_DMA((const char*)(gbase), v0, ldsb + (unsigned)(bufoff)); PG8_DMA((const char*)(gbase), v1, ldsb + (unsigned)((bufoff) + 8192)); } while (0)
#define PG8_LDA(dst, b, h) do { _Pragma("unroll") for (int m = 0; m < 4; ++m) _Pragma("unroll") for (int k = 0; k < 2; ++k) dst[m][k] = *(const PG8_LAS bf16x8*)(lds + PG8_SA(b, h) + aoff + m * 2048 + k * 1024); } while (0)
#define PG8_LDB(dst, b, h) do { _Pragma("unroll") for (int n = 0; n < 2; ++n) _Pragma("unroll") for (int k = 0; k < 2; ++k) dst[n][k] = *(const PG8_LAS bf16x8*)(lds + PG8_SB(b, h) + boff + n * 2048 + k * 1024); } while (0)
#define PG8_MMA(ai, bj, At, Bt) do { __builtin_amdgcn_s_setprio(1); if constexpr (epi_f8<Epi>::v) { _Pragma("unroll") for (int m = 0; m < 4; ++m) _Pragma("unroll") for (int n = 0; n < 2; ++n) \
        acc[ai][bj][m][n] = __builtin_amdgcn_mfma_scale_f32_16x16x128_f8f6f4(cat8(Bt[n][0], Bt[n][1]), cat8(At[m][0], At[m][1]), acc[ai][bj][m][n], 0, 0, 0, 0, 0, 0); } else { \
        _Pragma("unroll") for (int m = 0; m < 4; ++m) _Pragma("unroll") for (int n = 0; n < 2; ++n) _Pragma("unroll") for (int k = 0; k < 2; ++k) \
        acc[ai][bj][m][n] = __builtin_amdgcn_mfma_f32_16x16x32_bf16(Bt[n][k], At[m][k], acc[ai][bj][m][n], 0, 0, 0); } __builtin_amdgcn_s_setprio(0); } while (0)
#define PG8_WAIT_V(n) asm volatile("s_waitcnt vmcnt(" #n ")" ::: "memory")
#define PG8_WAIT_L(n) asm volatile("s_waitcnt lgkmcnt(" #n ")" ::: "memory")
#define PG8_BAR __builtin_amdgcn_s_barrier()
#define PG8_SCHED __builtin_amdgcn_sched_barrier(0)
#define PG8_AROWS(vo, u, ix) do { int t_ = threadIdx.x; asm volatile("" : "+v"(t_)); _Pragma("unroll") for (int _i = 0; _i < 2; ++_i) { int R_, C_; stage_rc(t_ * 16 + _i * 8192, R_, C_); \
        _Pragma("unroll") for (int _h = 0; _h < 2; ++_h) vo[_h * 2 + _i] = (unsigned)S.a_row(u, ix, _h * 128 + R_) * (unsigned)(K * 2) + (unsigned)(C_ * 2); } } while (0)
    const int skh = 0, snq = wid;
#define PG8_SGV() ({ int t_ = tid; asm volatile("" : "+v"(t_)); (unsigned)((4 * (t_ & 31)) * SD.ldb + 4 * ((t_ >> 5) & 1)) * 4u; })
#define PG8_SDV() ({ int t_ = tid; asm volatile("" : "+v"(t_)); (unsigned)(4 * ((t_ >> 5) & 1)) * 2048u + 4u * (unsigned)(t_ & 31); })
    const size_t sldb4 = Side::ON ? (size_t)SD.ldb * 4 : 0;
    int sstep = Side::ON ? SD.first : 0, sprev = 0, sit = (int)(blockIdx.x >> 3) % Side::PERIOD, sext = 0, sage = 0; bool spend = false;
    f32x4 sx[4] = {(f32x4){0.f, 0.f, 0.f, 0.f}, (f32x4){0.f, 0.f, 0.f, 0.f}, (f32x4){0.f, 0.f, 0.f, 0.f}, (f32x4){0.f, 0.f, 0.f, 0.f}};
    typedef unsigned u32x2s __attribute__((ext_vector_type(2)));
#define PG8_SIDE_LOAD() do { const char* sp_ = (const char*)SD.src(sstep, skh, snq); const unsigned sgv = PG8_SGV(); _Pragma("unroll") for (int _j = 0; _j < 4; ++_j) \
        asm volatile("global_load_dwordx4 %0, %1, %2" : "+v"(sx[_j]) : "v"(sgv), "s"(sp_ + (size_t)_j * sldb4) : "memory"); sprev = sstep; sstep += SD.stride; } while (0)
#define PG8_SIDE_STORE() do { asm volatile("" : "+v"(sx[0]), "+v"(sx[1]), "+v"(sx[2]), "+v"(sx[3])); \
        char* dp_ = (char*)SD.dst(sprev, skh, snq); const unsigned sdv = PG8_SDV(); _Pragma("unroll") for (int _i = 0; _i < 4; ++_i) { unsigned _w = 0u; \
            _w = __builtin_amdgcn_cvt_pk_fp8_f32(sx[0][_i] * W8_SCALE, sx[1][_i] * W8_SCALE, _w, false); _w = __builtin_amdgcn_cvt_pk_fp8_f32(sx[2][_i] * W8_SCALE, sx[3][_i] * W8_SCALE, _w, true); \
            asm volatile("global_store_dword %0, %1, %2" :: "v"(sdv), "v"(_w), "s"(dp_ + (size_t)_i * 2048) : "memory"); } } while (0)
#define PG8_SIDE_SLOT() do { if constexpr (Side::ON && Side::PAIR) { int ext_ = 0; if (spend) { PG8_SIDE_STORE(); spend = false; ext_ += 4; } \
        if (sstep < SD.nsteps) { PG8_SIDE_LOAD(); spend = true; ext_ += 4; } sext = ext_; } else if constexpr (Side::ON) { int ext_ = 0; if (spend) { if (++sage == Side::LAG) { if (Side::LAG == 1) PG8_WAIT_V(8); PG8_SIDE_STORE(); spend = false; ext_ += 4; } } \
        if (!spend && (sit % Side::PERIOD == 0) && (sstep < SD.nsteps)) { PG8_SIDE_LOAD(); spend = true; sage = 0; ext_ += 4; } ++sit; sext = ext_; } } while (0)
#define PG8_WAIT_K() do { if constexpr (Side::ON) { if (sext == 0) PG8_WAIT_V(8); else if (sext == 4) PG8_WAIT_V(12); else PG8_WAIT_V(16); } else PG8_WAIT_V(8); } while (0)
#define PG8_VON_LOAD(y0, y1, y2, y3) do { typedef unsigned u32x2_ __attribute__((ext_vector_type(2))); const u32x2_ q_ = *(const PG8_LAS u32x2_*)(lds + LDS_VON + tid * 8); \
        const unsigned rs_ = (unsigned)__builtin_ctz((unsigned)(K * 2)), m_ = (unsigned)(K * 2) - 1u, c0_ = voC[0] & m_, c1_ = voC[1] & m_; \
        y0 = ((q_.x & 0xffffu) << rs_) | c0_; y1 = ((q_.x >> 16) << rs_) | c1_; y2 = ((q_.y & 0xffffu) << rs_) | c0_; y3 = ((q_.y >> 16) << rs_) | c1_; } while (0)
    Unit cur, nxt; int ui = 0;
    if (!S.next(0, cur)) {
        if constexpr (Side::ON) { while (sstep < SD.nsteps) { PG8_SIDE_LOAD(); PG8_WAIT_V(0); PG8_SIDE_STORE(); } PG8_WAIT_V(0); }
        return;
    }
    f32x4 acc[2][2][4][2];
#pragma unroll
    for (int a = 0; a < 2; ++a)
#pragma unroll
        for (int b = 0; b < 2; ++b)
#pragma unroll
            for (int m = 0; m < 4; ++m)
#pragma unroll
                for (int n = 0; n < 2; ++n) acc[a][b][m][n] = (f32x4){0.f, 0.f, 0.f, 0.f};
    bf16x8 At[4][2], B0[2][2], B1[2][2];
    unsigned voC[4];
    PG8_AROWS(voC, cur, 0);
    const char* cA = (const char*)Arows; const char* cB = (const char*)Btiles + (size_t)cur.pn * tstep;
    PG8_STAGE(PG8_SB(0, 0), cB, voffB); PG8_STAGE(PG8_SB(0, 1), cB + hstep, voffB); PG8_STAGE2(PG8_SA(0, 0), cA, voC[0], voC[1]); PG8_STAGE2(PG8_SA(0, 1), cA, voC[2], voC[3]);
    if (wr == 1) PG8_BAR;
    PG8_WAIT_V(2); PG8_BAR;
    PG8_STAGE(PG8_SB(1, 0), cB + kstep, voffB); PG8_STAGE2(PG8_SA(1, 0), cA + kstep, voC[0], voC[1]); PG8_STAGE(PG8_SB(1, 1), cB + hstep + kstep, voffB);
    PG8_WAIT_V(6); PG8_BAR;
    for (;;) {
        const bool has_next = S.next(ui + 1, nxt);
        if (has_next) { unsigned vn_[4]; PG8_AROWS(vn_, nxt, ui + 1); typedef unsigned u32x2_ __attribute__((ext_vector_type(2)));
            const unsigned rs_ = (unsigned)__builtin_ctz((unsigned)(K * 2));
            *(PG8_LAS u32x2_*)(lds + LDS_VON + tid * 8) = (u32x2_){(vn_[0] >> rs_) | ((vn_[1] >> rs_) << 16), (vn_[2] >> rs_) | ((vn_[3] >> rs_) << 16)}; }
        const char* nB = has_next ? (const char*)Btiles + (size_t)nxt.pn * tstep : cB;
        for (int t = 0; t < nt; t += 2) {
            const bool last = (t == nt - 2);
            const char* a1 = cA + (size_t)(t + 1) * kstep;
            const char* a2 = last ? cA : cA + (size_t)(t + 2) * kstep; const char* b2 = last ? nB : cB + (size_t)(t + 2) * kstep;
            const char* a3 = a2 + kstep; const char* b3 = b2 + kstep;
            PG8_LDB(B0, 0, 0); PG8_LDB(B1, 0, 1); PG8_SCHED; PG8_LDA(At, 0, 0); PG8_STAGE2(PG8_SA(1, 1), a1, voC[2], voC[3]);
            if (last && has_next) PG8_VON_LOAD(voC[0], voC[1], voC[2], voC[3]);
            PG8_WAIT_K(); PG8_WAIT_L(0); PG8_BAR; PG8_MMA(0, 0, At, B0); PG8_MMA(0, 1, At, B1); PG8_BAR; PG8_SCHED;
            PG8_LDA(At, 0, 1); PG8_STAGE(PG8_SB(0, 0), b2, voffB); PG8_STAGE(PG8_SB(0, 1), b2 + hstep, voffB); PG8_STAGE2(PG8_SA(0, 0), a2, voC[0], voC[1]);
            PG8_WAIT_K(); PG8_SIDE_SLOT(); PG8_WAIT_L(0); PG8_BAR; PG8_MMA(1, 0, At, B0); PG8_MMA(1, 1, At, B1); PG8_BAR; PG8_SCHED;
            PG8_LDB(B0, 1, 0); PG8_LDB(B1, 1, 1); PG8_SCHED; PG8_LDA(At, 1, 0); PG8_STAGE2(PG8_SA(0, 1), a2, voC[2], voC[3]);
            PG8_WAIT_K(); PG8_WAIT_L(0); PG8_BAR; PG8_MMA(0, 0, At, B0); PG8_MMA(0, 1, At, B1); PG8_BAR; PG8_SCHED;
            PG8_LDA(At, 1, 1); PG8_STAGE(PG8_SB(1, 0), b3, voffB); PG8_STAGE(PG8_SB(1, 1), b3 + hstep, voffB); PG8_STAGE2(PG8_SA(1, 0), a3, voC[0], voC[1]);
            PG8_WAIT_K(); if constexpr (Side::PAIR) { sext = 0; } else { PG8_SIDE_SLOT(); } PG8_WAIT_L(0); PG8_BAR; PG8_MMA(1, 0, At, B0); PG8_MMA(1, 1, At, B1); PG8_BAR; PG8_SCHED;
        }
        if (wr == 0) PG8_BAR;
        if constexpr (epi_f8<Epi>::v) asm volatile("s_nop 7\n\ts_nop 7\n\ts_nop 7\n\ts_nop 7");
        E(acc, cur, wr, wc, fr, fq); S.done(cur);
        if (!has_next) break;
#pragma unroll
        for (int a = 0; a < 2; ++a)
#pragma unroll
            for (int b = 0; b < 2; ++b)
#pragma unroll
                for (int m = 0; m < 4; ++m)
#pragma unroll
                    for (int n = 0; n < 2; ++n) acc[a][b][m][n] = (f32x4){0.f, 0.f, 0.f, 0.f};
        cur = nxt; cB = nB; ++ui;
        if (wr == 1) PG8_BAR;
    }
    PG8_WAIT_V(0);
    PG8_BAR;
    if constexpr (Side::ON) { if (spend) { PG8_SIDE_STORE(); } while (sstep < SD.nsteps) { PG8_SIDE_LOAD(); PG8_WAIT_V(0); PG8_SIDE_STORE(); } PG8_WAIT_V(0); }
#undef PG8_SA
#undef PG8_SB
#undef PG8_STAGE
#undef PG8_STAGE2
#undef PG8_DMA
#undef PG8_LDA
#undef PG8_LDB
#undef PG8_MMA
#undef PG8_WAIT_V
#undef PG8_WAIT_L
#undef PG8_BAR
#undef PG8_SCHED
#undef PG8_AROWS
#undef PG8_SIDE_LOAD
#undef PG8_VON_LOAD
#undef PG8_SGV
#undef PG8_SDV
#undef PG8_SIDE_STORE
#undef PG8_SIDE_SLOT
#undef PG8_WAIT_K
}
}

struct NoSide { static constexpr bool ON = false, PAIR = false; static constexpr int PERIOD = 1, LAG = 1; int ldb, first, stride, nsteps;
    __device__ __forceinline__ const float* src(int, int, int) const { return nullptr; } __device__ __forceinline__ bf16* dst(int, int, int) const { return nullptr; } };
template <int PER, int LG> struct SideGU { static constexpr bool ON = true, PAIR = false; static constexpr int PERIOD = PER, LAG = LG; const float* w; unsigned char* wt; int ldb, first, stride, nsteps;
    __device__ __forceinline__ const float* src(int hs, int kh, int nq) const { const int qq = hs & 3, st = hs >> 2, tile = st >> 4, kt = st & 15, e = tile >> 4, j = tile & 15;
        return w + (size_t)e * 2048 * 4096 + (size_t)(128 * kt) * 4096 + ((qq >> 1) ? 2048 : 0) + 128 * j + 64 * (qq & 1) + 8 * nq; }
    __device__ __forceinline__ unsigned char* dst(int hs, int kh, int nq) const { const int qq = hs & 3, st = hs >> 2, tile = st >> 4, kt = st & 15; return wt + ((size_t)tile * 256 + 64 * qq + 8 * nq) * 2048 + 128 * kt; } };
template <int PER, int LG> struct SideDown { static constexpr bool ON = true, PAIR = true  ; static constexpr int PERIOD = PER, LAG = LG; const float* w; unsigned char* wt; int ldb, first, stride, nsteps;
    __device__ __forceinline__ const float* src(int hs, int kh, int nq) const { const int qq = hs & 3, st = hs >> 2, tile = st >> 4, kt = st & 15, e = tile >> 3, j = tile & 7;
        return w + (size_t)e * 2048 * 2048 + (size_t)(128 * kt) * 2048 + 256 * j + 64 * qq + 8 * nq; }
    __device__ __forceinline__ unsigned char* dst(int hs, int kh, int nq) const { const int qq = hs & 3, st = hs >> 2, tile = st >> 4, kt = st & 15; return wt + ((size_t)tile * 256 + 64 * qq + 8 * nq) * 2048 + 128 * kt; } };

__device__ __forceinline__ void phase10(const Ctx& C) {
    unsigned char* ws = C.ws;
    const bf16* x1b = (const bf16*)(ws + (size_t)X1B_T0 * MiB); const bf16* ybuf = (const bf16*)(ws + WS_YBUF);
    const float* g2 = C.A.in[26]; const float* b2 = C.A.in[27]; const int lane = C.lane;
    for (int tok = C.gw; tok < T; tok += C.NGW) {
        f32x4 v[8]; float s = 0.f;
#pragma unroll
        for (int j = 0; j < 8; ++j) { const int c0 = (lane + 64 * j) * 4; const v2u xw = *(const v2u*)(x1b + (size_t)tok * D + c0); f32x4 a = (f32x4){bflo(xw.x), bfhi(xw.x), bflo(xw.y), bfhi(xw.y)} * DN_ALPHA;
#pragma unroll
            for (int k = 0; k < 4; ++k) { const v2u yw = *(const v2u*)(ybuf + ((size_t)tok * 4 + k) * D + c0); a = a + (f32x4){bflo(yw.x), bfhi(yw.x), bflo(yw.y), bfhi(yw.y)}; }
            v[j] = a; s += (a.x + a.y) + (a.z + a.w); }
        const float mean = wave_sum(s) * (1.0f / D); float q = 0.f;
#pragma unroll
        for (int j = 0; j < 8; ++j) { v[j] = v[j] - mean; q += (v[j].x * v[j].x + v[j].y * v[j].y) + (v[j].z * v[j].z + v[j].w * v[j].w); }
        const float rstd = 1.0f / sqrtf(wave_sum(q) * (1.0f / D) + LN_EPS);
#pragma unroll
        for (int j = 0; j < 8; ++j) { const int c0 = (lane + 64 * j) * 4; const f32x4 gg = *(const f32x4*)(g2 + c0), bb = *(const f32x4*)(b2 + c0);
            *(f32x4*)(C.out + (size_t)tok * D + c0) = v[j] * rstd * gg + bb; }
    }
}

__global__ void __launch_bounds__(NTHREADS, 2) fwd_kernel(KArgs args) {
    extern __shared__ __attribute__((aligned(16))) unsigned char lds_raw[];
    const int tid_ = threadIdx.x, wave_ = __builtin_amdgcn_readfirstlane(tid_ >> 6), G_ = gridDim.x;
    Ctx C{args, args.out, args.ws, (LAS unsigned char*)lds_raw, tid_, tid_ & 63, wave_, G_, (int)blockIdx.x * NWAVES + wave_, G_ * NWAVES};
    volatile LAS unsigned* MISC = (volatile LAS unsigned*)(C.lds + LDS_MISC);
    if (C.tid < 4) MISC[C.tid] = 0u;
    __syncthreads();
    unsigned* ctl = (unsigned*)(args.ws + WS_CTL);
    XcdBarrier bar; bar.bar = ctl + CW_BAR; bar.x = 0; bar.st = MISC;
    const int lo = args.ph_lo, hi = args.ph_hi;
    if (hi - lo > 1) bar = xcd_barrier_post(ctl + CW_BAR, MISC);
#ifdef PROBE_PHASE
    unsigned long long pt0_ = 0, pdt_ = 0;
#define PT_BEGIN(k) do { if ((k) == PROBE_PHASE) pt0_ = __builtin_amdgcn_s_memrealtime(); } while (0)
#define PT_END(k) do { if ((k) == PROBE_PHASE) pdt_ = __builtin_amdgcn_s_memrealtime() - pt0_; } while (0)
#else
#define PT_BEGIN(k)
#define PT_END(k)
#endif
#ifndef PHASE_MASK
#define PHASE_MASK 0x7ff
#endif
#define IN(k) (((PHASE_MASK >> (k)) & 1) && lo <= (k) && (k) < hi)
#define SEAM(k) do { if (IN(k) && IN((k) + 1)) xcd_barrier(bar); PT_END(k); PT_BEGIN((k) + 1); } while (0)
    const pg8::Gemm g{(const pg8::bf16_t*)args.ws, (const pg8::bf16_t*)args.ws, 0, 0, 2048};
    PG8_LAS unsigned char* glds = (PG8_LAS unsigned char*)lds_raw;

#ifndef PROBE_DOUBLE
#define PROBE_DOUBLE 0
#endif
#define REP(k) for (int _rep = 0; _rep < (((PROBE_DOUBLE >> (k)) & 1) ? 2 : 1); ++_rep)
    PT_BEGIN(0);
    if (IN(0)) { REP(0) phase0(C); } SEAM(0);
    if (IN(1)) {
        Gemm1Order S{C.G, (int)blockIdx.x};
        unsigned char* ws = args.ws;
        Epi1 E{C.A.in[2], (bf16*)(ws + WS_HYT), (bf16*)(ws + WS_QKRAW), (bf16*)(ws + WS_VB), (bf16*)(ws + WS_OB), (float*)(ws + WS_GATES)};
#if MOE_SIDE
        { SideGU<SIDE_GU_PERIOD, SIDE_GU_LAG> SD{C.A.in[22], PROBE_SIDE_DUMMY ? (unsigned char*)(ws + WS_YBUF) : (unsigned char*)(ws + (size_t)WGU_T0 * MiB), 4096, (int)blockIdx.x, C.G, SIDE_GU_EXPERTS * 16 * 32 * 2};
          pg8::gemm_phase_ga<Epi1, Gemm1Order, SideGU<SIDE_GU_PERIOD, SIDE_GU_LAG>>(glds, (const pg8::bf16_t*)ws, (const pg8::bf16_t*)ws, 2048, S, E, SD); }
#else
        REP(1) pg8::gemm_phase<Epi1, Gemm1Order, true, true>(glds, g, S, E);
#endif
        { const pg8::Gemm g2{(const pg8::bf16_t*)(ws + WS_W3P), (const pg8::bf16_t*)(ws + WS_H2P), 0, 0, 256}; KtOrder S2{C.G, (int)blockIdx.x}; EpiKT E2{(float*)(ws + WS_KT)};
          pg8::gemm_phase<EpiKT, KtOrder, true, true>(glds, g2, S2, E2); }
    } SEAM(1);
    if (IN(2)) { REP(2) phase2(C); } SEAM(2);
    if (IN(3)) { REP(3) hyena_fft(C); REP(11) { mlstm_mfma(C); } } SEAM(3);
    if (IN(4)) { REP(4) phase4(C); } SEAM(4);
    if (IN(5)) {
        TileOrder S{32, 8, (OUTPROJ_F8 ? 2 : 1) * YCAT_T0, (OUTPROJ_F8 ? 2 : 1) * WOUT_T0, C.G, (int)blockIdx.x};
        const pg8::Gemm g5{(const pg8::bf16_t*)args.ws, (const pg8::bf16_t*)args.ws, 0, 0, OUTPROJ_F8 ? 1024 : 2048};
        EpiOut E{C.A.in[0], C.A.in[17], (float*)(args.ws + WS_R1)};
        REP(5) pg8::gemm_phase<EpiOut, TileOrder, true, true>(glds, g5, S, E);
    } SEAM(5);
    if (IN(6)) { REP(6) phase6(C, _rep); } if (IN(6) && IN(8)) xcd_barrier(bar); PT_END(6); PT_BEGIN(8);
    if (IN(8)) {
        moe_build_tb(C);
        MoeOrder S{(const LAS int*)(C.lds + LDS_TB), 16, ABUF_T0, WGU_Q0, C.G, (int)blockIdx.x, (const int*)(args.ws + WS_LIST), 1, (const LAS int*)(C.lds + LDS_UL), (const LAS int*)(C.lds + LDS_ROWT)};
        S.setup(C.tid);
        EpiGU E{C.A.in[23], args.ws + (size_t)ACT_T0 * MiB, 1.0f / W8_SCALE};
#if MOE_SIDE
        { SideDown<SIDE_DN_PERIOD, SIDE_DN_LAG> SD{C.A.in[24], PROBE_SIDE_DUMMY ? (unsigned char*)(args.ws + WS_YBUF) : (unsigned char*)(args.ws + (size_t)WDN_T0 * MiB), 2048, (int)blockIdx.x, C.G, NE * 8 * 32 * 2};
          pg8::gemm_phase_ga<EpiGU, MoeOrder, SideDown<SIDE_DN_PERIOD, SIDE_DN_LAG>>(glds, (const pg8::bf16_t*)(args.ws + WS_X1Q), (const pg8::bf16_t*)args.ws, 1024, S, E, SD); }
#else
        { NoSide SD{0, 0, 0, 0}; REP(8) pg8::gemm_phase_ga<EpiGU, MoeOrder, NoSide>(glds, (const pg8::bf16_t*)(args.ws + WS_X1Q), (const pg8::bf16_t*)args.ws, 1024, S, E, SD); }
#endif
    } SEAM(8);
    if (IN(9)) {
        moe_build_tb(C);
        MoeOrder S{(const LAS int*)(C.lds + LDS_TB), 8, ACT_Q0, WDN_Q0, C.G, (int)blockIdx.x, (const int*)(args.ws + WS_LIST), 0, (const LAS int*)(C.lds + LDS_UL), (const LAS int*)(C.lds + LDS_ROWT)};
        S.setup(C.tid);
        EpiDown E{C.A.in[25], (const int*)(args.ws + WS_LIST), (const float*)(args.ws + WS_TOKW), (const LAS int*)(C.lds + LDS_TB), (bf16*)(args.ws + WS_YBUF), 1.0f / W8_SCALE};
        const pg8::Gemm g9{(const pg8::bf16_t*)args.ws, (const pg8::bf16_t*)args.ws, 0, 0, 1024};
        REP(9) pg8::gemm_phase<EpiDown, MoeOrder, true, true>(glds, g9, S, E);
    } SEAM(9);
    if (IN(10)) { REP(10) phase10(C); }
#ifdef PROBE_PHASE
    PT_END(10);
    if (blockIdx.x == 0 && C.wave == 0) { const unsigned long long te_ = __builtin_amdgcn_s_memrealtime(); while (__builtin_amdgcn_s_memrealtime() - te_ < 9ull * pdt_) __builtin_amdgcn_s_sleep(32); }
#endif
#ifdef PROBE_BARRIERS
    if (hi - lo > 1) for (int i_ = 0; i_ < PROBE_BARRIERS; ++i_) xcd_barrier(bar);
#endif
#undef IN
#undef SEAM
}

extern "C" void kernel_launch(void* const* d_in, const int* in_sizes, int n_in, void* d_out, int out_size, void* d_ws, size_t ws_size, hipStream_t stream) {
    static int grid = 0;
    if (grid == 0) {
        if (n_in != 28 || in_sizes[0] != T * D || out_size != T * D || ws_size < WS_END) { fprintf(stderr, "kernel_launch: unexpected shapes (n_in %d, in0 %d, out %d, ws %zu)\n", n_in, n_in > 0 ? in_sizes[0] : -1, out_size, ws_size); grid = -1; return; }
        int dev = 0, cus = 0;
        if (hipGetDevice(&dev) != hipSuccess || hipDeviceGetAttribute(&cus, hipDeviceAttributeMultiprocessorCount, dev) != hipSuccess) { grid = -1; return; }
        if (hipFuncSetAttribute((const void*)fwd_kernel, hipFuncAttributeMaxDynamicSharedMemorySize, LDS_BYTES) != hipSuccess) { fprintf(stderr, "kernel_launch: hipFuncSetAttribute failed\n"); grid = -1; return; }
        int per_cu = 0;
        if (hipOccupancyMaxActiveBlocksPerMultiprocessor(&per_cu, (const void*)fwd_kernel, NTHREADS, LDS_BYTES) != hipSuccess || per_cu < 1) fprintf(stderr, "kernel_launch: occupancy query says %d\n", per_cu);
        (void)hipGetLastError();
        grid = cus;
    }
    if (grid < 0) return;
    if (hipMemsetAsync((char*)d_ws + WS_CTL, 0, CTL_ZERO_BYTES, stream) != hipSuccess) return;
    KArgs a{};
    for (int i = 0; i < 28; ++i) a.in[i] = (const float*)d_in[i];
    a.out = (float*)d_out; a.ws = (unsigned char*)d_ws;
#if MK_ONE_LAUNCH
    a.ph_lo = 0; a.ph_hi = N_PHASES;
    hipLaunchKernelGGL(fwd_kernel, dim3(grid), dim3(NTHREADS), LDS_BYTES, stream, a);
#else
    for (int ph = 0; ph < N_PHASES; ++ph) { a.ph_lo = ph; a.ph_hi = ph + 1; hipLaunchKernelGGL(fwd_kernel, dim3(grid), dim3(NTHREADS), LDS_BYTES, stream, a); }
#endif
}
```

```cpp
#include <hip/hip_runtime.h>
#include <cstdio>
#include <cstdint>

namespace pg8 {
#define PG8_LAS __attribute__((address_space(3)))
typedef unsigned short bf16_t;
typedef short bf16x8 __attribute__((ext_vector_type(8)));
typedef float f32x4 __attribute__((ext_vector_type(4)));
typedef unsigned u32x4 __attribute__((ext_vector_type(4)));
constexpr int BM = 256, BK = 64, HALF = 128, HTB = HALF * BK * 2  , STAGE_BYTES = 8 * HTB, NXCD = 8, WGM = 8;

__host__ __device__ __forceinline__ int lds_byte(int r, int c) { const int st = (r >> 4) * 2 + (c >> 5), rr = r & 15, cc = c & 31, ob = rr * 64 + cc * 2; return st * 1024 + (ob ^ (((ob >> 9) & 1) << 5)); }
__host__ __device__ __forceinline__ void stage_rc(int b, int& R, int& C) { const int st = b / 1024, sb = b % 1024, swz = sb ^ (((sb >> 9) & 1) << 5); R = (st >> 1) * 16 + swz / 64; C = (st & 1) * 32 + (swz % 64) / 2; }
__host__ __device__ __forceinline__ int perm32(int rho) { const int n = rho >> 4, i = rho & 15; return 8 * (i >> 2) + 4 * n + (i & 3); }

struct Unit { int pm, pn; };
struct Gemm { const bf16_t* A; const bf16_t* Bt; int M, N, K; };
__device__ __forceinline__ unsigned cvt_pk_bf16(float lo, float hi) { unsigned r; asm volatile("v_cvt_pk_bf16_f32 %0, %1, %2" : "=v"(r) : "v"(lo), "v"(hi)); return r; }
typedef float f32x2 __attribute__((ext_vector_type(2)));
typedef int i32x4 __attribute__((ext_vector_type(4)));
typedef int i32x8 __attribute__((ext_vector_type(8)));
typedef long i64x2 __attribute__((ext_vector_type(2)));
template <class E, class = void> struct epi_f8 { static constexpr bool v = false; };
template <class E> struct epi_f8<E, decltype((void)E::F8)> { static constexpr bool v = E::F8; };
__device__ __forceinline__ i32x8 cat8(const bf16x8 a, const bf16x8 b) { const i32x4 x = __builtin_bit_cast(i32x4, a), y = __builtin_bit_cast(i32x4, b); return (i32x8){x.x, x.y, x.z, x.w, y.x, y.y, y.z, y.w}; }
template <class Epi, class Sched, bool ALIGN_EPI = false, bool SP2 = false>
__device__ __forceinline__ void gemm_phase(PG8_LAS unsigned char* lds, const Gemm g, const Sched& S, const Epi& E) {
    const int tid = threadIdx.x, wid = __builtin_amdgcn_readfirstlane(tid >> 6), lane = tid & 63, wr = wid >> 2, wc = wid & 3, fr = lane & 15, fq = lane >> 4;
    const int K = g.K, nt = K / BK;
    unsigned voffA[2], voffB[2];
#pragma unroll
    for (int i = 0; i < 2; ++i) { int R, C; stage_rc(tid * 16 + i * 8192, R, C); const int Rb = Epi::PERM ? ((R & ~31) + perm32(R & 31)) : R;
        voffA[i] = (unsigned)(R * K + C) * 2u; voffB[i] = (unsigned)(Rb * K + C) * 2u; }
    const size_t kstep = (size_t)(BK * 2);
    const size_t hstep = (size_t)HALF * K * 2;
    const size_t tstep = 2 * hstep;
    const unsigned ldsw = (unsigned)wid * 1024u;
    const int aoff = lds_byte(wr * 64 + fr, fq * 8), boff = lds_byte(wc * 32 + fr, fq * 8);
#define PG8_SA(b, h) (((b) * 2 + (h)) * HTB)
#define PG8_SB(b, h) ((4 + (b) * 2 + (h)) * HTB)
#define PG8_STAGE(bufoff, gbase, voff) do { _Pragma("unroll") for (int _i = 0; _i < 2; ++_i) \
        __builtin_amdgcn_global_load_lds((const unsigned*)((const char*)(gbase) + (voff)[_i]), (PG8_LAS unsigned*)(lds + (bufoff) + ldsw + _i * 8192), 16, 0, 0); } while (0)
#define PG8_LDA(dst, b, h) do { _Pragma("unroll") for (int m = 0; m < 4; ++m) _Pragma("unroll") for (int k = 0; k < 2; ++k) dst[m][k] = *(const PG8_LAS bf16x8*)(lds + PG8_SA(b, h) + aoff + m * 2048 + k * 1024); } while (0)
#define PG8_LDB(dst, b, h) do { _Pragma("unroll") for (int n = 0; n < 2; ++n) _Pragma("unroll") for (int k = 0; k < 2; ++k) dst[n][k] = *(const PG8_LAS bf16x8*)(lds + PG8_SB(b, h) + boff + n * 2048 + k * 1024); } while (0)
#define PG8_MMA(ai, bj, At, Bt) do { __builtin_amdgcn_s_setprio(1); if constexpr (epi_f8<Epi>::v) { _Pragma("unroll") for (int m = 0; m < 4; ++m) _Pragma("unroll") for (int n = 0; n < 2; ++n) \
        { const i32x8 b_ = cat8(Bt[n][0], Bt[n][1]), a_ = cat8(At[m][0], At[m][1]); \
        asm volatile("v_mfma_f32_16x16x128_f8f6f4 %0, %1, %2, %0" : "+v"(acc[ai][bj][m][n]) : "v"(b_), "v"(a_)); } } else { \
        _Pragma("unroll") for (int m = 0; m < 4; ++m) _Pragma("unroll") for (int n = 0; n < 2; ++n) _Pragma("unroll") for (int k = 0; k < 2; ++k) \
        acc[ai][bj][m][n] = __builtin_amdgcn_mfma_f32_16x16x32_bf16(Bt[n][k], At[m][k], acc[ai][bj][m][n], 0, 0, 0); } __builtin_amdgcn_s_setprio(0); } while (0)
#define PG8_WAIT_V(n) asm volatile("s_waitcnt vmcnt(" #n ")" ::: "memory")
#define PG8_WAIT_L(n) asm volatile("s_waitcnt lgkmcnt(" #n ")" ::: "memory")
#define PG8_BAR __builtin_amdgcn_s_barrier()
#define PG8_SCHED __builtin_amdgcn_sched_barrier(0)
    Unit cur, nxt; int ui = 0;
    if (!S.next(0, cur)) return;
    f32x4 acc[2][2][4][2];
#pragma unroll
    for (int a = 0; a < 2; ++a)
#pragma unroll
        for (int b = 0; b < 2; ++b)
#pragma unroll
            for (int m = 0; m < 4; ++m)
#pragma unroll
                for (int n = 0; n < 2; ++n) acc[a][b][m][n] = (f32x4){0.f, 0.f, 0.f, 0.f};
    bf16x8 At[4][2], B0[2][2], B1[2][2];
    const char* cA = (const char*)g.A + (size_t)cur.pm * tstep; const char* cB = (const char*)g.Bt + (size_t)cur.pn * tstep;
    S.a_ready(cur);
    if constexpr (SP2) {
        PG8_STAGE(PG8_SB(0, 0), cB, voffB); PG8_STAGE(PG8_SB(0, 1), cB + hstep, voffB); PG8_STAGE(PG8_SA(0, 0), cA, voffA); PG8_STAGE(PG8_SA(0, 1), cA + hstep, voffA);
        if (wr == 1) PG8_BAR;
        PG8_WAIT_V(2); PG8_BAR;
        PG8_STAGE(PG8_SB(1, 0), cB + kstep, voffB); PG8_STAGE(PG8_SA(1, 0), cA + kstep, voffA); PG8_STAGE(PG8_SB(1, 1), cB + hstep + kstep, voffB);
        PG8_WAIT_V(6); PG8_BAR;
    } else {
        PG8_STAGE(PG8_SB(0, 0), cB, voffB); PG8_STAGE(PG8_SA(0, 0), cA, voffA); PG8_STAGE(PG8_SB(0, 1), cB + hstep, voffB); PG8_STAGE(PG8_SA(0, 1), cA + hstep, voffA);
        if (wr == 1) PG8_BAR;
        PG8_WAIT_V(4); PG8_BAR;
        PG8_STAGE(PG8_SB(1, 0), cB + kstep, voffB); PG8_STAGE(PG8_SA(1, 0), cA + kstep, voffA); PG8_STAGE(PG8_SB(1, 1), cB + hstep + kstep, voffB);
        PG8_WAIT_V(6); PG8_BAR;
    }
    for (;;) {
        const bool has_next = S.next(ui + 1, nxt);
        const char* nA = has_next ? (const char*)g.A + (size_t)nxt.pm * tstep : cA; const char* nB = has_next ? (const char*)g.Bt + (size_t)nxt.pn * tstep : cB;
        for (int t = 0; t < nt; t += 2) {
            const bool last = (t == nt - 2);
            const char* a1 = cA + (size_t)(t + 1) * kstep;
            const char* a2 = last ? nA : cA + (size_t)(t + 2) * kstep; const char* b2 = last ? nB : cB + (size_t)(t + 2) * kstep;
            const char* a3 = a2 + kstep; const char* b3 = b2 + kstep;
            if (last && has_next) S.a_ready(nxt);
            if constexpr (SP2) {
            PG8_LDB(B0, 0, 0); PG8_LDB(B1, 0, 1); PG8_SCHED; PG8_LDA(At, 0, 0); PG8_STAGE(PG8_SA(1, 1), a1 + hstep, voffA);
            PG8_WAIT_V(8); PG8_WAIT_L(0); PG8_BAR; PG8_MMA(0, 0, At, B0); PG8_MMA(0, 1, At, B1); PG8_BAR; PG8_SCHED;
            PG8_LDA(At, 0, 1); PG8_STAGE(PG8_SB(0, 0), b2, voffB); PG8_STAGE(PG8_SB(0, 1), b2 + hstep, voffB); PG8_STAGE(PG8_SA(0, 0), a2, voffA);
            PG8_WAIT_V(8); PG8_WAIT_L(0); PG8_BAR; PG8_MMA(1, 0, At, B0); PG8_MMA(1, 1, At, B1); PG8_BAR; PG8_SCHED;
            PG8_LDB(B0, 1, 0); PG8_LDB(B1, 1, 1); PG8_SCHED; PG8_LDA(At, 1, 0); PG8_STAGE(PG8_SA(0, 1), a2 + hstep, voffA);
            PG8_WAIT_V(8); PG8_WAIT_L(0); PG8_BAR; PG8_MMA(0, 0, At, B0); PG8_MMA(0, 1, At, B1); PG8_BAR; PG8_SCHED;
            PG8_LDA(At, 1, 1); PG8_STAGE(PG8_SB(1, 0), b3, voffB); PG8_STAGE(PG8_SB(1, 1), b3 + hstep, voffB); PG8_STAGE(PG8_SA(1, 0), a3, voffA);
            PG8_WAIT_V(8); PG8_WAIT_L(0); PG8_BAR; PG8_MMA(1, 0, At, B0); PG8_MMA(1, 1, At, B1); PG8_BAR; PG8_SCHED;
            } else {
            PG8_LDB(B0, 0, 0); PG8_SCHED; PG8_LDA(At, 0, 0); PG8_STAGE(PG8_SA(1, 1), a1 + hstep, voffA);
            PG8_WAIT_L(8); PG8_BAR; PG8_WAIT_L(0); PG8_MMA(0, 0, At, B0); PG8_BAR; PG8_SCHED;
            PG8_LDB(B1, 0, 1); PG8_STAGE(PG8_SB(0, 0), b2, voffB);
            PG8_BAR; PG8_WAIT_L(0); PG8_MMA(0, 1, At, B1); PG8_BAR;
            PG8_LDA(At, 0, 1); PG8_STAGE(PG8_SA(0, 0), a2, voffA);
            PG8_BAR; PG8_WAIT_L(0); PG8_MMA(1, 0, At, B0); PG8_BAR; PG8_SCHED;
            PG8_STAGE(PG8_SB(0, 1), b2 + hstep, voffB);
            PG8_WAIT_V(6); PG8_BAR; PG8_MMA(1, 1, At, B1); PG8_BAR;
            PG8_LDB(B0, 1, 0); PG8_SCHED; PG8_LDA(At, 1, 0); PG8_STAGE(PG8_SA(0, 1), a2 + hstep, voffA);
            PG8_WAIT_L(8); PG8_BAR; PG8_WAIT_L(0); PG8_MMA(0, 0, At, B0); PG8_BAR; PG8_SCHED;
            PG8_LDB(B1, 1, 1); PG8_STAGE(PG8_SB(1, 0), b3, voffB);
            PG8_BAR; PG8_WAIT_L(0); PG8_MMA(0, 1, At, B1); PG8_BAR;
            PG8_LDA(At, 1, 1); PG8_STAGE(PG8_SA(1, 0), a3, voffA);
            PG8_BAR; PG8_WAIT_L(0); PG8_MMA(1, 0, At, B0); PG8_BAR; PG8_SCHED;
            PG8_STAGE(PG8_SB(1, 1), b3 + hstep, voffB);
            PG8_WAIT_V(6); PG8_BAR; PG8_MMA(1, 1, At, B1); PG8_BAR;
            }
        }
        if constexpr (ALIGN_EPI) { if (wr == 0) PG8_BAR; }
        if constexpr (epi_f8<Epi>::v) asm volatile("s_nop 7\n\ts_nop 7\n\ts_nop 7\n\ts_nop 7");
        if constexpr (!Epi::AFTER_DRAIN) { E(acc, cur, wr, wc, fr, fq); S.done(cur); }
        if (!has_next) break;
#pragma unroll
        for (int a = 0; a < 2; ++a)
#pragma unroll
            for (int b = 0; b < 2; ++b)
#pragma unroll
                for (int m = 0; m < 4; ++m)
#pragma unroll
                    for (int n = 0; n < 2; ++n) acc[a][b][m][n] = (f32x4){0.f, 0.f, 0.f, 0.f};
        cur = nxt; cA = nA; cB = nB; ++ui;
        if constexpr (ALIGN_EPI) { if (wr == 1) PG8_BAR; }
    }
    PG8_WAIT_V(0);
    if constexpr (!ALIGN_EPI) { if (wr == 0) PG8_BAR; }
    PG8_BAR;
    if constexpr (Epi::AFTER_DRAIN) { E.fused(acc, cur, wr, wc, fr, fq, lds, wid, lane); S.done(cur); }
#undef PG8_SA
#undef PG8_SB
#undef PG8_STAGE
#undef PG8_LDA
#undef PG8_LDB
#undef PG8_MMA
#undef PG8_WAIT_V
#undef PG8_WAIT_L
#undef PG8_BAR
#undef PG8_SCHED
}
}

constexpr int NB = 4, SEQ = 2048, T = NB * SEQ, D = 2048, DHY = 1024, DML = 1024, DIN = 7200, NE = 32, TOPK = 4, NH = 8, HD = 128, DFF = 2048;
constexpr float LN_EPS = 1e-5f, DN_ALPHA = 1.189207115002721f;
constexpr int NWAVES = 8, NTHREADS = 512;
#ifndef MK_ONE_LAUNCH
#define MK_ONE_LAUNCH 1
#endif
constexpr int N_PHASES = 11;
#ifndef MOE_PRECONVERT
#define MOE_PRECONVERT 1
#endif
#ifndef SIDE_GU_PERIOD
#define SIDE_GU_PERIOD 1
#define SIDE_GU_LAG 1
#endif
#ifndef SIDE_DN_PERIOD
#define SIDE_DN_PERIOD 2
#define SIDE_DN_LAG 2
#endif
#ifndef SIDE_GU_EXPERTS
#define SIDE_GU_EXPERTS 32
#endif
#ifndef OUTPROJ_F8
#define OUTPROJ_F8 1
#endif
#ifndef PROBE_SIDE_DUMMY
#define PROBE_SIDE_DUMMY 0
#endif
#ifndef MOE_SIDE
#define MOE_SIDE 1
#endif

constexpr size_t MiB = 1u << 20;
constexpr size_t WS_CTL = 0, CTL_ZERO_BYTES = 1 * MiB;
constexpr size_t WS_H2P = 1936 * MiB;
constexpr size_t WS_W3P = 1937 * MiB;
constexpr size_t WS_GATES = 2 * MiB;
constexpr size_t WS_TOKW = 3 * MiB;
constexpr size_t WS_LIST = 4 * MiB;
constexpr size_t WS_ROWSLOT = 5 * MiB;
constexpr size_t WS_ROWW = 5 * MiB + 512 * 1024;
constexpr size_t WS_GA = 6 * MiB, WS_GP = 6 * MiB + 512 * 1024, WS_GE = 7 * MiB;
constexpr size_t TILE_BYTES = 256 * 2048 * 2;
constexpr int XB_T0 = 8, WIN_T0 = 40, WOUT_T0 = 72, YCAT_T0 = 80, X1B_T0 = 112, ABUF_T0 = 144, ACT_T0 = 304, WGU_T0 = 464, WDN_T0 = 976;
constexpr size_t WS_HYT = 1232 * MiB;
constexpr size_t WS_QKRAW = 1296 * MiB;
constexpr size_t WS_OB = 1328 * MiB;
constexpr size_t WS_QKC = 1344 * MiB;
constexpr size_t WS_KT = 1376 * MiB;
constexpr size_t WS_KF = 1840 * MiB;
constexpr size_t WS_ZT = 1904 * MiB;
constexpr size_t WS_Z = 1408 * MiB;
constexpr size_t WS_HML = 1440 * MiB;
constexpr size_t WS_R1 = 1504 * MiB;
constexpr int WGU_Q0 = 2 * WGU_T0, WDN_Q0 = 2 * WDN_T0, ACT_Q0 = 2 * ACT_T0;
constexpr size_t WS_X1Q = (size_t)ABUF_T0 * MiB;
constexpr float Y8_SCALE = 16.0f;
constexpr float W8_SCALE = 256.0f;
constexpr size_t WS_YBUF = 1568 * MiB;
constexpr size_t WS_VB = 1824 * MiB;
constexpr size_t WS_END = 1940 * MiB;
constexpr int CW_BAR = 4096, CW_CNT = 16384;

constexpr int LDS_STAGE = 131072, LDS_MISC = LDS_STAGE, LDS_TB = LDS_STAGE + 64, LDS_UL = LDS_STAGE + 512, LDS_ROWT = LDS_STAGE + 1024, MOE_MAXU = 10, LDS_VON = 143360  , LDS_BYTES = 147456;
static_assert(LDS_ROWT + MOE_MAXU * 256 * 4 <= LDS_VON && LDS_VON + 512 * 8 <= LDS_BYTES && LDS_BYTES <= 163840, "LDS map");

#define GAS __attribute__((address_space(1)))
#define LAS __attribute__((address_space(3)))
typedef unsigned short bf16;
typedef unsigned v4u __attribute__((ext_vector_type(4)));
typedef unsigned v2u __attribute__((ext_vector_type(2)));
typedef float f32x4 __attribute__((ext_vector_type(4)));
typedef float f32x2 __attribute__((ext_vector_type(2)));
#define LDS_WAIT() asm volatile("s_waitcnt lgkmcnt(0)" ::: "memory")
__device__ __forceinline__ unsigned f2bf(float f) { unsigned u = __builtin_bit_cast(unsigned, f); return (u + 0x7fffu + ((u >> 16) & 1u)) >> 16; }
__device__ __forceinline__ unsigned pk2(float lo, float hi) { return f2bf(lo) | (f2bf(hi) << 16); }
__device__ __forceinline__ unsigned pk4_fp8(float a, float b, float c, float d) { unsigned w = 0u; w = __builtin_amdgcn_cvt_pk_fp8_f32(a, b, w, false); w = __builtin_amdgcn_cvt_pk_fp8_f32(c, d, w, true); return w; }
__device__ __forceinline__ float bflo(unsigned w) { return __builtin_bit_cast(float, w << 16); }
__device__ __forceinline__ float bfhi(unsigned w) { return __builtin_bit_cast(float, w & 0xffff0000u); }
__device__ __forceinline__ float bf2f(bf16 b) { return __builtin_bit_cast(float, (unsigned)b << 16); }
__device__ __forceinline__ float wave_sum(float v) {
#pragma unroll
    for (int o = 1; o < 64; o <<= 1) v += __shfl_xor(v, o);
    return v;
}
__device__ __forceinline__ float wave_max(float v) {
#pragma unroll
    for (int o = 1; o < 64; o <<= 1) v = fmaxf(v, __shfl_xor(v, o));
    return v;
}

#define XB_TMO      128
#define XB_XCNT(j)  (256  + 64 * (j))
#define XB_XSUB(j)  (1280 + 64 * (j))
#define XB_XGEN(j)  (2304 + 64 * (j))
#define XB_TOP      3328
#define XB_TOPGEN   3392
#define XCD_BAR_WORDS 3456
#define XB_SPIN_CAP (1u << 22)

__device__ __forceinline__ unsigned xb_ld(unsigned* p)              { return __hip_atomic_load(p, __ATOMIC_RELAXED, __HIP_MEMORY_SCOPE_AGENT); }
__device__ __forceinline__ unsigned xb_add(unsigned* p, unsigned v) { return __hip_atomic_fetch_add(p, v, __ATOMIC_RELAXED, __HIP_MEMORY_SCOPE_AGENT); }
__device__ __forceinline__ unsigned xb_xcc_id() { return (unsigned)__builtin_amdgcn_s_getreg((3 << 11) | 20) & 0xFu; }
#define XB_SPIN(cond, bar) do { unsigned _sp = 0; while (cond) { __builtin_amdgcn_s_sleep(1); \
    if ((++_sp & 255u) == 0u) { if (xb_ld(&(bar)[XB_TMO])) break; if (_sp > XB_SPIN_CAP) { atomicAdd(&(bar)[XB_TMO], 1u); break; } } } } while (0)

struct XcdBarrier {
    unsigned* bar; unsigned x;
    volatile LAS unsigned* st;
};

__device__ __forceinline__ XcdBarrier xcd_barrier_post(unsigned* bar, volatile LAS unsigned* st) {
    XcdBarrier b; b.bar = bar; b.x = xb_xcc_id(); b.st = st;
    if (threadIdx.x == 0) (void)xb_add(&bar[XB_XCNT(b.x)], 1u);
    return b;
}
__device__ __forceinline__ void xcd_barrier_complete(unsigned* bar, unsigned x, unsigned& nloc, unsigned& nx) {
    const unsigned G = gridDim.x * gridDim.y * gridDim.z;
    unsigned sum, cnt, mine, sp = 0u;
    for (;;) {
        sum = 0u; cnt = 0u; mine = 0u;
#pragma unroll
        for (unsigned j = 0; j < 16; ++j) { const unsigned c = xb_ld(&bar[XB_XCNT(j)]); sum += c; cnt += (c > 0u) ? 1u : 0u; mine = (j == x) ? c : mine; }
        if (sum == G) break;
        __builtin_amdgcn_s_sleep(1);
        if ((++sp & 255u) == 0u) { if (xb_ld(&bar[XB_TMO])) break; if (sp > XB_SPIN_CAP) { atomicAdd(&bar[XB_TMO], 1u); break; } }
    }
    nloc = mine > 0u ? mine : 1u; nx = cnt > 0u ? cnt : 1u;
}

__device__ __forceinline__ void xcd_barrier(const XcdBarrier& b) {
    asm volatile("s_waitcnt vmcnt(0)" ::: "memory");
    __syncthreads();
    if (threadIdx.x == 0) {
        unsigned* bar = b.bar;
        __builtin_amdgcn_s_waitcnt(0);
        unsigned nloc = b.st[0], nx = b.st[1];
        if (nloc == 0u) { xcd_barrier_complete(bar, b.x, nloc, nx); b.st[0] = nloc; b.st[1] = nx; }
        const unsigned old = xb_add(&bar[XB_XSUB(b.x)], 1u);
        const unsigned gen = old / nloc;
        if (old + 1u == (gen + 1u) * nloc) {
            __builtin_amdgcn_fence(__ATOMIC_RELEASE, "agent");
            asm volatile("s_waitcnt vmcnt(0)" ::: "memory");
            const unsigned og = xb_add(&bar[XB_TOP], 1u);
            const unsigned tg = og / nx;
            if (og + 1u == (tg + 1u) * nx) xb_add(&bar[XB_TOPGEN], 1u);
            else XB_SPIN(xb_ld(&bar[XB_TOPGEN]) == tg, bar);
            __builtin_amdgcn_fence(__ATOMIC_ACQUIRE, "agent");
            xb_add(&bar[XB_XGEN(b.x)], 1u);
            asm volatile("s_waitcnt vmcnt(0)" ::: "memory");
        } else {
            XB_SPIN(xb_ld(&bar[XB_XGEN(b.x)]) == gen, bar);
            __builtin_amdgcn_fence(__ATOMIC_ACQUIRE, "agent");
            asm volatile("s_waitcnt vmcnt(0)" ::: "memory");
        }
    }
    __syncthreads();
}


#ifndef FFT_HD
#define FFT_HD __device__ __forceinline__
#define FFT_LDS LAS
#endif
constexpr int FFT_WORDS = 4096 + 1024 + 256;
FFT_HD int fidx(int i) { return i + 4 * (i >> 4) + 16 * (i >> 8); }

template <bool INV> FFT_HD void dft4(float& ar, float& ai, float& br, float& bi, float& cr, float& ci, float& dr, float& di) {
    const float s0r = ar + cr, s0i = ai + ci, s1r = ar - cr, s1i = ai - ci;
    const float s2r = br + dr, s2i = bi + di, s3r = br - dr, s3i = bi - di;
    ar = s0r + s2r; ai = s0i + s2i;
    cr = s0r - s2r; ci = s0i - s2i;
    if (!INV) { br = s1r + s3i; bi = s1i - s3r; dr = s1r - s3i; di = s1i + s3r; }
    else      { br = s1r - s3i; bi = s1i + s3r; dr = s1r + s3i; di = s1i - s3r; }
}
template <bool INV> FFT_HD void dft16(float (&xr)[16], float (&xi)[16]) {
#pragma unroll
    for (int n0 = 0; n0 < 4; ++n0) dft4<INV>(xr[n0], xi[n0], xr[n0 + 4], xi[n0 + 4], xr[n0 + 8], xi[n0 + 8], xr[n0 + 12], xi[n0 + 12]);
    constexpr float C1 = 0.9238795325112867f, S1 = 0.3826834323650898f, C2 = 0.7071067811865476f;
    const float tc[10] = {1.f, C1, C2, S1, 0.f, -S1, -C2, -C1, -1.f, -C1};
    const float ts[10] = {0.f, S1, C2, C1, 1.f, C1, C2, S1, 0.f, -S1};
#pragma unroll
    for (int n0 = 1; n0 < 4; ++n0)
#pragma unroll
        for (int k0 = 1; k0 < 4; ++k0) { const int m = n0 * k0; const float wr = tc[m], wi = INV ? ts[m] : -ts[m];
            const int id = n0 + 4 * k0; const float r = xr[id] * wr - xi[id] * wi, i = xr[id] * wi + xi[id] * wr; xr[id] = r; xi[id] = i; }
#pragma unroll
    for (int k0 = 0; k0 < 4; ++k0) dft4<INV>(xr[4 * k0], xi[4 * k0], xr[4 * k0 + 1], xi[4 * k0 + 1], xr[4 * k0 + 2], xi[4 * k0 + 2], xr[4 * k0 + 3], xi[4 * k0 + 3]);
#pragma unroll
    for (int a = 0; a < 4; ++a)
#pragma unroll
        for (int b = a + 1; b < 4; ++b) { float t = xr[4 * a + b]; xr[4 * a + b] = xr[4 * b + a]; xr[4 * b + a] = t; t = xi[4 * a + b]; xi[4 * a + b] = xi[4 * b + a]; xi[4 * b + a] = t; }
}
template <bool INV> FFT_HD void twiddle16(float (&xr)[16], float (&xi)[16], int j, int n) {
    float s, c;
#ifdef __HIP_DEVICE_COMPILE__
    asm volatile("" : "+v"(j));
    sincospif(2.0f * (float)j / (float)n, &s, &c);
#else
    s = (float)sin(2.0 * 3.14159265358979323846 * j / n); c = (float)cos(2.0 * 3.14159265358979323846 * j / n);
#endif
    const float wr = c, wi = INV ? s : -s;
    float pr = wr, pi = wi;
#pragma unroll
    for (int k = 1; k < 16; ++k) {
        const float r = xr[k] * pr - xi[k] * pi, i = xr[k] * pi + xi[k] * pr; xr[k] = r; xi[k] = i;
        const float nr = pr * wr - pi * wi, ni = pr * wi + pi * wr; pr = nr; pi = ni;
    }
}
FFT_HD void fft_store_s256(FFT_LDS float* re, FFT_LDS float* im, int g, const float (&xr)[16], const float (&xi)[16]) {
    const int a0 = fidx(g);
#pragma unroll
    for (int k = 0; k < 16; ++k) { re[a0 + 336 * k] = xr[k]; im[a0 + 336 * k] = xi[k]; }
}
FFT_HD void fft_load_s256(const FFT_LDS float* re, const FFT_LDS float* im, int g, float (&xr)[16], float (&xi)[16]) {
    const int a0 = fidx(g);
#pragma unroll
    for (int k = 0; k < 16; ++k) { xr[k] = re[a0 + 336 * k]; xi[k] = im[a0 + 336 * k]; }
}
FFT_HD void fft_load_s16(const FFT_LDS float* re, const FFT_LDS float* im, int g, float (&xr)[16], float (&xi)[16]) {
    const int a0 = fidx((g >> 4) * 256 + (g & 15));
#pragma unroll
    for (int k = 0; k < 16; ++k) { xr[k] = re[a0 + 20 * k]; xi[k] = im[a0 + 20 * k]; }
}
FFT_HD void fft_store_s16(FFT_LDS float* re, FFT_LDS float* im, int g, const float (&xr)[16], const float (&xi)[16]) {
    const int a0 = fidx((g >> 4) * 256 + (g & 15));
#pragma unroll
    for (int k = 0; k < 16; ++k) { re[a0 + 20 * k] = xr[k]; im[a0 + 20 * k] = xi[k]; }
}
FFT_HD void fft_load_s1(const FFT_LDS float* re, const FFT_LDS float* im, int g, float (&xr)[16], float (&xi)[16]) {
    const int a = fidx(g * 16);
#pragma unroll
    for (int k = 0; k < 16; ++k) { xr[k] = re[a + k]; xi[k] = im[a + k]; }
}
FFT_HD void fft_store_s1(FFT_LDS float* re, FFT_LDS float* im, int g, const float (&xr)[16], const float (&xi)[16]) {
    const int a = fidx(g * 16);
#pragma unroll
    for (int k = 0; k < 16; ++k) { re[a + k] = xr[k]; im[a + k] = xi[k]; }
}


struct KArgs { const float* in[28]; float* out; unsigned char* ws; int ph_lo, ph_hi; };
struct Ctx {
    const KArgs& A; float* out; unsigned char* ws; LAS unsigned char* lds;
    int tid, lane, wave, G, gw, NGW;
};

__device__ __forceinline__ void transpose_item(const float* __restrict__ W, int N, int k0, int n0, bf16* __restrict__ dst, LAS float* scr, int lane) {
#pragma unroll 8
    for (int i = 0; i < 32; ++i) { const int kk = 2 * i + (lane >> 5); scr[kk * 33 + (lane & 31)] = W[(size_t)(k0 + kk) * N + n0 + (lane & 31)]; }
    LDS_WAIT(); asm volatile("" ::: "memory");
    const int c = lane & 7;
#pragma unroll
    for (int j = 0; j < 4; ++j) { const int n = (lane >> 3) + 8 * j; const LAS float* s = scr + (8 * c) * 33 + n;
        v4u o; o.x = pk2(s[0 * 33], s[1 * 33]); o.y = pk2(s[2 * 33], s[3 * 33]); o.z = pk2(s[4 * 33], s[5 * 33]); o.w = pk2(s[6 * 33], s[7 * 33]);
        *(v4u*)(dst + (size_t)n * 2048 + k0 + 8 * c) = o; }
    LDS_WAIT(); asm volatile("" ::: "memory");
}

__device__ __forceinline__ void transpose_item8(const float* __restrict__ W, int N, int k0, int n0, unsigned char* __restrict__ dst, LAS float* scr, int lane) {
#pragma unroll 8
    for (int i = 0; i < 32; ++i) { const int kk = 2 * i + (lane >> 5); scr[kk * 33 + (lane & 31)] = W[(size_t)(k0 + kk) * N + n0 + (lane & 31)]; }
    LDS_WAIT(); asm volatile("" ::: "memory");
    const int c = lane & 3;
#pragma unroll
    for (int j = 0; j < 2; ++j) { const int n = (lane >> 2) + 16 * j; const LAS float* q = scr + (16 * c) * 33 + n;
        v4u o; o.x = pk4_fp8(q[0 * 33] * W8_SCALE, q[1 * 33] * W8_SCALE, q[2 * 33] * W8_SCALE, q[3 * 33] * W8_SCALE); o.y = pk4_fp8(q[4 * 33] * W8_SCALE, q[5 * 33] * W8_SCALE, q[6 * 33] * W8_SCALE, q[7 * 33] * W8_SCALE);
        o.z = pk4_fp8(q[8 * 33] * W8_SCALE, q[9 * 33] * W8_SCALE, q[10 * 33] * W8_SCALE, q[11 * 33] * W8_SCALE); o.w = pk4_fp8(q[12 * 33] * W8_SCALE, q[13 * 33] * W8_SCALE, q[14 * 33] * W8_SCALE, q[15 * 33] * W8_SCALE);
        *(v4u*)(dst + (size_t)n * 2048 + k0 + 16 * c) = o; }
    LDS_WAIT(); asm volatile("" ::: "memory");
}

__device__ __forceinline__ void phase0(const Ctx& C) {
    unsigned char* ws = C.ws;
    {
        const f32x4* x4 = (const f32x4*)C.A.in[0]; v4u* xb = (v4u*)(ws + (size_t)XB_T0 * MiB);
        const size_t n8 = (size_t)T * D / 8;
        for (size_t i = (size_t)blockIdx.x * NTHREADS + C.tid; i < n8; i += (size_t)C.G * NTHREADS) {
            const f32x4 a = x4[2 * i], b = x4[2 * i + 1]; v4u o; o.x = pk2(a.x, a.y); o.y = pk2(a.z, a.w); o.z = pk2(b.x, b.y); o.w = pk2(b.z, b.w); xb[i] = o; }
    }
    {
        LAS float* scr = (LAS float*)(C.lds + C.wave * 8448);
        constexpr int I_IN = 32 * 225, I_OUT = 32 * 64, E_GU0 = (MOE_SIDE && !PROBE_SIDE_DUMMY) ? SIDE_GU_EXPERTS : 0, I_GU = MOE_PRECONVERT ? (NE - E_GU0) * 32 * 128 : 0, I_DN = (MOE_PRECONVERT && (!MOE_SIDE || PROBE_SIDE_DUMMY)) ? NE * 32 * 64 : 0, NITEMS = I_IN + I_OUT + I_GU + I_DN;
        bf16* win_t = (bf16*)(ws + (size_t)WIN_T0 * MiB); bf16* wout_t = (bf16*)(ws + (size_t)WOUT_T0 * MiB);
        bf16* wgu_t = (bf16*)(ws + (size_t)WGU_T0 * MiB); bf16* wdn_t = (bf16*)(ws + (size_t)WDN_T0 * MiB);
        for (int it = C.gw; it < NITEMS; it += C.NGW) {
            int r = it;
            if (r < I_IN) { const int kb = r / 225, nb = r % 225; transpose_item(C.A.in[1], DIN, 64 * kb, 32 * nb, win_t + (size_t)(32 * nb) * 2048, scr, C.lane); continue; } r -= I_IN;
#if OUTPROJ_F8
            if (r < I_OUT) { const int kb = r / 64, nb = r % 64; transpose_item8(C.A.in[16], D, 64 * kb, 32 * nb, (unsigned char*)wout_t + (size_t)(32 * nb) * 2048, scr, C.lane); continue; } r -= I_OUT;
#else
            if (r < I_OUT) { const int kb = r / 64, nb = r % 64; transpose_item(C.A.in[16], D, 64 * kb, 32 * nb, wout_t + (size_t)(32 * nb) * 2048, scr, C.lane); continue; } r -= I_OUT;
#endif
            if (r < I_GU) { const int e = E_GU0 + r / 4096, rr = r % 4096, kb = rr / 128, nb = rr % 128, n0 = 32 * nb;
                const int drow = (n0 < 2048) ? ((n0 >> 7) * 256 + (n0 & 127)) : ((((n0 - 2048) >> 7) * 256) + 128 + ((n0 - 2048) & 127));
                transpose_item(C.A.in[22] + (size_t)e * 2048 * 4096, 4096, 64 * kb, n0, wgu_t + ((size_t)e * 4096 + drow) * 2048, scr, C.lane);
                continue; } r -= I_GU;
            { const int e = r / 2048, rr = r % 2048, kb = rr / 64, nb = rr % 64;
                transpose_item(C.A.in[24] + (size_t)e * 2048 * 2048, 2048, 64 * kb, 32 * nb, wdn_t + ((size_t)e * 2048 + 32 * nb) * 2048, scr, C.lane); }
        }
    }
    __syncthreads();
    {
        const float* w1 = C.A.in[5]; const float* b1 = C.A.in[6]; const float* w2 = C.A.in[7]; const float* b2 = C.A.in[8]; const float* freq = C.A.in[10];
        LAS float* h1s = (LAS float*)C.lds;
        const int tt = C.tid >> 6, j = C.tid & 63;
        for (int tb = blockIdx.x; tb < SEQ / 8; tb += C.G) {
            const int t = tb * 8 + tt;
            const float zt = (float)t / 2047.0f, wt = 6.283185307179586f * (float)t / 2048.0f;
            float acc = b1[j] + zt * w1[j];
            for (int i = 0; i < 16; ++i) { const float fb = 1e-4f + (float)i * ((15.0f - 1e-4f) / 15.0f); float sn, cs; sincospif(fb * (float)t * (1.0f / 1024.0f), &sn, &cs);
                acc += cs * w1[(1 + i) * 64 + j] - sn * w1[(17 + i) * 64 + j]; }
            h1s[tt * 64 + j] = sinf(freq[j] * acc);
            __syncthreads();
            float a2 = b2[j];
            for (int i = 0; i < 64; ++i) a2 += h1s[tt * 64 + i] * w2[i * 64 + j];
            { const float hv = sinf(freq[64 + j] * a2); const unsigned hi = f2bf(hv); const float lo = hv - bflo(hi);
              bf16* hp = (bf16*)(ws + WS_H2P) + (size_t)t * 256; hp[j] = (bf16)hi; hp[64 + j] = (bf16)hi; hp[128 + j] = (bf16)f2bf(lo); hp[192 + j] = 0; }
            __syncthreads();
        }
        const float* w3 = C.A.in[9]; bf16* wp = (bf16*)(ws + WS_W3P);
        for (int i = blockIdx.x * NTHREADS + C.tid; i < 4096 * 8; i += C.G * NTHREADS) {
            const int col = i & 4095, jo = i >> 12; float wv[8]; unsigned hi[8], lo[8];
#pragma unroll
            for (int k = 0; k < 8; ++k) { wv[k] = w3[(size_t)(jo * 8 + k) * 4096 + col]; hi[k] = f2bf(wv[k]); lo[k] = f2bf(wv[k] - bflo(hi[k])); }
            v4u vh, vl; vh.x = hi[0] | (hi[1] << 16); vh.y = hi[2] | (hi[3] << 16); vh.z = hi[4] | (hi[5] << 16); vh.w = hi[6] | (hi[7] << 16);
            vl.x = lo[0] | (lo[1] << 16); vl.y = lo[2] | (lo[3] << 16); vl.z = lo[4] | (lo[5] << 16); vl.w = lo[6] | (lo[7] << 16);
            bf16* row = wp + (size_t)col * 256 + jo * 8;
            *(v4u*)row = vh; *(v4u*)(row + 64) = vl; *(v4u*)(row + 128) = vh; *(v4u*)(row + 192) = (v4u){0u, 0u, 0u, 0u};
        }
    }
}

constexpr int N1_SW_TILES = 16, N1_SW = N1_SW_TILES * 32;
constexpr int N1_NORM_TILES = 13, N1_NORM = N1_NORM_TILES * 32, N1_UNITS = N1_SW + N1_NORM;
struct Gemm1Order {
    int G, c;
    __device__ __forceinline__ int a_row(const pg8::Unit& u, int, int r) const { return u.pm * 256 + r; }
    __device__ __forceinline__ bool next(int i, pg8::Unit& u) const {
        const int L = i * G + c; if (L >= N1_UNITS) return false;
        int w; { const int q = N1_UNITS / 8, r = N1_UNITS % 8, xcd = L % 8, off = L / 8; w = (xcd < r ? xcd * (q + 1) : r * (q + 1) + (xcd - r) * q) + off; }
        if (w < N1_SW) { const int nig = 8 * 32, gid = w / nig, wi = w % nig, mi = gid * 8 + (wi % 8), ni = wi / 8;
            u.pm = WIN_T0 + (mi < 12 ? mi : 8 + mi); u.pn = XB_T0 + ni; }
        else { w -= N1_SW; const int nig = 8 * N1_NORM_TILES, gid = w / nig, wi = w % nig, mi = gid * 8 + (wi % 8), ni = wi / 8;
            int wt;
            wt = (ni < 8) ? 12 + ni : 16 + ni;
            u.pm = XB_T0 + mi; u.pn = WIN_T0 + wt; }
        return true;
    }
    __device__ __forceinline__ void a_ready(const pg8::Unit&) const {}
    __device__ __forceinline__ void done(const pg8::Unit&) const {}
};
struct Epi1 {
    static constexpr bool PERM = true, AFTER_DRAIN = false;
    const float* b_in; bf16* hyt; bf16* qkraw; bf16* vb; bf16* ob; float* gates;
    __device__ __forceinline__ void operator()(const pg8::f32x4 (&acc)[2][2][4][2], const pg8::Unit& u, int wr, int wc, int fr_, int fq_) const {
        int ln_ = threadIdx.x & 63; asm volatile("" : "+v"(ln_));
        const int fr = ln_ & 15, fq = ln_ >> 4;
        using pg8::cvt_pk_bf16;
        if (u.pm >= WIN_T0) {
            const int wt = u.pm - WIN_T0, tt = u.pn - XB_T0;
            const int col0 = tt * 256 + wc * 32 + 8 * fq;
            float bv8[2][4];
#pragma unroll
            for (int ai = 0; ai < 2; ++ai)
#pragma unroll
                for (int m = 0; m < 4; ++m) bv8[ai][m] = b_in[wt * 256 + ai * 128 + wr * 64 + m * 16 + fr];
#pragma unroll
            for (int ai = 0; ai < 2; ++ai)
#pragma unroll
                for (int m = 0; m < 4; ++m) {
                    const int ch = wt * 256 + ai * 128 + wr * 64 + m * 16 + fr; const float bv = bv8[ai][m];
                    const int drow = ch < 3072 ? ch : ch - 2048;
                    bf16* rowp = hyt + (size_t)drow * T + col0;
#pragma unroll
                    for (int bj = 0; bj < 2; ++bj) { const pg8::f32x4 v0 = acc[ai][bj][m][0] + bv, v1 = acc[ai][bj][m][1] + bv;
                        v4u w; w.x = cvt_pk_bf16(v0[0], v0[1]); w.y = cvt_pk_bf16(v0[2], v0[3]); w.z = cvt_pk_bf16(v1[0], v1[1]); w.w = cvt_pk_bf16(v1[2], v1[3]);
                        *(v4u*)(rowp + bj * 128) = w; }
                }
        } else {
            const int tt = u.pm - XB_T0, wt = u.pn - WIN_T0;
            const int chb = wt * 256 + wc * 32 + 8 * fq;
            pg8::f32x4 bv[2][2];
#pragma unroll
            for (int bj = 0; bj < 2; ++bj)
#pragma unroll
                for (int n = 0; n < 2; ++n) { const int c0 = chb + bj * 128 + 4 * n; bv[bj][n] = (c0 < DIN) ? *(const pg8::f32x4*)(b_in + c0) : (pg8::f32x4){0.f, 0.f, 0.f, 0.f}; }
            if (wt == 28) {
                if (wc == 0) {
#pragma unroll
                    for (int ai = 0; ai < 2; ++ai)
#pragma unroll
                        for (int m = 0; m < 4; ++m) { const int tok = tt * 256 + ai * 128 + wr * 64 + m * 16 + fr;
                            float* gp = gates + (size_t)tok * 32 + 8 * fq;
                            *(pg8::f32x4*)(gp) = acc[ai][0][m][0] + bv[0][0]; *(pg8::f32x4*)(gp + 4) = acc[ai][0][m][1] + bv[0][1]; }
                }
            } else {
#define EPI1_STORE(base, ld, cb) do { _Pragma("unroll") for (int ai = 0; ai < 2; ++ai) _Pragma("unroll") for (int m = 0; m < 4; ++m) { const int tok = tt * 256 + ai * 128 + wr * 64 + m * 16 + fr; \
                    bf16* rowp = (base) + (size_t)tok * (ld) + (cb); \
                    _Pragma("unroll") for (int bj = 0; bj < 2; ++bj) { const pg8::f32x4 v0 = acc[ai][bj][m][0] + bv[bj][0], v1 = acc[ai][bj][m][1] + bv[bj][1]; \
                        v4u w; w.x = cvt_pk_bf16(v0[0], v0[1]); w.y = cvt_pk_bf16(v0[2], v0[3]); w.z = cvt_pk_bf16(v1[0], v1[1]); w.w = cvt_pk_bf16(v1[2], v1[3]); \
                        *(v4u*)(rowp + bj * 128) = w; } } } while (0)
                if (wt < 20) EPI1_STORE(qkraw, 2048, chb - 3072);
                else if (wt < 24) EPI1_STORE(vb, 1024, chb - 5120);
                else EPI1_STORE(ob, 1024, chb - 6144);
#undef EPI1_STORE
            }
        }
    }
};

struct KtOrder {
    int G, c;
    __device__ __forceinline__ bool next(int i, pg8::Unit& u) const { const int cc = G - 1 - c; if (i != 0 || cc >= 128) return false; u.pm = cc >> 3; u.pn = cc & 7; return true; }
    __device__ __forceinline__ void a_ready(const pg8::Unit&) const {}
    __device__ __forceinline__ void done(const pg8::Unit&) const {}
};
struct EpiKT {
    static constexpr bool PERM = true, AFTER_DRAIN = false;
    float* kt;
    __device__ __forceinline__ void operator()(const pg8::f32x4 (&acc)[2][2][4][2], const pg8::Unit& u, int wr, int wc, int fr, int fq) const {
        const float da = -3.0701134573253945f, db = -15.350567286626973f;
#pragma unroll
        for (int ai = 0; ai < 2; ++ai)
#pragma unroll
            for (int m = 0; m < 4; ++m) {
                const int col = u.pm * 256 + ai * 128 + wr * 64 + m * 16 + fr, o = col >> 11, dir = (col >> 10) & 1, c = col & 1023;
                const float delta = fabsf(da + (float)c * ((db - da) / 1023.0f)) * (1.0f / 2047.0f);
                float* kr = kt + ((size_t)o * 1024 + c) * 4096;
#pragma unroll
                for (int bj = 0; bj < 2; ++bj) {
                    const int t0 = u.pn * 256 + bj * 128 + wc * 32 + 8 * fq; float v[8];
#pragma unroll
                    for (int n = 0; n < 2; ++n)
#pragma unroll
                        for (int e = 0; e < 4; ++e) v[4 * n + e] = acc[ai][bj][m][n][e] * expf(-(float)(t0 + 4 * n + e) * delta);
                    if (dir == 0) { *(pg8::f32x4*)(kr + t0) = (pg8::f32x4){v[0], v[1], v[2], v[3]}; *(pg8::f32x4*)(kr + t0 + 4) = (pg8::f32x4){v[4], v[5], v[6], v[7]}; }
                    else {
#pragma unroll
                        for (int e = 0; e < 8; ++e) if (t0 + e >= 1) kr[4096 - t0 - e] = v[e]; }
                }
            }
    }
};

template <int OP> __device__ __forceinline__ LAS float* block_scan_2048(LAS float* x, LAS float* y, int tid) {
    LAS float* src = x; LAS float* dst = y;
    for (int off = 1; off < 2048; off <<= 1) {
#pragma unroll
        for (int i = 0; i < 4; ++i) { const int idx = tid + 512 * i; float v = src[idx]; if (idx >= off) { const float w = src[idx - off]; v = OP ? fmaxf(v, w) : v + w; } dst[idx] = v; }
        __syncthreads();
        LAS float* t = src; src = dst; dst = t;
    }
    return src;
}
__device__ __forceinline__ float logsigmoidf(float x) { return fminf(x, 0.f) - log1pf(expf(-fabsf(x))); }

__device__ __forceinline__ void phase2(const Ctx& C) {
    unsigned char* ws = C.ws;
    {
        const float* KT = (const float*)(ws + WS_KT); f32x4* KF = (f32x4*)(ws + WS_KF);
        const int half = C.tid >> 8, g = C.tid & 255;
        LAS float* re = (LAS float*)(C.lds + half * (2 * FFT_WORDS * 4)); LAS float* im = re + FFT_WORDS;
        LAS float* red = (LAS float*)(C.lds + 4 * FFT_WORDS * 4);
        for (int u = blockIdx.x; u < 1024; u += C.G) {
            const int o = u >> 9, c0 = (u & 511) * 2, c = c0 + half;
            __syncthreads();
            const float* kcol = KT + ((size_t)o * 1024 + c) * 4096;
            float xr[16], xi[16]; float asum = 0.f;
#pragma unroll
            for (int m = 0; m < 16; ++m) { const int idx = g + 256 * m; const float val = (idx == 2048) ? 0.f : kcol[idx]; xr[m] = val; xi[m] = 0.f; asum += fabsf(val); }
            asum = wave_sum(asum);
            if (C.lane == 0) red[C.wave] = asum;
            __syncthreads();
            const float tot = red[half * 4] + red[half * 4 + 1] + red[half * 4 + 2] + red[half * 4 + 3];
            const float scl = 1.0f / (tot * 4096.0f);
#pragma unroll
            for (int m = 0; m < 16; ++m) xr[m] *= scl;
            dft16<false>(xr, xi); twiddle16<false>(xr, xi, g, 4096); fft_store_s256(re, im, g, xr, xi);
            __syncthreads();
            fft_load_s16(re, im, g, xr, xi); dft16<false>(xr, xi); twiddle16<false>(xr, xi, g & 15, 256); fft_store_s16(re, im, g, xr, xi);
            __syncthreads();
            fft_load_s1(re, im, g, xr, xi); dft16<false>(xr, xi);
            f32x4* dst = KF + ((size_t)(o * 1024 + c) * 4096 + g * 16) / 2;
#pragma unroll
            for (int k = 0; k < 8; ++k) dst[k] = (f32x4){xr[2 * k], xi[2 * k], xr[2 * k + 1], xi[2 * k + 1]};
        }
        __syncthreads();
    }
    {
        const bf16* raw = (const bf16*)(ws + WS_QKRAW); bf16* qkc = (bf16*)(ws + WS_QKC); const float* cw = C.A.in[13]; const float* cb = C.A.in[14];
        const int qwg0 = C.G > 128 ? 64 : 0;
        if ((int)blockIdx.x >= qwg0) {
            const int g0 = ((int)blockIdx.x - qwg0) * NTHREADS + C.tid, gst = (C.G - qwg0) * NTHREADS;
            const int ch0 = (g0 & 255) * 8; const float sc = ch0 >= 1024 ? 0.08838834764831845f : 1.0f;
            float tw0[8], tw1[8], tw2[8], tbb[8];
#pragma unroll
            for (int i = 0; i < 8; ++i) { tw0[i] = cw[ch0 + i]; tw1[i] = cw[2048 + ch0 + i]; tw2[i] = cw[4096 + ch0 + i]; tbb[i] = cb[ch0 + i]; }
            const bool fixed_ch = (gst & 255) == 0;
#define QK_LOAD(G_, PRV, CUR, NXT) do { const int tok_ = (G_) >> 8, c_ = fixed_ch ? ch0 : ((G_) & 255) * 8, tl_ = tok_ & (SEQ - 1); \
                CUR = *(const v4u*)(raw + (size_t)tok_ * 2048 + c_); PRV = *(const v4u*)(raw + (size_t)(tl_ > 0 ? tok_ - 1 : tok_) * 2048 + c_); NXT = *(const v4u*)(raw + (size_t)(tl_ < SEQ - 1 ? tok_ + 1 : tok_) * 2048 + c_); } while (0)
#define QK_STORE(G_, PRV, CUR, NXT) do { const int tok_ = (G_) >> 8, c_ = fixed_ch ? ch0 : ((G_) & 255) * 8, tl_ = tok_ & (SEQ - 1); const bool hp_ = tl_ > 0, hn_ = tl_ < SEQ - 1; float o[8]; \
                _Pragma("unroll") for (int i = 0; i < 8; ++i) { const unsigned pw = PRV[i >> 1], cwd = CUR[i >> 1], nw = NXT[i >> 1]; \
                    const float p = hp_ ? ((i & 1) ? bfhi(pw) : bflo(pw)) : 0.f, q = (i & 1) ? bfhi(cwd) : bflo(cwd), n = hn_ ? ((i & 1) ? bfhi(nw) : bflo(nw)) : 0.f; \
                    const float v = fixed_ch ? (tw0[i] * p + tw1[i] * q + tw2[i] * n + tbb[i]) : (cw[c_ + i] * p + cw[2048 + c_ + i] * q + cw[4096 + c_ + i] * n + cb[c_ + i]); \
                    o[i] = (c_ >= 1024 ? 0.08838834764831845f : 1.0f) * v / (1.0f + expf(-v)); } \
                v4u w; w.x = pk2(o[0], o[1]); w.y = pk2(o[2], o[3]); w.z = pk2(o[4], o[5]); w.w = pk2(o[6], o[7]); *(v4u*)(qkc + (size_t)tok_ * 2048 + c_) = w; } while (0)
            int g = g0; (void)sc;
            for (; g + gst < T * 256; g += 2 * gst) {
                v4u pa, ca, na, pb, cb2, nb; QK_LOAD(g, pa, ca, na); QK_LOAD(g + gst, pb, cb2, nb);
                QK_STORE(g, pa, ca, na); QK_STORE(g + gst, pb, cb2, nb); }
            for (; g < T * 256; g += gst) { v4u pa, ca, na; QK_LOAD(g, pa, ca, na); QK_STORE(g, pa, ca, na); }
#undef QK_LOAD
#undef QK_STORE
        }
    }
    {
        const float* gates = (const float*)(ws + WS_GATES); float* GA = (float*)(ws + WS_GA); float* GP = (float*)(ws + WS_GP); float* GE = (float*)(ws + WS_GE);
        LAS float* s0 = (LAS float*)(C.lds + 8192); LAS float* s1 = s0 + 2048; LAS float* s2 = s1 + 2048; LAS float* s3 = s2 + 2048;
        for (int bhd = blockIdx.x; bhd < 64; bhd += C.G) {
            const int b = bhd >> 4, h = (bhd >> 1) & 7, dir = bhd & 1, col_i = dir * 16 + h, col_f = col_i + 8;
            float ig[4], lf[4];
            __syncthreads();
#pragma unroll
            for (int i = 0; i < 4; ++i) { const int t = C.tid + 512 * i; const float* gr = gates + (size_t)(b * SEQ + t) * 32; ig[i] = gr[col_i]; lf[i] = logsigmoidf(gr[col_f]); s0[t] = lf[i]; }
            __syncthreads();
            LAS float* Fc = block_scan_2048<0>(s0, s1, C.tid);
            float a[4], Fv[4], Gx[4];
#pragma unroll
            for (int i = 0; i < 4; ++i) { const int t = C.tid + 512 * i; Fv[i] = Fc[t]; Gx[i] = Fv[i] - lf[i]; a[i] = dir ? ig[i] + Gx[i] : ig[i] - Fv[i]; s2[dir ? 2047 - t : t] = a[i]; }
            __syncthreads();
            LAS float* Pm = block_scan_2048<1>(s2, s3, C.tid);
#pragma unroll
            for (int i = 0; i < 4; ++i) { const int t = C.tid + 512 * i; const float pm = Pm[dir ? 2047 - t : t];
                const float mt = dir ? pm - Gx[i] : Fv[i] + pm;
                GA[bhd * 2048 + t] = a[i]; GP[bhd * 2048 + t] = pm; GE[bhd * 2048 + t] = expf(-mt); }
        }
        __syncthreads();
    }
}

__device__ __forceinline__ void hyena_conv_once(LAS float* re, LAS float* im, int g, float (&xr)[16], float (&xi)[16], const f32x4* __restrict__ kf) {
    __syncthreads();
    dft16<false>(xr, xi); twiddle16<false>(xr, xi, g, 4096); fft_store_s256(re, im, g, xr, xi);
    __syncthreads();
    fft_load_s16(re, im, g, xr, xi); dft16<false>(xr, xi); twiddle16<false>(xr, xi, g & 15, 256); fft_store_s16(re, im, g, xr, xi);
    __syncthreads();
    fft_load_s1(re, im, g, xr, xi); dft16<false>(xr, xi);
#pragma unroll
    for (int k = 0; k < 8; ++k) { const f32x4 w = kf[g * 8 + k];
        const float r0 = xr[2 * k] * w.x - xi[2 * k] * w.y, i0 = xr[2 * k] * w.y + xi[2 * k] * w.x;
        const float r1 = xr[2 * k + 1] * w.z - xi[2 * k + 1] * w.w, i1 = xr[2 * k + 1] * w.w + xi[2 * k + 1] * w.z;
        xr[2 * k] = r0; xi[2 * k] = i0; xr[2 * k + 1] = r1; xi[2 * k + 1] = i1; }
    dft16<true>(xr, xi); fft_store_s1(re, im, g, xr, xi);
    __syncthreads();
    fft_load_s16(re, im, g, xr, xi); twiddle16<true>(xr, xi, g & 15, 256); dft16<true>(xr, xi); fft_store_s16(re, im, g, xr, xi);
    __syncthreads();
    fft_load_s256(re, im, g, xr, xi); twiddle16<true>(xr, xi, g, 4096); dft16<true>(xr, xi);
}
__device__ __forceinline__ void hyena_fft(const Ctx& C) {
    unsigned char* ws = C.ws;
    const bf16* hyt = (const bf16*)(ws + WS_HYT); const f32x4* KF = (const f32x4*)(ws + WS_KF); float* ZT = (float*)(ws + WS_ZT);
    const float* cw = C.A.in[3]; const float* cb = C.A.in[4]; const float* skip = C.A.in[11];
    const int half = C.tid >> 8, g = C.tid & 255;
    LAS float* re = (LAS float*)(C.lds + half * (2 * FFT_WORDS * 4)); LAS float* im = re + FFT_WORDS;
    LAS bf16* rows = (LAS bf16*)(C.lds + 4 * FFT_WORDS * 4 + half * 16384);
    for (int c = blockIdx.x; c < DHY; c += C.G) {
        float vr[8], vi[8], ar[8], ai[8];
        __syncthreads();
#pragma unroll
        for (int rr = 0; rr < 4; ++rr) { const int part = rr >> 1, bq = rr & 1;
            *(LAS v4u*)(rows + rr * 2048 + g * 8) = *(const v4u*)(hyt + (size_t)(part * 1024 + c) * T + (2 * half + bq) * SEQ + g * 8); }
        __syncthreads();
#pragma unroll
        for (int part = 0; part < 2; ++part) {
            const int ch = part * 1024 + c; const float w0 = cw[ch], w1 = cw[3072 + ch], w2 = cw[6144 + ch], bb = cb[ch];
#pragma unroll
            for (int bq = 0; bq < 2; ++bq) { const LAS bf16* row = rows + (part * 2 + bq) * 2048;
#pragma unroll
                for (int m = 0; m < 8; ++m) { const int t = g + 256 * m;
                    const float p = t > 0 ? bf2f(row[t - 1]) : 0.f, q = bf2f(row[t]), n = t < SEQ - 1 ? bf2f(row[t + 1]) : 0.f;
                    const float r = w0 * p + w1 * q + w2 * n + bb;
                    if (part == 0) { if (bq == 0) vr[m] = r; else vi[m] = r; } else { if (bq == 0) ar[m] = r; else ai[m] = r; } } }
        }
        const float sk0 = skip[c], sk1 = skip[1024 + c];
        float xr[16], xi[16];
#pragma unroll
        for (int m = 0; m < 8; ++m) { xr[m] = vr[m]; xi[m] = vi[m]; xr[m + 8] = 0.f; xi[m + 8] = 0.f; }
        hyena_conv_once(re, im, g, xr, xi, KF + (size_t)c * 2048);
#pragma unroll
        for (int m = 0; m < 8; ++m) { vr[m] = ar[m] * (xr[m] + sk0 * vr[m]); vi[m] = ai[m] * (xi[m] + sk0 * vi[m]); xr[m] = vr[m]; xi[m] = vi[m]; xr[m + 8] = 0.f; xi[m + 8] = 0.f; }
        v4u x2a, x2b;
        { const bf16* src = hyt + (size_t)(2048 + c) * T + (2 * half) * SEQ + g * 8; x2a = *(const v4u*)src; x2b = *(const v4u*)(src + SEQ); }
        hyena_conv_once(re, im, g, xr, xi, KF + (size_t)(1024 + c) * 2048);
        *(LAS v4u*)(rows + g * 8) = x2a; *(LAS v4u*)(rows + 2048 + g * 8) = x2b;
        __syncthreads();
        float* zr = ZT + (size_t)c * T + (2 * half) * SEQ;
        { const int ch = 2048 + c; const float w0 = cw[ch], w1 = cw[3072 + ch], w2 = cw[6144 + ch], bb = cb[ch];
#pragma unroll
          for (int bq = 0; bq < 2; ++bq) { const LAS bf16* row = rows + bq * 2048;
#pragma unroll
            for (int m = 0; m < 8; ++m) { const int t = g + 256 * m;
                const float p = t > 0 ? bf2f(row[t - 1]) : 0.f, q = bf2f(row[t]), n = t < SEQ - 1 ? bf2f(row[t + 1]) : 0.f;
                const float x2 = w0 * p + w1 * q + w2 * n + bb;
                if (bq == 0) zr[t] = x2 * (xr[m] + sk1 * vr[m]); else zr[SEQ + t] = x2 * (xi[m] + sk1 * vi[m]); } } }
    }
    __syncthreads();
}

typedef short ml_bf16x8 __attribute__((ext_vector_type(8)));
typedef short ml_s16x4 __attribute__((ext_vector_type(4)));
typedef float ml_f32x16 __attribute__((ext_vector_type(16)));
typedef __bf16 ml_bf2 __attribute__((ext_vector_type(2)));
constexpr int ML_KROW = 272, ML_VROW = 136, ML_KBUF = 64 * ML_KROW, ML_VBUF = 128 * ML_VROW;
__device__ __forceinline__ unsigned ml_pk(float lo, float hi) { const f32x2 v = {lo, hi}; return __builtin_bit_cast(unsigned, __builtin_convertvector(v, ml_bf2)); }
__device__ __forceinline__ void mlstm_mfma(const Ctx& C) {
    unsigned char* ws = C.ws;
    const bf16* qkc = (const bf16*)(ws + WS_QKC); const bf16* vt = (const bf16*)(ws + WS_HYT) + (size_t)3072 * T;
    const float* GA = (const float*)(ws + WS_GA); const float* GP = (const float*)(ws + WS_GP); const float* GE = (const float*)(ws + WS_GE);
    const bf16* ob = (const bf16*)(ws + WS_OB); bf16* ycat = (bf16*)(ws + (size_t)YCAT_T0 * MiB); const float* mlw = C.A.in[15];
    LAS unsigned char* KB = C.lds; LAS unsigned char* VB = C.lds + 2 * ML_KBUF; LAS float* AS = (LAS float*)(C.lds + 2 * ML_KBUF + 2 * ML_VBUF);
    const int w = C.wave;
    for (int u = blockIdx.x; u < 256; u += C.G) {
        int tid = C.tid; asm volatile("" : "+v"(tid));
        const int lane = tid & 63, r = lane & 31, hh = lane >> 5;
        const int bh = u >> 3, qb = u & 7, b = bh >> 3, h = bh & 7;
        const bf16* kbase = qkc + (size_t)(b * SEQ) * 2048 + 1024 + h * 128;
        const bf16* vbase = vt + (size_t)(h * 128) * T + b * SEQ;
        const int qlo = 256 * qb + 32 * w, tq = qlo + r;
        ml_bf16x8 qf[8];
        { const bf16* qrow = qkc + (size_t)(b * SEQ + tq) * 2048 + h * 128 + 8 * hh;
#pragma unroll
          for (int s = 0; s < 8; ++s) qf[s] = *(const ml_bf16x8*)(qrow + 16 * s); }
        ml_f32x16 O[4];
#pragma unroll 1
        for (int dir = 0; dir < 2; ++dir) {
            const int bhd = bh * 2 + dir;
            __syncthreads();
            for (int i = tid; i < SEQ; i += NTHREADS) AS[i] = GA[bhd * SEQ + i] * 1.4426950408889634f;
            const float pmt = GP[bhd * SEQ + tq] * 1.4426950408889634f;
#pragma unroll
            for (int d = 0; d < 4; ++d)
#pragma unroll
                for (int i = 0; i < 16; ++i) O[d][i] = 0.f;
            float den = 0.f;
            const int kt0 = dir ? 4 * qb : 0, kt1 = dir ? 31 : 4 * qb + 3;
            v4u kr0, kr1, vr0, vr1;
            const unsigned koff0 = (unsigned)((tid >> 4) * 4096 + (tid & 15) * 16), koff1 = koff0 + 32u * 4096u;
            const unsigned voff0 = (unsigned)((tid >> 3) * (T * 2) + (tid & 7) * 16), voff1 = voff0 + 64u * (unsigned)(T * 2);
#define ML_LOAD(kt) do { const char* ku_ = (const char*)kbase + (size_t)(kt) * (64 * 4096); const char* vu_ = (const char*)vbase + (size_t)(kt) * 128; \
                kr0 = *(const v4u*)(ku_ + koff0); kr1 = *(const v4u*)(ku_ + koff1); vr0 = *(const v4u*)(vu_ + voff0); vr1 = *(const v4u*)(vu_ + voff1); } while (0)
#define ML_STORE(buf) do { const int p0 = tid, p1 = tid + 512; \
                *(LAS v4u*)(KB + (buf) * ML_KBUF + (p0 >> 4) * ML_KROW + (p0 & 15) * 16) = kr0; *(LAS v4u*)(KB + (buf) * ML_KBUF + (p1 >> 4) * ML_KROW + (p1 & 15) * 16) = kr1; \
                { LAS unsigned char* d0 = VB + (buf) * ML_VBUF + (p0 >> 3) * ML_VROW + (p0 & 7) * 16; *(LAS v2u*)d0 = (v2u){vr0.x, vr0.y}; *(LAS v2u*)(d0 + 8) = (v2u){vr0.z, vr0.w}; } \
                { LAS unsigned char* d1 = VB + (buf) * ML_VBUF + (p1 >> 3) * ML_VROW + (p1 & 7) * 16; *(LAS v2u*)d1 = (v2u){vr1.x, vr1.y}; *(LAS v2u*)(d1 + 8) = (v2u){vr1.z, vr1.w}; } } while (0)
            ML_LOAD(kt0);
            __syncthreads();
            ML_STORE(0);
            __syncthreads();
#pragma unroll 1
            for (int kt = kt0; kt <= kt1; ++kt) {
                const int cur = (kt - kt0) & 1;
                if (kt < kt1) ML_LOAD(kt + 1);
                const int klo = 64 * kt, khi = klo + 63, qhi = qlo + 31;
                const bool none = dir ? (khi < qlo) : (klo > qhi);
                const bool all = dir ? (klo >= qhi) : (khi <= qlo);
                if (!none) {
                    const LAS unsigned char* Kb = KB + cur * ML_KBUF; const LAS unsigned char* Vb = VB + cur * ML_VBUF;
                    ml_f32x16 S0, S1;
#pragma unroll
                    for (int i = 0; i < 16; ++i) { S0[i] = 0.f; S1[i] = 0.f; }
#pragma unroll
                    for (int s = 0; s < 8; ++s) {
                        const ml_bf16x8 k0 = *(const LAS ml_bf16x8*)(Kb + r * ML_KROW + (16 * s + 8 * hh) * 2);
                        const ml_bf16x8 k1 = *(const LAS ml_bf16x8*)(Kb + (32 + r) * ML_KROW + (16 * s + 8 * hh) * 2);
                        S0 = __builtin_amdgcn_mfma_f32_32x32x16_bf16(k0, qf[s], S0, 0, 0, 0);
                        S1 = __builtin_amdgcn_mfma_f32_32x32x16_bf16(k1, qf[s], S1, 0, 0, 0);
                    }
                    float den1 = 0.f;
#define ML_WGT(COND) do { _Pragma("unroll") for (int kb = 0; kb < 2; ++kb) _Pragma("unroll") for (int g4 = 0; g4 < 4; ++g4) { \
                        const f32x4 a4 = *(const LAS f32x4*)(AS + klo + 32 * kb + 8 * g4 + 4 * hh); \
                        _Pragma("unroll") for (int e = 0; e < 4; ++e) { const int i = 4 * g4 + e; const int cpos = 32 * kb + 8 * g4 + e; (void)cpos; \
                            const float sv = kb ? S1[i] : S0[i]; float p = sv * __builtin_amdgcn_exp2f(a4[e] - pmt); \
                            p = (COND) ? p : 0.f; \
                            if (e & 1) den1 += p; else den += p; \
                            if (kb) S1[i] = p; else S0[i] = p; } } } while (0)
                    if (all) { ML_WGT(true); }
                    else { const int sgn = dir ? -1 : 1, dd = sgn * (tq - klo - 4 * hh);
                        ML_WGT(sgn * cpos <= dd); }
#undef ML_WGT
                    den += den1;
#pragma unroll
                    for (int kb = 0; kb < 2; ++kb)
#pragma unroll
                        for (int s = 0; s < 2; ++s) {
                            v4u pw;
                            if (kb == 0) { pw.x = ml_pk(S0[8 * s], S0[8 * s + 1]); pw.y = ml_pk(S0[8 * s + 2], S0[8 * s + 3]); pw.z = ml_pk(S0[8 * s + 4], S0[8 * s + 5]); pw.w = ml_pk(S0[8 * s + 6], S0[8 * s + 7]); }
                            else { pw.x = ml_pk(S1[8 * s], S1[8 * s + 1]); pw.y = ml_pk(S1[8 * s + 2], S1[8 * s + 3]); pw.z = ml_pk(S1[8 * s + 4], S1[8 * s + 5]); pw.w = ml_pk(S1[8 * s + 6], S1[8 * s + 7]); }
                            const ml_bf16x8 pf = __builtin_bit_cast(ml_bf16x8, pw);
#pragma unroll
                            for (int db = 0; db < 4; ++db) {
                                const LAS unsigned char* vp = Vb + (32 * db + r) * ML_VROW + 2 * (32 * kb + 16 * s + 4 * hh);
                                const ml_s16x4 lo = *(const LAS ml_s16x4*)vp, hi = *(const LAS ml_s16x4*)(vp + 16);
                                const ml_bf16x8 vf = __builtin_shufflevector(lo, hi, 0, 1, 2, 3, 4, 5, 6, 7);
                                O[db] = __builtin_amdgcn_mfma_f32_32x32x16_bf16(vf, pf, O[db], 0, 0, 0);
                            }
                        }
                }
                if (kt < kt1) ML_STORE(cur ^ 1);
                __syncthreads();
            }
#undef ML_LOAD
#undef ML_STORE
            den += __shfl_xor(den, 32);
            const float scl = 1.0f / fmaxf(fabsf(den), GE[bhd * SEQ + tq]);
            int th = tid; asm volatile("" : "+v"(th));
            v4u* hp = (v4u*)(ws + WS_HML) + ((size_t)u * NTHREADS + th) * 8;
            if (dir == 0) {
#pragma unroll
                for (int db = 0; db < 4; ++db)
#pragma unroll
                    for (int q2 = 0; q2 < 2; ++q2) { v4u pk;
#pragma unroll
                        for (int j = 0; j < 4; ++j) pk[j] = ml_pk(O[db][8 * q2 + 2 * j] * scl, O[db][8 * q2 + 2 * j + 1] * scl);
                        hp[db * 2 + q2] = pk; }
            } else {
#pragma unroll
                for (int db = 0; db < 4; ++db)
#pragma unroll
                    for (int q2 = 0; q2 < 2; ++q2) { const v4u pk = hp[db * 2 + q2];
#pragma unroll
                        for (int j = 0; j < 4; ++j) { O[db][8 * q2 + 2 * j] = O[db][8 * q2 + 2 * j] * scl + bflo(pk[j]); O[db][8 * q2 + 2 * j + 1] = O[db][8 * q2 + 2 * j + 1] * scl + bfhi(pk[j]); } }
            }
        }
        float sm = 0.f;
#pragma unroll
        for (int db = 0; db < 4; ++db)
#pragma unroll
            for (int i = 0; i < 16; ++i) sm += O[db][i];
        sm += __shfl_xor(sm, 32);
        const float mu = sm * (1.0f / 128.0f); float qv = 0.f;
#pragma unroll
        for (int db = 0; db < 4; ++db)
#pragma unroll
            for (int i = 0; i < 16; ++i) { O[db][i] -= mu; qv += O[db][i] * O[db][i]; }
        qv += __shfl_xor(qv, 32);
        const float rstd = 1.0f / sqrtf(qv * (1.0f / 128.0f) + LN_EPS);
        LAS unsigned char* TB = C.lds;
        int te = tid; asm volatile("" : "+v"(te));
        __syncthreads();
        if (te < 128) AS[te] = mlw[h * 128 + te];
#pragma unroll
        for (int i = 0; i < 8; ++i) { const int pc = te + 512 * i, row = pc >> 4, ch = pc & 15;
            *(LAS v4u*)(TB + row * 272 + ch * 16) = *(const v4u*)(ob + (size_t)(b * SEQ + 256 * qb + row) * 1024 + h * 128 + ch * 8); }
        __syncthreads();
        LAS unsigned char* myrow = TB + (32 * w + (te & 31)) * 272 + 8 * ((te & 63) >> 5);
#pragma unroll
        for (int db = 0; db < 4; ++db)
#pragma unroll
            for (int g4 = 0; g4 < 4; ++g4) {
                const int dim = 32 * db + 8 * g4 + 4 * ((te & 63) >> 5); const f32x4 gw = *(const LAS f32x4*)(AS + dim);
                LAS v2u* pp = (LAS v2u*)(myrow + (32 * db + 8 * g4) * 2); const v2u ow = *pp;
                const float o0 = bflo(ow.x), o1 = bfhi(ow.x), o2 = bflo(ow.y), o3 = bfhi(ow.y);
                const float y0 = O[db][4 * g4] * rstd * gw.x / (1.0f + __expf(-o0)), y1 = O[db][4 * g4 + 1] * rstd * gw.y / (1.0f + __expf(-o1));
                const float y2 = O[db][4 * g4 + 2] * rstd * gw.z / (1.0f + __expf(-o2)), y3 = O[db][4 * g4 + 3] * rstd * gw.w / (1.0f + __expf(-o3));
                *pp = (v2u){ml_pk(y0, y1), ml_pk(y2, y3)};
            }
        __syncthreads();
#pragma unroll
        for (int i = 0; i < 8; ++i) { const int pc = te + 512 * i, row = pc >> 4, ch = pc & 15;
#if OUTPROJ_F8
            { const v4u t8 = *(const LAS v4u*)(TB + row * 272 + ch * 16); v2u o8; o8.x = pk4_fp8(bflo(t8.x) * Y8_SCALE, bfhi(t8.x) * Y8_SCALE, bflo(t8.y) * Y8_SCALE, bfhi(t8.y) * Y8_SCALE); o8.y = pk4_fp8(bflo(t8.z) * Y8_SCALE, bfhi(t8.z) * Y8_SCALE, bflo(t8.w) * Y8_SCALE, bfhi(t8.w) * Y8_SCALE);
              *(v2u*)((unsigned char*)ycat + (size_t)(b * SEQ + 256 * qb + row) * 2048 + 1024 + h * 128 + ch * 8) = o8; } }
#else
            *(v4u*)(ycat + (size_t)(b * SEQ + 256 * qb + row) * 2048 + 1024 + h * 128 + ch * 8) = *(const LAS v4u*)(TB + row * 272 + ch * 16); }
#endif
    }
    __syncthreads();
}

__device__ __forceinline__ void phase4(const Ctx& C) {
    unsigned char* ws = C.ws;
    const float* ZT = (const float*)(ws + WS_ZT); const float* HML = (const float*)(ws + WS_HML); const bf16* ob = (const bf16*)(ws + WS_OB);
    bf16* ycat = (bf16*)(ws + (size_t)YCAT_T0 * MiB); const float* hyw = C.A.in[12]; const float* mlw = C.A.in[15];
    const int lane = C.lane;
    {
        LAS float* red = (LAS float*)C.lds;
        for (int u = blockIdx.x; u < 128 * 8; u += C.G) {
            const int tt = u >> 3, gi = u & 7, tok = tt * 64 + lane, ch0 = gi * 128 + C.wave * 16;
            float x[16]; float s = 0.f;
#pragma unroll
            for (int i = 0; i < 16; ++i) { x[i] = ZT[(size_t)(ch0 + i) * T + tok]; s += x[i]; }
            __syncthreads();
            red[C.wave * 64 + lane] = s;
            __syncthreads();
            float tot = 0.f;
#pragma unroll
            for (int w = 0; w < 8; ++w) tot += red[w * 64 + lane];
            const float mu = tot * (1.0f / 128.0f); float q = 0.f;
#pragma unroll
            for (int i = 0; i < 16; ++i) { x[i] -= mu; q += x[i] * x[i]; }
            __syncthreads();
            red[C.wave * 64 + lane] = q;
            __syncthreads();
            float qt = 0.f;
#pragma unroll
            for (int w = 0; w < 8; ++w) qt += red[w * 64 + lane];
            const float rstd = 1.0f / sqrtf(qt * (1.0f / 128.0f) + LN_EPS);
            float y[16];
#pragma unroll
            for (int i = 0; i < 16; ++i) y[i] = x[i] * rstd * hyw[ch0 + i];
            v4u w0, w1; w0.x = pk2(y[0], y[1]); w0.y = pk2(y[2], y[3]); w0.z = pk2(y[4], y[5]); w0.w = pk2(y[6], y[7]);
            w1.x = pk2(y[8], y[9]); w1.y = pk2(y[10], y[11]); w1.z = pk2(y[12], y[13]); w1.w = pk2(y[14], y[15]);
#if OUTPROJ_F8
            {
#pragma unroll
              for (int i = 0; i < 16; ++i) y[i] *= Y8_SCALE;
              v4u o8; o8.x = pk4_fp8(y[0], y[1], y[2], y[3]); o8.y = pk4_fp8(y[4], y[5], y[6], y[7]); o8.z = pk4_fp8(y[8], y[9], y[10], y[11]); o8.w = pk4_fp8(y[12], y[13], y[14], y[15]);
              *(v4u*)((unsigned char*)ycat + (size_t)tok * 2048 + ch0) = o8; (void)w0; (void)w1; }
#else
            bf16* dst = ycat + (size_t)tok * 2048 + ch0;
            *(v4u*)dst = w0; *(v4u*)(dst + 8) = w1;
#endif
        }
        __syncthreads();
    }
}

struct TileOrder {
    int nM, nN, a0, b0, G, c;
    __device__ __forceinline__ bool next(int i, pg8::Unit& u) const {
        const int nwg = nM * nN; const int L = i * G + c; if (L >= nwg) return false;
        int w; { const int q = nwg / 8, r = nwg % 8, xcd = L % 8, off = L / 8; w = (xcd < r ? xcd * (q + 1) : r * (q + 1) + (xcd - r) * q) + off; }
        const int nig = 8 * nN, gid = w / nig, wi = w % nig; u.pm = a0 + gid * 8 + (wi % 8); u.pn = b0 + wi / 8; return true;
    }
    __device__ __forceinline__ void a_ready(const pg8::Unit&) const {}
    __device__ __forceinline__ void done(const pg8::Unit&) const {}
};
struct EpiOut {
    static constexpr bool PERM = false, AFTER_DRAIN = false, F8 = OUTPROJ_F8 != 0;
    const float* x; const float* bias; float* r1;
    __device__ __forceinline__ void operator()(const pg8::f32x4 (&acc)[2][2][4][2], const pg8::Unit& u, int wr, int wc, int fr, int fq) const {
        constexpr int TS = OUTPROJ_F8 ? 2 : 1; constexpr float WSC = OUTPROJ_F8 ? 1.0f / (W8_SCALE * Y8_SCALE) : 1.0f;
        const int row0 = (u.pm - TS * YCAT_T0) * 256 + wr * 64 + fr, col0 = (u.pn - TS * WOUT_T0) * 256 + wc * 32 + 4 * fq;
        pg8::f32x4 bv[2][2];
#pragma unroll
        for (int bj = 0; bj < 2; ++bj)
#pragma unroll
            for (int n = 0; n < 2; ++n) bv[bj][n] = *(const pg8::f32x4*)(bias + col0 + bj * 128 + n * 16);
#pragma unroll
        for (int ai = 0; ai < 2; ++ai)
#pragma unroll
            for (int mp = 0; mp < 2; ++mp) { pg8::f32x4 xs[2][2][2];
#pragma unroll
                for (int mm = 0; mm < 2; ++mm) { const size_t off = (size_t)(row0 + ai * 128 + (2 * mp + mm) * 16) * D + col0;
#pragma unroll
                    for (int bj = 0; bj < 2; ++bj)
#pragma unroll
                        for (int n = 0; n < 2; ++n) xs[mm][bj][n] = *(const pg8::f32x4*)(x + off + bj * 128 + n * 16); }
#pragma unroll
                for (int mm = 0; mm < 2; ++mm) { const int m = 2 * mp + mm; const size_t off = (size_t)(row0 + ai * 128 + m * 16) * D + col0;
#pragma unroll
                    for (int bj = 0; bj < 2; ++bj)
#pragma unroll
                        for (int n = 0; n < 2; ++n) *(pg8::f32x4*)(r1 + off + bj * 128 + n * 16) = xs[mm][bj][n] * DN_ALPHA + acc[ai][bj][m][n] * WSC + bv[bj][n]; } }
    }
};

#define P6_RS_STEP(NV, XM) do { const bool up = (lane & (XM)) != 0; _Pragma("unroll") for (int e_ = 0; e_ < (NV); ++e_) { \
        const float keep0 = up ? a0[e_ + (NV)] : a0[e_], send0 = up ? a0[e_] : a0[e_ + (NV)]; a0[e_] = keep0 + __shfl_xor(send0, (XM)); \
        const float keep1 = up ? a1[e_ + (NV)] : a1[e_], send1 = up ? a1[e_] : a1[e_ + (NV)]; a1[e_] = keep1 + __shfl_xor(send1, (XM)); } } while (0)
__device__ __forceinline__ void phase6(const Ctx& C, int dummy) {
    unsigned char* ws = C.ws;
    float* r1 = (float*)(ws + WS_R1); bf16* x1b = (bf16*)(ws + (size_t)X1B_T0 * MiB);
    const float* g1 = C.A.in[18]; const float* b1 = C.A.in[19]; const float* rw = C.A.in[20]; const float* rb = C.A.in[21];
    unsigned* cnt = (unsigned*)(ws + WS_CTL) + CW_CNT + (dummy ? 4096 : 0); int* list = (int*)(ws + (dummy ? WS_YBUF : WS_LIST)); float* tokw = (float*)(ws + (dummy ? WS_YBUF + 2 * MiB : WS_TOKW));
    const int lane = C.lane;
    LAS unsigned char* wbuf = C.lds;
    LAS unsigned* hist = (LAS unsigned*)(C.lds + 65536); LAS unsigned* hbase = hist + 32;
    if (C.tid < NE) hist[C.tid] = 0u;
    __syncthreads();
    for (int it = blockIdx.x; it < T / 16; it += C.G) {
        const int pair = it * 8 + C.wave;
        int ln = lane; asm volatile("" : "+v"(ln));
        f32x4 v0[8], v1[8];
        f32x4 gg8[8], bb8[8];
#pragma unroll
        for (int j = 0; j < 8; ++j) { const int c0 = (ln + 64 * j) * 4; v0[j] = *(const f32x4*)(r1 + (size_t)(2 * pair) * D + c0); v1[j] = *(const f32x4*)(r1 + (size_t)(2 * pair + 1) * D + c0);
            gg8[j] = *(const f32x4*)(g1 + c0); bb8[j] = *(const f32x4*)(b1 + c0); }
#pragma unroll
        for (int tk = 0; tk < 2; ++tk) {
            const int tok = 2 * pair + tk; f32x4 v[8]; float s = 0.f;
#pragma unroll
            for (int j = 0; j < 8; ++j) { v[j] = tk ? v1[j] : v0[j]; s += (v[j].x + v[j].y) + (v[j].z + v[j].w); }
            const float mean = wave_sum(s) * (1.0f / D); float q = 0.f;
#pragma unroll
            for (int j = 0; j < 8; ++j) { v[j] = v[j] - mean; q += (v[j].x * v[j].x + v[j].y * v[j].y) + (v[j].z * v[j].z + v[j].w * v[j].w); }
            const float rstd = 1.0f / sqrtf(wave_sum(q) * (1.0f / D) + LN_EPS);
#pragma unroll
            for (int j = 0; j < 8; ++j) { const int c0 = (ln + 64 * j) * 4; const f32x4 gg = gg8[j], bb = bb8[j];
                const f32x4 y = v[j] * rstd * gg + bb;
                if (!dummy) { v2u w; w.x = pk2(y.x, y.y); w.y = pk2(y.z, y.w); *(v2u*)(x1b + (size_t)tok * D + c0) = w; }
                if (!dummy) { unsigned q8 = 0u; q8 = __builtin_amdgcn_cvt_pk_fp8_f32(y.x, y.y, q8, false); q8 = __builtin_amdgcn_cvt_pk_fp8_f32(y.z, y.w, q8, true); *(unsigned*)(ws + WS_X1Q + (size_t)tok * D + c0) = q8; }
                if (tk == 0) v0[j] = y; else v1[j] = y; }
        }
        int my_e0 = 0, my_r0 = 0, my_e1 = 0, my_r1 = 0;
        float a0[32], a1[32];
#pragma unroll
        for (int e = 0; e < 32; ++e) { a0[e] = 0.f; a1[e] = 0.f; }
        const int tid = C.tid; f32x4 st[4];
        const bool hi8 = (ln & 8) != 0;
        const unsigned rdoff = (unsigned)(4 * ln) * 128u, rdx = (unsigned)(ln & 7);
#define P6_CHUNK_LOAD(j_) do { _Pragma("unroll") for (int r_ = 0; r_ < 4; ++r_) st[r_] = *(const f32x4*)(rw + (size_t)(j_) * 8192 + (size_t)(tid + 512 * r_) * 4); } while (0)
#define P6_CHUNK_STORE(b_) do { _Pragma("unroll") for (int r_ = 0; r_ < 4; ++r_) { const int idx_ = tid + 512 * r_, row_ = idx_ >> 3, q_ = idx_ & 7; \
            *(LAS f32x4*)(wbuf + (b_) * 32768 + row_ * 128 + 16 * (q_ ^ ((row_ >> 2) & 7))) = st[r_]; } } while (0)
        __syncthreads();
        P6_CHUNK_LOAD(0); P6_CHUNK_STORE(0);
        __syncthreads();
#pragma unroll
        for (int j = 0; j < 8; ++j) {
            if (j < 7) P6_CHUNK_LOAD(j + 1);
            const LAS unsigned char* wb = wbuf + (j & 1) * 32768 + rdoff;
#pragma unroll
            for (int i = 0; i < 4; ++i) {
                const float x0 = hi8 ? v0[j][i ^ 1] : v0[j][i], x1 = hi8 ? v1[j][i ^ 1] : v1[j][i];
                const LAS unsigned char* wrow = wb + (hi8 ? (i ^ 1) : i) * 128;
#pragma unroll
                for (int q4 = 0; q4 < 8; ++q4) { const f32x4 w4 = *(const LAS f32x4*)(wrow + 16 * (q4 ^ rdx));
                    a0[4 * q4] += x0 * w4.x; a0[4 * q4 + 1] += x0 * w4.y; a0[4 * q4 + 2] += x0 * w4.z; a0[4 * q4 + 3] += x0 * w4.w;
                    a1[4 * q4] += x1 * w4.x; a1[4 * q4 + 1] += x1 * w4.y; a1[4 * q4 + 2] += x1 * w4.z; a1[4 * q4 + 3] += x1 * w4.w; }
            }
            if (j < 7) P6_CHUNK_STORE((j + 1) & 1);
            __syncthreads();
        }
#undef P6_CHUNK_LOAD
#undef P6_CHUNK_STORE
        P6_RS_STEP(16, 32); P6_RS_STEP(8, 16); P6_RS_STEP(4, 8); P6_RS_STEP(2, 4); P6_RS_STEP(1, 2);
        int le_ = lane; asm volatile("" : "+v"(le_));
        const int e = le_ >> 1; const float rbe = rb[e];
        float lg0 = a0[0] + __shfl_xor(a0[0], 1) + rbe, lg1 = a1[0] + __shfl_xor(a1[0], 1) + rbe;
#pragma unroll
        for (int tk = 0; tk < 2; ++tk) {
            const int tok = 2 * pair + tk; float val = tk ? lg1 : lg0; float vals[4]; int idxs[4];
#pragma unroll
            for (int k = 0; k < 4; ++k) {
                const float m = wave_max(val);
                const unsigned long long bal = __ballot(val == m);
                const int idx = (int)(__builtin_ctzll(bal) >> 1);
                vals[k] = m; idxs[k] = idx;
                if (e == idx) val = -3.0e38f;
            }
            const float e1 = expf(vals[1] - vals[0]), e2 = expf(vals[2] - vals[0]), e3 = expf(vals[3] - vals[0]);
            const float inv = 1.0f / (1.0f + e1 + e2 + e3);
            if (lane < 4) {
                const int sel_e = lane == 0 ? idxs[0] : lane == 1 ? idxs[1] : lane == 2 ? idxs[2] : idxs[3];
                const float sel_v = (lane == 0 ? 1.0f : lane == 1 ? e1 : lane == 2 ? e2 : e3) * inv;
                tokw[tok * 4 + lane] = sel_v;
                const int rk = (int)__hip_atomic_fetch_add(hist + sel_e, 1u, __ATOMIC_RELAXED, __HIP_MEMORY_SCOPE_WORKGROUP);
                if (tk == 0) { my_e0 = sel_e; my_r0 = rk; } else { my_e1 = sel_e; my_r1 = rk; }
            }
        }
        __syncthreads();
        int tl = C.tid; asm volatile("" : "+v"(tl));
        if (tl < NE) { const unsigned n = hist[tl]; hbase[tl] = n ? atomicAdd(cnt + 64 * tl, n) : 0u; }
        __syncthreads();
        if (lane < 4) { list[my_e0 * T + (int)hbase[my_e0] + my_r0] = (2 * pair) * 4 + lane; list[my_e1 * T + (int)hbase[my_e1] + my_r1] = (2 * pair + 1) * 4 + lane; }
        __syncthreads();
        if (tl < NE) hist[tl] = 0u;
    }
}
#undef P6_RS_STEP

__device__ __forceinline__ void moe_build_tb(const Ctx& C) {
    LAS int* tb = (LAS int*)(C.lds + LDS_TB);
    __syncthreads();
    if (C.tid < NE) { const unsigned* cnt = (const unsigned*)(C.ws + WS_CTL) + CW_CNT; tb[40 + C.tid] = (int)__hip_atomic_load(cnt + 64 * C.tid, __ATOMIC_RELAXED, __HIP_MEMORY_SCOPE_AGENT); }
    __syncthreads();
    if (C.tid == 0) { int acc = 0;
        for (int e = 0; e < NE; ++e) { const int n = tb[40 + e]; tb[e] = acc; acc += (n + 255) >> 8; }
        tb[32] = acc; }
    __syncthreads();
}
struct MoeOrder {
    const LAS int* tb; int NJ, a0, w0, G, c; const int* list; int gather;
    const LAS int* ul; const LAS int* rowt;
    __device__ __forceinline__ bool compute(int i, pg8::Unit& u) const {
        const int nwg = tb[32] * NJ; const int L = i * G + c; if (L >= nwg) return false;
        int w; { const int q = nwg / 8, r = nwg % 8, xcd = L % 8, off = L / 8; w = (xcd < r ? xcd * (q + 1) : r * (q + 1) + (xcd - r) * q) + off; }
        int e = 0;
        while (e < NE - 1 && tb[e + 1] * NJ <= w) ++e;
        const int local = w - tb[e] * NJ, nt = tb[e + 1] - tb[e], j = local / nt, ti = local - j * nt;
        u.pm = a0 + tb[e] + ti; u.pn = w0 + e * NJ + j; return true;
    }
    __device__ __forceinline__ bool next(int i, pg8::Unit& u) const {
        if (i < MOE_MAXU) { const int pm = __builtin_amdgcn_readfirstlane(ul[i]); if (pm < 0) return false; u.pm = pm; u.pn = __builtin_amdgcn_readfirstlane(ul[16 + i]); return true; }
        pg8::Unit t; const bool ok = compute(i, t); if (!ok) return false; u.pm = __builtin_amdgcn_readfirstlane(t.pm); u.pn = __builtin_amdgcn_readfirstlane(t.pn); return true;
    }
    __device__ __forceinline__ int row_slow(const pg8::Unit& u, int r) const { const int e = (u.pn - w0) / NJ; const int i = (u.pm - a0 - tb[e]) * 256 + r, n = tb[40 + e];
        const int v = list[e * T + (i < n ? i : (n > 0 ? n - 1 : 0))] >> 2; return i < n ? v : 0; }
    __device__ __forceinline__ int a_row(const pg8::Unit& u, int idx, int r) const { if (!gather) return (u.pm - a0) * 256 + r; if (idx < MOE_MAXU) return rowt[idx * 256 + r]; return row_slow(u, r); }
    __device__ __forceinline__ int b_tile(const pg8::Unit& u) const { return u.pn - w0; }
    __device__ __forceinline__ void a_ready(const pg8::Unit&) const {}
    __device__ __forceinline__ void done(const pg8::Unit&) const {}
    __device__ __forceinline__ void setup(int tid) const {
        LAS int* ulw = (LAS int*)ul; LAS int* rtw = (LAS int*)rowt;
        if (tid < MOE_MAXU) { pg8::Unit t; const bool ok = compute(tid, t); ulw[tid] = ok ? t.pm : -1; ulw[16 + tid] = ok ? t.pn : 0; }
        __syncthreads();
        if (gather) for (int idx = tid; idx < MOE_MAXU * 256; idx += NTHREADS) { const int i = idx >> 8; const int pm = ul[i]; if (pm >= 0) { pg8::Unit t; t.pm = pm; t.pn = ul[16 + i]; rtw[idx] = row_slow(t, idx & 255); } }
        __syncthreads();
    }
};
struct EpiGU {
    static constexpr bool PERM = true, AFTER_DRAIN = false, F8 = true;
    const float* b_gu; unsigned char* act; float wsc;
    __device__ __forceinline__ void operator()(const pg8::f32x4 (&acc)[2][2][4][2], const pg8::Unit& u, int wr, int wc, int fr_, int fq_) const {
        int ln_ = threadIdx.x & 63; asm volatile("" : "+v"(ln_));
        const int fr = ln_ & 15, fq = ln_ >> 4;
        using pg8::cvt_pk_bf16;
        const int rt = u.pm - ABUF_T0, rel = u.pn - WGU_Q0, e = rel >> 4, j = rel & 15;
        const int col0 = j * 128 + wc * 32 + 8 * fq;
        pg8::f32x4 bg[2], bu[2];
#pragma unroll
        for (int n = 0; n < 2; ++n) { bg[n] = *(const pg8::f32x4*)(b_gu + (size_t)e * 4096 + col0 + 4 * n); bu[n] = *(const pg8::f32x4*)(b_gu + (size_t)e * 4096 + 2048 + col0 + 4 * n); }
#pragma unroll
        for (int ai = 0; ai < 2; ++ai)
#pragma unroll
            for (int m = 0; m < 4; ++m) { const int row = rt * 256 + ai * 128 + wr * 64 + m * 16 + fr;
                float o[8];
#pragma unroll
                for (int n = 0; n < 2; ++n) { const pg8::f32x4 g = acc[ai][0][m][n] * wsc + bg[n], up = acc[ai][1][m][n] * wsc + bu[n];
#pragma unroll
                    for (int i = 0; i < 4; ++i) { const float gc = fminf(g[i], 7.0f), uc = fminf(fmaxf(up[i], -7.0f), 7.0f);
                        o[4 * n + i] = (uc + 1.0f) * (gc / (1.0f + __expf(-1.702f * gc))); } }
                v2u w; w.x = __builtin_amdgcn_cvt_pk_fp8_f32(o[0], o[1], 0u, false); w.x = __builtin_amdgcn_cvt_pk_fp8_f32(o[2], o[3], w.x, true);
                w.y = __builtin_amdgcn_cvt_pk_fp8_f32(o[4], o[5], 0u, false); w.y = __builtin_amdgcn_cvt_pk_fp8_f32(o[6], o[7], w.y, true);
                *(v2u*)(act + (size_t)row * DFF + col0) = w; }
    }
};
struct EpiDown {
    static constexpr bool PERM = true, AFTER_DRAIN = false, F8 = true;
    const float* b_down; const int* list; const float* tokw; const LAS int* tb; bf16* ybuf; float wsc;
    __device__ __forceinline__ void operator()(const pg8::f32x4 (&acc)[2][2][4][2], const pg8::Unit& u, int wr, int wc, int fr_, int fq_) const {
        using pg8::cvt_pk_bf16;
        int ln_ = threadIdx.x & 63; asm volatile("" : "+v"(ln_));
        const int fr = ln_ & 15, fq = ln_ >> 4;
        const int rel = u.pn - WDN_Q0, e = rel >> 3, j = rel & 7, ti = u.pm - ACT_Q0 - tb[e], n_e = tb[40 + e];
        const int col0 = j * 256 + wc * 32 + 8 * fq;
        pg8::f32x4 bv[2][2];
#pragma unroll
        for (int bj = 0; bj < 2; ++bj)
#pragma unroll
            for (int n = 0; n < 2; ++n) bv[bj][n] = *(const pg8::f32x4*)(b_down + (size_t)e * D + col0 + bj * 128 + 4 * n);
        int slot8[2][4]; float w8[2][4];
#pragma unroll
        for (int ai = 0; ai < 2; ++ai)
#pragma unroll
            for (int m = 0; m < 4; ++m) { const int i = ti * 256 + ai * 128 + wr * 64 + m * 16 + fr; slot8[ai][m] = list[e * T + (i < n_e ? i : (n_e > 0 ? n_e - 1 : 0))]; }
#pragma unroll
        for (int ai = 0; ai < 2; ++ai)
#pragma unroll
            for (int m = 0; m < 4; ++m) w8[ai][m] = tokw[slot8[ai][m]];
#pragma unroll
        for (int ai = 0; ai < 2; ++ai)
#pragma unroll
            for (int m = 0; m < 4; ++m) { const int i = ti * 256 + ai * 128 + wr * 64 + m * 16 + fr;
                { const int slot = (i < n_e) ? slot8[ai][m] : 32768; const float w = w8[ai][m]; bf16* dst = ybuf + (size_t)slot * D + col0;
#pragma unroll
                    for (int bj = 0; bj < 2; ++bj) { const pg8::f32x4 v0 = (acc[ai][bj][m][0] * wsc + bv[bj][0]) * w, v1 = (acc[ai][bj][m][1] * wsc + bv[bj][1]) * w;
                        v4u o; o.x = cvt_pk_bf16(v0[0], v0[1]); o.y = cvt_pk_bf16(v0[2], v0[3]); o.z = cvt_pk_bf16(v1[0], v1[1]); o.w = cvt_pk_bf16(v1[2], v1[3]);
                        *(v4u*)(dst + bj * 128) = o; } } }
    }
};

namespace pg8 {
template <class Epi, class Sched, class Side>
__device__ __forceinline__ void gemm_phase_ga(PG8_LAS unsigned char* lds, const bf16_t* Arows, const bf16_t* Btiles, const int K, const Sched& S, const Epi& E, const Side& SD) {
    const int tid = threadIdx.x, wid = __builtin_amdgcn_readfirstlane(tid >> 6), lane = tid & 63, wr = wid >> 2, wc = wid & 3, fr = lane & 15, fq = lane >> 4;
    const int nt = K / BK;
    unsigned voffB[2];
#pragma unroll
    for (int i = 0; i < 2; ++i) { int R, Cc; stage_rc(tid * 16 + i * 8192, R, Cc); const int Rb = Epi::PERM ? ((R & ~31) + perm32(R & 31)) : R; voffB[i] = (unsigned)(Rb * K + Cc) * 2u; }
    const size_t kstep = (size_t)(BK * 2), hstep = (size_t)HALF * K * 2, tstep = 2 * hstep;
    const unsigned ldsw = (unsigned)wid * 1024u;
    const int aoff = lds_byte(wr * 64 + fr, fq * 8), boff = lds_byte(wc * 32 + fr, fq * 8);
#define PG8_SA(b, h) (((b) * 2 + (h)) * HTB)
#define PG8_SB(b, h) ((4 + (b) * 2 + (h)) * HTB)
    const unsigned ldsb = __builtin_amdgcn_readfirstlane((unsigned)(size_t)lds + ldsw);
#define PG8_DMA(gptr, vo, laddr) asm volatile("s_mov_b32 m0, %2\n\tglobal_load_lds_dwordx4 %0, %1" :: "v"(vo), "s"(gptr), "s"(laddr) : "memory", "m0")
#define PG8_STAGE(bufoff, gbase, voff) do { _Pragma("unroll") for (int _i = 0; _i < 2; ++_i) PG8_DMA((const char*)(gbase), (voff)[_i], ldsb + (unsigned)((bufoff) + _i * 8192)); } while (0)
#define PG8_STAGE2(bufoff, gbase, v0, v1) do { PG8_DMA((const char*)(gbase), v0, ldsb + (unsigned)(bufoff)); PG8_DMA((const char*)(gbase), v1, ldsb + (unsigned)((bufoff) + 8192)); } while (0)
#define PG8_LDA(dst, b, h) do { _Pragma("unroll") for (int m = 0; m < 4; ++m) _Pragma("unroll") for (int k = 0; k < 2; ++k) dst[m][k] = *(const PG8_LAS bf16x8*)(lds + PG8_SA(b, h) + aoff + m * 2048 + k * 1024); } while (0)
#define PG8_LDB(dst, b, h) do { _Pragma("unroll") for (int n = 0; n < 2; ++n) _Pragma("unroll") for (int k = 0; k < 2; ++k) dst[n][k] = *(const PG8_LAS bf16x8*)(lds + PG8_SB(b, h) + boff + n * 2048 + k * 1024); } while (0)
#define PG8_MMA(ai, bj, At, Bt) do { __builtin_amdgcn_s_setprio(1); if constexpr (epi_f8<Epi>::v) { _Pragma("unroll") for (int m = 0; m < 4; ++m) _Pragma("unroll") for (int n = 0; n < 2; ++n) \
        acc[ai][bj][m][n] = __builtin_amdgcn_mfma_scale_f32_16x16x128_f8f6f4(cat8(Bt[n][0], Bt[n][1]), cat8(At[m][0], At[m][1]), acc[ai][bj][m][n], 0, 0, 0, 0, 0, 0); } else { \
        _Pragma("unroll") for (int m = 0; m < 4; ++m) _Pragma("unroll") for (int n = 0; n < 2; ++n) _Pragma("unroll") for (int k = 0; k < 2; ++k) \
        acc[ai][bj][m][n] = __builtin_amdgcn_mfma_f32_16x16x32_bf16(Bt[n][k], At[m][k], acc[ai][bj][m][n], 0, 0, 0); } __builtin_amdgcn_s_setprio(0); } while (0)
#define PG8_WAIT_V(n) asm volatile("s_waitcnt vmcnt(" #n ")" ::: "memory")
#define PG8_WAIT_L(n) asm volatile("s_waitcnt lgkmcnt(" #n ")" ::: "memory")
#define PG8_BAR __builtin_amdgcn_s_barrier()
#define PG8_SCHED __builtin_amdgcn_sched_barrier(0)
#define PG8_AROWS(vo, u, ix) do { int t_ = threadIdx.x; asm volatile("" : "+v"(t_)); _Pragma("unroll") for (int _i = 0; _i < 2; ++_i) { int R_, C_; stage_rc(t_ * 16 + _i * 8192, R_, C_); \
        _Pragma("unroll") for (int _h = 0; _h < 2; ++_h) vo[_h * 2 + _i] = (unsigned)S.a_row(u, ix, _h * 128 + R_) * (unsigned)(K * 2) + (unsigned)(C_ * 2); } } while (0)
    const int skh = 0, snq = wid;
#define PG8_SGV() ({ int t_ = tid; asm volatile("" : "+v"(t_)); (unsigned)((4 * (t_ & 31)) * SD.ldb + 4 * ((t_ >> 5) & 1)) * 4u; })
#define PG8_SDV() ({ int t_ = tid; asm volatile("" : "+v"(t_)); (unsigned)(4 * ((t_ >> 5) & 1)) * 2048u + 4u * (unsigned)(t_ & 31); })
    const size_t sldb4 = Side::ON ? (size_t)SD.ldb * 4 : 0;
    int sstep = Side::ON ? SD.first : 0, sprev = 0, sit = (int)(blockIdx.x >> 3) % Side::PERIOD, sext = 0, sage = 0; bool spend = false;
    f32x4 sx[4] = {(f32x4){0.f, 0.f, 0.f, 0.f}, (f32x4){0.f, 0.f, 0.f, 0.f}, (f32x4){0.f, 0.f, 0.f, 0.f}, (f32x4){0.f, 0.f, 0.f, 0.f}};
    typedef unsigned u32x2s __attribute__((ext_vector_type(2)));
#define PG8_SIDE_LOAD() do { const char* sp_ = (const char*)SD.src(sstep, skh, snq); const unsigned sgv = PG8_SGV(); _Pragma("unroll") for (int _j = 0; _j < 4; ++_j) \
        asm volatile("global_load_dwordx4 %0, %1, %2" : "+v"(sx[_j]) : "v"(sgv), "s"(sp_ + (size_t)_j * sldb4) : "memory"); sprev = sstep; sstep += SD.stride; } while (0)
#define PG8_SIDE_STORE() do { asm volatile("" : "+v"(sx[0]), "+v"(sx[1]), "+v"(sx[2]), "+v"(sx[3])); \
        char* dp_ = (char*)SD.dst(sprev, skh, snq); const unsigned sdv = PG8_SDV(); _Pragma("unroll") for (int _i = 0; _i < 4; ++_i) { unsigned _w = 0u; \
            _w = __builtin_amdgcn_cvt_pk_fp8_f32(sx[0][_i] * W8_SCALE, sx[1][_i] * W8_SCALE, _w, false); _w = __builtin_amdgcn_cvt_pk_fp8_f32(sx[2][_i] * W8_SCALE, sx[3][_i] * W8_SCALE, _w, true); \
            asm volatile("global_store_dword %0, %1, %2" :: "v"(sdv), "v"(_w), "s"(dp_ + (size_t)_i * 2048) : "memory"); } } while (0)
#define PG8_SIDE_SLOT() do { if constexpr (Side::ON && Side::PAIR) { int ext_ = 0; if (spend) { PG8_SIDE_STORE(); spend = false; ext_ += 4; } \
        if (sstep < SD.nsteps) { PG8_SIDE_LOAD(); spend = true; ext_ += 4; } sext = ext_; } else if constexpr (Side::ON) { int ext_ = 0; if (spend) { if (++sage == Side::LAG) { if (Side::LAG == 1) PG8_WAIT_V(8); PG8_SIDE_STORE(); spend = false; ext_ += 4; } } \
        if (!spend && (sit % Side::PERIOD == 0) && (sstep < SD.nsteps)) { PG8_SIDE_LOAD(); spend = true; sage = 0; ext_ += 4; } ++sit; sext = ext_; } } while (0)
#define PG8_WAIT_K() do { if constexpr (Side::ON) { if (sext == 0) PG8_WAIT_V(8); else if (sext == 4) PG8_WAIT_V(12); else PG8_WAIT_V(16); } else PG8_WAIT_V(8); } while (0)
#define PG8_VON_LOAD(y0, y1, y2, y3) do { typedef unsigned u32x2_ __attribute__((ext_vector_type(2))); const u32x2_ q_ = *(const PG8_LAS u32x2_*)(lds + LDS_VON + tid * 8); \
        const unsigned rs_ = (unsigned)__builtin_ctz((unsigned)(K * 2)), m_ = (unsigned)(K * 2) - 1u, c0_ = voC[0] & m_, c1_ = voC[1] & m_; \
        y0 = ((q_.x & 0xffffu) << rs_) | c0_; y1 = ((q_.x >> 16) << rs_) | c1_; y2 = ((q_.y & 0xffffu) << rs_) | c0_; y3 = ((q_.y >> 16) << rs_) | c1_; } while (0)
    Unit cur, nxt; int ui = 0;
    if (!S.next(0, cur)) {
        if constexpr (Side::ON) { while (sstep < SD.nsteps) { PG8_SIDE_LOAD(); PG8_WAIT_V(0); PG8_SIDE_STORE(); } PG8_WAIT_V(0); }
        return;
    }
    f32x4 acc[2][2][4][2];
#pragma unroll
    for (int a = 0; a < 2; ++a)
#pragma unroll
        for (int b = 0; b < 2; ++b)
#pragma unroll
            for (int m = 0; m < 4; ++m)
#pragma unroll
                for (int n = 0; n < 2; ++n) acc[a][b][m][n] = (f32x4){0.f, 0.f, 0.f, 0.f};
    bf16x8 At[4][2], B0[2][2], B1[2][2];
    unsigned voC[4];
    PG8_AROWS(voC, cur, 0);
    const char* cA = (const char*)Arows; const char* cB = (const char*)Btiles + (size_t)cur.pn * tstep;
    PG8_STAGE(PG8_SB(0, 0), cB, voffB); PG8_STAGE(PG8_SB(0, 1), cB + hstep, voffB); PG8_STAGE2(PG8_SA(0, 0), cA, voC[0], voC[1]); PG8_STAGE2(PG8_SA(0, 1), cA, voC[2], voC[3]);
    if (wr == 1) PG8_BAR;
    PG8_WAIT_V(2); PG8_BAR;
    PG8_STAGE(PG8_SB(1, 0), cB + kstep, voffB); PG8_STAGE2(PG8_SA(1, 0), cA + kstep, voC[0], voC[1]); PG8_STAGE(PG8_SB(1, 1), cB + hstep + kstep, voffB);
    PG8_WAIT_V(6); PG8_BAR;
    for (;;) {
        const bool has_next = S.next(ui + 1, nxt);
        if (has_next) { unsigned vn_[4]; PG8_AROWS(vn_, nxt, ui + 1); typedef unsigned u32x2_ __attribute__((ext_vector_type(2)));
            const unsigned rs_ = (unsigned)__builtin_ctz((unsigned)(K * 2));
            *(PG8_LAS u32x2_*)(lds + LDS_VON + tid * 8) = (u32x2_){(vn_[0] >> rs_) | ((vn_[1] >> rs_) << 16), (vn_[2] >> rs_) | ((vn_[3] >> rs_) << 16)}; }
        const char* nB = has_next ? (const char*)Btiles + (size_t)nxt.pn * tstep : cB;
        for (int t = 0; t < nt; t += 2) {
            const bool last = (t == nt - 2);
            const char* a1 = cA + (size_t)(t + 1) * kstep;
            const char* a2 = last ? cA : cA + (size_t)(t + 2) * kstep; const char* b2 = last ? nB : cB + (size_t)(t + 2) * kstep;
            const char* a3 = a2 + kstep; const char* b3 = b2 + kstep;
            PG8_LDB(B0, 0, 0); PG8_LDB(B1, 0, 1); PG8_SCHED; PG8_LDA(At, 0, 0); PG8_STAGE2(PG8_SA(1, 1), a1, voC[2], voC[3]);
            if (last && has_next) PG8_VON_LOAD(voC[0], voC[1], voC[2], voC[3]);
            PG8_WAIT_K(); PG8_WAIT_L(0); PG8_BAR; PG8_MMA(0, 0, At, B0); PG8_MMA(0, 1, At, B1); PG8_BAR; PG8_SCHED;
            PG8_LDA(At, 0, 1); PG8_STAGE(PG8_SB(0, 0), b2, voffB); PG8_STAGE(PG8_SB(0, 1), b2 + hstep, voffB); PG8_STAGE2(PG8_SA(0, 0), a2, voC[0], voC[1]);
            PG8_WAIT_K(); PG8_SIDE_SLOT(); PG8_WAIT_L(0); PG8_BAR; PG8_MMA(1, 0, At, B0); PG8_MMA(1, 1, At, B1); PG8_BAR; PG8_SCHED;
            PG8_LDB(B0, 1, 0); PG8_LDB(B1, 1, 1); PG8_SCHED; PG8_LDA(At, 1, 0); PG8_STAGE2(PG8_SA(0, 1), a2, voC[2], voC[3]);
            PG8_WAIT_K(); PG8_WAIT_L(0); PG8_BAR; PG8_MMA(0, 0, At, B0); PG8_MMA(0, 1, At, B1); PG8_BAR; PG8_SCHED;
            PG8_LDA(At, 1, 1); PG8_STAGE(PG8_SB(1, 0), b3, voffB); PG8_STAGE(PG8_SB(1, 1), b3 + hstep, voffB); PG8_STAGE2(PG8_SA(1, 0), a3, voC[0], voC[1]);
            PG8_WAIT_K(); if constexpr (Side::PAIR) { sext = 0; } else { PG8_SIDE_SLOT(); } PG8_WAIT_L(0); PG8_BAR; PG8_MMA(1, 0, At, B0); PG8_MMA(1, 1, At, B1); PG8_BAR; PG8_SCHED;
        }
        if (wr == 0) PG8_BAR;
        if constexpr (epi_f8<Epi>::v) asm volatile("s_nop 7\n\ts_nop 7\n\ts_nop 7\n\ts_nop 7");
        E(acc, cur, wr, wc, fr, fq); S.done(cur);
        if (!has_next) break;
#pragma unroll
        for (int a = 0; a < 2; ++a)
#pragma unroll
            for (int b = 0; b < 2; ++b)
#pragma unroll
                for (int m = 0; m < 4; ++m)
#pragma unroll
                    for (int n = 0; n < 2; ++n) acc[a][b][m][n] = (f32x4){0.f, 0.f, 0.f, 0.f};
        cur = nxt; cB = nB; ++ui;
        if (wr == 1) PG8_BAR;
    }
    PG8_WAIT_V(0);
    PG8_BAR;
    if constexpr (Side::ON) { if (spend) { PG8_SIDE_STORE(); } while (sstep < SD.nsteps) { PG8_SIDE_LOAD(); PG8_WAIT_V(0); PG8_SIDE_STORE(); } PG8_WAIT_V(0); }
#undef PG8_SA
#undef PG8_SB
#undef PG8_STAGE
#undef PG8_STAGE2
#undef PG8_DMA
#undef PG8_LDA
#undef PG8_LDB
#undef PG8_MMA
#undef PG8_WAIT_V
#undef PG8_WAIT_L
#undef PG8_BAR
#undef PG8_SCHED
#undef PG8_AROWS
#undef PG8_SIDE_LOAD
#undef PG8_VON_LOAD
#undef PG8_SGV
#undef PG8_SDV
#undef PG8_SIDE_STORE
#undef PG8_SIDE_SLOT
#undef PG8_WAIT_K
}
}

struct NoSide { static constexpr bool ON = false, PAIR = false; static constexpr int PERIOD = 1, LAG = 1; int ldb, first, stride, nsteps;
    __device__ __forceinline__ const float* src(int, int, int) const { return nullptr; } __device__ __forceinline__ bf16* dst(int, int, int) const { return nullptr; } };
template <int PER, int LG> struct SideGU { static constexpr bool ON = true, PAIR = false; static constexpr int PERIOD = PER, LAG = LG; const float* w; unsigned char* wt; int ldb, first, stride, nsteps;
    __device__ __forceinline__ const float* src(int hs, int kh, int nq) const { const int qq = hs & 3, st = hs >> 2, tile = st >> 4, kt = st & 15, e = tile >> 4, j = tile & 15;
        return w + (size_t)e * 2048 * 4096 + (size_t)(128 * kt) * 4096 + ((qq >> 1) ? 2048 : 0) + 128 * j + 64 * (qq & 1) + 8 * nq; }
    __device__ __forceinline__ unsigned char* dst(int hs, int kh, int nq) const { const int qq = hs & 3, st = hs >> 2, tile = st >> 4, kt = st & 15; return wt + ((size_t)tile * 256 + 64 * qq + 8 * nq) * 2048 + 128 * kt; } };
template <int PER, int LG> struct SideDown { static constexpr bool ON = true, PAIR = true  ; static constexpr int PERIOD = PER, LAG = LG; const float* w; unsigned char* wt; int ldb, first, stride, nsteps;
    __device__ __forceinline__ const float* src(int hs, int kh, int nq) const { const int qq = hs & 3, st = hs >> 2, tile = st >> 4, kt = st & 15, e = tile >> 3, j = tile & 7;
        return w + (size_t)e * 2048 * 2048 + (size_t)(128 * kt) * 2048 + 256 * j + 64 * qq + 8 * nq; }
    __device__ __forceinline__ unsigned char* dst(int hs, int kh, int nq) const { const int qq = hs & 3, st = hs >> 2, tile = st >> 4, kt = st & 15; return wt + ((size_t)tile * 256 + 64 * qq + 8 * nq) * 2048 + 128 * kt; } };

__device__ __forceinline__ void phase10(const Ctx& C) {
    unsigned char* ws = C.ws;
    const bf16* x1b = (const bf16*)(ws + (size_t)X1B_T0 * MiB); const bf16* ybuf = (const bf16*)(ws + WS_YBUF);
    const float* g2 = C.A.in[26]; const float* b2 = C.A.in[27]; const int lane = C.lane;
    f32x4 gg8[8], bb8[8];
#pragma unroll
    for (int j = 0; j < 8; ++j) { const int c0 = (lane + 64 * j) * 4; gg8[j] = *(const f32x4*)(g2 + c0); bb8[j] = *(const f32x4*)(b2 + c0); }
    for (int tok = C.gw; tok < T; tok += C.NGW) {
        f32x4 v[8]; float s = 0.f;
#pragma unroll
        for (int j = 0; j < 8; ++j) { const int c0 = (lane + 64 * j) * 4; const v2u xw = *(const v2u*)(x1b + (size_t)tok * D + c0); f32x4 a = (f32x4){bflo(xw.x), bfhi(xw.x), bflo(xw.y), bfhi(xw.y)} * DN_ALPHA;
#pragma unroll
            for (int k = 0; k < 4; ++k) { const v2u yw = *(const v2u*)(ybuf + ((size_t)tok * 4 + k) * D + c0); a = a + (f32x4){bflo(yw.x), bfhi(yw.x), bflo(yw.y), bfhi(yw.y)}; }
            v[j] = a; s += (a.x + a.y) + (a.z + a.w); }
        const float mean = wave_sum(s) * (1.0f / D); float q = 0.f;
#pragma unroll
        for (int j = 0; j < 8; ++j) { v[j] = v[j] - mean; q += (v[j].x * v[j].x + v[j].y * v[j].y) + (v[j].z * v[j].z + v[j].w * v[j].w); }
        const float rstd = 1.0f / sqrtf(wave_sum(q) * (1.0f / D) + LN_EPS);
#pragma unroll
        for (int j = 0; j < 8; ++j) { const int c0 = (lane + 64 * j) * 4; *(f32x4*)(C.out + (size_t)tok * D + c0) = v[j] * rstd * gg8[j] + bb8[j]; }
    }
}

__global__ void __launch_bounds__(NTHREADS, 2) fwd_kernel(KArgs args) {
    extern __shared__ __attribute__((aligned(16))) unsigned char lds_raw[];
    const int tid_ = threadIdx.x, wave_ = __builtin_amdgcn_readfirstlane(tid_ >> 6), G_ = gridDim.x;
    Ctx C{args, args.out, args.ws, (LAS unsigned char*)lds_raw, tid_, tid_ & 63, wave_, G_, (int)blockIdx.x * NWAVES + wave_, G_ * NWAVES};
    volatile LAS unsigned* MISC = (volatile LAS unsigned*)(C.lds + LDS_MISC);
    if (C.tid < 4) MISC[C.tid] = 0u;
    __syncthreads();
    unsigned* ctl = (unsigned*)(args.ws + WS_CTL);
    XcdBarrier bar; bar.bar = ctl + CW_BAR; bar.x = 0; bar.st = MISC;
    const int lo = args.ph_lo, hi = args.ph_hi;
    if (hi - lo > 1) bar = xcd_barrier_post(ctl + CW_BAR, MISC);
#ifdef PROBE_PHASE
    unsigned long long pt0_ = 0, pdt_ = 0;
#define PT_BEGIN(k) do { if ((k) == PROBE_PHASE) pt0_ = __builtin_amdgcn_s_memrealtime(); } while (0)
#define PT_END(k) do { if ((k) == PROBE_PHASE) pdt_ = __builtin_amdgcn_s_memrealtime() - pt0_; } while (0)
#else
#define PT_BEGIN(k)
#define PT_END(k)
#endif
#ifndef PHASE_MASK
#define PHASE_MASK 0x7ff
#endif
#define IN(k) (((PHASE_MASK >> (k)) & 1) && lo <= (k) && (k) < hi)
#define SEAM(k) do { if (IN(k) && IN((k) + 1)) xcd_barrier(bar); PT_END(k); PT_BEGIN((k) + 1); } while (0)
    const pg8::Gemm g{(const pg8::bf16_t*)args.ws, (const pg8::bf16_t*)args.ws, 0, 0, 2048};
    PG8_LAS unsigned char* glds = (PG8_LAS unsigned char*)lds_raw;

#ifndef PROBE_DOUBLE
#define PROBE_DOUBLE 0
#endif
#define REP(k) for (int _rep = 0; _rep < (((PROBE_DOUBLE >> (k)) & 1) ? 2 : 1); ++_rep)
    PT_BEGIN(0);
    if (IN(0)) { REP(0) phase0(C); } SEAM(0);
    if (IN(1)) {
        Gemm1Order S{C.G, (int)blockIdx.x};
        unsigned char* ws = args.ws;
        Epi1 E{C.A.in[2], (bf16*)(ws + WS_HYT), (bf16*)(ws + WS_QKRAW), (bf16*)(ws + WS_VB), (bf16*)(ws + WS_OB), (float*)(ws + WS_GATES)};
#if MOE_SIDE
        { SideGU<SIDE_GU_PERIOD, SIDE_GU_LAG> SD{C.A.in[22], PROBE_SIDE_DUMMY ? (unsigned char*)(ws + WS_YBUF) : (unsigned char*)(ws + (size_t)WGU_T0 * MiB), 4096, (int)blockIdx.x, C.G, SIDE_GU_EXPERTS * 16 * 32 * 2};
          pg8::gemm_phase_ga<Epi1, Gemm1Order, SideGU<SIDE_GU_PERIOD, SIDE_GU_LAG>>(glds, (const pg8::bf16_t*)ws, (const pg8::bf16_t*)ws, 2048, S, E, SD); }
#else
        REP(1) pg8::gemm_phase<Epi1, Gemm1Order, true, true>(glds, g, S, E);
#endif
        { const pg8::Gemm g2{(const pg8::bf16_t*)(ws + WS_W3P), (const pg8::bf16_t*)(ws + WS_H2P), 0, 0, 256}; KtOrder S2{C.G, (int)blockIdx.x}; EpiKT E2{(float*)(ws + WS_KT)};
          pg8::gemm_phase<EpiKT, KtOrder, true, true>(glds, g2, S2, E2); }
    } SEAM(1);
    if (IN(2)) { REP(2) phase2(C); } SEAM(2);
    if (IN(3)) { REP(3) hyena_fft(C); REP(11) { mlstm_mfma(C); } } SEAM(3);
    if (IN(4)) { REP(4) phase4(C); } SEAM(4);
    if (IN(5)) {
        TileOrder S{32, 8, (OUTPROJ_F8 ? 2 : 1) * YCAT_T0, (OUTPROJ_F8 ? 2 : 1) * WOUT_T0, C.G, (int)blockIdx.x};
        const pg8::Gemm g5{(const pg8::bf16_t*)args.ws, (const pg8::bf16_t*)args.ws, 0, 0, OUTPROJ_F8 ? 1024 : 2048};
        EpiOut E{C.A.in[0], C.A.in[17], (float*)(args.ws + WS_R1)};
        REP(5) pg8::gemm_phase<EpiOut, TileOrder, true, true>(glds, g5, S, E);
    } SEAM(5);
    if (IN(6)) { REP(6) phase6(C, _rep); } if (IN(6) && IN(8)) xcd_barrier(bar); PT_END(6); PT_BEGIN(8);
    if (IN(8)) {
        moe_build_tb(C);
        MoeOrder S{(const LAS int*)(C.lds + LDS_TB), 16, ABUF_T0, WGU_Q0, C.G, (int)blockIdx.x, (const int*)(args.ws + WS_LIST), 1, (const LAS int*)(C.lds + LDS_UL), (const LAS int*)(C.lds + LDS_ROWT)};
        S.setup(C.tid);
        EpiGU E{C.A.in[23], args.ws + (size_t)ACT_T0 * MiB, 1.0f / W8_SCALE};
#if MOE_SIDE
        { SideDown<SIDE_DN_PERIOD, SIDE_DN_LAG> SD{C.A.in[24], PROBE_SIDE_DUMMY ? (unsigned char*)(args.ws + WS_YBUF) : (unsigned char*)(args.ws + (size_t)WDN_T0 * MiB), 2048, (int)blockIdx.x, C.G, NE * 8 * 32 * 2};
          pg8::gemm_phase_ga<EpiGU, MoeOrder, SideDown<SIDE_DN_PERIOD, SIDE_DN_LAG>>(glds, (const pg8::bf16_t*)(args.ws + WS_X1Q), (const pg8::bf16_t*)args.ws, 1024, S, E, SD); }
#else
        { NoSide SD{0, 0, 0, 0}; REP(8) pg8::gemm_phase_ga<EpiGU, MoeOrder, NoSide>(glds, (const pg8::bf16_t*)(args.ws + WS_X1Q), (const pg8::bf16_t*)args.ws, 1024, S, E, SD); }
#endif
    } SEAM(8);
    if (IN(9)) {
        moe_build_tb(C);
        MoeOrder S{(const LAS int*)(C.lds + LDS_TB), 8, ACT_Q0, WDN_Q0, C.G, (int)blockIdx.x, (const int*)(args.ws + WS_LIST), 0, (const LAS int*)(C.lds + LDS_UL), (const LAS int*)(C.lds + LDS_ROWT)};
        S.setup(C.tid);
        EpiDown E{C.A.in[25], (const int*)(args.ws + WS_LIST), (const float*)(args.ws + WS_TOKW), (const LAS int*)(C.lds + LDS_TB), (bf16*)(args.ws + WS_YBUF), 1.0f / W8_SCALE};
        const pg8::Gemm g9{(const pg8::bf16_t*)args.ws, (const pg8::bf16_t*)args.ws, 0, 0, 1024};
        REP(9) pg8::gemm_phase<EpiDown, MoeOrder, true, true>(glds, g9, S, E);
    } SEAM(9);
    if (IN(10)) { REP(10) phase10(C); }
#ifdef PROBE_PHASE
    PT_END(10);
    if (blockIdx.x == 0 && C.wave == 0) { const unsigned long long te_ = __builtin_amdgcn_s_memrealtime(); while (__builtin_amdgcn_s_memrealtime() - te_ < 9ull * pdt_) __builtin_amdgcn_s_sleep(32); }
#endif
#ifdef PROBE_BARRIERS
    if (hi - lo > 1) for (int i_ = 0; i_ < PROBE_BARRIERS; ++i_) xcd_barrier(bar);
#endif
#undef IN
#undef SEAM
}

extern "C" void kernel_launch(void* const* d_in, const int* in_sizes, int n_in, void* d_out, int out_size, void* d_ws, size_t ws_size, hipStream_t stream) {
    static int grid = 0;
    if (grid == 0) {
        if (n_in != 28 || in_sizes[0] != T * D || out_size != T * D || ws_size < WS_END) { fprintf(stderr, "kernel_launch: unexpected shapes (n_in %d, in0 %d, out %d, ws %zu)\n", n_in, n_in > 0 ? in_sizes[0] : -1, out_size, ws_size); grid = -1; return; }
        int dev = 0, cus = 0;
        if (hipGetDevice(&dev) != hipSuccess || hipDeviceGetAttribute(&cus, hipDeviceAttributeMultiprocessorCount, dev) != hipSuccess) { grid = -1; return; }
        if (hipFuncSetAttribute((const void*)fwd_kernel, hipFuncAttributeMaxDynamicSharedMemorySize, LDS_BYTES) != hipSuccess) { fprintf(stderr, "kernel_launch: hipFuncSetAttribute failed\n"); grid = -1; return; }
        int per_cu = 0;
        if (hipOccupancyMaxActiveBlocksPerMultiprocessor(&per_cu, (const void*)fwd_kernel, NTHREADS, LDS_BYTES) != hipSuccess || per_cu < 1) fprintf(stderr, "kernel_launch: occupancy query says %d\n", per_cu);
        (void)hipGetLastError();
        grid = cus;
    }
    if (grid < 0) return;
    if (hipMemsetAsync((char*)d_ws + WS_CTL, 0, CTL_ZERO_BYTES, stream) != hipSuccess) return;
    KArgs a{};
    for (int i = 0; i < 28; ++i) a.in[i] = (const float*)d_in[i];
    a.out = (float*)d_out; a.ws = (unsigned char*)d_ws;
#if MK_ONE_LAUNCH
    a.ph_lo = 0; a.ph_hi = N_PHASES;
    hipLaunchKernelGGL(fwd_kernel, dim3(grid), dim3(NTHREADS), LDS_BYTES, stream, a);
#else
    for (int ph = 0; ph < N_PHASES; ++ph) { a.ph_lo = ph; a.ph_hi = ph + 1; hipLaunchKernelGGL(fwd_kernel, dim3(grid), dim3(NTHREADS), LDS_BYTES, stream, a); }
#endif
}
```
